# Optimizing an MI355X kernel written in HIP

```python
import jax, jax.numpy as jnp
from jax import lax
import numpy as np

D_MODEL = 2048
BATCH = 2
SEQ = 4096
DEPTH = 1

MIX_WIDTH = D_MODEL
POOL_WIDTH = MIX_WIDTH // 2
POOL_WINDOWS = (2, 4, 8, 16)
POOL_GROUP = POOL_WIDTH // len(POOL_WINDOWS)
FOX_WIDTH = MIX_WIDTH - POOL_WIDTH
FOX_HEADS = 8
FOX_HEAD_DIM = FOX_WIDTH // FOX_HEADS
Q_BLOCK = 128
IN_COLS = POOL_WIDTH + 3 * FOX_WIDTH + FOX_HEADS
N_MEM = 256
XATTN_HEADS = 4
XATTN_HEAD_DIM = D_MODEL // XATTN_HEADS
PEER_HEADS = 8
PEER_KEYS = 128
PEER_EXPERTS = PEER_KEYS * PEER_KEYS
PEER_QUERY_DIM = 256
PEER_HALF = PEER_QUERY_DIM // 2
PEER_TOPK = 16
PEER_TOKEN_CHUNK = 128
EPS = 1e-6

kernel_name = "hymba_pool_fox_peer_layer"


def rms_norm(x, g):
    xf = x.astype(jnp.float32)
    y = xf * lax.rsqrt(jnp.mean(xf * xf, axis=-1, keepdims=True) + EPS)
    return (y * g.astype(jnp.float32)).astype(x.dtype)


def causal_window_mean(x, w):
    S = x.shape[1]
    cs = jnp.pad(jnp.cumsum(x.astype(jnp.float32), axis=1), ((0, 0), (1, 0), (0, 0)))
    upper = cs[:, 1:]
    lower = jnp.pad(cs, ((0, 0), (w - 1, 0), (0, 0)))[:, :S]
    count = jnp.minimum(jnp.arange(S) + 1, w).astype(jnp.float32)[None, :, None]
    return ((upper - lower) / count).astype(x.dtype)


def pool_mixer(a, pool_w, pool_scale):
    B, S, _ = a.shape
    groups = a.reshape(B, S, len(POOL_WINDOWS), POOL_GROUP)
    diffs = jnp.stack([causal_window_mean(groups[:, :, i], w) - groups[:, :, i]
                       for i, w in enumerate(POOL_WINDOWS)], axis=2)
    y = jnp.einsum('bsgc,gcd->bsgd', diffs, pool_w).reshape(B, S, POOL_WIDTH)
    return y * pool_scale


def forgetting_attention(q, k, v, f_logit):
    B, S, H, Dh = q.shape
    c = jnp.cumsum(jax.nn.log_sigmoid(f_logit.astype(jnp.float32)), axis=1).transpose(0, 2, 1)
    qh = q.transpose(0, 2, 1, 3) * (Dh ** -0.5)
    kh = k.transpose(0, 2, 1, 3)
    vh = v.transpose(0, 2, 1, 3)
    outs = []
    for start in range(0, S, Q_BLOCK):
        end = start + Q_BLOCK
        s = jnp.einsum('bhqd,bhkd->bhqk', qh[:, :, start:end], kh[:, :, :end]).astype(jnp.float32)
        s = s + c[:, :, start:end, None] - c[:, :, None, :end]
        causal = jnp.arange(end)[None, :] <= jnp.arange(start, end)[:, None]
        s = jnp.where(causal, s, -jnp.inf)
        p = jax.nn.softmax(s, axis=-1).astype(vh.dtype)
        outs.append(jnp.einsum('bhqk,bhkd->bhqd', p, vh[:, :, :end]))
    o = jnp.concatenate(outs, axis=2)
    return o.transpose(0, 2, 1, 3).reshape(B, S, H * Dh)


def memory_cross_attention(h, m, wq, wk, wv, wo):
    B, S, D = h.shape
    M = m.shape[1]
    q = (h @ wq).reshape(B, S, XATTN_HEADS, XATTN_HEAD_DIM)
    k = (m @ wk).reshape(B, M, XATTN_HEADS, XATTN_HEAD_DIM)
    v = (m @ wv).reshape(B, M, XATTN_HEADS, XATTN_HEAD_DIM)
    s = jnp.einsum('bshd,bmhd->bhsm', q, k).astype(jnp.float32) * (XATTN_HEAD_DIM ** -0.5)
    p = jax.nn.softmax(s, axis=-1).astype(v.dtype)
    o = jnp.einsum('bhsm,bmhd->bshd', p, v).reshape(B, S, D)
    return o @ wo


def peer_ffn(h, w_query, sub_keys, expert_u, expert_v):
    B, S, D = h.shape
    q = (h @ w_query).reshape(B, S, PEER_HEADS, 2, PEER_HALF)
    scores = jnp.einsum('bshcd,hckd->bshck', q, sub_keys).astype(jnp.float32)
    s_top, i_top = lax.top_k(scores, PEER_TOPK)
    cand = s_top[..., 0, :, None] + s_top[..., 1, None, :]
    cand_idx = i_top[..., 0, :, None] * PEER_KEYS + i_top[..., 1, None, :]
    cand = cand.reshape(B, S, PEER_HEADS, PEER_TOPK * PEER_TOPK)
    cand_idx = cand_idx.reshape(B, S, PEER_HEADS, PEER_TOPK * PEER_TOPK)
    best, pos = lax.top_k(cand, PEER_TOPK)
    expert_idx = jnp.take_along_axis(cand_idx, pos, axis=-1)
    gate = jax.nn.softmax(best, axis=-1).astype(h.dtype)
    T = B * S
    n_chunks = T // PEER_TOKEN_CHUNK
    K = PEER_HEADS * PEER_TOPK
    xs = h.reshape(n_chunks, PEER_TOKEN_CHUNK, D)
    idx = expert_idx.reshape(n_chunks, PEER_TOKEN_CHUNK, K)
    gs = gate.reshape(n_chunks, PEER_TOKEN_CHUNK, K)

    def chunk_fn(args):
        xc, ic, gc = args
        u = jnp.take(expert_u, ic, axis=0)
        act = jax.nn.gelu(jnp.einsum('ckd,cd->ck', u, xc), approximate=False)
        vv = jnp.take(expert_v, ic, axis=0)
        return jnp.einsum('ck,ckd->cd', gc * act, vv)

    out = lax.map(chunk_fn, (xs, idx, gs))
    return out.reshape(B, S, D)


def setup_inputs(seed: int = 0) -> dict:
    key = jax.random.key(seed)
    ks = jax.random.split(key, 24)
    n = jax.random.normal
    D = D_MODEL
    f32 = jnp.float32
    return {
        "x": n(ks[0], (BATCH, SEQ, D), f32),
        "mem": n(ks[1], (BATCH, N_MEM, D), f32),
        "mix_norm": 1.0 + 0.05 * n(ks[2], (DEPTH, D), f32),
        "w_in": n(ks[3], (DEPTH, D, IN_COLS), f32) * D ** -0.5,
        "b_forget": 3.0 + 0.1 * n(ks[4], (DEPTH, FOX_HEADS), f32),
        "pool_w": n(ks[5], (DEPTH, len(POOL_WINDOWS), POOL_GROUP, POOL_GROUP), f32) * POOL_GROUP ** -0.5,
        "pool_scale": 1.0 + 0.1 * n(ks[6], (DEPTH, POOL_WIDTH), f32),
        "w_out": n(ks[7], (DEPTH, MIX_WIDTH, D), f32) * MIX_WIDTH ** -0.5,
        "xattn_norm": 1.0 + 0.05 * n(ks[8], (DEPTH, D), f32),
        "mem_norm": 1.0 + 0.05 * n(ks[9], (DEPTH, D), f32),
        "xattn_wq": n(ks[10], (DEPTH, D, D), f32) * D ** -0.5,
        "xattn_wk": n(ks[11], (DEPTH, D, D), f32) * D ** -0.5,
        "xattn_wv": n(ks[12], (DEPTH, D, D), f32) * D ** -0.5,
        "xattn_wo": n(ks[13], (DEPTH, D, D), f32) * D ** -0.5,
        "peer_norm": 1.0 + 0.05 * n(ks[14], (DEPTH, D), f32),
        "peer_wq": n(ks[15], (DEPTH, D, PEER_HEADS * PEER_QUERY_DIM), f32) * D ** -0.5,
        "peer_sub_keys": n(ks[16], (DEPTH, PEER_HEADS, 2, PEER_KEYS, PEER_HALF), f32) * PEER_HALF ** -0.5,
        "peer_u": n(ks[17], (DEPTH, PEER_EXPERTS, D), f32) * D ** -0.5,
        "peer_v": n(ks[18], (DEPTH, PEER_EXPERTS, D), f32) * 0.3,
        "final_norm": 1.0 + 0.05 * n(ks[19], (D,), f32),
    }


def reference(x, mem, mix_norm, w_in, b_forget, pool_w, pool_scale, w_out,
              xattn_norm, mem_norm, xattn_wq, xattn_wk, xattn_wv, xattn_wo,
              peer_norm, peer_wq, peer_sub_keys, peer_u, peer_v, final_norm):
    B, S, _ = x.shape
    h = x
    for l in range(DEPTH):
        a = rms_norm(h, mix_norm[l])
        proj = a @ w_in[l]
        o0 = POOL_WIDTH
        a_pool = proj[..., :o0]
        q = proj[..., o0:o0 + FOX_WIDTH].reshape(B, S, FOX_HEADS, FOX_HEAD_DIM)
        k = proj[..., o0 + FOX_WIDTH:o0 + 2 * FOX_WIDTH].reshape(B, S, FOX_HEADS, FOX_HEAD_DIM)
        v = proj[..., o0 + 2 * FOX_WIDTH:o0 + 3 * FOX_WIDTH].reshape(B, S, FOX_HEADS, FOX_HEAD_DIM)
        f_logit = proj[..., o0 + 3 * FOX_WIDTH:] + b_forget[l]
        y_pool = pool_mixer(a_pool, pool_w[l], pool_scale[l])
        y_fox = forgetting_attention(q, k, v, f_logit)
        h = h + jnp.concatenate([y_pool, y_fox], axis=-1) @ w_out[l]
        m = rms_norm(mem, mem_norm[l])
        h = h + memory_cross_attention(rms_norm(h, xattn_norm[l]), m,
                                       xattn_wq[l], xattn_wk[l], xattn_wv[l], xattn_wo[l])
        h = h + peer_ffn(rms_norm(h, peer_norm[l]), peer_wq[l], peer_sub_keys[l], peer_u[l], peer_v[l])
    return rms_norm(h, final_norm)
```

```cpp
#include <hip/hip_runtime.h>
#include <hip/hip_bf16.h>
#include <cstdio>
#include <cstdint>

#ifndef MK_ONE_LAUNCH
#define MK_ONE_LAUNCH 1
#endif

constexpr int BATCH = 2, SEQ = 4096, DM = 2048, TOK = BATCH * SEQ;
constexpr int INC = 4104, POOLW = 1024, FOXH = 8, FOXD = 128;
constexpr int NMEM = 256, XH = 4, XD = 512;
constexpr int PH = 8, PKEYS = 128, PEXP = 16384, TOPK = 16;
constexpr float EPS = 1e-6f;
constexpr float LOG2E = 1.4426950408889634f;

namespace pg8 {
#define PG8_LAS __attribute__((address_space(3)))
typedef unsigned short bf16_t;
typedef short bf16x8 __attribute__((ext_vector_type(8)));
typedef float f32x4 __attribute__((ext_vector_type(4)));
typedef float f32x2 __attribute__((ext_vector_type(2)));
typedef unsigned u32x4 __attribute__((ext_vector_type(4)));
typedef unsigned u32x2 __attribute__((ext_vector_type(2)));
constexpr int BM = 256, BK = 64, HALF = 128, HTB = HALF * BK * 2, STAGE_BYTES = 8 * HTB, NXCD = 8, WGM = 8;

__host__ __device__ __forceinline__ int lds_byte(int r, int c) { const int st = (r >> 4) * 2 + (c >> 5), rr = r & 15, cc = c & 31, ob = rr * 64 + cc * 2; return st * 1024 + (ob ^ (((ob >> 9) & 1) << 5)); }
__host__ __device__ __forceinline__ void stage_rc(int b, int& R, int& C) { const int st = b / 1024, sb = b % 1024, swz = sb ^ (((sb >> 9) & 1) << 5); R = (st >> 1) * 16 + swz / 64; C = (st & 1) * 32 + (swz % 64) / 2; }
__host__ __device__ __forceinline__ int perm32(int rho) { const int n = rho >> 4, i = rho & 15; return 8 * (i >> 2) + 4 * n + (i & 3); }

struct Unit { int pm, pn, z; long aoff, boff; };
struct Gemm { const bf16_t* A; const bf16_t* Bt; int K, lda, ldb; };

struct GSched {
    int nM, nN, nH, nZ, G, c; long sAb, sAh, sBb, sBh; int lda, ldb;
    __device__ __forceinline__ void init(int nM_, int nN_, int G_, int c_, int lda_, int ldb_) { nM = nM_; nN = nN_; nH = 1; nZ = 1; G = G_; c = c_; sAb = sAh = sBb = sBh = 0; lda = lda_; ldb = ldb_; }
    __device__ __forceinline__ bool next(int i, Unit& u) const {
        const long L = (long)i * G + c; const int nwg = nM * nN; if (L >= (long)nwg * nZ) return false;
        const int z = (int)(L / nwg); int wgid = (int)(L % nwg);
        { const int q = nwg / NXCD, r = nwg % NXCD, xcd = wgid % NXCD, off = wgid / NXCD; wgid = (xcd < r ? xcd * (q + 1) : r * (q + 1) + (xcd - r) * q) + off; }
        const int nig = WGM * nN, gid = wgid / nig, fm = gid * WGM, gsz = (nM - fm) < WGM ? (nM - fm) : WGM;
        u.pm = fm + ((wgid % nig) % gsz); u.pn = (wgid % nig) / gsz; u.z = z;
        const int zb = z / nH, zh = z % nH;
        u.aoff = zb * sAb + zh * sAh + (long)u.pm * BM * lda; u.boff = zb * sBb + zh * sBh + (long)u.pn * BM * ldb;
        return true;
    }
    __device__ __forceinline__ void a_ready(const Unit&) const {}
    __device__ __forceinline__ void done(const Unit&) const {}
};

__device__ __forceinline__ unsigned cvt_pk_bf16(float lo, float hi) { unsigned r; asm volatile("v_cvt_pk_bf16_f32 %0, %1, %2" : "=v"(r) : "v"(lo), "v"(hi)); return r; }


struct EpiStore {
    static constexpr bool PERM = true, AFTER_DRAIN = false;
    bf16_t* O; int ldc; long sCb, sCh; int nH;
    const float* ss; float rs_mul;
    int t0, t1; float tscale;
    __device__ __forceinline__ void operator()(const f32x4 (&acc)[2][2][4][2], const Unit& u, int wr, int wc, int fr, int fq) const {
        const int row0 = u.pm * BM + wr * 64 + fr, col0 = u.pn * BM + wc * 32 + 8 * fq;
        bf16_t* base = O + (u.z / nH) * sCb + (u.z % nH) * sCh;
        const float ts = (u.pn >= t0 && u.pn < t1) ? tscale : 1.f;
#pragma unroll
        for (int ai = 0; ai < 2; ++ai)
#pragma unroll
            for (int m = 0; m < 4; ++m) { const int row = row0 + ai * HALF + m * 16;
                float sc = ts; if (ss) sc *= __builtin_amdgcn_rsqf(ss[row] * (1.f / DM) + EPS) * rs_mul;
                bf16_t* rowp = base + (size_t)row * ldc + col0;
#pragma unroll
                for (int bj = 0; bj < 2; ++bj) { const f32x4 v0 = acc[ai][bj][m][0] * sc, v1 = acc[ai][bj][m][1] * sc;
                    u32x4 w; w.x = cvt_pk_bf16(v0[0], v0[1]); w.y = cvt_pk_bf16(v0[2], v0[3]); w.z = cvt_pk_bf16(v1[0], v1[1]); w.w = cvt_pk_bf16(v1[2], v1[3]);
                    *(u32x4*)(rowp + bj * HALF) = w; } }
    }
};
struct EpiResid {
    static constexpr bool PERM = true, AFTER_DRAIN = false;
    const float* base; float* H; bf16_t* HB; float* ss;
    __device__ __forceinline__ void operator()(const f32x4 (&acc)[2][2][4][2], const Unit& u, int wr, int wc, int fr, int fq) const {
        const int row0 = u.pm * BM + wr * 64 + fr, col0 = u.pn * BM + wc * 32 + 8 * fq;
#pragma unroll
        for (int ai = 0; ai < 2; ++ai)
#pragma unroll
            for (int m = 0; m < 4; ++m) { const int row = row0 + ai * HALF + m * 16; const size_t off = (size_t)row * DM + col0; float sq = 0.f;
#pragma unroll
                for (int bj = 0; bj < 2; ++bj) {
                    const f32x4 b0 = *(const f32x4*)(base + off + bj * HALF), b1 = *(const f32x4*)(base + off + bj * HALF + 4);
                    const f32x4 h0 = b0 + acc[ai][bj][m][0], h1 = b1 + acc[ai][bj][m][1];
                    *(f32x4*)(H + off + bj * HALF) = h0; *(f32x4*)(H + off + bj * HALF + 4) = h1;
                    u32x4 w; w.x = cvt_pk_bf16(h0[0], h0[1]); w.y = cvt_pk_bf16(h0[2], h0[3]); w.z = cvt_pk_bf16(h1[0], h1[1]); w.w = cvt_pk_bf16(h1[2], h1[3]);
                    *(u32x4*)(HB + off + bj * HALF) = w;
                    sq += (h0[0] * h0[0] + h0[1] * h0[1]) + (h0[2] * h0[2] + h0[3] * h0[3]) + (h1[0] * h1[0] + h1[1] * h1[1]) + (h1[2] * h1[2] + h1[3] * h1[3]); }
                sq += __shfl_xor(sq, 16); sq += __shfl_xor(sq, 32);
                if (fq == 0) atomicAdd(ss + row, sq); }
    }
};
struct EpiF32Col {
    static constexpr bool PERM = true, AFTER_DRAIN = false;
    float* O; int ldc; const float* ss;
    __device__ __forceinline__ void operator()(const f32x4 (&acc)[2][2][4][2], const Unit& u, int wr, int wc, int fr, int fq) const {
        const int row0 = u.pm * BM + wr * 64 + fr, col0 = u.pn * BM + wc * 32 + 8 * fq;
        f32x4 rs[2][2];
#pragma unroll
        for (int bj = 0; bj < 2; ++bj)
#pragma unroll
            for (int n = 0; n < 2; ++n) { const f32x4 s = *(const f32x4*)(ss + col0 + bj * HALF + 4 * n);
#pragma unroll
                for (int e = 0; e < 4; ++e) rs[bj][n][e] = __builtin_amdgcn_rsqf(s[e] * (1.f / DM) + EPS); }
#pragma unroll
        for (int ai = 0; ai < 2; ++ai)
#pragma unroll
            for (int m = 0; m < 4; ++m) { float* rowp = O + (size_t)(row0 + ai * HALF + m * 16) * ldc + col0;
#pragma unroll
                for (int bj = 0; bj < 2; ++bj) { *(f32x4*)(rowp + bj * HALF) = acc[ai][bj][m][0] * rs[bj][0]; *(f32x4*)(rowp + bj * HALF + 4) = acc[ai][bj][m][1] * rs[bj][1]; } }
    }
};
struct EpiSoftmax {
    static constexpr bool PERM = true, AFTER_DRAIN = true;
    bf16_t* P; int ldc; long sCb, sCh; int nH;
    __device__ __forceinline__ void fused(f32x4 (&acc)[2][2][4][2], const Unit& u, int wr, int wc, int fr, int fq, PG8_LAS unsigned char* lds, int wid, int lane) const {
        PG8_LAS float* Pm = (PG8_LAS float*)lds;
        PG8_LAS float* Ps = (PG8_LAS float*)(lds + 4096);
#pragma unroll
        for (int ai = 0; ai < 2; ++ai)
#pragma unroll
            for (int m = 0; m < 4; ++m) { float mx = -3.0e38f;
#pragma unroll
                for (int bj = 0; bj < 2; ++bj)
#pragma unroll
                    for (int n = 0; n < 2; ++n) { const f32x4 x = acc[ai][bj][m][n]; mx = fmaxf(mx, fmaxf(fmaxf(x[0], x[1]), fmaxf(x[2], x[3]))); }
                mx = fmaxf(mx, __shfl_xor(mx, 16)); mx = fmaxf(mx, __shfl_xor(mx, 32));
                if (fq == 0) Pm[(ai * HALF + wr * 64 + m * 16 + fr) * 4 + wc] = mx; }
        asm volatile("s_waitcnt lgkmcnt(0)" ::: "memory"); __builtin_amdgcn_s_barrier(); asm volatile("" ::: "memory");
#pragma unroll
        for (int ai = 0; ai < 2; ++ai)
#pragma unroll
            for (int m = 0; m < 4; ++m) { const int r = ai * HALF + wr * 64 + m * 16 + fr;
                const f32x4 pm4 = *(const PG8_LAS f32x4*)(Pm + r * 4); const float M = fmaxf(fmaxf(pm4[0], pm4[1]), fmaxf(pm4[2], pm4[3])); float s = 0.f;
#pragma unroll
                for (int bj = 0; bj < 2; ++bj)
#pragma unroll
                    for (int n = 0; n < 2; ++n) { f32x4 x = acc[ai][bj][m][n];
#pragma unroll
                        for (int e = 0; e < 4; ++e) { x[e] = __builtin_amdgcn_exp2f(x[e] - M); s += x[e]; }
                        acc[ai][bj][m][n] = x; }
                s += __shfl_xor(s, 16); s += __shfl_xor(s, 32);
                if (fq == 0) Ps[r * 4 + wc] = s; }
        asm volatile("s_waitcnt lgkmcnt(0)" ::: "memory"); __builtin_amdgcn_s_barrier(); asm volatile("" ::: "memory");
        bf16_t* base = P + (u.z / nH) * sCb + (u.z % nH) * sCh;
        const int row0 = u.pm * BM, col0 = u.pn * BM + wc * 32 + 8 * fq;
#pragma unroll
        for (int ai = 0; ai < 2; ++ai)
#pragma unroll
            for (int m = 0; m < 4; ++m) { const int r = ai * HALF + wr * 64 + m * 16 + fr;
                const f32x4 ps4 = *(const PG8_LAS f32x4*)(Ps + r * 4); const float inv = 1.f / ((ps4[0] + ps4[1]) + (ps4[2] + ps4[3]));
                bf16_t* rowp = base + (size_t)(row0 + r) * ldc + col0;
#pragma unroll
                for (int bj = 0; bj < 2; ++bj) { const f32x4 v0 = acc[ai][bj][m][0] * inv, v1 = acc[ai][bj][m][1] * inv;
                    u32x4 w; w.x = cvt_pk_bf16(v0[0], v0[1]); w.y = cvt_pk_bf16(v0[2], v0[3]); w.z = cvt_pk_bf16(v1[0], v1[1]); w.w = cvt_pk_bf16(v1[2], v1[3]);
                    *(u32x4*)(rowp + bj * HALF) = w; } }
    }
};

template <class Epi, class Sched, bool ALIGN_EPI>
__device__ __forceinline__ void gemm_phase(PG8_LAS unsigned char* lds, const Gemm g, const Sched& S, const Epi& E) {
    const int tid = threadIdx.x, wid = __builtin_amdgcn_readfirstlane(tid >> 6), lane = tid & 63, wr = wid >> 2, wc = wid & 3, fr = lane & 15, fq = lane >> 4;
    const int K = g.K, nt = K / BK;
    unsigned voffA[2], voffB[2];
#pragma unroll
    for (int i = 0; i < 2; ++i) { int R, C; stage_rc(tid * 16 + i * 8192, R, C); const int Rb = Epi::PERM ? ((R & ~31) + perm32(R & 31)) : R;
        voffA[i] = (unsigned)(R * g.lda + C) * 2u; voffB[i] = (unsigned)(Rb * g.ldb + C) * 2u; }
    const size_t kstep = (size_t)(BK * 2);
    const size_t hsA = (size_t)HALF * g.lda * 2, hsB = (size_t)HALF * g.ldb * 2;
    const unsigned ldsw = (unsigned)wid * 1024u;
    const int aoff = lds_byte(wr * 64 + fr, fq * 8), boff = lds_byte(wc * 32 + fr, fq * 8);
#define PG8_SA(b, h) (((b) * 2 + (h)) * HTB)
#define PG8_SB(b, h) ((4 + (b) * 2 + (h)) * HTB)
#define PG8_STAGE(bufoff, gbase, voff) do { _Pragma("unroll") for (int _i = 0; _i < 2; ++_i) \
        __builtin_amdgcn_global_load_lds((const unsigned*)((const char*)(gbase) + (voff)[_i]), (PG8_LAS unsigned*)(lds + (bufoff) + ldsw + _i * 8192), 16, 0, 0); } while (0)
#define PG8_LDA(dst, b, h) do { _Pragma("unroll") for (int m = 0; m < 4; ++m) _Pragma("unroll") for (int k = 0; k < 2; ++k) dst[m][k] = *(const PG8_LAS bf16x8*)(lds + PG8_SA(b, h) + aoff + m * 2048 + k * 1024); } while (0)
#define PG8_LDB(dst, b, h) do { _Pragma("unroll") for (int n = 0; n < 2; ++n) _Pragma("unroll") for (int k = 0; k < 2; ++k) dst[n][k] = *(const PG8_LAS bf16x8*)(lds + PG8_SB(b, h) + boff + n * 2048 + k * 1024); } while (0)
#define PG8_MMA(ai, bj, At, Bt) do { __builtin_amdgcn_s_setprio(1); _Pragma("unroll") for (int m = 0; m < 4; ++m) _Pragma("unroll") for (int n = 0; n < 2; ++n) _Pragma("unroll") for (int k = 0; k < 2; ++k) \
        acc[ai][bj][m][n] = __builtin_amdgcn_mfma_f32_16x16x32_bf16(Bt[n][k], At[m][k], acc[ai][bj][m][n], 0, 0, 0); __builtin_amdgcn_s_setprio(0); } while (0)
#define PG8_WAIT_V(n) asm volatile("s_waitcnt vmcnt(" #n ")" ::: "memory")
#define PG8_WAIT_L(n) asm volatile("s_waitcnt lgkmcnt(" #n ")" ::: "memory")
#define PG8_BAR __builtin_amdgcn_s_barrier()
#define PG8_SCHED __builtin_amdgcn_sched_barrier(0)
    Unit cur, nxt; int ui = 0;
    if (!S.next(0, cur)) return;
    f32x4 acc[2][2][4][2];
#pragma unroll
    for (int a = 0; a < 2; ++a)
#pragma unroll
        for (int b = 0; b < 2; ++b)
#pragma unroll
            for (int m = 0; m < 4; ++m)
#pragma unroll
                for (int n = 0; n < 2; ++n) acc[a][b][m][n] = (f32x4){0.f, 0.f, 0.f, 0.f};
    bf16x8 At[4][2], B0[2][2], B1[2][2];
    const char* cA = (const char*)g.A + (size_t)cur.aoff * 2; const char* cB = (const char*)g.Bt + (size_t)cur.boff * 2;
    S.a_ready(cur);
    PG8_STAGE(PG8_SB(0, 0), cB, voffB); PG8_STAGE(PG8_SB(0, 1), cB + hsB, voffB); PG8_STAGE(PG8_SA(0, 0), cA, voffA); PG8_STAGE(PG8_SA(0, 1), cA + hsA, voffA);
    if (wr == 1) PG8_BAR;
    PG8_WAIT_V(2); PG8_BAR;
    PG8_STAGE(PG8_SB(1, 0), cB + kstep, voffB); PG8_STAGE(PG8_SA(1, 0), cA + kstep, voffA); PG8_STAGE(PG8_SB(1, 1), cB + hsB + kstep, voffB);
    PG8_WAIT_V(6); PG8_BAR;
    for (;;) {
        const bool has_next = S.next(ui + 1, nxt);
        const char* nA = has_next ? (const char*)g.A + (size_t)nxt.aoff * 2 : cA; const char* nB = has_next ? (const char*)g.Bt + (size_t)nxt.boff * 2 : cB;
        for (int t = 0; t < nt; t += 2) {
            const bool last = (t == nt - 2);
            const char* a1 = cA + (size_t)(t + 1) * kstep;
            const char* a2 = last ? nA : cA + (size_t)(t + 2) * kstep; const char* b2 = last ? nB : cB + (size_t)(t + 2) * kstep;
            const char* a3 = a2 + kstep; const char* b3 = b2 + kstep;
            if (last && has_next) S.a_ready(nxt);
            PG8_LDB(B0, 0, 0); PG8_LDB(B1, 0, 1); PG8_SCHED; PG8_LDA(At, 0, 0); PG8_STAGE(PG8_SA(1, 1), a1 + hsA, voffA);
            PG8_WAIT_V(8); PG8_WAIT_L(0); PG8_BAR; PG8_MMA(0, 0, At, B0); PG8_MMA(0, 1, At, B1); PG8_BAR; PG8_SCHED;
            PG8_LDA(At, 0, 1); PG8_STAGE(PG8_SB(0, 0), b2, voffB); PG8_STAGE(PG8_SB(0, 1), b2 + hsB, voffB); PG8_STAGE(PG8_SA(0, 0), a2, voffA);
            PG8_WAIT_V(8); PG8_WAIT_L(0); PG8_BAR; PG8_MMA(1, 0, At, B0); PG8_MMA(1, 1, At, B1); PG8_BAR; PG8_SCHED;
            PG8_LDB(B0, 1, 0); PG8_LDB(B1, 1, 1); PG8_SCHED; PG8_LDA(At, 1, 0); PG8_STAGE(PG8_SA(0, 1), a2 + hsA, voffA);
            PG8_WAIT_V(8); PG8_WAIT_L(0); PG8_BAR; PG8_MMA(0, 0, At, B0); PG8_MMA(0, 1, At, B1); PG8_BAR; PG8_SCHED;
            PG8_LDA(At, 1, 1); PG8_STAGE(PG8_SB(1, 0), b3, voffB); PG8_STAGE(PG8_SB(1, 1), b3 + hsB, voffB); PG8_STAGE(PG8_SA(1, 0), a3, voffA);
            PG8_WAIT_V(8); PG8_WAIT_L(0); PG8_BAR; PG8_MMA(1, 0, At, B0); PG8_MMA(1, 1, At, B1); PG8_BAR; PG8_SCHED;
        }
        if constexpr (ALIGN_EPI) { if (wr == 0) PG8_BAR; }
        if constexpr (!Epi::AFTER_DRAIN) { E(acc, cur, wr, wc, fr, fq); S.done(cur); }
        if (!has_next) break;
#pragma unroll
        for (int a = 0; a < 2; ++a)
#pragma unroll
            for (int b = 0; b < 2; ++b)
#pragma unroll
                for (int m = 0; m < 4; ++m)
#pragma unroll
                    for (int n = 0; n < 2; ++n) acc[a][b][m][n] = (f32x4){0.f, 0.f, 0.f, 0.f};
        cur = nxt; cA = nA; cB = nB; ++ui;
        if constexpr (ALIGN_EPI) { if (wr == 1) PG8_BAR; }
    }
    PG8_WAIT_V(0);
    if constexpr (!ALIGN_EPI) { if (wr == 0) PG8_BAR; }
    PG8_BAR;
    if constexpr (Epi::AFTER_DRAIN) { E.fused(acc, cur, wr, wc, fr, fq, lds, wid, lane); S.done(cur); }
#undef PG8_SA
#undef PG8_SB
#undef PG8_STAGE
#undef PG8_LDA
#undef PG8_LDB
#undef PG8_MMA
#undef PG8_WAIT_V
#undef PG8_WAIT_L
#undef PG8_BAR
#undef PG8_SCHED
}
}

namespace fox {
typedef unsigned short bf16_t;
typedef short bf16x8 __attribute__((ext_vector_type(8)));
typedef short s16x4 __attribute__((ext_vector_type(4)));
typedef float f32x16 __attribute__((ext_vector_type(16)));
typedef float f32x4 __attribute__((ext_vector_type(4)));
typedef unsigned u32x4 __attribute__((ext_vector_type(4)));
constexpr int D = 128, NW = 8, QBLK = 32, KVBLK = 64, QB = NW * QBLK;
constexpr int SHM_V = KVBLK * D * 2, SHM_K = KVBLK * D * 2;
constexpr int LDS_C = 2 * SHM_V + 2 * SHM_K + NW * 64 * 4;
constexpr int LDS_BYTES = LDS_C + SEQ * 4;
constexpr int QP = 4096, OP = 2048;
constexpr float THR = 24.f;
#define KSWZ(row, colB) ((row) * 256 + ((colB) ^ (((row) & 7) << 4)))
#define SBAR() __builtin_amdgcn_sched_barrier(0)
__device__ __forceinline__ int v_st(int k, int c) { const int kk = (k & ~0xC) | ((k & 4) << 1) | ((k & 8) >> 1); return ((kk >> 3) * 4 + (c >> 5)) * 512 + ((kk & 7) * 32 + (c & 31)) * 2; }
__device__ __forceinline__ int v_rd_base(int lane) { return ((lane & 3) << 3) | (((lane >> 2) & 3) << 6) | (((lane >> 4) & 1) << 5) | (((lane >> 5) & 1) << 8); }
constexpr int v_rd_off(int d0, int ks, int half) { return d0 * 512 + ks * 4096 + half * 2048; }
__device__ __forceinline__ int crow(int r, int hi) { return (r & 3) + 8 * (r >> 2) + 4 * hi; }
__device__ __forceinline__ unsigned cvtpk(float lo, float hi) { unsigned r; asm volatile("v_cvt_pk_bf16_f32 %0, %1, %2" : "=v"(r) : "v"(lo), "v"(hi)); return r; }
__device__ __forceinline__ bf16x8 load8(const bf16_t* p) { return *reinterpret_cast<const bf16x8*>(p); }
__device__ __forceinline__ void mask_tile(f32x16& p0, f32x16& p1, int dq) {
    const float NEG = -__builtin_inff();
#pragma unroll
    for (int r = 0; r < 16; ++r) { const int c = (r & 3) + 8 * (r >> 2); if (dq - c < 0) p0[r] = NEG; if (dq - c - 32 < 0) p1[r] = NEG; }
}
__device__ __forceinline__ void bias_tile(f32x16& p0, f32x16& p1, const float* cb) {
#pragma unroll
    for (int i = 0; i < 4; ++i) { const f32x4 c0 = *(const f32x4*)(cb + 8 * i), c1 = *(const f32x4*)(cb + 32 + 8 * i);
#pragma unroll
        for (int j = 0; j < 4; ++j) { p0[4 * i + j] -= c0[j]; p1[4 * i + j] -= c1[j]; } }
}
__device__ __forceinline__ void partialSM(f32x16& p0, f32x16& p1, float& m_reg, float& mn, float& alpha) {
    float pmax = p0[0]; for (int r = 1; r < 16; ++r) pmax = fmaxf(pmax, p0[r]); for (int r = 0; r < 16; ++r) pmax = fmaxf(pmax, p1[r]);
    { auto rr = __builtin_amdgcn_permlane32_swap(__float_as_uint(pmax), __float_as_uint(pmax), false, false);
      pmax = fmaxf(__uint_as_float(rr[0]), __uint_as_float(rr[1])); }
    if (__builtin_expect(__all((pmax - m_reg) <= THR), 1)) { mn = m_reg; alpha = 1.f; }
    else { mn = fmaxf(m_reg, pmax); alpha = __builtin_amdgcn_exp2f(m_reg - mn); m_reg = mn; }
    for (int r = 0; r < 16; ++r) p0[r] = p0[r] - mn; for (int r = 0; r < 16; ++r) p1[r] = p1[r] - mn;
    for (int r = 0; r < 16; ++r) p0[r] = __builtin_amdgcn_exp2f(p0[r]);
}
__device__ __forceinline__ void finishSM(f32x16& p0, f32x16& p1, float alpha, float& l_reg, bf16x8& pa0, bf16x8& pa1, bf16x8& pa2, bf16x8& pa3) {
    for (int r = 0; r < 16; ++r) p1[r] = __builtin_amdgcn_exp2f(p1[r]);
    float ps = 0; for (int r = 0; r < 16; ++r) ps += p0[r]; for (int r = 0; r < 16; ++r) ps += p1[r];
    { auto rr = __builtin_amdgcn_permlane32_swap(__float_as_uint(ps), __float_as_uint(ps), false, false);
      ps = __uint_as_float(rr[0]) + __uint_as_float(rr[1]); }
    l_reg = l_reg * alpha + ps;
#define PK4(P, B_, OUT) do { unsigned a0 = cvtpk(P[B_+0], P[B_+1]), a1 = cvtpk(P[B_+2], P[B_+3]);                          \
        unsigned b0 = cvtpk(P[B_+4], P[B_+5]), b1 = cvtpk(P[B_+6], P[B_+7]);                                             \
        auto r0 = __builtin_amdgcn_permlane32_swap(a0, b0, false, false); auto r1 = __builtin_amdgcn_permlane32_swap(a1, b1, false, false); \
        u32x4 w = {r0[0], r1[0], r0[1], r1[1]}; OUT = *reinterpret_cast<bf16x8*>(&w); } while (0)
    PK4(p0, 0, pa0); PK4(p0, 8, pa1); PK4(p1, 0, pa2); PK4(p1, 8, pa3);
#undef PK4
}
template <int KB>
__device__ __forceinline__ void qkt(f32x16& p0, f32x16& p1, const char* K_lds, int r32, int hi, const bf16x8* qr) {
    p0 = f32x16{}; p1 = f32x16{};
    const char* kb[4];
#pragma unroll
    for (int dd = 0; dd < 4; ++dd) kb[dd] = K_lds + KB * SHM_K + KSWZ(r32, (dd * 16 + hi * 8) * 2);
#pragma unroll
    for (int d0 = 0; d0 < 8; ++d0) { const char* a = kb[d0 & 3] + (d0 >> 2) * 128;
        bf16x8 b0 = *reinterpret_cast<const bf16x8*>(a);
        bf16x8 b1 = *reinterpret_cast<const bf16x8*>(a + 32 * 256);
        p0 = __builtin_amdgcn_mfma_f32_32x32x16_bf16(b0, qr[d0], p0, 0, 0, 0);
        p1 = __builtin_amdgcn_mfma_f32_32x32x16_bf16(b1, qr[d0], p1, 0, 0, 0); }
}
template <int VB>
__device__ __forceinline__ void pv_tile(f32x16* o, int vb0, bf16x8 pa0, bf16x8 pa1, bf16x8 pa2, bf16x8 pa3) {
#define TRRD(dst, off) asm volatile("ds_read_b64_tr_b16 %0, %1 offset:%2" : "=&v"(dst) : "v"(vb0), "i"(off) : "memory")
#define PV_D0(d0) do { s16x4 l0, l1, l2, l3, h0, h1, h2, h3; constexpr int b_ = VB * SHM_V + v_rd_off(d0, 0, 0); \
        TRRD(l0, b_); TRRD(h0, b_ + 2048); TRRD(l1, b_ + 4096); TRRD(h1, b_ + 6144); TRRD(l2, b_ + 8192); TRRD(h2, b_ + 10240); TRRD(l3, b_ + 12288); TRRD(h3, b_ + 14336); \
        asm volatile("s_waitcnt lgkmcnt(0)" ::: "memory"); SBAR();   \
        o[d0] = __builtin_amdgcn_mfma_f32_32x32x16_bf16(pa0, (bf16x8){l0[0], l0[1], l0[2], l0[3], h0[0], h0[1], h0[2], h0[3]}, o[d0], 0, 0, 0);   \
        o[d0] = __builtin_amdgcn_mfma_f32_32x32x16_bf16(pa1, (bf16x8){l1[0], l1[1], l1[2], l1[3], h1[0], h1[1], h1[2], h1[3]}, o[d0], 0, 0, 0);   \
        o[d0] = __builtin_amdgcn_mfma_f32_32x32x16_bf16(pa2, (bf16x8){l2[0], l2[1], l2[2], l2[3], h2[0], h2[1], h2[2], h2[3]}, o[d0], 0, 0, 0);   \
        o[d0] = __builtin_amdgcn_mfma_f32_32x32x16_bf16(pa3, (bf16x8){l3[0], l3[1], l3[2], l3[3], h3[0], h3[1], h3[2], h3[3]}, o[d0], 0, 0, 0); } while (0)
    PV_D0(0); PV_D0(1); PV_D0(2); PV_D0(3);
#undef PV_D0
#undef TRRD
}
struct BlockRef { const bf16_t* Q; const bf16_t* K; const bf16_t* V; bf16_t* O; int P0; };
struct Seam { bf16x8 qr[8]; bf16x8 st_v0, st_v1, st_k0, st_k1; };
#define ROW(p, k0, rr) ((p) + (size_t)((k0) + (rr)) * QP + sc)
#define VMW() asm volatile("s_waitcnt vmcnt(0)" ::: "memory")
#define VMWN(n) asm volatile("s_waitcnt vmcnt(%0)" :: "i"(n) : "memory")
#define SLOAD_H(Kp, Vp, k0) do { S.st_v0 = load8(ROW(Vp, k0, sr)); S.st_v1 = load8(ROW(Vp, k0, 32 + sr)); S.st_k0 = load8(ROW(Kp, k0, sr)); S.st_k1 = load8(ROW(Kp, k0, 32 + sr)); } while (0)
#define SWRITE_HK(bf) do { *(bf16x8*)(K_lds + (bf) * SHM_K + kws) = S.st_k0; *(bf16x8*)(K_lds + (bf) * SHM_K + kws + 32 * 256) = S.st_k1; } while (0)
#define SWRITE_HV(bf) do { *(bf16x8*)(V_lds + (bf) * SHM_V + vst0) = S.st_v0; *(bf16x8*)(V_lds + (bf) * SHM_V + vst1) = S.st_v1; } while (0)
#define SWRITE_H(bf) do { SWRITE_HV(bf); SWRITE_HK(bf); } while (0)
__device__ __forceinline__ void prime(const BlockRef& cur, char* lds, Seam& S) {
    const int tid = threadIdx.x, wid = __builtin_amdgcn_readfirstlane(tid >> 6), lane = tid & 63, r32 = lane & 31, hi = lane >> 5;
    const int sr = tid >> 4, sc = (tid & 15) * 8, kws = KSWZ(sr, sc * 2); char* K_lds = lds + 2 * SHM_V;
    for (int d0 = 0; d0 < 8; ++d0) S.qr[d0] = load8(cur.Q + (size_t)(wid * QBLK + r32) * QP + d0 * 16 + hi * 8);
    SLOAD_H(cur.K, cur.V, 0); VMW(); SWRITE_HK(0);
    __syncthreads();
}
__device__ __forceinline__ void block(const BlockRef& cur, const BlockRef& nxt, char* lds, Seam& S) {
    const int tid = threadIdx.x, wid = __builtin_amdgcn_readfirstlane(tid >> 6), lane = tid & 63, r32 = lane & 31, hi = lane >> 5;
    const int NT = (cur.P0 + QB - 1) / KVBLK + 1;
    const int qlo = cur.P0 + wid * QBLK, qm = qlo + r32 - 4 * hi;
    char* V_lds = lds; char* K_lds = lds + 2 * SHM_V;
    float* ws = (float*)(lds + 2 * SHM_V + 2 * SHM_K) + wid * 64; float* li_l = ws, * al_l = ws + 32;
    const float* c_lds = (const float*)(lds + LDS_C) + 4 * hi;
    float m_reg = -1e30f, l_reg = 0; f32x16 o[4] = {};
    const int sr = tid >> 4, sc = (tid & 15) * 8, vst0 = v_st(sr, sc), vst1 = v_st(32 + sr, sc), kws = KSWZ(sr, sc * 2);
    const int vb0 = (int)(uintptr_t)V_lds + v_rd_base(lane);
    const bf16_t* Kh = cur.K; const bf16_t* Vh = cur.V;
#define RESC(a) do { if (__any((a) < 1.f)) { if (hi == 0) al_l[r32] = (a); asm volatile("s_waitcnt lgkmcnt(0)" ::: "memory");              \
                     for (int d_ = 0; d_ < 4; ++d_) for (int r = 0; r < 16; ++r) o[d_][r] *= al_l[crow(r, hi)]; } } while (0)
#define KBASE(t) ((t) * KVBLK)
#define MASKT(P0_, P1_, t) do { const int kb_ = KBASE(t); bias_tile(P0_, P1_, c_lds + kb_); if (kb_ + KVBLK - 1 > qlo) mask_tile(P0_, P1_, qm - kb_); } while (0)
#define SEAM_K0() do { VMWN(8); SWRITE_HK(0); SBAR(); } while (0)
    f32x16 pA0, pA1, pB0, pB1; float mnA, mnB, alA, alB; bf16x8 pa0, pa1, pa2, pa3;
    SWRITE_HV(0); SBAR();
    if (NT > 1) { SLOAD_H(Kh, Vh, KBASE(1)); }
    SBAR(); qkt<0>(pA0, pA1, K_lds, r32, hi, S.qr);
    MASKT(pA0, pA1, 0); partialSM(pA0, pA1, m_reg, mnA, alA);
    if (NT > 1) { VMW(); SWRITE_H(1); }
    __syncthreads();
#define HALF_STEP(PX0, PX1, mnX, alX, PY0, PY1, alY, t, KB, VB, SB) do {                                                      \
        SBAR(); qkt<KB>(PX0, PX1, K_lds, r32, hi, S.qr);                                                                     \
        finishSM(PY0, PY1, alY, l_reg, pa0, pa1, pa2, pa3); SBAR();                                                           \
        if ((t) + 1 < NT) { SLOAD_H(Kh, Vh, KBASE((t) + 1)); SBAR(); }                                                        \
        pv_tile<VB>(o, vb0, pa0, pa1, pa2, pa3); MASKT(PX0, PX1, (t)); partialSM(PX0, PX1, m_reg, mnX, alX);                 \
        __syncthreads();                                                                                                      \
        if ((t) + 1 < NT) { VMW(); SWRITE_H(SB); }                                                                            \
        RESC(alX); __syncthreads(); } while (0)
    for (int t = 1; t + 1 < NT; t += 2) {
        HALF_STEP(pB0, pB1, mnB, alB, pA0, pA1, alA, t, 1, 0, 0);
        HALF_STEP(pA0, pA1, mnA, alA, pB0, pB1, alB, t + 1, 0, 1, 1);
    }
    const bool even = (NT & 1) == 0;
    if (even) { SBAR(); qkt<1>(pB0, pB1, K_lds, r32, hi, S.qr); SBAR(); }
    SLOAD_H(nxt.K, nxt.V, 0); SBAR();
#pragma unroll
    for (int d0 = 0; d0 < 8; ++d0) S.qr[d0] = load8(nxt.Q + (size_t)(wid * QBLK + r32) * QP + d0 * 16 + hi * 8);
    SBAR();
    finishSM(pA0, pA1, alA, l_reg, pa0, pa1, pa2, pa3); SBAR();
    pv_tile<0>(o, vb0, pa0, pa1, pa2, pa3);
    if (even) { MASKT(pB0, pB1, NT - 1); partialSM(pB0, pB1, m_reg, mnB, alB); __syncthreads(); RESC(alB);
        finishSM(pB0, pB1, alB, l_reg, pa0, pa1, pa2, pa3); SBAR(); pv_tile<1>(o, vb0, pa0, pa1, pa2, pa3); }
    SBAR(); SEAM_K0();
    if (hi == 0) li_l[r32] = l_reg; asm volatile("s_waitcnt lgkmcnt(0)" ::: "memory");
    float rli[16];
#pragma unroll
    for (int r = 0; r < 16; ++r) rli[r] = __builtin_amdgcn_rcpf(li_l[crow(r, hi)]);
    bf16_t* Ow = cur.O + (size_t)(wid * QBLK) * OP;
#pragma unroll
    for (int r = 0; r < 16; ++r) { const int orow = crow(r, hi);
#pragma unroll
        for (int d0 = 0; d0 < 4; ++d0) { const float v = o[d0][r] * rli[r];
            const float vn = __shfl_xor(v, 1);
            if ((r32 & 1) == 0) *(unsigned*)(Ow + (size_t)orow * OP + d0 * 32 + r32) = cvtpk(v, vn); } }
    __syncthreads();
#undef RESC
#undef KBASE
#undef MASKT
#undef SEAM_K0
#undef HALF_STEP
}
#undef ROW
#undef VMW
#undef VMWN
#undef SLOAD_H
#undef SWRITE_HK
#undef SWRITE_HV
#undef SWRITE_H
#undef KSWZ
#undef SBAR
}

constexpr int NWAVES = 8, NTHREADS = 512;
constexpr int LDS_BYTES = 147456;
constexpr int LDS_MISC = 145408;
constexpr size_t MiB = 1u << 20;
constexpr size_t WS_CTL = 0, CTL_ZERO_BYTES = 1 * MiB;
constexpr int CW_BAR = 4096;
constexpr size_t CTL_SS1 = 256 * 1024, CTL_SS2 = 320 * 1024;
constexpr size_t WS_LF = 1 * MiB;
constexpr size_t WS_WIN = 2 * MiB, WS_WO1 = 18 * MiB, WS_WO2 = 26 * MiB, WS_WQ = 34 * MiB, WS_WK = 42 * MiB, WS_WV = 50 * MiB, WS_WO = 58 * MiB;
constexpr size_t WS_WPQ = 66 * MiB, WS_AEXP = 74 * MiB, WS_WSC = 82 * MiB, WS_PB = 90 * MiB, WS_MN = 91 * MiB, WS_KX = 93 * MiB, WS_VXT = 95 * MiB;
constexpr size_t WS_UB = 98 * MiB, WS_VB = 162 * MiB, WS_XN = 226 * MiB, WS_PROJ = 258 * MiB, WS_AMIX = 322 * MiB, WS_H = 354 * MiB, WS_HB = 418 * MiB, WS_P = 450 * MiB, WS_END = 466 * MiB;

#define GAS __attribute__((address_space(1)))
#define LAS __attribute__((address_space(3)))
typedef unsigned short bf16;
typedef unsigned v4u __attribute__((ext_vector_type(4)));
typedef unsigned v2u __attribute__((ext_vector_type(2)));
typedef float f32x4 __attribute__((ext_vector_type(4)));
typedef __bf16 bf16x2_t __attribute__((ext_vector_type(2)));
#define LDS_WAIT() asm volatile("s_waitcnt lgkmcnt(0)" ::: "memory")
__device__ __forceinline__ unsigned f2bf(float f) { unsigned u = __builtin_bit_cast(unsigned, f); return (u + 0x7fffu + ((u >> 16) & 1u)) >> 16; }
__device__ __forceinline__ unsigned pk2(float lo, float hi) { return f2bf(lo) | (f2bf(hi) << 16); }
__device__ __forceinline__ float wave_sum(float v) {
#pragma unroll
    for (int o = 1; o < 64; o <<= 1) v += __shfl_xor(v, o);
    return v;
}

#define XB_TMO      128
#define XB_XCNT(j)  (256  + 64 * (j))
#define XB_XSUB(j)  (1280 + 64 * (j))
#define XB_XGEN(j)  (2304 + 64 * (j))
#define XB_TOP      3328
#define XB_TOPGEN   3392
#define XCD_BAR_WORDS 3456
#define XB_SPIN_CAP (1u << 22)
__device__ __forceinline__ unsigned xb_ld(unsigned* p)              { return __hip_atomic_load(p, __ATOMIC_RELAXED, __HIP_MEMORY_SCOPE_AGENT); }
__device__ __forceinline__ unsigned xb_add(unsigned* p, unsigned v) { return __hip_atomic_fetch_add(p, v, __ATOMIC_RELAXED, __HIP_MEMORY_SCOPE_AGENT); }
__device__ __forceinline__ unsigned xb_xcc_id() { return (unsigned)__builtin_amdgcn_s_getreg((3 << 11) | 20) & 0xFu; }
#define XB_SPIN(cond, bar) do { unsigned _sp = 0; while (cond) { __builtin_amdgcn_s_sleep(1); \
    if ((++_sp & 255u) == 0u) { if (xb_ld(&(bar)[XB_TMO])) break; if (_sp > XB_SPIN_CAP) { atomicAdd(&(bar)[XB_TMO], 1u); break; } } } } while (0)
struct XcdBarrier { unsigned* bar; unsigned x; volatile LAS unsigned* st; };
__device__ __forceinline__ XcdBarrier xcd_barrier_post(unsigned* bar, volatile LAS unsigned* st) {
    XcdBarrier b; b.bar = bar; b.x = xb_xcc_id(); b.st = st;
    if (threadIdx.x == 0) (void)xb_add(&bar[XB_XCNT(b.x)], 1u);
    return b;
}
__device__ __forceinline__ void xcd_barrier_complete(unsigned* bar, unsigned x, unsigned& nloc, unsigned& nx) {
    const unsigned G = gridDim.x * gridDim.y * gridDim.z;
    unsigned sum, cnt, mine, sp = 0u;
    for (;;) {
        sum = 0u; cnt = 0u; mine = 0u;
#pragma unroll
        for (unsigned j = 0; j < 16; ++j) { const unsigned c = xb_ld(&bar[XB_XCNT(j)]); sum += c; cnt += (c > 0u) ? 1u : 0u; mine = (j == x) ? c : mine; }
        if (sum == G) break;
        __builtin_amdgcn_s_sleep(1);
        if ((++sp & 255u) == 0u) { if (xb_ld(&bar[XB_TMO])) break; if (sp > XB_SPIN_CAP) { atomicAdd(&bar[XB_TMO], 1u); break; } }
    }
    nloc = mine > 0u ? mine : 1u; nx = cnt > 0u ? cnt : 1u;
}
__device__ __forceinline__ void xcd_barrier(const XcdBarrier& b) {
    asm volatile("s_waitcnt vmcnt(0)" ::: "memory");
    __syncthreads();
    if (threadIdx.x == 0) {
        unsigned* bar = b.bar;
        __builtin_amdgcn_s_waitcnt(0);
        unsigned nloc = b.st[0], nx = b.st[1];
        if (nloc == 0u) { xcd_barrier_complete(bar, b.x, nloc, nx); b.st[0] = nloc; b.st[1] = nx; }
        const unsigned old = xb_add(&bar[XB_XSUB(b.x)], 1u);
        const unsigned gen = old / nloc;
        if (old + 1u == (gen + 1u) * nloc) {
            __builtin_amdgcn_fence(__ATOMIC_RELEASE, "agent");
            asm volatile("s_waitcnt vmcnt(0)" ::: "memory");
            const unsigned og = xb_add(&bar[XB_TOP], 1u);
            const unsigned tg = og / nx;
            if (og + 1u == (tg + 1u) * nx) xb_add(&bar[XB_TOPGEN], 1u);
            else XB_SPIN(xb_ld(&bar[XB_TOPGEN]) == tg, bar);
            __builtin_amdgcn_fence(__ATOMIC_ACQUIRE, "agent");
            xb_add(&bar[XB_XGEN(b.x)], 1u);
            asm volatile("s_waitcnt vmcnt(0)" ::: "memory");
        } else {
            XB_SPIN(xb_ld(&bar[XB_XGEN(b.x)]) == gen, bar);
            __builtin_amdgcn_fence(__ATOMIC_ACQUIRE, "agent");
            asm volatile("s_waitcnt vmcnt(0)" ::: "memory");
        }
    }
    __syncthreads();
}

struct Args { const float* in[20]; float* out; unsigned char* ws; int ph_lo, ph_hi; int one_launch, pad; };

__device__ __forceinline__ void p0_transpose_item(const float* W, int ldw, int nblk, const float* g, bf16* WT, bf16* WT2, int k2lo, int ldt, LAS float* scr, int item, int lane) {
    const int kb = item / nblk, nb = item % nblk, k0 = 64 * kb, n0 = 32 * nb;
#pragma unroll 8
    for (int i = 0; i < 32; ++i) { const int kk = 2 * i + (lane >> 5); float v = W[(size_t)(k0 + kk) * ldw + n0 + (lane & 31)]; if (g) v *= g[k0 + kk]; scr[kk * 33 + (lane & 31)] = v; }
    LDS_WAIT(); asm volatile("" ::: "memory");
    const int c = lane & 7;
#pragma unroll
    for (int j = 0; j < 4; ++j) { const int n = (lane >> 3) + 8 * j; const LAS float* s = scr + (8 * c) * 33 + n;
        v4u o; o.x = pk2(s[0 * 33], s[1 * 33]); o.y = pk2(s[2 * 33], s[3 * 33]); o.z = pk2(s[4 * 33], s[5 * 33]); o.w = pk2(s[6 * 33], s[7 * 33]);
        *(GAS v4u*)(WT + (size_t)(n0 + n) * ldt + k0 + 8 * c) = o;
        if (WT2 && k0 >= k2lo) *(GAS v4u*)(WT2 + (size_t)(n0 + n) * ldt + k0 + 8 * c) = o; }
    LDS_WAIT(); asm volatile("" ::: "memory");
}
__device__ __forceinline__ v4u cvt8(const float* p, float s) {
    const f32x4 a = *(const f32x4*)p, b = *(const f32x4*)(p + 4);
    v4u o; o.x = pk2(a[0] * s, a[1] * s); o.y = pk2(a[2] * s, a[3] * s); o.z = pk2(b[0] * s, b[1] * s); o.w = pk2(b[2] * s, b[3] * s); return o;
}

__device__ __forceinline__ float gelu_f(float v) {
    const float av = fabsf(v), t = __builtin_amdgcn_rcpf(av * 0.2316418882f + 1.0f);
    float q = t * 0.5307027145f + (-0.7265760135f); q = q * t + 0.7107068705f; q = q * t + (-0.142248368f); q = q * t + 0.127414796f; q = q * t;
    const float e = __builtin_amdgcn_exp2f((v * v) * (-0.72134752044f));
    const float m = v * (q * e);
    return v < 0.f ? m : v - m;
}
__device__ __forceinline__ float dot2bf(unsigned a, unsigned b, float c) { return __builtin_amdgcn_fdot2_f32_bf16(__builtin_bit_cast(bf16x2_t, a), __builtin_bit_cast(bf16x2_t, b), c, false); }
__device__ __forceinline__ unsigned fkey(float f) { const unsigned u = __float_as_uint(f); return (u & 0x80000000u) ? ~u : (u | 0x80000000u); }
__device__ __forceinline__ float fdec(unsigned k) { const unsigned u = (k & 0x80000000u) ? (k & 0x7fffffffu) : ~k; return __uint_as_float(u); }

__global__ void __launch_bounds__(NTHREADS, 2) fwd_kernel(Args args) {
    extern __shared__ __attribute__((aligned(16))) unsigned char lds[];
    LAS unsigned char* ldsL = (LAS unsigned char*)lds;
    volatile LAS unsigned* MISC = (volatile LAS unsigned*)(ldsL + LDS_MISC);
    const int tid = threadIdx.x, lane = tid & 63, wave = __builtin_amdgcn_readfirstlane(tid >> 6);
    const int G = gridDim.x; const int bx = blockIdx.x; const int vcu = (G % 8 == 0) ? (bx % 8) * (G / 8) + bx / 8 : bx;
    unsigned char* ws = args.ws;
    unsigned* ctl = (unsigned*)(ws + WS_CTL);
    const float* x = args.in[0]; const float* mem = args.in[1]; const float* mix_norm = args.in[2]; const float* w_in = args.in[3]; const float* b_forget = args.in[4];
    const float* pool_w = args.in[5]; const float* pool_scale = args.in[6]; const float* w_out = args.in[7]; const float* xattn_norm = args.in[8]; const float* mem_norm = args.in[9];
    const float* xwq = args.in[10]; const float* xwk = args.in[11]; const float* xwv = args.in[12]; const float* xwo = args.in[13]; const float* peer_norm = args.in[14];
    const float* peer_wq = args.in[15]; const float* sub_keys = args.in[16]; const float* peer_u = args.in[17]; const float* peer_v = args.in[18]; const float* final_norm = args.in[19];
    bf16* W_IN = (bf16*)(ws + WS_WIN); bf16* WO1 = (bf16*)(ws + WS_WO1); bf16* WO2 = (bf16*)(ws + WS_WO2); bf16* WQ = (bf16*)(ws + WS_WQ); bf16* WK = (bf16*)(ws + WS_WK);
    bf16* WV = (bf16*)(ws + WS_WV); bf16* WO = (bf16*)(ws + WS_WO); bf16* WPQ = (bf16*)(ws + WS_WPQ); bf16* AEXP = (bf16*)(ws + WS_AEXP); bf16* WSC = (bf16*)(ws + WS_WSC);
    bf16* PB = (bf16*)(ws + WS_PB); bf16* MN = (bf16*)(ws + WS_MN); bf16* KX = (bf16*)(ws + WS_KX); bf16* VXT = (bf16*)(ws + WS_VXT); bf16* UB = (bf16*)(ws + WS_UB); bf16* VB = (bf16*)(ws + WS_VB);
    bf16* XN = (bf16*)(ws + WS_XN); bf16* QX = XN; bf16* PROJ = (bf16*)(ws + WS_PROJ); float* SCT = (float*)(ws + WS_PROJ); bf16* AMIX = (bf16*)(ws + WS_AMIX); bf16* OX = AMIX;
    float* H = (float*)(ws + WS_H); bf16* HB = (bf16*)(ws + WS_HB); bf16* PP = (bf16*)(ws + WS_P); float* LF = (float*)(ws + WS_LF);
    float* SS1 = (float*)(ws + CTL_SS1); float* SS2 = (float*)(ws + CTL_SS2);

    for (int u = tid; u < (LDS_BYTES - LDS_MISC) / 4; u += NTHREADS) ((LAS unsigned*)(ldsL + LDS_MISC))[u] = 0u;
    __syncthreads();
    XcdBarrier bar; bar.bar = ctl + CW_BAR; bar.x = 0; bar.st = nullptr;
    if (args.one_launch) bar = xcd_barrier_post(ctl + CW_BAR, MISC + 8);
    const int lo = args.ph_lo, hi = args.ph_hi;
#ifndef PH_MASK
#define PH_MASK 0x3ff
#endif
#define IN(k) (((PH_MASK >> (k)) & 1) && lo <= (k) && (k) < hi)
#define SEAM(k) do { if (IN(k) && IN((k) + 1)) xcd_barrier(bar); } while (0)
    const int gw = vcu * NWAVES + wave, NGW = G * NWAVES;
    const int gt = vcu * NTHREADS + tid, NGT = G * NTHREADS;

    if (IN(0)) {
        LAS float* wf = (LAS float*)ldsL;
        LAS float* scr = (LAS float*)(ldsL + 65536 + wave * 8704);
        for (int i = tid; i < 8 * DM; i += NTHREADS) { const int d = i >> 3, h = i & 7; wf[h * DM + d] = w_in[(size_t)d * INC + 4096 + h]; }
        __syncthreads();
        for (int m = gw; m < TOK; m += NGW) {
            const GAS f32x4* xr = (const GAS f32x4*)(x + (size_t)m * DM) + lane; const GAS f32x4* gr = (const GAS f32x4*)mix_norm + lane;
            f32x4 v[8]; float s = 0.f;
#pragma unroll
            for (int j = 0; j < 8; ++j) { v[j] = xr[64 * j]; s += (v[j][0] * v[j][0] + v[j][1] * v[j][1]) + (v[j][2] * v[j][2] + v[j][3] * v[j][3]); }
            const float rstd = __builtin_amdgcn_rsqf(wave_sum(s) * (1.f / DM) + EPS);
            GAS v2u* o8 = (GAS v2u*)(XN + (size_t)m * DM) + lane;
#pragma unroll
            for (int j = 0; j < 8; ++j) { const f32x4 gg = gr[64 * j]; v[j] = v[j] * rstd * gg;
                v2u o; o.x = pk2(v[j][0], v[j][1]); o.y = pk2(v[j][2], v[j][3]); o8[64 * j] = o; }
            float fl[8];
#pragma unroll
            for (int h = 0; h < 8; ++h) { float a = 0.f;
#pragma unroll
                for (int j = 0; j < 8; ++j) { const f32x4 w = *(const LAS f32x4*)(wf + h * DM + j * 256 + lane * 4); a += (v[j][0] * w[0] + v[j][1] * w[1]) + (v[j][2] * w[2] + v[j][3] * w[3]); }
                fl[h] = wave_sum(a);
                asm volatile("" ::: "memory"); }
            if (lane < 8) { float f = fl[0];
#pragma unroll
                for (int h = 1; h < 8; ++h) f = (lane == h) ? fl[h] : f;
                f += b_forget[lane];
                const float ls = fminf(f, 0.f) - log1pf(expf(-fabsf(f)));
                const int b = m / SEQ, sq = m % SEQ; LF[(size_t)(b * FOXH + lane) * SEQ + sq] = ls; }
        }
        for (int m = gw; m < BATCH * NMEM; m += NGW) {
            const GAS f32x4* xr = (const GAS f32x4*)(mem + (size_t)m * DM) + lane; const GAS f32x4* gr = (const GAS f32x4*)mem_norm + lane;
            f32x4 v[8]; float s = 0.f;
#pragma unroll
            for (int j = 0; j < 8; ++j) { v[j] = xr[64 * j]; s += (v[j][0] * v[j][0] + v[j][1] * v[j][1]) + (v[j][2] * v[j][2] + v[j][3] * v[j][3]); }
            const float rstd = __builtin_amdgcn_rsqf(wave_sum(s) * (1.f / DM) + EPS);
            GAS v2u* o8 = (GAS v2u*)(MN + (size_t)m * DM) + lane;
#pragma unroll
            for (int j = 0; j < 8; ++j) { const f32x4 gg = gr[64 * j]; v[j] = v[j] * rstd * gg; v2u o; o.x = pk2(v[j][0], v[j][1]); o.y = pk2(v[j][2], v[j][3]); o8[64 * j] = o; }
        }
        {
            constexpr int I_IN = (DM / 64) * (4096 / 32), I_SQ = (DM / 64) * (DM / 32);
            constexpr int NITEMS = I_IN + 5 * I_SQ;
            for (int it = gw; it < NITEMS; it += NGW) {
                int r = it;
                if (r < I_IN) { p0_transpose_item(w_in, INC, 4096 / 32, nullptr, W_IN, nullptr, 0, DM, scr, r, lane); continue; } r -= I_IN;
                if (r < I_SQ) { p0_transpose_item(w_out, DM, DM / 32, nullptr, WO1, WO2, POOLW, DM, scr, r, lane); continue; } r -= I_SQ;
                if (r < I_SQ) { p0_transpose_item(xwq, DM, DM / 32, xattn_norm, WQ, nullptr, 0, DM, scr, r, lane); continue; } r -= I_SQ;
                if (r < I_SQ) { p0_transpose_item(xwk, DM, DM / 32, nullptr, WK, nullptr, 0, DM, scr, r, lane); continue; } r -= I_SQ;
                if (r < I_SQ) { p0_transpose_item(xwv, DM, DM / 32, nullptr, WV, nullptr, 0, DM, scr, r, lane); continue; } r -= I_SQ;
                p0_transpose_item(xwo, DM, DM / 32, nullptr, WO, nullptr, 0, DM, scr, r, lane);
            }
        }
        for (size_t i = gt; i < (size_t)PEXP * DM / 8; i += NGT) { *(GAS v4u*)(UB + i * 8) = cvt8(peer_u + i * 8, 1.f); *(GAS v4u*)(VB + i * 8) = cvt8(peer_v + i * 8, 1.f); }
        for (int i = gt; i < DM * DM / 8; i += NGT) {
            const int d = i / (DM / 8); *(GAS v4u*)(WPQ + (size_t)i * 8) = cvt8(peer_wq + (size_t)i * 8, peer_norm[d]); }
        for (int i = gt; i < DM * DM / 8; i += NGT) {
            const int r = i / (DM / 8), c0 = (i % (DM / 8)) * 8; const int hc = r >> 7;
            v4u o = {0u, 0u, 0u, 0u}; if ((c0 >> 7) == hc) o = cvt8(sub_keys + (size_t)r * 128 + (c0 & 127), 1.f);
            *(GAS v4u*)(AEXP + (size_t)i * 8) = o; }
        for (int i = gt; i < 4 * 256 * 256 / 8; i += NGT) {
            const int g = i / (256 * 256 / 8), d0 = (i % 32) * 8; const float* ps = pool_scale + g * 256 + d0; const float* p = pool_w + (size_t)i * 8;
            v4u o; o.x = pk2(p[0] * ps[0], p[1] * ps[1]); o.y = pk2(p[2] * ps[2], p[3] * ps[3]); o.z = pk2(p[4] * ps[4], p[5] * ps[5]); o.w = pk2(p[6] * ps[6], p[7] * ps[7]);
            *(GAS v4u*)(PB + (size_t)i * 8) = o; }
        __syncthreads();
    }
    SEAM(0);

    if (IN(1)) {
        pg8::Gemm g{XN, W_IN, DM, DM, DM}; pg8::GSched S; S.init(TOK / 256, 4096 / 256, G, bx, DM, DM);
        pg8::EpiStore E{PROJ, 4096, 0, 0, 1, nullptr, 1.f, 4, 8, 0.08838834764831845f * LOG2E};
        pg8::gemm_phase<pg8::EpiStore, pg8::GSched, true>(ldsL, g, S, E);
    }
    SEAM(1);

    if (IN(2)) {
        for (int it = vcu; it < TOK / 32; it += G) {
            const int ch = (tid & 127) * 8, rsub = tid >> 7, r0 = it * 32 + rsub * 8, w = 2 << (ch >> 8);
            const int s0 = r0 % SEQ;
            float acc[8];
#pragma unroll
            for (int e = 0; e < 8; ++e) acc[e] = 0.f;
            for (int k = 1; k < w; ++k) { if (s0 - k >= 0) { const v4u v = *(const GAS v4u*)(PROJ + (size_t)(r0 - k) * 4096 + ch);
#pragma unroll
                    for (int e = 0; e < 4; ++e) { acc[2 * e] += __uint_as_float(v[e] << 16); acc[2 * e + 1] += __uint_as_float(v[e] & 0xffff0000u); } } }
            for (int rr = 0; rr < 8; ++rr) {
                const v4u v = *(const GAS v4u*)(PROJ + (size_t)(r0 + rr) * 4096 + ch); float cur[8];
#pragma unroll
                for (int e = 0; e < 4; ++e) { cur[2 * e] = __uint_as_float(v[e] << 16); cur[2 * e + 1] = __uint_as_float(v[e] & 0xffff0000u); }
                const int sp = s0 + rr; const float inv = 1.f / (float)((sp + 1 < w) ? sp + 1 : w);
                v4u o;
#pragma unroll
                for (int e = 0; e < 8; ++e) acc[e] += cur[e];
                o.x = pk2(acc[0] * inv - cur[0], acc[1] * inv - cur[1]); o.y = pk2(acc[2] * inv - cur[2], acc[3] * inv - cur[3]);
                o.z = pk2(acc[4] * inv - cur[4], acc[5] * inv - cur[5]); o.w = pk2(acc[6] * inv - cur[6], acc[7] * inv - cur[7]);
                *(GAS v4u*)(AMIX + (size_t)(r0 + rr) * DM + ch) = o;
                if (sp - w + 1 >= 0) { const v4u vo = *(const GAS v4u*)(PROJ + (size_t)(r0 + rr - w + 1) * 4096 + ch);
#pragma unroll
                    for (int e = 0; e < 4; ++e) { acc[2 * e] -= __uint_as_float(vo[e] << 16); acc[2 * e + 1] -= __uint_as_float(vo[e] & 0xffff0000u); } }
            }
        }
        const int a_bh = vcu >> 4, a_qb = vcu & 15;
        if (a_qb < 8 && vcu < 256) {
            const int e = a_bh * 8 + a_qb;
            pg8::Gemm g; pg8::GSched S; S.init(1, 1, 1, 0, DM, DM); pg8::EpiStore E{nullptr, DM, 0, 0, 1, nullptr, 1.f, 0, 0, 1.f};
            int pm, pn;
            if (e < 16)      { pm = e >> 3; pn = e & 7; g = pg8::Gemm{MN, WK, DM, DM, DM}; E.O = KX; E.ldc = DM; }
            else if (e < 32) { const int q = e - 16; pm = q >> 1; pn = q & 1; g = pg8::Gemm{WV, MN, DM, DM, DM}; E.O = VXT; E.ldc = 512; }
            else if (e < 96) { const int q = e - 32; pm = q >> 3; pn = q & 7; g = pg8::Gemm{AEXP, WPQ, DM, DM, DM}; E.O = WSC; E.ldc = DM; }
            else             { const int q = e - 96; const int gg = q >> 3; pm = q & 7; pn = 0;
                               g = pg8::Gemm{WO1 + gg * 256, PB + (size_t)gg * 65536, 256, DM, 256}; S.lda = DM; S.ldb = 256; E.O = WO2 + gg * 256; E.ldc = DM; }
            struct One { int pm, pn; long ao, bo; __device__ __forceinline__ bool next(int i, pg8::Unit& u) const { if (i) return false; u.pm = pm; u.pn = pn; u.z = 0; u.aoff = ao; u.boff = bo; return true; }
                         __device__ __forceinline__ void a_ready(const pg8::Unit&) const {} __device__ __forceinline__ void done(const pg8::Unit&) const {} };
            const One S1{pm, pn, (long)pm * 256 * g.lda, (long)pn * 256 * g.ldb};
            pg8::gemm_phase<pg8::EpiStore, One, false>(ldsL, g, S1, E);
        }
        if (vcu < 256) {
            const int b = a_bh >> 3, h = a_bh & 7;
            float* c_lds = (float*)(lds + fox::LDS_C);
            if (wave == 0) {
                const float* lf = LF + (size_t)a_bh * SEQ + lane * 64; float loc[64]; float run = 0.f;
#pragma unroll
                for (int i = 0; i < 16; ++i) { const f32x4 v = *(const f32x4*)(lf + 4 * i);
#pragma unroll
                    for (int e = 0; e < 4; ++e) { run += v[e]; loc[4 * i + e] = run; } }
                float incl = run;
#pragma unroll
                for (int o = 1; o < 64; o <<= 1) { const float t = __shfl_up(incl, o); if (lane >= o) incl += t; }
                const float excl = incl - run;
#pragma unroll
                for (int i = 0; i < 16; ++i) { f32x4 v;
#pragma unroll
                    for (int e = 0; e < 4; ++e) v[e] = (loc[4 * i + e] + excl) * LOG2E;
                    *(f32x4*)(c_lds + lane * 64 + 4 * i) = v; }
            }
            __syncthreads();
            const bf16* Qb = PROJ + (size_t)(b * SEQ) * 4096 + 1024 + h * 128;
            fox::BlockRef cur{Qb + (size_t)(a_qb * 256) * 4096, Qb + 1024, Qb + 2048, AMIX + (size_t)(b * SEQ + a_qb * 256) * DM + 1024 + h * 128, a_qb * 256};
            fox::Seam S;
            fox::prime(cur, (char*)lds, S);
            fox::block(cur, cur, (char*)lds, S);
            asm volatile("s_waitcnt vmcnt(0)" ::: "memory");
            __syncthreads();
        }
    }
    SEAM(2);

    if (IN(3)) {
        pg8::Gemm g{AMIX, WO2, DM, DM, DM}; pg8::GSched S; S.init(TOK / 256, DM / 256, G, bx, DM, DM);
        pg8::EpiResid E{x, H, HB, SS1};
        pg8::gemm_phase<pg8::EpiResid, pg8::GSched, true>(ldsL, g, S, E);
    }
    SEAM(3);

    if (IN(4)) {
        pg8::Gemm g{HB, WQ, DM, DM, DM}; pg8::GSched S; S.init(TOK / 256, DM / 256, G, bx, DM, DM);
        pg8::EpiStore E{QX, DM, 0, 0, 1, SS1, 0.044194173824159216f * LOG2E, 0, 0, 1.f};
        pg8::gemm_phase<pg8::EpiStore, pg8::GSched, true>(ldsL, g, S, E);
    }
    SEAM(4);

    if (IN(5)) {
        pg8::Gemm g{QX, KX, XD, DM, DM}; pg8::GSched S; S.init(SEQ / 256, 1, G, bx, DM, DM);
        S.nH = XH; S.nZ = BATCH * XH; S.sAb = (long)SEQ * DM; S.sAh = XD; S.sBb = (long)NMEM * DM; S.sBh = XD;
        pg8::EpiSoftmax E{PP, 1024, (long)SEQ * 1024, 256, XH};
        pg8::gemm_phase<pg8::EpiSoftmax, pg8::GSched, false>(ldsL, g, S, E);
    }
    SEAM(5);

    if (IN(6)) {
        pg8::Gemm g{PP, VXT, NMEM, 1024, 512}; pg8::GSched S; S.init(SEQ / 256, XD / 256, G, bx, 1024, 512);
        S.nH = XH; S.nZ = BATCH * XH; S.sAb = (long)SEQ * 1024; S.sAh = 256; S.sBb = NMEM; S.sBh = (long)XD * 512;
        pg8::EpiStore E{OX, DM, (long)SEQ * DM, XD, XH, nullptr, 1.f, 0, 0, 1.f};
        pg8::gemm_phase<pg8::EpiStore, pg8::GSched, true>(ldsL, g, S, E);
    }
    SEAM(6);

    if (IN(7)) {
        pg8::Gemm g{OX, WO, DM, DM, DM}; pg8::GSched S; S.init(TOK / 256, DM / 256, G, bx, DM, DM);
        pg8::EpiResid E{H, H, HB, SS2};
        pg8::gemm_phase<pg8::EpiResid, pg8::GSched, true>(ldsL, g, S, E);
    }
    SEAM(7);

    if (IN(8)) {
        pg8::Gemm g{WSC, HB, DM, DM, DM}; pg8::GSched S; S.init(DM / 256, TOK / 256, G, bx, DM, DM);
        pg8::EpiF32Col E{SCT, TOK, SS2};
        pg8::gemm_phase<pg8::EpiF32Col, pg8::GSched, true>(ldsL, g, S, E);
    }
    SEAM(8);

    if (IN(9)) {
        LAS unsigned* TOP1 = (LAS unsigned*)ldsL;
        LAS unsigned* RIDX = (LAS unsigned*)(ldsL + 32768);
        LAS float* RGATE = (LAS float*)(ldsL + 49152);
        for (int blk = vcu; blk < TOK / 32; blk += G) {
            const int t0 = blk * 32;
            {
                const int tok = tid & 31, grp = tid >> 5;
                const float* sp = SCT + (size_t)(grp * 128) * TOK + t0 + tok;
                unsigned lst[16];
#pragma unroll
                for (int j = 0; j < 16; ++j) lst[j] = 0u;
                for (int i0 = 0; i0 < 128; i0 += 8) {
                    float v[8];
#pragma unroll
                    for (int e = 0; e < 8; ++e) v[e] = sp[(size_t)(i0 + e) * TOK];
#pragma unroll
                    for (int e = 0; e < 8; ++e) { unsigned xk = (fkey(v[e]) & ~127u) | (unsigned)(127 - (i0 + e));
#pragma unroll
                        for (int j = 0; j < 16; ++j) { const unsigned hi_ = max(lst[j], xk); xk = min(lst[j], xk); lst[j] = hi_; } }
                }
                LAS unsigned* dst = TOP1 + (tok * 16 + grp) * 16;
#pragma unroll
                for (int j = 0; j < 16; j += 4) *(LAS v4u*)(dst + j) = (v4u){lst[j], lst[j + 1], lst[j + 2], lst[j + 3]};
            }
            __syncthreads();
            if (tid < 256) {
                const int tok = tid & 31, head = tid >> 5;
                const LAS unsigned* ka = TOP1 + (tok * 16 + head * 2) * 16; const LAS unsigned* kb = ka + 16;
                float af[16], bfv[16];
#pragma unroll
                for (int j = 0; j < 16; ++j) { af[j] = fdec(ka[j] & ~127u); bfv[j] = fdec(kb[j] & ~127u); }
                unsigned best[16];
#pragma unroll
                for (int j = 0; j < 16; ++j) best[j] = 0u;
#pragma unroll
                for (int i = 0; i < 16; ++i)
#pragma unroll
                    for (int j = 0; j < 16; ++j) if ((i + 1) * (j + 1) <= 16) {
                        unsigned xk = (fkey(af[i] + bfv[j]) & ~255u) | (unsigned)(255 - (i * 16 + j));
#pragma unroll
                        for (int q = 0; q < 16; ++q) { const unsigned hi_ = max(best[q], xk); xk = min(best[q], xk); best[q] = hi_; } }
                float ev[16]; const float m0 = fdec(best[0] & ~255u); float sum = 0.f;
#pragma unroll
                for (int q = 0; q < 16; ++q) { ev[q] = __expf(fdec(best[q] & ~255u) - m0); sum += ev[q]; }
                const float inv = 1.f / sum;
#pragma unroll
                for (int q = 0; q < 16; ++q) { const unsigned code = 255u - (best[q] & 255u); const unsigned i = code >> 4, j = code & 15u;
                    const unsigned ia = 127u - (ka[i] & 127u), ib = 127u - (kb[j] & 127u);
                    RIDX[tok * 128 + head * 16 + q] = ia * 128u + ib; RGATE[tok * 128 + head * 16 + q] = ev[q] * inv; }
            }
            __syncthreads();
            for (int tt = 0; tt < 4; ++tt) {
                const int tok = wave * 4 + tt; const size_t t = (size_t)(t0 + tok);
                const float rstd2 = __builtin_amdgcn_rsqf(SS2[t] * (1.f / DM) + EPS);
                unsigned xp[4][4];
#pragma unroll
                for (int j = 0; j < 4; ++j) { const size_t d0 = (size_t)(j * 64 + lane) * 8;
                    const f32x4 a = *(const f32x4*)(H + t * DM + d0), b2 = *(const f32x4*)(H + t * DM + d0 + 4);
                    const f32x4 ga = *(const f32x4*)(peer_norm + d0), gb = *(const f32x4*)(peer_norm + d0 + 4);
                    xp[j][0] = pk2(a[0] * rstd2 * ga[0], a[1] * rstd2 * ga[1]); xp[j][1] = pk2(a[2] * rstd2 * ga[2], a[3] * rstd2 * ga[3]);
                    xp[j][2] = pk2(b2[0] * rstd2 * gb[0], b2[1] * rstd2 * gb[1]); xp[j][3] = pk2(b2[2] * rstd2 * gb[2], b2[3] * rstd2 * gb[3]); }
                float oacc[4][8];
#pragma unroll
                for (int j = 0; j < 4; ++j)
#pragma unroll
                    for (int e = 0; e < 8; ++e) oacc[j][e] = 0.f;
                const LAS unsigned* ridx = RIDX + tok * 128; const LAS float* rgate = RGATE + tok * 128;
#define PEER_LOAD(UU, VV, k) do { const unsigned ex_ = (unsigned)__builtin_amdgcn_readfirstlane((int)ridx[k]); \
        const bf16* up_ = UB + (size_t)ex_ * DM + lane * 8; const bf16* vp_ = VB + (size_t)ex_ * DM + lane * 8; \
        _Pragma("unroll") for (int j = 0; j < 4; ++j) { UU[j] = *(const GAS v4u*)(up_ + j * 512); VV[j] = *(const GAS v4u*)(vp_ + j * 512); } } while (0)
#define PEER_COMP(UU, VV, k) do { float d_ = 0.f; \
        _Pragma("unroll") for (int j = 0; j < 4; ++j) _Pragma("unroll") for (int e = 0; e < 4; ++e) \
            d_ = dot2bf(UU[j][e], xp[j][e], d_); \
        d_ = wave_sum(d_); const float w_ = gelu_f(d_) * rgate[k]; \
        _Pragma("unroll") for (int j = 0; j < 4; ++j) _Pragma("unroll") for (int e = 0; e < 4; ++e) { \
            oacc[j][2 * e] = fmaf(w_, __uint_as_float(VV[j][e] << 16), oacc[j][2 * e]); oacc[j][2 * e + 1] = fmaf(w_, __uint_as_float(VV[j][e] & 0xffff0000u), oacc[j][2 * e + 1]); } } while (0)
                v4u uA[4], vA[4], uB[4], vB[4];
                PEER_LOAD(uA, vA, 0);
                for (int k = 0; k < 128; k += 2) {
                    PEER_LOAD(uB, vB, k + 1);
                    PEER_COMP(uA, vA, k);
                    if (k + 2 < 128) PEER_LOAD(uA, vA, k + 2);
                    PEER_COMP(uB, vB, k + 1);
                }
#undef PEER_LOAD
#undef PEER_COMP
                float y[4][8]; float s = 0.f;
#pragma unroll
                for (int j = 0; j < 4; ++j) { const size_t d0 = (size_t)(j * 64 + lane) * 8;
                    const f32x4 a = *(const f32x4*)(H + t * DM + d0), b2 = *(const f32x4*)(H + t * DM + d0 + 4);
#pragma unroll
                    for (int e = 0; e < 4; ++e) { y[j][e] = a[e] + oacc[j][e]; y[j][4 + e] = b2[e] + oacc[j][4 + e]; s += y[j][e] * y[j][e] + y[j][4 + e] * y[j][4 + e]; } }
                const float rstd = __builtin_amdgcn_rsqf(wave_sum(s) * (1.f / DM) + EPS);
#pragma unroll
                for (int j = 0; j < 4; ++j) { const size_t d0 = (size_t)(j * 64 + lane) * 8;
                    const f32x4 ga = *(const f32x4*)(final_norm + d0), gb = *(const f32x4*)(final_norm + d0 + 4);
                    f32x4 o0, o1;
#pragma unroll
                    for (int e = 0; e < 4; ++e) { o0[e] = y[j][e] * rstd * ga[e]; o1[e] = y[j][4 + e] * rstd * gb[e]; }
                    *(f32x4*)(args.out + t * DM + d0) = o0; *(f32x4*)(args.out + t * DM + d0 + 4) = o1; }
            }
            __syncthreads();
        }
    }
#undef IN
#undef SEAM
}

constexpr int N_PHASES = 10;
extern "C" void kernel_launch(void* const* d_in, const int* in_sizes, int n_in, void* d_out, int out_size, void* d_ws, size_t ws_size, hipStream_t stream) {
    static int grid = 0;
    if (grid == 0) {
        if (n_in != 20 || in_sizes[0] != TOK * DM || out_size != TOK * DM || ws_size < WS_END) {
            fprintf(stderr, "kernel_launch: unexpected shapes (n_in %d, in0 %d, out %d, ws %zu < %zu)\n", n_in, n_in > 0 ? in_sizes[0] : -1, out_size, ws_size, (size_t)WS_END); grid = -1; return; }
        int dev = 0, cus = 0, per_cu = 0;
        if (hipGetDevice(&dev) != hipSuccess || hipDeviceGetAttribute(&cus, hipDeviceAttributeMultiprocessorCount, dev) != hipSuccess) { grid = -1; return; }
        if (hipFuncSetAttribute((const void*)fwd_kernel, hipFuncAttributeMaxDynamicSharedMemorySize, LDS_BYTES) != hipSuccess) { fprintf(stderr, "kernel_launch: hipFuncSetAttribute failed\n"); grid = -1; return; }
        if (hipOccupancyMaxActiveBlocksPerMultiprocessor(&per_cu, (const void*)fwd_kernel, NTHREADS, LDS_BYTES) != hipSuccess || per_cu < 1) { fprintf(stderr, "kernel_launch: occupancy query says %d\n", per_cu); per_cu = 1; }
        (void)hipGetLastError();
        grid = cus;
        if (grid != 256) fprintf(stderr, "kernel_launch: %d CUs (built for 256)\n", grid);
    }
    if (grid < 0) return;
    (void)hipMemsetAsync((char*)d_ws + WS_CTL, 0, CTL_ZERO_BYTES, stream);
    Args a{};
    for (int i = 0; i < 20; ++i) a.in[i] = (const float*)d_in[i];
    a.out = (float*)d_out; a.ws = (unsigned char*)d_ws;
#if MK_ONE_LAUNCH
    a.ph_lo = 0; a.ph_hi = N_PHASES; a.one_launch = 1;
    void* kargs[] = {&a};
    hipError_t e = hipLaunchCooperativeKernel((const void*)fwd_kernel, dim3(grid), dim3(NTHREADS), kargs, LDS_BYTES, stream);
    if (e != hipSuccess) fprintf(stderr, "kernel_launch: cooperative launch failed: %s\n", hipGetErrorString(e));
#else
    for (int p = 0; p < N_PHASES; ++p) {
        a.ph_lo = p; a.ph_hi = p + 1; a.one_launch = 0;
        hipLaunchKernelGGL(fwd_kernel, dim3(grid), dim3(NTHREADS), LDS_BYTES, stream, a);
    }
#endif
}
```

```cpp
#include <hip/hip_runtime.h>
#include <hip/hip_bf16.h>
#include <cstdio>
#include <cstdint>

#ifndef MK_ONE_LAUNCH
#define MK_ONE_LAUNCH 1
#endif

constexpr int BATCH = 2, SEQ = 4096, DM = 2048, TOK = BATCH * SEQ;
constexpr int INC = 4104, POOLW = 1024, FOXH = 8, FOXD = 128;
constexpr int NMEM = 256, XH = 4, XD = 512;
constexpr int PH = 8, PKEYS = 128, PEXP = 16384, TOPK = 16;
constexpr float EPS = 1e-6f;
constexpr float LOG2E = 1.4426950408889634f;

namespace pg8 {
#define PG8_LAS __attribute__((address_space(3)))
typedef unsigned short bf16_t;
typedef short bf16x8 __attribute__((ext_vector_type(8)));
typedef float f32x4 __attribute__((ext_vector_type(4)));
typedef float f32x2 __attribute__((ext_vector_type(2)));
typedef unsigned u32x4 __attribute__((ext_vector_type(4)));
typedef unsigned u32x2 __attribute__((ext_vector_type(2)));
constexpr int BM = 256, BK = 64, HALF = 128, HTB = HALF * BK * 2, STAGE_BYTES = 8 * HTB, NXCD = 8, WGM = 8;

__host__ __device__ __forceinline__ int lds_byte(int r, int c) { const int st = (r >> 4) * 2 + (c >> 5), rr = r & 15, cc = c & 31, ob = rr * 64 + cc * 2; return st * 1024 + (ob ^ (((ob >> 9) & 1) << 5)); }
__host__ __device__ __forceinline__ void stage_rc(int b, int& R, int& C) { const int st = b / 1024, sb = b % 1024, swz = sb ^ (((sb >> 9) & 1) << 5); R = (st >> 1) * 16 + swz / 64; C = (st & 1) * 32 + (swz % 64) / 2; }
__host__ __device__ __forceinline__ int perm32(int rho) { const int n = rho >> 4, i = rho & 15; return 8 * (i >> 2) + 4 * n + (i & 3); }

struct Unit { int pm, pn, z; long aoff, boff; };
struct Gemm { const bf16_t* A; const bf16_t* Bt; int K, lda, ldb; };

struct GSched {
    int nM, nN, nH, nZ, G, c; long sAb, sAh, sBb, sBh; int lda, ldb;
    __device__ __forceinline__ void init(int nM_, int nN_, int G_, int c_, int lda_, int ldb_) { nM = nM_; nN = nN_; nH = 1; nZ = 1; G = G_; c = c_; sAb = sAh = sBb = sBh = 0; lda = lda_; ldb = ldb_; }
    __device__ __forceinline__ bool next(int i, Unit& u) const {
        const long L = (long)i * G + c; const int nwg = nM * nN; if (L >= (long)nwg * nZ) return false;
        const int z = (int)(L / nwg); int wgid = (int)(L % nwg);
        { const int q = nwg / NXCD, r = nwg % NXCD, xcd = wgid % NXCD, off = wgid / NXCD; wgid = (xcd < r ? xcd * (q + 1) : r * (q + 1) + (xcd - r) * q) + off; }
        const int nig = WGM * nN, gid = wgid / nig, fm = gid * WGM, gsz = (nM - fm) < WGM ? (nM - fm) : WGM;
        u.pm = fm + ((wgid % nig) % gsz); u.pn = (wgid % nig) / gsz; u.z = z;
        const int zb = z / nH, zh = z % nH;
        u.aoff = zb * sAb + zh * sAh + (long)u.pm * BM * lda; u.boff = zb * sBb + zh * sBh + (long)u.pn * BM * ldb;
        return true;
    }
    __device__ __forceinline__ void a_ready(const Unit&) const {}
    __device__ __forceinline__ void done(const Unit&) const {}
};

__device__ __forceinline__ unsigned cvt_pk_bf16(float lo, float hi) { unsigned r; asm volatile("v_cvt_pk_bf16_f32 %0, %1, %2" : "=v"(r) : "v"(lo), "v"(hi)); return r; }


struct EpiStore {
    static constexpr bool PERM = true, AFTER_DRAIN = false;
    bf16_t* O; int ldc; long sCb, sCh; int nH;
    const float* ss; float rs_mul;
    int t0, t1; float tscale;
    __device__ __forceinline__ void operator()(const f32x4 (&acc)[2][2][4][2], const Unit& u, int wr, int wc, int fr, int fq) const {
        const int row0 = u.pm * BM + wr * 64 + fr, col0 = u.pn * BM + wc * 32 + 8 * fq;
        bf16_t* base = O + (u.z / nH) * sCb + (u.z % nH) * sCh;
        const float ts = (u.pn >= t0 && u.pn < t1) ? tscale : 1.f;
#pragma unroll
        for (int ai = 0; ai < 2; ++ai)
#pragma unroll
            for (int m = 0; m < 4; ++m) { const int row = row0 + ai * HALF + m * 16;
                float sc = ts; if (ss) sc *= __builtin_amdgcn_rsqf(ss[row] * (1.f / DM) + EPS) * rs_mul;
                bf16_t* rowp = base + (size_t)row * ldc + col0;
#pragma unroll
                for (int bj = 0; bj < 2; ++bj) { const f32x4 v0 = acc[ai][bj][m][0] * sc, v1 = acc[ai][bj][m][1] * sc;
                    u32x4 w; w.x = cvt_pk_bf16(v0[0], v0[1]); w.y = cvt_pk_bf16(v0[2], v0[3]); w.z = cvt_pk_bf16(v1[0], v1[1]); w.w = cvt_pk_bf16(v1[2], v1[3]);
                    *(u32x4*)(rowp + bj * HALF) = w; } }
    }
};
struct EpiResid {
    static constexpr bool PERM = true, AFTER_DRAIN = false;
    const float* base; float* H; bf16_t* HB; float* ss;
    __device__ __forceinline__ void operator()(const f32x4 (&acc)[2][2][4][2], const Unit& u, int wr, int wc, int fr, int fq) const {
        const int row0 = u.pm * BM + wr * 64 + fr, col0 = u.pn * BM + wc * 32 + 8 * fq;
#pragma unroll
        for (int ai = 0; ai < 2; ++ai)
#pragma unroll
            for (int m = 0; m < 4; ++m) { const int row = row0 + ai * HALF + m * 16; const size_t off = (size_t)row * DM + col0; float sq = 0.f;
#pragma unroll
                for (int bj = 0; bj < 2; ++bj) {
                    const f32x4 b0 = *(const f32x4*)(base + off + bj * HALF), b1 = *(const f32x4*)(base + off + bj * HALF + 4);
                    const f32x4 h0 = b0 + acc[ai][bj][m][0], h1 = b1 + acc[ai][bj][m][1];
                    *(f32x4*)(H + off + bj * HALF) = h0; *(f32x4*)(H + off + bj * HALF + 4) = h1;
                    u32x4 w; w.x = cvt_pk_bf16(h0[0], h0[1]); w.y = cvt_pk_bf16(h0[2], h0[3]); w.z = cvt_pk_bf16(h1[0], h1[1]); w.w = cvt_pk_bf16(h1[2], h1[3]);
                    *(u32x4*)(HB + off + bj * HALF) = w;
                    sq += (h0[0] * h0[0] + h0[1] * h0[1]) + (h0[2] * h0[2] + h0[3] * h0[3]) + (h1[0] * h1[0] + h1[1] * h1[1]) + (h1[2] * h1[2] + h1[3] * h1[3]); }
                sq += __shfl_xor(sq, 16); sq += __shfl_xor(sq, 32);
                if (fq == 0) atomicAdd(ss + row, sq); }
    }
};
struct EpiF32Col {
    static constexpr bool PERM = true, AFTER_DRAIN = false;
    float* O; int ldc; const float* ss;
    __device__ __forceinline__ void operator()(const f32x4 (&acc)[2][2][4][2], const Unit& u, int wr, int wc, int fr, int fq) const {
        const int row0 = u.pm * BM + wr * 64 + fr, col0 = u.pn * BM + wc * 32 + 8 * fq;
        f32x4 rs[2][2];
#pragma unroll
        for (int bj = 0; bj < 2; ++bj)
#pragma unroll
            for (int n = 0; n < 2; ++n) { const f32x4 s = *(const f32x4*)(ss + col0 + bj * HALF + 4 * n);
#pragma unroll
                for (int e = 0; e < 4; ++e) rs[bj][n][e] = __builtin_amdgcn_rsqf(s[e] * (1.f / DM) + EPS); }
#pragma unroll
        for (int ai = 0; ai < 2; ++ai)
#pragma unroll
            for (int m = 0; m < 4; ++m) { float* rowp = O + (size_t)(row0 + ai * HALF + m * 16) * ldc + col0;
#pragma unroll
                for (int bj = 0; bj < 2; ++bj) { *(f32x4*)(rowp + bj * HALF) = acc[ai][bj][m][0] * rs[bj][0]; *(f32x4*)(rowp + bj * HALF + 4) = acc[ai][bj][m][1] * rs[bj][1]; } }
    }
};
struct EpiSoftmax {
    static constexpr bool PERM = true, AFTER_DRAIN = true;
    bf16_t* P; int ldc; long sCb, sCh; int nH;
    __device__ __forceinline__ void fused(f32x4 (&acc)[2][2][4][2], const Unit& u, int wr, int wc, int fr, int fq, PG8_LAS unsigned char* lds, int wid, int lane) const {
        PG8_LAS float* Pm = (PG8_LAS float*)lds;
        PG8_LAS float* Ps = (PG8_LAS float*)(lds + 4096);
#pragma unroll
        for (int ai = 0; ai < 2; ++ai)
#pragma unroll
            for (int m = 0; m < 4; ++m) { float mx = -3.0e38f;
#pragma unroll
                for (int bj = 0; bj < 2; ++bj)
#pragma unroll
                    for (int n = 0; n < 2; ++n) { const f32x4 x = acc[ai][bj][m][n]; mx = fmaxf(mx, fmaxf(fmaxf(x[0], x[1]), fmaxf(x[2], x[3]))); }
                mx = fmaxf(mx, __shfl_xor(mx, 16)); mx = fmaxf(mx, __shfl_xor(mx, 32));
                if (fq == 0) Pm[(ai * HALF + wr * 64 + m * 16 + fr) * 4 + wc] = mx; }
        asm volatile("s_waitcnt lgkmcnt(0)" ::: "memory"); __builtin_amdgcn_s_barrier(); asm volatile("" ::: "memory");
#pragma unroll
        for (int ai = 0; ai < 2; ++ai)
#pragma unroll
            for (int m = 0; m < 4; ++m) { const int r = ai * HALF + wr * 64 + m * 16 + fr;
                const f32x4 pm4 = *(const PG8_LAS f32x4*)(Pm + r * 4); const float M = fmaxf(fmaxf(pm4[0], pm4[1]), fmaxf(pm4[2], pm4[3])); float s = 0.f;
#pragma unroll
                for (int bj = 0; bj < 2; ++bj)
#pragma unroll
                    for (int n = 0; n < 2; ++n) { f32x4 x = acc[ai][bj][m][n];
#pragma unroll
                        for (int e = 0; e < 4; ++e) { x[e] = __builtin_amdgcn_exp2f(x[e] - M); s += x[e]; }
                        acc[ai][bj][m][n] = x; }
                s += __shfl_xor(s, 16); s += __shfl_xor(s, 32);
                if (fq == 0) Ps[r * 4 + wc] = s; }
        asm volatile("s_waitcnt lgkmcnt(0)" ::: "memory"); __builtin_amdgcn_s_barrier(); asm volatile("" ::: "memory");
        bf16_t* base = P + (u.z / nH) * sCb + (u.z % nH) * sCh;
        const int row0 = u.pm * BM, col0 = u.pn * BM + wc * 32 + 8 * fq;
#pragma unroll
        for (int ai = 0; ai < 2; ++ai)
#pragma unroll
            for (int m = 0; m < 4; ++m) { const int r = ai * HALF + wr * 64 + m * 16 + fr;
                const f32x4 ps4 = *(const PG8_LAS f32x4*)(Ps + r * 4); const float inv = 1.f / ((ps4[0] + ps4[1]) + (ps4[2] + ps4[3]));
                bf16_t* rowp = base + (size_t)(row0 + r) * ldc + col0;
#pragma unroll
                for (int bj = 0; bj < 2; ++bj) { const f32x4 v0 = acc[ai][bj][m][0] * inv, v1 = acc[ai][bj][m][1] * inv;
                    u32x4 w; w.x = cvt_pk_bf16(v0[0], v0[1]); w.y = cvt_pk_bf16(v0[2], v0[3]); w.z = cvt_pk_bf16(v1[0], v1[1]); w.w = cvt_pk_bf16(v1[2], v1[3]);
                    *(u32x4*)(rowp + bj * HALF) = w; } }
    }
};

template <class Epi, class Sched, bool ALIGN_EPI>
__device__ __forceinline__ void gemm_phase(PG8_LAS unsigned char* lds, const Gemm g, const Sched& S, const Epi& E) {
    const int tid = threadIdx.x, wid = __builtin_amdgcn_readfirstlane(tid >> 6), lane = tid & 63, wr = wid >> 2, wc = wid & 3, fr = lane & 15, fq = lane >> 4;
    const int K = g.K, nt = K / BK;
    unsigned voffA[2], voffB[2];
#pragma unroll
    for (int i = 0; i < 2; ++i) { int R, C; stage_rc(tid * 16 + i * 8192, R, C); const int Rb = Epi::PERM ? ((R & ~31) + perm32(R & 31)) : R;
        voffA[i] = (unsigned)(R * g.lda + C) * 2u; voffB[i] = (unsigned)(Rb * g.ldb + C) * 2u; }
    const size_t kstep = (size_t)(BK * 2);
    const size_t hsA = (size_t)HALF * g.lda * 2, hsB = (size_t)HALF * g.ldb * 2;
    const unsigned ldsw = (unsigned)wid * 1024u;
    const int aoff = lds_byte(wr * 64 + fr, fq * 8), boff = lds_byte(wc * 32 + fr, fq * 8);
#define PG8_SA(b, h) (((b) * 2 + (h)) * HTB)
#define PG8_SB(b, h) ((4 + (b) * 2 + (h)) * HTB)
#define PG8_STAGE(bufoff, gbase, voff) do { _Pragma("unroll") for (int _i = 0; _i < 2; ++_i) \
        __builtin_amdgcn_global_load_lds((const unsigned*)((const char*)(gbase) + (voff)[_i]), (PG8_LAS unsigned*)(lds + (bufoff) + ldsw + _i * 8192), 16, 0, 0); } while (0)
#define PG8_LDA(dst, b, h) do { _Pragma("unroll") for (int m = 0; m < 4; ++m) _Pragma("unroll") for (int k = 0; k < 2; ++k) dst[m][k] = *(const PG8_LAS bf16x8*)(lds + PG8_SA(b, h) + aoff + m * 2048 + k * 1024); } while (0)
#define PG8_LDB(dst, b, h) do { _Pragma("unroll") for (int n = 0; n < 2; ++n) _Pragma("unroll") for (int k = 0; k < 2; ++k) dst[n][k] = *(const PG8_LAS bf16x8*)(lds + PG8_SB(b, h) + boff + n * 2048 + k * 1024); } while (0)
#define PG8_MMA(ai, bj, At, Bt) do { __builtin_amdgcn_s_setprio(1); _Pragma("unroll") for (int m = 0; m < 4; ++m) _Pragma("unroll") for (int n = 0; n < 2; ++n) _Pragma("unroll") for (int k = 0; k < 2; ++k) \
        acc[ai][bj][m][n] = __builtin_amdgcn_mfma_f32_16x16x32_bf16(Bt[n][k], At[m][k], acc[ai][bj][m][n], 0, 0, 0); __builtin_amdgcn_s_setprio(0); } while (0)
#define PG8_WAIT_V(n) asm volatile("s_waitcnt vmcnt(" #n ")" ::: "memory")
#define PG8_WAIT_L(n) asm volatile("s_waitcnt lgkmcnt(" #n ")" ::: "memory")
#define PG8_BAR __builtin_amdgcn_s_barrier()
#define PG8_SCHED __builtin_amdgcn_sched_barrier(0)
    Unit cur, nxt; int ui = 0;
    if (!S.next(0, cur)) return;
    f32x4 acc[2][2][4][2];
#pragma unroll
    for (int a = 0; a < 2; ++a)
#pragma unroll
        for (int b = 0; b < 2; ++b)
#pragma unroll
            for (int m = 0; m < 4; ++m)
#pragma unroll
                for (int n = 0; n < 2; ++n) acc[a][b][m][n] = (f32x4){0.f, 0.f, 0.f, 0.f};
    bf16x8 At[4][2], B0[2][2], B1[2][2];
    const char* cA = (const char*)g.A + (size_t)cur.aoff * 2; const char* cB = (const char*)g.Bt + (size_t)cur.boff * 2;
    S.a_ready(cur);
    PG8_STAGE(PG8_SB(0, 0), cB, voffB); PG8_STAGE(PG8_SB(0, 1), cB + hsB, voffB); PG8_STAGE(PG8_SA(0, 0), cA, voffA); PG8_STAGE(PG8_SA(0, 1), cA + hsA, voffA);
    if (wr == 1) PG8_BAR;
    PG8_WAIT_V(2); PG8_BAR;
    PG8_STAGE(PG8_SB(1, 0), cB + kstep, voffB); PG8_STAGE(PG8_SA(1, 0), cA + kstep, voffA); PG8_STAGE(PG8_SB(1, 1), cB + hsB + kstep, voffB);
    PG8_WAIT_V(6); PG8_BAR;
    for (;;) {
        const bool has_next = S.next(ui + 1, nxt);
        const char* nA = has_next ? (const char*)g.A + (size_t)nxt.aoff * 2 : cA; const char* nB = has_next ? (const char*)g.Bt + (size_t)nxt.boff * 2 : cB;
        for (int t = 0; t < nt; t += 2) {
            const bool last = (t == nt - 2);
            const char* a1 = cA + (size_t)(t + 1) * kstep;
            const char* a2 = last ? nA : cA + (size_t)(t + 2) * kstep; const char* b2 = last ? nB : cB + (size_t)(t + 2) * kstep;
            const char* a3 = a2 + kstep; const char* b3 = b2 + kstep;
            if (last && has_next) S.a_ready(nxt);
            PG8_LDB(B0, 0, 0); PG8_LDB(B1, 0, 1); PG8_SCHED; PG8_LDA(At, 0, 0); PG8_STAGE(PG8_SA(1, 1), a1 + hsA, voffA);
            PG8_WAIT_V(8); PG8_WAIT_L(0); PG8_BAR; PG8_MMA(0, 0, At, B0); PG8_MMA(0, 1, At, B1); PG8_BAR; PG8_SCHED;
            PG8_LDA(At, 0, 1); PG8_STAGE(PG8_SB(0, 0), b2, voffB); PG8_STAGE(PG8_SB(0, 1), b2 + hsB, voffB); PG8_STAGE(PG8_SA(0, 0), a2, voffA);
            PG8_WAIT_V(8); PG8_WAIT_L(0); PG8_BAR; PG8_MMA(1, 0, At, B0); PG8_MMA(1, 1, At, B1); PG8_BAR; PG8_SCHED;
            PG8_LDB(B0, 1, 0); PG8_LDB(B1, 1, 1); PG8_SCHED; PG8_LDA(At, 1, 0); PG8_STAGE(PG8_SA(0, 1), a2 + hsA, voffA);
            PG8_WAIT_V(8); PG8_WAIT_L(0); PG8_BAR; PG8_MMA(0, 0, At, B0); PG8_MMA(0, 1, At, B1); PG8_BAR; PG8_SCHED;
            PG8_LDA(At, 1, 1); PG8_STAGE(PG8_SB(1, 0), b3, voffB); PG8_STAGE(PG8_SB(1, 1), b3 + hsB, voffB); PG8_STAGE(PG8_SA(1, 0), a3, voffA);
            PG8_WAIT_V(8); PG8_WAIT_L(0); PG8_BAR; PG8_MMA(1, 0, At, B0); PG8_MMA(1, 1, At, B1); PG8_BAR; PG8_SCHED;
        }
        if constexpr (ALIGN_EPI) { if (wr == 0) PG8_BAR; }
        if constexpr (!Epi::AFTER_DRAIN) { E(acc, cur, wr, wc, fr, fq); S.done(cur); }
        if (!has_next) break;
#pragma unroll
        for (int a = 0; a < 2; ++a)
#pragma unroll
            for (int b = 0; b < 2; ++b)
#pragma unroll
                for (int m = 0; m < 4; ++m)
#pragma unroll
                    for (int n = 0; n < 2; ++n) acc[a][b][m][n] = (f32x4){0.f, 0.f, 0.f, 0.f};
        cur = nxt; cA = nA; cB = nB; ++ui;
        if constexpr (ALIGN_EPI) { if (wr == 1) PG8_BAR; }
    }
    PG8_WAIT_V(0);
    if constexpr (!ALIGN_EPI) { if (wr == 0) PG8_BAR; }
    PG8_BAR;
    if constexpr (Epi::AFTER_DRAIN) { E.fused(acc, cur, wr, wc, fr, fq, lds, wid, lane); S.done(cur); }
#undef PG8_SA
#undef PG8_SB
#undef PG8_STAGE
#undef PG8_LDA
#undef PG8_LDB
#undef PG8_MMA
#undef PG8_WAIT_V
#undef PG8_WAIT_L
#undef PG8_BAR
#undef PG8_SCHED
}
}

namespace fox {
typedef unsigned short bf16_t;
typedef short bf16x8 __attribute__((ext_vector_type(8)));
typedef short s16x4 __attribute__((ext_vector_type(4)));
typedef float f32x16 __attribute__((ext_vector_type(16)));
typedef float f32x4 __attribute__((ext_vector_type(4)));
typedef unsigned u32x4 __attribute__((ext_vector_type(4)));
constexpr int D = 128, NW = 8, QBLK = 32, KVBLK = 64, QB = NW * QBLK;
constexpr int SHM_V = KVBLK * D * 2, SHM_K = KVBLK * D * 2;
constexpr int LDS_C = 2 * SHM_V + 2 * SHM_K + NW * 64 * 4;
constexpr int LDS_BYTES = LDS_C + SEQ * 4;
constexpr int QP = 4096, OP = 2048;
constexpr float THR = 24.f;
#define KSWZ(row, colB) ((row) * 256 + ((colB) ^ (((row) & 7) << 4)))
#define SBAR() __builtin_amdgcn_sched_barrier(0)
__device__ __forceinline__ int v_st(int k, int c) { const int kk = (k & ~0xC) | ((k & 4) << 1) | ((k & 8) >> 1); return ((kk >> 3) * 4 + (c >> 5)) * 512 + ((kk & 7) * 32 + (c & 31)) * 2; }
__device__ __forceinline__ int v_rd_base(int lane) { return ((lane & 3) << 3) | (((lane >> 2) & 3) << 6) | (((lane >> 4) & 1) << 5) | (((lane >> 5) & 1) << 8); }
constexpr int v_rd_off(int d0, int ks, int half) { return d0 * 512 + ks * 4096 + half * 2048; }
__device__ __forceinline__ int crow(int r, int hi) { return (r & 3) + 8 * (r >> 2) + 4 * hi; }
__device__ __forceinline__ unsigned cvtpk(float lo, float hi) { unsigned r; asm volatile("v_cvt_pk_bf16_f32 %0, %1, %2" : "=v"(r) : "v"(lo), "v"(hi)); return r; }
__device__ __forceinline__ bf16x8 load8(const bf16_t* p) { return *reinterpret_cast<const bf16x8*>(p); }
__device__ __forceinline__ void mask_tile(f32x16& p0, f32x16& p1, int dq) {
    const float NEG = -__builtin_inff();
#pragma unroll
    for (int r = 0; r < 16; ++r) { const int c = (r & 3) + 8 * (r >> 2); if (dq - c < 0) p0[r] = NEG; if (dq - c - 32 < 0) p1[r] = NEG; }
}
__device__ __forceinline__ void bias_tile(f32x16& p0, f32x16& p1, const float* cb) {
#pragma unroll
    for (int i = 0; i < 4; ++i) { const f32x4 c0 = *(const f32x4*)(cb + 8 * i), c1 = *(const f32x4*)(cb + 32 + 8 * i);
#pragma unroll
        for (int j = 0; j < 4; ++j) { p0[4 * i + j] -= c0[j]; p1[4 * i + j] -= c1[j]; } }
}
__device__ __forceinline__ void partialSM(f32x16& p0, f32x16& p1, float& m_reg, float& mn, float& alpha) {
    float pmax = p0[0]; for (int r = 1; r < 16; ++r) pmax = fmaxf(pmax, p0[r]); for (int r = 0; r < 16; ++r) pmax = fmaxf(pmax, p1[r]);
    { auto rr = __builtin_amdgcn_permlane32_swap(__float_as_uint(pmax), __float_as_uint(pmax), false, false);
      pmax = fmaxf(__uint_as_float(rr[0]), __uint_as_float(rr[1])); }
    if (__builtin_expect(__all((pmax - m_reg) <= THR), 1)) { mn = m_reg; alpha = 1.f; }
    else { mn = fmaxf(m_reg, pmax); alpha = __builtin_amdgcn_exp2f(m_reg - mn); m_reg = mn; }
    for (int r = 0; r < 16; ++r) p0[r] = p0[r] - mn; for (int r = 0; r < 16; ++r) p1[r] = p1[r] - mn;
    for (int r = 0; r < 16; ++r) p0[r] = __builtin_amdgcn_exp2f(p0[r]);
}
__device__ __forceinline__ void finishSM(f32x16& p0, f32x16& p1, float alpha, float& l_reg, bf16x8& pa0, bf16x8& pa1, bf16x8& pa2, bf16x8& pa3) {
    for (int r = 0; r < 16; ++r) p1[r] = __builtin_amdgcn_exp2f(p1[r]);
    float ps = 0; for (int r = 0; r < 16; ++r) ps += p0[r]; for (int r = 0; r < 16; ++r) ps += p1[r];
    { auto rr = __builtin_amdgcn_permlane32_swap(__float_as_uint(ps), __float_as_uint(ps), false, false);
      ps = __uint_as_float(rr[0]) + __uint_as_float(rr[1]); }
    l_reg = l_reg * alpha + ps;
#define PK4(P, B_, OUT) do { unsigned a0 = cvtpk(P[B_+0], P[B_+1]), a1 = cvtpk(P[B_+2], P[B_+3]);                          \
        unsigned b0 = cvtpk(P[B_+4], P[B_+5]), b1 = cvtpk(P[B_+6], P[B_+7]);                                             \
        auto r0 = __builtin_amdgcn_permlane32_swap(a0, b0, false, false); auto r1 = __builtin_amdgcn_permlane32_swap(a1, b1, false, false); \
        u32x4 w = {r0[0], r1[0], r0[1], r1[1]}; OUT = *reinterpret_cast<bf16x8*>(&w); } while (0)
    PK4(p0, 0, pa0); PK4(p0, 8, pa1); PK4(p1, 0, pa2); PK4(p1, 8, pa3);
#undef PK4
}
template <int KB>
__device__ __forceinline__ void qkt(f32x16& p0, f32x16& p1, const char* K_lds, int r32, int hi, const bf16x8* qr) {
    p0 = f32x16{}; p1 = f32x16{};
    const char* kb[4];
#pragma unroll
    for (int dd = 0; dd < 4; ++dd) kb[dd] = K_lds + KB * SHM_K + KSWZ(r32, (dd * 16 + hi * 8) * 2);
#pragma unroll
    for (int d0 = 0; d0 < 8; ++d0) { const char* a = kb[d0 & 3] + (d0 >> 2) * 128;
        bf16x8 b0 = *reinterpret_cast<const bf16x8*>(a);
        bf16x8 b1 = *reinterpret_cast<const bf16x8*>(a + 32 * 256);
        p0 = __builtin_amdgcn_mfma_f32_32x32x16_bf16(b0, qr[d0], p0, 0, 0, 0);
        p1 = __builtin_amdgcn_mfma_f32_32x32x16_bf16(b1, qr[d0], p1, 0, 0, 0); }
}
template <int VB>
__device__ __forceinline__ void pv_tile(f32x16* o, int vb0, bf16x8 pa0, bf16x8 pa1, bf16x8 pa2, bf16x8 pa3) {
#define TRRD(dst, off) asm volatile("ds_read_b64_tr_b16 %0, %1 offset:%2" : "=&v"(dst) : "v"(vb0), "i"(off) : "memory")
#define PV_D0(d0) do { s16x4 l0, l1, l2, l3, h0, h1, h2, h3; constexpr int b_ = VB * SHM_V + v_rd_off(d0, 0, 0); \
        TRRD(l0, b_); TRRD(h0, b_ + 2048); TRRD(l1, b_ + 4096); TRRD(h1, b_ + 6144); TRRD(l2, b_ + 8192); TRRD(h2, b_ + 10240); TRRD(l3, b_ + 12288); TRRD(h3, b_ + 14336); \
        asm volatile("s_waitcnt lgkmcnt(0)" ::: "memory"); SBAR();   \
        o[d0] = __builtin_amdgcn_mfma_f32_32x32x16_bf16(pa0, (bf16x8){l0[0], l0[1], l0[2], l0[3], h0[0], h0[1], h0[2], h0[3]}, o[d0], 0, 0, 0);   \
        o[d0] = __builtin_amdgcn_mfma_f32_32x32x16_bf16(pa1, (bf16x8){l1[0], l1[1], l1[2], l1[3], h1[0], h1[1], h1[2], h1[3]}, o[d0], 0, 0, 0);   \
        o[d0] = __builtin_amdgcn_mfma_f32_32x32x16_bf16(pa2, (bf16x8){l2[0], l2[1], l2[2], l2[3], h2[0], h2[1], h2[2], h2[3]}, o[d0], 0, 0, 0);   \
        o[d0] = __builtin_amdgcn_mfma_f32_32x32x16_bf16(pa3, (bf16x8){l3[0], l3[1], l3[2], l3[3], h3[0], h3[1], h3[2], h3[3]}, o[d0], 0, 0, 0); } while (0)
    PV_D0(0); PV_D0(1); PV_D0(2); PV_D0(3);
#undef PV_D0
#undef TRRD
}
struct BlockRef { const bf16_t* Q; const bf16_t* K; const bf16_t* V; bf16_t* O; int P0; };
struct Seam { bf16x8 qr[8]; bf16x8 st_v0, st_v1, st_k0, st_k1; };
#define ROW(p, k0, rr) ((p) + (size_t)((k0) + (rr)) * QP + sc)
#define VMW() asm volatile("s_waitcnt vmcnt(0)" ::: "memory")
#define VMWN(n) asm volatile("s_waitcnt vmcnt(%0)" :: "i"(n) : "memory")
#define SLOAD_H(Kp, Vp, k0) do { S.st_v0 = load8(ROW(Vp, k0, sr)); S.st_v1 = load8(ROW(Vp, k0, 32 + sr)); S.st_k0 = load8(ROW(Kp, k0, sr)); S.st_k1 = load8(ROW(Kp, k0, 32 + sr)); } while (0)
#define SWRITE_HK(bf) do { *(bf16x8*)(K_lds + (bf) * SHM_K + kws) = S.st_k0; *(bf16x8*)(K_lds + (bf) * SHM_K + kws + 32 * 256) = S.st_k1; } while (0)
#define SWRITE_HV(bf) do { *(bf16x8*)(V_lds + (bf) * SHM_V + vst0) = S.st_v0; *(bf16x8*)(V_lds + (bf) * SHM_V + vst1) = S.st_v1; } while (0)
#define SWRITE_H(bf) do { SWRITE_HV(bf); SWRITE_HK(bf); } while (0)
__device__ __forceinline__ void prime(const BlockRef& cur, char* lds, Seam& S) {
    const int tid = threadIdx.x, wid = __builtin_amdgcn_readfirstlane(tid >> 6), lane = tid & 63, r32 = lane & 31, hi = lane >> 5;
    const int sr = tid >> 4, sc = (tid & 15) * 8, kws = KSWZ(sr, sc * 2); char* K_lds = lds + 2 * SHM_V;
    for (int d0 = 0; d0 < 8; ++d0) S.qr[d0] = load8(cur.Q + (size_t)(wid * QBLK + r32) * QP + d0 * 16 + hi * 8);
    SLOAD_H(cur.K, cur.V, 0); VMW(); SWRITE_HK(0);
    __syncthreads();
}
__device__ __forceinline__ void block(const BlockRef& cur, const BlockRef& nxt, char* lds, Seam& S) {
    const int tid = threadIdx.x, wid = __builtin_amdgcn_readfirstlane(tid >> 6), lane = tid & 63, r32 = lane & 31, hi = lane >> 5;
    const int NT = (cur.P0 + QB - 1) / KVBLK + 1;
    const int qlo = cur.P0 + wid * QBLK, qm = qlo + r32 - 4 * hi;
    char* V_lds = lds; char* K_lds = lds + 2 * SHM_V;
    float* ws = (float*)(lds + 2 * SHM_V + 2 * SHM_K) + wid * 64; float* li_l = ws, * al_l = ws + 32;
    const float* c_lds = (const float*)(lds + LDS_C) + 4 * hi;
    float m_reg = -1e30f, l_reg = 0; f32x16 o[4] = {};
    const int sr = tid >> 4, sc = (tid & 15) * 8, vst0 = v_st(sr, sc), vst1 = v_st(32 + sr, sc), kws = KSWZ(sr, sc * 2);
    const int vb0 = (int)(uintptr_t)V_lds + v_rd_base(lane);
    const bf16_t* Kh = cur.K; const bf16_t* Vh = cur.V;
#define RESC(a) do { if (__any((a) < 1.f)) { if (hi == 0) al_l[r32] = (a); asm volatile("s_waitcnt lgkmcnt(0)" ::: "memory");              \
                     for (int d_ = 0; d_ < 4; ++d_) for (int r = 0; r < 16; ++r) o[d_][r] *= al_l[crow(r, hi)]; } } while (0)
#define KBASE(t) ((t) * KVBLK)
#define MASKT(P0_, P1_, t) do { const int kb_ = KBASE(t); bias_tile(P0_, P1_, c_lds + kb_); if (kb_ + KVBLK - 1 > qlo) mask_tile(P0_, P1_, qm - kb_); } while (0)
#define SEAM_K0() do { VMWN(8); SWRITE_HK(0); SBAR(); } while (0)
    f32x16 pA0, pA1, pB0, pB1; float mnA, mnB, alA, alB; bf16x8 pa0, pa1, pa2, pa3;
    SWRITE_HV(0); SBAR();
    if (NT > 1) { SLOAD_H(Kh, Vh, KBASE(1)); }
    SBAR(); qkt<0>(pA0, pA1, K_lds, r32, hi, S.qr);
    MASKT(pA0, pA1, 0); partialSM(pA0, pA1, m_reg, mnA, alA);
    if (NT > 1) { VMW(); SWRITE_H(1); }
    __syncthreads();
#define HALF_STEP(PX0, PX1, mnX, alX, PY0, PY1, alY, t, KB, VB, SB) do {                                                      \
        SBAR(); qkt<KB>(PX0, PX1, K_lds, r32, hi, S.qr);                                                                     \
        finishSM(PY0, PY1, alY, l_reg, pa0, pa1, pa2, pa3); SBAR();                                                           \
        if ((t) + 1 < NT) { SLOAD_H(Kh, Vh, KBASE((t) + 1)); SBAR(); }                                                        \
        pv_tile<VB>(o, vb0, pa0, pa1, pa2, pa3); MASKT(PX0, PX1, (t)); partialSM(PX0, PX1, m_reg, mnX, alX);                 \
        __syncthreads();                                                                                                      \
        if ((t) + 1 < NT) { VMW(); SWRITE_H(SB); }                                                                            \
        RESC(alX); __syncthreads(); } while (0)
    for (int t = 1; t + 1 < NT; t += 2) {
        HALF_STEP(pB0, pB1, mnB, alB, pA0, pA1, alA, t, 1, 0, 0);
        HALF_STEP(pA0, pA1, mnA, alA, pB0, pB1, alB, t + 1, 0, 1, 1);
    }
    const bool even = (NT & 1) == 0;
    if (even) { SBAR(); qkt<1>(pB0, pB1, K_lds, r32, hi, S.qr); SBAR(); }
    SLOAD_H(nxt.K, nxt.V, 0); SBAR();
#pragma unroll
    for (int d0 = 0; d0 < 8; ++d0) S.qr[d0] = load8(nxt.Q + (size_t)(wid * QBLK + r32) * QP + d0 * 16 + hi * 8);
    SBAR();
    finishSM(pA0, pA1, alA, l_reg, pa0, pa1, pa2, pa3); SBAR();
    pv_tile<0>(o, vb0, pa0, pa1, pa2, pa3);
    if (even) { MASKT(pB0, pB1, NT - 1); partialSM(pB0, pB1, m_reg, mnB, alB); __syncthreads(); RESC(alB);
        finishSM(pB0, pB1, alB, l_reg, pa0, pa1, pa2, pa3); SBAR(); pv_tile<1>(o, vb0, pa0, pa1, pa2, pa3); }
    SBAR(); SEAM_K0();
    if (hi == 0) li_l[r32] = l_reg; asm volatile("s_waitcnt lgkmcnt(0)" ::: "memory");
    float rli[16];
#pragma unroll
    for (int r = 0; r < 16; ++r) rli[r] = __builtin_amdgcn_rcpf(li_l[crow(r, hi)]);
    bf16_t* Ow = cur.O + (size_t)(wid * QBLK) * OP;
#pragma unroll
    for (int r = 0; r < 16; ++r) { const int orow = crow(r, hi);
#pragma unroll
        for (int d0 = 0; d0 < 4; ++d0) { const float v = o[d0][r] * rli[r];
            const float vn = __shfl_xor(v, 1);
            if ((r32 & 1) == 0) *(unsigned*)(Ow + (size_t)orow * OP + d0 * 32 + r32) = cvtpk(v, vn); } }
    __syncthreads();
#undef RESC
#undef KBASE
#undef MASKT
#undef SEAM_K0
#undef HALF_STEP
}
#undef ROW
#undef VMW
#undef VMWN
#undef SLOAD_H
#undef SWRITE_HK
#undef SWRITE_HV
#undef SWRITE_H
#undef KSWZ
#undef SBAR
}

constexpr int NWAVES = 8, NTHREADS = 512;
constexpr int LDS_BYTES = 147456;
constexpr int LDS_MISC = 145408;
constexpr size_t MiB = 1u << 20;
constexpr size_t WS_CTL = 0, CTL_ZERO_BYTES = 1 * MiB;
constexpr int CW_BAR = 4096;
constexpr size_t CTL_SS1 = 256 * 1024, CTL_SS2 = 320 * 1024;
constexpr size_t WS_LF = 1 * MiB;
constexpr size_t WS_SU = 1 * MiB + 512 * 1024, WS_SV = 1 * MiB + 640 * 1024;
constexpr size_t WS_WIN = 2 * MiB, WS_WO1 = 18 * MiB, WS_WO2 = 26 * MiB, WS_WQ = 34 * MiB, WS_WK = 42 * MiB, WS_WV = 50 * MiB, WS_WO = 58 * MiB;
constexpr size_t WS_WPQ = 66 * MiB, WS_AEXP = 74 * MiB, WS_WSC = 82 * MiB, WS_PB = 90 * MiB, WS_MN = 91 * MiB, WS_KX = 93 * MiB, WS_VXT = 95 * MiB;
constexpr size_t WS_UB = 98 * MiB, WS_VB = 130 * MiB, WS_XN = 226 * MiB, WS_PROJ = 258 * MiB, WS_AMIX = 322 * MiB, WS_H = 354 * MiB, WS_HB = 418 * MiB, WS_P = 450 * MiB, WS_END = 466 * MiB;

#define GAS __attribute__((address_space(1)))
#define LAS __attribute__((address_space(3)))
typedef unsigned short bf16;
typedef unsigned v4u __attribute__((ext_vector_type(4)));
typedef unsigned v2u __attribute__((ext_vector_type(2)));
typedef float f32x4 __attribute__((ext_vector_type(4)));
typedef __bf16 bf16x2_t __attribute__((ext_vector_type(2)));
#define LDS_WAIT() asm volatile("s_waitcnt lgkmcnt(0)" ::: "memory")
__device__ __forceinline__ unsigned f2bf(float f) { unsigned u = __builtin_bit_cast(unsigned, f); return (u + 0x7fffu + ((u >> 16) & 1u)) >> 16; }
__device__ __forceinline__ unsigned pk2(float lo, float hi) { return f2bf(lo) | (f2bf(hi) << 16); }
__device__ __forceinline__ float wave_sum(float v) {
#pragma unroll
    for (int o = 1; o < 64; o <<= 1) v += __shfl_xor(v, o);
    return v;
}

#define XB_TMO      128
#define XB_XCNT(j)  (256  + 64 * (j))
#define XB_XSUB(j)  (1280 + 64 * (j))
#define XB_XGEN(j)  (2304 + 64 * (j))
#define XB_TOP      3328
#define XB_TOPGEN   3392
#define XCD_BAR_WORDS 3456
#define XB_SPIN_CAP (1u << 22)
__device__ __forceinline__ unsigned xb_ld(unsigned* p)              { return __hip_atomic_load(p, __ATOMIC_RELAXED, __HIP_MEMORY_SCOPE_AGENT); }
__device__ __forceinline__ unsigned xb_add(unsigned* p, unsigned v) { return __hip_atomic_fetch_add(p, v, __ATOMIC_RELAXED, __HIP_MEMORY_SCOPE_AGENT); }
__device__ __forceinline__ unsigned xb_xcc_id() { return (unsigned)__builtin_amdgcn_s_getreg((3 << 11) | 20) & 0xFu; }
#define XB_SPIN(cond, bar) do { unsigned _sp = 0; while (cond) { __builtin_amdgcn_s_sleep(1); \
    if ((++_sp & 255u) == 0u) { if (xb_ld(&(bar)[XB_TMO])) break; if (_sp > XB_SPIN_CAP) { atomicAdd(&(bar)[XB_TMO], 1u); break; } } } } while (0)
struct XcdBarrier { unsigned* bar; unsigned x; volatile LAS unsigned* st; };
__device__ __forceinline__ XcdBarrier xcd_barrier_post(unsigned* bar, volatile LAS unsigned* st) {
    XcdBarrier b; b.bar = bar; b.x = xb_xcc_id(); b.st = st;
    if (threadIdx.x == 0) (void)xb_add(&bar[XB_XCNT(b.x)], 1u);
    return b;
}
__device__ __forceinline__ void xcd_barrier_complete(unsigned* bar, unsigned x, unsigned& nloc, unsigned& nx) {
    const unsigned G = gridDim.x * gridDim.y * gridDim.z;
    unsigned sum, cnt, mine, sp = 0u;
    for (;;) {
        sum = 0u; cnt = 0u; mine = 0u;
#pragma unroll
        for (unsigned j = 0; j < 16; ++j) { const unsigned c = xb_ld(&bar[XB_XCNT(j)]); sum += c; cnt += (c > 0u) ? 1u : 0u; mine = (j == x) ? c : mine; }
        if (sum == G) break;
        __builtin_amdgcn_s_sleep(1);
        if ((++sp & 255u) == 0u) { if (xb_ld(&bar[XB_TMO])) break; if (sp > XB_SPIN_CAP) { atomicAdd(&bar[XB_TMO], 1u); break; } }
    }
    nloc = mine > 0u ? mine : 1u; nx = cnt > 0u ? cnt : 1u;
}
__device__ __forceinline__ void xcd_barrier(const XcdBarrier& b) {
    asm volatile("s_waitcnt vmcnt(0)" ::: "memory");
    __syncthreads();
    if (threadIdx.x == 0) {
        unsigned* bar = b.bar;
        __builtin_amdgcn_s_waitcnt(0);
        unsigned nloc = b.st[0], nx = b.st[1];
        if (nloc == 0u) { xcd_barrier_complete(bar, b.x, nloc, nx); b.st[0] = nloc; b.st[1] = nx; }
        const unsigned old = xb_add(&bar[XB_XSUB(b.x)], 1u);
        const unsigned gen = old / nloc;
        if (old + 1u == (gen + 1u) * nloc) {
            __builtin_amdgcn_fence(__ATOMIC_RELEASE, "agent");
            asm volatile("s_waitcnt vmcnt(0)" ::: "memory");
            const unsigned og = xb_add(&bar[XB_TOP], 1u);
            const unsigned tg = og / nx;
            if (og + 1u == (tg + 1u) * nx) xb_add(&bar[XB_TOPGEN], 1u);
            else XB_SPIN(xb_ld(&bar[XB_TOPGEN]) == tg, bar);
            __builtin_amdgcn_fence(__ATOMIC_ACQUIRE, "agent");
            xb_add(&bar[XB_XGEN(b.x)], 1u);
            asm volatile("s_waitcnt vmcnt(0)" ::: "memory");
        } else {
            XB_SPIN(xb_ld(&bar[XB_XGEN(b.x)]) == gen, bar);
            __builtin_amdgcn_fence(__ATOMIC_ACQUIRE, "agent");
            asm volatile("s_waitcnt vmcnt(0)" ::: "memory");
        }
    }
    __syncthreads();
}

struct Args { const float* in[20]; float* out; unsigned char* ws; int ph_lo, ph_hi; int one_launch, pad; };

__device__ __forceinline__ void p0_transpose_item(const float* W, int ldw, int nblk, const float* g, bf16* WT, bf16* WT2, int k2lo, int ldt, LAS float* scr, int item, int lane) {
    const int kb = item / nblk, nb = item % nblk, k0 = 64 * kb, n0 = 32 * nb;
#pragma unroll 8
    for (int i = 0; i < 32; ++i) { const int kk = 2 * i + (lane >> 5); float v = W[(size_t)(k0 + kk) * ldw + n0 + (lane & 31)]; if (g) v *= g[k0 + kk]; scr[kk * 33 + (lane & 31)] = v; }
    LDS_WAIT(); asm volatile("" ::: "memory");
    const int c = lane & 7;
#pragma unroll
    for (int j = 0; j < 4; ++j) { const int n = (lane >> 3) + 8 * j; const LAS float* s = scr + (8 * c) * 33 + n;
        v4u o; o.x = pk2(s[0 * 33], s[1 * 33]); o.y = pk2(s[2 * 33], s[3 * 33]); o.z = pk2(s[4 * 33], s[5 * 33]); o.w = pk2(s[6 * 33], s[7 * 33]);
        *(GAS v4u*)(WT + (size_t)(n0 + n) * ldt + k0 + 8 * c) = o;
        if (WT2 && k0 >= k2lo) *(GAS v4u*)(WT2 + (size_t)(n0 + n) * ldt + k0 + 8 * c) = o; }
    LDS_WAIT(); asm volatile("" ::: "memory");
}
__device__ __forceinline__ v4u cvt8(const float* p, float s) {
    const f32x4 a = *(const f32x4*)p, b = *(const f32x4*)(p + 4);
    v4u o; o.x = pk2(a[0] * s, a[1] * s); o.y = pk2(a[2] * s, a[3] * s); o.z = pk2(b[0] * s, b[1] * s); o.w = pk2(b[2] * s, b[3] * s); return o;
}

__device__ __forceinline__ float gelu_f(float v) {
    const float av = fabsf(v), t = __builtin_amdgcn_rcpf(av * 0.2316418882f + 1.0f);
    float q = t * 0.5307027145f + (-0.7265760135f); q = q * t + 0.7107068705f; q = q * t + (-0.142248368f); q = q * t + 0.127414796f; q = q * t;
    const float e = __builtin_amdgcn_exp2f((v * v) * (-0.72134752044f));
    const float m = v * (q * e);
    return v < 0.f ? m : v - m;
}
__device__ __forceinline__ float dot2bf(unsigned a, unsigned b, float c) { return __builtin_amdgcn_fdot2_f32_bf16(__builtin_bit_cast(bf16x2_t, a), __builtin_bit_cast(bf16x2_t, b), c, false); }
__device__ __forceinline__ unsigned fkey(float f) { const unsigned u = __float_as_uint(f); return (u & 0x80000000u) ? ~u : (u | 0x80000000u); }
__device__ __forceinline__ float fdec(unsigned k) { const unsigned u = (k & 0x80000000u) ? (k & 0x7fffffffu) : ~k; return __uint_as_float(u); }


typedef float f32x2v __attribute__((ext_vector_type(2)));
__device__ __forceinline__ float wave_sum_dpp(float v) {
    v += __builtin_bit_cast(float, __builtin_amdgcn_update_dpp(0, __builtin_bit_cast(int, v), 0xB1, 0xf, 0xf, true));
    v += __builtin_bit_cast(float, __builtin_amdgcn_update_dpp(0, __builtin_bit_cast(int, v), 0x4E, 0xf, 0xf, true));
    v += __builtin_bit_cast(float, __builtin_amdgcn_update_dpp(0, __builtin_bit_cast(int, v), 0x141, 0xf, 0xf, true));
    v += __builtin_bit_cast(float, __builtin_amdgcn_update_dpp(0, __builtin_bit_cast(int, v), 0x140, 0xf, 0xf, true));
    const float a = __builtin_bit_cast(float, __builtin_amdgcn_readlane(__builtin_bit_cast(int, v), 0));
    const float b = __builtin_bit_cast(float, __builtin_amdgcn_readlane(__builtin_bit_cast(int, v), 16));
    const float c = __builtin_bit_cast(float, __builtin_amdgcn_readlane(__builtin_bit_cast(int, v), 32));
    const float d = __builtin_bit_cast(float, __builtin_amdgcn_readlane(__builtin_bit_cast(int, v), 48));
    return (a + b) + (c + d);
}
struct PeerBuf { v4u u[2][2]; v4u v[2][2]; float su[2], sv[2], gt[2]; };
__device__ __forceinline__ void peer_load(PeerBuf& B, const unsigned char* UB, const unsigned char* VB, const float* SU, const float* SV, const LAS unsigned* ridx, const LAS float* rgate, int k0, int lane) {
#pragma unroll
    for (int p = 0; p < 2; ++p) { const unsigned ex = (unsigned)__builtin_amdgcn_readfirstlane((int)ridx[k0 + p]);
        B.su[p] = SU[ex]; B.sv[p] = SV[ex]; B.gt[p] = rgate[k0 + p];
        const unsigned char* up = UB + (size_t)ex * DM + lane * 16; const unsigned char* vp = VB + (size_t)ex * DM + lane * 16;
#pragma unroll
        for (int j = 0; j < 2; ++j) { B.u[p][j] = *(const GAS v4u*)(up + j * 1024); B.v[p][j] = *(const GAS v4u*)(vp + j * 1024); } }
}
__device__ __forceinline__ float dot4_fp8(unsigned w, float x0, float x1, float x2, float x3, float acc) {
    const f32x2v lo = __builtin_amdgcn_cvt_pk_f32_fp8((int)w, false), hi = __builtin_amdgcn_cvt_pk_f32_fp8((int)w, true);
    acc = fmaf(lo.x, x0, acc); acc = fmaf(lo.y, x1, acc); acc = fmaf(hi.x, x2, acc); acc = fmaf(hi.y, x3, acc); return acc;
}
__device__ __forceinline__ void axpy4_fp8(unsigned w, float a, float& o0, float& o1, float& o2, float& o3) {
    const f32x2v lo = __builtin_amdgcn_cvt_pk_f32_fp8((int)w, false), hi = __builtin_amdgcn_cvt_pk_f32_fp8((int)w, true);
    o0 = fmaf(a, lo.x, o0); o1 = fmaf(a, lo.y, o1); o2 = fmaf(a, hi.x, o2); o3 = fmaf(a, hi.y, o3);
}
__device__ __forceinline__ unsigned v4get(const v4u& v, int q) { return q == 0 ? v.x : q == 1 ? v.y : q == 2 ? v.z : v.w; }
__device__ __forceinline__ void peer_comp(const PeerBuf& B, const float (&xn)[2][16], float (&oacc)[2][16]) {
    float d[2];
#pragma unroll
    for (int p = 0; p < 2; ++p) { float a0 = 0.f, a1 = 0.f;
#pragma unroll
        for (int q = 0; q < 4; ++q) { a0 = dot4_fp8(v4get(B.u[p][0], q), xn[0][4 * q], xn[0][4 * q + 1], xn[0][4 * q + 2], xn[0][4 * q + 3], a0);
                                       a1 = dot4_fp8(v4get(B.u[p][1], q), xn[1][4 * q], xn[1][4 * q + 1], xn[1][4 * q + 2], xn[1][4 * q + 3], a1); }
        d[p] = a0 + a1; }
#pragma unroll
    for (int p = 0; p < 2; ++p) d[p] = wave_sum_dpp(d[p]) * B.su[p];
#pragma unroll
    for (int p = 0; p < 2; ++p) { const float w = gelu_f(d[p]) * B.gt[p] * B.sv[p];
#pragma unroll
        for (int j = 0; j < 2; ++j)
#pragma unroll
            for (int q = 0; q < 4; ++q) axpy4_fp8(v4get(B.v[p][j], q), w, oacc[j][4 * q], oacc[j][4 * q + 1], oacc[j][4 * q + 2], oacc[j][4 * q + 3]); }
}

__global__ void __launch_bounds__(NTHREADS, 2) fwd_kernel(Args args) {
    extern __shared__ __attribute__((aligned(16))) unsigned char lds[];
    LAS unsigned char* ldsL = (LAS unsigned char*)lds;
    volatile LAS unsigned* MISC = (volatile LAS unsigned*)(ldsL + LDS_MISC);
    const int tid = threadIdx.x, lane = tid & 63, wave = __builtin_amdgcn_readfirstlane(tid >> 6);
    const int G = gridDim.x; const int bx = blockIdx.x; const int vcu = (G % 8 == 0) ? (bx % 8) * (G / 8) + bx / 8 : bx;
    unsigned char* ws = args.ws;
    unsigned* ctl = (unsigned*)(ws + WS_CTL);
    const float* x = args.in[0]; const float* mem = args.in[1]; const float* mix_norm = args.in[2]; const float* w_in = args.in[3]; const float* b_forget = args.in[4];
    const float* pool_w = args.in[5]; const float* pool_scale = args.in[6]; const float* w_out = args.in[7]; const float* xattn_norm = args.in[8]; const float* mem_norm = args.in[9];
    const float* xwq = args.in[10]; const float* xwk = args.in[11]; const float* xwv = args.in[12]; const float* xwo = args.in[13]; const float* peer_norm = args.in[14];
    const float* peer_wq = args.in[15]; const float* sub_keys = args.in[16]; const float* peer_u = args.in[17]; const float* peer_v = args.in[18]; const float* final_norm = args.in[19];
    bf16* W_IN = (bf16*)(ws + WS_WIN); bf16* WO1 = (bf16*)(ws + WS_WO1); bf16* WO2 = (bf16*)(ws + WS_WO2); bf16* WQ = (bf16*)(ws + WS_WQ); bf16* WK = (bf16*)(ws + WS_WK);
    bf16* WV = (bf16*)(ws + WS_WV); bf16* WO = (bf16*)(ws + WS_WO); bf16* WPQ = (bf16*)(ws + WS_WPQ); bf16* AEXP = (bf16*)(ws + WS_AEXP); bf16* WSC = (bf16*)(ws + WS_WSC);
    bf16* PB = (bf16*)(ws + WS_PB); bf16* MN = (bf16*)(ws + WS_MN); bf16* KX = (bf16*)(ws + WS_KX); bf16* VXT = (bf16*)(ws + WS_VXT); unsigned char* UB = ws + WS_UB; unsigned char* VB = ws + WS_VB; float* SU = (float*)(ws + WS_SU); float* SV = (float*)(ws + WS_SV);
    bf16* XN = (bf16*)(ws + WS_XN); bf16* QX = XN; bf16* PROJ = (bf16*)(ws + WS_PROJ); float* SCT = (float*)(ws + WS_PROJ); bf16* AMIX = (bf16*)(ws + WS_AMIX); bf16* OX = AMIX;
    float* H = (float*)(ws + WS_H); bf16* HB = (bf16*)(ws + WS_HB); bf16* PP = (bf16*)(ws + WS_P); float* LF = (float*)(ws + WS_LF);
    float* SS1 = (float*)(ws + CTL_SS1); float* SS2 = (float*)(ws + CTL_SS2);

    for (int u = tid; u < (LDS_BYTES - LDS_MISC) / 4; u += NTHREADS) ((LAS unsigned*)(ldsL + LDS_MISC))[u] = 0u;
    __syncthreads();
    XcdBarrier bar; bar.bar = ctl + CW_BAR; bar.x = 0; bar.st = nullptr;
    if (args.one_launch) bar = xcd_barrier_post(ctl + CW_BAR, MISC + 8);
    const int lo = args.ph_lo, hi = args.ph_hi;
#ifndef PH_MASK
#define PH_MASK 0x3ff
#endif
#define IN(k) (((PH_MASK >> (k)) & 1) && lo <= (k) && (k) < hi)
#define SEAM(k) do { if (IN(k) && IN((k) + 1)) xcd_barrier(bar); } while (0)
    const int gw = vcu * NWAVES + wave, NGW = G * NWAVES;
    const int gt = vcu * NTHREADS + tid, NGT = G * NTHREADS;

    if (IN(0)) {
        LAS float* wf = (LAS float*)ldsL;
        LAS float* scr = (LAS float*)(ldsL + 65536 + wave * 8704);
        for (int i = tid; i < 8 * DM; i += NTHREADS) { const int d = i >> 3, h = i & 7; wf[h * DM + d] = w_in[(size_t)d * INC + 4096 + h]; }
        __syncthreads();
        for (int m = gw; m < TOK; m += NGW) {
            const GAS f32x4* xr = (const GAS f32x4*)(x + (size_t)m * DM) + lane; const GAS f32x4* gr = (const GAS f32x4*)mix_norm + lane;
            f32x4 v[8]; float s = 0.f;
#pragma unroll
            for (int j = 0; j < 8; ++j) { v[j] = xr[64 * j]; s += (v[j][0] * v[j][0] + v[j][1] * v[j][1]) + (v[j][2] * v[j][2] + v[j][3] * v[j][3]); }
            const float rstd = __builtin_amdgcn_rsqf(wave_sum(s) * (1.f / DM) + EPS);
            GAS v2u* o8 = (GAS v2u*)(XN + (size_t)m * DM) + lane;
#pragma unroll
            for (int j = 0; j < 8; ++j) { const f32x4 gg = gr[64 * j]; v[j] = v[j] * rstd * gg;
                v2u o; o.x = pk2(v[j][0], v[j][1]); o.y = pk2(v[j][2], v[j][3]); o8[64 * j] = o; }
            float fl[8];
#pragma unroll
            for (int h = 0; h < 8; ++h) { float a = 0.f;
#pragma unroll
                for (int j = 0; j < 8; ++j) { const f32x4 w = *(const LAS f32x4*)(wf + h * DM + j * 256 + lane * 4); a += (v[j][0] * w[0] + v[j][1] * w[1]) + (v[j][2] * w[2] + v[j][3] * w[3]); }
                fl[h] = wave_sum(a);
                asm volatile("" ::: "memory"); }
            if (lane < 8) { float f = fl[0];
#pragma unroll
                for (int h = 1; h < 8; ++h) f = (lane == h) ? fl[h] : f;
                f += b_forget[lane];
                const float ls = fminf(f, 0.f) - log1pf(expf(-fabsf(f)));
                const int b = m / SEQ, sq = m % SEQ; LF[(size_t)(b * FOXH + lane) * SEQ + sq] = ls; }
        }
        for (int m = gw; m < BATCH * NMEM; m += NGW) {
            const GAS f32x4* xr = (const GAS f32x4*)(mem + (size_t)m * DM) + lane; const GAS f32x4* gr = (const GAS f32x4*)mem_norm + lane;
            f32x4 v[8]; float s = 0.f;
#pragma unroll
            for (int j = 0; j < 8; ++j) { v[j] = xr[64 * j]; s += (v[j][0] * v[j][0] + v[j][1] * v[j][1]) + (v[j][2] * v[j][2] + v[j][3] * v[j][3]); }
            const float rstd = __builtin_amdgcn_rsqf(wave_sum(s) * (1.f / DM) + EPS);
            GAS v2u* o8 = (GAS v2u*)(MN + (size_t)m * DM) + lane;
#pragma unroll
            for (int j = 0; j < 8; ++j) { const f32x4 gg = gr[64 * j]; v[j] = v[j] * rstd * gg; v2u o; o.x = pk2(v[j][0], v[j][1]); o.y = pk2(v[j][2], v[j][3]); o8[64 * j] = o; }
        }
        {
            constexpr int I_IN = (DM / 64) * (4096 / 32), I_SQ = (DM / 64) * (DM / 32);
            constexpr int NITEMS = I_IN + 5 * I_SQ;
            for (int it = gw; it < NITEMS; it += NGW) {
                int r = it;
                if (r < I_IN) { p0_transpose_item(w_in, INC, 4096 / 32, nullptr, W_IN, nullptr, 0, DM, scr, r, lane); continue; } r -= I_IN;
                if (r < I_SQ) { p0_transpose_item(w_out, DM, DM / 32, nullptr, WO1, WO2, POOLW, DM, scr, r, lane); continue; } r -= I_SQ;
                if (r < I_SQ) { p0_transpose_item(xwq, DM, DM / 32, xattn_norm, WQ, nullptr, 0, DM, scr, r, lane); continue; } r -= I_SQ;
                if (r < I_SQ) { p0_transpose_item(xwk, DM, DM / 32, nullptr, WK, nullptr, 0, DM, scr, r, lane); continue; } r -= I_SQ;
                if (r < I_SQ) { p0_transpose_item(xwv, DM, DM / 32, nullptr, WV, nullptr, 0, DM, scr, r, lane); continue; } r -= I_SQ;
                p0_transpose_item(xwo, DM, DM / 32, nullptr, WO, nullptr, 0, DM, scr, r, lane);
            }
        }
        for (int r = gw; r < 2 * PEXP; r += NGW) {
            const int tb = r >> 14, rr = r & (PEXP - 1);
            const float* src = (tb ? peer_v : peer_u) + (size_t)rr * DM + lane * 16;
            f32x4 v[2][4]; float am = 0.f;
#pragma unroll
            for (int j = 0; j < 2; ++j)
#pragma unroll
                for (int q = 0; q < 4; ++q) { v[j][q] = *(const GAS f32x4*)(src + j * 1024 + q * 4);
                    am = fmaxf(am, fmaxf(fmaxf(fabsf(v[j][q][0]), fabsf(v[j][q][1])), fmaxf(fabsf(v[j][q][2]), fabsf(v[j][q][3])))); }
#pragma unroll
            for (int o = 1; o < 64; o <<= 1) am = fmaxf(am, __shfl_xor(am, o));
            int ex = 0; if (am > 0.f) { (void)frexpf(am, &ex); ex = 8 - ex; }
            ex -= 1;
            const float sc = ldexpf(1.f, ex);
            if (lane == 0) (tb ? SV : SU)[rr] = ldexpf(1.f, -ex);
            unsigned char* dst = (tb ? VB : UB) + (size_t)rr * DM + lane * 16;
#pragma unroll
            for (int j = 0; j < 2; ++j) { v4u o;
#pragma unroll
                for (int q = 0; q < 4; ++q) { int w = __builtin_amdgcn_cvt_pk_fp8_f32(v[j][q][0] * sc, v[j][q][1] * sc, 0, false);
                    w = __builtin_amdgcn_cvt_pk_fp8_f32(v[j][q][2] * sc, v[j][q][3] * sc, w, true); o[q] = (unsigned)w; }
                *(GAS v4u*)(dst + j * 1024) = o; }
        }
        for (int i = gt; i < DM * DM / 8; i += NGT) {
            const int d = i / (DM / 8); *(GAS v4u*)(WPQ + (size_t)i * 8) = cvt8(peer_wq + (size_t)i * 8, peer_norm[d]); }
        for (int i = gt; i < DM * DM / 8; i += NGT) {
            const int r = i / (DM / 8), c0 = (i % (DM / 8)) * 8; const int hc = r >> 7;
            v4u o = {0u, 0u, 0u, 0u}; if ((c0 >> 7) == hc) o = cvt8(sub_keys + (size_t)r * 128 + (c0 & 127), 1.f);
            *(GAS v4u*)(AEXP + (size_t)i * 8) = o; }
        for (int i = gt; i < 4 * 256 * 256 / 8; i += NGT) {
            const int g = i / (256 * 256 / 8), d0 = (i % 32) * 8; const float* ps = pool_scale + g * 256 + d0; const float* p = pool_w + (size_t)i * 8;
            v4u o; o.x = pk2(p[0] * ps[0], p[1] * ps[1]); o.y = pk2(p[2] * ps[2], p[3] * ps[3]); o.z = pk2(p[4] * ps[4], p[5] * ps[5]); o.w = pk2(p[6] * ps[6], p[7] * ps[7]);
            *(GAS v4u*)(PB + (size_t)i * 8) = o; }
        __syncthreads();
    }
    SEAM(0);

    if (IN(1)) {
        pg8::Gemm g{XN, W_IN, DM, DM, DM}; pg8::GSched S; S.init(TOK / 256, 4096 / 256, G, bx, DM, DM);
        pg8::EpiStore E{PROJ, 4096, 0, 0, 1, nullptr, 1.f, 4, 8, 0.08838834764831845f * LOG2E};
        pg8::gemm_phase<pg8::EpiStore, pg8::GSched, true>(ldsL, g, S, E);
    }
    SEAM(1);

    if (IN(2)) {
        for (int it = vcu; it < TOK / 32; it += G) {
            const int ch = (tid & 127) * 8, rsub = tid >> 7, r0 = it * 32 + rsub * 8, w = 2 << (ch >> 8);
            const int s0 = r0 % SEQ;
            float acc[8];
#pragma unroll
            for (int e = 0; e < 8; ++e) acc[e] = 0.f;
            for (int k = 1; k < w; ++k) { if (s0 - k >= 0) { const v4u v = *(const GAS v4u*)(PROJ + (size_t)(r0 - k) * 4096 + ch);
#pragma unroll
                    for (int e = 0; e < 4; ++e) { acc[2 * e] += __uint_as_float(v[e] << 16); acc[2 * e + 1] += __uint_as_float(v[e] & 0xffff0000u); } } }
            for (int rr = 0; rr < 8; ++rr) {
                const v4u v = *(const GAS v4u*)(PROJ + (size_t)(r0 + rr) * 4096 + ch); float cur[8];
#pragma unroll
                for (int e = 0; e < 4; ++e) { cur[2 * e] = __uint_as_float(v[e] << 16); cur[2 * e + 1] = __uint_as_float(v[e] & 0xffff0000u); }
                const int sp = s0 + rr; const float inv = 1.f / (float)((sp + 1 < w) ? sp + 1 : w);
                v4u o;
#pragma unroll
                for (int e = 0; e < 8; ++e) acc[e] += cur[e];
                o.x = pk2(acc[0] * inv - cur[0], acc[1] * inv - cur[1]); o.y = pk2(acc[2] * inv - cur[2], acc[3] * inv - cur[3]);
                o.z = pk2(acc[4] * inv - cur[4], acc[5] * inv - cur[5]); o.w = pk2(acc[6] * inv - cur[6], acc[7] * inv - cur[7]);
                *(GAS v4u*)(AMIX + (size_t)(r0 + rr) * DM + ch) = o;
                if (sp - w + 1 >= 0) { const v4u vo = *(const GAS v4u*)(PROJ + (size_t)(r0 + rr - w + 1) * 4096 + ch);
#pragma unroll
                    for (int e = 0; e < 4; ++e) { acc[2 * e] -= __uint_as_float(vo[e] << 16); acc[2 * e + 1] -= __uint_as_float(vo[e] & 0xffff0000u); } }
            }
        }
        const int a_bh = vcu >> 4, a_qb = vcu & 15;
        if (a_qb < 8 && vcu < 256) {
            const int e = a_bh * 8 + a_qb;
            pg8::Gemm g; pg8::GSched S; S.init(1, 1, 1, 0, DM, DM); pg8::EpiStore E{nullptr, DM, 0, 0, 1, nullptr, 1.f, 0, 0, 1.f};
            int pm, pn;
            if (e < 16)      { pm = e >> 3; pn = e & 7; g = pg8::Gemm{MN, WK, DM, DM, DM}; E.O = KX; E.ldc = DM; }
            else if (e < 32) { const int q = e - 16; pm = q >> 1; pn = q & 1; g = pg8::Gemm{WV, MN, DM, DM, DM}; E.O = VXT; E.ldc = 512; }
            else if (e < 96) { const int q = e - 32; pm = q >> 3; pn = q & 7; g = pg8::Gemm{AEXP, WPQ, DM, DM, DM}; E.O = WSC; E.ldc = DM; }
            else             { const int q = e - 96; const int gg = q >> 3; pm = q & 7; pn = 0;
                               g = pg8::Gemm{WO1 + gg * 256, PB + (size_t)gg * 65536, 256, DM, 256}; S.lda = DM; S.ldb = 256; E.O = WO2 + gg * 256; E.ldc = DM; }
            struct One { int pm, pn; long ao, bo; __device__ __forceinline__ bool next(int i, pg8::Unit& u) const { if (i) return false; u.pm = pm; u.pn = pn; u.z = 0; u.aoff = ao; u.boff = bo; return true; }
                         __device__ __forceinline__ void a_ready(const pg8::Unit&) const {} __device__ __forceinline__ void done(const pg8::Unit&) const {} };
            const One S1{pm, pn, (long)pm * 256 * g.lda, (long)pn * 256 * g.ldb};
            pg8::gemm_phase<pg8::EpiStore, One, false>(ldsL, g, S1, E);
        }
        if (vcu < 256) {
            const int b = a_bh >> 3, h = a_bh & 7;
            float* c_lds = (float*)(lds + fox::LDS_C);
            if (wave == 0) {
                const float* lf = LF + (size_t)a_bh * SEQ + lane * 64; float loc[64]; float run = 0.f;
#pragma unroll
                for (int i = 0; i < 16; ++i) { const f32x4 v = *(const f32x4*)(lf + 4 * i);
#pragma unroll
                    for (int e = 0; e < 4; ++e) { run += v[e]; loc[4 * i + e] = run; } }
                float incl = run;
#pragma unroll
                for (int o = 1; o < 64; o <<= 1) { const float t = __shfl_up(incl, o); if (lane >= o) incl += t; }
                const float excl = incl - run;
#pragma unroll
                for (int i = 0; i < 16; ++i) { f32x4 v;
#pragma unroll
                    for (int e = 0; e < 4; ++e) v[e] = (loc[4 * i + e] + excl) * LOG2E;
                    *(f32x4*)(c_lds + lane * 64 + 4 * i) = v; }
            }
            __syncthreads();
            const bf16* Qb = PROJ + (size_t)(b * SEQ) * 4096 + 1024 + h * 128;
            fox::BlockRef cur{Qb + (size_t)(a_qb * 256) * 4096, Qb + 1024, Qb + 2048, AMIX + (size_t)(b * SEQ + a_qb * 256) * DM + 1024 + h * 128, a_qb * 256};
            fox::Seam S;
            fox::prime(cur, (char*)lds, S);
            fox::block(cur, cur, (char*)lds, S);
            asm volatile("s_waitcnt vmcnt(0)" ::: "memory");
            __syncthreads();
        }
    }
    SEAM(2);

    if (IN(3)) {
        pg8::Gemm g{AMIX, WO2, DM, DM, DM}; pg8::GSched S; S.init(TOK / 256, DM / 256, G, bx, DM, DM);
        pg8::EpiResid E{x, H, HB, SS1};
        pg8::gemm_phase<pg8::EpiResid, pg8::GSched, true>(ldsL, g, S, E);
    }
    SEAM(3);

    if (IN(4)) {
        pg8::Gemm g{HB, WQ, DM, DM, DM}; pg8::GSched S; S.init(TOK / 256, DM / 256, G, bx, DM, DM);
        pg8::EpiStore E{QX, DM, 0, 0, 1, SS1, 0.044194173824159216f * LOG2E, 0, 0, 1.f};
        pg8::gemm_phase<pg8::EpiStore, pg8::GSched, true>(ldsL, g, S, E);
    }
    SEAM(4);

    if (IN(5)) {
        pg8::Gemm g{QX, KX, XD, DM, DM}; pg8::GSched S; S.init(SEQ / 256, 1, G, bx, DM, DM);
        S.nH = XH; S.nZ = BATCH * XH; S.sAb = (long)SEQ * DM; S.sAh = XD; S.sBb = (long)NMEM * DM; S.sBh = XD;
        pg8::EpiSoftmax E{PP, 1024, (long)SEQ * 1024, 256, XH};
        pg8::gemm_phase<pg8::EpiSoftmax, pg8::GSched, false>(ldsL, g, S, E);
    }
    SEAM(5);

    if (IN(6)) {
        pg8::Gemm g{PP, VXT, NMEM, 1024, 512}; pg8::GSched S; S.init(SEQ / 256, XD / 256, G, bx, 1024, 512);
        S.nH = XH; S.nZ = BATCH * XH; S.sAb = (long)SEQ * 1024; S.sAh = 256; S.sBb = NMEM; S.sBh = (long)XD * 512;
        pg8::EpiStore E{OX, DM, (long)SEQ * DM, XD, XH, nullptr, 1.f, 0, 0, 1.f};
        pg8::gemm_phase<pg8::EpiStore, pg8::GSched, true>(ldsL, g, S, E);
    }
    SEAM(6);

    if (IN(7)) {
        pg8::Gemm g{OX, WO, DM, DM, DM}; pg8::GSched S; S.init(TOK / 256, DM / 256, G, bx, DM, DM);
        pg8::EpiResid E{H, H, HB, SS2};
        pg8::gemm_phase<pg8::EpiResid, pg8::GSched, true>(ldsL, g, S, E);
    }
    SEAM(7);

    if (IN(8)) {
        pg8::Gemm g{WSC, HB, DM, DM, DM}; pg8::GSched S; S.init(DM / 256, TOK / 256, G, bx, DM, DM);
        pg8::EpiF32Col E{SCT, TOK, SS2};
        pg8::gemm_phase<pg8::EpiF32Col, pg8::GSched, true>(ldsL, g, S, E);
    }
    SEAM(8);

    if (IN(9)) {
        LAS unsigned* TOP1 = (LAS unsigned*)ldsL;
        LAS unsigned* RIDX = (LAS unsigned*)(ldsL + 32768);
        LAS float* RGATE = (LAS float*)(ldsL + 49152);
        for (int blk = vcu; blk < TOK / 32; blk += G) {
            const int t0 = blk * 32;
            {
                const int tok = tid & 31, grp = tid >> 5;
                const float* sp = SCT + (size_t)(grp * 128) * TOK + t0 + tok;
                unsigned lst[16];
#pragma unroll
                for (int j = 0; j < 16; ++j) lst[j] = 0u;
                for (int i0 = 0; i0 < 128; i0 += 8) {
                    float v[8];
#pragma unroll
                    for (int e = 0; e < 8; ++e) v[e] = sp[(size_t)(i0 + e) * TOK];
#pragma unroll
                    for (int e = 0; e < 8; ++e) { unsigned xk = (fkey(v[e]) & ~127u) | (unsigned)(127 - (i0 + e));
#pragma unroll
                        for (int j = 0; j < 16; ++j) { const unsigned hi_ = max(lst[j], xk); xk = min(lst[j], xk); lst[j] = hi_; } }
                }
                LAS unsigned* dst = TOP1 + (tok * 16 + grp) * 16;
#pragma unroll
                for (int j = 0; j < 16; j += 4) *(LAS v4u*)(dst + j) = (v4u){lst[j], lst[j + 1], lst[j + 2], lst[j + 3]};
            }
            __syncthreads();
            if (tid < 256) {
                const int tok = tid & 31, head = tid >> 5;
                const LAS unsigned* ka = TOP1 + (tok * 16 + head * 2) * 16; const LAS unsigned* kb = ka + 16;
                float af[16], bfv[16];
#pragma unroll
                for (int j = 0; j < 16; ++j) { af[j] = fdec(ka[j] & ~127u); bfv[j] = fdec(kb[j] & ~127u); }
                unsigned best[16];
#pragma unroll
                for (int j = 0; j < 16; ++j) best[j] = 0u;
#pragma unroll
                for (int i = 0; i < 16; ++i)
#pragma unroll
                    for (int j = 0; j < 16; ++j) if ((i + 1) * (j + 1) <= 16) {
                        unsigned xk = (fkey(af[i] + bfv[j]) & ~255u) | (unsigned)(255 - (i * 16 + j));
#pragma unroll
                        for (int q = 0; q < 16; ++q) { const unsigned hi_ = max(best[q], xk); xk = min(best[q], xk); best[q] = hi_; } }
                float ev[16]; const float m0 = fdec(best[0] & ~255u); float sum = 0.f;
#pragma unroll
                for (int q = 0; q < 16; ++q) { ev[q] = __expf(fdec(best[q] & ~255u) - m0); sum += ev[q]; }
                const float inv = 1.f / sum;
#pragma unroll
                for (int q = 0; q < 16; ++q) { const unsigned code = 255u - (best[q] & 255u); const unsigned i = code >> 4, j = code & 15u;
                    const unsigned ia = 127u - (ka[i] & 127u), ib = 127u - (kb[j] & 127u);
                    RIDX[tok * 128 + head * 16 + q] = ia * 128u + ib; RGATE[tok * 128 + head * 16 + q] = ev[q] * inv; }
            }
            __syncthreads();
            for (int tt = 0; tt < 4; ++tt) {
                const int tok = wave * 4 + tt; const size_t t = (size_t)(t0 + tok);
                const float rstd2 = __builtin_amdgcn_rsqf(SS2[t] * (1.f / DM) + EPS);
                float xn[2][16];
#pragma unroll
                for (int j = 0; j < 2; ++j)
#pragma unroll
                    for (int q = 0; q < 4; ++q) { const size_t d0 = (size_t)j * 1024 + lane * 16 + q * 4;
                        const f32x4 a = *(const f32x4*)(H + t * DM + d0), ga = *(const f32x4*)(peer_norm + d0);
#pragma unroll
                        for (int e = 0; e < 4; ++e) xn[j][q * 4 + e] = a[e] * rstd2 * ga[e]; }
                float oacc[2][16];
#pragma unroll
                for (int j = 0; j < 2; ++j)
#pragma unroll
                    for (int e = 0; e < 16; ++e) oacc[j][e] = 0.f;
                const LAS unsigned* ridx = RIDX + tok * 128; const LAS float* rgate = RGATE + tok * 128;
                PeerBuf bA, bB;
                peer_load(bA, UB, VB, SU, SV, ridx, rgate, 0, lane);
                for (int k = 0; k < 128; k += 4) {
                    peer_load(bB, UB, VB, SU, SV, ridx, rgate, k + 2, lane);
                    peer_comp(bA, xn, oacc);
                    if (k + 4 < 128) peer_load(bA, UB, VB, SU, SV, ridx, rgate, k + 4, lane);
                    peer_comp(bB, xn, oacc);
                }
                float s = 0.f;
#pragma unroll
                for (int j = 0; j < 2; ++j)
#pragma unroll
                    for (int q = 0; q < 4; ++q) { const size_t d0 = (size_t)j * 1024 + lane * 16 + q * 4; const f32x4 a = *(const f32x4*)(H + t * DM + d0);
#pragma unroll
                        for (int e = 0; e < 4; ++e) { const float y = a[e] + oacc[j][q * 4 + e]; oacc[j][q * 4 + e] = y; s += y * y; } }
                const float rstd = __builtin_amdgcn_rsqf(wave_sum(s) * (1.f / DM) + EPS);
#pragma unroll
                for (int j = 0; j < 2; ++j)
#pragma unroll
                    for (int q = 0; q < 4; ++q) { const size_t d0 = (size_t)j * 1024 + lane * 16 + q * 4; const f32x4 ga = *(const f32x4*)(final_norm + d0); f32x4 o;
#pragma unroll
                        for (int e = 0; e < 4; ++e) o[e] = oacc[j][q * 4 + e] * rstd * ga[e];
                        *(f32x4*)(args.out + t * DM + d0) = o; }
            }
            __syncthreads();
        }
    }
#undef IN
#undef SEAM
}

constexpr int N_PHASES = 10;
extern "C" void kernel_launch(void* const* d_in, const int* in_sizes, int n_in, void* d_out, int out_size, void* d_ws, size_t ws_size, hipStream_t stream) {
    static int grid = 0;
    if (grid == 0) {
        if (n_in != 20 || in_sizes[0] != TOK * DM || out_size != TOK * DM || ws_size < WS_END) {
            fprintf(stderr, "kernel_launch: unexpected shapes (n_in %d, in0 %d, out %d, ws %zu < %zu)\n", n_in, n_in > 0 ? in_sizes[0] : -1, out_size, ws_size, (size_t)WS_END); grid = -1; return; }
        int dev = 0, cus = 0, per_cu = 0;
        if (hipGetDevice(&dev) != hipSuccess || hipDeviceGetAttribute(&cus, hipDeviceAttributeMultiprocessorCount, dev) != hipSuccess) { grid = -1; return; }
        if (hipFuncSetAttribute((const void*)fwd_kernel, hipFuncAttributeMaxDynamicSharedMemorySize, LDS_BYTES) != hipSuccess) { fprintf(stderr, "kernel_launch: hipFuncSetAttribute failed\n"); grid = -1; return; }
        if (hipOccupancyMaxActiveBlocksPerMultiprocessor(&per_cu, (const void*)fwd_kernel, NTHREADS, LDS_BYTES) != hipSuccess || per_cu < 1) { fprintf(stderr, "kernel_launch: occupancy query says %d\n", per_cu); per_cu = 1; }
        (void)hipGetLastError();
        grid = cus;
        if (grid != 256) fprintf(stderr, "kernel_launch: %d CUs (built for 256)\n", grid);
    }
    if (grid < 0) return;
    (void)hipMemsetAsync((char*)d_ws + WS_CTL, 0, CTL_ZERO_BYTES, stream);
    Args a{};
    for (int i = 0; i < 20; ++i) a.in[i] = (const float*)d_in[i];
    a.out = (float*)d_out; a.ws = (unsigned char*)d_ws;
#if MK_ONE_LAUNCH
    a.ph_lo = 0; a.ph_hi = N_PHASES; a.one_launch = 1;
    void* kargs[] = {&a};
    hipError_t e = hipLaunchCooperativeKernel((const void*)fwd_kernel, dim3(grid), dim3(NTHREADS), kargs, LDS_BYTES, stream);
    if (e != hipSuccess) fprintf(stderr, "kernel_launch: cooperative launch failed: %s\n", hipGetErrorString(e));
#else
    for (int p = 0; p < N_PHASES; ++p) {
        a.ph_lo = p; a.ph_hi = p + 1; a.one_launch = 0;
        hipLaunchKernelGGL(fwd_kernel, dim3(grid), dim3(NTHREADS), LDS_BYTES, stream, a);
    }
#endif
}
```

```cpp
#include <hip/hip_runtime.h>
#include <hip/hip_bf16.h>
#include <cstdio>
#include <cstdint>

#ifndef DUP_MASK
#define DUP_MASK 0
#endif
#ifndef MK_ONE_LAUNCH
#define MK_ONE_LAUNCH 1
#endif

constexpr int BATCH = 2, SEQ = 4096, DM = 2048, TOK = BATCH * SEQ;
constexpr int INC = 4104, POOLW = 1024, FOXH = 8, FOXD = 128;
constexpr int NMEM = 256, XH = 4, XD = 512;
constexpr int PH = 8, PKEYS = 128, PEXP = 16384, TOPK = 16;
constexpr float EPS = 1e-6f;
constexpr float LOG2E = 1.4426950408889634f;

namespace pg8 {
#define PG8_LAS __attribute__((address_space(3)))
typedef unsigned short bf16_t;
typedef short bf16x8 __attribute__((ext_vector_type(8)));
typedef float f32x4 __attribute__((ext_vector_type(4)));
typedef float f32x2 __attribute__((ext_vector_type(2)));
typedef unsigned u32x4 __attribute__((ext_vector_type(4)));
typedef unsigned u32x2 __attribute__((ext_vector_type(2)));
constexpr int BM = 256, BK = 64, HALF = 128, HTB = HALF * BK * 2, STAGE_BYTES = 8 * HTB, NXCD = 8, WGM = 8;

__host__ __device__ __forceinline__ int lds_byte(int r, int c) { const int st = (r >> 4) * 2 + (c >> 5), rr = r & 15, cc = c & 31, ob = rr * 64 + cc * 2; return st * 1024 + (ob ^ (((ob >> 9) & 1) << 5)); }
__host__ __device__ __forceinline__ void stage_rc(int b, int& R, int& C) { const int st = b / 1024, sb = b % 1024, swz = sb ^ (((sb >> 9) & 1) << 5); R = (st >> 1) * 16 + swz / 64; C = (st & 1) * 32 + (swz % 64) / 2; }
__host__ __device__ __forceinline__ int perm32(int rho) { const int n = rho >> 4, i = rho & 15; return 8 * (i >> 2) + 4 * n + (i & 3); }

struct Unit { int pm, pn, z; long aoff, boff; };
struct Gemm { const bf16_t* A; const bf16_t* Bt; int K, lda, ldb; };

struct GSched {
    int nM, nN, nH, nZ, G, c; long sAb, sAh, sBb, sBh; int lda, ldb;
    __device__ __forceinline__ void init(int nM_, int nN_, int G_, int c_, int lda_, int ldb_) { nM = nM_; nN = nN_; nH = 1; nZ = 1; G = G_; c = c_; sAb = sAh = sBb = sBh = 0; lda = lda_; ldb = ldb_; }
    __device__ __forceinline__ bool next(int i, Unit& u) const {
        const long L = (long)i * G + c; const int nwg = nM * nN; if (L >= (long)nwg * nZ) return false;
        const int z = (int)(L / nwg); int wgid = (int)(L % nwg);
        { const int q = nwg / NXCD, r = nwg % NXCD, xcd = wgid % NXCD, off = wgid / NXCD; wgid = (xcd < r ? xcd * (q + 1) : r * (q + 1) + (xcd - r) * q) + off; }
        const int nig = WGM * nN, gid = wgid / nig, fm = gid * WGM, gsz = (nM - fm) < WGM ? (nM - fm) : WGM;
        u.pm = fm + ((wgid % nig) % gsz); u.pn = (wgid % nig) / gsz; u.z = z;
        const int zb = z / nH, zh = z % nH;
        u.aoff = zb * sAb + zh * sAh + (long)u.pm * BM * lda; u.boff = zb * sBb + zh * sBh + (long)u.pn * BM * ldb;
        return true;
    }
    __device__ __forceinline__ void a_ready(const Unit&) const {}
    __device__ __forceinline__ void done(const Unit&) const {}
};

__device__ __forceinline__ unsigned cvt_pk_bf16(float lo, float hi) { unsigned r; asm volatile("v_cvt_pk_bf16_f32 %0, %1, %2" : "=v"(r) : "v"(lo), "v"(hi)); return r; }


struct EpiStore {
    static constexpr bool PERM = true, AFTER_DRAIN = false;
    bf16_t* O; int ldc; long sCb, sCh; int nH;
    const float* ss; float rs_mul;
    int t0, t1; float tscale;
    __device__ __forceinline__ void operator()(const f32x4 (&acc)[2][2][4][2], const Unit& u, int wr, int wc, int fr, int fq) const {
        const int row0 = u.pm * BM + wr * 64 + fr, col0 = u.pn * BM + wc * 32 + 8 * fq;
        bf16_t* base = O + (u.z / nH) * sCb + (u.z % nH) * sCh;
        const float ts = (u.pn >= t0 && u.pn < t1) ? tscale : 1.f;
#pragma unroll
        for (int ai = 0; ai < 2; ++ai)
#pragma unroll
            for (int m = 0; m < 4; ++m) { const int row = row0 + ai * HALF + m * 16;
                float sc = ts; if (ss) sc *= __builtin_amdgcn_rsqf(ss[row] * (1.f / DM) + EPS) * rs_mul;
                bf16_t* rowp = base + (size_t)row * ldc + col0;
#pragma unroll
                for (int bj = 0; bj < 2; ++bj) { const f32x4 v0 = acc[ai][bj][m][0] * sc, v1 = acc[ai][bj][m][1] * sc;
                    u32x4 w; w.x = cvt_pk_bf16(v0[0], v0[1]); w.y = cvt_pk_bf16(v0[2], v0[3]); w.z = cvt_pk_bf16(v1[0], v1[1]); w.w = cvt_pk_bf16(v1[2], v1[3]);
                    *(u32x4*)(rowp + bj * HALF) = w; } }
    }
};
struct EpiResid {
    static constexpr bool PERM = true, AFTER_DRAIN = false;
    const float* base; float* H; bf16_t* HB; float* ss;
    __device__ __forceinline__ void operator()(const f32x4 (&acc)[2][2][4][2], const Unit& u, int wr, int wc, int fr, int fq) const {
        const int row0 = u.pm * BM + wr * 64 + fr, col0 = u.pn * BM + wc * 32 + 8 * fq;
#pragma unroll
        for (int ai = 0; ai < 2; ++ai)
#pragma unroll
            for (int m = 0; m < 4; ++m) { const int row = row0 + ai * HALF + m * 16; const size_t off = (size_t)row * DM + col0; float sq = 0.f;
#pragma unroll
                for (int bj = 0; bj < 2; ++bj) {
                    const f32x4 b0 = *(const f32x4*)(base + off + bj * HALF), b1 = *(const f32x4*)(base + off + bj * HALF + 4);
                    const f32x4 h0 = b0 + acc[ai][bj][m][0], h1 = b1 + acc[ai][bj][m][1];
                    *(f32x4*)(H + off + bj * HALF) = h0; *(f32x4*)(H + off + bj * HALF + 4) = h1;
                    u32x4 w; w.x = cvt_pk_bf16(h0[0], h0[1]); w.y = cvt_pk_bf16(h0[2], h0[3]); w.z = cvt_pk_bf16(h1[0], h1[1]); w.w = cvt_pk_bf16(h1[2], h1[3]);
                    *(u32x4*)(HB + off + bj * HALF) = w;
                    sq += (h0[0] * h0[0] + h0[1] * h0[1]) + (h0[2] * h0[2] + h0[3] * h0[3]) + (h1[0] * h1[0] + h1[1] * h1[1]) + (h1[2] * h1[2] + h1[3] * h1[3]); }
                sq += __shfl_xor(sq, 16); sq += __shfl_xor(sq, 32);
                if (fq == 0) atomicAdd(ss + row, sq); }
    }
};
struct EpiF32Col {
    static constexpr bool PERM = true, AFTER_DRAIN = false;
    float* O; int ldc; const float* ss;
    __device__ __forceinline__ void operator()(const f32x4 (&acc)[2][2][4][2], const Unit& u, int wr, int wc, int fr, int fq) const {
        const int row0 = u.pm * BM + wr * 64 + fr, col0 = u.pn * BM + wc * 32 + 8 * fq;
        f32x4 rs[2][2];
#pragma unroll
        for (int bj = 0; bj < 2; ++bj)
#pragma unroll
            for (int n = 0; n < 2; ++n) { const f32x4 s = *(const f32x4*)(ss + col0 + bj * HALF + 4 * n);
#pragma unroll
                for (int e = 0; e < 4; ++e) rs[bj][n][e] = __builtin_amdgcn_rsqf(s[e] * (1.f / DM) + EPS); }
#pragma unroll
        for (int ai = 0; ai < 2; ++ai)
#pragma unroll
            for (int m = 0; m < 4; ++m) { float* rowp = O + (size_t)(row0 + ai * HALF + m * 16) * ldc + col0;
#pragma unroll
                for (int bj = 0; bj < 2; ++bj) { *(f32x4*)(rowp + bj * HALF) = acc[ai][bj][m][0] * rs[bj][0]; *(f32x4*)(rowp + bj * HALF + 4) = acc[ai][bj][m][1] * rs[bj][1]; } }
    }
};
struct EpiSoftmax {
    static constexpr bool PERM = true, AFTER_DRAIN = true;
    bf16_t* P; int ldc; long sCb, sCh; int nH;
    __device__ __forceinline__ void fused(f32x4 (&acc)[2][2][4][2], const Unit& u, int wr, int wc, int fr, int fq, PG8_LAS unsigned char* lds, int wid, int lane) const {
        PG8_LAS float* Pm = (PG8_LAS float*)lds;
        PG8_LAS float* Ps = (PG8_LAS float*)(lds + 4096);
#pragma unroll
        for (int ai = 0; ai < 2; ++ai)
#pragma unroll
            for (int m = 0; m < 4; ++m) { float mx = -3.0e38f;
#pragma unroll
                for (int bj = 0; bj < 2; ++bj)
#pragma unroll
                    for (int n = 0; n < 2; ++n) { const f32x4 x = acc[ai][bj][m][n]; mx = fmaxf(mx, fmaxf(fmaxf(x[0], x[1]), fmaxf(x[2], x[3]))); }
                mx = fmaxf(mx, __shfl_xor(mx, 16)); mx = fmaxf(mx, __shfl_xor(mx, 32));
                if (fq == 0) Pm[(ai * HALF + wr * 64 + m * 16 + fr) * 4 + wc] = mx; }
        asm volatile("s_waitcnt lgkmcnt(0)" ::: "memory"); __builtin_amdgcn_s_barrier(); asm volatile("" ::: "memory");
#pragma unroll
        for (int ai = 0; ai < 2; ++ai)
#pragma unroll
            for (int m = 0; m < 4; ++m) { const int r = ai * HALF + wr * 64 + m * 16 + fr;
                const f32x4 pm4 = *(const PG8_LAS f32x4*)(Pm + r * 4); const float M = fmaxf(fmaxf(pm4[0], pm4[1]), fmaxf(pm4[2], pm4[3])); float s = 0.f;
#pragma unroll
                for (int bj = 0; bj < 2; ++bj)
#pragma unroll
                    for (int n = 0; n < 2; ++n) { f32x4 x = acc[ai][bj][m][n];
#pragma unroll
                        for (int e = 0; e < 4; ++e) { x[e] = __builtin_amdgcn_exp2f(x[e] - M); s += x[e]; }
                        acc[ai][bj][m][n] = x; }
                s += __shfl_xor(s, 16); s += __shfl_xor(s, 32);
                if (fq == 0) Ps[r * 4 + wc] = s; }
        asm volatile("s_waitcnt lgkmcnt(0)" ::: "memory"); __builtin_amdgcn_s_barrier(); asm volatile("" ::: "memory");
        bf16_t* base = P + (u.z / nH) * sCb + (u.z % nH) * sCh;
        const int row0 = u.pm * BM, col0 = u.pn * BM + wc * 32 + 8 * fq;
#pragma unroll
        for (int ai = 0; ai < 2; ++ai)
#pragma unroll
            for (int m = 0; m < 4; ++m) { const int r = ai * HALF + wr * 64 + m * 16 + fr;
                const f32x4 ps4 = *(const PG8_LAS f32x4*)(Ps + r * 4); const float inv = 1.f / ((ps4[0] + ps4[1]) + (ps4[2] + ps4[3]));
                bf16_t* rowp = base + (size_t)(row0 + r) * ldc + col0;
#pragma unroll
                for (int bj = 0; bj < 2; ++bj) { const f32x4 v0 = acc[ai][bj][m][0] * inv, v1 = acc[ai][bj][m][1] * inv;
                    u32x4 w; w.x = cvt_pk_bf16(v0[0], v0[1]); w.y = cvt_pk_bf16(v0[2], v0[3]); w.z = cvt_pk_bf16(v1[0], v1[1]); w.w = cvt_pk_bf16(v1[2], v1[3]);
                    *(u32x4*)(rowp + bj * HALF) = w; } }
    }
};

template <class Epi, class Sched, bool ALIGN_EPI>
__device__ __forceinline__ void gemm_phase(PG8_LAS unsigned char* lds, const Gemm g, const Sched& S, const Epi& E) {
    const int tid = threadIdx.x, wid = __builtin_amdgcn_readfirstlane(tid >> 6), lane = tid & 63, wr = wid >> 2, wc = wid & 3, fr = lane & 15, fq = lane >> 4;
    const int K = g.K, nt = K / BK;
    unsigned voffA[2], voffB[2];
#pragma unroll
    for (int i = 0; i < 2; ++i) { int R, C; stage_rc(tid * 16 + i * 8192, R, C); const int Rb = Epi::PERM ? ((R & ~31) + perm32(R & 31)) : R;
        voffA[i] = (unsigned)(R * g.lda + C) * 2u; voffB[i] = (unsigned)(Rb * g.ldb + C) * 2u; }
    const size_t kstep = (size_t)(BK * 2);
    const size_t hsA = (size_t)HALF * g.lda * 2, hsB = (size_t)HALF * g.ldb * 2;
    const unsigned ldsw = (unsigned)wid * 1024u;
    const int aoff = lds_byte(wr * 64 + fr, fq * 8), boff = lds_byte(wc * 32 + fr, fq * 8);
#define PG8_SA(b, h) (((b) * 2 + (h)) * HTB)
#define PG8_SB(b, h) ((4 + (b) * 2 + (h)) * HTB)
#define PG8_STAGE(bufoff, gbase, voff) do { _Pragma("unroll") for (int _i = 0; _i < 2; ++_i) \
        __builtin_amdgcn_global_load_lds((const unsigned*)((const char*)(gbase) + (voff)[_i]), (PG8_LAS unsigned*)(lds + (bufoff) + ldsw + _i * 8192), 16, 0, 0); } while (0)
#define PG8_LDA(dst, b, h) do { _Pragma("unroll") for (int m = 0; m < 4; ++m) _Pragma("unroll") for (int k = 0; k < 2; ++k) dst[m][k] = *(const PG8_LAS bf16x8*)(lds + PG8_SA(b, h) + aoff + m * 2048 + k * 1024); } while (0)
#define PG8_LDB(dst, b, h) do { _Pragma("unroll") for (int n = 0; n < 2; ++n) _Pragma("unroll") for (int k = 0; k < 2; ++k) dst[n][k] = *(const PG8_LAS bf16x8*)(lds + PG8_SB(b, h) + boff + n * 2048 + k * 1024); } while (0)
#define PG8_MMA(ai, bj, At, Bt) do { __builtin_amdgcn_s_setprio(1); _Pragma("unroll") for (int m = 0; m < 4; ++m) _Pragma("unroll") for (int n = 0; n < 2; ++n) _Pragma("unroll") for (int k = 0; k < 2; ++k) \
        acc[ai][bj][m][n] = __builtin_amdgcn_mfma_f32_16x16x32_bf16(Bt[n][k], At[m][k], acc[ai][bj][m][n], 0, 0, 0); __builtin_amdgcn_s_setprio(0); } while (0)
#define PG8_WAIT_V(n) asm volatile("s_waitcnt vmcnt(" #n ")" ::: "memory")
#define PG8_WAIT_L(n) asm volatile("s_waitcnt lgkmcnt(" #n ")" ::: "memory")
#define PG8_BAR __builtin_amdgcn_s_barrier()
#define PG8_SCHED __builtin_amdgcn_sched_barrier(0)
    Unit cur, nxt; int ui = 0;
    if (!S.next(0, cur)) return;
    f32x4 acc[2][2][4][2];
#pragma unroll
    for (int a = 0; a < 2; ++a)
#pragma unroll
        for (int b = 0; b < 2; ++b)
#pragma unroll
            for (int m = 0; m < 4; ++m)
#pragma unroll
                for (int n = 0; n < 2; ++n) acc[a][b][m][n] = (f32x4){0.f, 0.f, 0.f, 0.f};
    bf16x8 At[4][2], B0[2][2], B1[2][2];
    const char* cA = (const char*)g.A + (size_t)cur.aoff * 2; const char* cB = (const char*)g.Bt + (size_t)cur.boff * 2;
    S.a_ready(cur);
    PG8_STAGE(PG8_SB(0, 0), cB, voffB); PG8_STAGE(PG8_SB(0, 1), cB + hsB, voffB); PG8_STAGE(PG8_SA(0, 0), cA, voffA); PG8_STAGE(PG8_SA(0, 1), cA + hsA, voffA);
    if (wr == 1) PG8_BAR;
    PG8_WAIT_V(2); PG8_BAR;
    PG8_STAGE(PG8_SB(1, 0), cB + kstep, voffB); PG8_STAGE(PG8_SA(1, 0), cA + kstep, voffA); PG8_STAGE(PG8_SB(1, 1), cB + hsB + kstep, voffB);
    PG8_WAIT_V(6); PG8_BAR;
    for (;;) {
        const bool has_next = S.next(ui + 1, nxt);
        const char* nA = has_next ? (const char*)g.A + (size_t)nxt.aoff * 2 : cA; const char* nB = has_next ? (const char*)g.Bt + (size_t)nxt.boff * 2 : cB;
        for (int t = 0; t < nt; t += 2) {
            const bool last = (t == nt - 2);
            const char* a1 = cA + (size_t)(t + 1) * kstep;
            const char* a2 = last ? nA : cA + (size_t)(t + 2) * kstep; const char* b2 = last ? nB : cB + (size_t)(t + 2) * kstep;
            const char* a3 = a2 + kstep; const char* b3 = b2 + kstep;
            if (last && has_next) S.a_ready(nxt);
            PG8_LDB(B0, 0, 0); PG8_LDB(B1, 0, 1); PG8_SCHED; PG8_LDA(At, 0, 0); PG8_STAGE(PG8_SA(1, 1), a1 + hsA, voffA);
            PG8_WAIT_V(8); PG8_WAIT_L(0); PG8_BAR; PG8_MMA(0, 0, At, B0); PG8_MMA(0, 1, At, B1); PG8_BAR; PG8_SCHED;
            PG8_LDA(At, 0, 1); PG8_STAGE(PG8_SB(0, 0), b2, voffB); PG8_STAGE(PG8_SB(0, 1), b2 + hsB, voffB); PG8_STAGE(PG8_SA(0, 0), a2, voffA);
            PG8_WAIT_V(8); PG8_WAIT_L(0); PG8_BAR; PG8_MMA(1, 0, At, B0); PG8_MMA(1, 1, At, B1); PG8_BAR; PG8_SCHED;
            PG8_LDB(B0, 1, 0); PG8_LDB(B1, 1, 1); PG8_SCHED; PG8_LDA(At, 1, 0); PG8_STAGE(PG8_SA(0, 1), a2 + hsA, voffA);
            PG8_WAIT_V(8); PG8_WAIT_L(0); PG8_BAR; PG8_MMA(0, 0, At, B0); PG8_MMA(0, 1, At, B1); PG8_BAR; PG8_SCHED;
            PG8_LDA(At, 1, 1); PG8_STAGE(PG8_SB(1, 0), b3, voffB); PG8_STAGE(PG8_SB(1, 1), b3 + hsB, voffB); PG8_STAGE(PG8_SA(1, 0), a3, voffA);
            PG8_WAIT_V(8); PG8_WAIT_L(0); PG8_BAR; PG8_MMA(1, 0, At, B0); PG8_MMA(1, 1, At, B1); PG8_BAR; PG8_SCHED;
        }
        if constexpr (ALIGN_EPI) { if (wr == 0) PG8_BAR; }
        if constexpr (!Epi::AFTER_DRAIN) { E(acc, cur, wr, wc, fr, fq); S.done(cur); }
        if (!has_next) break;
#pragma unroll
        for (int a = 0; a < 2; ++a)
#pragma unroll
            for (int b = 0; b < 2; ++b)
#pragma unroll
                for (int m = 0; m < 4; ++m)
#pragma unroll
                    for (int n = 0; n < 2; ++n) acc[a][b][m][n] = (f32x4){0.f, 0.f, 0.f, 0.f};
        cur = nxt; cA = nA; cB = nB; ++ui;
        if constexpr (ALIGN_EPI) { if (wr == 1) PG8_BAR; }
    }
    PG8_WAIT_V(0);
    if constexpr (!ALIGN_EPI) { if (wr == 0) PG8_BAR; }
    PG8_BAR;
    if constexpr (Epi::AFTER_DRAIN) { E.fused(acc, cur, wr, wc, fr, fq, lds, wid, lane); S.done(cur); }
#undef PG8_SA
#undef PG8_SB
#undef PG8_STAGE
#undef PG8_LDA
#undef PG8_LDB
#undef PG8_MMA
#undef PG8_WAIT_V
#undef PG8_WAIT_L
#undef PG8_BAR
#undef PG8_SCHED
}
}

namespace fox {
typedef unsigned short bf16_t;
typedef short bf16x8 __attribute__((ext_vector_type(8)));
typedef short s16x4 __attribute__((ext_vector_type(4)));
typedef float f32x16 __attribute__((ext_vector_type(16)));
typedef float f32x4 __attribute__((ext_vector_type(4)));
typedef unsigned u32x4 __attribute__((ext_vector_type(4)));
constexpr int D = 128, NW = 8, QBLK = 32, KVBLK = 64, QB = NW * QBLK;
constexpr int SHM_V = KVBLK * D * 2, SHM_K = KVBLK * D * 2;
constexpr int LDS_C = 2 * SHM_V + 2 * SHM_K + NW * 64 * 4;
constexpr int LDS_BYTES = LDS_C + SEQ * 4;
constexpr int QP = 4096, OP = 2048;
constexpr float THR = 24.f;
#define KSWZ(row, colB) ((row) * 256 + ((colB) ^ (((row) & 7) << 4)))
#define SBAR() __builtin_amdgcn_sched_barrier(0)
__device__ __forceinline__ int v_st(int k, int c) { const int kk = (k & ~0xC) | ((k & 4) << 1) | ((k & 8) >> 1); return ((kk >> 3) * 4 + (c >> 5)) * 512 + ((kk & 7) * 32 + (c & 31)) * 2; }
__device__ __forceinline__ int v_rd_base(int lane) { return ((lane & 3) << 3) | (((lane >> 2) & 3) << 6) | (((lane >> 4) & 1) << 5) | (((lane >> 5) & 1) << 8); }
constexpr int v_rd_off(int d0, int ks, int half) { return d0 * 512 + ks * 4096 + half * 2048; }
__device__ __forceinline__ int crow(int r, int hi) { return (r & 3) + 8 * (r >> 2) + 4 * hi; }
__device__ __forceinline__ unsigned cvtpk(float lo, float hi) { unsigned r; asm volatile("v_cvt_pk_bf16_f32 %0, %1, %2" : "=v"(r) : "v"(lo), "v"(hi)); return r; }
__device__ __forceinline__ bf16x8 load8(const bf16_t* p) { return *reinterpret_cast<const bf16x8*>(p); }
__device__ __forceinline__ void mask_tile(f32x16& p0, f32x16& p1, int dq) {
    const float NEG = -__builtin_inff();
#pragma unroll
    for (int r = 0; r < 16; ++r) { const int c = (r & 3) + 8 * (r >> 2); if (dq - c < 0) p0[r] = NEG; if (dq - c - 32 < 0) p1[r] = NEG; }
}
__device__ __forceinline__ void bias_tile(f32x16& p0, f32x16& p1, const float* cb) {
#pragma unroll
    for (int i = 0; i < 4; ++i) { const f32x4 c0 = *(const f32x4*)(cb + 8 * i), c1 = *(const f32x4*)(cb + 32 + 8 * i);
#pragma unroll
        for (int j = 0; j < 4; ++j) { p0[4 * i + j] -= c0[j]; p1[4 * i + j] -= c1[j]; } }
}
__device__ __forceinline__ void partialSM(f32x16& p0, f32x16& p1, float& m_reg, float& mn, float& alpha) {
    float pmax = p0[0]; for (int r = 1; r < 16; ++r) pmax = fmaxf(pmax, p0[r]); for (int r = 0; r < 16; ++r) pmax = fmaxf(pmax, p1[r]);
    { auto rr = __builtin_amdgcn_permlane32_swap(__float_as_uint(pmax), __float_as_uint(pmax), false, false);
      pmax = fmaxf(__uint_as_float(rr[0]), __uint_as_float(rr[1])); }
    if (__builtin_expect(__all((pmax - m_reg) <= THR), 1)) { mn = m_reg; alpha = 1.f; }
    else { mn = fmaxf(m_reg, pmax); alpha = __builtin_amdgcn_exp2f(m_reg - mn); m_reg = mn; }
    for (int r = 0; r < 16; ++r) p0[r] = p0[r] - mn; for (int r = 0; r < 16; ++r) p1[r] = p1[r] - mn;
    for (int r = 0; r < 16; ++r) p0[r] = __builtin_amdgcn_exp2f(p0[r]);
}
__device__ __forceinline__ void finishSM(f32x16& p0, f32x16& p1, float alpha, float& l_reg, bf16x8& pa0, bf16x8& pa1, bf16x8& pa2, bf16x8& pa3) {
    for (int r = 0; r < 16; ++r) p1[r] = __builtin_amdgcn_exp2f(p1[r]);
    float ps = 0; for (int r = 0; r < 16; ++r) ps += p0[r]; for (int r = 0; r < 16; ++r) ps += p1[r];
    { auto rr = __builtin_amdgcn_permlane32_swap(__float_as_uint(ps), __float_as_uint(ps), false, false);
      ps = __uint_as_float(rr[0]) + __uint_as_float(rr[1]); }
    l_reg = l_reg * alpha + ps;
#define PK4(P, B_, OUT) do { unsigned a0 = cvtpk(P[B_+0], P[B_+1]), a1 = cvtpk(P[B_+2], P[B_+3]);                          \
        unsigned b0 = cvtpk(P[B_+4], P[B_+5]), b1 = cvtpk(P[B_+6], P[B_+7]);                                             \
        auto r0 = __builtin_amdgcn_permlane32_swap(a0, b0, false, false); auto r1 = __builtin_amdgcn_permlane32_swap(a1, b1, false, false); \
        u32x4 w = {r0[0], r1[0], r0[1], r1[1]}; OUT = *reinterpret_cast<bf16x8*>(&w); } while (0)
    PK4(p0, 0, pa0); PK4(p0, 8, pa1); PK4(p1, 0, pa2); PK4(p1, 8, pa3);
#undef PK4
}
template <int KB>
__device__ __forceinline__ void qkt(f32x16& p0, f32x16& p1, const char* K_lds, int r32, int hi, const bf16x8* qr) {
    p0 = f32x16{}; p1 = f32x16{};
    const char* kb[4];
#pragma unroll
    for (int dd = 0; dd < 4; ++dd) kb[dd] = K_lds + KB * SHM_K + KSWZ(r32, (dd * 16 + hi * 8) * 2);
#pragma unroll
    for (int d0 = 0; d0 < 8; ++d0) { const char* a = kb[d0 & 3] + (d0 >> 2) * 128;
        bf16x8 b0 = *reinterpret_cast<const bf16x8*>(a);
        bf16x8 b1 = *reinterpret_cast<const bf16x8*>(a + 32 * 256);
        p0 = __builtin_amdgcn_mfma_f32_32x32x16_bf16(b0, qr[d0], p0, 0, 0, 0);
        p1 = __builtin_amdgcn_mfma_f32_32x32x16_bf16(b1, qr[d0], p1, 0, 0, 0); }
}
template <int VB>
__device__ __forceinline__ void pv_tile(f32x16* o, int vb0, bf16x8 pa0, bf16x8 pa1, bf16x8 pa2, bf16x8 pa3) {
#define TRRD(dst, off) asm volatile("ds_read_b64_tr_b16 %0, %1 offset:%2" : "=&v"(dst) : "v"(vb0), "i"(off) : "memory")
#define PV_D0(d0) do { s16x4 l0, l1, l2, l3, h0, h1, h2, h3; constexpr int b_ = VB * SHM_V + v_rd_off(d0, 0, 0); \
        TRRD(l0, b_); TRRD(h0, b_ + 2048); TRRD(l1, b_ + 4096); TRRD(h1, b_ + 6144); TRRD(l2, b_ + 8192); TRRD(h2, b_ + 10240); TRRD(l3, b_ + 12288); TRRD(h3, b_ + 14336); \
        asm volatile("s_waitcnt lgkmcnt(0)" ::: "memory"); SBAR();   \
        o[d0] = __builtin_amdgcn_mfma_f32_32x32x16_bf16(pa0, (bf16x8){l0[0], l0[1], l0[2], l0[3], h0[0], h0[1], h0[2], h0[3]}, o[d0], 0, 0, 0);   \
        o[d0] = __builtin_amdgcn_mfma_f32_32x32x16_bf16(pa1, (bf16x8){l1[0], l1[1], l1[2], l1[3], h1[0], h1[1], h1[2], h1[3]}, o[d0], 0, 0, 0);   \
        o[d0] = __builtin_amdgcn_mfma_f32_32x32x16_bf16(pa2, (bf16x8){l2[0], l2[1], l2[2], l2[3], h2[0], h2[1], h2[2], h2[3]}, o[d0], 0, 0, 0);   \
        o[d0] = __builtin_amdgcn_mfma_f32_32x32x16_bf16(pa3, (bf16x8){l3[0], l3[1], l3[2], l3[3], h3[0], h3[1], h3[2], h3[3]}, o[d0], 0, 0, 0); } while (0)
    PV_D0(0); PV_D0(1); PV_D0(2); PV_D0(3);
#undef PV_D0
#undef TRRD
}
struct BlockRef { const bf16_t* Q; const bf16_t* K; const bf16_t* V; bf16_t* O; int P0; };
struct Seam { bf16x8 qr[8]; bf16x8 st_v0, st_v1, st_k0, st_k1; };
#define ROW(p, k0, rr) ((p) + (size_t)((k0) + (rr)) * QP + sc)
#define VMW() asm volatile("s_waitcnt vmcnt(0)" ::: "memory")
#define VMWN(n) asm volatile("s_waitcnt vmcnt(%0)" :: "i"(n) : "memory")
#define SLOAD_H(Kp, Vp, k0) do { S.st_v0 = load8(ROW(Vp, k0, sr)); S.st_v1 = load8(ROW(Vp, k0, 32 + sr)); S.st_k0 = load8(ROW(Kp, k0, sr)); S.st_k1 = load8(ROW(Kp, k0, 32 + sr)); } while (0)
#define SWRITE_HK(bf) do { *(bf16x8*)(K_lds + (bf) * SHM_K + kws) = S.st_k0; *(bf16x8*)(K_lds + (bf) * SHM_K + kws + 32 * 256) = S.st_k1; } while (0)
#define SWRITE_HV(bf) do { *(bf16x8*)(V_lds + (bf) * SHM_V + vst0) = S.st_v0; *(bf16x8*)(V_lds + (bf) * SHM_V + vst1) = S.st_v1; } while (0)
#define SWRITE_H(bf) do { SWRITE_HV(bf); SWRITE_HK(bf); } while (0)
__device__ __forceinline__ void prime(const BlockRef& cur, char* lds, Seam& S) {
    const int tid = threadIdx.x, wid = __builtin_amdgcn_readfirstlane(tid >> 6), lane = tid & 63, r32 = lane & 31, hi = lane >> 5;
    const int sr = tid >> 4, sc = (tid & 15) * 8, kws = KSWZ(sr, sc * 2); char* K_lds = lds + 2 * SHM_V;
    for (int d0 = 0; d0 < 8; ++d0) S.qr[d0] = load8(cur.Q + (size_t)(wid * QBLK + r32) * QP + d0 * 16 + hi * 8);
    SLOAD_H(cur.K, cur.V, 0); VMW(); SWRITE_HK(0);
    __syncthreads();
}
__device__ __forceinline__ void block(const BlockRef& cur, const BlockRef& nxt, char* lds, Seam& S) {
    const int tid = threadIdx.x, wid = __builtin_amdgcn_readfirstlane(tid >> 6), lane = tid & 63, r32 = lane & 31, hi = lane >> 5;
    const int NT = (cur.P0 + QB - 1) / KVBLK + 1;
    const int qlo = cur.P0 + wid * QBLK, qm = qlo + r32 - 4 * hi;
    char* V_lds = lds; char* K_lds = lds + 2 * SHM_V;
    float* ws = (float*)(lds + 2 * SHM_V + 2 * SHM_K) + wid * 64; float* li_l = ws, * al_l = ws + 32;
    const float* c_lds = (const float*)(lds + LDS_C) + 4 * hi;
    float m_reg = -1e30f, l_reg = 0; f32x16 o[4] = {};
    const int sr = tid >> 4, sc = (tid & 15) * 8, vst0 = v_st(sr, sc), vst1 = v_st(32 + sr, sc), kws = KSWZ(sr, sc * 2);
    const int vb0 = (int)(uintptr_t)V_lds + v_rd_base(lane);
    const bf16_t* Kh = cur.K; const bf16_t* Vh = cur.V;
#define RESC(a) do { if (__any((a) < 1.f)) { if (hi == 0) al_l[r32] = (a); asm volatile("s_waitcnt lgkmcnt(0)" ::: "memory");              \
                     for (int d_ = 0; d_ < 4; ++d_) for (int r = 0; r < 16; ++r) o[d_][r] *= al_l[crow(r, hi)]; } } while (0)
#define KBASE(t) ((t) * KVBLK)
#define MASKT(P0_, P1_, t) do { const int kb_ = KBASE(t); bias_tile(P0_, P1_, c_lds + kb_); if (kb_ + KVBLK - 1 > qlo) mask_tile(P0_, P1_, qm - kb_); } while (0)
#define SEAM_K0() do { VMWN(8); SWRITE_HK(0); SBAR(); } while (0)
    f32x16 pA0, pA1, pB0, pB1; float mnA, mnB, alA, alB; bf16x8 pa0, pa1, pa2, pa3;
    SWRITE_HV(0); SBAR();
    if (NT > 1) { SLOAD_H(Kh, Vh, KBASE(1)); }
    SBAR(); qkt<0>(pA0, pA1, K_lds, r32, hi, S.qr);
    MASKT(pA0, pA1, 0); partialSM(pA0, pA1, m_reg, mnA, alA);
    if (NT > 1) { VMW(); SWRITE_H(1); }
    __syncthreads();
#define HALF_STEP(PX0, PX1, mnX, alX, PY0, PY1, alY, t, KB, VB, SB) do {                                                      \
        SBAR(); qkt<KB>(PX0, PX1, K_lds, r32, hi, S.qr);                                                                     \
        finishSM(PY0, PY1, alY, l_reg, pa0, pa1, pa2, pa3); SBAR();                                                           \
        if ((t) + 1 < NT) { SLOAD_H(Kh, Vh, KBASE((t) + 1)); SBAR(); }                                                        \
        pv_tile<VB>(o, vb0, pa0, pa1, pa2, pa3); MASKT(PX0, PX1, (t)); partialSM(PX0, PX1, m_reg, mnX, alX);                 \
        __syncthreads();                                                                                                      \
        if ((t) + 1 < NT) { VMW(); SWRITE_H(SB); }                                                                            \
        RESC(alX); __syncthreads(); } while (0)
    for (int t = 1; t + 1 < NT; t += 2) {
        HALF_STEP(pB0, pB1, mnB, alB, pA0, pA1, alA, t, 1, 0, 0);
        HALF_STEP(pA0, pA1, mnA, alA, pB0, pB1, alB, t + 1, 0, 1, 1);
    }
    const bool even = (NT & 1) == 0;
    if (even) { SBAR(); qkt<1>(pB0, pB1, K_lds, r32, hi, S.qr); SBAR(); }
    SLOAD_H(nxt.K, nxt.V, 0); SBAR();
#pragma unroll
    for (int d0 = 0; d0 < 8; ++d0) S.qr[d0] = load8(nxt.Q + (size_t)(wid * QBLK + r32) * QP + d0 * 16 + hi * 8);
    SBAR();
    finishSM(pA0, pA1, alA, l_reg, pa0, pa1, pa2, pa3); SBAR();
    pv_tile<0>(o, vb0, pa0, pa1, pa2, pa3);
    if (even) { MASKT(pB0, pB1, NT - 1); partialSM(pB0, pB1, m_reg, mnB, alB); __syncthreads(); RESC(alB);
        finishSM(pB0, pB1, alB, l_reg, pa0, pa1, pa2, pa3); SBAR(); pv_tile<1>(o, vb0, pa0, pa1, pa2, pa3); }
    SBAR(); SEAM_K0();
    if (hi == 0) li_l[r32] = l_reg; asm volatile("s_waitcnt lgkmcnt(0)" ::: "memory");
    float rli[16];
#pragma unroll
    for (int r = 0; r < 16; ++r) rli[r] = __builtin_amdgcn_rcpf(li_l[crow(r, hi)]);
    bf16_t* Ow = cur.O + (size_t)(wid * QBLK) * OP;
#pragma unroll
    for (int r = 0; r < 16; ++r) { const int orow = crow(r, hi);
#pragma unroll
        for (int d0 = 0; d0 < 4; ++d0) { const float v = o[d0][r] * rli[r];
            const float vn = __shfl_xor(v, 1);
            if ((r32 & 1) == 0) *(unsigned*)(Ow + (size_t)orow * OP + d0 * 32 + r32) = cvtpk(v, vn); } }
    __syncthreads();
#undef RESC
#undef KBASE
#undef MASKT
#undef SEAM_K0
#undef HALF_STEP
}
#undef ROW
#undef VMW
#undef VMWN
#undef SLOAD_H
#undef SWRITE_HK
#undef SWRITE_HV
#undef SWRITE_H
#undef KSWZ
#undef SBAR
}

constexpr int NWAVES = 8, NTHREADS = 512;
constexpr int LDS_BYTES = 147456;
constexpr int LDS_MISC = 145408;
constexpr size_t MiB = 1u << 20;
constexpr size_t WS_CTL = 0, CTL_ZERO_BYTES = 1 * MiB;
constexpr int CW_BAR = 4096;
constexpr size_t CTL_SS1 = 256 * 1024, CTL_SS2 = 320 * 1024;
constexpr size_t WS_LF = 1 * MiB;
constexpr size_t WS_SU = 1 * MiB + 512 * 1024, WS_SV = 1 * MiB + 640 * 1024;
constexpr size_t WS_WIN = 2 * MiB, WS_WO1 = 18 * MiB, WS_WO2 = 26 * MiB, WS_WQ = 34 * MiB, WS_WK = 42 * MiB, WS_WV = 50 * MiB, WS_WO = 58 * MiB;
constexpr size_t WS_WPQ = 66 * MiB, WS_AEXP = 74 * MiB, WS_WSC = 82 * MiB, WS_PB = 90 * MiB, WS_MN = 91 * MiB, WS_KX = 93 * MiB, WS_VXT = 95 * MiB;
constexpr size_t WS_UB = 98 * MiB, WS_VB = 130 * MiB, WS_XN = 226 * MiB, WS_PROJ = 258 * MiB, WS_AMIX = 322 * MiB, WS_H = 354 * MiB, WS_HB = 418 * MiB, WS_P = 450 * MiB, WS_END = 466 * MiB;

#define GAS __attribute__((address_space(1)))
#define LAS __attribute__((address_space(3)))
typedef unsigned short bf16;
typedef unsigned v4u __attribute__((ext_vector_type(4)));
typedef unsigned v2u __attribute__((ext_vector_type(2)));
typedef float f32x4 __attribute__((ext_vector_type(4)));
typedef __bf16 bf16x2_t __attribute__((ext_vector_type(2)));
#define LDS_WAIT() asm volatile("s_waitcnt lgkmcnt(0)" ::: "memory")
__device__ __forceinline__ unsigned f2bf(float f) { unsigned u = __builtin_bit_cast(unsigned, f); return (u + 0x7fffu + ((u >> 16) & 1u)) >> 16; }
__device__ __forceinline__ unsigned pk2(float lo, float hi) { return f2bf(lo) | (f2bf(hi) << 16); }
__device__ __forceinline__ float wave_sum(float v) {
#pragma unroll
    for (int o = 1; o < 64; o <<= 1) v += __shfl_xor(v, o);
    return v;
}

#define XB_TMO      128
#define XB_XCNT(j)  (256  + 64 * (j))
#define XB_XSUB(j)  (1280 + 64 * (j))
#define XB_XGEN(j)  (2304 + 64 * (j))
#define XB_TOP      3328
#define XB_TOPGEN   3392
#define XCD_BAR_WORDS 3456
#define XB_SPIN_CAP (1u << 22)
__device__ __forceinline__ unsigned xb_ld(unsigned* p)              { return __hip_atomic_load(p, __ATOMIC_RELAXED, __HIP_MEMORY_SCOPE_AGENT); }
__device__ __forceinline__ unsigned xb_add(unsigned* p, unsigned v) { return __hip_atomic_fetch_add(p, v, __ATOMIC_RELAXED, __HIP_MEMORY_SCOPE_AGENT); }
__device__ __forceinline__ unsigned xb_xcc_id() { return (unsigned)__builtin_amdgcn_s_getreg((3 << 11) | 20) & 0xFu; }
#define XB_SPIN(cond, bar) do { unsigned _sp = 0; while (cond) { __builtin_amdgcn_s_sleep(1); \
    if ((++_sp & 255u) == 0u) { if (xb_ld(&(bar)[XB_TMO])) break; if (_sp > XB_SPIN_CAP) { atomicAdd(&(bar)[XB_TMO], 1u); break; } } } } while (0)
struct XcdBarrier { unsigned* bar; unsigned x; volatile LAS unsigned* st; };
__device__ __forceinline__ XcdBarrier xcd_barrier_post(unsigned* bar, volatile LAS unsigned* st) {
    XcdBarrier b; b.bar = bar; b.x = xb_xcc_id(); b.st = st;
    if (threadIdx.x == 0) (void)xb_add(&bar[XB_XCNT(b.x)], 1u);
    return b;
}
__device__ __forceinline__ void xcd_barrier_complete(unsigned* bar, unsigned x, unsigned& nloc, unsigned& nx) {
    const unsigned G = gridDim.x * gridDim.y * gridDim.z;
    unsigned sum, cnt, mine, sp = 0u;
    for (;;) {
        sum = 0u; cnt = 0u; mine = 0u;
#pragma unroll
        for (unsigned j = 0; j < 16; ++j) { const unsigned c = xb_ld(&bar[XB_XCNT(j)]); sum += c; cnt += (c > 0u) ? 1u : 0u; mine = (j == x) ? c : mine; }
        if (sum == G) break;
        __builtin_amdgcn_s_sleep(1);
        if ((++sp & 255u) == 0u) { if (xb_ld(&bar[XB_TMO])) break; if (sp > XB_SPIN_CAP) { atomicAdd(&bar[XB_TMO], 1u); break; } }
    }
    nloc = mine > 0u ? mine : 1u; nx = cnt > 0u ? cnt : 1u;
}
__device__ __forceinline__ void xcd_barrier(const XcdBarrier& b) {
    asm volatile("s_waitcnt vmcnt(0)" ::: "memory");
    __syncthreads();
    if (threadIdx.x == 0) {
        unsigned* bar = b.bar;
        __builtin_amdgcn_s_waitcnt(0);
        unsigned nloc = b.st[0], nx = b.st[1];
        if (nloc == 0u) { xcd_barrier_complete(bar, b.x, nloc, nx); b.st[0] = nloc; b.st[1] = nx; }
        const unsigned old = xb_add(&bar[XB_XSUB(b.x)], 1u);
        const unsigned gen = old / nloc;
        if (old + 1u == (gen + 1u) * nloc) {
            __builtin_amdgcn_fence(__ATOMIC_RELEASE, "agent");
            asm volatile("s_waitcnt vmcnt(0)" ::: "memory");
            const unsigned og = xb_add(&bar[XB_TOP], 1u);
            const unsigned tg = og / nx;
            if (og + 1u == (tg + 1u) * nx) xb_add(&bar[XB_TOPGEN], 1u);
            else XB_SPIN(xb_ld(&bar[XB_TOPGEN]) == tg, bar);
            __builtin_amdgcn_fence(__ATOMIC_ACQUIRE, "agent");
            xb_add(&bar[XB_XGEN(b.x)], 1u);
            asm volatile("s_waitcnt vmcnt(0)" ::: "memory");
        } else {
            XB_SPIN(xb_ld(&bar[XB_XGEN(b.x)]) == gen, bar);
            __builtin_amdgcn_fence(__ATOMIC_ACQUIRE, "agent");
            asm volatile("s_waitcnt vmcnt(0)" ::: "memory");
        }
    }
    __syncthreads();
}

struct Args { const float* in[20]; float* out; unsigned char* ws; int ph_lo, ph_hi; int one_launch, pad; };

__device__ __forceinline__ void p0_transpose_item(const float* W, int ldw, int nblk, const float* g, bf16* WT, bf16* WT2, int k2lo, int ldt, LAS float* scr, int item, int lane) {
    const int kb = item / nblk, nb = item % nblk, k0 = 64 * kb, n0 = 32 * nb;
#pragma unroll 8
    for (int i = 0; i < 32; ++i) { const int kk = 2 * i + (lane >> 5); float v = W[(size_t)(k0 + kk) * ldw + n0 + (lane & 31)]; if (g) v *= g[k0 + kk]; scr[kk * 33 + (lane & 31)] = v; }
    LDS_WAIT(); asm volatile("" ::: "memory");
    const int c = lane & 7;
#pragma unroll
    for (int j = 0; j < 4; ++j) { const int n = (lane >> 3) + 8 * j; const LAS float* s = scr + (8 * c) * 33 + n;
        v4u o; o.x = pk2(s[0 * 33], s[1 * 33]); o.y = pk2(s[2 * 33], s[3 * 33]); o.z = pk2(s[4 * 33], s[5 * 33]); o.w = pk2(s[6 * 33], s[7 * 33]);
        *(GAS v4u*)(WT + (size_t)(n0 + n) * ldt + k0 + 8 * c) = o;
        if (WT2 && k0 >= k2lo) *(GAS v4u*)(WT2 + (size_t)(n0 + n) * ldt + k0 + 8 * c) = o; }
    LDS_WAIT(); asm volatile("" ::: "memory");
}
__device__ __forceinline__ v4u cvt8(const float* p, float s) {
    const f32x4 a = *(const f32x4*)p, b = *(const f32x4*)(p + 4);
    v4u o; o.x = pk2(a[0] * s, a[1] * s); o.y = pk2(a[2] * s, a[3] * s); o.z = pk2(b[0] * s, b[1] * s); o.w = pk2(b[2] * s, b[3] * s); return o;
}

__device__ __forceinline__ float gelu_f(float v) {
    const float av = fabsf(v), t = __builtin_amdgcn_rcpf(av * 0.2316418882f + 1.0f);
    float q = t * 0.5307027145f + (-0.7265760135f); q = q * t + 0.7107068705f; q = q * t + (-0.142248368f); q = q * t + 0.127414796f; q = q * t;
    const float e = __builtin_amdgcn_exp2f((v * v) * (-0.72134752044f));
    const float m = v * (q * e);
    return v < 0.f ? m : v - m;
}
__device__ __forceinline__ float dot2bf(unsigned a, unsigned b, float c) { return __builtin_amdgcn_fdot2_f32_bf16(__builtin_bit_cast(bf16x2_t, a), __builtin_bit_cast(bf16x2_t, b), c, false); }
__device__ __forceinline__ unsigned fkey(float f) { const unsigned u = __float_as_uint(f); return (u & 0x80000000u) ? ~u : (u | 0x80000000u); }
__device__ __forceinline__ float fdec(unsigned k) { const unsigned u = (k & 0x80000000u) ? (k & 0x7fffffffu) : ~k; return __uint_as_float(u); }


typedef float f32x2v __attribute__((ext_vector_type(2)));
__device__ __forceinline__ float wave_sum_dpp(float v) {
    v += __builtin_bit_cast(float, __builtin_amdgcn_update_dpp(0, __builtin_bit_cast(int, v), 0xB1, 0xf, 0xf, true));
    v += __builtin_bit_cast(float, __builtin_amdgcn_update_dpp(0, __builtin_bit_cast(int, v), 0x4E, 0xf, 0xf, true));
    v += __builtin_bit_cast(float, __builtin_amdgcn_update_dpp(0, __builtin_bit_cast(int, v), 0x141, 0xf, 0xf, true));
    v += __builtin_bit_cast(float, __builtin_amdgcn_update_dpp(0, __builtin_bit_cast(int, v), 0x140, 0xf, 0xf, true));
    const float a = __builtin_bit_cast(float, __builtin_amdgcn_readlane(__builtin_bit_cast(int, v), 0));
    const float b = __builtin_bit_cast(float, __builtin_amdgcn_readlane(__builtin_bit_cast(int, v), 16));
    const float c = __builtin_bit_cast(float, __builtin_amdgcn_readlane(__builtin_bit_cast(int, v), 32));
    const float d = __builtin_bit_cast(float, __builtin_amdgcn_readlane(__builtin_bit_cast(int, v), 48));
    return (a + b) + (c + d);
}
typedef float v32f __attribute__((ext_vector_type(32)));
typedef float v16f __attribute__((ext_vector_type(16)));
typedef unsigned v6u __attribute__((ext_vector_type(6)));
#ifndef FP6_INTERLEAVED
#define FP6_INTERLEAVED 1
#endif
__device__ __forceinline__ v32f dec_fp6(const v4u a, const v2u b) { const v6u w = {a.x, a.y, a.z, a.w, b.x, b.y}; return __builtin_amdgcn_cvt_scalef32_pk32_f32_fp6(w, 1.0f); }
__device__ __forceinline__ float peer_dot(const v4u ua, const v2u ub, const v32f& xn) {
    const v32f f = dec_fp6(ua, ub); float a0 = 0.f, a1 = 0.f;
#pragma unroll
    for (int i = 0; i < 32; i += 2) { a0 = fmaf(f[i], xn[i], a0); a1 = fmaf(f[i + 1], xn[i + 1], a1); }
    return a0 + a1;
}
__device__ __forceinline__ void peer_axpy(const v4u va, const v2u vb, float w, v32f& oacc) {
    const v32f f = dec_fp6(va, vb);
#pragma unroll
    for (int i = 0; i < 32; ++i) oacc[i] = fmaf(w, f[i], oacc[i]);
}

__global__ void __launch_bounds__(NTHREADS, 2) fwd_kernel(Args args) {
    extern __shared__ __attribute__((aligned(16))) unsigned char lds[];
    LAS unsigned char* ldsL = (LAS unsigned char*)lds;
    volatile LAS unsigned* MISC = (volatile LAS unsigned*)(ldsL + LDS_MISC);
    const int tid = threadIdx.x, lane = tid & 63, wave = __builtin_amdgcn_readfirstlane(tid >> 6);
    const int G = gridDim.x; const int bx = blockIdx.x; const int vcu = (G % 8 == 0) ? (bx % 8) * (G / 8) + bx / 8 : bx;
#define G_ws (args.ws)
#define G_ctl ((unsigned*)(args.ws + WS_CTL))
#define G_x (args.in[0])
#define G_mem (args.in[1])
#define G_mix_norm (args.in[2])
#define G_w_in (args.in[3])
#define G_b_forget (args.in[4])
#define G_pool_w (args.in[5])
#define G_pool_scale (args.in[6])
#define G_w_out (args.in[7])
#define G_xattn_norm (args.in[8])
#define G_mem_norm (args.in[9])
#define G_xwq (args.in[10])
#define G_xwk (args.in[11])
#define G_xwv (args.in[12])
#define G_xwo (args.in[13])
#define G_peer_norm (args.in[14])
#define G_peer_wq (args.in[15])
#define G_sub_keys (args.in[16])
#define G_peer_u (args.in[17])
#define G_peer_v (args.in[18])
#define G_final_norm (args.in[19])
#define G_W_IN ((bf16*)(args.ws + WS_WIN))
#define G_WO1 ((bf16*)(args.ws + WS_WO1))
#define G_WO2 ((bf16*)(args.ws + WS_WO2))
#define G_WQ ((bf16*)(args.ws + WS_WQ))
#define G_WK ((bf16*)(args.ws + WS_WK))
#define G_WV ((bf16*)(args.ws + WS_WV))
#define G_WO ((bf16*)(args.ws + WS_WO))
#define G_WPQ ((bf16*)(args.ws + WS_WPQ))
#define G_AEXP ((bf16*)(args.ws + WS_AEXP))
#define G_WSC ((bf16*)(args.ws + WS_WSC))
#define G_PB ((bf16*)(args.ws + WS_PB))
#define G_MN ((bf16*)(args.ws + WS_MN))
#define G_KX ((bf16*)(args.ws + WS_KX))
#define G_VXT ((bf16*)(args.ws + WS_VXT))
#define G_UB (args.ws + WS_UB)
#define G_VB (args.ws + WS_VB)
#define G_SU ((float*)(args.ws + WS_SU))
#define G_SV ((float*)(args.ws + WS_SV))
#define G_XN ((bf16*)(args.ws + WS_XN))
#define G_QX ((bf16*)(args.ws + WS_XN))
#define G_PROJ ((bf16*)(args.ws + WS_PROJ))
#define G_SCT ((float*)(args.ws + WS_PROJ))
#define G_AMIX ((bf16*)(args.ws + WS_AMIX))
#define G_OX ((bf16*)(args.ws + WS_AMIX))
#define G_H ((float*)(args.ws + WS_H))
#define G_HB ((bf16*)(args.ws + WS_HB))
#define G_PP ((bf16*)(args.ws + WS_P))
#define G_LF ((float*)(args.ws + WS_LF))
#define G_SS1 ((float*)(args.ws + CTL_SS1))
#define G_SS2 ((float*)(args.ws + CTL_SS2))

    for (int u = tid; u < (LDS_BYTES - LDS_MISC) / 4; u += NTHREADS) ((LAS unsigned*)(ldsL + LDS_MISC))[u] = 0u;
    __syncthreads();
    XcdBarrier bar; bar.bar = G_ctl + CW_BAR; bar.x = 0; bar.st = nullptr;
    if (args.one_launch) bar = xcd_barrier_post(G_ctl + CW_BAR, MISC + 8);
    const int lo = args.ph_lo, hi = args.ph_hi;
#ifndef PH_MASK
#define PH_MASK 0x3ff
#endif
#define IN(k) (((PH_MASK >> (k)) & 1) && lo <= (k) && (k) < hi)
#define SEAM(k) do { if (IN(k) && IN((k) + 1)) xcd_barrier(bar); } while (0)
    const int gw = vcu * NWAVES + wave, NGW = G * NWAVES;
    const int gt = vcu * NTHREADS + tid, NGT = G * NTHREADS;

    if (IN(0)) for (int rep_ = 0; rep_ < (((DUP_MASK >> 0) & 1) ? 2 : 1); ++rep_) {
        LAS float* wf = (LAS float*)ldsL;
        LAS float* scr = (LAS float*)(ldsL + 65536 + wave * 8704);
        for (int i = tid; i < 8 * DM; i += NTHREADS) { const int d = i >> 3, h = i & 7; wf[h * DM + d] = G_w_in[(size_t)d * INC + 4096 + h]; }
        __syncthreads();
        for (int m = gw; m < TOK; m += NGW) {
            const GAS f32x4* xr = (const GAS f32x4*)(G_x + (size_t)m * DM) + lane; const GAS f32x4* gr = (const GAS f32x4*)G_mix_norm + lane;
            f32x4 v[8]; float s = 0.f;
#pragma unroll
            for (int j = 0; j < 8; ++j) { v[j] = xr[64 * j]; s += (v[j][0] * v[j][0] + v[j][1] * v[j][1]) + (v[j][2] * v[j][2] + v[j][3] * v[j][3]); }
            const float rstd = __builtin_amdgcn_rsqf(wave_sum(s) * (1.f / DM) + EPS);
            GAS v2u* o8 = (GAS v2u*)(G_XN + (size_t)m * DM) + lane;
#pragma unroll
            for (int j = 0; j < 8; ++j) { const f32x4 gg = gr[64 * j]; v[j] = v[j] * rstd * gg;
                v2u o; o.x = pk2(v[j][0], v[j][1]); o.y = pk2(v[j][2], v[j][3]); o8[64 * j] = o; }
            float fl[8];
#pragma unroll
            for (int h = 0; h < 8; ++h) { float a = 0.f;
#pragma unroll
                for (int j = 0; j < 8; ++j) { const f32x4 w = *(const LAS f32x4*)(wf + h * DM + j * 256 + lane * 4); a += (v[j][0] * w[0] + v[j][1] * w[1]) + (v[j][2] * w[2] + v[j][3] * w[3]); }
                fl[h] = wave_sum(a);
                asm volatile("" ::: "memory"); }
            if (lane < 8) { float f = fl[0];
#pragma unroll
                for (int h = 1; h < 8; ++h) f = (lane == h) ? fl[h] : f;
                f += G_b_forget[lane];
                const float ls = fminf(f, 0.f) - log1pf(expf(-fabsf(f)));
                const int b = m / SEQ, sq = m % SEQ; G_LF[(size_t)(b * FOXH + lane) * SEQ + sq] = ls; }
        }
        for (int m = gw; m < BATCH * NMEM; m += NGW) {
            const GAS f32x4* xr = (const GAS f32x4*)(G_mem + (size_t)m * DM) + lane; const GAS f32x4* gr = (const GAS f32x4*)G_mem_norm + lane;
            f32x4 v[8]; float s = 0.f;
#pragma unroll
            for (int j = 0; j < 8; ++j) { v[j] = xr[64 * j]; s += (v[j][0] * v[j][0] + v[j][1] * v[j][1]) + (v[j][2] * v[j][2] + v[j][3] * v[j][3]); }
            const float rstd = __builtin_amdgcn_rsqf(wave_sum(s) * (1.f / DM) + EPS);
            GAS v2u* o8 = (GAS v2u*)(G_MN + (size_t)m * DM) + lane;
#pragma unroll
            for (int j = 0; j < 8; ++j) { const f32x4 gg = gr[64 * j]; v[j] = v[j] * rstd * gg; v2u o; o.x = pk2(v[j][0], v[j][1]); o.y = pk2(v[j][2], v[j][3]); o8[64 * j] = o; }
        }
        {
            constexpr int I_IN = (DM / 64) * (4096 / 32), I_SQ = (DM / 64) * (DM / 32);
            constexpr int NITEMS = I_IN + 5 * I_SQ;
            for (int it = gw; it < NITEMS; it += NGW) {
                int r = it;
                if (r < I_IN) { p0_transpose_item(G_w_in, INC, 4096 / 32, nullptr, G_W_IN, nullptr, 0, DM, scr, r, lane); continue; } r -= I_IN;
                if (r < I_SQ) { p0_transpose_item(G_w_out, DM, DM / 32, nullptr, G_WO1, G_WO2, POOLW, DM, scr, r, lane); continue; } r -= I_SQ;
                if (r < I_SQ) { p0_transpose_item(G_xwq, DM, DM / 32, G_xattn_norm, G_WQ, nullptr, 0, DM, scr, r, lane); continue; } r -= I_SQ;
                if (r < I_SQ) { p0_transpose_item(G_xwk, DM, DM / 32, nullptr, G_WK, nullptr, 0, DM, scr, r, lane); continue; } r -= I_SQ;
                if (r < I_SQ) { p0_transpose_item(G_xwv, DM, DM / 32, nullptr, G_WV, nullptr, 0, DM, scr, r, lane); continue; } r -= I_SQ;
                p0_transpose_item(G_xwo, DM, DM / 32, nullptr, G_WO, nullptr, 0, DM, scr, r, lane);
            }
        }
        for (int r = gw; r < 2 * PEXP; r += NGW) {
            const int tb = r >> 14, rr = r & (PEXP - 1);
            const float* src = (tb ? G_peer_v : G_peer_u) + (size_t)rr * DM + lane * 4;
            f32x4 v[8]; float am = 0.f;
#pragma unroll
            for (int q = 0; q < 8; ++q) { v[q] = *(const GAS f32x4*)(src + q * 256);
                am = fmaxf(am, fmaxf(fmaxf(fabsf(v[q][0]), fabsf(v[q][1])), fmaxf(fabsf(v[q][2]), fabsf(v[q][3])))); }
#pragma unroll
            for (int o = 1; o < 64; o <<= 1) am = fmaxf(am, __shfl_xor(am, o));
            int ex = 0; if (am > 0.f) { (void)frexpf(am, &ex); ex = 3 - ex; if (ldexpf(am, ex) > 7.5f) ex -= 1; }
            const float sc = ldexpf(1.f, ex);
            if (lane == 0) (tb ? G_SV : G_SU)[rr] = ldexpf(1.f, -ex);
            v16f xa, xb;
#pragma unroll
            for (int i = 0; i < 16; ++i) {
#if FP6_INTERLEAVED
                xa[i] = v[(2 * i) >> 2][(2 * i) & 3] * sc; xb[i] = v[(2 * i + 1) >> 2][(2 * i + 1) & 3] * sc;
#else
                xa[i] = v[i >> 2][i & 3] * sc; xb[i] = v[(16 + i) >> 2][(16 + i) & 3] * sc;
#endif
            }
            const v6u w = __builtin_amdgcn_cvt_scalef32_2xpk16_fp6_f32(xa, xb, 1.0f);
            unsigned char* dst = (tb ? G_VB : G_UB) + (size_t)rr * 1536;
            *(GAS v4u*)(dst + lane * 16) = (v4u){w[0], w[1], w[2], w[3]};
            *(GAS v2u*)(dst + 1024 + lane * 8) = (v2u){w[4], w[5]};
        }
        for (int i = gt; i < DM * DM / 8; i += NGT) {
            const int d = i / (DM / 8); *(GAS v4u*)(G_WPQ + (size_t)i * 8) = cvt8(G_peer_wq + (size_t)i * 8, G_peer_norm[d]); }
        for (int i = gt; i < DM * DM / 8; i += NGT) {
            const int r = i / (DM / 8), c0 = (i % (DM / 8)) * 8; const int hc = r >> 7;
            v4u o = {0u, 0u, 0u, 0u}; if ((c0 >> 7) == hc) o = cvt8(G_sub_keys + (size_t)r * 128 + (c0 & 127), 1.f);
            *(GAS v4u*)(G_AEXP + (size_t)i * 8) = o; }
        for (int i = gt; i < 4 * 256 * 256 / 8; i += NGT) {
            const int g = i / (256 * 256 / 8), d0 = (i % 32) * 8; const float* ps = G_pool_scale + g * 256 + d0; const float* p = G_pool_w + (size_t)i * 8;
            v4u o; o.x = pk2(p[0] * ps[0], p[1] * ps[1]); o.y = pk2(p[2] * ps[2], p[3] * ps[3]); o.z = pk2(p[4] * ps[4], p[5] * ps[5]); o.w = pk2(p[6] * ps[6], p[7] * ps[7]);
            *(GAS v4u*)(G_PB + (size_t)i * 8) = o; }
        __syncthreads();
    }
    SEAM(0);

    if (IN(1)) for (int rep_ = 0; rep_ < (((DUP_MASK >> 1) & 1) ? 2 : 1); ++rep_) {
        pg8::Gemm g{G_XN, G_W_IN, DM, DM, DM}; pg8::GSched S; S.init(TOK / 256, 4096 / 256, G, bx, DM, DM);
        pg8::EpiStore E{G_PROJ, 4096, 0, 0, 1, nullptr, 1.f, 4, 8, 0.08838834764831845f * LOG2E};
        pg8::gemm_phase<pg8::EpiStore, pg8::GSched, true>(ldsL, g, S, E);
    }
    SEAM(1);

    if (IN(2)) for (int rep_ = 0; rep_ < (((DUP_MASK >> 2) & 1) ? 2 : 1); ++rep_) {
        for (int it = vcu; it < TOK / 32; it += G) {
            const int ch = (tid & 127) * 8, rsub = tid >> 7, r0 = it * 32 + rsub * 8, w = 2 << (ch >> 8);
            const int s0 = r0 % SEQ;
            float acc[8];
#pragma unroll
            for (int e = 0; e < 8; ++e) acc[e] = 0.f;
            for (int k = 1; k < w; ++k) { if (s0 - k >= 0) { const v4u v = *(const GAS v4u*)(G_PROJ + (size_t)(r0 - k) * 4096 + ch);
#pragma unroll
                    for (int e = 0; e < 4; ++e) { acc[2 * e] += __uint_as_float(v[e] << 16); acc[2 * e + 1] += __uint_as_float(v[e] & 0xffff0000u); } } }
            for (int rr = 0; rr < 8; ++rr) {
                const v4u v = *(const GAS v4u*)(G_PROJ + (size_t)(r0 + rr) * 4096 + ch); float cur[8];
#pragma unroll
                for (int e = 0; e < 4; ++e) { cur[2 * e] = __uint_as_float(v[e] << 16); cur[2 * e + 1] = __uint_as_float(v[e] & 0xffff0000u); }
                const int sp = s0 + rr; const float inv = 1.f / (float)((sp + 1 < w) ? sp + 1 : w);
                v4u o;
#pragma unroll
                for (int e = 0; e < 8; ++e) acc[e] += cur[e];
                o.x = pk2(acc[0] * inv - cur[0], acc[1] * inv - cur[1]); o.y = pk2(acc[2] * inv - cur[2], acc[3] * inv - cur[3]);
                o.z = pk2(acc[4] * inv - cur[4], acc[5] * inv - cur[5]); o.w = pk2(acc[6] * inv - cur[6], acc[7] * inv - cur[7]);
                *(GAS v4u*)(G_AMIX + (size_t)(r0 + rr) * DM + ch) = o;
                if (sp - w + 1 >= 0) { const v4u vo = *(const GAS v4u*)(G_PROJ + (size_t)(r0 + rr - w + 1) * 4096 + ch);
#pragma unroll
                    for (int e = 0; e < 4; ++e) { acc[2 * e] -= __uint_as_float(vo[e] << 16); acc[2 * e + 1] -= __uint_as_float(vo[e] & 0xffff0000u); } }
            }
        }
        const int a_bh = vcu >> 4, a_qb = vcu & 15;
        if (a_qb < 8 && vcu < 256) {
            const int e = a_bh * 8 + a_qb;
            pg8::Gemm g; pg8::GSched S; S.init(1, 1, 1, 0, DM, DM); pg8::EpiStore E{nullptr, DM, 0, 0, 1, nullptr, 1.f, 0, 0, 1.f};
            int pm, pn;
            if (e < 16)      { pm = e >> 3; pn = e & 7; g = pg8::Gemm{G_MN, G_WK, DM, DM, DM}; E.O = G_KX; E.ldc = DM; }
            else if (e < 32) { const int q = e - 16; pm = q >> 1; pn = q & 1; g = pg8::Gemm{G_WV, G_MN, DM, DM, DM}; E.O = G_VXT; E.ldc = 512; }
            else if (e < 96) { const int q = e - 32; pm = q >> 3; pn = q & 7; g = pg8::Gemm{G_AEXP, G_WPQ, DM, DM, DM}; E.O = G_WSC; E.ldc = DM; }
            else             { const int q = e - 96; const int gg = q >> 3; pm = q & 7; pn = 0;
                               g = pg8::Gemm{G_WO1 + gg * 256, G_PB + (size_t)gg * 65536, 256, DM, 256}; S.lda = DM; S.ldb = 256; E.O = G_WO2 + gg * 256; E.ldc = DM; }
            struct One { int pm, pn; long ao, bo; __device__ __forceinline__ bool next(int i, pg8::Unit& u) const { if (i) return false; u.pm = pm; u.pn = pn; u.z = 0; u.aoff = ao; u.boff = bo; return true; }
                         __device__ __forceinline__ void a_ready(const pg8::Unit&) const {} __device__ __forceinline__ void done(const pg8::Unit&) const {} };
            const One S1{pm, pn, (long)pm * 256 * g.lda, (long)pn * 256 * g.ldb};
            pg8::gemm_phase<pg8::EpiStore, One, false>(ldsL, g, S1, E);
        }
        if (vcu < 256) {
            const int b = a_bh >> 3, h = a_bh & 7;
            float* c_lds = (float*)(lds + fox::LDS_C);
            if (wave == 0) {
                const float* lf = G_LF + (size_t)a_bh * SEQ + lane * 64; float loc[64]; float run = 0.f;
#pragma unroll
                for (int i = 0; i < 16; ++i) { const f32x4 v = *(const f32x4*)(lf + 4 * i);
#pragma unroll
                    for (int e = 0; e < 4; ++e) { run += v[e]; loc[4 * i + e] = run; } }
                float incl = run;
#pragma unroll
                for (int o = 1; o < 64; o <<= 1) { const float t = __shfl_up(incl, o); if (lane >= o) incl += t; }
                const float excl = incl - run;
#pragma unroll
                for (int i = 0; i < 16; ++i) { f32x4 v;
#pragma unroll
                    for (int e = 0; e < 4; ++e) v[e] = (loc[4 * i + e] + excl) * LOG2E;
                    *(f32x4*)(c_lds + lane * 64 + 4 * i) = v; }
            }
            __syncthreads();
            const bf16* Qb = G_PROJ + (size_t)(b * SEQ) * 4096 + 1024 + h * 128;
            fox::BlockRef cur{Qb + (size_t)(a_qb * 256) * 4096, Qb + 1024, Qb + 2048, G_AMIX + (size_t)(b * SEQ + a_qb * 256) * DM + 1024 + h * 128, a_qb * 256};
            fox::Seam S;
            fox::prime(cur, (char*)lds, S);
            fox::block(cur, cur, (char*)lds, S);
            asm volatile("s_waitcnt vmcnt(0)" ::: "memory");
            __syncthreads();
        }
    }
    SEAM(2);

    if (IN(3)) for (int rep_ = 0; rep_ < (((DUP_MASK >> 3) & 1) ? 2 : 1); ++rep_) {
        pg8::Gemm g{G_AMIX, G_WO2, DM, DM, DM}; pg8::GSched S; S.init(TOK / 256, DM / 256, G, bx, DM, DM);
        pg8::EpiResid E{G_x, G_H, G_HB, G_SS1};
        pg8::gemm_phase<pg8::EpiResid, pg8::GSched, true>(ldsL, g, S, E);
    }
    SEAM(3);

    if (IN(4)) for (int rep_ = 0; rep_ < (((DUP_MASK >> 4) & 1) ? 2 : 1); ++rep_) {
        pg8::Gemm g{G_HB, G_WQ, DM, DM, DM}; pg8::GSched S; S.init(TOK / 256, DM / 256, G, bx, DM, DM);
        pg8::EpiStore E{G_QX, DM, 0, 0, 1, G_SS1, 0.044194173824159216f * LOG2E, 0, 0, 1.f};
        pg8::gemm_phase<pg8::EpiStore, pg8::GSched, true>(ldsL, g, S, E);
    }
    SEAM(4);

    if (IN(5)) for (int rep_ = 0; rep_ < (((DUP_MASK >> 5) & 1) ? 2 : 1); ++rep_) {
        pg8::Gemm g{G_QX, G_KX, XD, DM, DM}; pg8::GSched S; S.init(SEQ / 256, 1, G, bx, DM, DM);
        S.nH = XH; S.nZ = BATCH * XH; S.sAb = (long)SEQ * DM; S.sAh = XD; S.sBb = (long)NMEM * DM; S.sBh = XD;
        pg8::EpiSoftmax E{G_PP, 1024, (long)SEQ * 1024, 256, XH};
        pg8::gemm_phase<pg8::EpiSoftmax, pg8::GSched, false>(ldsL, g, S, E);
    }
    SEAM(5);

    if (IN(6)) for (int rep_ = 0; rep_ < (((DUP_MASK >> 6) & 1) ? 2 : 1); ++rep_) {
        pg8::Gemm g{G_PP, G_VXT, NMEM, 1024, 512}; pg8::GSched S; S.init(SEQ / 256, XD / 256, G, bx, 1024, 512);
        S.nH = XH; S.nZ = BATCH * XH; S.sAb = (long)SEQ * 1024; S.sAh = 256; S.sBb = NMEM; S.sBh = (long)XD * 512;
        pg8::EpiStore E{G_OX, DM, (long)SEQ * DM, XD, XH, nullptr, 1.f, 0, 0, 1.f};
        pg8::gemm_phase<pg8::EpiStore, pg8::GSched, true>(ldsL, g, S, E);
    }
    SEAM(6);

    if (IN(7)) for (int rep_ = 0; rep_ < (((DUP_MASK >> 7) & 1) ? 2 : 1); ++rep_) {
        pg8::Gemm g{G_OX, G_WO, DM, DM, DM}; pg8::GSched S; S.init(TOK / 256, DM / 256, G, bx, DM, DM);
        pg8::EpiResid E{G_H, G_H, G_HB, G_SS2};
        pg8::gemm_phase<pg8::EpiResid, pg8::GSched, true>(ldsL, g, S, E);
    }
    SEAM(7);

    if (IN(8)) for (int rep_ = 0; rep_ < (((DUP_MASK >> 8) & 1) ? 2 : 1); ++rep_) {
        pg8::Gemm g{G_WSC, G_HB, DM, DM, DM}; pg8::GSched S; S.init(DM / 256, TOK / 256, G, bx, DM, DM);
        pg8::EpiF32Col E{G_SCT, TOK, G_SS2};
        pg8::gemm_phase<pg8::EpiF32Col, pg8::GSched, true>(ldsL, g, S, E);
    }
    SEAM(8);

    if (IN(9)) for (int rep_ = 0; rep_ < (((DUP_MASK >> 9) & 1) ? 2 : 1); ++rep_) {
        LAS unsigned* TOP1 = (LAS unsigned*)ldsL;
        LAS unsigned* RIDX = (LAS unsigned*)(ldsL + 32768);
        LAS float* RGATE = (LAS float*)(ldsL + 49152);
        for (int blk = vcu; blk < TOK / 32; blk += G) {
            const int t0 = blk * 32;
            {
                const int tok = tid & 31, grp = tid >> 5;
                const float* sp = G_SCT + (size_t)(grp * 128) * TOK + t0 + tok;
                unsigned lst[16];
#pragma unroll
                for (int j = 0; j < 16; ++j) lst[j] = 0u;
                for (int i0 = 0; i0 < 128; i0 += 8) {
                    float v[8];
#pragma unroll
                    for (int e = 0; e < 8; ++e) v[e] = sp[(size_t)(i0 + e) * TOK];
#pragma unroll
                    for (int e = 0; e < 8; ++e) { unsigned xk = (fkey(v[e]) & ~127u) | (unsigned)(127 - (i0 + e));
#pragma unroll
                        for (int j = 0; j < 16; ++j) { const unsigned hi_ = max(lst[j], xk); xk = min(lst[j], xk); lst[j] = hi_; } }
                }
                LAS unsigned* dst = TOP1 + (tok * 16 + grp) * 16;
#pragma unroll
                for (int j = 0; j < 16; j += 4) *(LAS v4u*)(dst + j) = (v4u){lst[j], lst[j + 1], lst[j + 2], lst[j + 3]};
            }
            __syncthreads();
            if (tid < 256) {
                const int tok = tid & 31, head = tid >> 5;
                const LAS unsigned* ka = TOP1 + (tok * 16 + head * 2) * 16; const LAS unsigned* kb = ka + 16;
                float af[16], bfv[16];
#pragma unroll
                for (int j = 0; j < 16; ++j) { af[j] = fdec(ka[j] & ~127u); bfv[j] = fdec(kb[j] & ~127u); }
                unsigned best[16];
#pragma unroll
                for (int j = 0; j < 16; ++j) best[j] = 0u;
#pragma unroll
                for (int i = 0; i < 16; ++i)
#pragma unroll
                    for (int j = 0; j < 16; ++j) if ((i + 1) * (j + 1) <= 16) {
                        unsigned xk = (fkey(af[i] + bfv[j]) & ~255u) | (unsigned)(255 - (i * 16 + j));
#pragma unroll
                        for (int q = 0; q < 16; ++q) { const unsigned hi_ = max(best[q], xk); xk = min(best[q], xk); best[q] = hi_; } }
                float ev[16]; const float m0 = fdec(best[0] & ~255u); float sum = 0.f;
#pragma unroll
                for (int q = 0; q < 16; ++q) { ev[q] = __expf(fdec(best[q] & ~255u) - m0); sum += ev[q]; }
                const float inv = 1.f / sum;
#pragma unroll
                for (int q = 0; q < 16; ++q) { const unsigned code = 255u - (best[q] & 255u); const unsigned i = code >> 4, j = code & 15u;
                    const unsigned ia = 127u - (ka[i] & 127u), ib = 127u - (kb[j] & 127u);
                    RIDX[tok * 128 + head * 16 + q] = ia * 128u + ib; RGATE[tok * 128 + head * 16 + q] = ev[q] * inv; }
            }
            __syncthreads();
            for (int tt = 0; tt < 4; ++tt) {
                const int tok = wave * 4 + tt; const size_t t = (size_t)(t0 + tok);
                const float rstd2 = __builtin_amdgcn_rsqf(G_SS2[t] * (1.f / DM) + EPS);
                v32f xn, oacc;
#pragma unroll
                for (int q = 0; q < 8; ++q) { const size_t d0 = (size_t)q * 256 + lane * 4;
                    const f32x4 a = *(const f32x4*)(G_H + t * DM + d0), ga = *(const f32x4*)(G_peer_norm + d0);
#pragma unroll
                    for (int e = 0; e < 4; ++e) { xn[q * 4 + e] = a[e] * rstd2 * ga[e]; oacc[q * 4 + e] = 0.f; } }
                const LAS unsigned* ridx = RIDX + tok * 128; const LAS float* rgate = RGATE + tok * 128;
                v4u uaA0, vaA0, uaA1, vaA1, uaB0, vaB0, uaB1, vaB1; v2u ubA0, vbA0, ubA1, vbA1, ubB0, vbB0, ubB1, vbB1;
                float suA0, svA0, gtA0, suA1, svA1, gtA1, suB0, svB0, gtB0, suB1, svB1, gtB1;
#define PLD(S, k) do { const unsigned ex_ = (unsigned)__builtin_amdgcn_readfirstlane((int)ridx[k]); su##S = G_SU[ex_]; sv##S = G_SV[ex_]; gt##S = rgate[k]; \
        const unsigned char* up_ = G_UB + (size_t)ex_ * 1536; const unsigned char* vp_ = G_VB + (size_t)ex_ * 1536; \
        ua##S = *(const GAS v4u*)(up_ + lane * 16); ub##S = *(const GAS v2u*)(up_ + 1024 + lane * 8); \
        va##S = *(const GAS v4u*)(vp_ + lane * 16); vb##S = *(const GAS v2u*)(vp_ + 1024 + lane * 8); } while (0)
#define PCOMP(S0, S1) do { float d0_ = peer_dot(ua##S0, ub##S0, xn), d1_ = peer_dot(ua##S1, ub##S1, xn); \
        d0_ = wave_sum_dpp(d0_) * su##S0; d1_ = wave_sum_dpp(d1_) * su##S1; \
        peer_axpy(va##S0, vb##S0, gelu_f(d0_) * gt##S0 * sv##S0, oacc); peer_axpy(va##S1, vb##S1, gelu_f(d1_) * gt##S1 * sv##S1, oacc); } while (0)
                PLD(A0, 0); PLD(A1, 1);
                for (int k = 0; k < 128; k += 4) {
                    PLD(B0, k + 2); PLD(B1, k + 3);
                    PCOMP(A0, A1);
                    if (k + 4 < 128) { PLD(A0, k + 4); PLD(A1, k + 5); }
                    PCOMP(B0, B1);
                }
#undef PLD
#undef PCOMP
                float s = 0.f;
#pragma unroll
                for (int q = 0; q < 8; ++q) { const size_t d0 = (size_t)q * 256 + lane * 4; const f32x4 a = *(const f32x4*)(G_H + t * DM + d0);
#pragma unroll
                    for (int e = 0; e < 4; ++e) { const float y = a[e] + oacc[q * 4 + e]; oacc[q * 4 + e] = y; s += y * y; } }
                const float rstd = __builtin_amdgcn_rsqf(wave_sum(s) * (1.f / DM) + EPS);
#pragma unroll
                for (int q = 0; q < 8; ++q) { const size_t d0 = (size_t)q * 256 + lane * 4; const f32x4 ga = *(const f32x4*)(G_final_norm + d0); f32x4 o;
#pragma unroll
                    for (int e = 0; e < 4; ++e) o[e] = oacc[q * 4 + e] * rstd * ga[e];
                    *(f32x4*)(args.out + t * DM + d0) = o; }
            }
            __syncthreads();
        }
    }
#undef IN
#undef SEAM
#undef G_ws
#undef G_ctl
#undef G_x
#undef G_mem
#undef G_mix_norm
#undef G_w_in
#undef G_b_forget
#undef G_pool_w
#undef G_pool_scale
#undef G_w_out
#undef G_xattn_norm
#undef G_mem_norm
#undef G_xwq
#undef G_xwk
#undef G_xwv
#undef G_xwo
#undef G_peer_norm
#undef G_peer_wq
#undef G_sub_keys
#undef G_peer_u
#undef G_peer_v
#undef G_final_norm
#undef G_W_IN
#undef G_WO1
#undef G_WO2
#undef G_WQ
#undef G_WK
#undef G_WV
#undef G_WO
#undef G_WPQ
#undef G_AEXP
#undef G_WSC
#undef G_PB
#undef G_MN
#undef G_KX
#undef G_VXT
#undef G_UB
#undef G_VB
#undef G_SU
#undef G_SV
#undef G_XN
#undef G_QX
#undef G_PROJ
#undef G_SCT
#undef G_AMIX
#undef G_OX
#undef G_H
#undef G_HB
#undef G_PP
#undef G_LF
#undef G_SS1
#undef G_SS2

}

constexpr int N_PHASES = 10;
extern "C" void kernel_launch(void* const* d_in, const int* in_sizes, int n_in, void* d_out, int out_size, void* d_ws, size_t ws_size, hipStream_t stream) {
    static int grid = 0;
    if (grid == 0) {
        if (n_in != 20 || in_sizes[0] != TOK * DM || out_size != TOK * DM || ws_size < WS_END) {
            fprintf(stderr, "kernel_launch: unexpected shapes (n_in %d, in0 %d, out %d, ws %zu < %zu)\n", n_in, n_in > 0 ? in_sizes[0] : -1, out_size, ws_size, (size_t)WS_END); grid = -1; return; }
        int dev = 0, cus = 0, per_cu = 0;
        if (hipGetDevice(&dev) != hipSuccess || hipDeviceGetAttribute(&cus, hipDeviceAttributeMultiprocessorCount, dev) != hipSuccess) { grid = -1; return; }
        if (hipFuncSetAttribute((const void*)fwd_kernel, hipFuncAttributeMaxDynamicSharedMemorySize, LDS_BYTES) != hipSuccess) { fprintf(stderr, "kernel_launch: hipFuncSetAttribute failed\n"); grid = -1; return; }
        if (hipOccupancyMaxActiveBlocksPerMultiprocessor(&per_cu, (const void*)fwd_kernel, NTHREADS, LDS_BYTES) != hipSuccess || per_cu < 1) { fprintf(stderr, "kernel_launch: occupancy query says %d\n", per_cu); per_cu = 1; }
        (void)hipGetLastError();
        grid = cus;
        if (grid != 256) fprintf(stderr, "kernel_launch: %d CUs (built for 256)\n", grid);
    }
    if (grid < 0) return;
    (void)hipMemsetAsync((char*)d_ws + WS_CTL, 0, CTL_ZERO_BYTES, stream);
    Args a{};
    for (int i = 0; i < 20; ++i) a.in[i] = (const float*)d_in[i];
    a.out = (float*)d_out; a.ws = (unsigned char*)d_ws;
#if MK_ONE_LAUNCH
    a.ph_lo = 0; a.ph_hi = N_PHASES; a.one_launch = 1;
    void* kargs[] = {&a};
    hipError_t e = hipLaunchCooperativeKernel((const void*)fwd_kernel, dim3(grid), dim3(NTHREADS), kargs, LDS_BYTES, stream);
    if (e != hipSuccess) fprintf(stderr, "kernel_launch: cooperative launch failed: %s\n", hipGetErrorString(e));
#else
    for (int p = 0; p < N_PHASES; ++p) {
        a.ph_lo = p; a.ph_hi = p + 1; a.one_launch = 0;
        hipLaunchKernelGGL(fwd_kernel, dim3(grid), dim3(NTHREADS), LDS_BYTES, stream, a);
    }
#endif
}
```

```cpp
#include <hip/hip_runtime.h>
#include <hip/hip_bf16.h>
#include <cstdio>
#include <cstdint>

#ifndef DUP_MASK
#define DUP_MASK 0
#endif
#ifndef MK_ONE_LAUNCH
#define MK_ONE_LAUNCH 1
#endif

constexpr int BATCH = 2, SEQ = 4096, DM = 2048, TOK = BATCH * SEQ;
constexpr int INC = 4104, POOLW = 1024, FOXH = 8, FOXD = 128;
constexpr int NMEM = 256, XH = 4, XD = 512;
constexpr int PH = 8, PKEYS = 128, PEXP = 16384, TOPK = 16;
constexpr float EPS = 1e-6f;
constexpr float LOG2E = 1.4426950408889634f;

namespace pg8 {
#define PG8_LAS __attribute__((address_space(3)))
typedef unsigned short bf16_t;
typedef short bf16x8 __attribute__((ext_vector_type(8)));
typedef float f32x4 __attribute__((ext_vector_type(4)));
typedef float f32x2 __attribute__((ext_vector_type(2)));
typedef unsigned u32x4 __attribute__((ext_vector_type(4)));
typedef unsigned u32x2 __attribute__((ext_vector_type(2)));
constexpr int BM = 256, BK = 64, HALF = 128, HTB = HALF * BK * 2, STAGE_BYTES = 8 * HTB, NXCD = 8, WGM = 8;

__host__ __device__ __forceinline__ int lds_byte(int r, int c) { const int st = (r >> 4) * 2 + (c >> 5), rr = r & 15, cc = c & 31, ob = rr * 64 + cc * 2; return st * 1024 + (ob ^ (((ob >> 9) & 1) << 5)); }
__host__ __device__ __forceinline__ void stage_rc(int b, int& R, int& C) { const int st = b / 1024, sb = b % 1024, swz = sb ^ (((sb >> 9) & 1) << 5); R = (st >> 1) * 16 + swz / 64; C = (st & 1) * 32 + (swz % 64) / 2; }
__host__ __device__ __forceinline__ int perm32(int rho) { const int n = rho >> 4, i = rho & 15; return 8 * (i >> 2) + 4 * n + (i & 3); }

struct Unit { int pm, pn, z; long aoff, boff; };
struct Gemm { const bf16_t* A; const bf16_t* Bt; int K, lda, ldb; };

struct GSched {
    int nM, nN, nH, nZ, G, c; long sAb, sAh, sBb, sBh; int lda, ldb;
    __device__ __forceinline__ void init(int nM_, int nN_, int G_, int c_, int lda_, int ldb_) { nM = nM_; nN = nN_; nH = 1; nZ = 1; G = G_; c = c_; sAb = sAh = sBb = sBh = 0; lda = lda_; ldb = ldb_; }
    __device__ __forceinline__ bool next(int i, Unit& u) const {
        const long L = (long)i * G + c; const int nwg = nM * nN; if (L >= (long)nwg * nZ) return false;
        const int z = (int)(L / nwg); int wgid = (int)(L % nwg);
        { const int q = nwg / NXCD, r = nwg % NXCD, xcd = wgid % NXCD, off = wgid / NXCD; wgid = (xcd < r ? xcd * (q + 1) : r * (q + 1) + (xcd - r) * q) + off; }
        const int nig = WGM * nN, gid = wgid / nig, fm = gid * WGM, gsz = (nM - fm) < WGM ? (nM - fm) : WGM;
        u.pm = fm + ((wgid % nig) % gsz); u.pn = (wgid % nig) / gsz; u.z = z;
        const int zb = z / nH, zh = z % nH;
        u.aoff = zb * sAb + zh * sAh + (long)u.pm * BM * lda; u.boff = zb * sBb + zh * sBh + (long)u.pn * BM * ldb;
        return true;
    }
    __device__ __forceinline__ void a_ready(const Unit&) const {}
    __device__ __forceinline__ void done(const Unit&) const {}
};

__device__ __forceinline__ unsigned cvt_pk_bf16(float lo, float hi) { unsigned r; asm volatile("v_cvt_pk_bf16_f32 %0, %1, %2" : "=v"(r) : "v"(lo), "v"(hi)); return r; }


struct EpiStore {
    static constexpr bool PERM = true, AFTER_DRAIN = false;
    bf16_t* O; int ldc; long sCb, sCh; int nH;
    const float* ss; float rs_mul;
    int t0, t1; float tscale;
    __device__ __forceinline__ void operator()(const f32x4 (&acc)[2][2][4][2], const Unit& u, int wr, int wc, int fr, int fq) const {
        const int row0 = u.pm * BM + wr * 64 + fr, col0 = u.pn * BM + wc * 32 + 8 * fq;
        bf16_t* base = O + (u.z / nH) * sCb + (u.z % nH) * sCh;
        const float ts = (u.pn >= t0 && u.pn < t1) ? tscale : 1.f;
#pragma unroll
        for (int ai = 0; ai < 2; ++ai)
#pragma unroll
            for (int m = 0; m < 4; ++m) { const int row = row0 + ai * HALF + m * 16;
                float sc = ts; if (ss) sc *= __builtin_amdgcn_rsqf(ss[row] * (1.f / DM) + EPS) * rs_mul;
                bf16_t* rowp = base + (size_t)row * ldc + col0;
#pragma unroll
                for (int bj = 0; bj < 2; ++bj) { const f32x4 v0 = acc[ai][bj][m][0] * sc, v1 = acc[ai][bj][m][1] * sc;
                    u32x4 w; w.x = cvt_pk_bf16(v0[0], v0[1]); w.y = cvt_pk_bf16(v0[2], v0[3]); w.z = cvt_pk_bf16(v1[0], v1[1]); w.w = cvt_pk_bf16(v1[2], v1[3]);
                    *(u32x4*)(rowp + bj * HALF) = w; } }
    }
};
template <bool BASE_BF16> struct EpiResid {
    static constexpr bool PERM = true, AFTER_DRAIN = false;
    const void* base; bf16_t* HB; float* ss;
    __device__ __forceinline__ void operator()(const f32x4 (&acc)[2][2][4][2], const Unit& u, int wr, int wc, int fr, int fq) const {
        const int row0 = u.pm * BM + wr * 64 + fr, col0 = u.pn * BM + wc * 32 + 8 * fq;
#pragma unroll
        for (int ai = 0; ai < 2; ++ai)
#pragma unroll
            for (int m = 0; m < 4; ++m) { const int row = row0 + ai * HALF + m * 16; const size_t off = (size_t)row * DM + col0; float sq = 0.f;
#pragma unroll
                for (int bj = 0; bj < 2; ++bj) {
                    f32x4 b0, b1;
                    if constexpr (BASE_BF16) { const u32x4 r = *(const u32x4*)((const bf16_t*)base + off + bj * HALF);
                        b0 = (f32x4){__uint_as_float(r.x << 16), __uint_as_float(r.x & 0xffff0000u), __uint_as_float(r.y << 16), __uint_as_float(r.y & 0xffff0000u)};
                        b1 = (f32x4){__uint_as_float(r.z << 16), __uint_as_float(r.z & 0xffff0000u), __uint_as_float(r.w << 16), __uint_as_float(r.w & 0xffff0000u)}; }
                    else { b0 = *(const f32x4*)((const float*)base + off + bj * HALF); b1 = *(const f32x4*)((const float*)base + off + bj * HALF + 4); }
                    const f32x4 h0 = b0 + acc[ai][bj][m][0], h1 = b1 + acc[ai][bj][m][1];
                    u32x4 w; w.x = cvt_pk_bf16(h0[0], h0[1]); w.y = cvt_pk_bf16(h0[2], h0[3]); w.z = cvt_pk_bf16(h1[0], h1[1]); w.w = cvt_pk_bf16(h1[2], h1[3]);
                    *(u32x4*)(HB + off + bj * HALF) = w;
                    sq += (h0[0] * h0[0] + h0[1] * h0[1]) + (h0[2] * h0[2] + h0[3] * h0[3]) + (h1[0] * h1[0] + h1[1] * h1[1]) + (h1[2] * h1[2] + h1[3] * h1[3]); }
                sq += __shfl_xor(sq, 16); sq += __shfl_xor(sq, 32);
                if (fq == 0 && ss) atomicAdd(ss + row, sq); }
    }
};
struct EpiF32Col {
    static constexpr bool PERM = true, AFTER_DRAIN = false;
    float* O; int ldc; const float* ss;
    __device__ __forceinline__ void operator()(const f32x4 (&acc)[2][2][4][2], const Unit& u, int wr, int wc, int fr, int fq) const {
        const int row0 = u.pm * BM + wr * 64 + fr, col0 = u.pn * BM + wc * 32 + 8 * fq;
        f32x4 rs[2][2];
#pragma unroll
        for (int bj = 0; bj < 2; ++bj)
#pragma unroll
            for (int n = 0; n < 2; ++n) { const f32x4 s = *(const f32x4*)(ss + col0 + bj * HALF + 4 * n);
#pragma unroll
                for (int e = 0; e < 4; ++e) rs[bj][n][e] = __builtin_amdgcn_rsqf(s[e] * (1.f / DM) + EPS); }
#pragma unroll
        for (int ai = 0; ai < 2; ++ai)
#pragma unroll
            for (int m = 0; m < 4; ++m) { float* rowp = O + (size_t)(row0 + ai * HALF + m * 16) * ldc + col0;
#pragma unroll
                for (int bj = 0; bj < 2; ++bj) { *(f32x4*)(rowp + bj * HALF) = acc[ai][bj][m][0] * rs[bj][0]; *(f32x4*)(rowp + bj * HALF + 4) = acc[ai][bj][m][1] * rs[bj][1]; } }
    }
};
struct EpiSoftmax {
    static constexpr bool PERM = true, AFTER_DRAIN = true;
    bf16_t* P; int ldc; long sCb, sCh; int nH;
    __device__ __forceinline__ void fused(f32x4 (&acc)[2][2][4][2], const Unit& u, int wr, int wc, int fr, int fq, PG8_LAS unsigned char* lds, int wid, int lane) const {
        PG8_LAS float* Pm = (PG8_LAS float*)lds;
        PG8_LAS float* Ps = (PG8_LAS float*)(lds + 4096);
#pragma unroll
        for (int ai = 0; ai < 2; ++ai)
#pragma unroll
            for (int m = 0; m < 4; ++m) { float mx = -3.0e38f;
#pragma unroll
                for (int bj = 0; bj < 2; ++bj)
#pragma unroll
                    for (int n = 0; n < 2; ++n) { const f32x4 x = acc[ai][bj][m][n]; mx = fmaxf(mx, fmaxf(fmaxf(x[0], x[1]), fmaxf(x[2], x[3]))); }
                mx = fmaxf(mx, __shfl_xor(mx, 16)); mx = fmaxf(mx, __shfl_xor(mx, 32));
                if (fq == 0) Pm[(ai * HALF + wr * 64 + m * 16 + fr) * 4 + wc] = mx; }
        asm volatile("s_waitcnt lgkmcnt(0)" ::: "memory"); __builtin_amdgcn_s_barrier(); asm volatile("" ::: "memory");
#pragma unroll
        for (int ai = 0; ai < 2; ++ai)
#pragma unroll
            for (int m = 0; m < 4; ++m) { const int r = ai * HALF + wr * 64 + m * 16 + fr;
                const f32x4 pm4 = *(const PG8_LAS f32x4*)(Pm + r * 4); const float M = fmaxf(fmaxf(pm4[0], pm4[1]), fmaxf(pm4[2], pm4[3])); float s = 0.f;
#pragma unroll
                for (int bj = 0; bj < 2; ++bj)
#pragma unroll
                    for (int n = 0; n < 2; ++n) { f32x4 x = acc[ai][bj][m][n];
#pragma unroll
                        for (int e = 0; e < 4; ++e) { x[e] = __builtin_amdgcn_exp2f(x[e] - M); s += x[e]; }
                        acc[ai][bj][m][n] = x; }
                s += __shfl_xor(s, 16); s += __shfl_xor(s, 32);
                if (fq == 0) Ps[r * 4 + wc] = s; }
        asm volatile("s_waitcnt lgkmcnt(0)" ::: "memory"); __builtin_amdgcn_s_barrier(); asm volatile("" ::: "memory");
        bf16_t* base = P + (u.z / nH) * sCb + (u.z % nH) * sCh;
        const int row0 = u.pm * BM, col0 = u.pn * BM + wc * 32 + 8 * fq;
#pragma unroll
        for (int ai = 0; ai < 2; ++ai)
#pragma unroll
            for (int m = 0; m < 4; ++m) { const int r = ai * HALF + wr * 64 + m * 16 + fr;
                const f32x4 ps4 = *(const PG8_LAS f32x4*)(Ps + r * 4); const float inv = 1.f / ((ps4[0] + ps4[1]) + (ps4[2] + ps4[3]));
                bf16_t* rowp = base + (size_t)(row0 + r) * ldc + col0;
#pragma unroll
                for (int bj = 0; bj < 2; ++bj) { const f32x4 v0 = acc[ai][bj][m][0] * inv, v1 = acc[ai][bj][m][1] * inv;
                    u32x4 w; w.x = cvt_pk_bf16(v0[0], v0[1]); w.y = cvt_pk_bf16(v0[2], v0[3]); w.z = cvt_pk_bf16(v1[0], v1[1]); w.w = cvt_pk_bf16(v1[2], v1[3]);
                    *(u32x4*)(rowp + bj * HALF) = w; } }
    }
};

template <class Epi, class Sched, bool ALIGN_EPI>
__device__ __forceinline__ void gemm_phase(PG8_LAS unsigned char* lds, const Gemm g, const Sched& S, const Epi& E) {
    const int tid = threadIdx.x, wid = __builtin_amdgcn_readfirstlane(tid >> 6), lane = tid & 63, wr = wid >> 2, wc = wid & 3, fr = lane & 15, fq = lane >> 4;
    const int K = g.K, nt = K / BK;
    unsigned voffA[2], voffB[2];
#pragma unroll
    for (int i = 0; i < 2; ++i) { int R, C; stage_rc(tid * 16 + i * 8192, R, C); const int Rb = Epi::PERM ? ((R & ~31) + perm32(R & 31)) : R;
        voffA[i] = (unsigned)(R * g.lda + C) * 2u; voffB[i] = (unsigned)(Rb * g.ldb + C) * 2u; }
    const size_t kstep = (size_t)(BK * 2);
    const size_t hsA = (size_t)HALF * g.lda * 2, hsB = (size_t)HALF * g.ldb * 2;
    const unsigned ldsw = (unsigned)wid * 1024u;
    const int aoff = lds_byte(wr * 64 + fr, fq * 8), boff = lds_byte(wc * 32 + fr, fq * 8);
#define PG8_SA(b, h) (((b) * 2 + (h)) * HTB)
#define PG8_SB(b, h) ((4 + (b) * 2 + (h)) * HTB)
#define PG8_STAGE(bufoff, gbase, voff) do { _Pragma("unroll") for (int _i = 0; _i < 2; ++_i) \
        __builtin_amdgcn_global_load_lds((const unsigned*)((const char*)(gbase) + (voff)[_i]), (PG8_LAS unsigned*)(lds + (bufoff) + ldsw + _i * 8192), 16, 0, 0); } while (0)
#define PG8_LDA(dst, b, h) do { _Pragma("unroll") for (int m = 0; m < 4; ++m) _Pragma("unroll") for (int k = 0; k < 2; ++k) dst[m][k] = *(const PG8_LAS bf16x8*)(lds + PG8_SA(b, h) + aoff + m * 2048 + k * 1024); } while (0)
#define PG8_LDB(dst, b, h) do { _Pragma("unroll") for (int n = 0; n < 2; ++n) _Pragma("unroll") for (int k = 0; k < 2; ++k) dst[n][k] = *(const PG8_LAS bf16x8*)(lds + PG8_SB(b, h) + boff + n * 2048 + k * 1024); } while (0)
#define PG8_MMA(ai, bj, At, Bt) do { __builtin_amdgcn_s_setprio(1); _Pragma("unroll") for (int m = 0; m < 4; ++m) _Pragma("unroll") for (int n = 0; n < 2; ++n) _Pragma("unroll") for (int k = 0; k < 2; ++k) \
        acc[ai][bj][m][n] = __builtin_amdgcn_mfma_f32_16x16x32_bf16(Bt[n][k], At[m][k], acc[ai][bj][m][n], 0, 0, 0); __builtin_amdgcn_s_setprio(0); } while (0)
#define PG8_WAIT_V(n) asm volatile("s_waitcnt vmcnt(" #n ")" ::: "memory")
#define PG8_WAIT_L(n) asm volatile("s_waitcnt lgkmcnt(" #n ")" ::: "memory")
#define PG8_BAR __builtin_amdgcn_s_barrier()
#define PG8_SCHED __builtin_amdgcn_sched_barrier(0)
    Unit cur, nxt; int ui = 0;
    if (!S.next(0, cur)) return;
    f32x4 acc[2][2][4][2];
#pragma unroll
    for (int a = 0; a < 2; ++a)
#pragma unroll
        for (int b = 0; b < 2; ++b)
#pragma unroll
            for (int m = 0; m < 4; ++m)
#pragma unroll
                for (int n = 0; n < 2; ++n) acc[a][b][m][n] = (f32x4){0.f, 0.f, 0.f, 0.f};
    bf16x8 At[4][2], B0[2][2], B1[2][2];
    const char* cA = (const char*)g.A + (size_t)cur.aoff * 2; const char* cB = (const char*)g.Bt + (size_t)cur.boff * 2;
    S.a_ready(cur);
    PG8_STAGE(PG8_SB(0, 0), cB, voffB); PG8_STAGE(PG8_SB(0, 1), cB + hsB, voffB); PG8_STAGE(PG8_SA(0, 0), cA, voffA); PG8_STAGE(PG8_SA(0, 1), cA + hsA, voffA);
    if (wr == 1) PG8_BAR;
    PG8_WAIT_V(2); PG8_BAR;
    PG8_STAGE(PG8_SB(1, 0), cB + kstep, voffB); PG8_STAGE(PG8_SA(1, 0), cA + kstep, voffA); PG8_STAGE(PG8_SB(1, 1), cB + hsB + kstep, voffB);
    PG8_WAIT_V(6); PG8_BAR;
    for (;;) {
        const bool has_next = S.next(ui + 1, nxt);
        const char* nA = has_next ? (const char*)g.A + (size_t)nxt.aoff * 2 : cA; const char* nB = has_next ? (const char*)g.Bt + (size_t)nxt.boff * 2 : cB;
        for (int t = 0; t < nt; t += 2) {
            const bool last = (t == nt - 2);
            const char* a1 = cA + (size_t)(t + 1) * kstep;
            const char* a2 = last ? nA : cA + (size_t)(t + 2) * kstep; const char* b2 = last ? nB : cB + (size_t)(t + 2) * kstep;
            const char* a3 = a2 + kstep; const char* b3 = b2 + kstep;
            if (last && has_next) S.a_ready(nxt);
            PG8_LDB(B0, 0, 0); PG8_LDB(B1, 0, 1); PG8_SCHED; PG8_LDA(At, 0, 0); PG8_STAGE(PG8_SA(1, 1), a1 + hsA, voffA);
            PG8_WAIT_V(8); PG8_WAIT_L(0); PG8_BAR; PG8_MMA(0, 0, At, B0); PG8_MMA(0, 1, At, B1); PG8_BAR; PG8_SCHED;
            PG8_LDA(At, 0, 1); PG8_STAGE(PG8_SB(0, 0), b2, voffB); PG8_STAGE(PG8_SB(0, 1), b2 + hsB, voffB); PG8_STAGE(PG8_SA(0, 0), a2, voffA);
            PG8_WAIT_V(8); PG8_WAIT_L(0); PG8_BAR; PG8_MMA(1, 0, At, B0); PG8_MMA(1, 1, At, B1); PG8_BAR; PG8_SCHED;
            PG8_LDB(B0, 1, 0); PG8_LDB(B1, 1, 1); PG8_SCHED; PG8_LDA(At, 1, 0); PG8_STAGE(PG8_SA(0, 1), a2 + hsA, voffA);
            PG8_WAIT_V(8); PG8_WAIT_L(0); PG8_BAR; PG8_MMA(0, 0, At, B0); PG8_MMA(0, 1, At, B1); PG8_BAR; PG8_SCHED;
            PG8_LDA(At, 1, 1); PG8_STAGE(PG8_SB(1, 0), b3, voffB); PG8_STAGE(PG8_SB(1, 1), b3 + hsB, voffB); PG8_STAGE(PG8_SA(1, 0), a3, voffA);
            PG8_WAIT_V(8); PG8_WAIT_L(0); PG8_BAR; PG8_MMA(1, 0, At, B0); PG8_MMA(1, 1, At, B1); PG8_BAR; PG8_SCHED;
        }
        if constexpr (ALIGN_EPI) { if (wr == 0) PG8_BAR; }
        if constexpr (!Epi::AFTER_DRAIN) { E(acc, cur, wr, wc, fr, fq); S.done(cur); }
        if (!has_next) break;
#pragma unroll
        for (int a = 0; a < 2; ++a)
#pragma unroll
            for (int b = 0; b < 2; ++b)
#pragma unroll
                for (int m = 0; m < 4; ++m)
#pragma unroll
                    for (int n = 0; n < 2; ++n) acc[a][b][m][n] = (f32x4){0.f, 0.f, 0.f, 0.f};
        cur = nxt; cA = nA; cB = nB; ++ui;
        if constexpr (ALIGN_EPI) { if (wr == 1) PG8_BAR; }
    }
    PG8_WAIT_V(0);
    if constexpr (!ALIGN_EPI) { if (wr == 0) PG8_BAR; }
    PG8_BAR;
    if constexpr (Epi::AFTER_DRAIN) { E.fused(acc, cur, wr, wc, fr, fq, lds, wid, lane); S.done(cur); }
#undef PG8_SA
#undef PG8_SB
#undef PG8_STAGE
#undef PG8_LDA
#undef PG8_LDB
#undef PG8_MMA
#undef PG8_WAIT_V
#undef PG8_WAIT_L
#undef PG8_BAR
#undef PG8_SCHED
}
}

namespace fox {
typedef unsigned short bf16_t;
typedef short bf16x8 __attribute__((ext_vector_type(8)));
typedef short s16x4 __attribute__((ext_vector_type(4)));
typedef float f32x16 __attribute__((ext_vector_type(16)));
typedef float f32x4 __attribute__((ext_vector_type(4)));
typedef unsigned u32x4 __attribute__((ext_vector_type(4)));
constexpr int D = 128, NW = 8, QBLK = 32, KVBLK = 64, QB = NW * QBLK;
constexpr int SHM_V = KVBLK * D * 2, SHM_K = KVBLK * D * 2;
constexpr int LDS_C = 2 * SHM_V + 2 * SHM_K + NW * 64 * 4;
constexpr int LDS_BYTES = LDS_C + SEQ * 4;
constexpr int QP = 4096, OP = 2048;
constexpr float THR = 24.f;
#define KSWZ(row, colB) ((row) * 256 + ((colB) ^ (((row) & 7) << 4)))
#define SBAR() __builtin_amdgcn_sched_barrier(0)
__device__ __forceinline__ int v_st(int k, int c) { const int kk = (k & ~0xC) | ((k & 4) << 1) | ((k & 8) >> 1); return ((kk >> 3) * 4 + (c >> 5)) * 512 + ((kk & 7) * 32 + (c & 31)) * 2; }
__device__ __forceinline__ int v_rd_base(int lane) { return ((lane & 3) << 3) | (((lane >> 2) & 3) << 6) | (((lane >> 4) & 1) << 5) | (((lane >> 5) & 1) << 8); }
constexpr int v_rd_off(int d0, int ks, int half) { return d0 * 512 + ks * 4096 + half * 2048; }
__device__ __forceinline__ int crow(int r, int hi) { return (r & 3) + 8 * (r >> 2) + 4 * hi; }
__device__ __forceinline__ unsigned cvtpk(float lo, float hi) { unsigned r; asm volatile("v_cvt_pk_bf16_f32 %0, %1, %2" : "=v"(r) : "v"(lo), "v"(hi)); return r; }
__device__ __forceinline__ bf16x8 load8(const bf16_t* p) { return *reinterpret_cast<const bf16x8*>(p); }
__device__ __forceinline__ void mask_tile(f32x16& p0, f32x16& p1, int dq) {
    const float NEG = -__builtin_inff();
#pragma unroll
    for (int r = 0; r < 16; ++r) { const int c = (r & 3) + 8 * (r >> 2); if (dq - c < 0) p0[r] = NEG; if (dq - c - 32 < 0) p1[r] = NEG; }
}
__device__ __forceinline__ void bias_tile(f32x16& p0, f32x16& p1, const float* cb) {
#pragma unroll
    for (int i = 0; i < 4; ++i) { const f32x4 c0 = *(const f32x4*)(cb + 8 * i), c1 = *(const f32x4*)(cb + 32 + 8 * i);
#pragma unroll
        for (int j = 0; j < 4; ++j) { p0[4 * i + j] -= c0[j]; p1[4 * i + j] -= c1[j]; } }
}
__device__ __forceinline__ void partialSM(f32x16& p0, f32x16& p1, float& m_reg, float& mn, float& alpha) {
    float pmax = p0[0]; for (int r = 1; r < 16; ++r) pmax = fmaxf(pmax, p0[r]); for (int r = 0; r < 16; ++r) pmax = fmaxf(pmax, p1[r]);
    { auto rr = __builtin_amdgcn_permlane32_swap(__float_as_uint(pmax), __float_as_uint(pmax), false, false);
      pmax = fmaxf(__uint_as_float(rr[0]), __uint_as_float(rr[1])); }
    if (__builtin_expect(__all((pmax - m_reg) <= THR), 1)) { mn = m_reg; alpha = 1.f; }
    else { mn = fmaxf(m_reg, pmax); alpha = __builtin_amdgcn_exp2f(m_reg - mn); m_reg = mn; }
    for (int r = 0; r < 16; ++r) p0[r] = p0[r] - mn; for (int r = 0; r < 16; ++r) p1[r] = p1[r] - mn;
    for (int r = 0; r < 16; ++r) p0[r] = __builtin_amdgcn_exp2f(p0[r]);
}
__device__ __forceinline__ void finishSM(f32x16& p0, f32x16& p1, float alpha, float& l_reg, bf16x8& pa0, bf16x8& pa1, bf16x8& pa2, bf16x8& pa3) {
    for (int r = 0; r < 16; ++r) p1[r] = __builtin_amdgcn_exp2f(p1[r]);
    float ps = 0; for (int r = 0; r < 16; ++r) ps += p0[r]; for (int r = 0; r < 16; ++r) ps += p1[r];
    { auto rr = __builtin_amdgcn_permlane32_swap(__float_as_uint(ps), __float_as_uint(ps), false, false);
      ps = __uint_as_float(rr[0]) + __uint_as_float(rr[1]); }
    l_reg = l_reg * alpha + ps;
#define PK4(P, B_, OUT) do { unsigned a0 = cvtpk(P[B_+0], P[B_+1]), a1 = cvtpk(P[B_+2], P[B_+3]);                          \
        unsigned b0 = cvtpk(P[B_+4], P[B_+5]), b1 = cvtpk(P[B_+6], P[B_+7]);                                             \
        auto r0 = __builtin_amdgcn_permlane32_swap(a0, b0, false, false); auto r1 = __builtin_amdgcn_permlane32_swap(a1, b1, false, false); \
        u32x4 w = {r0[0], r1[0], r0[1], r1[1]}; OUT = *reinterpret_cast<bf16x8*>(&w); } while (0)
    PK4(p0, 0, pa0); PK4(p0, 8, pa1); PK4(p1, 0, pa2); PK4(p1, 8, pa3);
#undef PK4
}
template <int KB>
__device__ __forceinline__ void qkt(f32x16& p0, f32x16& p1, const char* K_lds, int r32, int hi, const bf16x8* qr) {
    p0 = f32x16{}; p1 = f32x16{};
    const char* kb[4];
#pragma unroll
    for (int dd = 0; dd < 4; ++dd) kb[dd] = K_lds + KB * SHM_K + KSWZ(r32, (dd * 16 + hi * 8) * 2);
#pragma unroll
    for (int d0 = 0; d0 < 8; ++d0) { const char* a = kb[d0 & 3] + (d0 >> 2) * 128;
        bf16x8 b0 = *reinterpret_cast<const bf16x8*>(a);
        bf16x8 b1 = *reinterpret_cast<const bf16x8*>(a + 32 * 256);
        p0 = __builtin_amdgcn_mfma_f32_32x32x16_bf16(b0, qr[d0], p0, 0, 0, 0);
        p1 = __builtin_amdgcn_mfma_f32_32x32x16_bf16(b1, qr[d0], p1, 0, 0, 0); }
}
template <int VB>
__device__ __forceinline__ void pv_tile(f32x16* o, int vb0, bf16x8 pa0, bf16x8 pa1, bf16x8 pa2, bf16x8 pa3) {
#define TRRD(dst, off) asm volatile("ds_read_b64_tr_b16 %0, %1 offset:%2" : "=&v"(dst) : "v"(vb0), "i"(off) : "memory")
#define PV_D0(d0) do { s16x4 l0, l1, l2, l3, h0, h1, h2, h3; constexpr int b_ = VB * SHM_V + v_rd_off(d0, 0, 0); \
        TRRD(l0, b_); TRRD(h0, b_ + 2048); TRRD(l1, b_ + 4096); TRRD(h1, b_ + 6144); TRRD(l2, b_ + 8192); TRRD(h2, b_ + 10240); TRRD(l3, b_ + 12288); TRRD(h3, b_ + 14336); \
        asm volatile("s_waitcnt lgkmcnt(0)" ::: "memory"); SBAR();   \
        o[d0] = __builtin_amdgcn_mfma_f32_32x32x16_bf16(pa0, (bf16x8){l0[0], l0[1], l0[2], l0[3], h0[0], h0[1], h0[2], h0[3]}, o[d0], 0, 0, 0);   \
        o[d0] = __builtin_amdgcn_mfma_f32_32x32x16_bf16(pa1, (bf16x8){l1[0], l1[1], l1[2], l1[3], h1[0], h1[1], h1[2], h1[3]}, o[d0], 0, 0, 0);   \
        o[d0] = __builtin_amdgcn_mfma_f32_32x32x16_bf16(pa2, (bf16x8){l2[0], l2[1], l2[2], l2[3], h2[0], h2[1], h2[2], h2[3]}, o[d0], 0, 0, 0);   \
        o[d0] = __builtin_amdgcn_mfma_f32_32x32x16_bf16(pa3, (bf16x8){l3[0], l3[1], l3[2], l3[3], h3[0], h3[1], h3[2], h3[3]}, o[d0], 0, 0, 0); } while (0)
    PV_D0(0); PV_D0(1); PV_D0(2); PV_D0(3);
#undef PV_D0
#undef TRRD
}
struct BlockRef { const bf16_t* Q; const bf16_t* K; const bf16_t* V; bf16_t* O; int P0; };
struct Seam { bf16x8 qr[8]; bf16x8 st_v0, st_v1, st_k0, st_k1; };
#define ROW(p, k0, rr) ((p) + (size_t)((k0) + (rr)) * QP + sc)
#define VMW() asm volatile("s_waitcnt vmcnt(0)" ::: "memory")
#define VMWN(n) asm volatile("s_waitcnt vmcnt(%0)" :: "i"(n) : "memory")
#define SLOAD_H(Kp, Vp, k0) do { S.st_v0 = load8(ROW(Vp, k0, sr)); S.st_v1 = load8(ROW(Vp, k0, 32 + sr)); S.st_k0 = load8(ROW(Kp, k0, sr)); S.st_k1 = load8(ROW(Kp, k0, 32 + sr)); } while (0)
#define SWRITE_HK(bf) do { *(bf16x8*)(K_lds + (bf) * SHM_K + kws) = S.st_k0; *(bf16x8*)(K_lds + (bf) * SHM_K + kws + 32 * 256) = S.st_k1; } while (0)
#define SWRITE_HV(bf) do { *(bf16x8*)(V_lds + (bf) * SHM_V + vst0) = S.st_v0; *(bf16x8*)(V_lds + (bf) * SHM_V + vst1) = S.st_v1; } while (0)
#define SWRITE_H(bf) do { SWRITE_HV(bf); SWRITE_HK(bf); } while (0)
__device__ __forceinline__ void prime(const BlockRef& cur, char* lds, Seam& S) {
    const int tid = threadIdx.x, wid = __builtin_amdgcn_readfirstlane(tid >> 6), lane = tid & 63, r32 = lane & 31, hi = lane >> 5;
    const int sr = tid >> 4, sc = (tid & 15) * 8, kws = KSWZ(sr, sc * 2); char* K_lds = lds + 2 * SHM_V;
    for (int d0 = 0; d0 < 8; ++d0) S.qr[d0] = load8(cur.Q + (size_t)(wid * QBLK + r32) * QP + d0 * 16 + hi * 8);
    SLOAD_H(cur.K, cur.V, 0); VMW(); SWRITE_HK(0);
    __syncthreads();
}
__device__ __forceinline__ void block(const BlockRef& cur, const BlockRef& nxt, char* lds, Seam& S) {
    const int tid = threadIdx.x, wid = __builtin_amdgcn_readfirstlane(tid >> 6), lane = tid & 63, r32 = lane & 31, hi = lane >> 5;
    const int NT = (cur.P0 + QB - 1) / KVBLK + 1;
    const int qlo = cur.P0 + wid * QBLK, qm = qlo + r32 - 4 * hi;
    char* V_lds = lds; char* K_lds = lds + 2 * SHM_V;
    float* ws = (float*)(lds + 2 * SHM_V + 2 * SHM_K) + wid * 64; float* li_l = ws, * al_l = ws + 32;
    const float* c_lds = (const float*)(lds + LDS_C) + 4 * hi;
    float m_reg = -1e30f, l_reg = 0; f32x16 o[4] = {};
    const int sr = tid >> 4, sc = (tid & 15) * 8, vst0 = v_st(sr, sc), vst1 = v_st(32 + sr, sc), kws = KSWZ(sr, sc * 2);
    const int vb0 = (int)(uintptr_t)V_lds + v_rd_base(lane);
    const bf16_t* Kh = cur.K; const bf16_t* Vh = cur.V;
#define RESC(a) do { if (__any((a) < 1.f)) { if (hi == 0) al_l[r32] = (a); asm volatile("s_waitcnt lgkmcnt(0)" ::: "memory");              \
                     for (int d_ = 0; d_ < 4; ++d_) for (int r = 0; r < 16; ++r) o[d_][r] *= al_l[crow(r, hi)]; } } while (0)
#define KBASE(t) ((t) * KVBLK)
#define MASKT(P0_, P1_, t) do { const int kb_ = KBASE(t); bias_tile(P0_, P1_, c_lds + kb_); if (kb_ + KVBLK - 1 > qlo) mask_tile(P0_, P1_, qm - kb_); } while (0)
#define SEAM_K0() do { VMWN(8); SWRITE_HK(0); SBAR(); } while (0)
    f32x16 pA0, pA1, pB0, pB1; float mnA, mnB, alA, alB; bf16x8 pa0, pa1, pa2, pa3;
    SWRITE_HV(0); SBAR();
    if (NT > 1) { SLOAD_H(Kh, Vh, KBASE(1)); }
    SBAR(); qkt<0>(pA0, pA1, K_lds, r32, hi, S.qr);
    MASKT(pA0, pA1, 0); partialSM(pA0, pA1, m_reg, mnA, alA);
    if (NT > 1) { VMW(); SWRITE_H(1); }
    __syncthreads();
#define HALF_STEP(PX0, PX1, mnX, alX, PY0, PY1, alY, t, KB, VB, SB) do {                                                      \
        SBAR(); qkt<KB>(PX0, PX1, K_lds, r32, hi, S.qr);                                                                     \
        finishSM(PY0, PY1, alY, l_reg, pa0, pa1, pa2, pa3); SBAR();                                                           \
        if ((t) + 1 < NT) { SLOAD_H(Kh, Vh, KBASE((t) + 1)); SBAR(); }                                                        \
        pv_tile<VB>(o, vb0, pa0, pa1, pa2, pa3); MASKT(PX0, PX1, (t)); partialSM(PX0, PX1, m_reg, mnX, alX);                 \
        __syncthreads();                                                                                                      \
        if ((t) + 1 < NT) { VMW(); SWRITE_H(SB); }                                                                            \
        RESC(alX); __syncthreads(); } while (0)
    for (int t = 1; t + 1 < NT; t += 2) {
        HALF_STEP(pB0, pB1, mnB, alB, pA0, pA1, alA, t, 1, 0, 0);
        HALF_STEP(pA0, pA1, mnA, alA, pB0, pB1, alB, t + 1, 0, 1, 1);
    }
    const bool even = (NT & 1) == 0;
    if (even) { SBAR(); qkt<1>(pB0, pB1, K_lds, r32, hi, S.qr); SBAR(); }
    SLOAD_H(nxt.K, nxt.V, 0); SBAR();
#pragma unroll
    for (int d0 = 0; d0 < 8; ++d0) S.qr[d0] = load8(nxt.Q + (size_t)(wid * QBLK + r32) * QP + d0 * 16 + hi * 8);
    SBAR();
    finishSM(pA0, pA1, alA, l_reg, pa0, pa1, pa2, pa3); SBAR();
    pv_tile<0>(o, vb0, pa0, pa1, pa2, pa3);
    if (even) { MASKT(pB0, pB1, NT - 1); partialSM(pB0, pB1, m_reg, mnB, alB); __syncthreads(); RESC(alB);
        finishSM(pB0, pB1, alB, l_reg, pa0, pa1, pa2, pa3); SBAR(); pv_tile<1>(o, vb0, pa0, pa1, pa2, pa3); }
    SBAR(); SEAM_K0();
    if (hi == 0) li_l[r32] = l_reg; asm volatile("s_waitcnt lgkmcnt(0)" ::: "memory");
    float rli[16];
#pragma unroll
    for (int r = 0; r < 16; ++r) rli[r] = __builtin_amdgcn_rcpf(li_l[crow(r, hi)]);
    bf16_t* Ow = cur.O + (size_t)(wid * QBLK) * OP;
#pragma unroll
    for (int r = 0; r < 16; ++r) { const int orow = crow(r, hi);
#pragma unroll
        for (int d0 = 0; d0 < 4; ++d0) { const float v = o[d0][r] * rli[r];
            const float vn = __shfl_xor(v, 1);
            if ((r32 & 1) == 0) *(unsigned*)(Ow + (size_t)orow * OP + d0 * 32 + r32) = cvtpk(v, vn); } }
    __syncthreads();
#undef RESC
#undef KBASE
#undef MASKT
#undef SEAM_K0
#undef HALF_STEP
}
#undef ROW
#undef VMW
#undef VMWN
#undef SLOAD_H
#undef SWRITE_HK
#undef SWRITE_HV
#undef SWRITE_H
#undef KSWZ
#undef SBAR
}

constexpr int NWAVES = 8, NTHREADS = 512;
constexpr int LDS_BYTES = 147456;
constexpr int LDS_MISC = 145408;
constexpr size_t MiB = 1u << 20;
constexpr size_t WS_CTL = 0, CTL_ZERO_BYTES = 1 * MiB;
constexpr int CW_QUEUE = 64;
constexpr int CW_BAR = 4096;
constexpr size_t CTL_SS1 = 256 * 1024, CTL_SS2 = 320 * 1024;
constexpr size_t WS_LF = 1 * MiB;
constexpr size_t WS_SU = 1 * MiB + 512 * 1024, WS_SV = 1 * MiB + 640 * 1024;
constexpr size_t WS_WIN = 2 * MiB, WS_WO1 = 18 * MiB, WS_WO2 = 26 * MiB, WS_WQ = 34 * MiB, WS_WK = 42 * MiB, WS_WV = 50 * MiB, WS_WO = 58 * MiB;
constexpr size_t WS_WPQ = 66 * MiB, WS_AEXP = 74 * MiB, WS_WSC = 82 * MiB, WS_PB = 90 * MiB, WS_MN = 91 * MiB, WS_KX = 93 * MiB, WS_VXT = 95 * MiB;
constexpr size_t WS_UB = 98 * MiB, WS_VB = 130 * MiB, WS_XN = 226 * MiB, WS_PROJ = 258 * MiB, WS_AMIX = 322 * MiB, WS_H = 354 * MiB, WS_HB = 418 * MiB, WS_P = 450 * MiB, WS_END = 466 * MiB;

#define GAS __attribute__((address_space(1)))
#define LAS __attribute__((address_space(3)))
typedef unsigned short bf16;
typedef unsigned v4u __attribute__((ext_vector_type(4)));
typedef unsigned v2u __attribute__((ext_vector_type(2)));
typedef float f32x4 __attribute__((ext_vector_type(4)));
typedef __bf16 bf16x2_t __attribute__((ext_vector_type(2)));
#define LDS_WAIT() asm volatile("s_waitcnt lgkmcnt(0)" ::: "memory")
__device__ __forceinline__ unsigned f2bf(float f) { unsigned u = __builtin_bit_cast(unsigned, f); return (u + 0x7fffu + ((u >> 16) & 1u)) >> 16; }
__device__ __forceinline__ unsigned pk2(float lo, float hi) { return f2bf(lo) | (f2bf(hi) << 16); }
__device__ __forceinline__ float wave_sum(float v) {
#pragma unroll
    for (int o = 1; o < 64; o <<= 1) v += __shfl_xor(v, o);
    return v;
}

#define XB_TMO      128
#define XB_XCNT(j)  (256  + 64 * (j))
#define XB_XSUB(j)  (1280 + 64 * (j))
#define XB_XGEN(j)  (2304 + 64 * (j))
#define XB_TOP      3328
#define XB_TOPGEN   3392
#define XCD_BAR_WORDS 3456
#define XB_SPIN_CAP (1u << 22)
__device__ __forceinline__ unsigned xb_ld(unsigned* p)              { return __hip_atomic_load(p, __ATOMIC_RELAXED, __HIP_MEMORY_SCOPE_AGENT); }
__device__ __forceinline__ unsigned xb_add(unsigned* p, unsigned v) { return __hip_atomic_fetch_add(p, v, __ATOMIC_RELAXED, __HIP_MEMORY_SCOPE_AGENT); }
__device__ __forceinline__ unsigned xb_xcc_id() { return (unsigned)__builtin_amdgcn_s_getreg((3 << 11) | 20) & 0xFu; }
#define XB_SPIN(cond, bar) do { unsigned _sp = 0; while (cond) { __builtin_amdgcn_s_sleep(1); \
    if ((++_sp & 255u) == 0u) { if (xb_ld(&(bar)[XB_TMO])) break; if (_sp > XB_SPIN_CAP) { atomicAdd(&(bar)[XB_TMO], 1u); break; } } } } while (0)
struct XcdBarrier { unsigned* bar; unsigned x; volatile LAS unsigned* st; };
__device__ __forceinline__ XcdBarrier xcd_barrier_post(unsigned* bar, volatile LAS unsigned* st) {
    XcdBarrier b; b.bar = bar; b.x = xb_xcc_id(); b.st = st;
    if (threadIdx.x == 0) (void)xb_add(&bar[XB_XCNT(b.x)], 1u);
    return b;
}
__device__ __forceinline__ void xcd_barrier_complete(unsigned* bar, unsigned x, unsigned& nloc, unsigned& nx) {
    const unsigned G = gridDim.x * gridDim.y * gridDim.z;
    unsigned sum, cnt, mine, sp = 0u;
    for (;;) {
        sum = 0u; cnt = 0u; mine = 0u;
#pragma unroll
        for (unsigned j = 0; j < 16; ++j) { const unsigned c = xb_ld(&bar[XB_XCNT(j)]); sum += c; cnt += (c > 0u) ? 1u : 0u; mine = (j == x) ? c : mine; }
        if (sum == G) break;
        __builtin_amdgcn_s_sleep(1);
        if ((++sp & 255u) == 0u) { if (xb_ld(&bar[XB_TMO])) break; if (sp > XB_SPIN_CAP) { atomicAdd(&bar[XB_TMO], 1u); break; } }
    }
    nloc = mine > 0u ? mine : 1u; nx = cnt > 0u ? cnt : 1u;
}
__device__ __forceinline__ void xcd_barrier(const XcdBarrier& b) {
    asm volatile("s_waitcnt vmcnt(0)" ::: "memory");
    __syncthreads();
    if (threadIdx.x == 0) {
        unsigned* bar = b.bar;
        __builtin_amdgcn_s_waitcnt(0);
        unsigned nloc = b.st[0], nx = b.st[1];
        if (nloc == 0u) { xcd_barrier_complete(bar, b.x, nloc, nx); b.st[0] = nloc; b.st[1] = nx; }
        const unsigned old = xb_add(&bar[XB_XSUB(b.x)], 1u);
        const unsigned gen = old / nloc;
        if (old + 1u == (gen + 1u) * nloc) {
            __builtin_amdgcn_fence(__ATOMIC_RELEASE, "agent");
            asm volatile("s_waitcnt vmcnt(0)" ::: "memory");
            const unsigned og = xb_add(&bar[XB_TOP], 1u);
            const unsigned tg = og / nx;
            if (og + 1u == (tg + 1u) * nx) xb_add(&bar[XB_TOPGEN], 1u);
            else XB_SPIN(xb_ld(&bar[XB_TOPGEN]) == tg, bar);
            __builtin_amdgcn_fence(__ATOMIC_ACQUIRE, "agent");
            xb_add(&bar[XB_XGEN(b.x)], 1u);
            asm volatile("s_waitcnt vmcnt(0)" ::: "memory");
        } else {
            XB_SPIN(xb_ld(&bar[XB_XGEN(b.x)]) == gen, bar);
            __builtin_amdgcn_fence(__ATOMIC_ACQUIRE, "agent");
            asm volatile("s_waitcnt vmcnt(0)" ::: "memory");
        }
    }
    __syncthreads();
}

struct Args { const float* in[20]; float* out; unsigned char* ws; int ph_lo, ph_hi; int one_launch, pad; };

__device__ __forceinline__ void p0_transpose_item(const float* W, int ldw, int nblk, const float* g, bf16* WT, bf16* WT2, int k2lo, int ldt, LAS float* scr, int item, int lane) {
    const int kb = item / nblk, nb = item % nblk, k0 = 64 * kb, n0 = 32 * nb;
#pragma unroll 8
    for (int i = 0; i < 32; ++i) { const int kk = 2 * i + (lane >> 5); float v = W[(size_t)(k0 + kk) * ldw + n0 + (lane & 31)]; if (g) v *= g[k0 + kk]; scr[kk * 33 + (lane & 31)] = v; }
    LDS_WAIT(); asm volatile("" ::: "memory");
    const int c = lane & 7;
#pragma unroll
    for (int j = 0; j < 4; ++j) { const int n = (lane >> 3) + 8 * j; const LAS float* s = scr + (8 * c) * 33 + n;
        v4u o; o.x = pk2(s[0 * 33], s[1 * 33]); o.y = pk2(s[2 * 33], s[3 * 33]); o.z = pk2(s[4 * 33], s[5 * 33]); o.w = pk2(s[6 * 33], s[7 * 33]);
        *(GAS v4u*)(WT + (size_t)(n0 + n) * ldt + k0 + 8 * c) = o;
        if (WT2 && k0 >= k2lo) *(GAS v4u*)(WT2 + (size_t)(n0 + n) * ldt + k0 + 8 * c) = o; }
    LDS_WAIT(); asm volatile("" ::: "memory");
}
__device__ __forceinline__ v4u cvt8(const float* p, float s) {
    const f32x4 a = *(const f32x4*)p, b = *(const f32x4*)(p + 4);
    v4u o; o.x = pk2(a[0] * s, a[1] * s); o.y = pk2(a[2] * s, a[3] * s); o.z = pk2(b[0] * s, b[1] * s); o.w = pk2(b[2] * s, b[3] * s); return o;
}

__device__ __forceinline__ float gelu_f(float v) {
    const float av = fabsf(v), t = __builtin_amdgcn_rcpf(av * 0.2316418882f + 1.0f);
    float q = t * 0.5307027145f + (-0.7265760135f); q = q * t + 0.7107068705f; q = q * t + (-0.142248368f); q = q * t + 0.127414796f; q = q * t;
    const float e = __builtin_amdgcn_exp2f((v * v) * (-0.72134752044f));
    const float m = v * (q * e);
    return v < 0.f ? m : v - m;
}
__device__ __forceinline__ float dot2bf(unsigned a, unsigned b, float c) { return __builtin_amdgcn_fdot2_f32_bf16(__builtin_bit_cast(bf16x2_t, a), __builtin_bit_cast(bf16x2_t, b), c, false); }
__device__ __forceinline__ unsigned fkey(float f) { const unsigned u = __float_as_uint(f); return (u & 0x80000000u) ? ~u : (u | 0x80000000u); }
__device__ __forceinline__ float fdec(unsigned k) { const unsigned u = (k & 0x80000000u) ? (k & 0x7fffffffu) : ~k; return __uint_as_float(u); }


typedef float f32x2v __attribute__((ext_vector_type(2)));
__device__ __forceinline__ float wave_sum_dpp(float v) {
    v += __builtin_bit_cast(float, __builtin_amdgcn_update_dpp(0, __builtin_bit_cast(int, v), 0xB1, 0xf, 0xf, true));
    v += __builtin_bit_cast(float, __builtin_amdgcn_update_dpp(0, __builtin_bit_cast(int, v), 0x4E, 0xf, 0xf, true));
    v += __builtin_bit_cast(float, __builtin_amdgcn_update_dpp(0, __builtin_bit_cast(int, v), 0x141, 0xf, 0xf, true));
    v += __builtin_bit_cast(float, __builtin_amdgcn_update_dpp(0, __builtin_bit_cast(int, v), 0x140, 0xf, 0xf, true));
    const float a = __builtin_bit_cast(float, __builtin_amdgcn_readlane(__builtin_bit_cast(int, v), 0));
    const float b = __builtin_bit_cast(float, __builtin_amdgcn_readlane(__builtin_bit_cast(int, v), 16));
    const float c = __builtin_bit_cast(float, __builtin_amdgcn_readlane(__builtin_bit_cast(int, v), 32));
    const float d = __builtin_bit_cast(float, __builtin_amdgcn_readlane(__builtin_bit_cast(int, v), 48));
    return (a + b) + (c + d);
}
typedef float v32f __attribute__((ext_vector_type(32)));
typedef float v16f __attribute__((ext_vector_type(16)));
typedef unsigned v6u __attribute__((ext_vector_type(6)));
#ifndef FP6_INTERLEAVED
#define FP6_INTERLEAVED 1
#endif
__device__ __forceinline__ v32f dec_fp6(const v4u a, const v2u b) { const v6u w = {a.x, a.y, a.z, a.w, b.x, b.y}; return __builtin_amdgcn_cvt_scalef32_pk32_f32_fp6(w, 1.0f); }
__device__ __forceinline__ float peer_dot(const v4u ua, const v2u ub, const v32f& xn) {
    const v32f f = dec_fp6(ua, ub); float a0 = 0.f, a1 = 0.f;
#pragma unroll
    for (int i = 0; i < 32; i += 2) { a0 = fmaf(f[i], xn[i], a0); a1 = fmaf(f[i + 1], xn[i + 1], a1); }
    return a0 + a1;
}
__device__ __forceinline__ void peer_axpy(const v4u va, const v2u vb, float w, v32f& oacc) {
    const v32f f = dec_fp6(va, vb);
#pragma unroll
    for (int i = 0; i < 32; ++i) oacc[i] = fmaf(w, f[i], oacc[i]);
}


__device__ __forceinline__ void conv_row_fp6(const float* srow, unsigned char* drow, float* scale_out, int lane) {
    const float* src = srow + lane * 4;
    f32x4 v[8]; float am = 0.f;
#pragma unroll
    for (int q = 0; q < 8; ++q) { v[q] = *(const GAS f32x4*)(src + q * 256);
        am = fmaxf(am, fmaxf(fmaxf(fabsf(v[q][0]), fabsf(v[q][1])), fmaxf(fabsf(v[q][2]), fabsf(v[q][3])))); }
#pragma unroll
    for (int o = 1; o < 64; o <<= 1) am = fmaxf(am, __shfl_xor(am, o));
    int ex = 0; if (am > 0.f) { (void)frexpf(am, &ex); ex = 3 - ex; if (ldexpf(am, ex) > 7.5f) ex -= 1; }
    const float sc = ldexpf(1.f, ex);
    if (lane == 0) *scale_out = ldexpf(1.f, -ex);
    v16f xa, xb;
#pragma unroll
    for (int i = 0; i < 16; ++i) { xa[i] = v[(2 * i) >> 2][(2 * i) & 3] * sc; xb[i] = v[(2 * i + 1) >> 2][(2 * i + 1) & 3] * sc; }
    const v6u w = __builtin_amdgcn_cvt_scalef32_2xpk16_fp6_f32(xa, xb, 1.0f);
    *(GAS v4u*)(drow + lane * 16) = (v4u){w[0], w[1], w[2], w[3]};
    *(GAS v2u*)(drow + 1024 + lane * 8) = (v2u){w[4], w[5]};
}

__global__ void __launch_bounds__(NTHREADS, 2) fwd_kernel(Args args) {
    extern __shared__ __attribute__((aligned(16))) unsigned char lds[];
    LAS unsigned char* ldsL = (LAS unsigned char*)lds;
    volatile LAS unsigned* MISC = (volatile LAS unsigned*)(ldsL + LDS_MISC);
    const int tid = threadIdx.x, lane = tid & 63, wave = __builtin_amdgcn_readfirstlane(tid >> 6);
    const int G = gridDim.x; const int bx = blockIdx.x; const int vcu = (G % 8 == 0) ? (bx % 8) * (G / 8) + bx / 8 : bx;
#define G_ws (args.ws)
#define G_ctl ((unsigned*)(args.ws + WS_CTL))
#define G_x (args.in[0])
#define G_mem (args.in[1])
#define G_mix_norm (args.in[2])
#define G_w_in (args.in[3])
#define G_b_forget (args.in[4])
#define G_pool_w (args.in[5])
#define G_pool_scale (args.in[6])
#define G_w_out (args.in[7])
#define G_xattn_norm (args.in[8])
#define G_mem_norm (args.in[9])
#define G_xwq (args.in[10])
#define G_xwk (args.in[11])
#define G_xwv (args.in[12])
#define G_xwo (args.in[13])
#define G_peer_norm (args.in[14])
#define G_peer_wq (args.in[15])
#define G_sub_keys (args.in[16])
#define G_peer_u (args.in[17])
#define G_peer_v (args.in[18])
#define G_final_norm (args.in[19])
#define G_W_IN ((bf16*)(args.ws + WS_WIN))
#define G_WO1 ((bf16*)(args.ws + WS_WO1))
#define G_WO2 ((bf16*)(args.ws + WS_WO2))
#define G_WQ ((bf16*)(args.ws + WS_WQ))
#define G_WK ((bf16*)(args.ws + WS_WK))
#define G_WV ((bf16*)(args.ws + WS_WV))
#define G_WO ((bf16*)(args.ws + WS_WO))
#define G_WPQ ((bf16*)(args.ws + WS_WPQ))
#define G_AEXP ((bf16*)(args.ws + WS_AEXP))
#define G_WSC ((bf16*)(args.ws + WS_WSC))
#define G_PB ((bf16*)(args.ws + WS_PB))
#define G_MN ((bf16*)(args.ws + WS_MN))
#define G_KX ((bf16*)(args.ws + WS_KX))
#define G_VXT ((bf16*)(args.ws + WS_VXT))
#define G_UB (args.ws + WS_UB)
#define G_VB (args.ws + WS_VB)
#define G_SU ((float*)(args.ws + WS_SU))
#define G_SV ((float*)(args.ws + WS_SV))
#define G_XN ((bf16*)(args.ws + WS_XN))
#define G_QX ((bf16*)(args.ws + WS_XN))
#define G_PROJ ((bf16*)(args.ws + WS_PROJ))
#define G_SCT ((float*)(args.ws + WS_PROJ))
#define G_AMIX ((bf16*)(args.ws + WS_AMIX))
#define G_OX ((bf16*)(args.ws + WS_AMIX))
#define G_H ((float*)(args.ws + WS_H))
#define G_HB ((bf16*)(args.ws + WS_HB))
#define G_PP ((bf16*)(args.ws + WS_P))
#define G_LF ((float*)(args.ws + WS_LF))
#define G_SS1 ((float*)(args.ws + CTL_SS1))
#define G_SS2 ((float*)(args.ws + CTL_SS2))

    for (int u = tid; u < (LDS_BYTES - LDS_MISC) / 4; u += NTHREADS) ((LAS unsigned*)(ldsL + LDS_MISC))[u] = 0u;
    __syncthreads();
    XcdBarrier bar; bar.bar = G_ctl + CW_BAR; bar.x = 0; bar.st = nullptr;
    if (args.one_launch) bar = xcd_barrier_post(G_ctl + CW_BAR, MISC + 8);
    const int lo = args.ph_lo, hi = args.ph_hi;
#ifndef PH_MASK
#define PH_MASK 0x3ff
#endif
#define IN(k) (((PH_MASK >> (k)) & 1) && lo <= (k) && (k) < hi)
#define SEAM(k) do { if (IN(k) && IN((k) + 1)) xcd_barrier(bar); } while (0)
    const int gw = vcu * NWAVES + wave, NGW = G * NWAVES;
    const int gt = vcu * NTHREADS + tid, NGT = G * NTHREADS;

    if (IN(0)) for (int rep_ = 0; rep_ < (((DUP_MASK >> 0) & 1) ? args.pad + 1 : 1); ++rep_) {
        LAS float* wf = (LAS float*)ldsL;
        LAS float* scr = (LAS float*)(ldsL + 65536 + wave * 8704);
        for (int i = tid; i < 8 * DM; i += NTHREADS) { const int d = i >> 3, h = i & 7; wf[h * DM + d] = G_w_in[(size_t)d * INC + 4096 + h]; }
        __syncthreads();
        for (int m = gw; m < TOK; m += NGW) {
            const GAS f32x4* xr = (const GAS f32x4*)(G_x + (size_t)m * DM) + lane; const GAS f32x4* gr = (const GAS f32x4*)G_mix_norm + lane;
            f32x4 v[8]; float s = 0.f;
#pragma unroll
            for (int j = 0; j < 8; ++j) { v[j] = xr[64 * j]; s += (v[j][0] * v[j][0] + v[j][1] * v[j][1]) + (v[j][2] * v[j][2] + v[j][3] * v[j][3]); }
            const float rstd = __builtin_amdgcn_rsqf(wave_sum(s) * (1.f / DM) + EPS);
            GAS v2u* o8 = (GAS v2u*)(G_XN + (size_t)m * DM) + lane;
#pragma unroll
            for (int j = 0; j < 8; ++j) { const f32x4 gg = gr[64 * j]; v[j] = v[j] * rstd * gg;
                v2u o; o.x = pk2(v[j][0], v[j][1]); o.y = pk2(v[j][2], v[j][3]); o8[64 * j] = o; }
            float fl[8];
#pragma unroll
            for (int h = 0; h < 8; ++h) { float a = 0.f;
#pragma unroll
                for (int j = 0; j < 8; ++j) { const f32x4 w = *(const LAS f32x4*)(wf + h * DM + j * 256 + lane * 4); a += (v[j][0] * w[0] + v[j][1] * w[1]) + (v[j][2] * w[2] + v[j][3] * w[3]); }
                fl[h] = wave_sum(a);
                asm volatile("" ::: "memory"); }
            if (lane < 8) { float f = fl[0];
#pragma unroll
                for (int h = 1; h < 8; ++h) f = (lane == h) ? fl[h] : f;
                f += G_b_forget[lane];
                const float ls = fminf(f, 0.f) - log1pf(expf(-fabsf(f)));
                const int b = m / SEQ, sq = m % SEQ; G_LF[(size_t)(b * FOXH + lane) * SEQ + sq] = ls; }
        }
        for (int m = gw; m < BATCH * NMEM; m += NGW) {
            const GAS f32x4* xr = (const GAS f32x4*)(G_mem + (size_t)m * DM) + lane; const GAS f32x4* gr = (const GAS f32x4*)G_mem_norm + lane;
            f32x4 v[8]; float s = 0.f;
#pragma unroll
            for (int j = 0; j < 8; ++j) { v[j] = xr[64 * j]; s += (v[j][0] * v[j][0] + v[j][1] * v[j][1]) + (v[j][2] * v[j][2] + v[j][3] * v[j][3]); }
            const float rstd = __builtin_amdgcn_rsqf(wave_sum(s) * (1.f / DM) + EPS);
            GAS v2u* o8 = (GAS v2u*)(G_MN + (size_t)m * DM) + lane;
#pragma unroll
            for (int j = 0; j < 8; ++j) { const f32x4 gg = gr[64 * j]; v[j] = v[j] * rstd * gg; v2u o; o.x = pk2(v[j][0], v[j][1]); o.y = pk2(v[j][2], v[j][3]); o8[64 * j] = o; }
        }
        {
            constexpr int I_IN = (DM / 64) * (4096 / 32), I_SQ = (DM / 64) * (DM / 32);
            constexpr int NITEMS = I_IN + 3 * I_SQ;
            for (int it = gw; it < NITEMS; it += NGW) {
                int r = it;
                if (r < I_IN) { p0_transpose_item(G_w_in, INC, 4096 / 32, nullptr, G_W_IN, nullptr, 0, DM, scr, r, lane); continue; } r -= I_IN;
                if (r < I_SQ) { p0_transpose_item(G_w_out, DM, DM / 32, nullptr, G_WO1, G_WO2, POOLW, DM, scr, r, lane); continue; } r -= I_SQ;
                if (r < I_SQ) { p0_transpose_item(G_xwk, DM, DM / 32, nullptr, G_WK, nullptr, 0, DM, scr, r, lane); continue; } r -= I_SQ;
                p0_transpose_item(G_xwv, DM, DM / 32, nullptr, G_WV, nullptr, 0, DM, scr, r, lane);
            }
        }
        for (int i = gt; i < DM * DM / 8; i += NGT) {
            const int d = i / (DM / 8); *(GAS v4u*)(G_WPQ + (size_t)i * 8) = cvt8(G_peer_wq + (size_t)i * 8, G_peer_norm[d]); }
        for (int i = gt; i < DM * DM / 8; i += NGT) {
            const int r = i / (DM / 8), c0 = (i % (DM / 8)) * 8; const int hc = r >> 7;
            v4u o = {0u, 0u, 0u, 0u}; if ((c0 >> 7) == hc) o = cvt8(G_sub_keys + (size_t)r * 128 + (c0 & 127), 1.f);
            *(GAS v4u*)(G_AEXP + (size_t)i * 8) = o; }
        for (int i = gt; i < 4 * 256 * 256 / 8; i += NGT) {
            const int g = i / (256 * 256 / 8), d0 = (i % 32) * 8; const float* ps = G_pool_scale + g * 256 + d0; const float* p = G_pool_w + (size_t)i * 8;
            v4u o; o.x = pk2(p[0] * ps[0], p[1] * ps[1]); o.y = pk2(p[2] * ps[2], p[3] * ps[3]); o.z = pk2(p[4] * ps[4], p[5] * ps[5]); o.w = pk2(p[6] * ps[6], p[7] * ps[7]);
            *(GAS v4u*)(G_PB + (size_t)i * 8) = o; }
        __syncthreads();
    }
    SEAM(0);

    if (IN(1)) for (int rep_ = 0; rep_ < (((DUP_MASK >> 1) & 1) ? args.pad + 1 : 1); ++rep_) {
        pg8::Gemm g{G_XN, G_W_IN, DM, DM, DM}; pg8::GSched S; S.init(TOK / 256, 4096 / 256, G, bx, DM, DM);
        pg8::EpiStore E{G_PROJ, 4096, 0, 0, 1, nullptr, 1.f, 4, 8, 0.08838834764831845f * LOG2E};
        pg8::gemm_phase<pg8::EpiStore, pg8::GSched, true>(ldsL, g, S, E);
    }
    SEAM(1);

    if (IN(2)) for (int rep_ = 0; rep_ < (((DUP_MASK >> 2) & 1) ? args.pad + 1 : 1); ++rep_) {
        for (int it = vcu; it < TOK / 32; it += G) {
            const int ch = (tid & 127) * 8, rsub = tid >> 7, r0 = it * 32 + rsub * 8, w = 2 << (ch >> 8);
            const int s0 = r0 % SEQ;
            float acc[8];
#pragma unroll
            for (int e = 0; e < 8; ++e) acc[e] = 0.f;
            for (int k = 1; k < w; ++k) { if (s0 - k >= 0) { const v4u v = *(const GAS v4u*)(G_PROJ + (size_t)(r0 - k) * 4096 + ch);
#pragma unroll
                    for (int e = 0; e < 4; ++e) { acc[2 * e] += __uint_as_float(v[e] << 16); acc[2 * e + 1] += __uint_as_float(v[e] & 0xffff0000u); } } }
            for (int rr = 0; rr < 8; ++rr) {
                const v4u v = *(const GAS v4u*)(G_PROJ + (size_t)(r0 + rr) * 4096 + ch); float cur[8];
#pragma unroll
                for (int e = 0; e < 4; ++e) { cur[2 * e] = __uint_as_float(v[e] << 16); cur[2 * e + 1] = __uint_as_float(v[e] & 0xffff0000u); }
                const int sp = s0 + rr; const float inv = 1.f / (float)((sp + 1 < w) ? sp + 1 : w);
                v4u o;
#pragma unroll
                for (int e = 0; e < 8; ++e) acc[e] += cur[e];
                o.x = pk2(acc[0] * inv - cur[0], acc[1] * inv - cur[1]); o.y = pk2(acc[2] * inv - cur[2], acc[3] * inv - cur[3]);
                o.z = pk2(acc[4] * inv - cur[4], acc[5] * inv - cur[5]); o.w = pk2(acc[6] * inv - cur[6], acc[7] * inv - cur[7]);
                *(GAS v4u*)(G_AMIX + (size_t)(r0 + rr) * DM + ch) = o;
                if (sp - w + 1 >= 0) { const v4u vo = *(const GAS v4u*)(G_PROJ + (size_t)(r0 + rr - w + 1) * 4096 + ch);
#pragma unroll
                    for (int e = 0; e < 4; ++e) { acc[2 * e] -= __uint_as_float(vo[e] << 16); acc[2 * e + 1] -= __uint_as_float(vo[e] & 0xffff0000u); } }
            }
        }
        const int a_bh = vcu >> 4, a_qb = vcu & 15;
        if (a_qb < 8 && vcu < 256) {
            const int e = a_bh * 8 + a_qb;
            pg8::Gemm g; pg8::GSched S; S.init(1, 1, 1, 0, DM, DM); pg8::EpiStore E{nullptr, DM, 0, 0, 1, nullptr, 1.f, 0, 0, 1.f};
            int pm, pn;
            if (e < 16)      { pm = e >> 3; pn = e & 7; g = pg8::Gemm{G_MN, G_WK, DM, DM, DM}; E.O = G_KX; E.ldc = DM; }
            else if (e < 32) { const int q = e - 16; pm = q >> 1; pn = q & 1; g = pg8::Gemm{G_WV, G_MN, DM, DM, DM}; E.O = G_VXT; E.ldc = 512; }
            else if (e < 96) { const int q = e - 32; pm = q >> 3; pn = q & 7; g = pg8::Gemm{G_AEXP, G_WPQ, DM, DM, DM}; E.O = G_WSC; E.ldc = DM; }
            else             { const int q = e - 96; const int gg = q >> 3; pm = q & 7; pn = 0;
                               g = pg8::Gemm{G_WO1 + gg * 256, G_PB + (size_t)gg * 65536, 256, DM, 256}; S.lda = DM; S.ldb = 256; E.O = G_WO2 + gg * 256; E.ldc = DM; }
            struct One { int pm, pn; long ao, bo; __device__ __forceinline__ bool next(int i, pg8::Unit& u) const { if (i) return false; u.pm = pm; u.pn = pn; u.z = 0; u.aoff = ao; u.boff = bo; return true; }
                         __device__ __forceinline__ void a_ready(const pg8::Unit&) const {} __device__ __forceinline__ void done(const pg8::Unit&) const {} };
            const One S1{pm, pn, (long)pm * 256 * g.lda, (long)pn * 256 * g.ldb};
            pg8::gemm_phase<pg8::EpiStore, One, false>(ldsL, g, S1, E);
        }
        if (vcu < 256) {
            const int b = a_bh >> 3, h = a_bh & 7;
            float* c_lds = (float*)(lds + fox::LDS_C);
            if (wave == 0) {
                const float* lf = G_LF + (size_t)a_bh * SEQ + lane * 64; float loc[64]; float run = 0.f;
#pragma unroll
                for (int i = 0; i < 16; ++i) { const f32x4 v = *(const f32x4*)(lf + 4 * i);
#pragma unroll
                    for (int e = 0; e < 4; ++e) { run += v[e]; loc[4 * i + e] = run; } }
                float incl = run;
#pragma unroll
                for (int o = 1; o < 64; o <<= 1) { const float t = __shfl_up(incl, o); if (lane >= o) incl += t; }
                const float excl = incl - run;
#pragma unroll
                for (int i = 0; i < 16; ++i) { f32x4 v;
#pragma unroll
                    for (int e = 0; e < 4; ++e) v[e] = (loc[4 * i + e] + excl) * LOG2E;
                    *(f32x4*)(c_lds + lane * 64 + 4 * i) = v; }
            }
            __syncthreads();
            const bf16* Qb = G_PROJ + (size_t)(b * SEQ) * 4096 + 1024 + h * 128;
            fox::BlockRef cur{Qb + (size_t)(a_qb * 256) * 4096, Qb + 1024, Qb + 2048, G_AMIX + (size_t)(b * SEQ + a_qb * 256) * DM + 1024 + h * 128, a_qb * 256};
            fox::Seam S;
            fox::prime(cur, (char*)lds, S);
            fox::block(cur, cur, (char*)lds, S);
            asm volatile("s_waitcnt vmcnt(0)" ::: "memory");
            __syncthreads();
        }
        {
            constexpr int C_UV = 2 * PEXP / 32, C_T = (DM / 64) * (DM / 32) / 8, NCHUNK = C_UV + 2 * C_T;
            LAS float* scr = (LAS float*)(ldsL + wave * 8704);
            for (;;) {
                __syncthreads();
                if (tid == 0) MISC[16] = atomicAdd(G_ctl + CW_QUEUE, 1u);
                __syncthreads();
                const int c = (int)MISC[16];
                if (c >= NCHUNK) break;
                if (c < C_UV) {
#pragma unroll 1
                    for (int i = 0; i < 4; ++i) { const int r = c * 32 + wave * 4 + i; const int tb = r >> 14, rr = r & (PEXP - 1);
                        conv_row_fp6((tb ? G_peer_v : G_peer_u) + (size_t)rr * DM, (tb ? G_VB : G_UB) + (size_t)rr * 1536, (tb ? G_SV : G_SU) + rr, lane); }
                } else if (c < C_UV + C_T) { p0_transpose_item(G_xwq, DM, DM / 32, G_xattn_norm, G_WQ, nullptr, 0, DM, scr, (c - C_UV) * 8 + wave, lane); }
                else { p0_transpose_item(G_xwo, DM, DM / 32, nullptr, G_WO, nullptr, 0, DM, scr, (c - C_UV - C_T) * 8 + wave, lane); }
            }
        }
    }
    SEAM(2);

    if (IN(3)) for (int rep_ = 0; rep_ < (((DUP_MASK >> 3) & 1) ? args.pad + 1 : 1); ++rep_) {
        pg8::Gemm g{G_AMIX, G_WO2, DM, DM, DM}; pg8::GSched S; S.init(TOK / 256, DM / 256, G, bx, DM, DM);
        pg8::EpiResid<false> E{G_x, G_HB, rep_ ? nullptr : G_SS1};
        pg8::gemm_phase<pg8::EpiResid<false>, pg8::GSched, true>(ldsL, g, S, E);
    }
    SEAM(3);

    if (IN(4)) for (int rep_ = 0; rep_ < (((DUP_MASK >> 4) & 1) ? args.pad + 1 : 1); ++rep_) {
        pg8::Gemm g{G_HB, G_WQ, DM, DM, DM}; pg8::GSched S; S.init(TOK / 256, DM / 256, G, bx, DM, DM);
        pg8::EpiStore E{G_QX, DM, 0, 0, 1, G_SS1, 0.044194173824159216f * LOG2E, 0, 0, 1.f};
        pg8::gemm_phase<pg8::EpiStore, pg8::GSched, true>(ldsL, g, S, E);
    }
    SEAM(4);

    if (IN(5)) for (int rep_ = 0; rep_ < (((DUP_MASK >> 5) & 1) ? args.pad + 1 : 1); ++rep_) {
        pg8::Gemm g{G_QX, G_KX, XD, DM, DM}; pg8::GSched S; S.init(SEQ / 256, 1, G, bx, DM, DM);
        S.nH = XH; S.nZ = BATCH * XH; S.sAb = (long)SEQ * DM; S.sAh = XD; S.sBb = (long)NMEM * DM; S.sBh = XD;
        pg8::EpiSoftmax E{G_PP, 1024, (long)SEQ * 1024, 256, XH};
        pg8::gemm_phase<pg8::EpiSoftmax, pg8::GSched, false>(ldsL, g, S, E);
    }
    SEAM(5);

    if (IN(6)) for (int rep_ = 0; rep_ < (((DUP_MASK >> 6) & 1) ? args.pad + 1 : 1); ++rep_) {
        pg8::Gemm g{G_PP, G_VXT, NMEM, 1024, 512}; pg8::GSched S; S.init(SEQ / 256, XD / 256, G, bx, 1024, 512);
        S.nH = XH; S.nZ = BATCH * XH; S.sAb = (long)SEQ * 1024; S.sAh = 256; S.sBb = NMEM; S.sBh = (long)XD * 512;
        pg8::EpiStore E{G_OX, DM, (long)SEQ * DM, XD, XH, nullptr, 1.f, 0, 0, 1.f};
        pg8::gemm_phase<pg8::EpiStore, pg8::GSched, true>(ldsL, g, S, E);
    }
    SEAM(6);

    if (IN(7)) for (int rep_ = 0; rep_ < (((DUP_MASK >> 7) & 1) ? args.pad + 1 : 1); ++rep_) {
        pg8::Gemm g{G_OX, G_WO, DM, DM, DM}; pg8::GSched S; S.init(TOK / 256, DM / 256, G, bx, DM, DM);
        pg8::EpiResid<true> E{G_HB, G_HB, G_SS2};
        pg8::gemm_phase<pg8::EpiResid<true>, pg8::GSched, true>(ldsL, g, S, E);
    }
    SEAM(7);

    if (IN(8)) for (int rep_ = 0; rep_ < (((DUP_MASK >> 8) & 1) ? args.pad + 1 : 1); ++rep_) {
        pg8::Gemm g{G_WSC, G_HB, DM, DM, DM}; pg8::GSched S; S.init(DM / 256, TOK / 256, G, bx, DM, DM);
        pg8::EpiF32Col E{G_SCT, TOK, G_SS2};
        pg8::gemm_phase<pg8::EpiF32Col, pg8::GSched, true>(ldsL, g, S, E);
    }
    SEAM(8);

    if (IN(9)) for (int rep_ = 0; rep_ < (((DUP_MASK >> 9) & 1) ? args.pad + 1 : 1); ++rep_) {
        LAS unsigned* TOP1 = (LAS unsigned*)ldsL;
        LAS unsigned* RIDX = (LAS unsigned*)(ldsL + 32768);
        LAS float* RGATE = (LAS float*)(ldsL + 49152);
        for (int blk = vcu; blk < TOK / 32; blk += G) {
            const int t0 = blk * 32;
            {
                const int tok = tid & 31, grp = tid >> 5;
                const float* sp = G_SCT + (size_t)(grp * 128) * TOK + t0 + tok;
                unsigned lst[16];
#pragma unroll
                for (int j = 0; j < 16; ++j) lst[j] = 0u;
                for (int i0 = 0; i0 < 128; i0 += 8) {
                    float v[8];
#pragma unroll
                    for (int e = 0; e < 8; ++e) v[e] = sp[(size_t)(i0 + e) * TOK];
#pragma unroll
                    for (int e = 0; e < 8; ++e) { unsigned xk = (fkey(v[e]) & ~127u) | (unsigned)(127 - (i0 + e));
#pragma unroll
                        for (int j = 0; j < 16; ++j) { const unsigned hi_ = max(lst[j], xk); xk = min(lst[j], xk); lst[j] = hi_; } }
                }
                LAS unsigned* dst = TOP1 + (tok * 16 + grp) * 16;
#pragma unroll
                for (int j = 0; j < 16; j += 4) *(LAS v4u*)(dst + j) = (v4u){lst[j], lst[j + 1], lst[j + 2], lst[j + 3]};
            }
            __syncthreads();
            if (tid < 256) {
                const int tok = tid & 31, head = tid >> 5;
                const LAS unsigned* ka = TOP1 + (tok * 16 + head * 2) * 16; const LAS unsigned* kb = ka + 16;
                float af[16], bfv[16];
#pragma unroll
                for (int j = 0; j < 16; ++j) { af[j] = fdec(ka[j] & ~127u); bfv[j] = fdec(kb[j] & ~127u); }
                unsigned best[16];
#pragma unroll
                for (int j = 0; j < 16; ++j) best[j] = 0u;
#pragma unroll
                for (int i = 0; i < 16; ++i)
#pragma unroll
                    for (int j = 0; j < 16; ++j) if ((i + 1) * (j + 1) <= 16) {
                        unsigned xk = (fkey(af[i] + bfv[j]) & ~255u) | (unsigned)(255 - (i * 16 + j));
#pragma unroll
                        for (int q = 0; q < 16; ++q) { const unsigned hi_ = max(best[q], xk); xk = min(best[q], xk); best[q] = hi_; } }
                float ev[16]; const float m0 = fdec(best[0] & ~255u); float sum = 0.f;
#pragma unroll
                for (int q = 0; q < 16; ++q) { ev[q] = __expf(fdec(best[q] & ~255u) - m0); sum += ev[q]; }
                const float inv = 1.f / sum;
#pragma unroll
                for (int q = 0; q < 16; ++q) { const unsigned code = 255u - (best[q] & 255u); const unsigned i = code >> 4, j = code & 15u;
                    const unsigned ia = 127u - (ka[i] & 127u), ib = 127u - (kb[j] & 127u);
                    RIDX[tok * 128 + head * 16 + q] = ia * 128u + ib; RGATE[tok * 128 + head * 16 + q] = ev[q] * inv; }
            }
            __syncthreads();
            for (int tt = 0; tt < 4; ++tt) {
                const int tok = wave * 4 + tt; const size_t t = (size_t)(t0 + tok);
                const float rstd2 = __builtin_amdgcn_rsqf(G_SS2[t] * (1.f / DM) + EPS);
                v32f xn, oacc;
#pragma unroll
                for (int q = 0; q < 8; ++q) { const size_t d0 = (size_t)q * 256 + lane * 4;
                    const v2u hb = *(const GAS v2u*)(G_HB + t * DM + d0); const f32x4 ga = *(const f32x4*)(G_peer_norm + d0);
                    const f32x4 a = {__uint_as_float(hb.x << 16), __uint_as_float(hb.x & 0xffff0000u), __uint_as_float(hb.y << 16), __uint_as_float(hb.y & 0xffff0000u)};
#pragma unroll
                    for (int e = 0; e < 4; ++e) { xn[q * 4 + e] = a[e] * rstd2 * ga[e]; oacc[q * 4 + e] = 0.f; } }
                const LAS unsigned* ridx = RIDX + tok * 128; const LAS float* rgate = RGATE + tok * 128;
                v4u uaA0, vaA0, uaA1, vaA1, uaB0, vaB0, uaB1, vaB1; v2u ubA0, vbA0, ubA1, vbA1, ubB0, vbB0, ubB1, vbB1;
                float suA0, svA0, gtA0, suA1, svA1, gtA1, suB0, svB0, gtB0, suB1, svB1, gtB1;
#define PLD(S, k) do { const unsigned ex_ = (unsigned)__builtin_amdgcn_readfirstlane((int)ridx[k]); su##S = G_SU[ex_]; sv##S = G_SV[ex_]; gt##S = rgate[k]; \
        const unsigned char* up_ = G_UB + (size_t)ex_ * 1536; const unsigned char* vp_ = G_VB + (size_t)ex_ * 1536; \
        ua##S = *(const GAS v4u*)(up_ + lane * 16); ub##S = *(const GAS v2u*)(up_ + 1024 + lane * 8); \
        va##S = *(const GAS v4u*)(vp_ + lane * 16); vb##S = *(const GAS v2u*)(vp_ + 1024 + lane * 8); } while (0)
#define PCOMP(S0, S1) do { float d0_ = peer_dot(ua##S0, ub##S0, xn), d1_ = peer_dot(ua##S1, ub##S1, xn); \
        d0_ = wave_sum_dpp(d0_) * su##S0; d1_ = wave_sum_dpp(d1_) * su##S1; \
        peer_axpy(va##S0, vb##S0, gelu_f(d0_) * gt##S0 * sv##S0, oacc); peer_axpy(va##S1, vb##S1, gelu_f(d1_) * gt##S1 * sv##S1, oacc); } while (0)
                PLD(A0, 0); PLD(A1, 1);
                for (int k = 0; k < 128; k += 4) {
                    PLD(B0, k + 2); PLD(B1, k + 3);
                    PCOMP(A0, A1);
                    if (k + 4 < 128) { PLD(A0, k + 4); PLD(A1, k + 5); }
                    PCOMP(B0, B1);
                }
#undef PLD
#undef PCOMP
                float s = 0.f;
#pragma unroll
                for (int q = 0; q < 8; ++q) { const size_t d0 = (size_t)q * 256 + lane * 4; const v2u hb = *(const GAS v2u*)(G_HB + t * DM + d0);
                    const f32x4 a = {__uint_as_float(hb.x << 16), __uint_as_float(hb.x & 0xffff0000u), __uint_as_float(hb.y << 16), __uint_as_float(hb.y & 0xffff0000u)};
#pragma unroll
                    for (int e = 0; e < 4; ++e) { const float y = a[e] + oacc[q * 4 + e]; oacc[q * 4 + e] = y; s += y * y; } }
                const float rstd = __builtin_amdgcn_rsqf(wave_sum(s) * (1.f / DM) + EPS);
#pragma unroll
                for (int q = 0; q < 8; ++q) { const size_t d0 = (size_t)q * 256 + lane * 4; const f32x4 ga = *(const f32x4*)(G_final_norm + d0); f32x4 o;
#pragma unroll
                    for (int e = 0; e < 4; ++e) o[e] = oacc[q * 4 + e] * rstd * ga[e];
                    *(f32x4*)(args.out + t * DM + d0) = o; }
            }
            __syncthreads();
        }
    }
#undef IN
#undef SEAM
#undef G_ws
#undef G_ctl
#undef G_x
#undef G_mem
#undef G_mix_norm
#undef G_w_in
#undef G_b_forget
#undef G_pool_w
#undef G_pool_scale
#undef G_w_out
#undef G_xattn_norm
#undef G_mem_norm
#undef G_xwq
#undef G_xwk
#undef G_xwv
#undef G_xwo
#undef G_peer_norm
#undef G_peer_wq
#undef G_sub_keys
#undef G_peer_u
#undef G_peer_v
#undef G_final_norm
#undef G_W_IN
#undef G_WO1
#undef G_WO2
#undef G_WQ
#undef G_WK
#undef G_WV
#undef G_WO
#undef G_WPQ
#undef G_AEXP
#undef G_WSC
#undef G_PB
#undef G_MN
#undef G_KX
#undef G_VXT
#undef G_UB
#undef G_VB
#undef G_SU
#undef G_SV
#undef G_XN
#undef G_QX
#undef G_PROJ
#undef G_SCT
#undef G_AMIX
#undef G_OX
#undef G_H
#undef G_HB
#undef G_PP
#undef G_LF
#undef G_SS1
#undef G_SS2

}

constexpr int N_PHASES = 10;
extern "C" void kernel_launch(void* const* d_in, const int* in_sizes, int n_in, void* d_out, int out_size, void* d_ws, size_t ws_size, hipStream_t stream) {
    static int grid = 0;
    if (grid == 0) {
        if (n_in != 20 || in_sizes[0] != TOK * DM || out_size != TOK * DM || ws_size < WS_END) {
            fprintf(stderr, "kernel_launch: unexpected shapes (n_in %d, in0 %d, out %d, ws %zu < %zu)\n", n_in, n_in > 0 ? in_sizes[0] : -1, out_size, ws_size, (size_t)WS_END); grid = -1; return; }
        int dev = 0, cus = 0, per_cu = 0;
        if (hipGetDevice(&dev) != hipSuccess || hipDeviceGetAttribute(&cus, hipDeviceAttributeMultiprocessorCount, dev) != hipSuccess) { grid = -1; return; }
        if (hipFuncSetAttribute((const void*)fwd_kernel, hipFuncAttributeMaxDynamicSharedMemorySize, LDS_BYTES) != hipSuccess) { fprintf(stderr, "kernel_launch: hipFuncSetAttribute failed\n"); grid = -1; return; }
        if (hipOccupancyMaxActiveBlocksPerMultiprocessor(&per_cu, (const void*)fwd_kernel, NTHREADS, LDS_BYTES) != hipSuccess || per_cu < 1) { fprintf(stderr, "kernel_launch: occupancy query says %d\n", per_cu); per_cu = 1; }
        (void)hipGetLastError();
        grid = cus;
        if (grid != 256) fprintf(stderr, "kernel_launch: %d CUs (built for 256)\n", grid);
    }
    if (grid < 0) return;
    (void)hipMemsetAsync((char*)d_ws + WS_CTL, 0, CTL_ZERO_BYTES, stream);
    Args a{};
    for (int i = 0; i < 20; ++i) a.in[i] = (const float*)d_in[i];
    a.out = (float*)d_out; a.ws = (unsigned char*)d_ws; a.pad = DUP_MASK ? 1 : 0;
#if MK_ONE_LAUNCH
    a.ph_lo = 0; a.ph_hi = N_PHASES; a.one_launch = 1;
    void* kargs[] = {&a};
    hipError_t e = hipLaunchCooperativeKernel((const void*)fwd_kernel, dim3(grid), dim3(NTHREADS), kargs, LDS_BYTES, stream);
    if (e != hipSuccess) fprintf(stderr, "kernel_launch: cooperative launch failed: %s\n", hipGetErrorString(e));
#else
    for (int p = 0; p < N_PHASES; ++p) {
        a.ph_lo = p; a.ph_hi = p + 1; a.one_launch = 0;
        hipLaunchKernelGGL(fwd_kernel, dim3(grid), dim3(NTHREADS), LDS_BYTES, stream, a);
    }
#endif
}
```

```cpp
#include <hip/hip_runtime.h>
#include <hip/hip_bf16.h>
#include <cstdio>
#include <cstdint>

#ifndef DUP_MASK
#define DUP_MASK 0
#endif
#ifndef MK_ONE_LAUNCH
#define MK_ONE_LAUNCH 1
#endif

constexpr int BATCH = 2, SEQ = 4096, DM = 2048, TOK = BATCH * SEQ;
constexpr int INC = 4104, POOLW = 1024, FOXH = 8, FOXD = 128;
constexpr int NMEM = 256, XH = 4, XD = 512;
constexpr int PH = 8, PKEYS = 128, PEXP = 16384, TOPK = 16;
constexpr float EPS = 1e-6f;
constexpr float LOG2E = 1.4426950408889634f;

namespace pg8 {
#define PG8_LAS __attribute__((address_space(3)))
typedef unsigned short bf16_t;
typedef short bf16x8 __attribute__((ext_vector_type(8)));
typedef float f32x4 __attribute__((ext_vector_type(4)));
typedef float f32x2 __attribute__((ext_vector_type(2)));
typedef unsigned u32x4 __attribute__((ext_vector_type(4)));
typedef unsigned u32x2 __attribute__((ext_vector_type(2)));
constexpr int BM = 256, BK = 64, HALF = 128, HTB = HALF * BK * 2, STAGE_BYTES = 8 * HTB, NXCD = 8, WGM = 8;

__host__ __device__ __forceinline__ int lds_byte(int r, int c) { const int st = (r >> 4) * 2 + (c >> 5), rr = r & 15, cc = c & 31, ob = rr * 64 + cc * 2; return st * 1024 + (ob ^ (((ob >> 9) & 1) << 5)); }
__host__ __device__ __forceinline__ void stage_rc(int b, int& R, int& C) { const int st = b / 1024, sb = b % 1024, swz = sb ^ (((sb >> 9) & 1) << 5); R = (st >> 1) * 16 + swz / 64; C = (st & 1) * 32 + (swz % 64) / 2; }
__host__ __device__ __forceinline__ int perm32(int rho) { const int n = rho >> 4, i = rho & 15; return 8 * (i >> 2) + 4 * n + (i & 3); }

struct Unit { int pm, pn, z; long aoff, boff; };
struct Gemm { const bf16_t* A; const bf16_t* Bt; int K, lda, ldb; };

struct GSched {
    int nM, nN, nH, nZ, G, c; long sAb, sAh, sBb, sBh; int lda, ldb;
    __device__ __forceinline__ void init(int nM_, int nN_, int G_, int c_, int lda_, int ldb_) { nM = nM_; nN = nN_; nH = 1; nZ = 1; G = G_; c = c_; sAb = sAh = sBb = sBh = 0; lda = lda_; ldb = ldb_; }
    __device__ __forceinline__ bool next(int i, Unit& u) const {
        const long L = (long)i * G + c; const int nwg = nM * nN; if (L >= (long)nwg * nZ) return false;
        const int z = (int)(L / nwg); int wgid = (int)(L % nwg);
        { const int q = nwg / NXCD, r = nwg % NXCD, xcd = wgid % NXCD, off = wgid / NXCD; wgid = (xcd < r ? xcd * (q + 1) : r * (q + 1) + (xcd - r) * q) + off; }
        const int nig = WGM * nN, gid = wgid / nig, fm = gid * WGM, gsz = (nM - fm) < WGM ? (nM - fm) : WGM;
        u.pm = fm + ((wgid % nig) % gsz); u.pn = (wgid % nig) / gsz; u.z = z;
        const int zb = z / nH, zh = z % nH;
        u.aoff = zb * sAb + zh * sAh + (long)u.pm * BM * lda; u.boff = zb * sBb + zh * sBh + (long)u.pn * BM * ldb;
        return true;
    }
    __device__ __forceinline__ void a_ready(const Unit&) const {}
    __device__ __forceinline__ void done(const Unit&) const {}
};

struct OneSched { int pm, pn; long ao, bo;
    __device__ __forceinline__ bool next(int i, Unit& u) const { if (i) return false; u.pm = pm; u.pn = pn; u.z = 0; u.aoff = ao; u.boff = bo; return true; }
    __device__ __forceinline__ void a_ready(const Unit&) const {}
    __device__ __forceinline__ void done(const Unit&) const {} };
__device__ __forceinline__ unsigned cvt_pk_bf16(float lo, float hi) { unsigned r; asm volatile("v_cvt_pk_bf16_f32 %0, %1, %2" : "=v"(r) : "v"(lo), "v"(hi)); return r; }


struct EpiStore {
    static constexpr bool PERM = true, AFTER_DRAIN = false;
    bf16_t* O; int ldc; long sCb, sCh; int nH;
    const float* ss; float rs_mul;
    int t0, t1; float tscale;
    __device__ __forceinline__ void operator()(const f32x4 (&acc)[2][2][4][2], const Unit& u, int wr, int wc, int fr, int fq) const {
        const int row0 = u.pm * BM + wr * 64 + fr, col0 = u.pn * BM + wc * 32 + 8 * fq;
        bf16_t* base = O + (u.z / nH) * sCb + (u.z % nH) * sCh;
        const float ts = (u.pn >= t0 && u.pn < t1) ? tscale : 1.f;
#pragma unroll
        for (int ai = 0; ai < 2; ++ai)
#pragma unroll
            for (int m = 0; m < 4; ++m) { const int row = row0 + ai * HALF + m * 16;
                float sc = ts; if (ss) sc *= __builtin_amdgcn_rsqf(ss[row] * (1.f / DM) + EPS) * rs_mul;
                bf16_t* rowp = base + (size_t)row * ldc + col0;
#pragma unroll
                for (int bj = 0; bj < 2; ++bj) { const f32x4 v0 = acc[ai][bj][m][0] * sc, v1 = acc[ai][bj][m][1] * sc;
                    u32x4 w; w.x = cvt_pk_bf16(v0[0], v0[1]); w.y = cvt_pk_bf16(v0[2], v0[3]); w.z = cvt_pk_bf16(v1[0], v1[1]); w.w = cvt_pk_bf16(v1[2], v1[3]);
                    *(u32x4*)(rowp + bj * HALF) = w; } }
    }
};
template <bool BASE_BF16> struct EpiResid {
    static constexpr bool PERM = true, AFTER_DRAIN = false;
    const void* base; bf16_t* HB; float* ss; int zrows;
    __device__ __forceinline__ void operator()(const f32x4 (&acc)[2][2][4][2], const Unit& u, int wr, int wc, int fr, int fq) const {
        const int row0 = u.z * zrows + u.pm * BM + wr * 64 + fr, col0 = u.pn * BM + wc * 32 + 8 * fq;
#pragma unroll
        for (int ai = 0; ai < 2; ++ai)
#pragma unroll
            for (int m = 0; m < 4; ++m) { const int row = row0 + ai * HALF + m * 16; const size_t off = (size_t)row * DM + col0; float sq = 0.f;
#pragma unroll
                for (int bj = 0; bj < 2; ++bj) {
                    f32x4 b0, b1;
                    if constexpr (BASE_BF16) { const u32x4 r = *(const u32x4*)((const bf16_t*)base + off + bj * HALF);
                        b0 = (f32x4){__uint_as_float(r.x << 16), __uint_as_float(r.x & 0xffff0000u), __uint_as_float(r.y << 16), __uint_as_float(r.y & 0xffff0000u)};
                        b1 = (f32x4){__uint_as_float(r.z << 16), __uint_as_float(r.z & 0xffff0000u), __uint_as_float(r.w << 16), __uint_as_float(r.w & 0xffff0000u)}; }
                    else { b0 = *(const f32x4*)((const float*)base + off + bj * HALF); b1 = *(const f32x4*)((const float*)base + off + bj * HALF + 4); }
                    const f32x4 h0 = b0 + acc[ai][bj][m][0], h1 = b1 + acc[ai][bj][m][1];
                    u32x4 w; w.x = cvt_pk_bf16(h0[0], h0[1]); w.y = cvt_pk_bf16(h0[2], h0[3]); w.z = cvt_pk_bf16(h1[0], h1[1]); w.w = cvt_pk_bf16(h1[2], h1[3]);
                    *(u32x4*)(HB + off + bj * HALF) = w;
                    sq += (h0[0] * h0[0] + h0[1] * h0[1]) + (h0[2] * h0[2] + h0[3] * h0[3]) + (h1[0] * h1[0] + h1[1] * h1[1]) + (h1[2] * h1[2] + h1[3] * h1[3]); }
                sq += __shfl_xor(sq, 16); sq += __shfl_xor(sq, 32);
                if (fq == 0 && ss) atomicAdd(ss + row, sq); }
    }
};
struct EpiF32Col {
    static constexpr bool PERM = true, AFTER_DRAIN = false;
    float* O; int ldc; const float* ss;
    __device__ __forceinline__ void operator()(const f32x4 (&acc)[2][2][4][2], const Unit& u, int wr, int wc, int fr, int fq) const {
        const int row0 = u.pm * BM + wr * 64 + fr, col0 = u.pn * BM + wc * 32 + 8 * fq;
        f32x4 rs[2][2];
#pragma unroll
        for (int bj = 0; bj < 2; ++bj)
#pragma unroll
            for (int n = 0; n < 2; ++n) { const f32x4 s = *(const f32x4*)(ss + col0 + bj * HALF + 4 * n);
#pragma unroll
                for (int e = 0; e < 4; ++e) rs[bj][n][e] = __builtin_amdgcn_rsqf(s[e] * (1.f / DM) + EPS); }
#pragma unroll
        for (int ai = 0; ai < 2; ++ai)
#pragma unroll
            for (int m = 0; m < 4; ++m) { float* rowp = O + (size_t)(row0 + ai * HALF + m * 16) * ldc + col0;
#pragma unroll
                for (int bj = 0; bj < 2; ++bj) { *(f32x4*)(rowp + bj * HALF) = acc[ai][bj][m][0] * rs[bj][0]; *(f32x4*)(rowp + bj * HALF + 4) = acc[ai][bj][m][1] * rs[bj][1]; } }
    }
};
struct EpiSoftmax {
    static constexpr bool PERM = true, AFTER_DRAIN = true;
    bf16_t* P; int ldc; long sCb, sCh; int nH; const float* ss; float mul; int zrows;
    __device__ __forceinline__ void fused(f32x4 (&acc)[2][2][4][2], const Unit& u, int wr, int wc, int fr, int fq, PG8_LAS unsigned char* lds, int wid, int lane) const {
        PG8_LAS float* Pm = (PG8_LAS float*)lds;
        PG8_LAS float* Ps = (PG8_LAS float*)(lds + 4096);
#pragma unroll
        for (int ai = 0; ai < 2; ++ai)
#pragma unroll
            for (int m = 0; m < 4; ++m) { float mx = -3.0e38f;
                const float rs = __builtin_amdgcn_rsqf(ss[u.z * zrows + u.pm * BM + ai * HALF + wr * 64 + m * 16 + fr] * (1.f / DM) + EPS) * mul;
#pragma unroll
                for (int bj = 0; bj < 2; ++bj)
#pragma unroll
                    for (int n = 0; n < 2; ++n) { const f32x4 x = acc[ai][bj][m][n] * rs; acc[ai][bj][m][n] = x; mx = fmaxf(mx, fmaxf(fmaxf(x[0], x[1]), fmaxf(x[2], x[3]))); }
                mx = fmaxf(mx, __shfl_xor(mx, 16)); mx = fmaxf(mx, __shfl_xor(mx, 32));
                if (fq == 0) Pm[(ai * HALF + wr * 64 + m * 16 + fr) * 4 + wc] = mx; }
        asm volatile("s_waitcnt lgkmcnt(0)" ::: "memory"); __builtin_amdgcn_s_barrier(); asm volatile("" ::: "memory");
#pragma unroll
        for (int ai = 0; ai < 2; ++ai)
#pragma unroll
            for (int m = 0; m < 4; ++m) { const int r = ai * HALF + wr * 64 + m * 16 + fr;
                const f32x4 pm4 = *(const PG8_LAS f32x4*)(Pm + r * 4); const float M = fmaxf(fmaxf(pm4[0], pm4[1]), fmaxf(pm4[2], pm4[3])); float s = 0.f;
#pragma unroll
                for (int bj = 0; bj < 2; ++bj)
#pragma unroll
                    for (int n = 0; n < 2; ++n) { f32x4 x = acc[ai][bj][m][n];
#pragma unroll
                        for (int e = 0; e < 4; ++e) { x[e] = __builtin_amdgcn_exp2f(x[e] - M); s += x[e]; }
                        acc[ai][bj][m][n] = x; }
                s += __shfl_xor(s, 16); s += __shfl_xor(s, 32);
                if (fq == 0) Ps[r * 4 + wc] = s; }
        asm volatile("s_waitcnt lgkmcnt(0)" ::: "memory"); __builtin_amdgcn_s_barrier(); asm volatile("" ::: "memory");
        bf16_t* base = P + (u.z / nH) * sCb + (u.z % nH) * sCh;
        const int row0 = u.pm * BM, col0 = u.pn * BM + wc * 32 + 8 * fq;
#pragma unroll
        for (int ai = 0; ai < 2; ++ai)
#pragma unroll
            for (int m = 0; m < 4; ++m) { const int r = ai * HALF + wr * 64 + m * 16 + fr;
                const f32x4 ps4 = *(const PG8_LAS f32x4*)(Ps + r * 4); const float inv = 1.f / ((ps4[0] + ps4[1]) + (ps4[2] + ps4[3]));
                bf16_t* rowp = base + (size_t)(row0 + r) * ldc + col0;
#pragma unroll
                for (int bj = 0; bj < 2; ++bj) { const f32x4 v0 = acc[ai][bj][m][0] * inv, v1 = acc[ai][bj][m][1] * inv;
                    u32x4 w; w.x = cvt_pk_bf16(v0[0], v0[1]); w.y = cvt_pk_bf16(v0[2], v0[3]); w.z = cvt_pk_bf16(v1[0], v1[1]); w.w = cvt_pk_bf16(v1[2], v1[3]);
                    *(u32x4*)(rowp + bj * HALF) = w; } }
    }
};

template <class Epi, class Sched, bool ALIGN_EPI>
__device__ __forceinline__ void gemm_phase(PG8_LAS unsigned char* lds, const Gemm g, const Sched& S, const Epi& E) {
    const int tid = threadIdx.x, wid = __builtin_amdgcn_readfirstlane(tid >> 6), lane = tid & 63, wr = wid >> 2, wc = wid & 3, fr = lane & 15, fq = lane >> 4;
    const int K = g.K, nt = K / BK;
    unsigned voffA[2], voffB[2];
#pragma unroll
    for (int i = 0; i < 2; ++i) { int R, C; stage_rc(tid * 16 + i * 8192, R, C); const int Rb = Epi::PERM ? ((R & ~31) + perm32(R & 31)) : R;
        voffA[i] = (unsigned)(R * g.lda + C) * 2u; voffB[i] = (unsigned)(Rb * g.ldb + C) * 2u; }
    const size_t kstep = (size_t)(BK * 2);
    const size_t hsA = (size_t)HALF * g.lda * 2, hsB = (size_t)HALF * g.ldb * 2;
    const unsigned ldsw = (unsigned)wid * 1024u;
    const int aoff = lds_byte(wr * 64 + fr, fq * 8), boff = lds_byte(wc * 32 + fr, fq * 8);
#define PG8_SA(b, h) (((b) * 2 + (h)) * HTB)
#define PG8_SB(b, h) ((4 + (b) * 2 + (h)) * HTB)
#define PG8_STAGE(bufoff, gbase, voff) do { _Pragma("unroll") for (int _i = 0; _i < 2; ++_i) \
        __builtin_amdgcn_global_load_lds((const unsigned*)((const char*)(gbase) + (voff)[_i]), (PG8_LAS unsigned*)(lds + (bufoff) + ldsw + _i * 8192), 16, 0, 0); } while (0)
#define PG8_LDA(dst, b, h) do { _Pragma("unroll") for (int m = 0; m < 4; ++m) _Pragma("unroll") for (int k = 0; k < 2; ++k) dst[m][k] = *(const PG8_LAS bf16x8*)(lds + PG8_SA(b, h) + aoff + m * 2048 + k * 1024); } while (0)
#define PG8_LDB(dst, b, h) do { _Pragma("unroll") for (int n = 0; n < 2; ++n) _Pragma("unroll") for (int k = 0; k < 2; ++k) dst[n][k] = *(const PG8_LAS bf16x8*)(lds + PG8_SB(b, h) + boff + n * 2048 + k * 1024); } while (0)
#define PG8_MMA(ai, bj, At, Bt) do { __builtin_amdgcn_s_setprio(1); _Pragma("unroll") for (int m = 0; m < 4; ++m) _Pragma("unroll") for (int n = 0; n < 2; ++n) _Pragma("unroll") for (int k = 0; k < 2; ++k) \
        acc[ai][bj][m][n] = __builtin_amdgcn_mfma_f32_16x16x32_bf16(Bt[n][k], At[m][k], acc[ai][bj][m][n], 0, 0, 0); __builtin_amdgcn_s_setprio(0); } while (0)
#define PG8_WAIT_V(n) asm volatile("s_waitcnt vmcnt(" #n ")" ::: "memory")
#define PG8_WAIT_L(n) asm volatile("s_waitcnt lgkmcnt(" #n ")" ::: "memory")
#define PG8_BAR __builtin_amdgcn_s_barrier()
#define PG8_SCHED __builtin_amdgcn_sched_barrier(0)
    Unit cur, nxt; int ui = 0;
    if (!S.next(0, cur)) return;
    f32x4 acc[2][2][4][2];
#pragma unroll
    for (int a = 0; a < 2; ++a)
#pragma unroll
        for (int b = 0; b < 2; ++b)
#pragma unroll
            for (int m = 0; m < 4; ++m)
#pragma unroll
                for (int n = 0; n < 2; ++n) acc[a][b][m][n] = (f32x4){0.f, 0.f, 0.f, 0.f};
    bf16x8 At[4][2], B0[2][2], B1[2][2];
    const char* cA = (const char*)g.A + (size_t)cur.aoff * 2; const char* cB = (const char*)g.Bt + (size_t)cur.boff * 2;
    S.a_ready(cur);
    PG8_STAGE(PG8_SB(0, 0), cB, voffB); PG8_STAGE(PG8_SB(0, 1), cB + hsB, voffB); PG8_STAGE(PG8_SA(0, 0), cA, voffA); PG8_STAGE(PG8_SA(0, 1), cA + hsA, voffA);
    if (wr == 1) PG8_BAR;
    PG8_WAIT_V(2); PG8_BAR;
    PG8_STAGE(PG8_SB(1, 0), cB + kstep, voffB); PG8_STAGE(PG8_SA(1, 0), cA + kstep, voffA); PG8_STAGE(PG8_SB(1, 1), cB + hsB + kstep, voffB);
    PG8_WAIT_V(6); PG8_BAR;
    for (;;) {
        const bool has_next = S.next(ui + 1, nxt);
        const char* nA = has_next ? (const char*)g.A + (size_t)nxt.aoff * 2 : cA; const char* nB = has_next ? (const char*)g.Bt + (size_t)nxt.boff * 2 : cB;
        for (int t = 0; t < nt; t += 2) {
            const bool last = (t == nt - 2);
            const char* a1 = cA + (size_t)(t + 1) * kstep;
            const char* a2 = last ? nA : cA + (size_t)(t + 2) * kstep; const char* b2 = last ? nB : cB + (size_t)(t + 2) * kstep;
            const char* a3 = a2 + kstep; const char* b3 = b2 + kstep;
            if (last && has_next) S.a_ready(nxt);
            PG8_LDB(B0, 0, 0); PG8_LDB(B1, 0, 1); PG8_SCHED; PG8_LDA(At, 0, 0); PG8_STAGE(PG8_SA(1, 1), a1 + hsA, voffA);
            PG8_WAIT_V(8); PG8_WAIT_L(0); PG8_BAR; PG8_MMA(0, 0, At, B0); PG8_MMA(0, 1, At, B1); PG8_BAR; PG8_SCHED;
            PG8_LDA(At, 0, 1); PG8_STAGE(PG8_SB(0, 0), b2, voffB); PG8_STAGE(PG8_SB(0, 1), b2 + hsB, voffB); PG8_STAGE(PG8_SA(0, 0), a2, voffA);
            PG8_WAIT_V(8); PG8_WAIT_L(0); PG8_BAR; PG8_MMA(1, 0, At, B0); PG8_MMA(1, 1, At, B1); PG8_BAR; PG8_SCHED;
            PG8_LDB(B0, 1, 0); PG8_LDB(B1, 1, 1); PG8_SCHED; PG8_LDA(At, 1, 0); PG8_STAGE(PG8_SA(0, 1), a2 + hsA, voffA);
            PG8_WAIT_V(8); PG8_WAIT_L(0); PG8_BAR; PG8_MMA(0, 0, At, B0); PG8_MMA(0, 1, At, B1); PG8_BAR; PG8_SCHED;
            PG8_LDA(At, 1, 1); PG8_STAGE(PG8_SB(1, 0), b3, voffB); PG8_STAGE(PG8_SB(1, 1), b3 + hsB, voffB); PG8_STAGE(PG8_SA(1, 0), a3, voffA);
            PG8_WAIT_V(8); PG8_WAIT_L(0); PG8_BAR; PG8_MMA(1, 0, At, B0); PG8_MMA(1, 1, At, B1); PG8_BAR; PG8_SCHED;
        }
        if constexpr (ALIGN_EPI) { if (wr == 0) PG8_BAR; }
        if constexpr (!Epi::AFTER_DRAIN) { E(acc, cur, wr, wc, fr, fq); S.done(cur); }
        if (!has_next) break;
#pragma unroll
        for (int a = 0; a < 2; ++a)
#pragma unroll
            for (int b = 0; b < 2; ++b)
#pragma unroll
                for (int m = 0; m < 4; ++m)
#pragma unroll
                    for (int n = 0; n < 2; ++n) acc[a][b][m][n] = (f32x4){0.f, 0.f, 0.f, 0.f};
        cur = nxt; cA = nA; cB = nB; ++ui;
        if constexpr (ALIGN_EPI) { if (wr == 1) PG8_BAR; }
    }
    PG8_WAIT_V(0);
    if constexpr (!ALIGN_EPI) { if (wr == 0) PG8_BAR; }
    PG8_BAR;
    if constexpr (Epi::AFTER_DRAIN) { E.fused(acc, cur, wr, wc, fr, fq, lds, wid, lane); S.done(cur); }
#undef PG8_SA
#undef PG8_SB
#undef PG8_STAGE
#undef PG8_LDA
#undef PG8_LDB
#undef PG8_MMA
#undef PG8_WAIT_V
#undef PG8_WAIT_L
#undef PG8_BAR
#undef PG8_SCHED
}
}

namespace fox {
typedef unsigned short bf16_t;
typedef short bf16x8 __attribute__((ext_vector_type(8)));
typedef short s16x4 __attribute__((ext_vector_type(4)));
typedef float f32x16 __attribute__((ext_vector_type(16)));
typedef float f32x4 __attribute__((ext_vector_type(4)));
typedef unsigned u32x4 __attribute__((ext_vector_type(4)));
constexpr int D = 128, NW = 8, QBLK = 32, KVBLK = 64, QB = NW * QBLK;
constexpr int SHM_V = KVBLK * D * 2, SHM_K = KVBLK * D * 2;
constexpr int LDS_C = 2 * SHM_V + 2 * SHM_K + NW * 64 * 4;
constexpr int LDS_BYTES = LDS_C + SEQ * 4;
constexpr int QP = 4096, OP = 2048;
constexpr float THR = 24.f;
#define KSWZ(row, colB) ((row) * 256 + ((colB) ^ (((row) & 7) << 4)))
#define SBAR() __builtin_amdgcn_sched_barrier(0)
__device__ __forceinline__ int v_st(int k, int c) { const int kk = (k & ~0xC) | ((k & 4) << 1) | ((k & 8) >> 1); return ((kk >> 3) * 4 + (c >> 5)) * 512 + ((kk & 7) * 32 + (c & 31)) * 2; }
__device__ __forceinline__ int v_rd_base(int lane) { return ((lane & 3) << 3) | (((lane >> 2) & 3) << 6) | (((lane >> 4) & 1) << 5) | (((lane >> 5) & 1) << 8); }
constexpr int v_rd_off(int d0, int ks, int half) { return d0 * 512 + ks * 4096 + half * 2048; }
__device__ __forceinline__ int crow(int r, int hi) { return (r & 3) + 8 * (r >> 2) + 4 * hi; }
__device__ __forceinline__ unsigned cvtpk(float lo, float hi) { unsigned r; asm volatile("v_cvt_pk_bf16_f32 %0, %1, %2" : "=v"(r) : "v"(lo), "v"(hi)); return r; }
__device__ __forceinline__ bf16x8 load8(const bf16_t* p) { return *reinterpret_cast<const bf16x8*>(p); }
__device__ __forceinline__ void mask_tile(f32x16& p0, f32x16& p1, int dq) {
    const float NEG = -__builtin_inff();
#pragma unroll
    for (int r = 0; r < 16; ++r) { const int c = (r & 3) + 8 * (r >> 2); if (dq - c < 0) p0[r] = NEG; if (dq - c - 32 < 0) p1[r] = NEG; }
}
__device__ __forceinline__ void bias_tile(f32x16& p0, f32x16& p1, const float* cb) {
#pragma unroll
    for (int i = 0; i < 4; ++i) { const f32x4 c0 = *(const f32x4*)(cb + 8 * i), c1 = *(const f32x4*)(cb + 32 + 8 * i);
#pragma unroll
        for (int j = 0; j < 4; ++j) { p0[4 * i + j] -= c0[j]; p1[4 * i + j] -= c1[j]; } }
}
__device__ __forceinline__ void partialSM(f32x16& p0, f32x16& p1, float& m_reg, float& mn, float& alpha) {
    float pmax = p0[0]; for (int r = 1; r < 16; ++r) pmax = fmaxf(pmax, p0[r]); for (int r = 0; r < 16; ++r) pmax = fmaxf(pmax, p1[r]);
    { auto rr = __builtin_amdgcn_permlane32_swap(__float_as_uint(pmax), __float_as_uint(pmax), false, false);
      pmax = fmaxf(__uint_as_float(rr[0]), __uint_as_float(rr[1])); }
    if (__builtin_expect(__all((pmax - m_reg) <= THR), 1)) { mn = m_reg; alpha = 1.f; }
    else { mn = fmaxf(m_reg, pmax); alpha = __builtin_amdgcn_exp2f(m_reg - mn); m_reg = mn; }
    for (int r = 0; r < 16; ++r) p0[r] = p0[r] - mn; for (int r = 0; r < 16; ++r) p1[r] = p1[r] - mn;
    for (int r = 0; r < 16; ++r) p0[r] = __builtin_amdgcn_exp2f(p0[r]);
}
__device__ __forceinline__ void finishSM(f32x16& p0, f32x16& p1, float alpha, float& l_reg, bf16x8& pa0, bf16x8& pa1, bf16x8& pa2, bf16x8& pa3) {
    for (int r = 0; r < 16; ++r) p1[r] = __builtin_amdgcn_exp2f(p1[r]);
    float ps = 0; for (int r = 0; r < 16; ++r) ps += p0[r]; for (int r = 0; r < 16; ++r) ps += p1[r];
    { auto rr = __builtin_amdgcn_permlane32_swap(__float_as_uint(ps), __float_as_uint(ps), false, false);
      ps = __uint_as_float(rr[0]) + __uint_as_float(rr[1]); }
    l_reg = l_reg * alpha + ps;
#define PK4(P, B_, OUT) do { unsigned a0 = cvtpk(P[B_+0], P[B_+1]), a1 = cvtpk(P[B_+2], P[B_+3]);                          \
        unsigned b0 = cvtpk(P[B_+4], P[B_+5]), b1 = cvtpk(P[B_+6], P[B_+7]);                                             \
        auto r0 = __builtin_amdgcn_permlane32_swap(a0, b0, false, false); auto r1 = __builtin_amdgcn_permlane32_swap(a1, b1, false, false); \
        u32x4 w = {r0[0], r1[0], r0[1], r1[1]}; OUT = *reinterpret_cast<bf16x8*>(&w); } while (0)
    PK4(p0, 0, pa0); PK4(p0, 8, pa1); PK4(p1, 0, pa2); PK4(p1, 8, pa3);
#undef PK4
}
template <int KB>
__device__ __forceinline__ void qkt(f32x16& p0, f32x16& p1, const char* K_lds, int r32, int hi, const bf16x8* qr) {
    p0 = f32x16{}; p1 = f32x16{};
    const char* kb[4];
#pragma unroll
    for (int dd = 0; dd < 4; ++dd) kb[dd] = K_lds + KB * SHM_K + KSWZ(r32, (dd * 16 + hi * 8) * 2);
#pragma unroll
    for (int d0 = 0; d0 < 8; ++d0) { const char* a = kb[d0 & 3] + (d0 >> 2) * 128;
        bf16x8 b0 = *reinterpret_cast<const bf16x8*>(a);
        bf16x8 b1 = *reinterpret_cast<const bf16x8*>(a + 32 * 256);
        p0 = __builtin_amdgcn_mfma_f32_32x32x16_bf16(b0, qr[d0], p0, 0, 0, 0);
        p1 = __builtin_amdgcn_mfma_f32_32x32x16_bf16(b1, qr[d0], p1, 0, 0, 0); }
}
template <int VB>
__device__ __forceinline__ void pv_tile(f32x16* o, int vb0, bf16x8 pa0, bf16x8 pa1, bf16x8 pa2, bf16x8 pa3) {
#define TRRD(dst, off) asm volatile("ds_read_b64_tr_b16 %0, %1 offset:%2" : "=&v"(dst) : "v"(vb0), "i"(off) : "memory")
#define PV_D0(d0) do { s16x4 l0, l1, l2, l3, h0, h1, h2, h3; constexpr int b_ = VB * SHM_V + v_rd_off(d0, 0, 0); \
        TRRD(l0, b_); TRRD(h0, b_ + 2048); TRRD(l1, b_ + 4096); TRRD(h1, b_ + 6144); TRRD(l2, b_ + 8192); TRRD(h2, b_ + 10240); TRRD(l3, b_ + 12288); TRRD(h3, b_ + 14336); \
        asm volatile("s_waitcnt lgkmcnt(0)" ::: "memory"); SBAR();   \
        o[d0] = __builtin_amdgcn_mfma_f32_32x32x16_bf16(pa0, (bf16x8){l0[0], l0[1], l0[2], l0[3], h0[0], h0[1], h0[2], h0[3]}, o[d0], 0, 0, 0);   \
        o[d0] = __builtin_amdgcn_mfma_f32_32x32x16_bf16(pa1, (bf16x8){l1[0], l1[1], l1[2], l1[3], h1[0], h1[1], h1[2], h1[3]}, o[d0], 0, 0, 0);   \
        o[d0] = __builtin_amdgcn_mfma_f32_32x32x16_bf16(pa2, (bf16x8){l2[0], l2[1], l2[2], l2[3], h2[0], h2[1], h2[2], h2[3]}, o[d0], 0, 0, 0);   \
        o[d0] = __builtin_amdgcn_mfma_f32_32x32x16_bf16(pa3, (bf16x8){l3[0], l3[1], l3[2], l3[3], h3[0], h3[1], h3[2], h3[3]}, o[d0], 0, 0, 0); } while (0)
    PV_D0(0); PV_D0(1); PV_D0(2); PV_D0(3);
#undef PV_D0
#undef TRRD
}
struct BlockRef { const bf16_t* Q; const bf16_t* K; const bf16_t* V; bf16_t* O; int P0; };
struct Seam { bf16x8 qr[8]; bf16x8 st_v0, st_v1, st_k0, st_k1; };
#define ROW(p, k0, rr) ((p) + (size_t)((k0) + (rr)) * QP + sc)
#define VMW() asm volatile("s_waitcnt vmcnt(0)" ::: "memory")
#define VMWN(n) asm volatile("s_waitcnt vmcnt(%0)" :: "i"(n) : "memory")
#define SLOAD_H(Kp, Vp, k0) do { S.st_v0 = load8(ROW(Vp, k0, sr)); S.st_v1 = load8(ROW(Vp, k0, 32 + sr)); S.st_k0 = load8(ROW(Kp, k0, sr)); S.st_k1 = load8(ROW(Kp, k0, 32 + sr)); } while (0)
#define SWRITE_HK(bf) do { *(bf16x8*)(K_lds + (bf) * SHM_K + kws) = S.st_k0; *(bf16x8*)(K_lds + (bf) * SHM_K + kws + 32 * 256) = S.st_k1; } while (0)
#define SWRITE_HV(bf) do { *(bf16x8*)(V_lds + (bf) * SHM_V + vst0) = S.st_v0; *(bf16x8*)(V_lds + (bf) * SHM_V + vst1) = S.st_v1; } while (0)
#define SWRITE_H(bf) do { SWRITE_HV(bf); SWRITE_HK(bf); } while (0)
__device__ __forceinline__ void prime(const BlockRef& cur, char* lds, Seam& S) {
    const int tid = threadIdx.x, wid = __builtin_amdgcn_readfirstlane(tid >> 6), lane = tid & 63, r32 = lane & 31, hi = lane >> 5;
    const int sr = tid >> 4, sc = (tid & 15) * 8, kws = KSWZ(sr, sc * 2); char* K_lds = lds + 2 * SHM_V;
    for (int d0 = 0; d0 < 8; ++d0) S.qr[d0] = load8(cur.Q + (size_t)(wid * QBLK + r32) * QP + d0 * 16 + hi * 8);
    SLOAD_H(cur.K, cur.V, 0); VMW(); SWRITE_HK(0);
    __syncthreads();
}
__device__ __forceinline__ void block(const BlockRef& cur, const BlockRef& nxt, char* lds, Seam& S) {
    const int tid = threadIdx.x, wid = __builtin_amdgcn_readfirstlane(tid >> 6), lane = tid & 63, r32 = lane & 31, hi = lane >> 5;
    const int NT = (cur.P0 + QB - 1) / KVBLK + 1;
    const int qlo = cur.P0 + wid * QBLK, qm = qlo + r32 - 4 * hi;
    char* V_lds = lds; char* K_lds = lds + 2 * SHM_V;
    float* ws = (float*)(lds + 2 * SHM_V + 2 * SHM_K) + wid * 64; float* li_l = ws, * al_l = ws + 32;
    const float* c_lds = (const float*)(lds + LDS_C) + 4 * hi;
    float m_reg = -1e30f, l_reg = 0; f32x16 o[4] = {};
    const int sr = tid >> 4, sc = (tid & 15) * 8, vst0 = v_st(sr, sc), vst1 = v_st(32 + sr, sc), kws = KSWZ(sr, sc * 2);
    const int vb0 = (int)(uintptr_t)V_lds + v_rd_base(lane);
    const bf16_t* Kh = cur.K; const bf16_t* Vh = cur.V;
#define RESC(a) do { if (__any((a) < 1.f)) { if (hi == 0) al_l[r32] = (a); asm volatile("s_waitcnt lgkmcnt(0)" ::: "memory");              \
                     for (int d_ = 0; d_ < 4; ++d_) for (int r = 0; r < 16; ++r) o[d_][r] *= al_l[crow(r, hi)]; } } while (0)
#define KBASE(t) ((t) * KVBLK)
#define MASKT(P0_, P1_, t) do { const int kb_ = KBASE(t); bias_tile(P0_, P1_, c_lds + kb_); if (kb_ + KVBLK - 1 > qlo) mask_tile(P0_, P1_, qm - kb_); } while (0)
#define SEAM_K0() do { VMWN(8); SWRITE_HK(0); SBAR(); } while (0)
    f32x16 pA0, pA1, pB0, pB1; float mnA, mnB, alA, alB; bf16x8 pa0, pa1, pa2, pa3;
    SWRITE_HV(0); SBAR();
    if (NT > 1) { SLOAD_H(Kh, Vh, KBASE(1)); }
    SBAR(); qkt<0>(pA0, pA1, K_lds, r32, hi, S.qr);
    MASKT(pA0, pA1, 0); partialSM(pA0, pA1, m_reg, mnA, alA);
    if (NT > 1) { VMW(); SWRITE_H(1); }
    __syncthreads();
#define HALF_STEP(PX0, PX1, mnX, alX, PY0, PY1, alY, t, KB, VB, SB) do {                                                      \
        SBAR(); qkt<KB>(PX0, PX1, K_lds, r32, hi, S.qr);                                                                     \
        finishSM(PY0, PY1, alY, l_reg, pa0, pa1, pa2, pa3); SBAR();                                                           \
        if ((t) + 1 < NT) { SLOAD_H(Kh, Vh, KBASE((t) + 1)); SBAR(); }                                                        \
        pv_tile<VB>(o, vb0, pa0, pa1, pa2, pa3); MASKT(PX0, PX1, (t)); partialSM(PX0, PX1, m_reg, mnX, alX);                 \
        __syncthreads();                                                                                                      \
        if ((t) + 1 < NT) { VMW(); SWRITE_H(SB); }                                                                            \
        RESC(alX); __syncthreads(); } while (0)
    for (int t = 1; t + 1 < NT; t += 2) {
        HALF_STEP(pB0, pB1, mnB, alB, pA0, pA1, alA, t, 1, 0, 0);
        HALF_STEP(pA0, pA1, mnA, alA, pB0, pB1, alB, t + 1, 0, 1, 1);
    }
    const bool even = (NT & 1) == 0;
    if (even) { SBAR(); qkt<1>(pB0, pB1, K_lds, r32, hi, S.qr); SBAR(); }
    SLOAD_H(nxt.K, nxt.V, 0); SBAR();
#pragma unroll
    for (int d0 = 0; d0 < 8; ++d0) S.qr[d0] = load8(nxt.Q + (size_t)(wid * QBLK + r32) * QP + d0 * 16 + hi * 8);
    SBAR();
    finishSM(pA0, pA1, alA, l_reg, pa0, pa1, pa2, pa3); SBAR();
    pv_tile<0>(o, vb0, pa0, pa1, pa2, pa3);
    if (even) { MASKT(pB0, pB1, NT - 1); partialSM(pB0, pB1, m_reg, mnB, alB); __syncthreads(); RESC(alB);
        finishSM(pB0, pB1, alB, l_reg, pa0, pa1, pa2, pa3); SBAR(); pv_tile<1>(o, vb0, pa0, pa1, pa2, pa3); }
    SBAR(); SEAM_K0();
    if (hi == 0) li_l[r32] = l_reg; asm volatile("s_waitcnt lgkmcnt(0)" ::: "memory");
    float rli[16];
#pragma unroll
    for (int r = 0; r < 16; ++r) rli[r] = __builtin_amdgcn_rcpf(li_l[crow(r, hi)]);
    bf16_t* Ow = cur.O + (size_t)(wid * QBLK) * OP;
#pragma unroll
    for (int r = 0; r < 16; ++r) { const int orow = crow(r, hi);
#pragma unroll
        for (int d0 = 0; d0 < 4; ++d0) { const float v = o[d0][r] * rli[r];
            const float vn = __shfl_xor(v, 1);
            if ((r32 & 1) == 0) *(unsigned*)(Ow + (size_t)orow * OP + d0 * 32 + r32) = cvtpk(v, vn); } }
    __syncthreads();
#undef RESC
#undef KBASE
#undef MASKT
#undef SEAM_K0
#undef HALF_STEP
}
#undef ROW
#undef VMW
#undef VMWN
#undef SLOAD_H
#undef SWRITE_HK
#undef SWRITE_HV
#undef SWRITE_H
#undef KSWZ
#undef SBAR
}

constexpr int NWAVES = 8, NTHREADS = 512;
constexpr int LDS_BYTES = 147456;
constexpr int LDS_MISC = 145408;
constexpr size_t MiB = 1u << 20;
constexpr size_t WS_CTL = 0, CTL_ZERO_BYTES = 1 * MiB;
constexpr int CW_QUEUE = 64;
constexpr int CW_BAR = 4096;
constexpr size_t CTL_SS1 = 256 * 1024, CTL_SS2 = 320 * 1024;
constexpr size_t WS_LF = 1 * MiB;
constexpr size_t WS_SU = 1 * MiB + 512 * 1024, WS_SV = 1 * MiB + 640 * 1024;
constexpr size_t WS_WIN = 2 * MiB, WS_WO1 = 18 * MiB, WS_WO2 = 26 * MiB, WS_WQ = 34 * MiB, WS_WK = 42 * MiB, WS_WV = 50 * MiB, WS_WO = 58 * MiB;
constexpr size_t WS_WPQ = 66 * MiB, WS_AEXP = 74 * MiB, WS_WSC = 82 * MiB, WS_PB = 90 * MiB, WS_MN = 91 * MiB, WS_KX = 93 * MiB, WS_VXT = 95 * MiB;
constexpr size_t WS_UB = 98 * MiB, WS_VB = 130 * MiB, WS_XN = 226 * MiB, WS_PROJ = 258 * MiB, WS_AMIX = 322 * MiB, WS_H = 354 * MiB, WS_HB = 418 * MiB, WS_P = 450 * MiB, WS_END = 466 * MiB;

#define GAS __attribute__((address_space(1)))
#define LAS __attribute__((address_space(3)))
typedef unsigned short bf16;
typedef unsigned v4u __attribute__((ext_vector_type(4)));
typedef unsigned v2u __attribute__((ext_vector_type(2)));
typedef float f32x4 __attribute__((ext_vector_type(4)));
typedef __bf16 bf16x2_t __attribute__((ext_vector_type(2)));
#define LDS_WAIT() asm volatile("s_waitcnt lgkmcnt(0)" ::: "memory")
__device__ __forceinline__ unsigned f2bf(float f) { unsigned u = __builtin_bit_cast(unsigned, f); return (u + 0x7fffu + ((u >> 16) & 1u)) >> 16; }
__device__ __forceinline__ unsigned pk2(float lo, float hi) { return f2bf(lo) | (f2bf(hi) << 16); }
__device__ __forceinline__ float wave_sum(float v) {
#pragma unroll
    for (int o = 1; o < 64; o <<= 1) v += __shfl_xor(v, o);
    return v;
}

#define XB_TMO      128
#define XB_XCNT(j)  (256  + 64 * (j))
#define XB_XSUB(j)  (1280 + 64 * (j))
#define XB_XGEN(j)  (2304 + 64 * (j))
#define XB_TOP      3328
#define XB_TOPGEN   3392
#define XCD_BAR_WORDS 3456
#define XB_SPIN_CAP (1u << 22)
__device__ __forceinline__ unsigned xb_ld(unsigned* p)              { return __hip_atomic_load(p, __ATOMIC_RELAXED, __HIP_MEMORY_SCOPE_AGENT); }
__device__ __forceinline__ unsigned xb_add(unsigned* p, unsigned v) { return __hip_atomic_fetch_add(p, v, __ATOMIC_RELAXED, __HIP_MEMORY_SCOPE_AGENT); }
__device__ __forceinline__ unsigned xb_xcc_id() { return (unsigned)__builtin_amdgcn_s_getreg((3 << 11) | 20) & 0xFu; }
#define XB_SPIN(cond, bar) do { unsigned _sp = 0; while (cond) { __builtin_amdgcn_s_sleep(1); \
    if ((++_sp & 255u) == 0u) { if (xb_ld(&(bar)[XB_TMO])) break; if (_sp > XB_SPIN_CAP) { atomicAdd(&(bar)[XB_TMO], 1u); break; } } } } while (0)
struct XcdBarrier { unsigned* bar; unsigned x; volatile LAS unsigned* st; };
__device__ __forceinline__ XcdBarrier xcd_barrier_post(unsigned* bar, volatile LAS unsigned* st) {
    XcdBarrier b; b.bar = bar; b.x = xb_xcc_id(); b.st = st;
    if (threadIdx.x == 0) (void)xb_add(&bar[XB_XCNT(b.x)], 1u);
    return b;
}
__device__ __forceinline__ void xcd_barrier_complete(unsigned* bar, unsigned x, unsigned& nloc, unsigned& nx) {
    const unsigned G = gridDim.x * gridDim.y * gridDim.z;
    unsigned sum, cnt, mine, sp = 0u;
    for (;;) {
        sum = 0u; cnt = 0u; mine = 0u;
#pragma unroll
        for (unsigned j = 0; j < 16; ++j) { const unsigned c = xb_ld(&bar[XB_XCNT(j)]); sum += c; cnt += (c > 0u) ? 1u : 0u; mine = (j == x) ? c : mine; }
        if (sum == G) break;
        __builtin_amdgcn_s_sleep(1);
        if ((++sp & 255u) == 0u) { if (xb_ld(&bar[XB_TMO])) break; if (sp > XB_SPIN_CAP) { atomicAdd(&bar[XB_TMO], 1u); break; } }
    }
    nloc = mine > 0u ? mine : 1u; nx = cnt > 0u ? cnt : 1u;
}
__device__ __forceinline__ void xcd_barrier(const XcdBarrier& b) {
    asm volatile("s_waitcnt vmcnt(0)" ::: "memory");
    __syncthreads();
    if (threadIdx.x == 0) {
        unsigned* bar = b.bar;
        __builtin_amdgcn_s_waitcnt(0);
        unsigned nloc = b.st[0], nx = b.st[1];
        if (nloc == 0u) { xcd_barrier_complete(bar, b.x, nloc, nx); b.st[0] = nloc; b.st[1] = nx; }
        const unsigned old = xb_add(&bar[XB_XSUB(b.x)], 1u);
        const unsigned gen = old / nloc;
        if (old + 1u == (gen + 1u) * nloc) {
            __builtin_amdgcn_fence(__ATOMIC_RELEASE, "agent");
            asm volatile("s_waitcnt vmcnt(0)" ::: "memory");
            const unsigned og = xb_add(&bar[XB_TOP], 1u);
            const unsigned tg = og / nx;
            if (og + 1u == (tg + 1u) * nx) xb_add(&bar[XB_TOPGEN], 1u);
            else XB_SPIN(xb_ld(&bar[XB_TOPGEN]) == tg, bar);
            __builtin_amdgcn_fence(__ATOMIC_ACQUIRE, "agent");
            xb_add(&bar[XB_XGEN(b.x)], 1u);
            asm volatile("s_waitcnt vmcnt(0)" ::: "memory");
        } else {
            XB_SPIN(xb_ld(&bar[XB_XGEN(b.x)]) == gen, bar);
            __builtin_amdgcn_fence(__ATOMIC_ACQUIRE, "agent");
            asm volatile("s_waitcnt vmcnt(0)" ::: "memory");
        }
    }
    __syncthreads();
}

struct Args { const float* in[20]; float* out; unsigned char* ws; int ph_lo, ph_hi; int one_launch, pad; };

__device__ __forceinline__ void p0_transpose_item(const float* W, int ldw, int nblk, const float* g, bf16* WT, bf16* WT2, int k2lo, int ldt, LAS float* scr, int item, int lane) {
    const int kb = item / nblk, nb = item % nblk, k0 = 64 * kb, n0 = 32 * nb;
#pragma unroll 8
    for (int i = 0; i < 32; ++i) { const int kk = 2 * i + (lane >> 5); float v = W[(size_t)(k0 + kk) * ldw + n0 + (lane & 31)]; if (g) v *= g[k0 + kk]; scr[kk * 33 + (lane & 31)] = v; }
    LDS_WAIT(); asm volatile("" ::: "memory");
    const int c = lane & 7;
#pragma unroll
    for (int j = 0; j < 4; ++j) { const int n = (lane >> 3) + 8 * j; const LAS float* s = scr + (8 * c) * 33 + n;
        v4u o; o.x = pk2(s[0 * 33], s[1 * 33]); o.y = pk2(s[2 * 33], s[3 * 33]); o.z = pk2(s[4 * 33], s[5 * 33]); o.w = pk2(s[6 * 33], s[7 * 33]);
        *(GAS v4u*)(WT + (size_t)(n0 + n) * ldt + k0 + 8 * c) = o;
        if (WT2 && k0 >= k2lo) *(GAS v4u*)(WT2 + (size_t)(n0 + n) * ldt + k0 + 8 * c) = o; }
    LDS_WAIT(); asm volatile("" ::: "memory");
}
__device__ __forceinline__ v4u cvt8(const float* p, float s) {
    const f32x4 a = *(const f32x4*)p, b = *(const f32x4*)(p + 4);
    v4u o; o.x = pk2(a[0] * s, a[1] * s); o.y = pk2(a[2] * s, a[3] * s); o.z = pk2(b[0] * s, b[1] * s); o.w = pk2(b[2] * s, b[3] * s); return o;
}

__device__ __forceinline__ float gelu_f(float v) {
    const float av = fabsf(v), t = __builtin_amdgcn_rcpf(av * 0.2316418882f + 1.0f);
    float q = t * 0.5307027145f + (-0.7265760135f); q = q * t + 0.7107068705f; q = q * t + (-0.142248368f); q = q * t + 0.127414796f; q = q * t;
    const float e = __builtin_amdgcn_exp2f((v * v) * (-0.72134752044f));
    const float m = v * (q * e);
    return v < 0.f ? m : v - m;
}
__device__ __forceinline__ float dot2bf(unsigned a, unsigned b, float c) { return __builtin_amdgcn_fdot2_f32_bf16(__builtin_bit_cast(bf16x2_t, a), __builtin_bit_cast(bf16x2_t, b), c, false); }
__device__ __forceinline__ unsigned fkey(float f) { const unsigned u = __float_as_uint(f); return (u & 0x80000000u) ? ~u : (u | 0x80000000u); }
__device__ __forceinline__ float fdec(unsigned k) { const unsigned u = (k & 0x80000000u) ? (k & 0x7fffffffu) : ~k; return __uint_as_float(u); }


typedef float f32x2v __attribute__((ext_vector_type(2)));
__device__ __forceinline__ float wave_sum_dpp(float v) {
    v += __builtin_bit_cast(float, __builtin_amdgcn_update_dpp(0, __builtin_bit_cast(int, v), 0xB1, 0xf, 0xf, true));
    v += __builtin_bit_cast(float, __builtin_amdgcn_update_dpp(0, __builtin_bit_cast(int, v), 0x4E, 0xf, 0xf, true));
    v += __builtin_bit_cast(float, __builtin_amdgcn_update_dpp(0, __builtin_bit_cast(int, v), 0x141, 0xf, 0xf, true));
    v += __builtin_bit_cast(float, __builtin_amdgcn_update_dpp(0, __builtin_bit_cast(int, v), 0x140, 0xf, 0xf, true));
    const float a = __builtin_bit_cast(float, __builtin_amdgcn_readlane(__builtin_bit_cast(int, v), 0));
    const float b = __builtin_bit_cast(float, __builtin_amdgcn_readlane(__builtin_bit_cast(int, v), 16));
    const float c = __builtin_bit_cast(float, __builtin_amdgcn_readlane(__builtin_bit_cast(int, v), 32));
    const float d = __builtin_bit_cast(float, __builtin_amdgcn_readlane(__builtin_bit_cast(int, v), 48));
    return (a + b) + (c + d);
}
typedef float v32f __attribute__((ext_vector_type(32)));
typedef float v16f __attribute__((ext_vector_type(16)));
typedef unsigned v6u __attribute__((ext_vector_type(6)));
#ifndef FP6_INTERLEAVED
#define FP6_INTERLEAVED 1
#endif
__device__ __forceinline__ v32f dec_fp6(const v4u a, const v2u b) { const v6u w = {a.x, a.y, a.z, a.w, b.x, b.y}; return __builtin_amdgcn_cvt_scalef32_pk32_f32_fp6(w, 1.0f); }
__device__ __forceinline__ float peer_dot(const v4u ua, const v2u ub, const v32f& xn) {
    const v32f f = dec_fp6(ua, ub); float a0 = 0.f, a1 = 0.f;
#pragma unroll
    for (int i = 0; i < 32; i += 2) { a0 = fmaf(f[i], xn[i], a0); a1 = fmaf(f[i + 1], xn[i + 1], a1); }
    return a0 + a1;
}
__device__ __forceinline__ void peer_axpy(const v4u va, const v2u vb, float w, v32f& oacc) {
    const v32f f = dec_fp6(va, vb);
#pragma unroll
    for (int i = 0; i < 32; ++i) oacc[i] = fmaf(w, f[i], oacc[i]);
}


__device__ __forceinline__ void conv_row_fp6(const float* srow, unsigned char* drow, float* scale_out, int lane) {
    const float* src = srow + lane * 4;
    f32x4 v[8]; float am = 0.f;
#pragma unroll
    for (int q = 0; q < 8; ++q) { v[q] = *(const GAS f32x4*)(src + q * 256);
        am = fmaxf(am, fmaxf(fmaxf(fabsf(v[q][0]), fabsf(v[q][1])), fmaxf(fabsf(v[q][2]), fabsf(v[q][3])))); }
#pragma unroll
    for (int o = 1; o < 64; o <<= 1) am = fmaxf(am, __shfl_xor(am, o));
    int ex = 0; if (am > 0.f) { (void)frexpf(am, &ex); ex = 3 - ex; if (ldexpf(am, ex) > 7.5f) ex -= 1; }
    const float sc = ldexpf(1.f, ex);
    if (lane == 0) *scale_out = ldexpf(1.f, -ex);
    v16f xa, xb;
#pragma unroll
    for (int i = 0; i < 16; ++i) { xa[i] = v[(2 * i) >> 2][(2 * i) & 3] * sc; xb[i] = v[(2 * i + 1) >> 2][(2 * i + 1) & 3] * sc; }
    const v6u w = __builtin_amdgcn_cvt_scalef32_2xpk16_fp6_f32(xa, xb, 1.0f);
    *(GAS v4u*)(drow + lane * 16) = (v4u){w[0], w[1], w[2], w[3]};
    *(GAS v2u*)(drow + 1024 + lane * 8) = (v2u){w[4], w[5]};
}

__global__ void __launch_bounds__(NTHREADS, 2) fwd_kernel(Args args) {
    extern __shared__ __attribute__((aligned(16))) unsigned char lds[];
    LAS unsigned char* ldsL = (LAS unsigned char*)lds;
    volatile LAS unsigned* MISC = (volatile LAS unsigned*)(ldsL + LDS_MISC);
    const int tid = threadIdx.x, lane = tid & 63, wave = __builtin_amdgcn_readfirstlane(tid >> 6);
    const int G = gridDim.x; const int bx = blockIdx.x; const int vcu = (G % 8 == 0) ? (bx % 8) * (G / 8) + bx / 8 : bx;
#define G_ws (args.ws)
#define G_ctl ((unsigned*)(args.ws + WS_CTL))
#define G_x (args.in[0])
#define G_mem (args.in[1])
#define G_mix_norm (args.in[2])
#define G_w_in (args.in[3])
#define G_b_forget (args.in[4])
#define G_pool_w (args.in[5])
#define G_pool_scale (args.in[6])
#define G_w_out (args.in[7])
#define G_xattn_norm (args.in[8])
#define G_mem_norm (args.in[9])
#define G_xwq (args.in[10])
#define G_xwk (args.in[11])
#define G_xwv (args.in[12])
#define G_xwo (args.in[13])
#define G_peer_norm (args.in[14])
#define G_peer_wq (args.in[15])
#define G_sub_keys (args.in[16])
#define G_peer_u (args.in[17])
#define G_peer_v (args.in[18])
#define G_final_norm (args.in[19])
#define G_W_IN ((bf16*)(args.ws + WS_WIN))
#define G_WO1 ((bf16*)(args.ws + WS_WO1))
#define G_WO2 ((bf16*)(args.ws + WS_WO2))
#define G_WQ ((bf16*)(args.ws + WS_WQ))
#define G_WK ((bf16*)(args.ws + WS_WK))
#define G_WV ((bf16*)(args.ws + WS_WV))
#define G_WO ((bf16*)(args.ws + WS_WO))
#define G_WPQ ((bf16*)(args.ws + WS_WPQ))
#define G_AEXP ((bf16*)(args.ws + WS_AEXP))
#define G_W1 ((bf16*)(args.ws + WS_AEXP))
#define G_W2 ((bf16*)(args.ws + WS_WPQ))
#define G_WSC ((bf16*)(args.ws + WS_WSC))
#define G_PB ((bf16*)(args.ws + WS_PB))
#define G_MN ((bf16*)(args.ws + WS_MN))
#define G_KX ((bf16*)(args.ws + WS_KX))
#define G_VXT ((bf16*)(args.ws + WS_VXT))
#define G_UB (args.ws + WS_UB)
#define G_VB (args.ws + WS_VB)
#define G_SU ((float*)(args.ws + WS_SU))
#define G_SV ((float*)(args.ws + WS_SV))
#define G_XN ((bf16*)(args.ws + WS_XN))
#define G_QX ((bf16*)(args.ws + WS_XN))
#define G_PROJ ((bf16*)(args.ws + WS_PROJ))
#define G_SCT ((float*)(args.ws + WS_PROJ))
#define G_AMIX ((bf16*)(args.ws + WS_AMIX))
#define G_OX ((bf16*)(args.ws + WS_AMIX))
#define G_H ((float*)(args.ws + WS_H))
#define G_HB ((bf16*)(args.ws + WS_HB))
#define G_PP ((bf16*)(args.ws + WS_P))
#define G_LF ((float*)(args.ws + WS_LF))
#define G_SS1 ((float*)(args.ws + CTL_SS1))
#define G_SS2 ((float*)(args.ws + CTL_SS2))

    for (int u = tid; u < (LDS_BYTES - LDS_MISC) / 4; u += NTHREADS) ((LAS unsigned*)(ldsL + LDS_MISC))[u] = 0u;
    __syncthreads();
    XcdBarrier bar; bar.bar = G_ctl + CW_BAR; bar.x = 0; bar.st = nullptr;
    if (args.one_launch) bar = xcd_barrier_post(G_ctl + CW_BAR, MISC + 8);
    const int lo = args.ph_lo, hi = args.ph_hi;
#ifndef PH_MASK
#define PH_MASK 0xff
#endif
#define IN(k) (((PH_MASK >> (k)) & 1) && lo <= (k) && (k) < hi)
#define SEAM(k) do { if (IN(k) && IN((k) + 1)) xcd_barrier(bar); } while (0)
    const int gw = vcu * NWAVES + wave, NGW = G * NWAVES;
    const int gt = vcu * NTHREADS + tid, NGT = G * NTHREADS;

    if (IN(0)) for (int rep_ = 0; rep_ < (((DUP_MASK >> 0) & 1) ? args.pad + 1 : 1); ++rep_) {
        LAS float* wf = (LAS float*)ldsL;
        LAS float* scr = (LAS float*)(ldsL + 65536 + wave * 8704);
        for (int i = tid; i < 8 * DM; i += NTHREADS) { const int d = i >> 3, h = i & 7; wf[h * DM + d] = G_w_in[(size_t)d * INC + 4096 + h]; }
        __syncthreads();
        for (int m = gw; m < TOK; m += NGW) {
            const GAS f32x4* xr = (const GAS f32x4*)(G_x + (size_t)m * DM) + lane; const GAS f32x4* gr = (const GAS f32x4*)G_mix_norm + lane;
            f32x4 v[8]; float s = 0.f;
#pragma unroll
            for (int j = 0; j < 8; ++j) { v[j] = xr[64 * j]; s += (v[j][0] * v[j][0] + v[j][1] * v[j][1]) + (v[j][2] * v[j][2] + v[j][3] * v[j][3]); }
            const float rstd = __builtin_amdgcn_rsqf(wave_sum(s) * (1.f / DM) + EPS);
            GAS v2u* o8 = (GAS v2u*)(G_XN + (size_t)m * DM) + lane;
#pragma unroll
            for (int j = 0; j < 8; ++j) { const f32x4 gg = gr[64 * j]; v[j] = v[j] * rstd * gg;
                v2u o; o.x = pk2(v[j][0], v[j][1]); o.y = pk2(v[j][2], v[j][3]); o8[64 * j] = o; }
            float fl[8];
#pragma unroll
            for (int h = 0; h < 8; ++h) { float a = 0.f;
#pragma unroll
                for (int j = 0; j < 8; ++j) { const f32x4 w = *(const LAS f32x4*)(wf + h * DM + j * 256 + lane * 4); a += (v[j][0] * w[0] + v[j][1] * w[1]) + (v[j][2] * w[2] + v[j][3] * w[3]); }
                fl[h] = wave_sum(a);
                asm volatile("" ::: "memory"); }
            if (lane < 8) { float f = fl[0];
#pragma unroll
                for (int h = 1; h < 8; ++h) f = (lane == h) ? fl[h] : f;
                f += G_b_forget[lane];
                const float ls = fminf(f, 0.f) - log1pf(expf(-fabsf(f)));
                const int b = m / SEQ, sq = m % SEQ; G_LF[(size_t)(b * FOXH + lane) * SEQ + sq] = ls; }
        }
        for (int m = gw; m < BATCH * NMEM; m += NGW) {
            const GAS f32x4* xr = (const GAS f32x4*)(G_mem + (size_t)m * DM) + lane; const GAS f32x4* gr = (const GAS f32x4*)G_mem_norm + lane;
            f32x4 v[8]; float s = 0.f;
#pragma unroll
            for (int j = 0; j < 8; ++j) { v[j] = xr[64 * j]; s += (v[j][0] * v[j][0] + v[j][1] * v[j][1]) + (v[j][2] * v[j][2] + v[j][3] * v[j][3]); }
            const float rstd = __builtin_amdgcn_rsqf(wave_sum(s) * (1.f / DM) + EPS);
            GAS v2u* o8 = (GAS v2u*)(G_MN + (size_t)m * DM) + lane;
#pragma unroll
            for (int j = 0; j < 8; ++j) { const f32x4 gg = gr[64 * j]; v[j] = v[j] * rstd * gg; v2u o; o.x = pk2(v[j][0], v[j][1]); o.y = pk2(v[j][2], v[j][3]); o8[64 * j] = o; }
        }
        {
            constexpr int I_IN = (DM / 64) * (4096 / 32), I_SQ = (DM / 64) * (DM / 32);
            constexpr int NITEMS = I_IN + 3 * I_SQ;
            for (int it = gw; it < NITEMS; it += NGW) {
                int r = it;
                if (r < I_IN) { p0_transpose_item(G_w_in, INC, 4096 / 32, nullptr, G_W_IN, nullptr, 0, DM, scr, r, lane); continue; } r -= I_IN;
                if (r < I_SQ) { p0_transpose_item(G_w_out, DM, DM / 32, nullptr, G_WO1, G_WO2, POOLW, DM, scr, r, lane); continue; } r -= I_SQ;
                if (r < I_SQ) { p0_transpose_item(G_xwk, DM, DM / 32, nullptr, G_WK, nullptr, 0, DM, scr, r, lane); continue; } r -= I_SQ;
                p0_transpose_item(G_xwv, DM, DM / 32, nullptr, G_WV, nullptr, 0, DM, scr, r, lane);
            }
        }
        for (int i = gt; i < DM * DM / 8; i += NGT) {
            const int d = i / (DM / 8); *(GAS v4u*)(G_WPQ + (size_t)i * 8) = cvt8(G_peer_wq + (size_t)i * 8, G_peer_norm[d]); }
        for (int i = gt; i < DM * DM / 8; i += NGT) {
            const int d = i / (DM / 8); *(GAS v4u*)(G_WQ + (size_t)i * 8) = cvt8(G_xwq + (size_t)i * 8, G_xattn_norm[d]); }
        for (int i = gt; i < DM * DM / 8; i += NGT) {
            const int r = i / (DM / 8), c0 = (i % (DM / 8)) * 8; const int hc = r >> 7;
            v4u o = {0u, 0u, 0u, 0u}; if ((c0 >> 7) == hc) o = cvt8(G_sub_keys + (size_t)r * 128 + (c0 & 127), 1.f);
            *(GAS v4u*)(G_AEXP + (size_t)i * 8) = o; }
        for (int i = gt; i < 4 * 256 * 256 / 8; i += NGT) {
            const int g = i / (256 * 256 / 8), d0 = (i % 32) * 8; const float* ps = G_pool_scale + g * 256 + d0; const float* p = G_pool_w + (size_t)i * 8;
            v4u o; o.x = pk2(p[0] * ps[0], p[1] * ps[1]); o.y = pk2(p[2] * ps[2], p[3] * ps[3]); o.z = pk2(p[4] * ps[4], p[5] * ps[5]); o.w = pk2(p[6] * ps[6], p[7] * ps[7]);
            *(GAS v4u*)(G_PB + (size_t)i * 8) = o; }
        __syncthreads();
    }
    SEAM(0);

    if (IN(1)) for (int rep_ = 0; rep_ < (((DUP_MASK >> 1) & 1) ? args.pad + 1 : 1); ++rep_) {
        pg8::Gemm g{G_XN, G_W_IN, DM, DM, DM}; pg8::GSched S; S.init(TOK / 256, 4096 / 256, G, bx, DM, DM);
        pg8::EpiStore E{G_PROJ, 4096, 0, 0, 1, nullptr, 1.f, 4, 8, 0.08838834764831845f * LOG2E};
        pg8::gemm_phase<pg8::EpiStore, pg8::GSched, true>(ldsL, g, S, E);
    }
    SEAM(1);

    if (IN(2)) for (int rep_ = 0; rep_ < (((DUP_MASK >> 2) & 1) ? args.pad + 1 : 1); ++rep_) {
        for (int it = vcu; it < TOK / 32; it += G) {
            const int ch = (tid & 127) * 8, rsub = tid >> 7, r0 = it * 32 + rsub * 8, w = 2 << (ch >> 8);
            const int s0 = r0 % SEQ;
            float acc[8];
#pragma unroll
            for (int e = 0; e < 8; ++e) acc[e] = 0.f;
            for (int k = 1; k < w; ++k) { if (s0 - k >= 0) { const v4u v = *(const GAS v4u*)(G_PROJ + (size_t)(r0 - k) * 4096 + ch);
#pragma unroll
                    for (int e = 0; e < 4; ++e) { acc[2 * e] += __uint_as_float(v[e] << 16); acc[2 * e + 1] += __uint_as_float(v[e] & 0xffff0000u); } } }
            for (int rr = 0; rr < 8; ++rr) {
                const v4u v = *(const GAS v4u*)(G_PROJ + (size_t)(r0 + rr) * 4096 + ch); float cur[8];
#pragma unroll
                for (int e = 0; e < 4; ++e) { cur[2 * e] = __uint_as_float(v[e] << 16); cur[2 * e + 1] = __uint_as_float(v[e] & 0xffff0000u); }
                const int sp = s0 + rr; const float inv = 1.f / (float)((sp + 1 < w) ? sp + 1 : w);
                v4u o;
#pragma unroll
                for (int e = 0; e < 8; ++e) acc[e] += cur[e];
                o.x = pk2(acc[0] * inv - cur[0], acc[1] * inv - cur[1]); o.y = pk2(acc[2] * inv - cur[2], acc[3] * inv - cur[3]);
                o.z = pk2(acc[4] * inv - cur[4], acc[5] * inv - cur[5]); o.w = pk2(acc[6] * inv - cur[6], acc[7] * inv - cur[7]);
                *(GAS v4u*)(G_AMIX + (size_t)(r0 + rr) * DM + ch) = o;
                if (sp - w + 1 >= 0) { const v4u vo = *(const GAS v4u*)(G_PROJ + (size_t)(r0 + rr - w + 1) * 4096 + ch);
#pragma unroll
                    for (int e = 0; e < 4; ++e) { acc[2 * e] -= __uint_as_float(vo[e] << 16); acc[2 * e + 1] -= __uint_as_float(vo[e] & 0xffff0000u); } }
            }
        }
        const int a_bh = vcu >> 4, a_qb = vcu & 15;
        if (a_qb < 8 && vcu < 256) {
            const int e = a_bh * 8 + a_qb;
            pg8::Gemm g; pg8::EpiStore E{nullptr, DM, 0, 0, 1, nullptr, 1.f, 0, 0, 1.f};
            int pm, pn;
            if (e < 16)      { pm = e >> 3; pn = e & 7; g = pg8::Gemm{G_MN, G_WK, DM, DM, DM}; E.O = G_KX; E.ldc = DM; }
            else if (e < 32) { const int q = e - 16; pm = q >> 3; pn = q & 7; g = pg8::Gemm{G_MN, G_WV, DM, DM, DM}; E.O = G_VXT; E.ldc = DM; }
            else if (e < 96) { const int q = e - 32; pm = q >> 3; pn = q & 7; g = pg8::Gemm{G_AEXP, G_WPQ, DM, DM, DM}; E.O = G_WSC; E.ldc = DM; }
            else             { const int q = e - 96; const int gg = q >> 3; pm = q & 7; pn = 0;
                               g = pg8::Gemm{G_WO1 + gg * 256, G_PB + (size_t)gg * 65536, 256, DM, 256}; E.O = G_WO2 + gg * 256; E.ldc = DM; }
            const pg8::OneSched S1{pm, pn, (long)pm * 256 * g.lda, (long)pn * 256 * g.ldb};
            pg8::gemm_phase<pg8::EpiStore, pg8::OneSched, false>(ldsL, g, S1, E);
        }
        if (vcu < 256) {
            const int b = a_bh >> 3, h = a_bh & 7;
            float* c_lds = (float*)(lds + fox::LDS_C);
            if (wave == 0) {
                const float* lf = G_LF + (size_t)a_bh * SEQ + lane * 64; float loc[64]; float run = 0.f;
#pragma unroll
                for (int i = 0; i < 16; ++i) { const f32x4 v = *(const f32x4*)(lf + 4 * i);
#pragma unroll
                    for (int e = 0; e < 4; ++e) { run += v[e]; loc[4 * i + e] = run; } }
                float incl = run;
#pragma unroll
                for (int o = 1; o < 64; o <<= 1) { const float t = __shfl_up(incl, o); if (lane >= o) incl += t; }
                const float excl = incl - run;
#pragma unroll
                for (int i = 0; i < 16; ++i) { f32x4 v;
#pragma unroll
                    for (int e = 0; e < 4; ++e) v[e] = (loc[4 * i + e] + excl) * LOG2E;
                    *(f32x4*)(c_lds + lane * 64 + 4 * i) = v; }
            }
            __syncthreads();
            const bf16* Qb = G_PROJ + (size_t)(b * SEQ) * 4096 + 1024 + h * 128;
            fox::BlockRef cur{Qb + (size_t)(a_qb * 256) * 4096, Qb + 1024, Qb + 2048, G_AMIX + (size_t)(b * SEQ + a_qb * 256) * DM + 1024 + h * 128, a_qb * 256};
            fox::Seam S;
            fox::prime(cur, (char*)lds, S);
            fox::block(cur, cur, (char*)lds, S);
            asm volatile("s_waitcnt vmcnt(0)" ::: "memory");
            __syncthreads();
        }
        {
            constexpr int C_UV = 2 * PEXP / 32, C_T = (DM / 64) * (DM / 32) / 8, NCHUNK = C_UV + C_T;
            LAS float* scr = (LAS float*)(ldsL + wave * 8704);
            for (;;) {
                __syncthreads();
                if (tid == 0) MISC[16] = atomicAdd(G_ctl + CW_QUEUE, 1u);
                __syncthreads();
                const int c = (int)MISC[16];
                if (c >= NCHUNK) break;
                if (c < C_UV) {
#pragma unroll 1
                    for (int i = 0; i < 4; ++i) { const int r = c * 32 + wave * 4 + i; const int tb = r >> 14, rr = r & (PEXP - 1);
                        conv_row_fp6((tb ? G_peer_v : G_peer_u) + (size_t)rr * DM, (tb ? G_VB : G_UB) + (size_t)rr * 1536, (tb ? G_SV : G_SU) + rr, lane); }
                } else { p0_transpose_item(G_xwo, DM, DM / 32, nullptr, G_WO, nullptr, 0, DM, scr, (c - C_UV) * 8 + wave, lane); }
            }
        }
    }
    SEAM(2);

    if (IN(3)) for (int rep_ = 0; rep_ < (((DUP_MASK >> 3) & 1) ? args.pad + 1 : 1); ++rep_) {
        { pg8::Gemm g{G_AMIX, G_WO2, DM, DM, DM}; pg8::GSched S; S.init(TOK / 256, DM / 256, G, bx, DM, DM);
          pg8::EpiResid<false> E{G_x, G_HB, rep_ ? nullptr : G_SS1, 0};
          pg8::gemm_phase<pg8::EpiResid<false>, pg8::GSched, true>(ldsL, g, S, E); }
        if (bx < 128) {
            const int f = bx & 63, b = f >> 5, h = (f >> 3) & 3, t = f & 7;
            pg8::Gemm g; pg8::EpiStore E{nullptr, DM, 0, 0, 1, nullptr, 1.f, 0, 0, 1.f}; int pm, pn;
            if (bx < 64) { g = pg8::Gemm{G_KX + (size_t)(b * NMEM) * DM + h * XD, G_WQ + h * XD, XD, DM, DM}; pm = 0; pn = t; E.O = G_W1 + (size_t)(b * 1024 + h * 256) * DM; E.ldc = DM; }
            else         { g = pg8::Gemm{G_WO + h * XD, G_VXT + (size_t)(b * NMEM) * DM + h * XD, XD, DM, DM}; pm = t; pn = 0; E.O = G_W2 + (size_t)b * DM * 1024 + h * 256; E.ldc = 1024; }
            const pg8::OneSched S1{pm, pn, (long)pm * 256 * g.lda, (long)pn * 256 * g.ldb};
            pg8::gemm_phase<pg8::EpiStore, pg8::OneSched, false>(ldsL, g, S1, E);
        }
    }
    SEAM(3);

    if (IN(4)) for (int rep_ = 0; rep_ < (((DUP_MASK >> 4) & 1) ? args.pad + 1 : 1); ++rep_) {
        pg8::Gemm g{G_HB, G_W1, DM, DM, DM}; pg8::GSched S; S.init(SEQ / 256, XH, G, bx, DM, DM);
        S.nH = 1; S.nZ = BATCH; S.sAb = (long)SEQ * DM; S.sBb = (long)1024 * DM;
        pg8::EpiSoftmax E{G_PP, 1024, (long)SEQ * 1024, 0, 1, G_SS1, 0.044194173824159216f * LOG2E, SEQ};
        pg8::gemm_phase<pg8::EpiSoftmax, pg8::GSched, false>(ldsL, g, S, E);
    }
    SEAM(4);

    if (IN(5)) for (int rep_ = 0; rep_ < (((DUP_MASK >> 5) & 1) ? args.pad + 1 : 1); ++rep_) {
        pg8::Gemm g{G_PP, G_W2, 1024, 1024, 1024}; pg8::GSched S; S.init(SEQ / 256, DM / 256, G, bx, 1024, 1024);
        S.nH = 1; S.nZ = BATCH; S.sAb = (long)SEQ * 1024; S.sBb = (long)DM * 1024;
        pg8::EpiResid<true> E{G_HB, G_HB, G_SS2, SEQ};
        pg8::gemm_phase<pg8::EpiResid<true>, pg8::GSched, true>(ldsL, g, S, E);
    }
    SEAM(5);

    if (IN(6)) for (int rep_ = 0; rep_ < (((DUP_MASK >> 6) & 1) ? args.pad + 1 : 1); ++rep_) {
        pg8::Gemm g{G_WSC, G_HB, DM, DM, DM}; pg8::GSched S; S.init(DM / 256, TOK / 256, G, bx, DM, DM);
        pg8::EpiF32Col E{G_SCT, TOK, G_SS2};
        pg8::gemm_phase<pg8::EpiF32Col, pg8::GSched, true>(ldsL, g, S, E);
    }
    SEAM(6);

    if (IN(7)) for (int rep_ = 0; rep_ < (((DUP_MASK >> 7) & 1) ? args.pad + 1 : 1); ++rep_) {
        LAS unsigned* TOP1 = (LAS unsigned*)ldsL;
        LAS unsigned* RIDX = (LAS unsigned*)(ldsL + 32768);
        LAS float* RGATE = (LAS float*)(ldsL + 49152);
        for (int blk = vcu; blk < TOK / 32; blk += G) {
            const int t0 = blk * 32;
            {
                const int tok = tid & 31, grp = tid >> 5;
                const float* sp = G_SCT + (size_t)(grp * 128) * TOK + t0 + tok;
                unsigned lst[16];
#pragma unroll
                for (int j = 0; j < 16; ++j) lst[j] = 0u;
                for (int i0 = 0; i0 < 128; i0 += 8) {
                    float v[8];
#pragma unroll
                    for (int e = 0; e < 8; ++e) v[e] = sp[(size_t)(i0 + e) * TOK];
#pragma unroll
                    for (int e = 0; e < 8; ++e) { unsigned xk = (fkey(v[e]) & ~127u) | (unsigned)(127 - (i0 + e));
#pragma unroll
                        for (int j = 0; j < 16; ++j) { const unsigned hi_ = max(lst[j], xk); xk = min(lst[j], xk); lst[j] = hi_; } }
                }
                LAS unsigned* dst = TOP1 + (tok * 16 + grp) * 16;
#pragma unroll
                for (int j = 0; j < 16; j += 4) *(LAS v4u*)(dst + j) = (v4u){lst[j], lst[j + 1], lst[j + 2], lst[j + 3]};
            }
            __syncthreads();
            if (tid < 256) {
                const int tok = tid & 31, head = tid >> 5;
                const LAS unsigned* ka = TOP1 + (tok * 16 + head * 2) * 16; const LAS unsigned* kb = ka + 16;
                float af[16], bfv[16];
#pragma unroll
                for (int j = 0; j < 16; ++j) { af[j] = fdec(ka[j] & ~127u); bfv[j] = fdec(kb[j] & ~127u); }
                unsigned best[16];
#pragma unroll
                for (int j = 0; j < 16; ++j) best[j] = 0u;
#pragma unroll
                for (int i = 0; i < 16; ++i)
#pragma unroll
                    for (int j = 0; j < 16; ++j) if ((i + 1) * (j + 1) <= 16) {
                        unsigned xk = (fkey(af[i] + bfv[j]) & ~255u) | (unsigned)(255 - (i * 16 + j));
#pragma unroll
                        for (int q = 0; q < 16; ++q) { const unsigned hi_ = max(best[q], xk); xk = min(best[q], xk); best[q] = hi_; } }
                float ev[16]; const float m0 = fdec(best[0] & ~255u); float sum = 0.f;
#pragma unroll
                for (int q = 0; q < 16; ++q) { ev[q] = __expf(fdec(best[q] & ~255u) - m0); sum += ev[q]; }
                const float inv = 1.f / sum;
#pragma unroll
                for (int q = 0; q < 16; ++q) { const unsigned code = 255u - (best[q] & 255u); const unsigned i = code >> 4, j = code & 15u;
                    const unsigned ia = 127u - (ka[i] & 127u), ib = 127u - (kb[j] & 127u);
                    RIDX[tok * 128 + head * 16 + q] = ia * 128u + ib; RGATE[tok * 128 + head * 16 + q] = ev[q] * inv; }
            }
            __syncthreads();
            for (int tt = 0; tt < 4; ++tt) {
                const int tok = wave * 4 + tt; const size_t t = (size_t)(t0 + tok);
                const float rstd2 = __builtin_amdgcn_rsqf(G_SS2[t] * (1.f / DM) + EPS);
                v32f xn, oacc;
#pragma unroll
                for (int q = 0; q < 8; ++q) { const size_t d0 = (size_t)q * 256 + lane * 4;
                    const v2u hb = *(const GAS v2u*)(G_HB + t * DM + d0); const f32x4 ga = *(const f32x4*)(G_peer_norm + d0);
                    const f32x4 a = {__uint_as_float(hb.x << 16), __uint_as_float(hb.x & 0xffff0000u), __uint_as_float(hb.y << 16), __uint_as_float(hb.y & 0xffff0000u)};
#pragma unroll
                    for (int e = 0; e < 4; ++e) { xn[q * 4 + e] = a[e] * rstd2 * ga[e]; oacc[q * 4 + e] = 0.f; } }
                const LAS unsigned* ridx = RIDX + tok * 128; const LAS float* rgate = RGATE + tok * 128;
                v4u uaA0, vaA0, uaA1, vaA1, uaB0, vaB0, uaB1, vaB1; v2u ubA0, vbA0, ubA1, vbA1, ubB0, vbB0, ubB1, vbB1;
                float suA0, svA0, gtA0, suA1, svA1, gtA1, suB0, svB0, gtB0, suB1, svB1, gtB1;
#define PLD(S, k) do { const unsigned ex_ = (unsigned)__builtin_amdgcn_readfirstlane((int)ridx[k]); su##S = G_SU[ex_]; sv##S = G_SV[ex_]; gt##S = rgate[k]; \
        const unsigned char* up_ = G_UB + (size_t)ex_ * 1536; const unsigned char* vp_ = G_VB + (size_t)ex_ * 1536; \
        ua##S = *(const GAS v4u*)(up_ + lane * 16); ub##S = *(const GAS v2u*)(up_ + 1024 + lane * 8); \
        va##S = *(const GAS v4u*)(vp_ + lane * 16); vb##S = *(const GAS v2u*)(vp_ + 1024 + lane * 8); } while (0)
#define PCOMP(S0, S1) do { float d0_ = peer_dot(ua##S0, ub##S0, xn), d1_ = peer_dot(ua##S1, ub##S1, xn); \
        d0_ = wave_sum_dpp(d0_) * su##S0; d1_ = wave_sum_dpp(d1_) * su##S1; \
        peer_axpy(va##S0, vb##S0, gelu_f(d0_) * gt##S0 * sv##S0, oacc); peer_axpy(va##S1, vb##S1, gelu_f(d1_) * gt##S1 * sv##S1, oacc); } while (0)
                PLD(A0, 0); PLD(A1, 1);
                for (int k = 0; k < 128; k += 4) {
                    PLD(B0, k + 2); PLD(B1, k + 3);
                    PCOMP(A0, A1);
                    if (k + 4 < 128) { PLD(A0, k + 4); PLD(A1, k + 5); }
                    PCOMP(B0, B1);
                }
#undef PLD
#undef PCOMP
                float s = 0.f;
#pragma unroll
                for (int q = 0; q < 8; ++q) { const size_t d0 = (size_t)q * 256 + lane * 4; const v2u hb = *(const GAS v2u*)(G_HB + t * DM + d0);
                    const f32x4 a = {__uint_as_float(hb.x << 16), __uint_as_float(hb.x & 0xffff0000u), __uint_as_float(hb.y << 16), __uint_as_float(hb.y & 0xffff0000u)};
#pragma unroll
                    for (int e = 0; e < 4; ++e) { const float y = a[e] + oacc[q * 4 + e]; oacc[q * 4 + e] = y; s += y * y; } }
                const float rstd = __builtin_amdgcn_rsqf(wave_sum(s) * (1.f / DM) + EPS);
#pragma unroll
                for (int q = 0; q < 8; ++q) { const size_t d0 = (size_t)q * 256 + lane * 4; const f32x4 ga = *(const f32x4*)(G_final_norm + d0); f32x4 o;
#pragma unroll
                    for (int e = 0; e < 4; ++e) o[e] = oacc[q * 4 + e] * rstd * ga[e];
                    *(f32x4*)(args.out + t * DM + d0) = o; }
            }
            __syncthreads();
        }
    }
#undef IN
#undef SEAM
#undef G_ws
#undef G_ctl
#undef G_x
#undef G_mem
#undef G_mix_norm
#undef G_w_in
#undef G_b_forget
#undef G_pool_w
#undef G_pool_scale
#undef G_w_out
#undef G_xattn_norm
#undef G_mem_norm
#undef G_xwq
#undef G_xwk
#undef G_xwv
#undef G_xwo
#undef G_peer_norm
#undef G_peer_wq
#undef G_sub_keys
#undef G_peer_u
#undef G_peer_v
#undef G_final_norm
#undef G_W_IN
#undef G_WO1
#undef G_WO2
#undef G_WQ
#undef G_WK
#undef G_WV
#undef G_WO
#undef G_WPQ
#undef G_AEXP
#undef G_W1
#undef G_W2
#undef G_WSC
#undef G_PB
#undef G_MN
#undef G_KX
#undef G_VXT
#undef G_UB
#undef G_VB
#undef G_SU
#undef G_SV
#undef G_XN
#undef G_QX
#undef G_PROJ
#undef G_SCT
#undef G_AMIX
#undef G_OX
#undef G_H
#undef G_HB
#undef G_PP
#undef G_LF
#undef G_SS1
#undef G_SS2

}

constexpr int N_PHASES = 8;
extern "C" void kernel_launch(void* const* d_in, const int* in_sizes, int n_in, void* d_out, int out_size, void* d_ws, size_t ws_size, hipStream_t stream) {
    static int grid = 0;
    if (grid == 0) {
        if (n_in != 20 || in_sizes[0] != TOK * DM || out_size != TOK * DM || ws_size < WS_END) {
            fprintf(stderr, "kernel_launch: unexpected shapes (n_in %d, in0 %d, out %d, ws %zu < %zu)\n", n_in, n_in > 0 ? in_sizes[0] : -1, out_size, ws_size, (size_t)WS_END); grid = -1; return; }
        int dev = 0, cus = 0, per_cu = 0;
        if (hipGetDevice(&dev) != hipSuccess || hipDeviceGetAttribute(&cus, hipDeviceAttributeMultiprocessorCount, dev) != hipSuccess) { grid = -1; return; }
        if (hipFuncSetAttribute((const void*)fwd_kernel, hipFuncAttributeMaxDynamicSharedMemorySize, LDS_BYTES) != hipSuccess) { fprintf(stderr, "kernel_launch: hipFuncSetAttribute failed\n"); grid = -1; return; }
        if (hipOccupancyMaxActiveBlocksPerMultiprocessor(&per_cu, (const void*)fwd_kernel, NTHREADS, LDS_BYTES) != hipSuccess || per_cu < 1) { fprintf(stderr, "kernel_launch: occupancy query says %d\n", per_cu); per_cu = 1; }
        (void)hipGetLastError();
        grid = cus;
        if (grid != 256) fprintf(stderr, "kernel_launch: %d CUs (built for 256)\n", grid);
    }
    if (grid < 0) return;
    (void)hipMemsetAsync((char*)d_ws + WS_CTL, 0, CTL_ZERO_BYTES, stream);
    Args a{};
    for (int i = 0; i < 20; ++i) a.in[i] = (const float*)d_in[i];
    a.out = (float*)d_out; a.ws = (unsigned char*)d_ws; a.pad = DUP_MASK ? 1 : 0;
#if MK_ONE_LAUNCH
    a.ph_lo = 0; a.ph_hi = N_PHASES; a.one_launch = 1;
    void* kargs[] = {&a};
    hipError_t e = hipLaunchCooperativeKernel((const void*)fwd_kernel, dim3(grid), dim3(NTHREADS), kargs, LDS_BYTES, stream);
    if (e != hipSuccess) fprintf(stderr, "kernel_launch: cooperative launch failed: %s\n", hipGetErrorString(e));
#else
    for (int p = 0; p < N_PHASES; ++p) {
        a.ph_lo = p; a.ph_hi = p + 1; a.one_launch = 0;
        hipLaunchKernelGGL(fwd_kernel, dim3(grid), dim3(NTHREADS), LDS_BYTES, stream, a);
    }
#endif
}
```

```cpp
#include <hip/hip_runtime.h>
#include <hip/hip_bf16.h>
#include <cstdio>
#include <cstdint>

#ifndef DUP_MASK
#define DUP_MASK 0
#endif
#ifndef MK_ONE_LAUNCH
#define MK_ONE_LAUNCH 1
#endif

constexpr int BATCH = 2, SEQ = 4096, DM = 2048, TOK = BATCH * SEQ;
constexpr int INC = 4104, POOLW = 1024, FOXH = 8, FOXD = 128;
constexpr int NMEM = 256, XH = 4, XD = 512;
constexpr int PH = 8, PKEYS = 128, PEXP = 16384, TOPK = 16;
constexpr float EPS = 1e-6f;
constexpr float LOG2E = 1.4426950408889634f;

namespace pg8 {
#define PG8_LAS __attribute__((address_space(3)))
typedef unsigned short bf16_t;
typedef short bf16x8 __attribute__((ext_vector_type(8)));
typedef float f32x4 __attribute__((ext_vector_type(4)));
typedef float f32x2 __attribute__((ext_vector_type(2)));
typedef unsigned u32x4 __attribute__((ext_vector_type(4)));
typedef unsigned u32x2 __attribute__((ext_vector_type(2)));
constexpr int BM = 256, BK = 64, HALF = 128, HTB = HALF * BK * 2, STAGE_BYTES = 8 * HTB, NXCD = 8, WGM = 8;

__host__ __device__ __forceinline__ int lds_byte(int r, int c) { const int st = (r >> 4) * 2 + (c >> 5), rr = r & 15, cc = c & 31, ob = rr * 64 + cc * 2; return st * 1024 + (ob ^ (((ob >> 9) & 1) << 5)); }
__host__ __device__ __forceinline__ void stage_rc(int b, int& R, int& C) { const int st = b / 1024, sb = b % 1024, swz = sb ^ (((sb >> 9) & 1) << 5); R = (st >> 1) * 16 + swz / 64; C = (st & 1) * 32 + (swz % 64) / 2; }
__host__ __device__ __forceinline__ int perm32(int rho) { const int n = rho >> 4, i = rho & 15; return 8 * (i >> 2) + 4 * n + (i & 3); }

struct Unit { int pm, pn, z; long aoff, boff; };
struct Gemm { const bf16_t* A; const bf16_t* Bt; int K, lda, ldb; };

struct GSched {
    int nM, nN, nH, nZ, G, c; long sAb, sAh, sBb, sBh; int lda, ldb;
    __device__ __forceinline__ void init(int nM_, int nN_, int G_, int c_, int lda_, int ldb_) { nM = nM_; nN = nN_; nH = 1; nZ = 1; G = G_; c = c_; sAb = sAh = sBb = sBh = 0; lda = lda_; ldb = ldb_; }
    __device__ __forceinline__ bool next(int i, Unit& u) const {
        const long L = (long)i * G + c; const int nwg = nM * nN; if (L >= (long)nwg * nZ) return false;
        const int z = (int)(L / nwg); int wgid = (int)(L % nwg);
        { const int q = nwg / NXCD, r = nwg % NXCD, xcd = wgid % NXCD, off = wgid / NXCD; wgid = (xcd < r ? xcd * (q + 1) : r * (q + 1) + (xcd - r) * q) + off; }
        const int nig = WGM * nN, gid = wgid / nig, fm = gid * WGM, gsz = (nM - fm) < WGM ? (nM - fm) : WGM;
        u.pm = fm + ((wgid % nig) % gsz); u.pn = (wgid % nig) / gsz; u.z = z;
        const int zb = z / nH, zh = z % nH;
        u.aoff = zb * sAb + zh * sAh + (long)u.pm * BM * lda; u.boff = zb * sBb + zh * sBh + (long)u.pn * BM * ldb;
        return true;
    }
    __device__ __forceinline__ void a_ready(const Unit&) const {}
    __device__ __forceinline__ void done(const Unit&) const {}
};

struct OneSched { int pm, pn; long ao, bo;
    __device__ __forceinline__ bool next(int i, Unit& u) const { if (i) return false; u.pm = pm; u.pn = pn; u.z = 0; u.aoff = ao; u.boff = bo; return true; }
    __device__ __forceinline__ void a_ready(const Unit&) const {}
    __device__ __forceinline__ void done(const Unit&) const {} };
__device__ __forceinline__ unsigned cvt_pk_bf16(float lo, float hi) { unsigned r; asm volatile("v_cvt_pk_bf16_f32 %0, %1, %2" : "=v"(r) : "v"(lo), "v"(hi)); return r; }


struct EpiStore {
    static constexpr bool PERM = true, AFTER_DRAIN = false;
    bf16_t* O; int ldc; long sCb, sCh; int nH;
    const float* ss; float rs_mul;
    int t0, t1; float tscale;
    __device__ __forceinline__ void operator()(const f32x4 (&acc)[2][2][4][2], const Unit& u, int wr, int wc, int fr, int fq) const {
        const int row0 = u.pm * BM + wr * 64 + fr, col0 = u.pn * BM + wc * 32 + 8 * fq;
        bf16_t* base = O + (u.z / nH) * sCb + (u.z % nH) * sCh;
        const float ts = (u.pn >= t0 && u.pn < t1) ? tscale : 1.f;
#pragma unroll
        for (int ai = 0; ai < 2; ++ai)
#pragma unroll
            for (int m = 0; m < 4; ++m) { const int row = row0 + ai * HALF + m * 16;
                float sc = ts; if (ss) sc *= __builtin_amdgcn_rsqf(ss[row] * (1.f / DM) + EPS) * rs_mul;
                bf16_t* rowp = base + (size_t)row * ldc + col0;
#pragma unroll
                for (int bj = 0; bj < 2; ++bj) { const f32x4 v0 = acc[ai][bj][m][0] * sc, v1 = acc[ai][bj][m][1] * sc;
                    u32x4 w; w.x = cvt_pk_bf16(v0[0], v0[1]); w.y = cvt_pk_bf16(v0[2], v0[3]); w.z = cvt_pk_bf16(v1[0], v1[1]); w.w = cvt_pk_bf16(v1[2], v1[3]);
                    *(u32x4*)(rowp + bj * HALF) = w; } }
    }
};
template <bool BASE_BF16> struct EpiResid {
    static constexpr bool PERM = true, AFTER_DRAIN = false;
    const void* base; bf16_t* HB; float* ss; int zrows;
    __device__ __forceinline__ void operator()(const f32x4 (&acc)[2][2][4][2], const Unit& u, int wr, int wc, int fr, int fq) const {
        const int row0 = u.z * zrows + u.pm * BM + wr * 64 + fr, col0 = u.pn * BM + wc * 32 + 8 * fq;
#pragma unroll
        for (int ai = 0; ai < 2; ++ai)
#pragma unroll
            for (int m = 0; m < 4; ++m) { const int row = row0 + ai * HALF + m * 16; const size_t off = (size_t)row * DM + col0; float sq = 0.f;
#pragma unroll
                for (int bj = 0; bj < 2; ++bj) {
                    f32x4 b0, b1;
                    if constexpr (BASE_BF16) { const u32x4 r = *(const u32x4*)((const bf16_t*)base + off + bj * HALF);
                        b0 = (f32x4){__uint_as_float(r.x << 16), __uint_as_float(r.x & 0xffff0000u), __uint_as_float(r.y << 16), __uint_as_float(r.y & 0xffff0000u)};
                        b1 = (f32x4){__uint_as_float(r.z << 16), __uint_as_float(r.z & 0xffff0000u), __uint_as_float(r.w << 16), __uint_as_float(r.w & 0xffff0000u)}; }
                    else { b0 = *(const f32x4*)((const float*)base + off + bj * HALF); b1 = *(const f32x4*)((const float*)base + off + bj * HALF + 4); }
                    const f32x4 h0 = b0 + acc[ai][bj][m][0], h1 = b1 + acc[ai][bj][m][1];
                    u32x4 w; w.x = cvt_pk_bf16(h0[0], h0[1]); w.y = cvt_pk_bf16(h0[2], h0[3]); w.z = cvt_pk_bf16(h1[0], h1[1]); w.w = cvt_pk_bf16(h1[2], h1[3]);
                    *(u32x4*)(HB + off + bj * HALF) = w;
                    sq += (h0[0] * h0[0] + h0[1] * h0[1]) + (h0[2] * h0[2] + h0[3] * h0[3]) + (h1[0] * h1[0] + h1[1] * h1[1]) + (h1[2] * h1[2] + h1[3] * h1[3]); }
                sq += __shfl_xor(sq, 16); sq += __shfl_xor(sq, 32);
                if (fq == 0 && ss) atomicAdd(ss + row, sq); }
    }
};
struct EpiF32Col {
    static constexpr bool PERM = true, AFTER_DRAIN = false;
    float* O; int ldc; const float* ss;
    __device__ __forceinline__ void operator()(const f32x4 (&acc)[2][2][4][2], const Unit& u, int wr, int wc, int fr, int fq) const {
        const int row0 = u.pm * BM + wr * 64 + fr, col0 = u.pn * BM + wc * 32 + 8 * fq;
        f32x4 rs[2][2];
#pragma unroll
        for (int bj = 0; bj < 2; ++bj)
#pragma unroll
            for (int n = 0; n < 2; ++n) { const f32x4 s = *(const f32x4*)(ss + col0 + bj * HALF + 4 * n);
#pragma unroll
                for (int e = 0; e < 4; ++e) rs[bj][n][e] = __builtin_amdgcn_rsqf(s[e] * (1.f / DM) + EPS); }
#pragma unroll
        for (int ai = 0; ai < 2; ++ai)
#pragma unroll
            for (int m = 0; m < 4; ++m) { float* rowp = O + (size_t)(row0 + ai * HALF + m * 16) * ldc + col0;
#pragma unroll
                for (int bj = 0; bj < 2; ++bj) { *(f32x4*)(rowp + bj * HALF) = acc[ai][bj][m][0] * rs[bj][0]; *(f32x4*)(rowp + bj * HALF + 4) = acc[ai][bj][m][1] * rs[bj][1]; } }
    }
};
struct EpiSoftmax {
    static constexpr bool PERM = true, AFTER_DRAIN = true;
    bf16_t* P; int ldc; long sCb, sCh; int nH; const float* ss; float mul; int zrows;
    __device__ __forceinline__ void fused(f32x4 (&acc)[2][2][4][2], const Unit& u, int wr, int wc, int fr, int fq, PG8_LAS unsigned char* lds, int wid, int lane) const {
        PG8_LAS float* Pm = (PG8_LAS float*)lds;
        PG8_LAS float* Ps = (PG8_LAS float*)(lds + 4096);
#pragma unroll
        for (int ai = 0; ai < 2; ++ai)
#pragma unroll
            for (int m = 0; m < 4; ++m) { float mx = -3.0e38f;
                const float rs = __builtin_amdgcn_rsqf(ss[u.z * zrows + u.pm * BM + ai * HALF + wr * 64 + m * 16 + fr] * (1.f / DM) + EPS) * mul;
#pragma unroll
                for (int bj = 0; bj < 2; ++bj)
#pragma unroll
                    for (int n = 0; n < 2; ++n) { const f32x4 x = acc[ai][bj][m][n] * rs; acc[ai][bj][m][n] = x; mx = fmaxf(mx, fmaxf(fmaxf(x[0], x[1]), fmaxf(x[2], x[3]))); }
                mx = fmaxf(mx, __shfl_xor(mx, 16)); mx = fmaxf(mx, __shfl_xor(mx, 32));
                if (fq == 0) Pm[(ai * HALF + wr * 64 + m * 16 + fr) * 4 + wc] = mx; }
        asm volatile("s_waitcnt lgkmcnt(0)" ::: "memory"); __builtin_amdgcn_s_barrier(); asm volatile("" ::: "memory");
#pragma unroll
        for (int ai = 0; ai < 2; ++ai)
#pragma unroll
            for (int m = 0; m < 4; ++m) { const int r = ai * HALF + wr * 64 + m * 16 + fr;
                const f32x4 pm4 = *(const PG8_LAS f32x4*)(Pm + r * 4); const float M = fmaxf(fmaxf(pm4[0], pm4[1]), fmaxf(pm4[2], pm4[3])); float s = 0.f;
#pragma unroll
                for (int bj = 0; bj < 2; ++bj)
#pragma unroll
                    for (int n = 0; n < 2; ++n) { f32x4 x = acc[ai][bj][m][n];
#pragma unroll
                        for (int e = 0; e < 4; ++e) { x[e] = __builtin_amdgcn_exp2f(x[e] - M); s += x[e]; }
                        acc[ai][bj][m][n] = x; }
                s += __shfl_xor(s, 16); s += __shfl_xor(s, 32);
                if (fq == 0) Ps[r * 4 + wc] = s; }
        asm volatile("s_waitcnt lgkmcnt(0)" ::: "memory"); __builtin_amdgcn_s_barrier(); asm volatile("" ::: "memory");
        bf16_t* base = P + (u.z / nH) * sCb + (u.z % nH) * sCh;
        const int row0 = u.pm * BM, col0 = u.pn * BM + wc * 32 + 8 * fq;
#pragma unroll
        for (int ai = 0; ai < 2; ++ai)
#pragma unroll
            for (int m = 0; m < 4; ++m) { const int r = ai * HALF + wr * 64 + m * 16 + fr;
                const f32x4 ps4 = *(const PG8_LAS f32x4*)(Ps + r * 4); const float inv = 1.f / ((ps4[0] + ps4[1]) + (ps4[2] + ps4[3]));
                bf16_t* rowp = base + (size_t)(row0 + r) * ldc + col0;
#pragma unroll
                for (int bj = 0; bj < 2; ++bj) { const f32x4 v0 = acc[ai][bj][m][0] * inv, v1 = acc[ai][bj][m][1] * inv;
                    u32x4 w; w.x = cvt_pk_bf16(v0[0], v0[1]); w.y = cvt_pk_bf16(v0[2], v0[3]); w.z = cvt_pk_bf16(v1[0], v1[1]); w.w = cvt_pk_bf16(v1[2], v1[3]);
                    *(u32x4*)(rowp + bj * HALF) = w; } }
    }
};

template <class Epi, class Sched, bool ALIGN_EPI>
__device__ __forceinline__ void gemm_phase(PG8_LAS unsigned char* lds, const Gemm g, const Sched& S, const Epi& E) {
    const int tid = threadIdx.x, wid = __builtin_amdgcn_readfirstlane(tid >> 6), lane = tid & 63, wr = wid >> 2, wc = wid & 3, fr = lane & 15, fq = lane >> 4;
    const int K = g.K, nt = K / BK;
    unsigned voffA[2], voffB[2];
#pragma unroll
    for (int i = 0; i < 2; ++i) { int R, C; stage_rc(tid * 16 + i * 8192, R, C); const int Rb = Epi::PERM ? ((R & ~31) + perm32(R & 31)) : R;
        voffA[i] = (unsigned)(R * g.lda + C) * 2u; voffB[i] = (unsigned)(Rb * g.ldb + C) * 2u; }
    const size_t kstep = (size_t)(BK * 2);
    const size_t hsA = (size_t)HALF * g.lda * 2, hsB = (size_t)HALF * g.ldb * 2;
    const unsigned ldsw = (unsigned)wid * 1024u;
    const int aoff = lds_byte(wr * 64 + fr, fq * 8), boff = lds_byte(wc * 32 + fr, fq * 8);
#define PG8_SA(b, h) (((b) * 2 + (h)) * HTB)
#define PG8_SB(b, h) ((4 + (b) * 2 + (h)) * HTB)
#define PG8_STAGE(bufoff, gbase, voff) do { _Pragma("unroll") for (int _i = 0; _i < 2; ++_i) \
        __builtin_amdgcn_global_load_lds((const unsigned*)((const char*)(gbase) + (voff)[_i]), (PG8_LAS unsigned*)(lds + (bufoff) + ldsw + _i * 8192), 16, 0, 0); } while (0)
#define PG8_LDA(dst, b, h) do { _Pragma("unroll") for (int m = 0; m < 4; ++m) _Pragma("unroll") for (int k = 0; k < 2; ++k) dst[m][k] = *(const PG8_LAS bf16x8*)(lds + PG8_SA(b, h) + aoff + m * 2048 + k * 1024); } while (0)
#define PG8_LDB(dst, b, h) do { _Pragma("unroll") for (int n = 0; n < 2; ++n) _Pragma("unroll") for (int k = 0; k < 2; ++k) dst[n][k] = *(const PG8_LAS bf16x8*)(lds + PG8_SB(b, h) + boff + n * 2048 + k * 1024); } while (0)
#define PG8_MMA(ai, bj, At, Bt) do { __builtin_amdgcn_s_setprio(1); _Pragma("unroll") for (int m = 0; m < 4; ++m) _Pragma("unroll") for (int n = 0; n < 2; ++n) _Pragma("unroll") for (int k = 0; k < 2; ++k) \
        acc[ai][bj][m][n] = __builtin_amdgcn_mfma_f32_16x16x32_bf16(Bt[n][k], At[m][k], acc[ai][bj][m][n], 0, 0, 0); __builtin_amdgcn_s_setprio(0); } while (0)
#define PG8_WAIT_V(n) asm volatile("s_waitcnt vmcnt(" #n ")" ::: "memory")
#define PG8_WAIT_L(n) asm volatile("s_waitcnt lgkmcnt(" #n ")" ::: "memory")
#define PG8_BAR __builtin_amdgcn_s_barrier()
#define PG8_SCHED __builtin_amdgcn_sched_barrier(0)
    Unit cur, nxt; int ui = 0;
    if (!S.next(0, cur)) return;
    f32x4 acc[2][2][4][2];
#pragma unroll
    for (int a = 0; a < 2; ++a)
#pragma unroll
        for (int b = 0; b < 2; ++b)
#pragma unroll
            for (int m = 0; m < 4; ++m)
#pragma unroll
                for (int n = 0; n < 2; ++n) acc[a][b][m][n] = (f32x4){0.f, 0.f, 0.f, 0.f};
    bf16x8 At[4][2], B0[2][2], B1[2][2];
    const char* cA = (const char*)g.A + (size_t)cur.aoff * 2; const char* cB = (const char*)g.Bt + (size_t)cur.boff * 2;
    S.a_ready(cur);
    PG8_STAGE(PG8_SB(0, 0), cB, voffB); PG8_STAGE(PG8_SB(0, 1), cB + hsB, voffB); PG8_STAGE(PG8_SA(0, 0), cA, voffA); PG8_STAGE(PG8_SA(0, 1), cA + hsA, voffA);
    if (wr == 1) PG8_BAR;
    PG8_WAIT_V(2); PG8_BAR;
    PG8_STAGE(PG8_SB(1, 0), cB + kstep, voffB); PG8_STAGE(PG8_SA(1, 0), cA + kstep, voffA); PG8_STAGE(PG8_SB(1, 1), cB + hsB + kstep, voffB);
    PG8_WAIT_V(6); PG8_BAR;
    for (;;) {
        const bool has_next = S.next(ui + 1, nxt);
        const char* nA = has_next ? (const char*)g.A + (size_t)nxt.aoff * 2 : cA; const char* nB = has_next ? (const char*)g.Bt + (size_t)nxt.boff * 2 : cB;
        for (int t = 0; t < nt; t += 2) {
            const bool last = (t == nt - 2);
            const char* a1 = cA + (size_t)(t + 1) * kstep;
            const char* a2 = last ? nA : cA + (size_t)(t + 2) * kstep; const char* b2 = last ? nB : cB + (size_t)(t + 2) * kstep;
            const char* a3 = a2 + kstep; const char* b3 = b2 + kstep;
            if (last && has_next) S.a_ready(nxt);
            PG8_LDB(B0, 0, 0); PG8_LDB(B1, 0, 1); PG8_SCHED; PG8_LDA(At, 0, 0); PG8_STAGE(PG8_SA(1, 1), a1 + hsA, voffA);
            PG8_WAIT_V(8); PG8_WAIT_L(0); PG8_BAR; PG8_MMA(0, 0, At, B0); PG8_MMA(0, 1, At, B1); PG8_BAR; PG8_SCHED;
            PG8_LDA(At, 0, 1); PG8_STAGE(PG8_SB(0, 0), b2, voffB); PG8_STAGE(PG8_SB(0, 1), b2 + hsB, voffB); PG8_STAGE(PG8_SA(0, 0), a2, voffA);
            PG8_WAIT_V(8); PG8_WAIT_L(0); PG8_BAR; PG8_MMA(1, 0, At, B0); PG8_MMA(1, 1, At, B1); PG8_BAR; PG8_SCHED;
            PG8_LDB(B0, 1, 0); PG8_LDB(B1, 1, 1); PG8_SCHED; PG8_LDA(At, 1, 0); PG8_STAGE(PG8_SA(0, 1), a2 + hsA, voffA);
            PG8_WAIT_V(8); PG8_WAIT_L(0); PG8_BAR; PG8_MMA(0, 0, At, B0); PG8_MMA(0, 1, At, B1); PG8_BAR; PG8_SCHED;
            PG8_LDA(At, 1, 1); PG8_STAGE(PG8_SB(1, 0), b3, voffB); PG8_STAGE(PG8_SB(1, 1), b3 + hsB, voffB); PG8_STAGE(PG8_SA(1, 0), a3, voffA);
            PG8_WAIT_V(8); PG8_WAIT_L(0); PG8_BAR; PG8_MMA(1, 0, At, B0); PG8_MMA(1, 1, At, B1); PG8_BAR; PG8_SCHED;
        }
        if constexpr (ALIGN_EPI) { if (wr == 0) PG8_BAR; }
        if constexpr (!Epi::AFTER_DRAIN) { E(acc, cur, wr, wc, fr, fq); S.done(cur); }
        if (!has_next) break;
#pragma unroll
        for (int a = 0; a < 2; ++a)
#pragma unroll
            for (int b = 0; b < 2; ++b)
#pragma unroll
                for (int m = 0; m < 4; ++m)
#pragma unroll
                    for (int n = 0; n < 2; ++n) acc[a][b][m][n] = (f32x4){0.f, 0.f, 0.f, 0.f};
        cur = nxt; cA = nA; cB = nB; ++ui;
        if constexpr (ALIGN_EPI) { if (wr == 1) PG8_BAR; }
    }
    PG8_WAIT_V(0);
    if constexpr (!ALIGN_EPI) { if (wr == 0) PG8_BAR; }
    PG8_BAR;
    if constexpr (Epi::AFTER_DRAIN) { E.fused(acc, cur, wr, wc, fr, fq, lds, wid, lane); S.done(cur); }
#undef PG8_SA
#undef PG8_SB
#undef PG8_STAGE
#undef PG8_LDA
#undef PG8_LDB
#undef PG8_MMA
#undef PG8_WAIT_V
#undef PG8_WAIT_L
#undef PG8_BAR
#undef PG8_SCHED
}
}

namespace fox {
typedef unsigned short bf16_t;
typedef short bf16x8 __attribute__((ext_vector_type(8)));
typedef short s16x4 __attribute__((ext_vector_type(4)));
typedef float f32x16 __attribute__((ext_vector_type(16)));
typedef float f32x4 __attribute__((ext_vector_type(4)));
typedef unsigned u32x4 __attribute__((ext_vector_type(4)));
constexpr int D = 128, NW = 8, QBLK = 32, KVBLK = 64, QB = NW * QBLK;
constexpr int SHM_V = KVBLK * D * 2, SHM_K = KVBLK * D * 2;
constexpr int LDS_C = 2 * SHM_V + 2 * SHM_K + NW * 64 * 4;
constexpr int LDS_BYTES = LDS_C + SEQ * 4;
constexpr int QP = 4096, OP = 2048;
constexpr float THR = 24.f;
#define KSWZ(row, colB) ((row) * 256 + ((colB) ^ (((row) & 7) << 4)))
#define SBAR() __builtin_amdgcn_sched_barrier(0)
__device__ __forceinline__ int v_st(int k, int c) { const int kk = (k & ~0xC) | ((k & 4) << 1) | ((k & 8) >> 1); return ((kk >> 3) * 4 + (c >> 5)) * 512 + ((kk & 7) * 32 + (c & 31)) * 2; }
__device__ __forceinline__ int v_rd_base(int lane) { return ((lane & 3) << 3) | (((lane >> 2) & 3) << 6) | (((lane >> 4) & 1) << 5) | (((lane >> 5) & 1) << 8); }
constexpr int v_rd_off(int d0, int ks, int half) { return d0 * 512 + ks * 4096 + half * 2048; }
__device__ __forceinline__ int crow(int r, int hi) { return (r & 3) + 8 * (r >> 2) + 4 * hi; }
__device__ __forceinline__ unsigned cvtpk(float lo, float hi) { unsigned r; asm volatile("v_cvt_pk_bf16_f32 %0, %1, %2" : "=v"(r) : "v"(lo), "v"(hi)); return r; }
__device__ __forceinline__ bf16x8 load8(const bf16_t* p) { return *reinterpret_cast<const bf16x8*>(p); }
__device__ __forceinline__ void mask_tile(f32x16& p0, f32x16& p1, int dq) {
    const float NEG = -__builtin_inff();
#pragma unroll
    for (int r = 0; r < 16; ++r) { const int c = (r & 3) + 8 * (r >> 2); if (dq - c < 0) p0[r] = NEG; if (dq - c - 32 < 0) p1[r] = NEG; }
}
__device__ __forceinline__ void bias_tile(f32x16& p0, f32x16& p1, const float* cb) {
#pragma unroll
    for (int i = 0; i < 4; ++i) { const f32x4 c0 = *(const f32x4*)(cb + 8 * i), c1 = *(const f32x4*)(cb + 32 + 8 * i);
#pragma unroll
        for (int j = 0; j < 4; ++j) { p0[4 * i + j] -= c0[j]; p1[4 * i + j] -= c1[j]; } }
}
__device__ __forceinline__ void partialSM(f32x16& p0, f32x16& p1, float& m_reg, float& mn, float& alpha) {
    float pmax = p0[0]; for (int r = 1; r < 16; ++r) pmax = fmaxf(pmax, p0[r]); for (int r = 0; r < 16; ++r) pmax = fmaxf(pmax, p1[r]);
    { auto rr = __builtin_amdgcn_permlane32_swap(__float_as_uint(pmax), __float_as_uint(pmax), false, false);
      pmax = fmaxf(__uint_as_float(rr[0]), __uint_as_float(rr[1])); }
    if (__builtin_expect(__all((pmax - m_reg) <= THR), 1)) { mn = m_reg; alpha = 1.f; }
    else { mn = fmaxf(m_reg, pmax); alpha = __builtin_amdgcn_exp2f(m_reg - mn); m_reg = mn; }
    for (int r = 0; r < 16; ++r) p0[r] = p0[r] - mn; for (int r = 0; r < 16; ++r) p1[r] = p1[r] - mn;
    for (int r = 0; r < 16; ++r) p0[r] = __builtin_amdgcn_exp2f(p0[r]);
}
__device__ __forceinline__ void finishSM(f32x16& p0, f32x16& p1, float alpha, float& l_reg, bf16x8& pa0, bf16x8& pa1, bf16x8& pa2, bf16x8& pa3) {
    for (int r = 0; r < 16; ++r) p1[r] = __builtin_amdgcn_exp2f(p1[r]);
    float ps = 0; for (int r = 0; r < 16; ++r) ps += p0[r]; for (int r = 0; r < 16; ++r) ps += p1[r];
    { auto rr = __builtin_amdgcn_permlane32_swap(__float_as_uint(ps), __float_as_uint(ps), false, false);
      ps = __uint_as_float(rr[0]) + __uint_as_float(rr[1]); }
    l_reg = l_reg * alpha + ps;
#define PK4(P, B_, OUT) do { unsigned a0 = cvtpk(P[B_+0], P[B_+1]), a1 = cvtpk(P[B_+2], P[B_+3]);                          \
        unsigned b0 = cvtpk(P[B_+4], P[B_+5]), b1 = cvtpk(P[B_+6], P[B_+7]);                                             \
        auto r0 = __builtin_amdgcn_permlane32_swap(a0, b0, false, false); auto r1 = __builtin_amdgcn_permlane32_swap(a1, b1, false, false); \
        u32x4 w = {r0[0], r1[0], r0[1], r1[1]}; OUT = *reinterpret_cast<bf16x8*>(&w); } while (0)
    PK4(p0, 0, pa0); PK4(p0, 8, pa1); PK4(p1, 0, pa2); PK4(p1, 8, pa3);
#undef PK4
}
template <int KB>
__device__ __forceinline__ void qkt(f32x16& p0, f32x16& p1, const char* K_lds, int r32, int hi, const bf16x8* qr) {
    p0 = f32x16{}; p1 = f32x16{};
    const char* kb[4];
#pragma unroll
    for (int dd = 0; dd < 4; ++dd) kb[dd] = K_lds + KB * SHM_K + KSWZ(r32, (dd * 16 + hi * 8) * 2);
#pragma unroll
    for (int d0 = 0; d0 < 8; ++d0) { const char* a = kb[d0 & 3] + (d0 >> 2) * 128;
        bf16x8 b0 = *reinterpret_cast<const bf16x8*>(a);
        bf16x8 b1 = *reinterpret_cast<const bf16x8*>(a + 32 * 256);
        p0 = __builtin_amdgcn_mfma_f32_32x32x16_bf16(b0, qr[d0], p0, 0, 0, 0);
        p1 = __builtin_amdgcn_mfma_f32_32x32x16_bf16(b1, qr[d0], p1, 0, 0, 0); }
}
template <int VB>
__device__ __forceinline__ void pv_tile(f32x16* o, int vb0, bf16x8 pa0, bf16x8 pa1, bf16x8 pa2, bf16x8 pa3) {
#define TRRD(dst, off) asm volatile("ds_read_b64_tr_b16 %0, %1 offset:%2" : "=&v"(dst) : "v"(vb0), "i"(off) : "memory")
#define PV_D0(d0) do { s16x4 l0, l1, l2, l3, h0, h1, h2, h3; constexpr int b_ = VB * SHM_V + v_rd_off(d0, 0, 0); \
        TRRD(l0, b_); TRRD(h0, b_ + 2048); TRRD(l1, b_ + 4096); TRRD(h1, b_ + 6144); TRRD(l2, b_ + 8192); TRRD(h2, b_ + 10240); TRRD(l3, b_ + 12288); TRRD(h3, b_ + 14336); \
        asm volatile("s_waitcnt lgkmcnt(0)" ::: "memory"); SBAR();   \
        o[d0] = __builtin_amdgcn_mfma_f32_32x32x16_bf16(pa0, (bf16x8){l0[0], l0[1], l0[2], l0[3], h0[0], h0[1], h0[2], h0[3]}, o[d0], 0, 0, 0);   \
        o[d0] = __builtin_amdgcn_mfma_f32_32x32x16_bf16(pa1, (bf16x8){l1[0], l1[1], l1[2], l1[3], h1[0], h1[1], h1[2], h1[3]}, o[d0], 0, 0, 0);   \
        o[d0] = __builtin_amdgcn_mfma_f32_32x32x16_bf16(pa2, (bf16x8){l2[0], l2[1], l2[2], l2[3], h2[0], h2[1], h2[2], h2[3]}, o[d0], 0, 0, 0);   \
        o[d0] = __builtin_amdgcn_mfma_f32_32x32x16_bf16(pa3, (bf16x8){l3[0], l3[1], l3[2], l3[3], h3[0], h3[1], h3[2], h3[3]}, o[d0], 0, 0, 0); } while (0)
    PV_D0(0); PV_D0(1); PV_D0(2); PV_D0(3);
#undef PV_D0
#undef TRRD
}
struct BlockRef { const bf16_t* Q; const bf16_t* K; const bf16_t* V; bf16_t* O; int P0; };
struct Seam { bf16x8 qr[8]; bf16x8 st_v0, st_v1, st_k0, st_k1; };
#define ROW(p, k0, rr) ((p) + (size_t)((k0) + (rr)) * QP + sc)
#define VMW() asm volatile("s_waitcnt vmcnt(0)" ::: "memory")
#define VMWN(n) asm volatile("s_waitcnt vmcnt(%0)" :: "i"(n) : "memory")
#define SLOAD_H(Kp, Vp, k0) do { S.st_v0 = load8(ROW(Vp, k0, sr)); S.st_v1 = load8(ROW(Vp, k0, 32 + sr)); S.st_k0 = load8(ROW(Kp, k0, sr)); S.st_k1 = load8(ROW(Kp, k0, 32 + sr)); } while (0)
#define SWRITE_HK(bf) do { *(bf16x8*)(K_lds + (bf) * SHM_K + kws) = S.st_k0; *(bf16x8*)(K_lds + (bf) * SHM_K + kws + 32 * 256) = S.st_k1; } while (0)
#define SWRITE_HV(bf) do { *(bf16x8*)(V_lds + (bf) * SHM_V + vst0) = S.st_v0; *(bf16x8*)(V_lds + (bf) * SHM_V + vst1) = S.st_v1; } while (0)
#define SWRITE_H(bf) do { SWRITE_HV(bf); SWRITE_HK(bf); } while (0)
__device__ __forceinline__ void prime(const BlockRef& cur, char* lds, Seam& S) {
    const int tid = threadIdx.x, wid = __builtin_amdgcn_readfirstlane(tid >> 6), lane = tid & 63, r32 = lane & 31, hi = lane >> 5;
    const int sr = tid >> 4, sc = (tid & 15) * 8, kws = KSWZ(sr, sc * 2); char* K_lds = lds + 2 * SHM_V;
    for (int d0 = 0; d0 < 8; ++d0) S.qr[d0] = load8(cur.Q + (size_t)(wid * QBLK + r32) * QP + d0 * 16 + hi * 8);
    SLOAD_H(cur.K, cur.V, 0); VMW(); SWRITE_HK(0);
    __syncthreads();
}
__device__ __forceinline__ void block(const BlockRef& cur, const BlockRef& nxt, char* lds, Seam& S) {
    const int tid = threadIdx.x, wid = __builtin_amdgcn_readfirstlane(tid >> 6), lane = tid & 63, r32 = lane & 31, hi = lane >> 5;
    const int NT = (cur.P0 + QB - 1) / KVBLK + 1;
    const int qlo = cur.P0 + wid * QBLK, qm = qlo + r32 - 4 * hi;
    char* V_lds = lds; char* K_lds = lds + 2 * SHM_V;
    float* ws = (float*)(lds + 2 * SHM_V + 2 * SHM_K) + wid * 64; float* li_l = ws, * al_l = ws + 32;
    const float* c_lds = (const float*)(lds + LDS_C) + 4 * hi;
    float m_reg = -1e30f, l_reg = 0; f32x16 o[4] = {};
    const int sr = tid >> 4, sc = (tid & 15) * 8, vst0 = v_st(sr, sc), vst1 = v_st(32 + sr, sc), kws = KSWZ(sr, sc * 2);
    const int vb0 = (int)(uintptr_t)V_lds + v_rd_base(lane);
    const bf16_t* Kh = cur.K; const bf16_t* Vh = cur.V;
#define RESC(a) do { if (__any((a) < 1.f)) { if (hi == 0) al_l[r32] = (a); asm volatile("s_waitcnt lgkmcnt(0)" ::: "memory");              \
                     for (int d_ = 0; d_ < 4; ++d_) for (int r = 0; r < 16; ++r) o[d_][r] *= al_l[crow(r, hi)]; } } while (0)
#define KBASE(t) ((t) * KVBLK)
#define MASKT(P0_, P1_, t) do { const int kb_ = KBASE(t); bias_tile(P0_, P1_, c_lds + kb_); if (kb_ + KVBLK - 1 > qlo) mask_tile(P0_, P1_, qm - kb_); } while (0)
#define SEAM_K0() do { VMWN(8); SWRITE_HK(0); SBAR(); } while (0)
    f32x16 pA0, pA1, pB0, pB1; float mnA, mnB, alA, alB; bf16x8 pa0, pa1, pa2, pa3;
    SWRITE_HV(0); SBAR();
    if (NT > 1) { SLOAD_H(Kh, Vh, KBASE(1)); }
    SBAR(); qkt<0>(pA0, pA1, K_lds, r32, hi, S.qr);
    MASKT(pA0, pA1, 0); partialSM(pA0, pA1, m_reg, mnA, alA);
    if (NT > 1) { VMW(); SWRITE_H(1); }
    __syncthreads();
#define HALF_STEP(PX0, PX1, mnX, alX, PY0, PY1, alY, t, KB, VB, SB) do {                                                      \
        SBAR(); qkt<KB>(PX0, PX1, K_lds, r32, hi, S.qr);                                                                     \
        finishSM(PY0, PY1, alY, l_reg, pa0, pa1, pa2, pa3); SBAR();                                                           \
        if ((t) + 1 < NT) { SLOAD_H(Kh, Vh, KBASE((t) + 1)); SBAR(); }                                                        \
        pv_tile<VB>(o, vb0, pa0, pa1, pa2, pa3); MASKT(PX0, PX1, (t)); partialSM(PX0, PX1, m_reg, mnX, alX);                 \
        __syncthreads();                                                                                                      \
        if ((t) + 1 < NT) { VMW(); SWRITE_H(SB); }                                                                            \
        RESC(alX); __syncthreads(); } while (0)
    for (int t = 1; t + 1 < NT; t += 2) {
        HALF_STEP(pB0, pB1, mnB, alB, pA0, pA1, alA, t, 1, 0, 0);
        HALF_STEP(pA0, pA1, mnA, alA, pB0, pB1, alB, t + 1, 0, 1, 1);
    }
    const bool even = (NT & 1) == 0;
    if (even) { SBAR(); qkt<1>(pB0, pB1, K_lds, r32, hi, S.qr); SBAR(); }
    SLOAD_H(nxt.K, nxt.V, 0); SBAR();
#pragma unroll
    for (int d0 = 0; d0 < 8; ++d0) S.qr[d0] = load8(nxt.Q + (size_t)(wid * QBLK + r32) * QP + d0 * 16 + hi * 8);
    SBAR();
    finishSM(pA0, pA1, alA, l_reg, pa0, pa1, pa2, pa3); SBAR();
    pv_tile<0>(o, vb0, pa0, pa1, pa2, pa3);
    if (even) { MASKT(pB0, pB1, NT - 1); partialSM(pB0, pB1, m_reg, mnB, alB); __syncthreads(); RESC(alB);
        finishSM(pB0, pB1, alB, l_reg, pa0, pa1, pa2, pa3); SBAR(); pv_tile<1>(o, vb0, pa0, pa1, pa2, pa3); }
    SBAR(); SEAM_K0();
    if (hi == 0) li_l[r32] = l_reg; asm volatile("s_waitcnt lgkmcnt(0)" ::: "memory");
    float rli[16];
#pragma unroll
    for (int r = 0; r < 16; ++r) rli[r] = __builtin_amdgcn_rcpf(li_l[crow(r, hi)]);
    bf16_t* Ow = cur.O + (size_t)(wid * QBLK) * OP;
#pragma unroll
    for (int r = 0; r < 16; ++r) { const int orow = crow(r, hi);
#pragma unroll
        for (int d0 = 0; d0 < 4; ++d0) { const float v = o[d0][r] * rli[r];
            const float vn = __shfl_xor(v, 1);
            if ((r32 & 1) == 0) *(unsigned*)(Ow + (size_t)orow * OP + d0 * 32 + r32) = cvtpk(v, vn); } }
    __syncthreads();
#undef RESC
#undef KBASE
#undef MASKT
#undef SEAM_K0
#undef HALF_STEP
}
#undef ROW
#undef VMW
#undef VMWN
#undef SLOAD_H
#undef SWRITE_HK
#undef SWRITE_HV
#undef SWRITE_H
#undef KSWZ
#undef SBAR
}

constexpr int NWAVES = 8, NTHREADS = 512;
constexpr int LDS_BYTES = 147456;
constexpr int LDS_MISC = 145408;
constexpr size_t MiB = 1u << 20;
constexpr size_t WS_CTL = 0, CTL_ZERO_BYTES = 1 * MiB;
#ifndef QSPLIT
#define QSPLIT 1024
#endif
constexpr int CW_QUEUE2 = 128;
constexpr int CW_QUEUE = 64;
constexpr int CW_BAR = 4096;
constexpr size_t CTL_SS1 = 256 * 1024, CTL_SS2 = 320 * 1024;
constexpr size_t WS_LF = 1 * MiB;
constexpr size_t WS_SU = 1 * MiB + 512 * 1024, WS_SV = 1 * MiB + 640 * 1024;
constexpr size_t WS_WIN = 2 * MiB, WS_WO1 = 18 * MiB, WS_WO2 = 26 * MiB, WS_WQ = 34 * MiB, WS_WK = 42 * MiB, WS_WV = 50 * MiB, WS_WO = 58 * MiB;
constexpr size_t WS_WPQ = 66 * MiB, WS_AEXP = 74 * MiB, WS_WSC = 82 * MiB, WS_PB = 90 * MiB, WS_MN = 91 * MiB, WS_KX = 93 * MiB, WS_VXT = 95 * MiB;
constexpr size_t WS_UB = 98 * MiB, WS_VB = 130 * MiB, WS_XN = 226 * MiB, WS_PROJ = 258 * MiB, WS_AMIX = 322 * MiB, WS_H = 354 * MiB, WS_HB = 418 * MiB, WS_P = 450 * MiB, WS_END = 466 * MiB;

#define GAS __attribute__((address_space(1)))
#define LAS __attribute__((address_space(3)))
typedef unsigned short bf16;
typedef unsigned v4u __attribute__((ext_vector_type(4)));
typedef unsigned v2u __attribute__((ext_vector_type(2)));
typedef float f32x4 __attribute__((ext_vector_type(4)));
typedef __bf16 bf16x2_t __attribute__((ext_vector_type(2)));
#define LDS_WAIT() asm volatile("s_waitcnt lgkmcnt(0)" ::: "memory")
__device__ __forceinline__ unsigned f2bf(float f) { unsigned u = __builtin_bit_cast(unsigned, f); return (u + 0x7fffu + ((u >> 16) & 1u)) >> 16; }
__device__ __forceinline__ unsigned pk2(float lo, float hi) { return f2bf(lo) | (f2bf(hi) << 16); }
__device__ __forceinline__ float wave_sum(float v) {
#pragma unroll
    for (int o = 1; o < 64; o <<= 1) v += __shfl_xor(v, o);
    return v;
}

#define XB_TMO      128
#define XB_XCNT(j)  (256  + 64 * (j))
#define XB_XSUB(j)  (1280 + 64 * (j))
#define XB_XGEN(j)  (2304 + 64 * (j))
#define XB_TOP      3328
#define XB_TOPGEN   3392
#define XCD_BAR_WORDS 3456
#define XB_SPIN_CAP (1u << 22)
__device__ __forceinline__ unsigned xb_ld(unsigned* p)              { return __hip_atomic_load(p, __ATOMIC_RELAXED, __HIP_MEMORY_SCOPE_AGENT); }
__device__ __forceinline__ unsigned xb_add(unsigned* p, unsigned v) { return __hip_atomic_fetch_add(p, v, __ATOMIC_RELAXED, __HIP_MEMORY_SCOPE_AGENT); }
__device__ __forceinline__ unsigned xb_xcc_id() { return (unsigned)__builtin_amdgcn_s_getreg((3 << 11) | 20) & 0xFu; }
#define XB_SPIN(cond, bar) do { unsigned _sp = 0; while (cond) { __builtin_amdgcn_s_sleep(1); \
    if ((++_sp & 255u) == 0u) { if (xb_ld(&(bar)[XB_TMO])) break; if (_sp > XB_SPIN_CAP) { atomicAdd(&(bar)[XB_TMO], 1u); break; } } } } while (0)
struct XcdBarrier { unsigned* bar; unsigned x; volatile LAS unsigned* st; };
__device__ __forceinline__ XcdBarrier xcd_barrier_post(unsigned* bar, volatile LAS unsigned* st) {
    XcdBarrier b; b.bar = bar; b.x = xb_xcc_id(); b.st = st;
    if (threadIdx.x == 0) (void)xb_add(&bar[XB_XCNT(b.x)], 1u);
    return b;
}
__device__ __forceinline__ void xcd_barrier_complete(unsigned* bar, unsigned x, unsigned& nloc, unsigned& nx) {
    const unsigned G = gridDim.x * gridDim.y * gridDim.z;
    unsigned sum, cnt, mine, sp = 0u;
    for (;;) {
        sum = 0u; cnt = 0u; mine = 0u;
#pragma unroll
        for (unsigned j = 0; j < 16; ++j) { const unsigned c = xb_ld(&bar[XB_XCNT(j)]); sum += c; cnt += (c > 0u) ? 1u : 0u; mine = (j == x) ? c : mine; }
        if (sum == G) break;
        __builtin_amdgcn_s_sleep(1);
        if ((++sp & 255u) == 0u) { if (xb_ld(&bar[XB_TMO])) break; if (sp > XB_SPIN_CAP) { atomicAdd(&bar[XB_TMO], 1u); break; } }
    }
    nloc = mine > 0u ? mine : 1u; nx = cnt > 0u ? cnt : 1u;
}
__device__ __forceinline__ void xcd_barrier(const XcdBarrier& b) {
    asm volatile("s_waitcnt vmcnt(0)" ::: "memory");
    __syncthreads();
    if (threadIdx.x == 0) {
        unsigned* bar = b.bar;
        __builtin_amdgcn_s_waitcnt(0);
        unsigned nloc = b.st[0], nx = b.st[1];
        if (nloc == 0u) { xcd_barrier_complete(bar, b.x, nloc, nx); b.st[0] = nloc; b.st[1] = nx; }
        const unsigned old = xb_add(&bar[XB_XSUB(b.x)], 1u);
        const unsigned gen = old / nloc;
        if (old + 1u == (gen + 1u) * nloc) {
            __builtin_amdgcn_fence(__ATOMIC_RELEASE, "agent");
            asm volatile("s_waitcnt vmcnt(0)" ::: "memory");
            const unsigned og = xb_add(&bar[XB_TOP], 1u);
            const unsigned tg = og / nx;
            if (og + 1u == (tg + 1u) * nx) xb_add(&bar[XB_TOPGEN], 1u);
            else XB_SPIN(xb_ld(&bar[XB_TOPGEN]) == tg, bar);
            __builtin_amdgcn_fence(__ATOMIC_ACQUIRE, "agent");
            xb_add(&bar[XB_XGEN(b.x)], 1u);
            asm volatile("s_waitcnt vmcnt(0)" ::: "memory");
        } else {
            XB_SPIN(xb_ld(&bar[XB_XGEN(b.x)]) == gen, bar);
            __builtin_amdgcn_fence(__ATOMIC_ACQUIRE, "agent");
            asm volatile("s_waitcnt vmcnt(0)" ::: "memory");
        }
    }
    __syncthreads();
}

struct Args { const float* in[20]; float* out; unsigned char* ws; int ph_lo, ph_hi; int one_launch, pad; };

__device__ __forceinline__ void p0_transpose_item(const float* W, int ldw, int nblk, const float* g, bf16* WT, bf16* WT2, int k2lo, int ldt, LAS float* scr, int item, int lane) {
    const int kb = item / nblk, nb = item % nblk, k0 = 64 * kb, n0 = 32 * nb;
#pragma unroll
    for (int i = 0; i < 32; ++i) { const int kk = 2 * i + (lane >> 5); float v = W[(size_t)(k0 + kk) * ldw + n0 + (lane & 31)]; if (g) v *= g[k0 + kk]; scr[kk * 33 + (lane & 31)] = v; }
    LDS_WAIT(); asm volatile("" ::: "memory");
    const int c = lane & 7;
#pragma unroll
    for (int j = 0; j < 4; ++j) { const int n = (lane >> 3) + 8 * j; const LAS float* s = scr + (8 * c) * 33 + n;
        v4u o; o.x = pk2(s[0 * 33], s[1 * 33]); o.y = pk2(s[2 * 33], s[3 * 33]); o.z = pk2(s[4 * 33], s[5 * 33]); o.w = pk2(s[6 * 33], s[7 * 33]);
        *(GAS v4u*)(WT + (size_t)(n0 + n) * ldt + k0 + 8 * c) = o;
        if (WT2 && k0 >= k2lo) *(GAS v4u*)(WT2 + (size_t)(n0 + n) * ldt + k0 + 8 * c) = o; }
    LDS_WAIT(); asm volatile("" ::: "memory");
}
__device__ __forceinline__ v4u cvt8(const float* p, float s) {
    const f32x4 a = *(const f32x4*)p, b = *(const f32x4*)(p + 4);
    v4u o; o.x = pk2(a[0] * s, a[1] * s); o.y = pk2(a[2] * s, a[3] * s); o.z = pk2(b[0] * s, b[1] * s); o.w = pk2(b[2] * s, b[3] * s); return o;
}

__device__ __forceinline__ float gelu_f(float v) {
    const float av = fabsf(v), t = __builtin_amdgcn_rcpf(av * 0.2316418882f + 1.0f);
    float q = t * 0.5307027145f + (-0.7265760135f); q = q * t + 0.7107068705f; q = q * t + (-0.142248368f); q = q * t + 0.127414796f; q = q * t;
    const float e = __builtin_amdgcn_exp2f((v * v) * (-0.72134752044f));
    const float m = v * (q * e);
    return v < 0.f ? m : v - m;
}
__device__ __forceinline__ float dot2bf(unsigned a, unsigned b, float c) { return __builtin_amdgcn_fdot2_f32_bf16(__builtin_bit_cast(bf16x2_t, a), __builtin_bit_cast(bf16x2_t, b), c, false); }
__device__ __forceinline__ unsigned fkey(float f) { const unsigned u = __float_as_uint(f); return (u & 0x80000000u) ? ~u : (u | 0x80000000u); }
__device__ __forceinline__ float fdec(unsigned k) { const unsigned u = (k & 0x80000000u) ? (k & 0x7fffffffu) : ~k; return __uint_as_float(u); }


typedef float f32x2v __attribute__((ext_vector_type(2)));
__device__ __forceinline__ float wave_sum_dpp(float v) {
    v += __builtin_bit_cast(float, __builtin_amdgcn_update_dpp(0, __builtin_bit_cast(int, v), 0xB1, 0xf, 0xf, true));
    v += __builtin_bit_cast(float, __builtin_amdgcn_update_dpp(0, __builtin_bit_cast(int, v), 0x4E, 0xf, 0xf, true));
    v += __builtin_bit_cast(float, __builtin_amdgcn_update_dpp(0, __builtin_bit_cast(int, v), 0x141, 0xf, 0xf, true));
    v += __builtin_bit_cast(float, __builtin_amdgcn_update_dpp(0, __builtin_bit_cast(int, v), 0x140, 0xf, 0xf, true));
    const float a = __builtin_bit_cast(float, __builtin_amdgcn_readlane(__builtin_bit_cast(int, v), 0));
    const float b = __builtin_bit_cast(float, __builtin_amdgcn_readlane(__builtin_bit_cast(int, v), 16));
    const float c = __builtin_bit_cast(float, __builtin_amdgcn_readlane(__builtin_bit_cast(int, v), 32));
    const float d = __builtin_bit_cast(float, __builtin_amdgcn_readlane(__builtin_bit_cast(int, v), 48));
    return (a + b) + (c + d);
}
typedef float v32f __attribute__((ext_vector_type(32)));
typedef float v16f __attribute__((ext_vector_type(16)));
typedef unsigned v6u __attribute__((ext_vector_type(6)));
#ifndef FP6_INTERLEAVED
#define FP6_INTERLEAVED 1
#endif
__device__ __forceinline__ v32f dec_fp6(const v4u a, const v2u b) { const v6u w = {a.x, a.y, a.z, a.w, b.x, b.y}; return __builtin_amdgcn_cvt_scalef32_pk32_f32_fp6(w, 1.0f); }
typedef __bf16 v32bf __attribute__((ext_vector_type(32)));
typedef unsigned v16u __attribute__((ext_vector_type(16)));
__device__ __forceinline__ float peer_dot(const v4u ua, const v2u ub, const unsigned (&xnp)[16]) {
    const v6u w = {ua.x, ua.y, ua.z, ua.w, ub.x, ub.y};
    const v16u fu = __builtin_bit_cast(v16u, __builtin_amdgcn_cvt_scalef32_pk32_bf16_fp6(w, 1.0f));
    unsigned fa[16];
#pragma unroll
    for (int i = 0; i < 16; ++i) fa[i] = fu[i];
    float a[4] = {0.f, 0.f, 0.f, 0.f};
#pragma unroll
    for (int i = 0; i < 16; ++i) a[i & 3] = dot2bf(fa[i], xnp[i], a[i & 3]);
    return (a[0] + a[1]) + (a[2] + a[3]);
}
__device__ __forceinline__ void peer_axpy(const v4u va, const v2u vb, float w, v32f& oacc) {
    const v32f f = dec_fp6(va, vb);
#pragma unroll
    for (int i = 0; i < 32; ++i) oacc[i] = fmaf(w, f[i], oacc[i]);
}


__device__ __forceinline__ void conv_rows2_fp6(const float* srow0, const float* srow1, unsigned char* drow0, unsigned char* drow1, float* sc0, float* sc1, int lane) {
    f32x4 v[2][8]; float am[2] = {0.f, 0.f};
#pragma unroll
    for (int q = 0; q < 8; ++q) { v[0][q] = *(const GAS f32x4*)(srow0 + lane * 4 + q * 256); v[1][q] = *(const GAS f32x4*)(srow1 + lane * 4 + q * 256); }
#pragma unroll
    for (int r = 0; r < 2; ++r)
#pragma unroll
        for (int q = 0; q < 8; ++q) am[r] = fmaxf(am[r], fmaxf(fmaxf(fabsf(v[r][q][0]), fabsf(v[r][q][1])), fmaxf(fabsf(v[r][q][2]), fabsf(v[r][q][3]))));
#pragma unroll
    for (int o = 1; o < 64; o <<= 1) { am[0] = fmaxf(am[0], __shfl_xor(am[0], o)); am[1] = fmaxf(am[1], __shfl_xor(am[1], o)); }
#pragma unroll
    for (int r = 0; r < 2; ++r) {
        int ex = 0; if (am[r] > 0.f) { (void)frexpf(am[r], &ex); ex = 3 - ex; if (ldexpf(am[r], ex) > 7.5f) ex -= 1; }
        const float sc = ldexpf(1.f, ex);
        if (lane == 0) *(r ? sc1 : sc0) = ldexpf(1.f, -ex);
        v16f xa, xb;
#pragma unroll
        for (int i = 0; i < 16; ++i) { xa[i] = v[r][(2 * i) >> 2][(2 * i) & 3] * sc; xb[i] = v[r][(2 * i + 1) >> 2][(2 * i + 1) & 3] * sc; }
        const v6u w = __builtin_amdgcn_cvt_scalef32_2xpk16_fp6_f32(xa, xb, 1.0f);
        unsigned char* drow = r ? drow1 : drow0;
        *(GAS v4u*)(drow + lane * 16) = (v4u){w[0], w[1], w[2], w[3]};
        *(GAS v2u*)(drow + 1024 + lane * 8) = (v2u){w[4], w[5]};
    }
}

__global__ void __launch_bounds__(NTHREADS, 2) fwd_kernel(Args args) {
    extern __shared__ __attribute__((aligned(16))) unsigned char lds[];
    LAS unsigned char* ldsL = (LAS unsigned char*)lds;
    volatile LAS unsigned* MISC = (volatile LAS unsigned*)(ldsL + LDS_MISC);
    const int tid = threadIdx.x, lane = tid & 63, wave = __builtin_amdgcn_readfirstlane(tid >> 6);
    const int G = gridDim.x; const int bx = blockIdx.x; const int vcu = (G % 8 == 0) ? (bx % 8) * (G / 8) + bx / 8 : bx;
#define G_ws (args.ws)
#define G_ctl ((unsigned*)(args.ws + WS_CTL))
#define G_x (args.in[0])
#define G_mem (args.in[1])
#define G_mix_norm (args.in[2])
#define G_w_in (args.in[3])
#define G_b_forget (args.in[4])
#define G_pool_w (args.in[5])
#define G_pool_scale (args.in[6])
#define G_w_out (args.in[7])
#define G_xattn_norm (args.in[8])
#define G_mem_norm (args.in[9])
#define G_xwq (args.in[10])
#define G_xwk (args.in[11])
#define G_xwv (args.in[12])
#define G_xwo (args.in[13])
#define G_peer_norm (args.in[14])
#define G_peer_wq (args.in[15])
#define G_sub_keys (args.in[16])
#define G_peer_u (args.in[17])
#define G_peer_v (args.in[18])
#define G_final_norm (args.in[19])
#define G_W_IN ((bf16*)(args.ws + WS_WIN))
#define G_WO1 ((bf16*)(args.ws + WS_WO1))
#define G_WO2 ((bf16*)(args.ws + WS_WO2))
#define G_WQ ((bf16*)(args.ws + WS_WQ))
#define G_WK ((bf16*)(args.ws + WS_WK))
#define G_WV ((bf16*)(args.ws + WS_WV))
#define G_WO ((bf16*)(args.ws + WS_WO))
#define G_WPQ ((bf16*)(args.ws + WS_WPQ))
#define G_AEXP ((bf16*)(args.ws + WS_AEXP))
#define G_W1 ((bf16*)(args.ws + WS_AEXP))
#define G_W2 ((bf16*)(args.ws + WS_WPQ))
#define G_WSC ((bf16*)(args.ws + WS_WSC))
#define G_PB ((bf16*)(args.ws + WS_PB))
#define G_MN ((bf16*)(args.ws + WS_MN))
#define G_KX ((bf16*)(args.ws + WS_KX))
#define G_VXT ((bf16*)(args.ws + WS_VXT))
#define G_UB (args.ws + WS_UB)
#define G_VB (args.ws + WS_VB)
#define G_SU ((float*)(args.ws + WS_SU))
#define G_SV ((float*)(args.ws + WS_SV))
#define G_XN ((bf16*)(args.ws + WS_XN))
#define G_QX ((bf16*)(args.ws + WS_XN))
#define G_PROJ ((bf16*)(args.ws + WS_PROJ))
#define G_SCT ((float*)(args.ws + WS_PROJ))
#define G_AMIX ((bf16*)(args.ws + WS_AMIX))
#define G_OX ((bf16*)(args.ws + WS_AMIX))
#define G_H ((float*)(args.ws + WS_H))
#define G_HB ((bf16*)(args.ws + WS_HB))
#define G_PP ((bf16*)(args.ws + WS_P))
#define G_LF ((float*)(args.ws + WS_LF))
#define G_SS1 ((float*)(args.ws + CTL_SS1))
#define G_SS2 ((float*)(args.ws + CTL_SS2))

    for (int u = tid; u < (LDS_BYTES - LDS_MISC) / 4; u += NTHREADS) ((LAS unsigned*)(ldsL + LDS_MISC))[u] = 0u;
    __syncthreads();
    XcdBarrier bar; bar.bar = G_ctl + CW_BAR; bar.x = 0; bar.st = nullptr;
    if (args.one_launch) bar = xcd_barrier_post(G_ctl + CW_BAR, MISC + 8);
    const int lo = args.ph_lo, hi = args.ph_hi;
#ifndef PH_MASK
#define PH_MASK 0xff
#endif
#define IN(k) (((PH_MASK >> (k)) & 1) && lo <= (k) && (k) < hi)
#ifdef PROBE_SEL
#define STAMP(i) do { if (bx == 0 && tid == 0) { const unsigned long long t_ = __builtin_amdgcn_s_memrealtime(); MISC[32 + 2 * (i)] = (unsigned)t_; MISC[33 + 2 * (i)] = (unsigned)(t_ >> 32); } } while (0)
#else
#define STAMP(i) do { } while (0)
#endif
#define SEAM(k) do { if (IN(k) && IN((k) + 1)) xcd_barrier(bar); STAMP((k) + 1); } while (0)
#define TABLE_CHUNK(c_) do { _Pragma("unroll 1") for (int i_ = 0; i_ < 4; i_ += 2) { const int r_ = (c_) * 32 + wave * 4 + i_; const int tb_ = r_ >> 14, rr_ = r_ & (PEXP - 1); \
        const float* sp_ = (tb_ ? G_peer_v : G_peer_u) + (size_t)rr_ * DM; unsigned char* dp_ = (tb_ ? G_VB : G_UB) + (size_t)rr_ * 1536; float* scp_ = (tb_ ? G_SV : G_SU) + rr_; \
        conv_rows2_fp6(sp_, sp_ + DM, dp_, dp_ + 1536, scp_, scp_ + 1, lane); } } while (0)
    STAMP(0);
    const int gw = vcu * NWAVES + wave, NGW = G * NWAVES;
    const int gt = vcu * NTHREADS + tid, NGT = G * NTHREADS;

    if (IN(0)) for (int rep_ = 0; rep_ < (((DUP_MASK >> 0) & 1) ? args.pad + 1 : 1); ++rep_) {
        LAS float* wf = (LAS float*)ldsL;
        LAS float* scr = (LAS float*)(ldsL + 65536 + wave * 8704);
        for (int i = tid; i < 8 * DM; i += NTHREADS) { const int d = i >> 3, h = i & 7; wf[h * DM + d] = G_w_in[(size_t)d * INC + 4096 + h]; }
        __syncthreads();
        f32x4 vnx[8];
        if (gw < TOK) {
#pragma unroll
            for (int j = 0; j < 8; ++j) vnx[j] = ((const GAS f32x4*)(G_x + (size_t)gw * DM) + lane)[64 * j]; }
        for (int m = gw; m < TOK; m += NGW) {
            const GAS f32x4* gr = (const GAS f32x4*)G_mix_norm + lane;
            f32x4 v[8]; float s = 0.f;
#pragma unroll
            for (int j = 0; j < 8; ++j) v[j] = vnx[j];
            if (m + NGW < TOK) {
#pragma unroll
                for (int j = 0; j < 8; ++j) vnx[j] = ((const GAS f32x4*)(G_x + (size_t)(m + NGW) * DM) + lane)[64 * j]; }
#pragma unroll
            for (int j = 0; j < 8; ++j) s += (v[j][0] * v[j][0] + v[j][1] * v[j][1]) + (v[j][2] * v[j][2] + v[j][3] * v[j][3]);
            const float rstd = __builtin_amdgcn_rsqf(wave_sum(s) * (1.f / DM) + EPS);
            GAS v2u* o8 = (GAS v2u*)(G_XN + (size_t)m * DM) + lane;
#pragma unroll
            for (int j = 0; j < 8; ++j) { const f32x4 gg = gr[64 * j]; v[j] = v[j] * rstd * gg;
                v2u o; o.x = pk2(v[j][0], v[j][1]); o.y = pk2(v[j][2], v[j][3]); o8[64 * j] = o; }
            float fl[8];
#pragma unroll
            for (int h = 0; h < 8; ++h) { float a = 0.f;
#pragma unroll
                for (int j = 0; j < 8; ++j) { const f32x4 w = *(const LAS f32x4*)(wf + h * DM + j * 256 + lane * 4); a += (v[j][0] * w[0] + v[j][1] * w[1]) + (v[j][2] * w[2] + v[j][3] * w[3]); }
                fl[h] = wave_sum(a);
                asm volatile("" ::: "memory"); }
            if (lane < 8) { float f = fl[0];
#pragma unroll
                for (int h = 1; h < 8; ++h) f = (lane == h) ? fl[h] : f;
                f += G_b_forget[lane];
                const float ls = fminf(f, 0.f) - log1pf(expf(-fabsf(f)));
                const int b = m / SEQ, sq = m % SEQ; G_LF[(size_t)(b * FOXH + lane) * SEQ + sq] = ls; }
        }
        for (int m = gw; m < BATCH * NMEM; m += NGW) {
            const GAS f32x4* xr = (const GAS f32x4*)(G_mem + (size_t)m * DM) + lane; const GAS f32x4* gr = (const GAS f32x4*)G_mem_norm + lane;
            f32x4 v[8]; float s = 0.f;
#pragma unroll
            for (int j = 0; j < 8; ++j) { v[j] = xr[64 * j]; s += (v[j][0] * v[j][0] + v[j][1] * v[j][1]) + (v[j][2] * v[j][2] + v[j][3] * v[j][3]); }
            const float rstd = __builtin_amdgcn_rsqf(wave_sum(s) * (1.f / DM) + EPS);
            GAS v2u* o8 = (GAS v2u*)(G_MN + (size_t)m * DM) + lane;
#pragma unroll
            for (int j = 0; j < 8; ++j) { const f32x4 gg = gr[64 * j]; v[j] = v[j] * rstd * gg; v2u o; o.x = pk2(v[j][0], v[j][1]); o.y = pk2(v[j][2], v[j][3]); o8[64 * j] = o; }
        }
        {
            constexpr int I_IN = (DM / 64) * (4096 / 32), I_SQ = (DM / 64) * (DM / 32);
            constexpr int NITEMS = I_IN + 3 * I_SQ;
            for (int it = gw; it < NITEMS; it += NGW) {
                int r = it;
                if (r < I_IN) { p0_transpose_item(G_w_in, INC, 4096 / 32, nullptr, G_W_IN, nullptr, 0, DM, scr, r, lane); continue; } r -= I_IN;
                if (r < I_SQ) { p0_transpose_item(G_w_out, DM, DM / 32, nullptr, G_WO1, G_WO2, POOLW, DM, scr, r, lane); continue; } r -= I_SQ;
                if (r < I_SQ) { p0_transpose_item(G_xwk, DM, DM / 32, nullptr, G_WK, nullptr, 0, DM, scr, r, lane); continue; } r -= I_SQ;
                p0_transpose_item(G_xwv, DM, DM / 32, nullptr, G_WV, nullptr, 0, DM, scr, r, lane);
            }
        }
        for (int i = gt; i < DM * DM / 8; i += NGT) {
            const int d = i / (DM / 8); *(GAS v4u*)(G_WPQ + (size_t)i * 8) = cvt8(G_peer_wq + (size_t)i * 8, G_peer_norm[d]); }
        for (int i = gt; i < DM * DM / 8; i += NGT) {
            const int d = i / (DM / 8); *(GAS v4u*)(G_WQ + (size_t)i * 8) = cvt8(G_xwq + (size_t)i * 8, G_xattn_norm[d]); }
        for (int i = gt; i < DM * DM / 8; i += NGT) {
            const int r = i / (DM / 8), c0 = (i % (DM / 8)) * 8; const int hc = r >> 7;
            v4u o = {0u, 0u, 0u, 0u}; if ((c0 >> 7) == hc) o = cvt8(G_sub_keys + (size_t)r * 128 + (c0 & 127), 1.f);
            *(GAS v4u*)(G_AEXP + (size_t)i * 8) = o; }
        for (int i = gt; i < 4 * 256 * 256 / 8; i += NGT) {
            const int g = i / (256 * 256 / 8), d0 = (i % 32) * 8; const float* ps = G_pool_scale + g * 256 + d0; const float* p = G_pool_w + (size_t)i * 8;
            v4u o; o.x = pk2(p[0] * ps[0], p[1] * ps[1]); o.y = pk2(p[2] * ps[2], p[3] * ps[3]); o.z = pk2(p[4] * ps[4], p[5] * ps[5]); o.w = pk2(p[6] * ps[6], p[7] * ps[7]);
            *(GAS v4u*)(G_PB + (size_t)i * 8) = o; }
        __syncthreads();
    }
    SEAM(0);

    if (IN(1)) for (int rep_ = 0; rep_ < (((DUP_MASK >> 1) & 1) ? args.pad + 1 : 1); ++rep_) {
        pg8::Gemm g{G_XN, G_W_IN, DM, DM, DM}; pg8::GSched S; S.init(TOK / 256, 4096 / 256, G, bx, DM, DM);
        pg8::EpiStore E{G_PROJ, 4096, 0, 0, 1, nullptr, 1.f, 4, 8, 0.08838834764831845f * LOG2E};
        pg8::gemm_phase<pg8::EpiStore, pg8::GSched, true>(ldsL, g, S, E);
    }
    SEAM(1);

    if (IN(2)) for (int rep_ = 0; rep_ < (((DUP_MASK >> 2) & 1) ? args.pad + 1 : 1); ++rep_) {
        for (int it = vcu; it < TOK / 32; it += G) {
            const int ch = (tid & 127) * 8, rsub = tid >> 7, r0 = it * 32 + rsub * 8, w = 2 << (ch >> 8);
            const int s0 = r0 % SEQ;
            float acc[8];
#pragma unroll
            for (int e = 0; e < 8; ++e) acc[e] = 0.f;
            for (int k = 1; k < w; ++k) { if (s0 - k >= 0) { const v4u v = *(const GAS v4u*)(G_PROJ + (size_t)(r0 - k) * 4096 + ch);
#pragma unroll
                    for (int e = 0; e < 4; ++e) { acc[2 * e] += __uint_as_float(v[e] << 16); acc[2 * e + 1] += __uint_as_float(v[e] & 0xffff0000u); } } }
            for (int rr = 0; rr < 8; ++rr) {
                const v4u v = *(const GAS v4u*)(G_PROJ + (size_t)(r0 + rr) * 4096 + ch); float cur[8];
#pragma unroll
                for (int e = 0; e < 4; ++e) { cur[2 * e] = __uint_as_float(v[e] << 16); cur[2 * e + 1] = __uint_as_float(v[e] & 0xffff0000u); }
                const int sp = s0 + rr; const float inv = 1.f / (float)((sp + 1 < w) ? sp + 1 : w);
                v4u o;
#pragma unroll
                for (int e = 0; e < 8; ++e) acc[e] += cur[e];
                o.x = pk2(acc[0] * inv - cur[0], acc[1] * inv - cur[1]); o.y = pk2(acc[2] * inv - cur[2], acc[3] * inv - cur[3]);
                o.z = pk2(acc[4] * inv - cur[4], acc[5] * inv - cur[5]); o.w = pk2(acc[6] * inv - cur[6], acc[7] * inv - cur[7]);
                *(GAS v4u*)(G_AMIX + (size_t)(r0 + rr) * DM + ch) = o;
                if (sp - w + 1 >= 0) { const v4u vo = *(const GAS v4u*)(G_PROJ + (size_t)(r0 + rr - w + 1) * 4096 + ch);
#pragma unroll
                    for (int e = 0; e < 4; ++e) { acc[2 * e] -= __uint_as_float(vo[e] << 16); acc[2 * e + 1] -= __uint_as_float(vo[e] & 0xffff0000u); } }
            }
        }
        const int a_bh = vcu >> 4, a_qb = vcu & 15;
        if (a_qb < 8 && vcu < 256) {
            const int e = a_bh * 8 + a_qb;
            pg8::Gemm g; pg8::EpiStore E{nullptr, DM, 0, 0, 1, nullptr, 1.f, 0, 0, 1.f};
            int pm, pn;
            if (e < 16)      { pm = e >> 3; pn = e & 7; g = pg8::Gemm{G_MN, G_WK, DM, DM, DM}; E.O = G_KX; E.ldc = DM; }
            else if (e < 32) { const int q = e - 16; pm = q >> 3; pn = q & 7; g = pg8::Gemm{G_MN, G_WV, DM, DM, DM}; E.O = G_VXT; E.ldc = DM; }
            else if (e < 96) { const int q = e - 32; pm = q >> 3; pn = q & 7; g = pg8::Gemm{G_AEXP, G_WPQ, DM, DM, DM}; E.O = G_WSC; E.ldc = DM; }
            else             { const int q = e - 96; const int gg = q >> 3; pm = q & 7; pn = 0;
                               g = pg8::Gemm{G_WO1 + gg * 256, G_PB + (size_t)gg * 65536, 256, DM, 256}; E.O = G_WO2 + gg * 256; E.ldc = DM; }
            const pg8::OneSched S1{pm, pn, (long)pm * 256 * g.lda, (long)pn * 256 * g.ldb};
            pg8::gemm_phase<pg8::EpiStore, pg8::OneSched, false>(ldsL, g, S1, E);
        }
        if (vcu < 256) {
            const int b = a_bh >> 3, h = a_bh & 7;
            float* c_lds = (float*)(lds + fox::LDS_C);
            if (wave == 0) {
                const float* lf = G_LF + (size_t)a_bh * SEQ + lane * 64; float loc[64]; float run = 0.f;
#pragma unroll
                for (int i = 0; i < 16; ++i) { const f32x4 v = *(const f32x4*)(lf + 4 * i);
#pragma unroll
                    for (int e = 0; e < 4; ++e) { run += v[e]; loc[4 * i + e] = run; } }
                float incl = run;
#pragma unroll
                for (int o = 1; o < 64; o <<= 1) { const float t = __shfl_up(incl, o); if (lane >= o) incl += t; }
                const float excl = incl - run;
#pragma unroll
                for (int i = 0; i < 16; ++i) { f32x4 v;
#pragma unroll
                    for (int e = 0; e < 4; ++e) v[e] = (loc[4 * i + e] + excl) * LOG2E;
                    *(f32x4*)(c_lds + lane * 64 + 4 * i) = v; }
            }
            __syncthreads();
            const bf16* Qb = G_PROJ + (size_t)(b * SEQ) * 4096 + 1024 + h * 128;
            fox::BlockRef cur{Qb + (size_t)(a_qb * 256) * 4096, Qb + 1024, Qb + 2048, G_AMIX + (size_t)(b * SEQ + a_qb * 256) * DM + 1024 + h * 128, a_qb * 256};
            fox::Seam S;
            fox::prime(cur, (char*)lds, S);
            fox::block(cur, cur, (char*)lds, S);
            asm volatile("s_waitcnt vmcnt(0)" ::: "memory");
            __syncthreads();
        }
        {
            constexpr int C_T = (DM / 64) * (DM / 32) / 8, NCHUNK = C_T + QSPLIT;
            LAS float* scr = (LAS float*)(ldsL + wave * 8704);
            for (;;) {
                __syncthreads();
                if (tid == 0) MISC[16] = atomicAdd(G_ctl + CW_QUEUE, 1u);
                __syncthreads();
                const int c = (int)MISC[16];
                if (c >= NCHUNK) break;
                if (c < C_T) { p0_transpose_item(G_xwo, DM, DM / 32, nullptr, G_WO, nullptr, 0, DM, scr, c * 8 + wave, lane); }
                else { TABLE_CHUNK(c - C_T); }
            }
        }
    }
    SEAM(2);

    if (IN(3)) for (int rep_ = 0; rep_ < (((DUP_MASK >> 3) & 1) ? args.pad + 1 : 1); ++rep_) {
        { pg8::Gemm g{G_AMIX, G_WO2, DM, DM, DM}; pg8::GSched S; S.init(TOK / 256, DM / 256, G, bx, DM, DM);
          pg8::EpiResid<false> E{G_x, G_HB, rep_ ? nullptr : G_SS1, 0};
          pg8::gemm_phase<pg8::EpiResid<false>, pg8::GSched, true>(ldsL, g, S, E); }
        if (bx < 64) {
            const int f = bx & 63, b = f >> 5, h = (f >> 3) & 3, t = f & 7;
            pg8::Gemm g{G_KX + (size_t)(b * NMEM) * DM + h * XD, G_WQ + h * XD, XD, DM, DM};
            pg8::EpiStore E{G_W1 + (size_t)(b * 1024 + h * 256) * DM, DM, 0, 0, 1, nullptr, 1.f, 0, 0, 1.f};
            const pg8::OneSched S1{0, t, 0, (long)t * 256 * DM};
            pg8::gemm_phase<pg8::EpiStore, pg8::OneSched, false>(ldsL, g, S1, E);
        }
    }
    SEAM(3);

    if (IN(4)) for (int rep_ = 0; rep_ < (((DUP_MASK >> 4) & 1) ? args.pad + 1 : 1); ++rep_) {
        pg8::Gemm g{G_HB, G_W1, DM, DM, DM}; pg8::GSched S; S.init(SEQ / 256, XH, G, bx, DM, DM);
        S.nH = 1; S.nZ = BATCH; S.sAb = (long)SEQ * DM; S.sBb = (long)1024 * DM;
        pg8::EpiSoftmax E{G_PP, 1024, (long)SEQ * 1024, 0, 1, G_SS1, 0.044194173824159216f * LOG2E, SEQ};
        pg8::gemm_phase<pg8::EpiSoftmax, pg8::GSched, false>(ldsL, g, S, E);
        if (bx >= 128 && bx < 192) {
            const int f = bx & 63, b = f >> 5, h = (f >> 3) & 3, t = f & 7;
            pg8::Gemm g2{G_WO + h * XD, G_VXT + (size_t)(b * NMEM) * DM + h * XD, XD, DM, DM};
            pg8::EpiStore E2{G_W2 + (size_t)b * DM * 1024 + h * 256, 1024, 0, 0, 1, nullptr, 1.f, 0, 0, 1.f};
            const pg8::OneSched S2{t, 0, (long)t * 256 * DM, 0};
            pg8::gemm_phase<pg8::EpiStore, pg8::OneSched, false>(ldsL, g2, S2, E2);
        }
        for (;;) {
            __syncthreads();
            if (tid == 0) MISC[16] = atomicAdd(G_ctl + CW_QUEUE2, 1u);
            __syncthreads();
            const int c = (int)MISC[16] + QSPLIT;
            if (c >= 2 * PEXP / 32) break;
            TABLE_CHUNK(c);
        }
    }
    SEAM(4);

    if (IN(5)) for (int rep_ = 0; rep_ < (((DUP_MASK >> 5) & 1) ? args.pad + 1 : 1); ++rep_) {
        pg8::Gemm g{G_PP, G_W2, 1024, 1024, 1024}; pg8::GSched S; S.init(SEQ / 256, DM / 256, G, bx, 1024, 1024);
        S.nH = 1; S.nZ = BATCH; S.sAb = (long)SEQ * 1024; S.sBb = (long)DM * 1024;
        pg8::EpiResid<true> E{G_HB, G_HB, G_SS2, SEQ};
        pg8::gemm_phase<pg8::EpiResid<true>, pg8::GSched, true>(ldsL, g, S, E);
    }
    SEAM(5);

    if (IN(6)) for (int rep_ = 0; rep_ < (((DUP_MASK >> 6) & 1) ? args.pad + 1 : 1); ++rep_) {
        pg8::Gemm g{G_WSC, G_HB, DM, DM, DM}; pg8::GSched S; S.init(DM / 256, TOK / 256, G, bx, DM, DM);
        pg8::EpiF32Col E{G_SCT, TOK, G_SS2};
        pg8::gemm_phase<pg8::EpiF32Col, pg8::GSched, true>(ldsL, g, S, E);
    }
    SEAM(6);

    if (IN(7)) for (int rep_ = 0; rep_ < (((DUP_MASK >> 7) & 1) ? args.pad + 1 : 1); ++rep_) {
        LAS unsigned* TOP1 = (LAS unsigned*)ldsL;
        LAS unsigned* RIDX = (LAS unsigned*)(ldsL + 32768);
        LAS float* RGATE = (LAS float*)(ldsL + 49152);
        for (int blk = vcu; blk < TOK / 32; blk += G) {
            const int t0 = blk * 32;
            {
                const int tok = tid & 31, grp = tid >> 5;
                const float* sp = G_SCT + (size_t)(grp * 128) * TOK + t0 + tok;
                unsigned lst[16];
#pragma unroll
                for (int j = 0; j < 16; ++j) lst[j] = 0u;
                for (int i0 = 0; i0 < 128; i0 += 32) {
                    float v[32];
#pragma unroll
                    for (int e = 0; e < 32; ++e) v[e] = sp[(size_t)(i0 + e) * TOK];
#pragma unroll
                    for (int e = 0; e < 32; ++e) { unsigned xk = (fkey(v[e]) & ~127u) | (unsigned)(127 - (i0 + e));
#pragma unroll
                        for (int j = 0; j < 16; ++j) { const unsigned hi_ = max(lst[j], xk); xk = min(lst[j], xk); lst[j] = hi_; } }
                }
                LAS unsigned* dst = TOP1 + (tok * 16 + grp) * 16;
#pragma unroll
                for (int j = 0; j < 16; j += 4) *(LAS v4u*)(dst + j) = (v4u){lst[j], lst[j + 1], lst[j + 2], lst[j + 3]};
            }
            __syncthreads();
            if (tid < 256) {
                const int tok = tid & 31, head = tid >> 5;
                const LAS unsigned* ka = TOP1 + (tok * 16 + head * 2) * 16; const LAS unsigned* kb = ka + 16;
                float af[16], bfv[16];
#pragma unroll
                for (int j = 0; j < 16; ++j) { af[j] = fdec(ka[j] & ~127u); bfv[j] = fdec(kb[j] & ~127u); }
                unsigned best[16];
#pragma unroll
                for (int j = 0; j < 16; ++j) best[j] = 0u;
#pragma unroll
                for (int i = 0; i < 16; ++i)
#pragma unroll
                    for (int j = 0; j < 16; ++j) if ((i + 1) * (j + 1) <= 16) {
                        unsigned xk = (fkey(af[i] + bfv[j]) & ~255u) | (unsigned)(255 - (i * 16 + j));
#pragma unroll
                        for (int q = 0; q < 16; ++q) { const unsigned hi_ = max(best[q], xk); xk = min(best[q], xk); best[q] = hi_; } }
                float ev[16]; const float m0 = fdec(best[0] & ~255u); float sum = 0.f;
#pragma unroll
                for (int q = 0; q < 16; ++q) { ev[q] = __expf(fdec(best[q] & ~255u) - m0); sum += ev[q]; }
                const float inv = 1.f / sum;
#pragma unroll
                for (int q = 0; q < 16; ++q) { const unsigned code = 255u - (best[q] & 255u); const unsigned i = code >> 4, j = code & 15u;
                    const unsigned ia = 127u - (ka[i] & 127u), ib = 127u - (kb[j] & 127u);
                    RIDX[tok * 128 + head * 16 + q] = ia * 128u + ib; RGATE[tok * 128 + head * 16 + q] = ev[q] * inv; }
            }
            __syncthreads();
            {
                LAS unsigned* SIDX = (LAS unsigned*)ldsL; LAS float* SGATE = (LAS float*)(ldsL + 16384);
                const int tok = tid >> 4; const LAS unsigned* src = RIDX + tok * 128;
                unsigned mine[8]; unsigned rank[8];
#pragma unroll
                for (int i = 0; i < 8; ++i) { mine[i] = src[(tid & 15) + 16 * i]; rank[i] = 0u; }
                for (int j0 = 0; j0 < 128; j0 += 4) { const v4u o4 = *(const LAS v4u*)(src + j0);
#pragma unroll
                    for (int jj = 0; jj < 4; ++jj) { const unsigned oj = jj == 0 ? o4.x : jj == 1 ? o4.y : jj == 2 ? o4.z : o4.w; const int j = j0 + jj;
#pragma unroll
                        for (int i = 0; i < 8; ++i) rank[i] += (oj < mine[i] || (oj == mine[i] && j < (int)((tid & 15) + 16 * i))) ? 1u : 0u; } }
#pragma unroll
                for (int i = 0; i < 8; ++i) { const unsigned pos = (tok & 1) ? 127u - rank[i] : rank[i];
                    SIDX[tok * 128 + pos] = mine[i]; SGATE[tok * 128 + pos] = RGATE[tok * 128 + (tid & 15) + 16 * i]; }
            }
            __syncthreads();
            for (int tt = 0; tt < 4; ++tt) {
                const int tok = wave * 4 + tt; const size_t t = (size_t)(t0 + tok);
                const float rstd2 = __builtin_amdgcn_rsqf(G_SS2[t] * (1.f / DM) + EPS);
                unsigned xn[16]; v32f oacc;
#pragma unroll
                for (int q = 0; q < 8; ++q) { const size_t d0 = (size_t)q * 256 + lane * 4;
                    const v2u hb = *(const GAS v2u*)(G_HB + t * DM + d0); const f32x4 ga = *(const f32x4*)(G_peer_norm + d0);
                    const f32x4 a = {__uint_as_float(hb.x << 16), __uint_as_float(hb.x & 0xffff0000u), __uint_as_float(hb.y << 16), __uint_as_float(hb.y & 0xffff0000u)};
                    xn[q * 2] = pk2(a[0] * rstd2 * ga[0], a[1] * rstd2 * ga[1]); xn[q * 2 + 1] = pk2(a[2] * rstd2 * ga[2], a[3] * rstd2 * ga[3]);
#pragma unroll
                    for (int e = 0; e < 4; ++e) oacc[q * 4 + e] = 0.f; }
                const LAS unsigned* ridx = (const LAS unsigned*)ldsL + tok * 128; const LAS float* rgate = (const LAS float*)(ldsL + 16384) + tok * 128;
                v4u uaA0, uaA1, uaB0, uaB1, vaA0, vaA1, vaB0, vaB1; v2u ubA0, ubA1, ubB0, ubB1, vbA0, vbA1, vbB0, vbB1;
                float suA0, suA1, suB0, suB1, gsA0, gsA1, gsB0, gsB1, wA0 = 0.f, wA1 = 0.f, wB0 = 0.f, wB1 = 0.f;
#define PLDU(S, k) do { const unsigned ex_ = (unsigned)__builtin_amdgcn_readfirstlane((int)ridx[k]); su##S = G_SU[ex_]; gs##S = rgate[k] * G_SV[ex_]; \
        const unsigned char* up_ = G_UB + (size_t)ex_ * 1536; ua##S = *(const GAS v4u*)(up_ + lane * 16); ub##S = *(const GAS v2u*)(up_ + 1024 + lane * 8); } while (0)
#define PLDV(S, k) do { const unsigned ex_ = (unsigned)__builtin_amdgcn_readfirstlane((int)ridx[k]); \
        const unsigned char* vp_ = G_VB + (size_t)ex_ * 1536; va##S = *(const GAS v4u*)(vp_ + lane * 16); vb##S = *(const GAS v2u*)(vp_ + 1024 + lane * 8); } while (0)
#define STEP(C, P, k, HASPREV, HASNEXT) do { \
        PLDV(C##0, (k)); PLDV(C##1, (k) + 1); \
        float d0_ = peer_dot(ua##C##0, ub##C##0, xn), d1_ = peer_dot(ua##C##1, ub##C##1, xn); \
        if (HASNEXT) { PLDU(P##0, (k) + 2); PLDU(P##1, (k) + 3); } \
        d0_ = wave_sum_dpp(d0_) * su##C##0; d1_ = wave_sum_dpp(d1_) * su##C##1; \
        if (HASPREV) { peer_axpy(va##P##0, vb##P##0, w##P##0, oacc); __builtin_amdgcn_sched_barrier(0); peer_axpy(va##P##1, vb##P##1, w##P##1, oacc); } \
        w##C##0 = gelu_f(d0_) * gs##C##0; w##C##1 = gelu_f(d1_) * gs##C##1; } while (0)
                PLDU(A0, 0); PLDU(A1, 1);
                STEP(A, B, 0, false, true);
                for (int k = 2; k < 126; k += 4) { STEP(B, A, k, true, true); STEP(A, B, k + 2, true, true); }
                STEP(B, A, 126, true, false);
                peer_axpy(vaB0, vbB0, wB0, oacc); peer_axpy(vaB1, vbB1, wB1, oacc);
#undef PLDU
#undef PLDV
#undef STEP
                float s = 0.f;
#pragma unroll
                for (int q = 0; q < 8; ++q) { const size_t d0 = (size_t)q * 256 + lane * 4; const v2u hb = *(const GAS v2u*)(G_HB + t * DM + d0);
                    const f32x4 a = {__uint_as_float(hb.x << 16), __uint_as_float(hb.x & 0xffff0000u), __uint_as_float(hb.y << 16), __uint_as_float(hb.y & 0xffff0000u)};
#pragma unroll
                    for (int e = 0; e < 4; ++e) { const float y = a[e] + oacc[q * 4 + e]; oacc[q * 4 + e] = y; s += y * y; } }
                const float rstd = __builtin_amdgcn_rsqf(wave_sum(s) * (1.f / DM) + EPS);
#pragma unroll
                for (int q = 0; q < 8; ++q) { const size_t d0 = (size_t)q * 256 + lane * 4; const f32x4 ga = *(const f32x4*)(G_final_norm + d0); f32x4 o;
#pragma unroll
                    for (int e = 0; e < 4; ++e) o[e] = oacc[q * 4 + e] * rstd * ga[e];
#ifdef PROBE_SEL
                    if (t == 0 && lane == 0 && q == 0) { const unsigned long long a_ = ((unsigned long long)MISC[33 + 2 * PROBE_SEL] << 32) | MISC[32 + 2 * PROBE_SEL], b_ = ((unsigned long long)MISC[35 + 2 * PROBE_SEL] << 32) | MISC[34 + 2 * PROBE_SEL];
                        o[0] += (float)(b_ - a_) * 0.001f; }
#endif
                    *(f32x4*)(args.out + t * DM + d0) = o; }
            }
            __syncthreads();
        }
    }
#undef IN
#undef SEAM
#undef G_ws
#undef G_ctl
#undef G_x
#undef G_mem
#undef G_mix_norm
#undef G_w_in
#undef G_b_forget
#undef G_pool_w
#undef G_pool_scale
#undef G_w_out
#undef G_xattn_norm
#undef G_mem_norm
#undef G_xwq
#undef G_xwk
#undef G_xwv
#undef G_xwo
#undef G_peer_norm
#undef G_peer_wq
#undef G_sub_keys
#undef G_peer_u
#undef G_peer_v
#undef G_final_norm
#undef G_W_IN
#undef G_WO1
#undef G_WO2
#undef G_WQ
#undef G_WK
#undef G_WV
#undef G_WO
#undef G_WPQ
#undef G_AEXP
#undef G_W1
#undef G_W2
#undef G_WSC
#undef G_PB
#undef G_MN
#undef G_KX
#undef G_VXT
#undef G_UB
#undef G_VB
#undef G_SU
#undef G_SV
#undef G_XN
#undef G_QX
#undef G_PROJ
#undef G_SCT
#undef G_AMIX
#undef G_OX
#undef G_H
#undef G_HB
#undef G_PP
#undef G_LF
#undef G_SS1
#undef G_SS2

}

constexpr int N_PHASES = 8;
extern "C" void kernel_launch(void* const* d_in, const int* in_sizes, int n_in, void* d_out, int out_size, void* d_ws, size_t ws_size, hipStream_t stream) {
    static int grid = 0;
    if (grid == 0) {
        if (n_in != 20 || in_sizes[0] != TOK * DM || out_size != TOK * DM || ws_size < WS_END) {
            fprintf(stderr, "kernel_launch: unexpected shapes (n_in %d, in0 %d, out %d, ws %zu < %zu)\n", n_in, n_in > 0 ? in_sizes[0] : -1, out_size, ws_size, (size_t)WS_END); grid = -1; return; }
        int dev = 0, cus = 0, per_cu = 0;
        if (hipGetDevice(&dev) != hipSuccess || hipDeviceGetAttribute(&cus, hipDeviceAttributeMultiprocessorCount, dev) != hipSuccess) { grid = -1; return; }
        if (hipFuncSetAttribute((const void*)fwd_kernel, hipFuncAttributeMaxDynamicSharedMemorySize, LDS_BYTES) != hipSuccess) { fprintf(stderr, "kernel_launch: hipFuncSetAttribute failed\n"); grid = -1; return; }
        if (hipOccupancyMaxActiveBlocksPerMultiprocessor(&per_cu, (const void*)fwd_kernel, NTHREADS, LDS_BYTES) != hipSuccess || per_cu < 1) { fprintf(stderr, "kernel_launch: occupancy query says %d\n", per_cu); per_cu = 1; }
        (void)hipGetLastError();
        grid = cus;
        if (grid != 256) fprintf(stderr, "kernel_launch: %d CUs (built for 256)\n", grid);
    }
    if (grid < 0) return;
    (void)hipMemsetAsync((char*)d_ws + WS_CTL, 0, CTL_ZERO_BYTES, stream);
    Args a{};
    for (int i = 0; i < 20; ++i) a.in[i] = (const float*)d_in[i];
    a.out = (float*)d_out; a.ws = (unsigned char*)d_ws; a.pad = DUP_MASK ? 1 : 0;
#if MK_ONE_LAUNCH
    a.ph_lo = 0; a.ph_hi = N_PHASES; a.one_launch = 1;
    void* kargs[] = {&a};
    hipError_t e = hipLaunchCooperativeKernel((const void*)fwd_kernel, dim3(grid), dim3(NTHREADS), kargs, LDS_BYTES, stream);
    if (e != hipSuccess) fprintf(stderr, "kernel_launch: cooperative launch failed: %s\n", hipGetErrorString(e));
#else
    for (int p = 0; p < N_PHASES; ++p) {
        a.ph_lo = p; a.ph_hi = p + 1; a.one_launch = 0;
        hipLaunchKernelGGL(fwd_kernel, dim3(grid), dim3(NTHREADS), LDS_BYTES, stream, a);
    }
#endif
}
```

```cpp
#include <hip/hip_runtime.h>
#include <hip/hip_bf16.h>
#include <cstdio>
#include <cstdint>

#ifndef DUP_MASK
#define DUP_MASK 0
#endif
#ifndef MK_ONE_LAUNCH
#define MK_ONE_LAUNCH 1
#endif

constexpr int BATCH = 2, SEQ = 4096, DM = 2048, TOK = BATCH * SEQ;
constexpr int INC = 4104, POOLW = 1024, FOXH = 8, FOXD = 128;
constexpr int NMEM = 256, XH = 4, XD = 512;
constexpr int PH = 8, PKEYS = 128, PEXP = 16384, TOPK = 16;
constexpr float EPS = 1e-6f;
constexpr float LOG2E = 1.4426950408889634f;

namespace pg8 {
#define PG8_LAS __attribute__((address_space(3)))
typedef unsigned short bf16_t;
typedef short bf16x8 __attribute__((ext_vector_type(8)));
typedef float f32x4 __attribute__((ext_vector_type(4)));
typedef float f32x2 __attribute__((ext_vector_type(2)));
typedef unsigned u32x4 __attribute__((ext_vector_type(4)));
typedef unsigned u32x2 __attribute__((ext_vector_type(2)));
constexpr int BM = 256, BK = 64, HALF = 128, HTB = HALF * BK * 2, STAGE_BYTES = 8 * HTB, NXCD = 8, WGM = 8;

__host__ __device__ __forceinline__ int lds_byte(int r, int c) { const int st = (r >> 4) * 2 + (c >> 5), rr = r & 15, cc = c & 31, ob = rr * 64 + cc * 2; return st * 1024 + (ob ^ (((ob >> 9) & 1) << 5)); }
__host__ __device__ __forceinline__ void stage_rc(int b, int& R, int& C) { const int st = b / 1024, sb = b % 1024, swz = sb ^ (((sb >> 9) & 1) << 5); R = (st >> 1) * 16 + swz / 64; C = (st & 1) * 32 + (swz % 64) / 2; }
__host__ __device__ __forceinline__ int perm32(int rho) { const int n = rho >> 4, i = rho & 15; return 8 * (i >> 2) + 4 * n + (i & 3); }

struct Unit { int pm, pn, z; long aoff, boff; };
struct Gemm { const bf16_t* A; const bf16_t* Bt; int K, lda, ldb; };

struct GSched {
    int nM, nN, nH, nZ, G, c; long sAb, sAh, sBb, sBh; int lda, ldb;
    __device__ __forceinline__ void init(int nM_, int nN_, int G_, int c_, int lda_, int ldb_) { nM = nM_; nN = nN_; nH = 1; nZ = 1; G = G_; c = c_; sAb = sAh = sBb = sBh = 0; lda = lda_; ldb = ldb_; }
    __device__ __forceinline__ bool next(int i, Unit& u) const {
        const long L = (long)i * G + c; const int nwg = nM * nN; if (L >= (long)nwg * nZ) return false;
        const int z = (int)(L / nwg); int wgid = (int)(L % nwg);
        { const int q = nwg / NXCD, r = nwg % NXCD, xcd = wgid % NXCD, off = wgid / NXCD; wgid = (xcd < r ? xcd * (q + 1) : r * (q + 1) + (xcd - r) * q) + off; }
        const int nig = WGM * nN, gid = wgid / nig, fm = gid * WGM, gsz = (nM - fm) < WGM ? (nM - fm) : WGM;
        u.pm = fm + ((wgid % nig) % gsz); u.pn = (wgid % nig) / gsz; u.z = z;
        const int zb = z / nH, zh = z % nH;
        u.aoff = zb * sAb + zh * sAh + (long)u.pm * BM * lda; u.boff = zb * sBb + zh * sBh + (long)u.pn * BM * ldb;
        return true;
    }
    __device__ __forceinline__ void a_ready(const Unit&) const {}
    __device__ __forceinline__ void done(const Unit&) const {}
};

struct OneSched { int pm, pn; long ao, bo;
    __device__ __forceinline__ bool next(int i, Unit& u) const { if (i) return false; u.pm = pm; u.pn = pn; u.z = 0; u.aoff = ao; u.boff = bo; return true; }
    __device__ __forceinline__ void a_ready(const Unit&) const {}
    __device__ __forceinline__ void done(const Unit&) const {} };
__device__ __forceinline__ unsigned cvt_pk_bf16(float lo, float hi) { unsigned r; asm volatile("v_cvt_pk_bf16_f32 %0, %1, %2" : "=v"(r) : "v"(lo), "v"(hi)); return r; }


struct EpiStore {
    static constexpr bool PERM = true, AFTER_DRAIN = false;
    bf16_t* O; int ldc; long sCb, sCh; int nH;
    const float* ss; float rs_mul;
    int t0, t1; float tscale;
    __device__ __forceinline__ void operator()(const f32x4 (&acc)[2][2][4][2], const Unit& u, int wr, int wc, int fr, int fq) const {
        const int row0 = u.pm * BM + wr * 64 + fr, col0 = u.pn * BM + wc * 32 + 8 * fq;
        bf16_t* base = O + (u.z / nH) * sCb + (u.z % nH) * sCh;
        const float ts = (u.pn >= t0 && u.pn < t1) ? tscale : 1.f;
#pragma unroll
        for (int ai = 0; ai < 2; ++ai)
#pragma unroll
            for (int m = 0; m < 4; ++m) { const int row = row0 + ai * HALF + m * 16;
                float sc = ts; if (ss) sc *= __builtin_amdgcn_rsqf(ss[row] * (1.f / DM) + EPS) * rs_mul;
                bf16_t* rowp = base + (size_t)row * ldc + col0;
#pragma unroll
                for (int bj = 0; bj < 2; ++bj) { const f32x4 v0 = acc[ai][bj][m][0] * sc, v1 = acc[ai][bj][m][1] * sc;
                    u32x4 w; w.x = cvt_pk_bf16(v0[0], v0[1]); w.y = cvt_pk_bf16(v0[2], v0[3]); w.z = cvt_pk_bf16(v1[0], v1[1]); w.w = cvt_pk_bf16(v1[2], v1[3]);
                    *(u32x4*)(rowp + bj * HALF) = w; } }
    }
};
template <bool BASE_BF16> struct EpiResid {
    static constexpr bool PERM = true, AFTER_DRAIN = false;
    const void* base; bf16_t* HB; float* ss; int zrows;
    __device__ __forceinline__ void operator()(const f32x4 (&acc)[2][2][4][2], const Unit& u, int wr, int wc, int fr, int fq) const {
        const int row0 = u.z * zrows + u.pm * BM + wr * 64 + fr, col0 = u.pn * BM + wc * 32 + 8 * fq;
#pragma unroll
        for (int ai = 0; ai < 2; ++ai)
#pragma unroll
            for (int m = 0; m < 4; ++m) { const int row = row0 + ai * HALF + m * 16; const size_t off = (size_t)row * DM + col0; float sq = 0.f;
#pragma unroll
                for (int bj = 0; bj < 2; ++bj) {
                    f32x4 b0, b1;
                    if constexpr (BASE_BF16) { const u32x4 r = *(const u32x4*)((const bf16_t*)base + off + bj * HALF);
                        b0 = (f32x4){__uint_as_float(r.x << 16), __uint_as_float(r.x & 0xffff0000u), __uint_as_float(r.y << 16), __uint_as_float(r.y & 0xffff0000u)};
                        b1 = (f32x4){__uint_as_float(r.z << 16), __uint_as_float(r.z & 0xffff0000u), __uint_as_float(r.w << 16), __uint_as_float(r.w & 0xffff0000u)}; }
                    else { b0 = *(const f32x4*)((const float*)base + off + bj * HALF); b1 = *(const f32x4*)((const float*)base + off + bj * HALF + 4); }
                    const f32x4 h0 = b0 + acc[ai][bj][m][0], h1 = b1 + acc[ai][bj][m][1];
                    u32x4 w; w.x = cvt_pk_bf16(h0[0], h0[1]); w.y = cvt_pk_bf16(h0[2], h0[3]); w.z = cvt_pk_bf16(h1[0], h1[1]); w.w = cvt_pk_bf16(h1[2], h1[3]);
                    *(u32x4*)(HB + off + bj * HALF) = w;
                    sq += (h0[0] * h0[0] + h0[1] * h0[1]) + (h0[2] * h0[2] + h0[3] * h0[3]) + (h1[0] * h1[0] + h1[1] * h1[1]) + (h1[2] * h1[2] + h1[3] * h1[3]); }
                sq += __shfl_xor(sq, 16); sq += __shfl_xor(sq, 32);
                if (fq == 0 && ss) atomicAdd(ss + row, sq); }
    }
};
struct EpiF32Col {
    static constexpr bool PERM = true, AFTER_DRAIN = false;
    float* O; int ldc; const float* ss;
    __device__ __forceinline__ void operator()(const f32x4 (&acc)[2][2][4][2], const Unit& u, int wr, int wc, int fr, int fq) const {
        const int row0 = u.pm * BM + wr * 64 + fr, col0 = u.pn * BM + wc * 32 + 8 * fq;
        f32x4 rs[2][2];
#pragma unroll
        for (int bj = 0; bj < 2; ++bj)
#pragma unroll
            for (int n = 0; n < 2; ++n) { const f32x4 s = *(const f32x4*)(ss + col0 + bj * HALF + 4 * n);
#pragma unroll
                for (int e = 0; e < 4; ++e) rs[bj][n][e] = __builtin_amdgcn_rsqf(s[e] * (1.f / DM) + EPS); }
#pragma unroll
        for (int ai = 0; ai < 2; ++ai)
#pragma unroll
            for (int m = 0; m < 4; ++m) { float* rowp = O + (size_t)(row0 + ai * HALF + m * 16) * ldc + col0;
#pragma unroll
                for (int bj = 0; bj < 2; ++bj) { *(f32x4*)(rowp + bj * HALF) = acc[ai][bj][m][0] * rs[bj][0]; *(f32x4*)(rowp + bj * HALF + 4) = acc[ai][bj][m][1] * rs[bj][1]; } }
    }
};
struct EpiSoftmax {
    static constexpr bool PERM = true, AFTER_DRAIN = true;
    bf16_t* P; int ldc; long sCb, sCh; int nH; const float* ss; float mul; int zrows;
    __device__ __forceinline__ void fused(f32x4 (&acc)[2][2][4][2], const Unit& u, int wr, int wc, int fr, int fq, PG8_LAS unsigned char* lds, int wid, int lane) const {
        PG8_LAS float* Pm = (PG8_LAS float*)lds;
        PG8_LAS float* Ps = (PG8_LAS float*)(lds + 4096);
#pragma unroll
        for (int ai = 0; ai < 2; ++ai)
#pragma unroll
            for (int m = 0; m < 4; ++m) { float mx = -3.0e38f;
                const float rs = __builtin_amdgcn_rsqf(ss[u.z * zrows + u.pm * BM + ai * HALF + wr * 64 + m * 16 + fr] * (1.f / DM) + EPS) * mul;
#pragma unroll
                for (int bj = 0; bj < 2; ++bj)
#pragma unroll
                    for (int n = 0; n < 2; ++n) { const f32x4 x = acc[ai][bj][m][n] * rs; acc[ai][bj][m][n] = x; mx = fmaxf(mx, fmaxf(fmaxf(x[0], x[1]), fmaxf(x[2], x[3]))); }
                mx = fmaxf(mx, __shfl_xor(mx, 16)); mx = fmaxf(mx, __shfl_xor(mx, 32));
                if (fq == 0) Pm[(ai * HALF + wr * 64 + m * 16 + fr) * 4 + wc] = mx; }
        asm volatile("s_waitcnt lgkmcnt(0)" ::: "memory"); __builtin_amdgcn_s_barrier(); asm volatile("" ::: "memory");
#pragma unroll
        for (int ai = 0; ai < 2; ++ai)
#pragma unroll
            for (int m = 0; m < 4; ++m) { const int r = ai * HALF + wr * 64 + m * 16 + fr;
                const f32x4 pm4 = *(const PG8_LAS f32x4*)(Pm + r * 4); const float M = fmaxf(fmaxf(pm4[0], pm4[1]), fmaxf(pm4[2], pm4[3])); float s = 0.f;
#pragma unroll
                for (int bj = 0; bj < 2; ++bj)
#pragma unroll
                    for (int n = 0; n < 2; ++n) { f32x4 x = acc[ai][bj][m][n];
#pragma unroll
                        for (int e = 0; e < 4; ++e) { x[e] = __builtin_amdgcn_exp2f(x[e] - M); s += x[e]; }
                        acc[ai][bj][m][n] = x; }
                s += __shfl_xor(s, 16); s += __shfl_xor(s, 32);
                if (fq == 0) Ps[r * 4 + wc] = s; }
        asm volatile("s_waitcnt lgkmcnt(0)" ::: "memory"); __builtin_amdgcn_s_barrier(); asm volatile("" ::: "memory");
        bf16_t* base = P + (u.z / nH) * sCb + (u.z % nH) * sCh;
        const int row0 = u.pm * BM, col0 = u.pn * BM + wc * 32 + 8 * fq;
#pragma unroll
        for (int ai = 0; ai < 2; ++ai)
#pragma unroll
            for (int m = 0; m < 4; ++m) { const int r = ai * HALF + wr * 64 + m * 16 + fr;
                const f32x4 ps4 = *(const PG8_LAS f32x4*)(Ps + r * 4); const float inv = 1.f / ((ps4[0] + ps4[1]) + (ps4[2] + ps4[3]));
                bf16_t* rowp = base + (size_t)(row0 + r) * ldc + col0;
#pragma unroll
                for (int bj = 0; bj < 2; ++bj) { const f32x4 v0 = acc[ai][bj][m][0] * inv, v1 = acc[ai][bj][m][1] * inv;
                    u32x4 w; w.x = cvt_pk_bf16(v0[0], v0[1]); w.y = cvt_pk_bf16(v0[2], v0[3]); w.z = cvt_pk_bf16(v1[0], v1[1]); w.w = cvt_pk_bf16(v1[2], v1[3]);
                    *(u32x4*)(rowp + bj * HALF) = w; } }
    }
};

template <class Epi, class Sched, bool ALIGN_EPI>
__device__ __forceinline__ void gemm_phase(PG8_LAS unsigned char* lds, const Gemm g, const Sched& S, const Epi& E) {
    const int tid = threadIdx.x, wid = __builtin_amdgcn_readfirstlane(tid >> 6), lane = tid & 63, wr = wid >> 2, wc = wid & 3, fr = lane & 15, fq = lane >> 4;
    const int K = g.K, nt = K / BK;
    unsigned voffA[2], voffB[2];
#pragma unroll
    for (int i = 0; i < 2; ++i) { int R, C; stage_rc(tid * 16 + i * 8192, R, C); const int Rb = Epi::PERM ? ((R & ~31) + perm32(R & 31)) : R;
        voffA[i] = (unsigned)(R * g.lda + C) * 2u; voffB[i] = (unsigned)(Rb * g.ldb + C) * 2u; }
    const size_t kstep = (size_t)(BK * 2);
    const size_t hsA = (size_t)HALF * g.lda * 2, hsB = (size_t)HALF * g.ldb * 2;
    const unsigned ldsw = (unsigned)wid * 1024u;
    const int aoff = lds_byte(wr * 64 + fr, fq * 8), boff = lds_byte(wc * 32 + fr, fq * 8);
#define PG8_SA(b, h) (((b) * 2 + (h)) * HTB)
#define PG8_SB(b, h) ((4 + (b) * 2 + (h)) * HTB)
#define PG8_STAGE(bufoff, gbase, voff) do { _Pragma("unroll") for (int _i = 0; _i < 2; ++_i) \
        __builtin_amdgcn_global_load_lds((const unsigned*)((const char*)(gbase) + (voff)[_i]), (PG8_LAS unsigned*)(lds + (bufoff) + ldsw + _i * 8192), 16, 0, 0); } while (0)
#define PG8_LDA(dst, b, h) do { _Pragma("unroll") for (int m = 0; m < 4; ++m) _Pragma("unroll") for (int k = 0; k < 2; ++k) dst[m][k] = *(const PG8_LAS bf16x8*)(lds + PG8_SA(b, h) + aoff + m * 2048 + k * 1024); } while (0)
#define PG8_LDB(dst, b, h) do { _Pragma("unroll") for (int n = 0; n < 2; ++n) _Pragma("unroll") for (int k = 0; k < 2; ++k) dst[n][k] = *(const PG8_LAS bf16x8*)(lds + PG8_SB(b, h) + boff + n * 2048 + k * 1024); } while (0)
#define PG8_MMA(ai, bj, At, Bt) do { __builtin_amdgcn_s_setprio(1); _Pragma("unroll") for (int m = 0; m < 4; ++m) _Pragma("unroll") for (int n = 0; n < 2; ++n) _Pragma("unroll") for (int k = 0; k < 2; ++k) \
        acc[ai][bj][m][n] = __builtin_amdgcn_mfma_f32_16x16x32_bf16(Bt[n][k], At[m][k], acc[ai][bj][m][n], 0, 0, 0); __builtin_amdgcn_s_setprio(0); } while (0)
#define PG8_WAIT_V(n) asm volatile("s_waitcnt vmcnt(" #n ")" ::: "memory")
#define PG8_WAIT_L(n) asm volatile("s_waitcnt lgkmcnt(" #n ")" ::: "memory")
#define PG8_BAR __builtin_amdgcn_s_barrier()
#define PG8_SCHED __builtin_amdgcn_sched_barrier(0)
    Unit cur, nxt; int ui = 0;
    if (!S.next(0, cur)) return;
    f32x4 acc[2][2][4][2];
#pragma unroll
    for (int a = 0; a < 2; ++a)
#pragma unroll
        for (int b = 0; b < 2; ++b)
#pragma unroll
            for (int m = 0; m < 4; ++m)
#pragma unroll
                for (int n = 0; n < 2; ++n) acc[a][b][m][n] = (f32x4){0.f, 0.f, 0.f, 0.f};
    bf16x8 At[4][2], B0[2][2], B1[2][2];
    const char* cA = (const char*)g.A + (size_t)cur.aoff * 2; const char* cB = (const char*)g.Bt + (size_t)cur.boff * 2;
    S.a_ready(cur);
    PG8_STAGE(PG8_SB(0, 0), cB, voffB); PG8_STAGE(PG8_SB(0, 1), cB + hsB, voffB); PG8_STAGE(PG8_SA(0, 0), cA, voffA); PG8_STAGE(PG8_SA(0, 1), cA + hsA, voffA);
    if (wr == 1) PG8_BAR;
    PG8_WAIT_V(2); PG8_BAR;
    PG8_STAGE(PG8_SB(1, 0), cB + kstep, voffB); PG8_STAGE(PG8_SA(1, 0), cA + kstep, voffA); PG8_STAGE(PG8_SB(1, 1), cB + hsB + kstep, voffB);
    PG8_WAIT_V(6); PG8_BAR;
    for (;;) {
        const bool has_next = S.next(ui + 1, nxt);
        const char* nA = has_next ? (const char*)g.A + (size_t)nxt.aoff * 2 : cA; const char* nB = has_next ? (const char*)g.Bt + (size_t)nxt.boff * 2 : cB;
        for (int t = 0; t < nt; t += 2) {
            const bool last = (t == nt - 2);
            const char* a1 = cA + (size_t)(t + 1) * kstep;
            const char* a2 = last ? nA : cA + (size_t)(t + 2) * kstep; const char* b2 = last ? nB : cB + (size_t)(t + 2) * kstep;
            const char* a3 = a2 + kstep; const char* b3 = b2 + kstep;
            if (last && has_next) S.a_ready(nxt);
            PG8_LDB(B0, 0, 0); PG8_LDB(B1, 0, 1); PG8_SCHED; PG8_LDA(At, 0, 0); PG8_STAGE(PG8_SA(1, 1), a1 + hsA, voffA);
            PG8_WAIT_V(8); PG8_WAIT_L(0); PG8_BAR; PG8_MMA(0, 0, At, B0); PG8_MMA(0, 1, At, B1); PG8_BAR; PG8_SCHED;
            PG8_LDA(At, 0, 1); PG8_STAGE(PG8_SB(0, 0), b2, voffB); PG8_STAGE(PG8_SB(0, 1), b2 + hsB, voffB); PG8_STAGE(PG8_SA(0, 0), a2, voffA);
            PG8_WAIT_V(8); PG8_WAIT_L(0); PG8_BAR; PG8_MMA(1, 0, At, B0); PG8_MMA(1, 1, At, B1); PG8_BAR; PG8_SCHED;
            PG8_LDB(B0, 1, 0); PG8_LDB(B1, 1, 1); PG8_SCHED; PG8_LDA(At, 1, 0); PG8_STAGE(PG8_SA(0, 1), a2 + hsA, voffA);
            PG8_WAIT_V(8); PG8_WAIT_L(0); PG8_BAR; PG8_MMA(0, 0, At, B0); PG8_MMA(0, 1, At, B1); PG8_BAR; PG8_SCHED;
            PG8_LDA(At, 1, 1); PG8_STAGE(PG8_SB(1, 0), b3, voffB); PG8_STAGE(PG8_SB(1, 1), b3 + hsB, voffB); PG8_STAGE(PG8_SA(1, 0), a3, voffA);
            PG8_WAIT_V(8); PG8_WAIT_L(0); PG8_BAR; PG8_MMA(1, 0, At, B0); PG8_MMA(1, 1, At, B1); PG8_BAR; PG8_SCHED;
        }
        if constexpr (ALIGN_EPI) { if (wr == 0) PG8_BAR; }
        if constexpr (!Epi::AFTER_DRAIN) { E(acc, cur, wr, wc, fr, fq); S.done(cur); }
        if (!has_next) break;
#pragma unroll
        for (int a = 0; a < 2; ++a)
#pragma unroll
            for (int b = 0; b < 2; ++b)
#pragma unroll
                for (int m = 0; m < 4; ++m)
#pragma unroll
                    for (int n = 0; n < 2; ++n) acc[a][b][m][n] = (f32x4){0.f, 0.f, 0.f, 0.f};
        cur = nxt; cA = nA; cB = nB; ++ui;
        if constexpr (ALIGN_EPI) { if (wr == 1) PG8_BAR; }
    }
    PG8_WAIT_V(0);
    if constexpr (!ALIGN_EPI) { if (wr == 0) PG8_BAR; }
    PG8_BAR;
    if constexpr (Epi::AFTER_DRAIN) { E.fused(acc, cur, wr, wc, fr, fq, lds, wid, lane); S.done(cur); }
#undef PG8_SA
#undef PG8_SB
#undef PG8_STAGE
#undef PG8_LDA
#undef PG8_LDB
#undef PG8_MMA
#undef PG8_WAIT_V
#undef PG8_WAIT_L
#undef PG8_BAR
#undef PG8_SCHED
}
}

namespace fox {
typedef unsigned short bf16_t;
typedef short bf16x8 __attribute__((ext_vector_type(8)));
typedef short s16x4 __attribute__((ext_vector_type(4)));
typedef float f32x16 __attribute__((ext_vector_type(16)));
typedef float f32x4 __attribute__((ext_vector_type(4)));
typedef unsigned u32x4 __attribute__((ext_vector_type(4)));
constexpr int D = 128, NW = 8, QBLK = 32, KVBLK = 64, QB = NW * QBLK;
constexpr int SHM_V = KVBLK * D * 2, SHM_K = KVBLK * D * 2;
constexpr int LDS_C = 2 * SHM_V + 2 * SHM_K + NW * 64 * 4;
constexpr int LDS_BYTES = LDS_C + SEQ * 4;
constexpr int QP = 4096, OP = 2048;
constexpr float THR = 24.f;
#define KSWZ(row, colB) ((row) * 256 + ((colB) ^ (((row) & 7) << 4)))
#define SBAR() __builtin_amdgcn_sched_barrier(0)
__device__ __forceinline__ int v_st(int k, int c) { const int kk = (k & ~0xC) | ((k & 4) << 1) | ((k & 8) >> 1); return ((kk >> 3) * 4 + (c >> 5)) * 512 + ((kk & 7) * 32 + (c & 31)) * 2; }
__device__ __forceinline__ int v_rd_base(int lane) { return ((lane & 3) << 3) | (((lane >> 2) & 3) << 6) | (((lane >> 4) & 1) << 5) | (((lane >> 5) & 1) << 8); }
constexpr int v_rd_off(int d0, int ks, int half) { return d0 * 512 + ks * 4096 + half * 2048; }
__device__ __forceinline__ int crow(int r, int hi) { return (r & 3) + 8 * (r >> 2) + 4 * hi; }
__device__ __forceinline__ unsigned cvtpk(float lo, float hi) { unsigned r; asm volatile("v_cvt_pk_bf16_f32 %0, %1, %2" : "=v"(r) : "v"(lo), "v"(hi)); return r; }
__device__ __forceinline__ bf16x8 load8(const bf16_t* p) { return *reinterpret_cast<const bf16x8*>(p); }
__device__ __forceinline__ void mask_tile(f32x16& p0, f32x16& p1, int dq) {
    const float NEG = -__builtin_inff();
#pragma unroll
    for (int r = 0; r < 16; ++r) { const int c = (r & 3) + 8 * (r >> 2); if (dq - c < 0) p0[r] = NEG; if (dq - c - 32 < 0) p1[r] = NEG; }
}
__device__ __forceinline__ void bias_tile(f32x16& p0, f32x16& p1, const float* cb) {
#pragma unroll
    for (int i = 0; i < 4; ++i) { const f32x4 c0 = *(const f32x4*)(cb + 8 * i), c1 = *(const f32x4*)(cb + 32 + 8 * i);
#pragma unroll
        for (int j = 0; j < 4; ++j) { p0[4 * i + j] -= c0[j]; p1[4 * i + j] -= c1[j]; } }
}
__device__ __forceinline__ void partialSM(f32x16& p0, f32x16& p1, float& m_reg, float& mn, float& alpha) {
    float pmax = p0[0]; for (int r = 1; r < 16; ++r) pmax = fmaxf(pmax, p0[r]); for (int r = 0; r < 16; ++r) pmax = fmaxf(pmax, p1[r]);
    { auto rr = __builtin_amdgcn_permlane32_swap(__float_as_uint(pmax), __float_as_uint(pmax), false, false);
      pmax = fmaxf(__uint_as_float(rr[0]), __uint_as_float(rr[1])); }
    if (__builtin_expect(__all((pmax - m_reg) <= THR), 1)) { mn = m_reg; alpha = 1.f; }
    else { mn = fmaxf(m_reg, pmax); alpha = __builtin_amdgcn_exp2f(m_reg - mn); m_reg = mn; }
    for (int r = 0; r < 16; ++r) p0[r] = p0[r] - mn; for (int r = 0; r < 16; ++r) p1[r] = p1[r] - mn;
    for (int r = 0; r < 16; ++r) p0[r] = __builtin_amdgcn_exp2f(p0[r]);
}
__device__ __forceinline__ void finishSM(f32x16& p0, f32x16& p1, float alpha, float& l_reg, bf16x8& pa0, bf16x8& pa1, bf16x8& pa2, bf16x8& pa3) {
    for (int r = 0; r < 16; ++r) p1[r] = __builtin_amdgcn_exp2f(p1[r]);
    float ps = 0; for (int r = 0; r < 16; ++r) ps += p0[r]; for (int r = 0; r < 16; ++r) ps += p1[r];
    { auto rr = __builtin_amdgcn_permlane32_swap(__float_as_uint(ps), __float_as_uint(ps), false, false);
      ps = __uint_as_float(rr[0]) + __uint_as_float(rr[1]); }
    l_reg = l_reg * alpha + ps;
#define PK4(P, B_, OUT) do { unsigned a0 = cvtpk(P[B_+0], P[B_+1]), a1 = cvtpk(P[B_+2], P[B_+3]);                          \
        unsigned b0 = cvtpk(P[B_+4], P[B_+5]), b1 = cvtpk(P[B_+6], P[B_+7]);                                             \
        auto r0 = __builtin_amdgcn_permlane32_swap(a0, b0, false, false); auto r1 = __builtin_amdgcn_permlane32_swap(a1, b1, false, false); \
        u32x4 w = {r0[0], r1[0], r0[1], r1[1]}; OUT = *reinterpret_cast<bf16x8*>(&w); } while (0)
    PK4(p0, 0, pa0); PK4(p0, 8, pa1); PK4(p1, 0, pa2); PK4(p1, 8, pa3);
#undef PK4
}
template <int KB>
__device__ __forceinline__ void qkt(f32x16& p0, f32x16& p1, const char* K_lds, int r32, int hi, const bf16x8* qr) {
    p0 = f32x16{}; p1 = f32x16{};
    const char* kb[4];
#pragma unroll
    for (int dd = 0; dd < 4; ++dd) kb[dd] = K_lds + KB * SHM_K + KSWZ(r32, (dd * 16 + hi * 8) * 2);
#pragma unroll
    for (int d0 = 0; d0 < 8; ++d0) { const char* a = kb[d0 & 3] + (d0 >> 2) * 128;
        bf16x8 b0 = *reinterpret_cast<const bf16x8*>(a);
        bf16x8 b1 = *reinterpret_cast<const bf16x8*>(a + 32 * 256);
        p0 = __builtin_amdgcn_mfma_f32_32x32x16_bf16(b0, qr[d0], p0, 0, 0, 0);
        p1 = __builtin_amdgcn_mfma_f32_32x32x16_bf16(b1, qr[d0], p1, 0, 0, 0); }
}
template <int VB>
__device__ __forceinline__ void pv_tile(f32x16* o, int vb0, bf16x8 pa0, bf16x8 pa1, bf16x8 pa2, bf16x8 pa3) {
#define TRRD(dst, off) asm volatile("ds_read_b64_tr_b16 %0, %1 offset:%2" : "=&v"(dst) : "v"(vb0), "i"(off) : "memory")
#define PV_D0(d0) do { s16x4 l0, l1, l2, l3, h0, h1, h2, h3; constexpr int b_ = VB * SHM_V + v_rd_off(d0, 0, 0); \
        TRRD(l0, b_); TRRD(h0, b_ + 2048); TRRD(l1, b_ + 4096); TRRD(h1, b_ + 6144); TRRD(l2, b_ + 8192); TRRD(h2, b_ + 10240); TRRD(l3, b_ + 12288); TRRD(h3, b_ + 14336); \
        asm volatile("s_waitcnt lgkmcnt(0)" ::: "memory"); SBAR();   \
        o[d0] = __builtin_amdgcn_mfma_f32_32x32x16_bf16(pa0, (bf16x8){l0[0], l0[1], l0[2], l0[3], h0[0], h0[1], h0[2], h0[3]}, o[d0], 0, 0, 0);   \
        o[d0] = __builtin_amdgcn_mfma_f32_32x32x16_bf16(pa1, (bf16x8){l1[0], l1[1], l1[2], l1[3], h1[0], h1[1], h1[2], h1[3]}, o[d0], 0, 0, 0);   \
        o[d0] = __builtin_amdgcn_mfma_f32_32x32x16_bf16(pa2, (bf16x8){l2[0], l2[1], l2[2], l2[3], h2[0], h2[1], h2[2], h2[3]}, o[d0], 0, 0, 0);   \
        o[d0] = __builtin_amdgcn_mfma_f32_32x32x16_bf16(pa3, (bf16x8){l3[0], l3[1], l3[2], l3[3], h3[0], h3[1], h3[2], h3[3]}, o[d0], 0, 0, 0); } while (0)
    PV_D0(0); PV_D0(1); PV_D0(2); PV_D0(3);
#undef PV_D0
#undef TRRD
}
struct BlockRef { const bf16_t* Q; const bf16_t* K; const bf16_t* V; bf16_t* O; int P0; };
struct Seam { bf16x8 qr[8]; bf16x8 st_v0, st_v1, st_k0, st_k1; };
#define ROW(p, k0, rr) ((p) + (size_t)((k0) + (rr)) * QP + sc)
#define VMW() asm volatile("s_waitcnt vmcnt(0)" ::: "memory")
#define VMWN(n) asm volatile("s_waitcnt vmcnt(%0)" :: "i"(n) : "memory")
#define SLOAD_H(Kp, Vp, k0) do { S.st_v0 = load8(ROW(Vp, k0, sr)); S.st_v1 = load8(ROW(Vp, k0, 32 + sr)); S.st_k0 = load8(ROW(Kp, k0, sr)); S.st_k1 = load8(ROW(Kp, k0, 32 + sr)); } while (0)
#define SWRITE_HK(bf) do { *(bf16x8*)(K_lds + (bf) * SHM_K + kws) = S.st_k0; *(bf16x8*)(K_lds + (bf) * SHM_K + kws + 32 * 256) = S.st_k1; } while (0)
#define SWRITE_HV(bf) do { *(bf16x8*)(V_lds + (bf) * SHM_V + vst0) = S.st_v0; *(bf16x8*)(V_lds + (bf) * SHM_V + vst1) = S.st_v1; } while (0)
#define SWRITE_H(bf) do { SWRITE_HV(bf); SWRITE_HK(bf); } while (0)
__device__ __forceinline__ void prime(const BlockRef& cur, char* lds, Seam& S) {
    const int tid = threadIdx.x, wid = __builtin_amdgcn_readfirstlane(tid >> 6), lane = tid & 63, r32 = lane & 31, hi = lane >> 5;
    const int sr = tid >> 4, sc = (tid & 15) * 8, kws = KSWZ(sr, sc * 2); char* K_lds = lds + 2 * SHM_V;
    for (int d0 = 0; d0 < 8; ++d0) S.qr[d0] = load8(cur.Q + (size_t)(wid * QBLK + r32) * QP + d0 * 16 + hi * 8);
    SLOAD_H(cur.K, cur.V, 0); VMW(); SWRITE_HK(0);
    __syncthreads();
}
__device__ __forceinline__ void block(const BlockRef& cur, const BlockRef& nxt, char* lds, Seam& S) {
    const int tid = threadIdx.x, wid = __builtin_amdgcn_readfirstlane(tid >> 6), lane = tid & 63, r32 = lane & 31, hi = lane >> 5;
    const int NT = (cur.P0 + QB - 1) / KVBLK + 1;
    const int qlo = cur.P0 + wid * QBLK, qm = qlo + r32 - 4 * hi;
    char* V_lds = lds; char* K_lds = lds + 2 * SHM_V;
    float* ws = (float*)(lds + 2 * SHM_V + 2 * SHM_K) + wid * 64; float* li_l = ws, * al_l = ws + 32;
    const float* c_lds = (const float*)(lds + LDS_C) + 4 * hi;
    float m_reg = -1e30f, l_reg = 0; f32x16 o[4] = {};
    const int sr = tid >> 4, sc = (tid & 15) * 8, vst0 = v_st(sr, sc), vst1 = v_st(32 + sr, sc), kws = KSWZ(sr, sc * 2);
    const int vb0 = (int)(uintptr_t)V_lds + v_rd_base(lane);
    const bf16_t* Kh = cur.K; const bf16_t* Vh = cur.V;
#define RESC(a) do { if (__any((a) < 1.f)) { if (hi == 0) al_l[r32] = (a); asm volatile("s_waitcnt lgkmcnt(0)" ::: "memory");              \
                     for (int d_ = 0; d_ < 4; ++d_) for (int r = 0; r < 16; ++r) o[d_][r] *= al_l[crow(r, hi)]; } } while (0)
#define KBASE(t) ((t) * KVBLK)
#define MASKT(P0_, P1_, t) do { const int kb_ = KBASE(t); bias_tile(P0_, P1_, c_lds + kb_); if (kb_ + KVBLK - 1 > qlo) mask_tile(P0_, P1_, qm - kb_); } while (0)
#define SEAM_K0() do { VMWN(8); SWRITE_HK(0); SBAR(); } while (0)
    f32x16 pA0, pA1, pB0, pB1; float mnA, mnB, alA, alB; bf16x8 pa0, pa1, pa2, pa3;
    SWRITE_HV(0); SBAR();
    if (NT > 1) { SLOAD_H(Kh, Vh, KBASE(1)); }
    SBAR(); qkt<0>(pA0, pA1, K_lds, r32, hi, S.qr);
    MASKT(pA0, pA1, 0); partialSM(pA0, pA1, m_reg, mnA, alA);
    if (NT > 1) { VMW(); SWRITE_H(1); }
    __syncthreads();
#define HALF_STEP(PX0, PX1, mnX, alX, PY0, PY1, alY, t, KB, VB, SB) do {                                                      \
        SBAR(); qkt<KB>(PX0, PX1, K_lds, r32, hi, S.qr);                                                                     \
        finishSM(PY0, PY1, alY, l_reg, pa0, pa1, pa2, pa3); SBAR();                                                           \
        if ((t) + 1 < NT) { SLOAD_H(Kh, Vh, KBASE((t) + 1)); SBAR(); }                                                        \
        pv_tile<VB>(o, vb0, pa0, pa1, pa2, pa3); MASKT(PX0, PX1, (t)); partialSM(PX0, PX1, m_reg, mnX, alX);                 \
        __syncthreads();                                                                                                      \
        if ((t) + 1 < NT) { VMW(); SWRITE_H(SB); }                                                                            \
        RESC(alX); __syncthreads(); } while (0)
    for (int t = 1; t + 1 < NT; t += 2) {
        HALF_STEP(pB0, pB1, mnB, alB, pA0, pA1, alA, t, 1, 0, 0);
        HALF_STEP(pA0, pA1, mnA, alA, pB0, pB1, alB, t + 1, 0, 1, 1);
    }
    const bool even = (NT & 1) == 0;
    if (even) { SBAR(); qkt<1>(pB0, pB1, K_lds, r32, hi, S.qr); SBAR(); }
    SLOAD_H(nxt.K, nxt.V, 0); SBAR();
#pragma unroll
    for (int d0 = 0; d0 < 8; ++d0) S.qr[d0] = load8(nxt.Q + (size_t)(wid * QBLK + r32) * QP + d0 * 16 + hi * 8);
    SBAR();
    finishSM(pA0, pA1, alA, l_reg, pa0, pa1, pa2, pa3); SBAR();
    pv_tile<0>(o, vb0, pa0, pa1, pa2, pa3);
    if (even) { MASKT(pB0, pB1, NT - 1); partialSM(pB0, pB1, m_reg, mnB, alB); __syncthreads(); RESC(alB);
        finishSM(pB0, pB1, alB, l_reg, pa0, pa1, pa2, pa3); SBAR(); pv_tile<1>(o, vb0, pa0, pa1, pa2, pa3); }
    SBAR(); SEAM_K0();
    if (hi == 0) li_l[r32] = l_reg; asm volatile("s_waitcnt lgkmcnt(0)" ::: "memory");
    float rli[16];
#pragma unroll
    for (int r = 0; r < 16; ++r) rli[r] = __builtin_amdgcn_rcpf(li_l[crow(r, hi)]);
    bf16_t* Ow = cur.O + (size_t)(wid * QBLK) * OP;
#pragma unroll
    for (int r = 0; r < 16; ++r) { const int orow = crow(r, hi);
#pragma unroll
        for (int d0 = 0; d0 < 4; ++d0) { const float v = o[d0][r] * rli[r];
            const float vn = __shfl_xor(v, 1);
            if ((r32 & 1) == 0) *(unsigned*)(Ow + (size_t)orow * OP + d0 * 32 + r32) = cvtpk(v, vn); } }
    __syncthreads();
#undef RESC
#undef KBASE
#undef MASKT
#undef SEAM_K0
#undef HALF_STEP
}
#undef ROW
#undef VMW
#undef VMWN
#undef SLOAD_H
#undef SWRITE_HK
#undef SWRITE_HV
#undef SWRITE_H
#undef KSWZ
#undef SBAR
}

constexpr int NWAVES = 8, NTHREADS = 512;
constexpr int LDS_BYTES = 147456;
constexpr int LDS_MISC = 145408;
constexpr size_t MiB = 1u << 20;
constexpr size_t WS_CTL = 0, CTL_ZERO_BYTES = 1 * MiB;
#ifndef QSPLIT
#define QSPLIT 1024
#endif
constexpr int CW_QUEUE2 = 128;
constexpr int CW_QUEUE = 64;
constexpr int CW_BAR = 4096;
constexpr size_t CTL_SS1 = 256 * 1024, CTL_SS2 = 320 * 1024;
constexpr size_t WS_LF = 1 * MiB;
constexpr size_t WS_SU = 1 * MiB + 512 * 1024, WS_SV = 1 * MiB + 640 * 1024;
constexpr size_t WS_WIN = 2 * MiB, WS_WO1 = 18 * MiB, WS_WO2 = 26 * MiB, WS_WQ = 34 * MiB, WS_WK = 42 * MiB, WS_WV = 50 * MiB, WS_WO = 58 * MiB;
constexpr size_t WS_WPQ = 66 * MiB, WS_AEXP = 74 * MiB, WS_WSC = 82 * MiB, WS_PB = 90 * MiB, WS_MN = 91 * MiB, WS_KX = 93 * MiB, WS_VXT = 95 * MiB;
constexpr size_t WS_UB = 98 * MiB, WS_VB = 130 * MiB, WS_XN = 226 * MiB, WS_PROJ = 258 * MiB, WS_AMIX = 322 * MiB, WS_H = 354 * MiB, WS_HB = 418 * MiB, WS_P = 450 * MiB, WS_END = 466 * MiB;

#define GAS __attribute__((address_space(1)))
#define LAS __attribute__((address_space(3)))
typedef unsigned short bf16;
typedef unsigned v4u __attribute__((ext_vector_type(4)));
typedef unsigned v2u __attribute__((ext_vector_type(2)));
typedef float f32x4 __attribute__((ext_vector_type(4)));
typedef __bf16 bf16x2_t __attribute__((ext_vector_type(2)));
#define LDS_WAIT() asm volatile("s_waitcnt lgkmcnt(0)" ::: "memory")
__device__ __forceinline__ unsigned f2bf(float f) { unsigned u = __builtin_bit_cast(unsigned, f); return (u + 0x7fffu + ((u >> 16) & 1u)) >> 16; }
__device__ __forceinline__ unsigned pk2(float lo, float hi) { return f2bf(lo) | (f2bf(hi) << 16); }
__device__ __forceinline__ float wave_sum(float v) {
#pragma unroll
    for (int o = 1; o < 64; o <<= 1) v += __shfl_xor(v, o);
    return v;
}

#define XB_TMO      128
#define XB_XCNT(j)  (256  + 64 * (j))
#define XB_XSUB(j)  (1280 + 64 * (j))
#define XB_XGEN(j)  (2304 + 64 * (j))
#define XB_TOP      3328
#define XB_TOPGEN   3392
#define XCD_BAR_WORDS 3456
#define XB_SPIN_CAP (1u << 22)
__device__ __forceinline__ unsigned xb_ld(unsigned* p)              { return __hip_atomic_load(p, __ATOMIC_RELAXED, __HIP_MEMORY_SCOPE_AGENT); }
__device__ __forceinline__ unsigned xb_add(unsigned* p, unsigned v) { return __hip_atomic_fetch_add(p, v, __ATOMIC_RELAXED, __HIP_MEMORY_SCOPE_AGENT); }
__device__ __forceinline__ unsigned xb_xcc_id() { return (unsigned)__builtin_amdgcn_s_getreg((3 << 11) | 20) & 0xFu; }
#define XB_SPIN(cond, bar) do { unsigned _sp = 0; while (cond) { __builtin_amdgcn_s_sleep(1); \
    if ((++_sp & 255u) == 0u) { if (xb_ld(&(bar)[XB_TMO])) break; if (_sp > XB_SPIN_CAP) { atomicAdd(&(bar)[XB_TMO], 1u); break; } } } } while (0)
struct XcdBarrier { unsigned* bar; unsigned x; volatile LAS unsigned* st; };
__device__ __forceinline__ XcdBarrier xcd_barrier_post(unsigned* bar, volatile LAS unsigned* st) {
    XcdBarrier b; b.bar = bar; b.x = xb_xcc_id(); b.st = st;
    if (threadIdx.x == 0) (void)xb_add(&bar[XB_XCNT(b.x)], 1u);
    return b;
}
__device__ __forceinline__ void xcd_barrier_complete(unsigned* bar, unsigned x, unsigned& nloc, unsigned& nx) {
    const unsigned G = gridDim.x * gridDim.y * gridDim.z;
    unsigned sum, cnt, mine, sp = 0u;
    for (;;) {
        sum = 0u; cnt = 0u; mine = 0u;
#pragma unroll
        for (unsigned j = 0; j < 16; ++j) { const unsigned c = xb_ld(&bar[XB_XCNT(j)]); sum += c; cnt += (c > 0u) ? 1u : 0u; mine = (j == x) ? c : mine; }
        if (sum == G) break;
        __builtin_amdgcn_s_sleep(1);
        if ((++sp & 255u) == 0u) { if (xb_ld(&bar[XB_TMO])) break; if (sp > XB_SPIN_CAP) { atomicAdd(&bar[XB_TMO], 1u); break; } }
    }
    nloc = mine > 0u ? mine : 1u; nx = cnt > 0u ? cnt : 1u;
}
__device__ __forceinline__ void xcd_barrier(const XcdBarrier& b) {
    asm volatile("s_waitcnt vmcnt(0)" ::: "memory");
    __syncthreads();
    if (threadIdx.x == 0) {
        unsigned* bar = b.bar;
        __builtin_amdgcn_s_waitcnt(0);
        unsigned nloc = b.st[0], nx = b.st[1];
        if (nloc == 0u) { xcd_barrier_complete(bar, b.x, nloc, nx); b.st[0] = nloc; b.st[1] = nx; }
        const unsigned old = xb_add(&bar[XB_XSUB(b.x)], 1u);
        const unsigned gen = old / nloc;
        if (old + 1u == (gen + 1u) * nloc) {
            __builtin_amdgcn_fence(__ATOMIC_RELEASE, "agent");
            asm volatile("s_waitcnt vmcnt(0)" ::: "memory");
            const unsigned og = xb_add(&bar[XB_TOP], 1u);
            const unsigned tg = og / nx;
            if (og + 1u == (tg + 1u) * nx) xb_add(&bar[XB_TOPGEN], 1u);
            else XB_SPIN(xb_ld(&bar[XB_TOPGEN]) == tg, bar);
            __builtin_amdgcn_fence(__ATOMIC_ACQUIRE, "agent");
            xb_add(&bar[XB_XGEN(b.x)], 1u);
            asm volatile("s_waitcnt vmcnt(0)" ::: "memory");
        } else {
            XB_SPIN(xb_ld(&bar[XB_XGEN(b.x)]) == gen, bar);
            __builtin_amdgcn_fence(__ATOMIC_ACQUIRE, "agent");
            asm volatile("s_waitcnt vmcnt(0)" ::: "memory");
        }
    }
    __syncthreads();
}

struct Args { const float* in[20]; float* out; unsigned char* ws; int ph_lo, ph_hi; int one_launch, pad; };

__device__ __forceinline__ void p0_transpose_item(const float* W, int ldw, int nblk, const float* g, bf16* WT, bf16* WT2, int k2lo, int ldt, LAS float* scr, int item, int lane) {
    const int kb = item / nblk, nb = item % nblk, k0 = 64 * kb, n0 = 32 * nb;
#pragma unroll
    for (int i = 0; i < 32; ++i) { const int kk = 2 * i + (lane >> 5); float v = W[(size_t)(k0 + kk) * ldw + n0 + (lane & 31)]; if (g) v *= g[k0 + kk]; scr[kk * 33 + (lane & 31)] = v; }
    LDS_WAIT(); asm volatile("" ::: "memory");
    const int c = lane & 7;
#pragma unroll
    for (int j = 0; j < 4; ++j) { const int n = (lane >> 3) + 8 * j; const LAS float* s = scr + (8 * c) * 33 + n;
        v4u o; o.x = pk2(s[0 * 33], s[1 * 33]); o.y = pk2(s[2 * 33], s[3 * 33]); o.z = pk2(s[4 * 33], s[5 * 33]); o.w = pk2(s[6 * 33], s[7 * 33]);
        *(GAS v4u*)(WT + (size_t)(n0 + n) * ldt + k0 + 8 * c) = o;
        if (WT2 && k0 >= k2lo) *(GAS v4u*)(WT2 + (size_t)(n0 + n) * ldt + k0 + 8 * c) = o; }
    LDS_WAIT(); asm volatile("" ::: "memory");
}
__device__ __forceinline__ v4u cvt8(const float* p, float s) {
    const f32x4 a = *(const f32x4*)p, b = *(const f32x4*)(p + 4);
    v4u o; o.x = pk2(a[0] * s, a[1] * s); o.y = pk2(a[2] * s, a[3] * s); o.z = pk2(b[0] * s, b[1] * s); o.w = pk2(b[2] * s, b[3] * s); return o;
}

__device__ __forceinline__ float gelu_f(float v) {
    const float av = fabsf(v), t = __builtin_amdgcn_rcpf(av * 0.2316418882f + 1.0f);
    float q = t * 0.5307027145f + (-0.7265760135f); q = q * t + 0.7107068705f; q = q * t + (-0.142248368f); q = q * t + 0.127414796f; q = q * t;
    const float e = __builtin_amdgcn_exp2f((v * v) * (-0.72134752044f));
    const float m = v * (q * e);
    return v < 0.f ? m : v - m;
}
__device__ __forceinline__ float dot2bf(unsigned a, unsigned b, float c) { return __builtin_amdgcn_fdot2_f32_bf16(__builtin_bit_cast(bf16x2_t, a), __builtin_bit_cast(bf16x2_t, b), c, false); }
__device__ __forceinline__ unsigned fkey(float f) { const unsigned u = __float_as_uint(f); return (u & 0x80000000u) ? ~u : (u | 0x80000000u); }
__device__ __forceinline__ float fdec(unsigned k) { const unsigned u = (k & 0x80000000u) ? (k & 0x7fffffffu) : ~k; return __uint_as_float(u); }


typedef float f32x2v __attribute__((ext_vector_type(2)));
__device__ __forceinline__ float wave_sum_dpp(float v) {
    v += __builtin_bit_cast(float, __builtin_amdgcn_update_dpp(0, __builtin_bit_cast(int, v), 0xB1, 0xf, 0xf, true));
    v += __builtin_bit_cast(float, __builtin_amdgcn_update_dpp(0, __builtin_bit_cast(int, v), 0x4E, 0xf, 0xf, true));
    v += __builtin_bit_cast(float, __builtin_amdgcn_update_dpp(0, __builtin_bit_cast(int, v), 0x141, 0xf, 0xf, true));
    v += __builtin_bit_cast(float, __builtin_amdgcn_update_dpp(0, __builtin_bit_cast(int, v), 0x140, 0xf, 0xf, true));
    const float a = __builtin_bit_cast(float, __builtin_amdgcn_readlane(__builtin_bit_cast(int, v), 0));
    const float b = __builtin_bit_cast(float, __builtin_amdgcn_readlane(__builtin_bit_cast(int, v), 16));
    const float c = __builtin_bit_cast(float, __builtin_amdgcn_readlane(__builtin_bit_cast(int, v), 32));
    const float d = __builtin_bit_cast(float, __builtin_amdgcn_readlane(__builtin_bit_cast(int, v), 48));
    return (a + b) + (c + d);
}
typedef float v32f __attribute__((ext_vector_type(32)));
typedef float v16f __attribute__((ext_vector_type(16)));
typedef unsigned v6u __attribute__((ext_vector_type(6)));
#ifndef FP6_INTERLEAVED
#define FP6_INTERLEAVED 1
#endif
__device__ __forceinline__ v32f dec_fp6(const v4u a, const v2u b) { const v6u w = {a.x, a.y, a.z, a.w, b.x, b.y}; return __builtin_amdgcn_cvt_scalef32_pk32_f32_fp6(w, 1.0f); }
typedef __bf16 v32bf __attribute__((ext_vector_type(32)));
typedef unsigned v16u __attribute__((ext_vector_type(16)));
__device__ __forceinline__ float peer_dot(const v4u ua, const v2u ub, const unsigned (&xnp)[16]) {
    const v6u w = {ua.x, ua.y, ua.z, ua.w, ub.x, ub.y};
    const v16u fu = __builtin_bit_cast(v16u, __builtin_amdgcn_cvt_scalef32_pk32_bf16_fp6(w, 1.0f));
    unsigned fa[16];
#pragma unroll
    for (int i = 0; i < 16; ++i) fa[i] = fu[i];
    float a[4] = {0.f, 0.f, 0.f, 0.f};
#pragma unroll
    for (int i = 0; i < 16; ++i) a[i & 3] = dot2bf(fa[i], xnp[i], a[i & 3]);
    return (a[0] + a[1]) + (a[2] + a[3]);
}
__device__ __forceinline__ float peer_dot_lds(const v4u ua, const v2u ub, const LAS v4u* xl) {
    const v6u w = {ua.x, ua.y, ua.z, ua.w, ub.x, ub.y};
    const v16u fu = __builtin_bit_cast(v16u, __builtin_amdgcn_cvt_scalef32_pk32_bf16_fp6(w, 1.0f));
    unsigned fa[16];
#pragma unroll
    for (int i = 0; i < 16; ++i) fa[i] = fu[i];
    float a[4] = {0.f, 0.f, 0.f, 0.f};
#pragma unroll
    for (int i4 = 0; i4 < 4; ++i4) { const v4u x4 = xl[i4 * 64];
        a[0] = dot2bf(fa[i4 * 4 + 0], x4.x, a[0]); a[1] = dot2bf(fa[i4 * 4 + 1], x4.y, a[1]); a[2] = dot2bf(fa[i4 * 4 + 2], x4.z, a[2]); a[3] = dot2bf(fa[i4 * 4 + 3], x4.w, a[3]); }
    return (a[0] + a[1]) + (a[2] + a[3]);
}
__device__ __forceinline__ void peer_axpy(const v4u va, const v2u vb, float w, float (&oacc)[32]) {
    const v32f f = dec_fp6(va, vb);
#pragma unroll
    for (int i = 0; i < 32; ++i) oacc[i] = fmaf(w, f[i], oacc[i]);
}


__device__ __forceinline__ void conv_rows2_fp6(const float* srow0, const float* srow1, unsigned char* drow0, unsigned char* drow1, float* sc0, float* sc1, int lane) {
    f32x4 v[2][8]; float am[2] = {0.f, 0.f};
#pragma unroll
    for (int q = 0; q < 8; ++q) { v[0][q] = *(const GAS f32x4*)(srow0 + lane * 4 + q * 256); v[1][q] = *(const GAS f32x4*)(srow1 + lane * 4 + q * 256); }
#pragma unroll
    for (int r = 0; r < 2; ++r)
#pragma unroll
        for (int q = 0; q < 8; ++q) am[r] = fmaxf(am[r], fmaxf(fmaxf(fabsf(v[r][q][0]), fabsf(v[r][q][1])), fmaxf(fabsf(v[r][q][2]), fabsf(v[r][q][3]))));
#pragma unroll
    for (int o = 1; o < 64; o <<= 1) { am[0] = fmaxf(am[0], __shfl_xor(am[0], o)); am[1] = fmaxf(am[1], __shfl_xor(am[1], o)); }
#pragma unroll
    for (int r = 0; r < 2; ++r) {
        int ex = 0; if (am[r] > 0.f) { (void)frexpf(am[r], &ex); ex = 3 - ex; if (ldexpf(am[r], ex) > 7.5f) ex -= 1; }
        const float sc = ldexpf(1.f, ex);
        if (lane == 0) *(r ? sc1 : sc0) = ldexpf(1.f, -ex);
        v16f xa, xb;
#pragma unroll
        for (int i = 0; i < 16; ++i) { xa[i] = v[r][(2 * i) >> 2][(2 * i) & 3] * sc; xb[i] = v[r][(2 * i + 1) >> 2][(2 * i + 1) & 3] * sc; }
        const v6u w = __builtin_amdgcn_cvt_scalef32_2xpk16_fp6_f32(xa, xb, 1.0f);
        unsigned char* drow = r ? drow1 : drow0;
        *(GAS v4u*)(drow + lane * 16) = (v4u){w[0], w[1], w[2], w[3]};
        *(GAS v2u*)(drow + 1024 + lane * 8) = (v2u){w[4], w[5]};
    }
}

__global__ void __launch_bounds__(NTHREADS, 2) fwd_kernel(Args args) {
    extern __shared__ __attribute__((aligned(16))) unsigned char lds[];
    LAS unsigned char* ldsL = (LAS unsigned char*)lds;
    volatile LAS unsigned* MISC = (volatile LAS unsigned*)(ldsL + LDS_MISC);
    const int tid = threadIdx.x, lane = tid & 63, wave = __builtin_amdgcn_readfirstlane(tid >> 6);
    const int G = gridDim.x; const int bx = blockIdx.x; const int vcu = (G % 8 == 0) ? (bx % 8) * (G / 8) + bx / 8 : bx;
#define G_ws (args.ws)
#define G_ctl ((unsigned*)(args.ws + WS_CTL))
#define G_x (args.in[0])
#define G_mem (args.in[1])
#define G_mix_norm (args.in[2])
#define G_w_in (args.in[3])
#define G_b_forget (args.in[4])
#define G_pool_w (args.in[5])
#define G_pool_scale (args.in[6])
#define G_w_out (args.in[7])
#define G_xattn_norm (args.in[8])
#define G_mem_norm (args.in[9])
#define G_xwq (args.in[10])
#define G_xwk (args.in[11])
#define G_xwv (args.in[12])
#define G_xwo (args.in[13])
#define G_peer_norm (args.in[14])
#define G_peer_wq (args.in[15])
#define G_sub_keys (args.in[16])
#define G_peer_u (args.in[17])
#define G_peer_v (args.in[18])
#define G_final_norm (args.in[19])
#define G_W_IN ((bf16*)(args.ws + WS_WIN))
#define G_WO1 ((bf16*)(args.ws + WS_WO1))
#define G_WO2 ((bf16*)(args.ws + WS_WO2))
#define G_WQ ((bf16*)(args.ws + WS_WQ))
#define G_WK ((bf16*)(args.ws + WS_WK))
#define G_WV ((bf16*)(args.ws + WS_WV))
#define G_WO ((bf16*)(args.ws + WS_WO))
#define G_WPQ ((bf16*)(args.ws + WS_WPQ))
#define G_AEXP ((bf16*)(args.ws + WS_AEXP))
#define G_W1 ((bf16*)(args.ws + WS_AEXP))
#define G_W2 ((bf16*)(args.ws + WS_WPQ))
#define G_WSC ((bf16*)(args.ws + WS_WSC))
#define G_PB ((bf16*)(args.ws + WS_PB))
#define G_MN ((bf16*)(args.ws + WS_MN))
#define G_KX ((bf16*)(args.ws + WS_KX))
#define G_VXT ((bf16*)(args.ws + WS_VXT))
#define G_UB (args.ws + WS_UB)
#define G_VB (args.ws + WS_VB)
#define G_SU ((float*)(args.ws + WS_SU))
#define G_SV ((float*)(args.ws + WS_SV))
#define G_XN ((bf16*)(args.ws + WS_XN))
#define G_QX ((bf16*)(args.ws + WS_XN))
#define G_PROJ ((bf16*)(args.ws + WS_PROJ))
#define G_SCT ((float*)(args.ws + WS_PROJ))
#define G_AMIX ((bf16*)(args.ws + WS_AMIX))
#define G_OX ((bf16*)(args.ws + WS_AMIX))
#define G_H ((float*)(args.ws + WS_H))
#define G_HB ((bf16*)(args.ws + WS_HB))
#define G_PP ((bf16*)(args.ws + WS_P))
#define G_LF ((float*)(args.ws + WS_LF))
#define G_SS1 ((float*)(args.ws + CTL_SS1))
#define G_SS2 ((float*)(args.ws + CTL_SS2))

    for (int u = tid; u < (LDS_BYTES - LDS_MISC) / 4; u += NTHREADS) ((LAS unsigned*)(ldsL + LDS_MISC))[u] = 0u;
    __syncthreads();
    XcdBarrier bar; bar.bar = G_ctl + CW_BAR; bar.x = 0; bar.st = nullptr;
    if (args.one_launch) bar = xcd_barrier_post(G_ctl + CW_BAR, MISC + 8);
    const int lo = args.ph_lo, hi = args.ph_hi;
#ifndef PH_MASK
#define PH_MASK 0xff
#endif
#define IN(k) (((PH_MASK >> (k)) & 1) && lo <= (k) && (k) < hi)
#ifdef PROBE_SEL
#define STAMP(i) do { if (bx == 0 && tid == 0) { const unsigned long long t_ = __builtin_amdgcn_s_memrealtime(); MISC[32 + 2 * (i)] = (unsigned)t_; MISC[33 + 2 * (i)] = (unsigned)(t_ >> 32); } } while (0)
#else
#define STAMP(i) do { } while (0)
#endif
#define SEAM(k) do { if (IN(k) && IN((k) + 1)) xcd_barrier(bar); STAMP((k) + 1); } while (0)
#define TABLE_CHUNK(c_) do { _Pragma("unroll 1") for (int i_ = 0; i_ < 4; i_ += 2) { const int r_ = (c_) * 32 + wave * 4 + i_; const int tb_ = r_ >> 14, rr_ = r_ & (PEXP - 1); \
        const float* sp_ = (tb_ ? G_peer_v : G_peer_u) + (size_t)rr_ * DM; unsigned char* dp_ = (tb_ ? G_VB : G_UB) + (size_t)rr_ * 1536; float* scp_ = (tb_ ? G_SV : G_SU) + rr_; \
        conv_rows2_fp6(sp_, sp_ + DM, dp_, dp_ + 1536, scp_, scp_ + 1, lane); } } while (0)
    STAMP(0);
    const int gw = vcu * NWAVES + wave, NGW = G * NWAVES;
    const int gt = vcu * NTHREADS + tid, NGT = G * NTHREADS;

    if (IN(0)) for (int rep_ = 0; rep_ < (((DUP_MASK >> 0) & 1) ? args.pad + 1 : 1); ++rep_) {
        LAS float* wf = (LAS float*)ldsL;
        LAS float* scr = (LAS float*)(ldsL + 65536 + wave * 8704);
        for (int i = tid; i < 8 * DM; i += NTHREADS) { const int d = i >> 3, h = i & 7; wf[h * DM + d] = G_w_in[(size_t)d * INC + 4096 + h]; }
        __syncthreads();
        f32x4 vnx[8];
        if (gw < TOK) {
#pragma unroll
            for (int j = 0; j < 8; ++j) vnx[j] = ((const GAS f32x4*)(G_x + (size_t)gw * DM) + lane)[64 * j]; }
        for (int m = gw; m < TOK; m += NGW) {
            const GAS f32x4* gr = (const GAS f32x4*)G_mix_norm + lane;
            f32x4 v[8]; float s = 0.f;
#pragma unroll
            for (int j = 0; j < 8; ++j) v[j] = vnx[j];
            if (m + NGW < TOK) {
#pragma unroll
                for (int j = 0; j < 8; ++j) vnx[j] = ((const GAS f32x4*)(G_x + (size_t)(m + NGW) * DM) + lane)[64 * j]; }
#pragma unroll
            for (int j = 0; j < 8; ++j) s += (v[j][0] * v[j][0] + v[j][1] * v[j][1]) + (v[j][2] * v[j][2] + v[j][3] * v[j][3]);
            const float rstd = __builtin_amdgcn_rsqf(wave_sum(s) * (1.f / DM) + EPS);
            GAS v2u* o8 = (GAS v2u*)(G_XN + (size_t)m * DM) + lane;
#pragma unroll
            for (int j = 0; j < 8; ++j) { const f32x4 gg = gr[64 * j]; v[j] = v[j] * rstd * gg;
                v2u o; o.x = pk2(v[j][0], v[j][1]); o.y = pk2(v[j][2], v[j][3]); o8[64 * j] = o; }
            float fl[8];
#pragma unroll
            for (int h = 0; h < 8; ++h) { float a = 0.f;
#pragma unroll
                for (int j = 0; j < 8; ++j) { const f32x4 w = *(const LAS f32x4*)(wf + h * DM + j * 256 + lane * 4); a += (v[j][0] * w[0] + v[j][1] * w[1]) + (v[j][2] * w[2] + v[j][3] * w[3]); }
                fl[h] = wave_sum(a);
                asm volatile("" ::: "memory"); }
            if (lane < 8) { float f = fl[0];
#pragma unroll
                for (int h = 1; h < 8; ++h) f = (lane == h) ? fl[h] : f;
                f += G_b_forget[lane];
                const float ls = fminf(f, 0.f) - log1pf(expf(-fabsf(f)));
                const int b = m / SEQ, sq = m % SEQ; G_LF[(size_t)(b * FOXH + lane) * SEQ + sq] = ls; }
        }
        for (int m = gw; m < BATCH * NMEM; m += NGW) {
            const GAS f32x4* xr = (const GAS f32x4*)(G_mem + (size_t)m * DM) + lane; const GAS f32x4* gr = (const GAS f32x4*)G_mem_norm + lane;
            f32x4 v[8]; float s = 0.f;
#pragma unroll
            for (int j = 0; j < 8; ++j) { v[j] = xr[64 * j]; s += (v[j][0] * v[j][0] + v[j][1] * v[j][1]) + (v[j][2] * v[j][2] + v[j][3] * v[j][3]); }
            const float rstd = __builtin_amdgcn_rsqf(wave_sum(s) * (1.f / DM) + EPS);
            GAS v2u* o8 = (GAS v2u*)(G_MN + (size_t)m * DM) + lane;
#pragma unroll
            for (int j = 0; j < 8; ++j) { const f32x4 gg = gr[64 * j]; v[j] = v[j] * rstd * gg; v2u o; o.x = pk2(v[j][0], v[j][1]); o.y = pk2(v[j][2], v[j][3]); o8[64 * j] = o; }
        }
        {
            constexpr int I_IN = (DM / 64) * (4096 / 32), I_SQ = (DM / 64) * (DM / 32);
            constexpr int NITEMS = I_IN + 3 * I_SQ;
            for (int it = gw; it < NITEMS; it += NGW) {
                int r = it;
                if (r < I_IN) { p0_transpose_item(G_w_in, INC, 4096 / 32, nullptr, G_W_IN, nullptr, 0, DM, scr, r, lane); continue; } r -= I_IN;
                if (r < I_SQ) { p0_transpose_item(G_w_out, DM, DM / 32, nullptr, G_WO1, G_WO2, POOLW, DM, scr, r, lane); continue; } r -= I_SQ;
                if (r < I_SQ) { p0_transpose_item(G_xwk, DM, DM / 32, nullptr, G_WK, nullptr, 0, DM, scr, r, lane); continue; } r -= I_SQ;
                p0_transpose_item(G_xwv, DM, DM / 32, nullptr, G_WV, nullptr, 0, DM, scr, r, lane);
            }
        }
        for (int i = gt; i < DM * DM / 8; i += NGT) {
            const int d = i / (DM / 8); *(GAS v4u*)(G_WPQ + (size_t)i * 8) = cvt8(G_peer_wq + (size_t)i * 8, G_peer_norm[d]); }
        for (int i = gt; i < DM * DM / 8; i += NGT) {
            const int d = i / (DM / 8); *(GAS v4u*)(G_WQ + (size_t)i * 8) = cvt8(G_xwq + (size_t)i * 8, G_xattn_norm[d]); }
        for (int i = gt; i < DM * DM / 8; i += NGT) {
            const int r = i / (DM / 8), c0 = (i % (DM / 8)) * 8; const int hc = r >> 7;
            v4u o = {0u, 0u, 0u, 0u}; if ((c0 >> 7) == hc) o = cvt8(G_sub_keys + (size_t)r * 128 + (c0 & 127), 1.f);
            *(GAS v4u*)(G_AEXP + (size_t)i * 8) = o; }
        for (int i = gt; i < 4 * 256 * 256 / 8; i += NGT) {
            const int g = i / (256 * 256 / 8), d0 = (i % 32) * 8; const float* ps = G_pool_scale + g * 256 + d0; const float* p = G_pool_w + (size_t)i * 8;
            v4u o; o.x = pk2(p[0] * ps[0], p[1] * ps[1]); o.y = pk2(p[2] * ps[2], p[3] * ps[3]); o.z = pk2(p[4] * ps[4], p[5] * ps[5]); o.w = pk2(p[6] * ps[6], p[7] * ps[7]);
            *(GAS v4u*)(G_PB + (size_t)i * 8) = o; }
        __syncthreads();
    }
    SEAM(0);

    if (IN(1)) for (int rep_ = 0; rep_ < (((DUP_MASK >> 1) & 1) ? args.pad + 1 : 1); ++rep_) {
        pg8::Gemm g{G_XN, G_W_IN, DM, DM, DM}; pg8::GSched S; S.init(TOK / 256, 4096 / 256, G, bx, DM, DM);
        pg8::EpiStore E{G_PROJ, 4096, 0, 0, 1, nullptr, 1.f, 4, 8, 0.08838834764831845f * LOG2E};
        pg8::gemm_phase<pg8::EpiStore, pg8::GSched, true>(ldsL, g, S, E);
    }
    SEAM(1);

    if (IN(2)) for (int rep_ = 0; rep_ < (((DUP_MASK >> 2) & 1) ? args.pad + 1 : 1); ++rep_) {
        for (int it = vcu; it < TOK / 32; it += G) {
            const int ch = (tid & 127) * 8, rsub = tid >> 7, r0 = it * 32 + rsub * 8, w = 2 << (ch >> 8);
            const int s0 = r0 % SEQ;
            float acc[8];
#pragma unroll
            for (int e = 0; e < 8; ++e) acc[e] = 0.f;
            for (int k = 1; k < w; ++k) { if (s0 - k >= 0) { const v4u v = *(const GAS v4u*)(G_PROJ + (size_t)(r0 - k) * 4096 + ch);
#pragma unroll
                    for (int e = 0; e < 4; ++e) { acc[2 * e] += __uint_as_float(v[e] << 16); acc[2 * e + 1] += __uint_as_float(v[e] & 0xffff0000u); } } }
            for (int rr = 0; rr < 8; ++rr) {
                const v4u v = *(const GAS v4u*)(G_PROJ + (size_t)(r0 + rr) * 4096 + ch); float cur[8];
#pragma unroll
                for (int e = 0; e < 4; ++e) { cur[2 * e] = __uint_as_float(v[e] << 16); cur[2 * e + 1] = __uint_as_float(v[e] & 0xffff0000u); }
                const int sp = s0 + rr; const float inv = 1.f / (float)((sp + 1 < w) ? sp + 1 : w);
                v4u o;
#pragma unroll
                for (int e = 0; e < 8; ++e) acc[e] += cur[e];
                o.x = pk2(acc[0] * inv - cur[0], acc[1] * inv - cur[1]); o.y = pk2(acc[2] * inv - cur[2], acc[3] * inv - cur[3]);
                o.z = pk2(acc[4] * inv - cur[4], acc[5] * inv - cur[5]); o.w = pk2(acc[6] * inv - cur[6], acc[7] * inv - cur[7]);
                *(GAS v4u*)(G_AMIX + (size_t)(r0 + rr) * DM + ch) = o;
                if (sp - w + 1 >= 0) { const v4u vo = *(const GAS v4u*)(G_PROJ + (size_t)(r0 + rr - w + 1) * 4096 + ch);
#pragma unroll
                    for (int e = 0; e < 4; ++e) { acc[2 * e] -= __uint_as_float(vo[e] << 16); acc[2 * e + 1] -= __uint_as_float(vo[e] & 0xffff0000u); } }
            }
        }
        const int a_bh = vcu >> 4, a_qb = vcu & 15;
        if (a_qb < 8 && vcu < 256) {
            const int e = a_bh * 8 + a_qb;
            pg8::Gemm g; pg8::EpiStore E{nullptr, DM, 0, 0, 1, nullptr, 1.f, 0, 0, 1.f};
            int pm, pn;
            if (e < 16)      { pm = e >> 3; pn = e & 7; g = pg8::Gemm{G_MN, G_WK, DM, DM, DM}; E.O = G_KX; E.ldc = DM; }
            else if (e < 32) { const int q = e - 16; pm = q >> 3; pn = q & 7; g = pg8::Gemm{G_MN, G_WV, DM, DM, DM}; E.O = G_VXT; E.ldc = DM; }
            else if (e < 96) { const int q = e - 32; pm = q >> 3; pn = q & 7; g = pg8::Gemm{G_AEXP, G_WPQ, DM, DM, DM}; E.O = G_WSC; E.ldc = DM; }
            else             { const int q = e - 96; const int gg = q >> 3; pm = q & 7; pn = 0;
                               g = pg8::Gemm{G_WO1 + gg * 256, G_PB + (size_t)gg * 65536, 256, DM, 256}; E.O = G_WO2 + gg * 256; E.ldc = DM; }
            const pg8::OneSched S1{pm, pn, (long)pm * 256 * g.lda, (long)pn * 256 * g.ldb};
            pg8::gemm_phase<pg8::EpiStore, pg8::OneSched, false>(ldsL, g, S1, E);
        }
        if (vcu < 256) {
            const int b = a_bh >> 3, h = a_bh & 7;
            float* c_lds = (float*)(lds + fox::LDS_C);
            if (wave == 0) {
                const float* lf = G_LF + (size_t)a_bh * SEQ + lane * 64; float loc[64]; float run = 0.f;
#pragma unroll
                for (int i = 0; i < 16; ++i) { const f32x4 v = *(const f32x4*)(lf + 4 * i);
#pragma unroll
                    for (int e = 0; e < 4; ++e) { run += v[e]; loc[4 * i + e] = run; } }
                float incl = run;
#pragma unroll
                for (int o = 1; o < 64; o <<= 1) { const float t = __shfl_up(incl, o); if (lane >= o) incl += t; }
                const float excl = incl - run;
#pragma unroll
                for (int i = 0; i < 16; ++i) { f32x4 v;
#pragma unroll
                    for (int e = 0; e < 4; ++e) v[e] = (loc[4 * i + e] + excl) * LOG2E;
                    *(f32x4*)(c_lds + lane * 64 + 4 * i) = v; }
            }
            __syncthreads();
            const bf16* Qb = G_PROJ + (size_t)(b * SEQ) * 4096 + 1024 + h * 128;
            fox::BlockRef cur{Qb + (size_t)(a_qb * 256) * 4096, Qb + 1024, Qb + 2048, G_AMIX + (size_t)(b * SEQ + a_qb * 256) * DM + 1024 + h * 128, a_qb * 256};
            fox::Seam S;
            fox::prime(cur, (char*)lds, S);
            fox::block(cur, cur, (char*)lds, S);
            asm volatile("s_waitcnt vmcnt(0)" ::: "memory");
            __syncthreads();
        }
        {
            constexpr int C_T = (DM / 64) * (DM / 32) / 8, NCHUNK = C_T + QSPLIT;
            LAS float* scr = (LAS float*)(ldsL + wave * 8704);
            for (;;) {
                __syncthreads();
                if (tid == 0) MISC[16] = atomicAdd(G_ctl + CW_QUEUE, 1u);
                __syncthreads();
                const int c = (int)MISC[16];
                if (c >= NCHUNK) break;
                if (c < C_T) { p0_transpose_item(G_xwo, DM, DM / 32, nullptr, G_WO, nullptr, 0, DM, scr, c * 8 + wave, lane); }
                else { TABLE_CHUNK(c - C_T); }
            }
        }
    }
    SEAM(2);

    if (IN(3)) for (int rep_ = 0; rep_ < (((DUP_MASK >> 3) & 1) ? args.pad + 1 : 1); ++rep_) {
        { pg8::Gemm g{G_AMIX, G_WO2, DM, DM, DM}; pg8::GSched S; S.init(TOK / 256, DM / 256, G, bx, DM, DM);
          pg8::EpiResid<false> E{G_x, G_HB, rep_ ? nullptr : G_SS1, 0};
          pg8::gemm_phase<pg8::EpiResid<false>, pg8::GSched, true>(ldsL, g, S, E); }
        if (bx < 64) {
            const int f = bx & 63, b = f >> 5, h = (f >> 3) & 3, t = f & 7;
            pg8::Gemm g{G_KX + (size_t)(b * NMEM) * DM + h * XD, G_WQ + h * XD, XD, DM, DM};
            pg8::EpiStore E{G_W1 + (size_t)(b * 1024 + h * 256) * DM, DM, 0, 0, 1, nullptr, 1.f, 0, 0, 1.f};
            const pg8::OneSched S1{0, t, 0, (long)t * 256 * DM};
            pg8::gemm_phase<pg8::EpiStore, pg8::OneSched, false>(ldsL, g, S1, E);
        }
    }
    SEAM(3);

    if (IN(4)) for (int rep_ = 0; rep_ < (((DUP_MASK >> 4) & 1) ? args.pad + 1 : 1); ++rep_) {
        pg8::Gemm g{G_HB, G_W1, DM, DM, DM}; pg8::GSched S; S.init(SEQ / 256, XH, G, bx, DM, DM);
        S.nH = 1; S.nZ = BATCH; S.sAb = (long)SEQ * DM; S.sBb = (long)1024 * DM;
        pg8::EpiSoftmax E{G_PP, 1024, (long)SEQ * 1024, 0, 1, G_SS1, 0.044194173824159216f * LOG2E, SEQ};
        pg8::gemm_phase<pg8::EpiSoftmax, pg8::GSched, false>(ldsL, g, S, E);
        if (bx >= 128 && bx < 192) {
            const int f = bx & 63, b = f >> 5, h = (f >> 3) & 3, t = f & 7;
            pg8::Gemm g2{G_WO + h * XD, G_VXT + (size_t)(b * NMEM) * DM + h * XD, XD, DM, DM};
            pg8::EpiStore E2{G_W2 + (size_t)b * DM * 1024 + h * 256, 1024, 0, 0, 1, nullptr, 1.f, 0, 0, 1.f};
            const pg8::OneSched S2{t, 0, (long)t * 256 * DM, 0};
            pg8::gemm_phase<pg8::EpiStore, pg8::OneSched, false>(ldsL, g2, S2, E2);
        }
        for (;;) {
            __syncthreads();
            if (tid == 0) MISC[16] = atomicAdd(G_ctl + CW_QUEUE2, 1u);
            __syncthreads();
            const int c = (int)MISC[16] + QSPLIT;
            if (c >= 2 * PEXP / 32) break;
            TABLE_CHUNK(c);
        }
    }
    SEAM(4);

    if (IN(5)) for (int rep_ = 0; rep_ < (((DUP_MASK >> 5) & 1) ? args.pad + 1 : 1); ++rep_) {
        pg8::Gemm g{G_PP, G_W2, 1024, 1024, 1024}; pg8::GSched S; S.init(SEQ / 256, DM / 256, G, bx, 1024, 1024);
        S.nH = 1; S.nZ = BATCH; S.sAb = (long)SEQ * 1024; S.sBb = (long)DM * 1024;
        pg8::EpiResid<true> E{G_HB, G_HB, G_SS2, SEQ};
        pg8::gemm_phase<pg8::EpiResid<true>, pg8::GSched, true>(ldsL, g, S, E);
    }
    SEAM(5);

    if (IN(6)) for (int rep_ = 0; rep_ < (((DUP_MASK >> 6) & 1) ? args.pad + 1 : 1); ++rep_) {
        pg8::Gemm g{G_WSC, G_HB, DM, DM, DM}; pg8::GSched S; S.init(DM / 256, TOK / 256, G, bx, DM, DM);
        pg8::EpiF32Col E{G_SCT, TOK, G_SS2};
        pg8::gemm_phase<pg8::EpiF32Col, pg8::GSched, true>(ldsL, g, S, E);
    }
    SEAM(6);

    if (IN(7)) for (int rep_ = 0; rep_ < (((DUP_MASK >> 7) & 1) ? args.pad + 1 : 1); ++rep_) {
        LAS unsigned* TOP1 = (LAS unsigned*)ldsL;
        LAS unsigned* RIDX = (LAS unsigned*)(ldsL + 32768);
        LAS float* RGATE = (LAS float*)(ldsL + 49152);
        for (int blk = vcu; blk < TOK / 32; blk += G) {
            const int t0 = blk * 32;
            {
                const int tok = tid & 31, grp = tid >> 5;
                const float* sp = G_SCT + (size_t)(grp * 128) * TOK + t0 + tok;
                unsigned lst[16];
#pragma unroll
                for (int j = 0; j < 16; ++j) lst[j] = 0u;
                for (int i0 = 0; i0 < 128; i0 += 32) {
                    float v[32];
#pragma unroll
                    for (int e = 0; e < 32; ++e) v[e] = sp[(size_t)(i0 + e) * TOK];
#pragma unroll
                    for (int e = 0; e < 32; ++e) { unsigned xk = (fkey(v[e]) & ~127u) | (unsigned)(127 - (i0 + e));
#pragma unroll
                        for (int j = 0; j < 16; ++j) { const unsigned hi_ = max(lst[j], xk); xk = min(lst[j], xk); lst[j] = hi_; } }
                }
                LAS unsigned* dst = TOP1 + (tok * 16 + grp) * 16;
#pragma unroll
                for (int j = 0; j < 16; j += 4) *(LAS v4u*)(dst + j) = (v4u){lst[j], lst[j + 1], lst[j + 2], lst[j + 3]};
            }
            __syncthreads();
            if (tid < 256) {
                const int tok = tid & 31, head = tid >> 5;
                const LAS unsigned* ka = TOP1 + (tok * 16 + head * 2) * 16; const LAS unsigned* kb = ka + 16;
                float af[16], bfv[16];
#pragma unroll
                for (int j = 0; j < 16; ++j) { af[j] = fdec(ka[j] & ~127u); bfv[j] = fdec(kb[j] & ~127u); }
                unsigned best[16];
#pragma unroll
                for (int j = 0; j < 16; ++j) best[j] = 0u;
#pragma unroll
                for (int i = 0; i < 16; ++i)
#pragma unroll
                    for (int j = 0; j < 16; ++j) if ((i + 1) * (j + 1) <= 16) {
                        unsigned xk = (fkey(af[i] + bfv[j]) & ~255u) | (unsigned)(255 - (i * 16 + j));
#pragma unroll
                        for (int q = 0; q < 16; ++q) { const unsigned hi_ = max(best[q], xk); xk = min(best[q], xk); best[q] = hi_; } }
                float ev[16]; const float m0 = fdec(best[0] & ~255u); float sum = 0.f;
#pragma unroll
                for (int q = 0; q < 16; ++q) { ev[q] = __expf(fdec(best[q] & ~255u) - m0); sum += ev[q]; }
                const float inv = 1.f / sum;
#pragma unroll
                for (int q = 0; q < 16; ++q) { const unsigned code = 255u - (best[q] & 255u); const unsigned i = code >> 4, j = code & 15u;
                    const unsigned ia = 127u - (ka[i] & 127u), ib = 127u - (kb[j] & 127u);
                    RIDX[tok * 128 + head * 16 + q] = ia * 128u + ib; RGATE[tok * 128 + head * 16 + q] = ev[q] * inv; }
            }
            __syncthreads();
            {
                LAS unsigned* SIDX = (LAS unsigned*)ldsL; LAS unsigned* SGATE = (LAS unsigned*)(ldsL + 16384);
                const int tok = tid >> 4; const LAS unsigned* src = RIDX + tok * 128;
                unsigned mine[8]; unsigned rank[8];
#pragma unroll
                for (int i = 0; i < 8; ++i) { mine[i] = (src[(tid & 15) + 16 * i] << 7) | (unsigned)((tid & 15) + 16 * i); rank[i] = 0u; }
                for (int j0 = 0; j0 < 128; j0 += 4) { const v4u o4 = *(const LAS v4u*)(src + j0);
#pragma unroll
                    for (int jj = 0; jj < 4; ++jj) { const unsigned oj = ((jj == 0 ? o4.x : jj == 1 ? o4.y : jj == 2 ? o4.z : o4.w) << 7) | (unsigned)(j0 + jj);
#pragma unroll
                        for (int i = 0; i < 8; ++i) rank[i] += (oj < mine[i]) ? 1u : 0u; } }
#pragma unroll
                for (int i = 0; i < 8; ++i) mine[i] >>= 7;
#pragma unroll
                for (int i = 0; i < 8; ++i) { const unsigned pos = (tok & 2) ? 127u - rank[i] : rank[i];
                    SIDX[tok * 128 + pos] = mine[i];
                    const float su_ = G_SU[mine[i]], gs_ = RGATE[tok * 128 + (tid & 15) + 16 * i] * G_SV[mine[i]];
                    SGATE[tok * 128 + pos] = (__float_as_uint(su_) & 0xffff0000u) | f2bf(gs_); }
            }
            __syncthreads();
            for (int tt = 0; tt < 4; tt += 2) {
                const int tokA = wave * 4 + tt, tokB = tokA + 1; const size_t tA = (size_t)(t0 + tokA), tB = tA + 1;
                float oaccA[32], oaccB[32];
                LAS v4u* xlA = (LAS v4u*)(ldsL + 65536 + wave * 8192) + lane; LAS v4u* xlB = xlA + 256;
                { const float rsA = __builtin_amdgcn_rsqf(G_SS2[tA] * (1.f / DM) + EPS), rsB = __builtin_amdgcn_rsqf(G_SS2[tB] * (1.f / DM) + EPS);
#pragma unroll
                for (int q2 = 0; q2 < 4; ++q2) { v4u pa, pb;
#pragma unroll
                    for (int h2 = 0; h2 < 2; ++h2) { const int q = q2 * 2 + h2; const size_t d0 = (size_t)q * 256 + lane * 4;
                        const v2u ha = *(const GAS v2u*)(G_HB + tA * DM + d0), hb = *(const GAS v2u*)(G_HB + tB * DM + d0); const f32x4 ga = *(const f32x4*)(G_peer_norm + d0);
                        const unsigned a0 = pk2(__uint_as_float(ha.x << 16) * rsA * ga[0], __uint_as_float(ha.x & 0xffff0000u) * rsA * ga[1]), a1 = pk2(__uint_as_float(ha.y << 16) * rsA * ga[2], __uint_as_float(ha.y & 0xffff0000u) * rsA * ga[3]);
                        const unsigned b0 = pk2(__uint_as_float(hb.x << 16) * rsB * ga[0], __uint_as_float(hb.x & 0xffff0000u) * rsB * ga[1]), b1 = pk2(__uint_as_float(hb.y << 16) * rsB * ga[2], __uint_as_float(hb.y & 0xffff0000u) * rsB * ga[3]);
                        if (h2 == 0) { pa.x = a0; pa.y = a1; pb.x = b0; pb.y = b1; } else { pa.z = a0; pa.w = a1; pb.z = b0; pb.w = b1; } }
                    xlA[q2 * 64] = pa; xlB[q2 * 64] = pb; }
#pragma unroll
                for (int e = 0; e < 32; ++e) { oaccA[e] = 0.f; oaccB[e] = 0.f; } }
                const LAS unsigned* ridxA = (const LAS unsigned*)ldsL + tokA * 128; const LAS unsigned* rgsA = (const LAS unsigned*)(ldsL + 16384) + tokA * 128;
                const LAS unsigned* ridxB = ridxA + 128; const LAS unsigned* rgsB = rgsA + 128;
                const __amdgpu_buffer_rsrc_t rsT = __builtin_amdgcn_make_buffer_rsrc((void*)G_UB, 0, 64 << 20, 0x00020000);
                v4u uaX0, uaX1, uaY0, uaY1, va0, va1; v2u ubX0, ubX1, ubY0, ubY1, vb0, vb1;
                unsigned sgX0, sgX1, sgY0, sgY1;
#define PLDU(S, RI, RG, k) do { const unsigned ex_ = (unsigned)__builtin_amdgcn_readfirstlane((int)RI[k]); sg##S = RG[k]; \
        ua##S = __builtin_bit_cast(v4u, __builtin_amdgcn_raw_buffer_load_b128(rsT, lane * 16, ex_ * 1536u, 0)); ub##S = __builtin_bit_cast(v2u, __builtin_amdgcn_raw_buffer_load_b64(rsT, lane * 8 + 1024, ex_ * 1536u, 0)); } while (0)
#define PLDV(S, RI, k) do { const unsigned ex_ = (unsigned)__builtin_amdgcn_readfirstlane((int)RI[k]); \
        va##S = __builtin_bit_cast(v4u, __builtin_amdgcn_raw_buffer_load_b128(rsT, lane * 16, ex_ * 1536u + (32u << 20), 0)); vb##S = __builtin_bit_cast(v2u, __builtin_amdgcn_raw_buffer_load_b64(rsT, lane * 8 + 1024, ex_ * 1536u + (32u << 20), 0)); } while (0)
#define STEP(C, P, k, HASNEXT) do { asm volatile("" ::: "memory");     \
        PLDV(0, ridxA, (k)); PLDV(1, ridxB, (k)); \
        float d0_ = peer_dot_lds(ua##C##0, ub##C##0, xlA), d1_ = peer_dot_lds(ua##C##1, ub##C##1, xlB); \
        const unsigned sg0_ = sg##C##0, sg1_ = sg##C##1; \
        if (HASNEXT) { PLDU(P##0, ridxA, rgsA, (k) + 1); PLDU(P##1, ridxB, rgsB, (k) + 1); } \
        d0_ = wave_sum_dpp(d0_) * __uint_as_float(sg0_ & 0xffff0000u); d1_ = wave_sum_dpp(d1_) * __uint_as_float(sg1_ & 0xffff0000u); \
        const float w0_ = gelu_f(d0_) * __uint_as_float(sg0_ << 16), w1_ = gelu_f(d1_) * __uint_as_float(sg1_ << 16); \
        peer_axpy(va0, vb0, w0_, oaccA); __builtin_amdgcn_sched_barrier(0); peer_axpy(va1, vb1, w1_, oaccB); } while (0)
                PLDU(X0, ridxA, rgsA, 0); PLDU(X1, ridxB, rgsB, 0);
                for (int k = 0; k < 126; k += 2) { STEP(X, Y, k, true); STEP(Y, X, k + 1, true); }
                STEP(X, Y, 126, true); STEP(Y, X, 127, false);
#undef PLDU
#undef PLDV
#undef STEP
#define FINISH(T_, OACC) do { float s_ = 0.f; \
        _Pragma("unroll") for (int q = 0; q < 8; ++q) { const size_t d0 = (size_t)q * 256 + lane * 4; const v2u hb = *(const GAS v2u*)(G_HB + (T_) * DM + d0); \
            const f32x4 a = {__uint_as_float(hb.x << 16), __uint_as_float(hb.x & 0xffff0000u), __uint_as_float(hb.y << 16), __uint_as_float(hb.y & 0xffff0000u)}; \
            _Pragma("unroll") for (int e = 0; e < 4; ++e) { const float y = a[e] + OACC[q * 4 + e]; OACC[q * 4 + e] = y; s_ += y * y; } } \
        const float rstd_ = __builtin_amdgcn_rsqf(wave_sum(s_) * (1.f / DM) + EPS); \
        _Pragma("unroll") for (int q = 0; q < 8; ++q) { const size_t d0 = (size_t)q * 256 + lane * 4; const f32x4 ga = *(const f32x4*)(G_final_norm + d0); f32x4 o; \
            _Pragma("unroll") for (int e = 0; e < 4; ++e) o[e] = OACC[q * 4 + e] * rstd_ * ga[e]; \
            *(f32x4*)(args.out + (T_) * DM + d0) = o; } } while (0)
                FINISH(tA, oaccA); FINISH(tB, oaccB);
#undef FINISH
            }
            __syncthreads();
        }
    }
#undef IN
#undef SEAM
#undef G_ws
#undef G_ctl
#undef G_x
#undef G_mem
#undef G_mix_norm
#undef G_w_in
#undef G_b_forget
#undef G_pool_w
#undef G_pool_scale
#undef G_w_out
#undef G_xattn_norm
#undef G_mem_norm
#undef G_xwq
#undef G_xwk
#undef G_xwv
#undef G_xwo
#undef G_peer_norm
#undef G_peer_wq
#undef G_sub_keys
#undef G_peer_u
#undef G_peer_v
#undef G_final_norm
#undef G_W_IN
#undef G_WO1
#undef G_WO2
#undef G_WQ
#undef G_WK
#undef G_WV
#undef G_WO
#undef G_WPQ
#undef G_AEXP
#undef G_W1
#undef G_W2
#undef G_WSC
#undef G_PB
#undef G_MN
#undef G_KX
#undef G_VXT
#undef G_UB
#undef G_VB
#undef G_SU
#undef G_SV
#undef G_XN
#undef G_QX
#undef G_PROJ
#undef G_SCT
#undef G_AMIX
#undef G_OX
#undef G_H
#undef G_HB
#undef G_PP
#undef G_LF
#undef G_SS1
#undef G_SS2

}

constexpr int N_PHASES = 8;
extern "C" void kernel_launch(void* const* d_in, const int* in_sizes, int n_in, void* d_out, int out_size, void* d_ws, size_t ws_size, hipStream_t stream) {
    static int grid = 0;
    if (grid == 0) {
        if (n_in != 20 || in_sizes[0] != TOK * DM || out_size != TOK * DM || ws_size < WS_END) {
            fprintf(stderr, "kernel_launch: unexpected shapes (n_in %d, in0 %d, out %d, ws %zu < %zu)\n", n_in, n_in > 0 ? in_sizes[0] : -1, out_size, ws_size, (size_t)WS_END); grid = -1; return; }
        int dev = 0, cus = 0, per_cu = 0;
        if (hipGetDevice(&dev) != hipSuccess || hipDeviceGetAttribute(&cus, hipDeviceAttributeMultiprocessorCount, dev) != hipSuccess) { grid = -1; return; }
        if (hipFuncSetAttribute((const void*)fwd_kernel, hipFuncAttributeMaxDynamicSharedMemorySize, LDS_BYTES) != hipSuccess) { fprintf(stderr, "kernel_launch: hipFuncSetAttribute failed\n"); grid = -1; return; }
        if (hipOccupancyMaxActiveBlocksPerMultiprocessor(&per_cu, (const void*)fwd_kernel, NTHREADS, LDS_BYTES) != hipSuccess || per_cu < 1) { fprintf(stderr, "kernel_launch: occupancy query says %d\n", per_cu); per_cu = 1; }
        (void)hipGetLastError();
        grid = cus;
        if (grid != 256) fprintf(stderr, "kernel_launch: %d CUs (built for 256)\n", grid);
    }
    if (grid < 0) return;
    (void)hipMemsetAsync((char*)d_ws + WS_CTL, 0, CTL_ZERO_BYTES, stream);
    Args a{};
    for (int i = 0; i < 20; ++i) a.in[i] = (const float*)d_in[i];
    a.out = (float*)d_out; a.ws = (unsigned char*)d_ws; a.pad = DUP_MASK ? 1 : 0;
#if MK_ONE_LAUNCH
    a.ph_lo = 0; a.ph_hi = N_PHASES; a.one_launch = 1;
    void* kargs[] = {&a};
    hipError_t e = hipLaunchCooperativeKernel((const void*)fwd_kernel, dim3(grid), dim3(NTHREADS), kargs, LDS_BYTES, stream);
    if (e != hipSuccess) fprintf(stderr, "kernel_launch: cooperative launch failed: %s\n", hipGetErrorString(e));
#else
    for (int p = 0; p < N_PHASES; ++p) {
        a.ph_lo = p; a.ph_hi = p + 1; a.one_launch = 0;
        hipLaunchKernelGGL(fwd_kernel, dim3(grid), dim3(NTHREADS), LDS_BYTES, stream, a);
    }
#endif
}
```

```cpp
#include <hip/hip_runtime.h>
#include <hip/hip_bf16.h>
#include <cstdio>
#include <cstdint>

#ifndef DUP_MASK
#define DUP_MASK 0
#endif
#ifndef MK_ONE_LAUNCH
#define MK_ONE_LAUNCH 1
#endif

constexpr int BATCH = 2, SEQ = 4096, DM = 2048, TOK = BATCH * SEQ;
constexpr int INC = 4104, POOLW = 1024, FOXH = 8, FOXD = 128;
constexpr int NMEM = 256, XH = 4, XD = 512;
constexpr int PH = 8, PKEYS = 128, PEXP = 16384, TOPK = 16;
constexpr float EPS = 1e-6f;
constexpr float LOG2E = 1.4426950408889634f;

namespace pg8 {
#define PG8_LAS __attribute__((address_space(3)))
typedef unsigned short bf16_t;
typedef short bf16x8 __attribute__((ext_vector_type(8)));
typedef float f32x4 __attribute__((ext_vector_type(4)));
typedef float f32x2 __attribute__((ext_vector_type(2)));
typedef unsigned u32x4 __attribute__((ext_vector_type(4)));
typedef unsigned u32x2 __attribute__((ext_vector_type(2)));
constexpr int BM = 256, BK = 64, HALF = 128, HTB = HALF * BK * 2, STAGE_BYTES = 8 * HTB, NXCD = 8, WGM = 8;

__host__ __device__ __forceinline__ int lds_byte(int r, int c) { const int st = (r >> 4) * 2 + (c >> 5), rr = r & 15, cc = c & 31, ob = rr * 64 + cc * 2; return st * 1024 + (ob ^ (((ob >> 9) & 1) << 5)); }
__host__ __device__ __forceinline__ void stage_rc(int b, int& R, int& C) { const int st = b / 1024, sb = b % 1024, swz = sb ^ (((sb >> 9) & 1) << 5); R = (st >> 1) * 16 + swz / 64; C = (st & 1) * 32 + (swz % 64) / 2; }
__host__ __device__ __forceinline__ int perm32(int rho) { const int n = rho >> 4, i = rho & 15; return 8 * (i >> 2) + 4 * n + (i & 3); }

struct Unit { int pm, pn, z; long aoff, boff; };
struct Gemm { const bf16_t* A; const bf16_t* Bt; int K, lda, ldb; };

struct GSched {
    int nM, nN, nH, nZ, G, c; long sAb, sAh, sBb, sBh; int lda, ldb;
    __device__ __forceinline__ void init(int nM_, int nN_, int G_, int c_, int lda_, int ldb_) { nM = nM_; nN = nN_; nH = 1; nZ = 1; G = G_; c = c_; sAb = sAh = sBb = sBh = 0; lda = lda_; ldb = ldb_; }
    __device__ __forceinline__ bool next(int i, Unit& u) const {
        const long L = (long)i * G + c; const int nwg = nM * nN; if (L >= (long)nwg * nZ) return false;
        const int z = (int)(L / nwg); int wgid = (int)(L % nwg);
        { const int q = nwg / NXCD, r = nwg % NXCD, xcd = wgid % NXCD, off = wgid / NXCD; wgid = (xcd < r ? xcd * (q + 1) : r * (q + 1) + (xcd - r) * q) + off; }
        const int nig = WGM * nN, gid = wgid / nig, fm = gid * WGM, gsz = (nM - fm) < WGM ? (nM - fm) : WGM;
        u.pm = fm + ((wgid % nig) % gsz); u.pn = (wgid % nig) / gsz; u.z = z;
        const int zb = z / nH, zh = z % nH;
        u.aoff = zb * sAb + zh * sAh + (long)u.pm * BM * lda; u.boff = zb * sBb + zh * sBh + (long)u.pn * BM * ldb;
        return true;
    }
    __device__ __forceinline__ void a_ready(const Unit&) const {}
    __device__ __forceinline__ void done(const Unit&) const {}
};

struct OneSched { int pm, pn; long ao, bo;
    __device__ __forceinline__ bool next(int i, Unit& u) const { if (i) return false; u.pm = pm; u.pn = pn; u.z = 0; u.aoff = ao; u.boff = bo; return true; }
    __device__ __forceinline__ void a_ready(const Unit&) const {}
    __device__ __forceinline__ void done(const Unit&) const {} };
__device__ __forceinline__ unsigned cvt_pk_bf16(float lo, float hi) { unsigned r; asm volatile("v_cvt_pk_bf16_f32 %0, %1, %2" : "=v"(r) : "v"(lo), "v"(hi)); return r; }


struct EpiStore {
    static constexpr bool PERM = true, AFTER_DRAIN = false;
    bf16_t* O; int ldc; long sCb, sCh; int nH;
    const float* ss; float rs_mul;
    int t0, t1; float tscale;
    __device__ __forceinline__ void operator()(const f32x4 (&acc)[2][2][4][2], const Unit& u, int wr, int wc, int fr, int fq) const {
        const int row0 = u.pm * BM + wr * 64 + fr, col0 = u.pn * BM + wc * 32 + 8 * fq;
        bf16_t* base = O + (u.z / nH) * sCb + (u.z % nH) * sCh;
        const float ts = (u.pn >= t0 && u.pn < t1) ? tscale : 1.f;
#pragma unroll
        for (int ai = 0; ai < 2; ++ai)
#pragma unroll
            for (int m = 0; m < 4; ++m) { const int row = row0 + ai * HALF + m * 16;
                float sc = ts; if (ss) sc *= __builtin_amdgcn_rsqf(ss[row] * (1.f / DM) + EPS) * rs_mul;
                bf16_t* rowp = base + (size_t)row * ldc + col0;
#pragma unroll
                for (int bj = 0; bj < 2; ++bj) { const f32x4 v0 = acc[ai][bj][m][0] * sc, v1 = acc[ai][bj][m][1] * sc;
                    u32x4 w; w.x = cvt_pk_bf16(v0[0], v0[1]); w.y = cvt_pk_bf16(v0[2], v0[3]); w.z = cvt_pk_bf16(v1[0], v1[1]); w.w = cvt_pk_bf16(v1[2], v1[3]);
                    *(u32x4*)(rowp + bj * HALF) = w; } }
    }
};
template <bool BASE_BF16> struct EpiResid {
    static constexpr bool PERM = true, AFTER_DRAIN = false;
    const void* base; bf16_t* HB; float* ss; int zrows;
    __device__ __forceinline__ void operator()(const f32x4 (&acc)[2][2][4][2], const Unit& u, int wr, int wc, int fr, int fq) const {
        const int row0 = u.z * zrows + u.pm * BM + wr * 64 + fr, col0 = u.pn * BM + wc * 32 + 8 * fq;
#pragma unroll
        for (int ai = 0; ai < 2; ++ai)
#pragma unroll
            for (int m = 0; m < 4; ++m) { const int row = row0 + ai * HALF + m * 16; const size_t off = (size_t)row * DM + col0; float sq = 0.f;
#pragma unroll
                for (int bj = 0; bj < 2; ++bj) {
                    f32x4 b0, b1;
                    if constexpr (BASE_BF16) { const u32x4 r = *(const u32x4*)((const bf16_t*)base + off + bj * HALF);
                        b0 = (f32x4){__uint_as_float(r.x << 16), __uint_as_float(r.x & 0xffff0000u), __uint_as_float(r.y << 16), __uint_as_float(r.y & 0xffff0000u)};
                        b1 = (f32x4){__uint_as_float(r.z << 16), __uint_as_float(r.z & 0xffff0000u), __uint_as_float(r.w << 16), __uint_as_float(r.w & 0xffff0000u)}; }
                    else { b0 = *(const f32x4*)((const float*)base + off + bj * HALF); b1 = *(const f32x4*)((const float*)base + off + bj * HALF + 4); }
                    const f32x4 h0 = b0 + acc[ai][bj][m][0], h1 = b1 + acc[ai][bj][m][1];
                    u32x4 w; w.x = cvt_pk_bf16(h0[0], h0[1]); w.y = cvt_pk_bf16(h0[2], h0[3]); w.z = cvt_pk_bf16(h1[0], h1[1]); w.w = cvt_pk_bf16(h1[2], h1[3]);
                    *(u32x4*)(HB + off + bj * HALF) = w;
                    sq += (h0[0] * h0[0] + h0[1] * h0[1]) + (h0[2] * h0[2] + h0[3] * h0[3]) + (h1[0] * h1[0] + h1[1] * h1[1]) + (h1[2] * h1[2] + h1[3] * h1[3]); }
                sq += __shfl_xor(sq, 16); sq += __shfl_xor(sq, 32);
                if (fq == 0 && ss) atomicAdd(ss + row, sq); }
    }
};
struct EpiF32Col {
    static constexpr bool PERM = true, AFTER_DRAIN = false;
    float* O; int ldc; const float* ss;
    __device__ __forceinline__ void operator()(const f32x4 (&acc)[2][2][4][2], const Unit& u, int wr, int wc, int fr, int fq) const {
        const int row0 = u.pm * BM + wr * 64 + fr, col0 = u.pn * BM + wc * 32 + 8 * fq;
        f32x4 rs[2][2];
#pragma unroll
        for (int bj = 0; bj < 2; ++bj)
#pragma unroll
            for (int n = 0; n < 2; ++n) { const f32x4 s = *(const f32x4*)(ss + col0 + bj * HALF + 4 * n);
#pragma unroll
                for (int e = 0; e < 4; ++e) rs[bj][n][e] = __builtin_amdgcn_rsqf(s[e] * (1.f / DM) + EPS); }
#pragma unroll
        for (int ai = 0; ai < 2; ++ai)
#pragma unroll
            for (int m = 0; m < 4; ++m) { float* rowp = O + (size_t)(row0 + ai * HALF + m * 16) * ldc + col0;
#pragma unroll
                for (int bj = 0; bj < 2; ++bj) { *(f32x4*)(rowp + bj * HALF) = acc[ai][bj][m][0] * rs[bj][0]; *(f32x4*)(rowp + bj * HALF + 4) = acc[ai][bj][m][1] * rs[bj][1]; } }
    }
};
struct EpiSoftmax {
    static constexpr bool PERM = true, AFTER_DRAIN = true;
    bf16_t* P; int ldc; long sCb, sCh; int nH; const float* ss; float mul; int zrows;
    __device__ __forceinline__ void fused(f32x4 (&acc)[2][2][4][2], const Unit& u, int wr, int wc, int fr, int fq, PG8_LAS unsigned char* lds, int wid, int lane) const {
        PG8_LAS float* Pm = (PG8_LAS float*)lds;
        PG8_LAS float* Ps = (PG8_LAS float*)(lds + 4096);
#pragma unroll
        for (int ai = 0; ai < 2; ++ai)
#pragma unroll
            for (int m = 0; m < 4; ++m) { float mx = -3.0e38f;
                const float rs = __builtin_amdgcn_rsqf(ss[u.z * zrows + u.pm * BM + ai * HALF + wr * 64 + m * 16 + fr] * (1.f / DM) + EPS) * mul;
#pragma unroll
                for (int bj = 0; bj < 2; ++bj)
#pragma unroll
                    for (int n = 0; n < 2; ++n) { const f32x4 x = acc[ai][bj][m][n] * rs; acc[ai][bj][m][n] = x; mx = fmaxf(mx, fmaxf(fmaxf(x[0], x[1]), fmaxf(x[2], x[3]))); }
                mx = fmaxf(mx, __shfl_xor(mx, 16)); mx = fmaxf(mx, __shfl_xor(mx, 32));
                if (fq == 0) Pm[(ai * HALF + wr * 64 + m * 16 + fr) * 4 + wc] = mx; }
        asm volatile("s_waitcnt lgkmcnt(0)" ::: "memory"); __builtin_amdgcn_s_barrier(); asm volatile("" ::: "memory");
#pragma unroll
        for (int ai = 0; ai < 2; ++ai)
#pragma unroll
            for (int m = 0; m < 4; ++m) { const int r = ai * HALF + wr * 64 + m * 16 + fr;
                const f32x4 pm4 = *(const PG8_LAS f32x4*)(Pm + r * 4); const float M = fmaxf(fmaxf(pm4[0], pm4[1]), fmaxf(pm4[2], pm4[3])); float s = 0.f;
#pragma unroll
                for (int bj = 0; bj < 2; ++bj)
#pragma unroll
                    for (int n = 0; n < 2; ++n) { f32x4 x = acc[ai][bj][m][n];
#pragma unroll
                        for (int e = 0; e < 4; ++e) { x[e] = __builtin_amdgcn_exp2f(x[e] - M); s += x[e]; }
                        acc[ai][bj][m][n] = x; }
                s += __shfl_xor(s, 16); s += __shfl_xor(s, 32);
                if (fq == 0) Ps[r * 4 + wc] = s; }
        asm volatile("s_waitcnt lgkmcnt(0)" ::: "memory"); __builtin_amdgcn_s_barrier(); asm volatile("" ::: "memory");
        bf16_t* base = P + (u.z / nH) * sCb + (u.z % nH) * sCh;
        const int row0 = u.pm * BM, col0 = u.pn * BM + wc * 32 + 8 * fq;
#pragma unroll
        for (int ai = 0; ai < 2; ++ai)
#pragma unroll
            for (int m = 0; m < 4; ++m) { const int r = ai * HALF + wr * 64 + m * 16 + fr;
                const f32x4 ps4 = *(const PG8_LAS f32x4*)(Ps + r * 4); const float inv = 1.f / ((ps4[0] + ps4[1]) + (ps4[2] + ps4[3]));
                bf16_t* rowp = base + (size_t)(row0 + r) * ldc + col0;
#pragma unroll
                for (int bj = 0; bj < 2; ++bj) { const f32x4 v0 = acc[ai][bj][m][0] * inv, v1 = acc[ai][bj][m][1] * inv;
                    u32x4 w; w.x = cvt_pk_bf16(v0[0], v0[1]); w.y = cvt_pk_bf16(v0[2], v0[3]); w.z = cvt_pk_bf16(v1[0], v1[1]); w.w = cvt_pk_bf16(v1[2], v1[3]);
                    *(u32x4*)(rowp + bj * HALF) = w; } }
    }
};

template <class Epi, class Sched, bool ALIGN_EPI>
__device__ __forceinline__ void gemm_phase(PG8_LAS unsigned char* lds, const Gemm g, const Sched& S, const Epi& E) {
    const int tid = threadIdx.x, wid = __builtin_amdgcn_readfirstlane(tid >> 6), lane = tid & 63, wr = wid >> 2, wc = wid & 3, fr = lane & 15, fq = lane >> 4;
    const int K = g.K, nt = K / BK;
    unsigned voffA[2], voffB[2];
#pragma unroll
    for (int i = 0; i < 2; ++i) { int R, C; stage_rc(tid * 16 + i * 8192, R, C); const int Rb = Epi::PERM ? ((R & ~31) + perm32(R & 31)) : R;
        voffA[i] = (unsigned)(R * g.lda + C) * 2u; voffB[i] = (unsigned)(Rb * g.ldb + C) * 2u; }
    const size_t kstep = (size_t)(BK * 2);
    const size_t hsA = (size_t)HALF * g.lda * 2, hsB = (size_t)HALF * g.ldb * 2;
    const unsigned ldsw = (unsigned)wid * 1024u;
    const int aoff = lds_byte(wr * 64 + fr, fq * 8), boff = lds_byte(wc * 32 + fr, fq * 8);
#define PG8_SA(b, h) (((b) * 2 + (h)) * HTB)
#define PG8_SB(b, h) ((4 + (b) * 2 + (h)) * HTB)
#define PG8_STAGE(bufoff, gbase, voff) do { _Pragma("unroll") for (int _i = 0; _i < 2; ++_i) \
        __builtin_amdgcn_global_load_lds((const unsigned*)((const char*)(gbase) + (voff)[_i]), (PG8_LAS unsigned*)(lds + (bufoff) + ldsw + _i * 8192), 16, 0, 0); } while (0)
#define PG8_LDA(dst, b, h) do { _Pragma("unroll") for (int m = 0; m < 4; ++m) _Pragma("unroll") for (int k = 0; k < 2; ++k) dst[m][k] = *(const PG8_LAS bf16x8*)(lds + PG8_SA(b, h) + aoff + m * 2048 + k * 1024); } while (0)
#define PG8_LDB(dst, b, h) do { _Pragma("unroll") for (int n = 0; n < 2; ++n) _Pragma("unroll") for (int k = 0; k < 2; ++k) dst[n][k] = *(const PG8_LAS bf16x8*)(lds + PG8_SB(b, h) + boff + n * 2048 + k * 1024); } while (0)
#define PG8_MMA(ai, bj, At, Bt) do { __builtin_amdgcn_s_setprio(1); _Pragma("unroll") for (int m = 0; m < 4; ++m) _Pragma("unroll") for (int n = 0; n < 2; ++n) _Pragma("unroll") for (int k = 0; k < 2; ++k) \
        acc[ai][bj][m][n] = __builtin_amdgcn_mfma_f32_16x16x32_bf16(Bt[n][k], At[m][k], acc[ai][bj][m][n], 0, 0, 0); __builtin_amdgcn_s_setprio(0); } while (0)
#define PG8_WAIT_V(n) asm volatile("s_waitcnt vmcnt(" #n ")" ::: "memory")
#define PG8_WAIT_L(n) asm volatile("s_waitcnt lgkmcnt(" #n ")" ::: "memory")
#define PG8_BAR __builtin_amdgcn_s_barrier()
#define PG8_SCHED __builtin_amdgcn_sched_barrier(0)
    Unit cur, nxt; int ui = 0;
    if (!S.next(0, cur)) return;
    f32x4 acc[2][2][4][2];
#pragma unroll
    for (int a = 0; a < 2; ++a)
#pragma unroll
        for (int b = 0; b < 2; ++b)
#pragma unroll
            for (int m = 0; m < 4; ++m)
#pragma unroll
                for (int n = 0; n < 2; ++n) acc[a][b][m][n] = (f32x4){0.f, 0.f, 0.f, 0.f};
    bf16x8 At[4][2], B0[2][2], B1[2][2];
    const char* cA = (const char*)g.A + (size_t)cur.aoff * 2; const char* cB = (const char*)g.Bt + (size_t)cur.boff * 2;
    S.a_ready(cur);
    PG8_STAGE(PG8_SB(0, 0), cB, voffB); PG8_STAGE(PG8_SB(0, 1), cB + hsB, voffB); PG8_STAGE(PG8_SA(0, 0), cA, voffA); PG8_STAGE(PG8_SA(0, 1), cA + hsA, voffA);
    if (wr == 1) PG8_BAR;
    PG8_WAIT_V(2); PG8_BAR;
    PG8_STAGE(PG8_SB(1, 0), cB + kstep, voffB); PG8_STAGE(PG8_SA(1, 0), cA + kstep, voffA); PG8_STAGE(PG8_SB(1, 1), cB + hsB + kstep, voffB);
    PG8_WAIT_V(6); PG8_BAR;
    for (;;) {
        const bool has_next = S.next(ui + 1, nxt);
        const char* nA = has_next ? (const char*)g.A + (size_t)nxt.aoff * 2 : cA; const char* nB = has_next ? (const char*)g.Bt + (size_t)nxt.boff * 2 : cB;
        for (int t = 0; t < nt; t += 2) {
            const bool last = (t == nt - 2);
            const char* a1 = cA + (size_t)(t + 1) * kstep;
            const char* a2 = last ? nA : cA + (size_t)(t + 2) * kstep; const char* b2 = last ? nB : cB + (size_t)(t + 2) * kstep;
            const char* a3 = a2 + kstep; const char* b3 = b2 + kstep;
            if (last && has_next) S.a_ready(nxt);
            PG8_LDB(B0, 0, 0); PG8_LDB(B1, 0, 1); PG8_SCHED; PG8_LDA(At, 0, 0); PG8_STAGE(PG8_SA(1, 1), a1 + hsA, voffA);
            PG8_WAIT_V(8); PG8_WAIT_L(0); PG8_BAR; PG8_MMA(0, 0, At, B0); PG8_MMA(0, 1, At, B1); PG8_BAR; PG8_SCHED;
            PG8_LDA(At, 0, 1); PG8_STAGE(PG8_SB(0, 0), b2, voffB); PG8_STAGE(PG8_SB(0, 1), b2 + hsB, voffB); PG8_STAGE(PG8_SA(0, 0), a2, voffA);
            PG8_WAIT_V(8); PG8_WAIT_L(0); PG8_BAR; PG8_MMA(1, 0, At, B0); PG8_MMA(1, 1, At, B1); PG8_BAR; PG8_SCHED;
            PG8_LDB(B0, 1, 0); PG8_LDB(B1, 1, 1); PG8_SCHED; PG8_LDA(At, 1, 0); PG8_STAGE(PG8_SA(0, 1), a2 + hsA, voffA);
            PG8_WAIT_V(8); PG8_WAIT_L(0); PG8_BAR; PG8_MMA(0, 0, At, B0); PG8_MMA(0, 1, At, B1); PG8_BAR; PG8_SCHED;
            PG8_LDA(At, 1, 1); PG8_STAGE(PG8_SB(1, 0), b3, voffB); PG8_STAGE(PG8_SB(1, 1), b3 + hsB, voffB); PG8_STAGE(PG8_SA(1, 0), a3, voffA);
            PG8_WAIT_V(8); PG8_WAIT_L(0); PG8_BAR; PG8_MMA(1, 0, At, B0); PG8_MMA(1, 1, At, B1); PG8_BAR; PG8_SCHED;
        }
        if constexpr (ALIGN_EPI) { if (wr == 0) PG8_BAR; }
        if constexpr (!Epi::AFTER_DRAIN) { E(acc, cur, wr, wc, fr, fq); S.done(cur); }
        if (!has_next) break;
#pragma unroll
        for (int a = 0; a < 2; ++a)
#pragma unroll
            for (int b = 0; b < 2; ++b)
#pragma unroll
                for (int m = 0; m < 4; ++m)
#pragma unroll
                    for (int n = 0; n < 2; ++n) acc[a][b][m][n] = (f32x4){0.f, 0.f, 0.f, 0.f};
        cur = nxt; cA = nA; cB = nB; ++ui;
        if constexpr (ALIGN_EPI) { if (wr == 1) PG8_BAR; }
    }
    PG8_WAIT_V(0);
    if constexpr (!ALIGN_EPI) { if (wr == 0) PG8_BAR; }
    PG8_BAR;
    if constexpr (Epi::AFTER_DRAIN) { E.fused(acc, cur, wr, wc, fr, fq, lds, wid, lane); S.done(cur); }
#undef PG8_SA
#undef PG8_SB
#undef PG8_STAGE
#undef PG8_LDA
#undef PG8_LDB
#undef PG8_MMA
#undef PG8_WAIT_V
#undef PG8_WAIT_L
#undef PG8_BAR
#undef PG8_SCHED
}
}

namespace fox {
typedef unsigned short bf16_t;
typedef short bf16x8 __attribute__((ext_vector_type(8)));
typedef short s16x4 __attribute__((ext_vector_type(4)));
typedef float f32x16 __attribute__((ext_vector_type(16)));
typedef float f32x4 __attribute__((ext_vector_type(4)));
typedef unsigned u32x4 __attribute__((ext_vector_type(4)));
constexpr int D = 128, NW = 8, QBLK = 32, KVBLK = 64, QB = NW * QBLK;
constexpr int SHM_V = KVBLK * D * 2, SHM_K = KVBLK * D * 2;
constexpr int LDS_C = 2 * SHM_V + 2 * SHM_K + NW * 64 * 4;
constexpr int LDS_BYTES = LDS_C + SEQ * 4;
constexpr int QP = 4096, OP = 2048;
constexpr float THR = 24.f;
#define KSWZ(row, colB) ((row) * 256 + ((colB) ^ (((row) & 7) << 4)))
#define SBAR() __builtin_amdgcn_sched_barrier(0)
__device__ __forceinline__ int v_st(int k, int c) { const int kk = (k & ~0xC) | ((k & 4) << 1) | ((k & 8) >> 1); return ((kk >> 3) * 4 + (c >> 5)) * 512 + ((kk & 7) * 32 + (c & 31)) * 2; }
__device__ __forceinline__ int v_rd_base(int lane) { return ((lane & 3) << 3) | (((lane >> 2) & 3) << 6) | (((lane >> 4) & 1) << 5) | (((lane >> 5) & 1) << 8); }
constexpr int v_rd_off(int d0, int ks, int half) { return d0 * 512 + ks * 4096 + half * 2048; }
__device__ __forceinline__ int crow(int r, int hi) { return (r & 3) + 8 * (r >> 2) + 4 * hi; }
__device__ __forceinline__ unsigned cvtpk(float lo, float hi) { unsigned r; asm volatile("v_cvt_pk_bf16_f32 %0, %1, %2" : "=v"(r) : "v"(lo), "v"(hi)); return r; }
__device__ __forceinline__ bf16x8 load8(const bf16_t* p) { return *reinterpret_cast<const bf16x8*>(p); }
__device__ __forceinline__ void mask_tile(f32x16& p0, f32x16& p1, int dq) {
    const float NEG = -__builtin_inff();
#pragma unroll
    for (int r = 0; r < 16; ++r) { const int c = (r & 3) + 8 * (r >> 2); if (dq - c < 0) p0[r] = NEG; if (dq - c - 32 < 0) p1[r] = NEG; }
}
__device__ __forceinline__ void bias_tile(f32x16& p0, f32x16& p1, const float* cb) {
#pragma unroll
    for (int i = 0; i < 4; ++i) { const f32x4 c0 = *(const f32x4*)(cb + 8 * i), c1 = *(const f32x4*)(cb + 32 + 8 * i);
#pragma unroll
        for (int j = 0; j < 4; ++j) { p0[4 * i + j] -= c0[j]; p1[4 * i + j] -= c1[j]; } }
}
__device__ __forceinline__ void partialSM(f32x16& p0, f32x16& p1, float& m_reg, float& mn, float& alpha) {
    float pmax = p0[0]; for (int r = 1; r < 16; ++r) pmax = fmaxf(pmax, p0[r]); for (int r = 0; r < 16; ++r) pmax = fmaxf(pmax, p1[r]);
    { auto rr = __builtin_amdgcn_permlane32_swap(__float_as_uint(pmax), __float_as_uint(pmax), false, false);
      pmax = fmaxf(__uint_as_float(rr[0]), __uint_as_float(rr[1])); }
    if (__builtin_expect(__all((pmax - m_reg) <= THR), 1)) { mn = m_reg; alpha = 1.f; }
    else { mn = fmaxf(m_reg, pmax); alpha = __builtin_amdgcn_exp2f(m_reg - mn); m_reg = mn; }
    for (int r = 0; r < 16; ++r) p0[r] = p0[r] - mn; for (int r = 0; r < 16; ++r) p1[r] = p1[r] - mn;
    for (int r = 0; r < 16; ++r) p0[r] = __builtin_amdgcn_exp2f(p0[r]);
}
__device__ __forceinline__ void finishSM(f32x16& p0, f32x16& p1, float alpha, float& l_reg, bf16x8& pa0, bf16x8& pa1, bf16x8& pa2, bf16x8& pa3) {
    for (int r = 0; r < 16; ++r) p1[r] = __builtin_amdgcn_exp2f(p1[r]);
    float ps = 0; for (int r = 0; r < 16; ++r) ps += p0[r]; for (int r = 0; r < 16; ++r) ps += p1[r];
    { auto rr = __builtin_amdgcn_permlane32_swap(__float_as_uint(ps), __float_as_uint(ps), false, false);
      ps = __uint_as_float(rr[0]) + __uint_as_float(rr[1]); }
    l_reg = l_reg * alpha + ps;
#define PK4(P, B_, OUT) do { unsigned a0 = cvtpk(P[B_+0], P[B_+1]), a1 = cvtpk(P[B_+2], P[B_+3]);                          \
        unsigned b0 = cvtpk(P[B_+4], P[B_+5]), b1 = cvtpk(P[B_+6], P[B_+7]);                                             \
        auto r0 = __builtin_amdgcn_permlane32_swap(a0, b0, false, false); auto r1 = __builtin_amdgcn_permlane32_swap(a1, b1, false, false); \
        u32x4 w = {r0[0], r1[0], r0[1], r1[1]}; OUT = *reinterpret_cast<bf16x8*>(&w); } while (0)
    PK4(p0, 0, pa0); PK4(p0, 8, pa1); PK4(p1, 0, pa2); PK4(p1, 8, pa3);
#undef PK4
}
template <int KB>
__device__ __forceinline__ void qkt(f32x16& p0, f32x16& p1, const char* K_lds, int r32, int hi, const bf16x8* qr) {
    p0 = f32x16{}; p1 = f32x16{};
    const char* kb[4];
#pragma unroll
    for (int dd = 0; dd < 4; ++dd) kb[dd] = K_lds + KB * SHM_K + KSWZ(r32, (dd * 16 + hi * 8) * 2);
#pragma unroll
    for (int d0 = 0; d0 < 8; ++d0) { const char* a = kb[d0 & 3] + (d0 >> 2) * 128;
        bf16x8 b0 = *reinterpret_cast<const bf16x8*>(a);
        bf16x8 b1 = *reinterpret_cast<const bf16x8*>(a + 32 * 256);
        p0 = __builtin_amdgcn_mfma_f32_32x32x16_bf16(b0, qr[d0], p0, 0, 0, 0);
        p1 = __builtin_amdgcn_mfma_f32_32x32x16_bf16(b1, qr[d0], p1, 0, 0, 0); }
}
template <int VB>
__device__ __forceinline__ void pv_tile(f32x16* o, int vb0, bf16x8 pa0, bf16x8 pa1, bf16x8 pa2, bf16x8 pa3) {
#define TRRD(dst, off) asm volatile("ds_read_b64_tr_b16 %0, %1 offset:%2" : "=&v"(dst) : "v"(vb0), "i"(off) : "memory")
#define PV_D0(d0) do { s16x4 l0, l1, l2, l3, h0, h1, h2, h3; constexpr int b_ = VB * SHM_V + v_rd_off(d0, 0, 0); \
        TRRD(l0, b_); TRRD(h0, b_ + 2048); TRRD(l1, b_ + 4096); TRRD(h1, b_ + 6144); TRRD(l2, b_ + 8192); TRRD(h2, b_ + 10240); TRRD(l3, b_ + 12288); TRRD(h3, b_ + 14336); \
        asm volatile("s_waitcnt lgkmcnt(0)" ::: "memory"); SBAR();   \
        o[d0] = __builtin_amdgcn_mfma_f32_32x32x16_bf16(pa0, (bf16x8){l0[0], l0[1], l0[2], l0[3], h0[0], h0[1], h0[2], h0[3]}, o[d0], 0, 0, 0);   \
        o[d0] = __builtin_amdgcn_mfma_f32_32x32x16_bf16(pa1, (bf16x8){l1[0], l1[1], l1[2], l1[3], h1[0], h1[1], h1[2], h1[3]}, o[d0], 0, 0, 0);   \
        o[d0] = __builtin_amdgcn_mfma_f32_32x32x16_bf16(pa2, (bf16x8){l2[0], l2[1], l2[2], l2[3], h2[0], h2[1], h2[2], h2[3]}, o[d0], 0, 0, 0);   \
        o[d0] = __builtin_amdgcn_mfma_f32_32x32x16_bf16(pa3, (bf16x8){l3[0], l3[1], l3[2], l3[3], h3[0], h3[1], h3[2], h3[3]}, o[d0], 0, 0, 0); } while (0)
    PV_D0(0); PV_D0(1); PV_D0(2); PV_D0(3);
#undef PV_D0
#undef TRRD
}
struct BlockRef { const bf16_t* Q; const bf16_t* K; const bf16_t* V; bf16_t* O; int P0; };
struct Seam { bf16x8 qr[8]; bf16x8 st_v0, st_v1, st_k0, st_k1; };
#define ROW(p, k0, rr) ((p) + (size_t)((k0) + (rr)) * QP + sc)
#define VMW() asm volatile("s_waitcnt vmcnt(0)" ::: "memory")
#define VMWN(n) asm volatile("s_waitcnt vmcnt(%0)" :: "i"(n) : "memory")
#define SLOAD_H(Kp, Vp, k0) do { S.st_v0 = load8(ROW(Vp, k0, sr)); S.st_v1 = load8(ROW(Vp, k0, 32 + sr)); S.st_k0 = load8(ROW(Kp, k0, sr)); S.st_k1 = load8(ROW(Kp, k0, 32 + sr)); } while (0)
#define SWRITE_HK(bf) do { *(bf16x8*)(K_lds + (bf) * SHM_K + kws) = S.st_k0; *(bf16x8*)(K_lds + (bf) * SHM_K + kws + 32 * 256) = S.st_k1; } while (0)
#define SWRITE_HV(bf) do { *(bf16x8*)(V_lds + (bf) * SHM_V + vst0) = S.st_v0; *(bf16x8*)(V_lds + (bf) * SHM_V + vst1) = S.st_v1; } while (0)
#define SWRITE_H(bf) do { SWRITE_HV(bf); SWRITE_HK(bf); } while (0)
__device__ __forceinline__ void prime(const BlockRef& cur, char* lds, Seam& S) {
    const int tid = threadIdx.x, wid = __builtin_amdgcn_readfirstlane(tid >> 6), lane = tid & 63, r32 = lane & 31, hi = lane >> 5;
    const int sr = tid >> 4, sc = (tid & 15) * 8, kws = KSWZ(sr, sc * 2); char* K_lds = lds + 2 * SHM_V;
    for (int d0 = 0; d0 < 8; ++d0) S.qr[d0] = load8(cur.Q + (size_t)(wid * QBLK + r32) * QP + d0 * 16 + hi * 8);
    SLOAD_H(cur.K, cur.V, 0); VMW(); SWRITE_HK(0);
    __syncthreads();
}
__device__ __forceinline__ void block(const BlockRef& cur, const BlockRef& nxt, char* lds, Seam& S) {
    const int tid = threadIdx.x, wid = __builtin_amdgcn_readfirstlane(tid >> 6), lane = tid & 63, r32 = lane & 31, hi = lane >> 5;
    const int NT = (cur.P0 + QB - 1) / KVBLK + 1;
    const int qlo = cur.P0 + wid * QBLK, qm = qlo + r32 - 4 * hi;
    char* V_lds = lds; char* K_lds = lds + 2 * SHM_V;
    float* ws = (float*)(lds + 2 * SHM_V + 2 * SHM_K) + wid * 64; float* li_l = ws, * al_l = ws + 32;
    const float* c_lds = (const float*)(lds + LDS_C) + 4 * hi;
    float m_reg = -1e30f, l_reg = 0; f32x16 o[4] = {};
    const int sr = tid >> 4, sc = (tid & 15) * 8, vst0 = v_st(sr, sc), vst1 = v_st(32 + sr, sc), kws = KSWZ(sr, sc * 2);
    const int vb0 = (int)(uintptr_t)V_lds + v_rd_base(lane);
    const bf16_t* Kh = cur.K; const bf16_t* Vh = cur.V;
#define RESC(a) do { if (__any((a) < 1.f)) { if (hi == 0) al_l[r32] = (a); asm volatile("s_waitcnt lgkmcnt(0)" ::: "memory");              \
                     for (int d_ = 0; d_ < 4; ++d_) for (int r = 0; r < 16; ++r) o[d_][r] *= al_l[crow(r, hi)]; } } while (0)
#define KBASE(t) ((t) * KVBLK)
#define MASKT(P0_, P1_, t) do { const int kb_ = KBASE(t); bias_tile(P0_, P1_, c_lds + kb_); if (kb_ + KVBLK - 1 > qlo) mask_tile(P0_, P1_, qm - kb_); } while (0)
#define SEAM_K0() do { VMWN(8); SWRITE_HK(0); SBAR(); } while (0)
    f32x16 pA0, pA1, pB0, pB1; float mnA, mnB, alA, alB; bf16x8 pa0, pa1, pa2, pa3;
    SWRITE_HV(0); SBAR();
    if (NT > 1) { SLOAD_H(Kh, Vh, KBASE(1)); }
    SBAR(); qkt<0>(pA0, pA1, K_lds, r32, hi, S.qr);
    MASKT(pA0, pA1, 0); partialSM(pA0, pA1, m_reg, mnA, alA);
    if (NT > 1) { VMW(); SWRITE_H(1); }
    __syncthreads();
#define HALF_STEP(PX0, PX1, mnX, alX, PY0, PY1, alY, t, KB, VB, SB) do {                                                      \
        SBAR(); qkt<KB>(PX0, PX1, K_lds, r32, hi, S.qr);                                                                     \
        finishSM(PY0, PY1, alY, l_reg, pa0, pa1, pa2, pa3); SBAR();                                                           \
        if ((t) + 1 < NT) { SLOAD_H(Kh, Vh, KBASE((t) + 1)); SBAR(); }                                                        \
        pv_tile<VB>(o, vb0, pa0, pa1, pa2, pa3); MASKT(PX0, PX1, (t)); partialSM(PX0, PX1, m_reg, mnX, alX);                 \
        __syncthreads();                                                                                                      \
        if ((t) + 1 < NT) { VMW(); SWRITE_H(SB); }                                                                            \
        RESC(alX); __syncthreads(); } while (0)
    for (int t = 1; t + 1 < NT; t += 2) {
        HALF_STEP(pB0, pB1, mnB, alB, pA0, pA1, alA, t, 1, 0, 0);
        HALF_STEP(pA0, pA1, mnA, alA, pB0, pB1, alB, t + 1, 0, 1, 1);
    }
    const bool even = (NT & 1) == 0;
    if (even) { SBAR(); qkt<1>(pB0, pB1, K_lds, r32, hi, S.qr); SBAR(); }
    SLOAD_H(nxt.K, nxt.V, 0); SBAR();
#pragma unroll
    for (int d0 = 0; d0 < 8; ++d0) S.qr[d0] = load8(nxt.Q + (size_t)(wid * QBLK + r32) * QP + d0 * 16 + hi * 8);
    SBAR();
    finishSM(pA0, pA1, alA, l_reg, pa0, pa1, pa2, pa3); SBAR();
    pv_tile<0>(o, vb0, pa0, pa1, pa2, pa3);
    if (even) { MASKT(pB0, pB1, NT - 1); partialSM(pB0, pB1, m_reg, mnB, alB); __syncthreads(); RESC(alB);
        finishSM(pB0, pB1, alB, l_reg, pa0, pa1, pa2, pa3); SBAR(); pv_tile<1>(o, vb0, pa0, pa1, pa2, pa3); }
    SBAR(); SEAM_K0();
    if (hi == 0) li_l[r32] = l_reg; asm volatile("s_waitcnt lgkmcnt(0)" ::: "memory");
    float rli[16];
#pragma unroll
    for (int r = 0; r < 16; ++r) rli[r] = __builtin_amdgcn_rcpf(li_l[crow(r, hi)]);
    bf16_t* Ow = cur.O + (size_t)(wid * QBLK) * OP;
#pragma unroll
    for (int r = 0; r < 16; ++r) { const int orow = crow(r, hi);
#pragma unroll
        for (int d0 = 0; d0 < 4; ++d0) { const float v = o[d0][r] * rli[r];
            const float vn = __shfl_xor(v, 1);
            if ((r32 & 1) == 0) *(unsigned*)(Ow + (size_t)orow * OP + d0 * 32 + r32) = cvtpk(v, vn); } }
    __syncthreads();
#undef RESC
#undef KBASE
#undef MASKT
#undef SEAM_K0
#undef HALF_STEP
}
#undef ROW
#undef VMW
#undef VMWN
#undef SLOAD_H
#undef SWRITE_HK
#undef SWRITE_HV
#undef SWRITE_H
#undef KSWZ
#undef SBAR
}

constexpr int NWAVES = 8, NTHREADS = 512;
constexpr int LDS_BYTES = 147456;
constexpr int LDS_MISC = 145408;
constexpr size_t MiB = 1u << 20;
constexpr size_t WS_CTL = 0, CTL_ZERO_BYTES = 1 * MiB;
#ifndef QSPLIT
#define QSPLIT 1024
#endif
constexpr int CW_QUEUE2 = 128;
constexpr int CW_QUEUE = 64;
constexpr int CW_BAR = 4096;
constexpr size_t CTL_SS1 = 256 * 1024, CTL_SS2 = 320 * 1024;
constexpr size_t WS_LF = 1 * MiB;
constexpr size_t WS_SU = 1 * MiB + 512 * 1024, WS_SV = 1 * MiB + 640 * 1024;
constexpr size_t WS_WIN = 2 * MiB, WS_WO1 = 18 * MiB, WS_WO2 = 26 * MiB, WS_WQ = 34 * MiB, WS_WK = 42 * MiB, WS_WV = 50 * MiB, WS_WO = 58 * MiB;
constexpr size_t WS_WPQ = 66 * MiB, WS_AEXP = 74 * MiB, WS_WSC = 82 * MiB, WS_PB = 90 * MiB, WS_MN = 91 * MiB, WS_KX = 93 * MiB, WS_VXT = 95 * MiB;
constexpr size_t WS_UB = 98 * MiB, WS_VB = 130 * MiB, WS_XN = 226 * MiB, WS_PROJ = 258 * MiB, WS_AMIX = 322 * MiB, WS_H = 354 * MiB, WS_HB = 418 * MiB, WS_P = 450 * MiB, WS_END = 466 * MiB;

#define GAS __attribute__((address_space(1)))
#define LAS __attribute__((address_space(3)))
typedef unsigned short bf16;
typedef unsigned v4u __attribute__((ext_vector_type(4)));
typedef unsigned v2u __attribute__((ext_vector_type(2)));
typedef float f32x4 __attribute__((ext_vector_type(4)));
typedef __bf16 bf16x2_t __attribute__((ext_vector_type(2)));
#define LDS_WAIT() asm volatile("s_waitcnt lgkmcnt(0)" ::: "memory")
__device__ __forceinline__ unsigned f2bf(float f) { unsigned u = __builtin_bit_cast(unsigned, f); return (u + 0x7fffu + ((u >> 16) & 1u)) >> 16; }
__device__ __forceinline__ unsigned pk2(float lo, float hi) { return f2bf(lo) | (f2bf(hi) << 16); }
__device__ __forceinline__ float wave_sum(float v) {
#pragma unroll
    for (int o = 1; o < 64; o <<= 1) v += __shfl_xor(v, o);
    return v;
}

#define XB_TMO      128
#define XB_XCNT(j)  (256  + 64 * (j))
#define XB_XSUB(j)  (1280 + 64 * (j))
#define XB_XGEN(j)  (2304 + 64 * (j))
#define XB_TOP      3328
#define XB_TOPGEN   3392
#define XCD_BAR_WORDS 3456
#define XB_SPIN_CAP (1u << 22)
__device__ __forceinline__ unsigned xb_ld(unsigned* p)              { return __hip_atomic_load(p, __ATOMIC_RELAXED, __HIP_MEMORY_SCOPE_AGENT); }
__device__ __forceinline__ unsigned xb_add(unsigned* p, unsigned v) { return __hip_atomic_fetch_add(p, v, __ATOMIC_RELAXED, __HIP_MEMORY_SCOPE_AGENT); }
__device__ __forceinline__ unsigned xb_xcc_id() { return (unsigned)__builtin_amdgcn_s_getreg((3 << 11) | 20) & 0xFu; }
#define XB_SPIN(cond, bar) do { unsigned _sp = 0; while (cond) { __builtin_amdgcn_s_sleep(1); \
    if ((++_sp & 255u) == 0u) { if (xb_ld(&(bar)[XB_TMO])) break; if (_sp > XB_SPIN_CAP) { atomicAdd(&(bar)[XB_TMO], 1u); break; } } } } while (0)
struct XcdBarrier { unsigned* bar; unsigned x; volatile LAS unsigned* st; };
__device__ __forceinline__ XcdBarrier xcd_barrier_post(unsigned* bar, volatile LAS unsigned* st) {
    XcdBarrier b; b.bar = bar; b.x = xb_xcc_id(); b.st = st;
    if (threadIdx.x == 0) (void)xb_add(&bar[XB_XCNT(b.x)], 1u);
    return b;
}
__device__ __forceinline__ void xcd_barrier_complete(unsigned* bar, unsigned x, unsigned& nloc, unsigned& nx) {
    const unsigned G = gridDim.x * gridDim.y * gridDim.z;
    unsigned sum, cnt, mine, sp = 0u;
    for (;;) {
        sum = 0u; cnt = 0u; mine = 0u;
#pragma unroll
        for (unsigned j = 0; j < 16; ++j) { const unsigned c = xb_ld(&bar[XB_XCNT(j)]); sum += c; cnt += (c > 0u) ? 1u : 0u; mine = (j == x) ? c : mine; }
        if (sum == G) break;
        __builtin_amdgcn_s_sleep(1);
        if ((++sp & 255u) == 0u) { if (xb_ld(&bar[XB_TMO])) break; if (sp > XB_SPIN_CAP) { atomicAdd(&bar[XB_TMO], 1u); break; } }
    }
    nloc = mine > 0u ? mine : 1u; nx = cnt > 0u ? cnt : 1u;
}
__device__ __forceinline__ void xcd_barrier(const XcdBarrier& b) {
    asm volatile("s_waitcnt vmcnt(0)" ::: "memory");
    __syncthreads();
    if (threadIdx.x == 0) {
        unsigned* bar = b.bar;
        __builtin_amdgcn_s_waitcnt(0);
        unsigned nloc = b.st[0], nx = b.st[1];
        if (nloc == 0u) { xcd_barrier_complete(bar, b.x, nloc, nx); b.st[0] = nloc; b.st[1] = nx; }
        const unsigned old = xb_add(&bar[XB_XSUB(b.x)], 1u);
        const unsigned gen = old / nloc;
        if (old + 1u == (gen + 1u) * nloc) {
            __builtin_amdgcn_fence(__ATOMIC_RELEASE, "agent");
            asm volatile("s_waitcnt vmcnt(0)" ::: "memory");
            const unsigned og = xb_add(&bar[XB_TOP], 1u);
            const unsigned tg = og / nx;
            if (og + 1u == (tg + 1u) * nx) xb_add(&bar[XB_TOPGEN], 1u);
            else XB_SPIN(xb_ld(&bar[XB_TOPGEN]) == tg, bar);
            __builtin_amdgcn_fence(__ATOMIC_ACQUIRE, "agent");
            xb_add(&bar[XB_XGEN(b.x)], 1u);
            asm volatile("s_waitcnt vmcnt(0)" ::: "memory");
        } else {
            XB_SPIN(xb_ld(&bar[XB_XGEN(b.x)]) == gen, bar);
            __builtin_amdgcn_fence(__ATOMIC_ACQUIRE, "agent");
            asm volatile("s_waitcnt vmcnt(0)" ::: "memory");
        }
    }
    __syncthreads();
}

struct Args { const float* in[20]; float* out; unsigned char* ws; int ph_lo, ph_hi; int one_launch, pad; };

__device__ __forceinline__ void p0_transpose_item(const float* W, int ldw, int nblk, const float* g, bf16* WT, bf16* WT2, int k2lo, int ldt, LAS float* scr, int item, int lane) {
    const int kb = item / nblk, nb = item % nblk, k0 = 64 * kb, n0 = 32 * nb;
#pragma unroll
    for (int i = 0; i < 32; ++i) { const int kk = 2 * i + (lane >> 5); float v = W[(size_t)(k0 + kk) * ldw + n0 + (lane & 31)]; if (g) v *= g[k0 + kk]; scr[kk * 33 + (lane & 31)] = v; }
    LDS_WAIT(); asm volatile("" ::: "memory");
    const int c = lane & 7;
#pragma unroll
    for (int j = 0; j < 4; ++j) { const int n = (lane >> 3) + 8 * j; const LAS float* s = scr + (8 * c) * 33 + n;
        v4u o; o.x = pk2(s[0 * 33], s[1 * 33]); o.y = pk2(s[2 * 33], s[3 * 33]); o.z = pk2(s[4 * 33], s[5 * 33]); o.w = pk2(s[6 * 33], s[7 * 33]);
        *(GAS v4u*)(WT + (size_t)(n0 + n) * ldt + k0 + 8 * c) = o;
        if (WT2 && k0 >= k2lo) *(GAS v4u*)(WT2 + (size_t)(n0 + n) * ldt + k0 + 8 * c) = o; }
    LDS_WAIT(); asm volatile("" ::: "memory");
}
__device__ __forceinline__ v4u cvt8(const float* p, float s) {
    const f32x4 a = *(const f32x4*)p, b = *(const f32x4*)(p + 4);
    v4u o; o.x = pk2(a[0] * s, a[1] * s); o.y = pk2(a[2] * s, a[3] * s); o.z = pk2(b[0] * s, b[1] * s); o.w = pk2(b[2] * s, b[3] * s); return o;
}

__device__ __forceinline__ float gelu_f(float v) {
    const float av = fabsf(v), t = __builtin_amdgcn_rcpf(av * 0.2316418882f + 1.0f);
    float q = t * 0.5307027145f + (-0.7265760135f); q = q * t + 0.7107068705f; q = q * t + (-0.142248368f); q = q * t + 0.127414796f; q = q * t;
    const float e = __builtin_amdgcn_exp2f((v * v) * (-0.72134752044f));
    const float m = v * (q * e);
    return v < 0.f ? m : v - m;
}
__device__ __forceinline__ float dot2bf(unsigned a, unsigned b, float c) { return __builtin_amdgcn_fdot2_f32_bf16(__builtin_bit_cast(bf16x2_t, a), __builtin_bit_cast(bf16x2_t, b), c, false); }
__device__ __forceinline__ unsigned fkey(float f) { const unsigned u = __float_as_uint(f); return (u & 0x80000000u) ? ~u : (u | 0x80000000u); }
__device__ __forceinline__ float fdec(unsigned k) { const unsigned u = (k & 0x80000000u) ? (k & 0x7fffffffu) : ~k; return __uint_as_float(u); }


typedef float f32x2v __attribute__((ext_vector_type(2)));
__device__ __forceinline__ float wave_sum_dpp(float v) {
    v += __builtin_bit_cast(float, __builtin_amdgcn_update_dpp(0, __builtin_bit_cast(int, v), 0xB1, 0xf, 0xf, true));
    v += __builtin_bit_cast(float, __builtin_amdgcn_update_dpp(0, __builtin_bit_cast(int, v), 0x4E, 0xf, 0xf, true));
    v += __builtin_bit_cast(float, __builtin_amdgcn_update_dpp(0, __builtin_bit_cast(int, v), 0x141, 0xf, 0xf, true));
    v += __builtin_bit_cast(float, __builtin_amdgcn_update_dpp(0, __builtin_bit_cast(int, v), 0x140, 0xf, 0xf, true));
    const float a = __builtin_bit_cast(float, __builtin_amdgcn_readlane(__builtin_bit_cast(int, v), 0));
    const float b = __builtin_bit_cast(float, __builtin_amdgcn_readlane(__builtin_bit_cast(int, v), 16));
    const float c = __builtin_bit_cast(float, __builtin_amdgcn_readlane(__builtin_bit_cast(int, v), 32));
    const float d = __builtin_bit_cast(float, __builtin_amdgcn_readlane(__builtin_bit_cast(int, v), 48));
    return (a + b) + (c + d);
}
typedef float v32f __attribute__((ext_vector_type(32)));
typedef float v16f __attribute__((ext_vector_type(16)));
typedef unsigned v6u __attribute__((ext_vector_type(6)));
#ifndef FP6_INTERLEAVED
#define FP6_INTERLEAVED 1
#endif
__device__ __forceinline__ v32f dec_fp6(const v4u a, const v2u b) { const v6u w = {a.x, a.y, a.z, a.w, b.x, b.y}; return __builtin_amdgcn_cvt_scalef32_pk32_f32_fp6(w, 1.0f); }
typedef __bf16 v32bf __attribute__((ext_vector_type(32)));
typedef unsigned v16u __attribute__((ext_vector_type(16)));
__device__ __forceinline__ float peer_dot(const v4u ua, const v2u ub, const unsigned (&xnp)[16]) {
    const v6u w = {ua.x, ua.y, ua.z, ua.w, ub.x, ub.y};
    const v16u fu = __builtin_bit_cast(v16u, __builtin_amdgcn_cvt_scalef32_pk32_bf16_fp6(w, 1.0f));
    unsigned fa[16];
#pragma unroll
    for (int i = 0; i < 16; ++i) fa[i] = fu[i];
    float a[4] = {0.f, 0.f, 0.f, 0.f};
#pragma unroll
    for (int i = 0; i < 16; ++i) a[i & 3] = dot2bf(fa[i], xnp[i], a[i & 3]);
    return (a[0] + a[1]) + (a[2] + a[3]);
}
__device__ __forceinline__ float peer_dot_lds(const v4u ua, const v2u ub, const LAS v4u* xl) {
    const v6u w = {ua.x, ua.y, ua.z, ua.w, ub.x, ub.y};
    const v16u fu = __builtin_bit_cast(v16u, __builtin_amdgcn_cvt_scalef32_pk32_bf16_fp6(w, 1.0f));
    unsigned fa[16];
#pragma unroll
    for (int i = 0; i < 16; ++i) fa[i] = fu[i];
    float a[4] = {0.f, 0.f, 0.f, 0.f};
#pragma unroll
    for (int i4 = 0; i4 < 4; ++i4) { const v4u x4 = xl[i4 * 64];
        a[0] = dot2bf(fa[i4 * 4 + 0], x4.x, a[0]); a[1] = dot2bf(fa[i4 * 4 + 1], x4.y, a[1]); a[2] = dot2bf(fa[i4 * 4 + 2], x4.z, a[2]); a[3] = dot2bf(fa[i4 * 4 + 3], x4.w, a[3]); }
    return (a[0] + a[1]) + (a[2] + a[3]);
}
__device__ __forceinline__ void peer_axpy(const v4u va, const v2u vb, float w, float (&oacc)[32]) {
    const v32f f = dec_fp6(va, vb);
#pragma unroll
    for (int i = 0; i < 32; ++i) oacc[i] = fmaf(w, f[i], oacc[i]);
}


__device__ __forceinline__ void conv_rows2_fp6(const float* srow0, const float* srow1, unsigned char* drow0, unsigned char* drow1, float* sc0, float* sc1, int lane) {
    f32x4 v[2][8]; float am[2] = {0.f, 0.f};
#pragma unroll
    for (int q = 0; q < 8; ++q) { v[0][q] = *(const GAS f32x4*)(srow0 + lane * 4 + q * 256); v[1][q] = *(const GAS f32x4*)(srow1 + lane * 4 + q * 256); }
#pragma unroll
    for (int r = 0; r < 2; ++r)
#pragma unroll
        for (int q = 0; q < 8; ++q) am[r] = fmaxf(am[r], fmaxf(fmaxf(fabsf(v[r][q][0]), fabsf(v[r][q][1])), fmaxf(fabsf(v[r][q][2]), fabsf(v[r][q][3]))));
#pragma unroll
    for (int o = 1; o < 64; o <<= 1) { am[0] = fmaxf(am[0], __shfl_xor(am[0], o)); am[1] = fmaxf(am[1], __shfl_xor(am[1], o)); }
#pragma unroll
    for (int r = 0; r < 2; ++r) {
        int ex = 0; if (am[r] > 0.f) { (void)frexpf(am[r], &ex); ex = 3 - ex; if (ldexpf(am[r], ex) > 7.5f) ex -= 1; }
        const float sc = ldexpf(1.f, ex);
        if (lane == 0) *(r ? sc1 : sc0) = ldexpf(1.f, -ex);
        v16f xa, xb;
#pragma unroll
        for (int i = 0; i < 16; ++i) { xa[i] = v[r][(2 * i) >> 2][(2 * i) & 3] * sc; xb[i] = v[r][(2 * i + 1) >> 2][(2 * i + 1) & 3] * sc; }
        const v6u w = __builtin_amdgcn_cvt_scalef32_2xpk16_fp6_f32(xa, xb, 1.0f);
        unsigned char* drow = r ? drow1 : drow0;
        *(GAS v4u*)(drow + lane * 16) = (v4u){w[0], w[1], w[2], w[3]};
        *(GAS v2u*)(drow + 1024 + lane * 8) = (v2u){w[4], w[5]};
    }
}

__global__ void __launch_bounds__(NTHREADS, 2) fwd_kernel(Args args) {
    extern __shared__ __attribute__((aligned(16))) unsigned char lds[];
    LAS unsigned char* ldsL = (LAS unsigned char*)lds;
    volatile LAS unsigned* MISC = (volatile LAS unsigned*)(ldsL + LDS_MISC);
    const int tid = threadIdx.x, lane = tid & 63, wave = __builtin_amdgcn_readfirstlane(tid >> 6);
    const int G = gridDim.x; const int bx = blockIdx.x; const int vcu = (G % 8 == 0) ? (bx % 8) * (G / 8) + bx / 8 : bx;
#define G_ws (args.ws)
#define G_ctl ((unsigned*)(args.ws + WS_CTL))
#define G_x (args.in[0])
#define G_mem (args.in[1])
#define G_mix_norm (args.in[2])
#define G_w_in (args.in[3])
#define G_b_forget (args.in[4])
#define G_pool_w (args.in[5])
#define G_pool_scale (args.in[6])
#define G_w_out (args.in[7])
#define G_xattn_norm (args.in[8])
#define G_mem_norm (args.in[9])
#define G_xwq (args.in[10])
#define G_xwk (args.in[11])
#define G_xwv (args.in[12])
#define G_xwo (args.in[13])
#define G_peer_norm (args.in[14])
#define G_peer_wq (args.in[15])
#define G_sub_keys (args.in[16])
#define G_peer_u (args.in[17])
#define G_peer_v (args.in[18])
#define G_final_norm (args.in[19])
#define G_W_IN ((bf16*)(args.ws + WS_WIN))
#define G_WO1 ((bf16*)(args.ws + WS_WO1))
#define G_WO2 ((bf16*)(args.ws + WS_WO2))
#define G_WQ ((bf16*)(args.ws + WS_WQ))
#define G_WK ((bf16*)(args.ws + WS_WK))
#define G_WV ((bf16*)(args.ws + WS_WV))
#define G_WO ((bf16*)(args.ws + WS_WO))
#define G_WPQ ((bf16*)(args.ws + WS_WPQ))
#define G_AEXP ((bf16*)(args.ws + WS_AEXP))
#define G_W1 ((bf16*)(args.ws + WS_AEXP))
#define G_W2 ((bf16*)(args.ws + WS_WPQ))
#define G_WSC ((bf16*)(args.ws + WS_WSC))
#define G_PB ((bf16*)(args.ws + WS_PB))
#define G_MN ((bf16*)(args.ws + WS_MN))
#define G_KX ((bf16*)(args.ws + WS_KX))
#define G_VXT ((bf16*)(args.ws + WS_VXT))
#define G_UB (args.ws + WS_UB)
#define G_VB (args.ws + WS_VB)
#define G_SU ((float*)(args.ws + WS_SU))
#define G_SV ((float*)(args.ws + WS_SV))
#define G_XN ((bf16*)(args.ws + WS_XN))
#define G_QX ((bf16*)(args.ws + WS_XN))
#define G_PROJ ((bf16*)(args.ws + WS_PROJ))
#define G_SCT ((float*)(args.ws + WS_PROJ))
#define G_AMIX ((bf16*)(args.ws + WS_AMIX))
#define G_OX ((bf16*)(args.ws + WS_AMIX))
#define G_H ((float*)(args.ws + WS_H))
#define G_HB ((bf16*)(args.ws + WS_HB))
#define G_PP ((bf16*)(args.ws + WS_P))
#define G_LF ((float*)(args.ws + WS_LF))
#define G_SS1 ((float*)(args.ws + CTL_SS1))
#define G_SS2 ((float*)(args.ws + CTL_SS2))

    for (int u = tid; u < (LDS_BYTES - LDS_MISC) / 4; u += NTHREADS) ((LAS unsigned*)(ldsL + LDS_MISC))[u] = 0u;
    __syncthreads();
    XcdBarrier bar; bar.bar = G_ctl + CW_BAR; bar.x = 0; bar.st = nullptr;
    if (args.one_launch) bar = xcd_barrier_post(G_ctl + CW_BAR, MISC + 8);
    const int lo = args.ph_lo, hi = args.ph_hi;
#ifndef PH_MASK
#define PH_MASK 0xff
#endif
#define IN(k) (((PH_MASK >> (k)) & 1) && lo <= (k) && (k) < hi)
#ifdef PROBE_SEL
#define STAMP(i) do { if (bx == 0 && tid == 0) { const unsigned long long t_ = __builtin_amdgcn_s_memrealtime(); MISC[32 + 2 * (i)] = (unsigned)t_; MISC[33 + 2 * (i)] = (unsigned)(t_ >> 32); } } while (0)
#else
#define STAMP(i) do { } while (0)
#endif
#define SEAM(k) do { if (IN(k) && IN((k) + 1)) xcd_barrier(bar); STAMP((k) + 1); } while (0)
#define TABLE_CHUNK(c_) do { _Pragma("unroll 1") for (int i_ = 0; i_ < 4; i_ += 2) { const int r_ = (c_) * 32 + wave * 4 + i_; const int tb_ = r_ >> 14, rr_ = r_ & (PEXP - 1); \
        const float* sp_ = (tb_ ? G_peer_v : G_peer_u) + (size_t)rr_ * DM; unsigned char* dp_ = (tb_ ? G_VB : G_UB) + (size_t)rr_ * 1536; float* scp_ = (tb_ ? G_SV : G_SU) + rr_; \
        conv_rows2_fp6(sp_, sp_ + DM, dp_, dp_ + 1536, scp_, scp_ + 1, lane); } } while (0)
    STAMP(0);
    const int gw = vcu * NWAVES + wave, NGW = G * NWAVES;
    const int gt = vcu * NTHREADS + tid, NGT = G * NTHREADS;

    if (IN(0)) for (int rep_ = 0; rep_ < (((DUP_MASK >> 0) & 1) ? args.pad + 1 : 1); ++rep_) {
        LAS float* wf = (LAS float*)ldsL;
        LAS float* scr = (LAS float*)(ldsL + 65536 + wave * 8704);
        for (int i = tid; i < 8 * DM; i += NTHREADS) { const int d = i >> 3, h = i & 7; wf[h * DM + d] = G_w_in[(size_t)d * INC + 4096 + h]; }
        __syncthreads();
        f32x4 vnx[8];
        if (gw < TOK) {
#pragma unroll
            for (int j = 0; j < 8; ++j) vnx[j] = ((const GAS f32x4*)(G_x + (size_t)gw * DM) + lane)[64 * j]; }
        for (int m = gw; m < TOK; m += NGW) {
            const GAS f32x4* gr = (const GAS f32x4*)G_mix_norm + lane;
            f32x4 v[8]; float s = 0.f;
#pragma unroll
            for (int j = 0; j < 8; ++j) v[j] = vnx[j];
            if (m + NGW < TOK) {
#pragma unroll
                for (int j = 0; j < 8; ++j) vnx[j] = ((const GAS f32x4*)(G_x + (size_t)(m + NGW) * DM) + lane)[64 * j]; }
#pragma unroll
            for (int j = 0; j < 8; ++j) s += (v[j][0] * v[j][0] + v[j][1] * v[j][1]) + (v[j][2] * v[j][2] + v[j][3] * v[j][3]);
            const float rstd = __builtin_amdgcn_rsqf(wave_sum(s) * (1.f / DM) + EPS);
            GAS v2u* o8 = (GAS v2u*)(G_XN + (size_t)m * DM) + lane;
#pragma unroll
            for (int j = 0; j < 8; ++j) { const f32x4 gg = gr[64 * j]; v[j] = v[j] * rstd * gg;
                v2u o; o.x = pk2(v[j][0], v[j][1]); o.y = pk2(v[j][2], v[j][3]); o8[64 * j] = o; }
            float fl[8];
#pragma unroll
            for (int h = 0; h < 8; ++h) { float a = 0.f;
#pragma unroll
                for (int j = 0; j < 8; ++j) { const f32x4 w = *(const LAS f32x4*)(wf + h * DM + j * 256 + lane * 4); a += (v[j][0] * w[0] + v[j][1] * w[1]) + (v[j][2] * w[2] + v[j][3] * w[3]); }
                fl[h] = wave_sum(a);
                asm volatile("" ::: "memory"); }
            if (lane < 8) { float f = fl[0];
#pragma unroll
                for (int h = 1; h < 8; ++h) f = (lane == h) ? fl[h] : f;
                f += G_b_forget[lane];
                const float ls = fminf(f, 0.f) - log1pf(expf(-fabsf(f)));
                const int b = m / SEQ, sq = m % SEQ; G_LF[(size_t)(b * FOXH + lane) * SEQ + sq] = ls; }
        }
        for (int m = gw; m < BATCH * NMEM; m += NGW) {
            const GAS f32x4* xr = (const GAS f32x4*)(G_mem + (size_t)m * DM) + lane; const GAS f32x4* gr = (const GAS f32x4*)G_mem_norm + lane;
            f32x4 v[8]; float s = 0.f;
#pragma unroll
            for (int j = 0; j < 8; ++j) { v[j] = xr[64 * j]; s += (v[j][0] * v[j][0] + v[j][1] * v[j][1]) + (v[j][2] * v[j][2] + v[j][3] * v[j][3]); }
            const float rstd = __builtin_amdgcn_rsqf(wave_sum(s) * (1.f / DM) + EPS);
            GAS v2u* o8 = (GAS v2u*)(G_MN + (size_t)m * DM) + lane;
#pragma unroll
            for (int j = 0; j < 8; ++j) { const f32x4 gg = gr[64 * j]; v[j] = v[j] * rstd * gg; v2u o; o.x = pk2(v[j][0], v[j][1]); o.y = pk2(v[j][2], v[j][3]); o8[64 * j] = o; }
        }
        {
            constexpr int I_IN = (DM / 64) * (4096 / 32), I_SQ = (DM / 64) * (DM / 32);
            constexpr int NITEMS = I_IN + 3 * I_SQ;
            for (int it = gw; it < NITEMS; it += NGW) {
                int r = it;
                if (r < I_IN) { p0_transpose_item(G_w_in, INC, 4096 / 32, nullptr, G_W_IN, nullptr, 0, DM, scr, r, lane); continue; } r -= I_IN;
                if (r < I_SQ) { p0_transpose_item(G_w_out, DM, DM / 32, nullptr, G_WO1, G_WO2, POOLW, DM, scr, r, lane); continue; } r -= I_SQ;
                if (r < I_SQ) { p0_transpose_item(G_xwk, DM, DM / 32, nullptr, G_WK, nullptr, 0, DM, scr, r, lane); continue; } r -= I_SQ;
                p0_transpose_item(G_xwv, DM, DM / 32, nullptr, G_WV, nullptr, 0, DM, scr, r, lane);
            }
        }
        for (int i = gt; i < DM * DM / 8; i += NGT) {
            const int d = i / (DM / 8); *(GAS v4u*)(G_WPQ + (size_t)i * 8) = cvt8(G_peer_wq + (size_t)i * 8, G_peer_norm[d]); }
        for (int i = gt; i < DM * DM / 8; i += NGT) {
            const int d = i / (DM / 8); *(GAS v4u*)(G_WQ + (size_t)i * 8) = cvt8(G_xwq + (size_t)i * 8, G_xattn_norm[d]); }
        for (int i = gt; i < DM * DM / 8; i += NGT) {
            const int r = i / (DM / 8), c0 = (i % (DM / 8)) * 8; const int hc = r >> 7;
            v4u o = {0u, 0u, 0u, 0u}; if ((c0 >> 7) == hc) o = cvt8(G_sub_keys + (size_t)r * 128 + (c0 & 127), 1.f);
            *(GAS v4u*)(G_AEXP + (size_t)i * 8) = o; }
        for (int i = gt; i < 4 * 256 * 256 / 8; i += NGT) {
            const int g = i / (256 * 256 / 8), d0 = (i % 32) * 8; const float* ps = G_pool_scale + g * 256 + d0; const float* p = G_pool_w + (size_t)i * 8;
            v4u o; o.x = pk2(p[0] * ps[0], p[1] * ps[1]); o.y = pk2(p[2] * ps[2], p[3] * ps[3]); o.z = pk2(p[4] * ps[4], p[5] * ps[5]); o.w = pk2(p[6] * ps[6], p[7] * ps[7]);
            *(GAS v4u*)(G_PB + (size_t)i * 8) = o; }
        __syncthreads();
    }
    SEAM(0);

    if (IN(1)) for (int rep_ = 0; rep_ < (((DUP_MASK >> 1) & 1) ? args.pad + 1 : 1); ++rep_) {
        pg8::Gemm g{G_XN, G_W_IN, DM, DM, DM}; pg8::GSched S; S.init(TOK / 256, 4096 / 256, G, bx, DM, DM);
        pg8::EpiStore E{G_PROJ, 4096, 0, 0, 1, nullptr, 1.f, 4, 8, 0.08838834764831845f * LOG2E};
        pg8::gemm_phase<pg8::EpiStore, pg8::GSched, true>(ldsL, g, S, E);
    }
    SEAM(1);

    if (IN(2)) for (int rep_ = 0; rep_ < (((DUP_MASK >> 2) & 1) ? args.pad + 1 : 1); ++rep_) {
        for (int it = vcu; it < TOK / 32; it += G) {
            const int ch = (tid & 127) * 8, rsub = tid >> 7, r0 = it * 32 + rsub * 8, w = 2 << (ch >> 8);
            const int s0 = r0 % SEQ;
            float acc[8];
#pragma unroll
            for (int e = 0; e < 8; ++e) acc[e] = 0.f;
            for (int k = 1; k < w; ++k) { if (s0 - k >= 0) { const v4u v = *(const GAS v4u*)(G_PROJ + (size_t)(r0 - k) * 4096 + ch);
#pragma unroll
                    for (int e = 0; e < 4; ++e) { acc[2 * e] += __uint_as_float(v[e] << 16); acc[2 * e + 1] += __uint_as_float(v[e] & 0xffff0000u); } } }
            for (int rr = 0; rr < 8; ++rr) {
                const v4u v = *(const GAS v4u*)(G_PROJ + (size_t)(r0 + rr) * 4096 + ch); float cur[8];
#pragma unroll
                for (int e = 0; e < 4; ++e) { cur[2 * e] = __uint_as_float(v[e] << 16); cur[2 * e + 1] = __uint_as_float(v[e] & 0xffff0000u); }
                const int sp = s0 + rr; const float inv = 1.f / (float)((sp + 1 < w) ? sp + 1 : w);
                v4u o;
#pragma unroll
                for (int e = 0; e < 8; ++e) acc[e] += cur[e];
                o.x = pk2(acc[0] * inv - cur[0], acc[1] * inv - cur[1]); o.y = pk2(acc[2] * inv - cur[2], acc[3] * inv - cur[3]);
                o.z = pk2(acc[4] * inv - cur[4], acc[5] * inv - cur[5]); o.w = pk2(acc[6] * inv - cur[6], acc[7] * inv - cur[7]);
                *(GAS v4u*)(G_AMIX + (size_t)(r0 + rr) * DM + ch) = o;
                if (sp - w + 1 >= 0) { const v4u vo = *(const GAS v4u*)(G_PROJ + (size_t)(r0 + rr - w + 1) * 4096 + ch);
#pragma unroll
                    for (int e = 0; e < 4; ++e) { acc[2 * e] -= __uint_as_float(vo[e] << 16); acc[2 * e + 1] -= __uint_as_float(vo[e] & 0xffff0000u); } }
            }
        }
        const int a_bh = vcu >> 4, a_qb = vcu & 15;
        if (a_qb < 8 && vcu < 256) {
            const int e = a_bh * 8 + a_qb;
            pg8::Gemm g; pg8::EpiStore E{nullptr, DM, 0, 0, 1, nullptr, 1.f, 0, 0, 1.f};
            int pm, pn;
            if (e < 16)      { pm = e >> 3; pn = e & 7; g = pg8::Gemm{G_MN, G_WK, DM, DM, DM}; E.O = G_KX; E.ldc = DM; }
            else if (e < 32) { const int q = e - 16; pm = q >> 3; pn = q & 7; g = pg8::Gemm{G_MN, G_WV, DM, DM, DM}; E.O = G_VXT; E.ldc = DM; }
            else if (e < 96) { const int q = e - 32; pm = q >> 3; pn = q & 7; g = pg8::Gemm{G_AEXP, G_WPQ, DM, DM, DM}; E.O = G_WSC; E.ldc = DM; }
            else             { const int q = e - 96; const int gg = q >> 3; pm = q & 7; pn = 0;
                               g = pg8::Gemm{G_WO1 + gg * 256, G_PB + (size_t)gg * 65536, 256, DM, 256}; E.O = G_WO2 + gg * 256; E.ldc = DM; }
            const pg8::OneSched S1{pm, pn, (long)pm * 256 * g.lda, (long)pn * 256 * g.ldb};
            pg8::gemm_phase<pg8::EpiStore, pg8::OneSched, false>(ldsL, g, S1, E);
        }
        if (vcu < 256) {
            const int b = a_bh >> 3, h = a_bh & 7;
            float* c_lds = (float*)(lds + fox::LDS_C);
            if (wave == 0) {
                const float* lf = G_LF + (size_t)a_bh * SEQ + lane * 64; float loc[64]; float run = 0.f;
#pragma unroll
                for (int i = 0; i < 16; ++i) { const f32x4 v = *(const f32x4*)(lf + 4 * i);
#pragma unroll
                    for (int e = 0; e < 4; ++e) { run += v[e]; loc[4 * i + e] = run; } }
                float incl = run;
#pragma unroll
                for (int o = 1; o < 64; o <<= 1) { const float t = __shfl_up(incl, o); if (lane >= o) incl += t; }
                const float excl = incl - run;
#pragma unroll
                for (int i = 0; i < 16; ++i) { f32x4 v;
#pragma unroll
                    for (int e = 0; e < 4; ++e) v[e] = (loc[4 * i + e] + excl) * LOG2E;
                    *(f32x4*)(c_lds + lane * 64 + 4 * i) = v; }
            }
            __syncthreads();
            const bf16* Qb = G_PROJ + (size_t)(b * SEQ) * 4096 + 1024 + h * 128;
            fox::BlockRef cur{Qb + (size_t)(a_qb * 256) * 4096, Qb + 1024, Qb + 2048, G_AMIX + (size_t)(b * SEQ + a_qb * 256) * DM + 1024 + h * 128, a_qb * 256};
            fox::Seam S;
            fox::prime(cur, (char*)lds, S);
            fox::block(cur, cur, (char*)lds, S);
            asm volatile("s_waitcnt vmcnt(0)" ::: "memory");
            __syncthreads();
        }
        {
            constexpr int C_T = (DM / 64) * (DM / 32) / 8, NCHUNK = C_T + QSPLIT;
            LAS float* scr = (LAS float*)(ldsL + wave * 8704);
            for (;;) {
                __syncthreads();
                if (tid == 0) MISC[16] = atomicAdd(G_ctl + CW_QUEUE, 1u);
                __syncthreads();
                const int c = (int)MISC[16];
                if (c >= NCHUNK) break;
                if (c < C_T) { p0_transpose_item(G_xwo, DM, DM / 32, nullptr, G_WO, nullptr, 0, DM, scr, c * 8 + wave, lane); }
                else { TABLE_CHUNK(c - C_T); }
            }
        }
    }
    SEAM(2);

    if (IN(3)) for (int rep_ = 0; rep_ < (((DUP_MASK >> 3) & 1) ? args.pad + 1 : 1); ++rep_) {
        { pg8::Gemm g{G_AMIX, G_WO2, DM, DM, DM}; pg8::GSched S; S.init(TOK / 256, DM / 256, G, bx, DM, DM);
          pg8::EpiResid<false> E{G_x, G_HB, rep_ ? nullptr : G_SS1, 0};
          pg8::gemm_phase<pg8::EpiResid<false>, pg8::GSched, true>(ldsL, g, S, E); }
        if (bx < 64) {
            const int f = bx & 63, b = f >> 5, h = (f >> 3) & 3, t = f & 7;
            pg8::Gemm g{G_KX + (size_t)(b * NMEM) * DM + h * XD, G_WQ + h * XD, XD, DM, DM};
            pg8::EpiStore E{G_W1 + (size_t)(b * 1024 + h * 256) * DM, DM, 0, 0, 1, nullptr, 1.f, 0, 0, 1.f};
            const pg8::OneSched S1{0, t, 0, (long)t * 256 * DM};
            pg8::gemm_phase<pg8::EpiStore, pg8::OneSched, false>(ldsL, g, S1, E);
        }
    }
    SEAM(3);

    if (IN(4)) for (int rep_ = 0; rep_ < (((DUP_MASK >> 4) & 1) ? args.pad + 1 : 1); ++rep_) {
        pg8::Gemm g{G_HB, G_W1, DM, DM, DM}; pg8::GSched S; S.init(SEQ / 256, XH, G, bx, DM, DM);
        S.nH = 1; S.nZ = BATCH; S.sAb = (long)SEQ * DM; S.sBb = (long)1024 * DM;
        pg8::EpiSoftmax E{G_PP, 1024, (long)SEQ * 1024, 0, 1, G_SS1, 0.044194173824159216f * LOG2E, SEQ};
        pg8::gemm_phase<pg8::EpiSoftmax, pg8::GSched, false>(ldsL, g, S, E);
        if (bx >= 128 && bx < 192) {
            const int f = bx & 63, b = f >> 5, h = (f >> 3) & 3, t = f & 7;
            pg8::Gemm g2{G_WO + h * XD, G_VXT + (size_t)(b * NMEM) * DM + h * XD, XD, DM, DM};
            pg8::EpiStore E2{G_W2 + (size_t)b * DM * 1024 + h * 256, 1024, 0, 0, 1, nullptr, 1.f, 0, 0, 1.f};
            const pg8::OneSched S2{t, 0, (long)t * 256 * DM, 0};
            pg8::gemm_phase<pg8::EpiStore, pg8::OneSched, false>(ldsL, g2, S2, E2);
        }
        for (;;) {
            __syncthreads();
            if (tid == 0) MISC[16] = atomicAdd(G_ctl + CW_QUEUE2, 1u);
            __syncthreads();
            const int c = (int)MISC[16] + QSPLIT;
            if (c >= 2 * PEXP / 32) break;
            TABLE_CHUNK(c);
        }
    }
    SEAM(4);

    if (IN(5)) for (int rep_ = 0; rep_ < (((DUP_MASK >> 5) & 1) ? args.pad + 1 : 1); ++rep_) {
        pg8::Gemm g{G_PP, G_W2, 1024, 1024, 1024}; pg8::GSched S; S.init(SEQ / 256, DM / 256, G, bx, 1024, 1024);
        S.nH = 1; S.nZ = BATCH; S.sAb = (long)SEQ * 1024; S.sBb = (long)DM * 1024;
        pg8::EpiResid<true> E{G_HB, G_HB, G_SS2, SEQ};
        pg8::gemm_phase<pg8::EpiResid<true>, pg8::GSched, true>(ldsL, g, S, E);
    }
    SEAM(5);

    if (IN(6)) for (int rep_ = 0; rep_ < (((DUP_MASK >> 6) & 1) ? args.pad + 1 : 1); ++rep_) {
        pg8::Gemm g{G_WSC, G_HB, DM, DM, DM}; pg8::GSched S; S.init(DM / 256, TOK / 256, G, bx, DM, DM);
        pg8::EpiF32Col E{G_SCT, TOK, G_SS2};
        pg8::gemm_phase<pg8::EpiF32Col, pg8::GSched, true>(ldsL, g, S, E);
    }
    SEAM(6);

    if (IN(7)) for (int rep_ = 0; rep_ < (((DUP_MASK >> 7) & 1) ? args.pad + 1 : 1); ++rep_) {
        LAS unsigned* TOP1 = (LAS unsigned*)ldsL;
        LAS unsigned* RIDX = (LAS unsigned*)(ldsL + 32768);
        LAS float* RGATE = (LAS float*)(ldsL + 49152);
        for (int blk = vcu; blk < TOK / 32; blk += G) {
            const int t0 = blk * 32;
            {
                const int tok = tid & 31, grp = tid >> 5;
                const float* sp = G_SCT + (size_t)(grp * 128) * TOK + t0 + tok;
                unsigned lst[16];
#pragma unroll
                for (int j = 0; j < 16; ++j) lst[j] = 0u;
                for (int i0 = 0; i0 < 128; i0 += 32) {
                    float v[32];
#pragma unroll
                    for (int e = 0; e < 32; ++e) v[e] = sp[(size_t)(i0 + e) * TOK];
#pragma unroll
                    for (int e = 0; e < 32; ++e) { unsigned xk = (fkey(v[e]) & ~127u) | (unsigned)(127 - (i0 + e));
#pragma unroll
                        for (int j = 0; j < 16; ++j) { const unsigned hi_ = max(lst[j], xk); xk = min(lst[j], xk); lst[j] = hi_; } }
                }
                LAS unsigned* dst = TOP1 + (tok * 16 + grp) * 16;
#pragma unroll
                for (int j = 0; j < 16; j += 4) *(LAS v4u*)(dst + j) = (v4u){lst[j], lst[j + 1], lst[j + 2], lst[j + 3]};
            }
            __syncthreads();
            if (tid < 256) {
                const int tok = tid & 31, head = tid >> 5;
                const LAS unsigned* ka = TOP1 + (tok * 16 + head * 2) * 16; const LAS unsigned* kb = ka + 16;
                float af[16], bfv[16];
#pragma unroll
                for (int j = 0; j < 16; ++j) { af[j] = fdec(ka[j] & ~127u); bfv[j] = fdec(kb[j] & ~127u); }
                unsigned best[16];
#pragma unroll
                for (int j = 0; j < 16; ++j) best[j] = 0u;
#pragma unroll
                for (int i = 0; i < 16; ++i)
#pragma unroll
                    for (int j = 0; j < 16; ++j) if ((i + 1) * (j + 1) <= 16) {
                        unsigned xk = (fkey(af[i] + bfv[j]) & ~255u) | (unsigned)(255 - (i * 16 + j));
#pragma unroll
                        for (int q = 0; q < 16; ++q) { const unsigned hi_ = max(best[q], xk); xk = min(best[q], xk); best[q] = hi_; } }
                float ev[16]; const float m0 = fdec(best[0] & ~255u); float sum = 0.f;
#pragma unroll
                for (int q = 0; q < 16; ++q) { ev[q] = __expf(fdec(best[q] & ~255u) - m0); sum += ev[q]; }
                const float inv = 1.f / sum;
#pragma unroll
                for (int q = 0; q < 16; ++q) { const unsigned code = 255u - (best[q] & 255u); const unsigned i = code >> 4, j = code & 15u;
                    const unsigned ia = 127u - (ka[i] & 127u), ib = 127u - (kb[j] & 127u);
                    RIDX[tok * 128 + head * 16 + q] = ia * 128u + ib; RGATE[tok * 128 + head * 16 + q] = ev[q] * inv; }
            }
            __syncthreads();
            {
                LAS unsigned* SIDX = (LAS unsigned*)ldsL; LAS unsigned* SGATE = (LAS unsigned*)(ldsL + 16384);
                const int tok = tid >> 4; const LAS unsigned* src = RIDX + tok * 128;
                unsigned mine[8]; unsigned rank[8];
#pragma unroll
                for (int i = 0; i < 8; ++i) { mine[i] = (src[(tid & 15) + 16 * i] << 7) | (unsigned)((tid & 15) + 16 * i); rank[i] = 0u; }
                for (int j0 = 0; j0 < 128; j0 += 4) { const v4u o4 = *(const LAS v4u*)(src + j0);
#pragma unroll
                    for (int jj = 0; jj < 4; ++jj) { const unsigned oj = ((jj == 0 ? o4.x : jj == 1 ? o4.y : jj == 2 ? o4.z : o4.w) << 7) | (unsigned)(j0 + jj);
#pragma unroll
                        for (int i = 0; i < 8; ++i) rank[i] += (oj < mine[i]) ? 1u : 0u; } }
#pragma unroll
                for (int i = 0; i < 8; ++i) mine[i] >>= 7;
#pragma unroll
                for (int i = 0; i < 8; ++i) { const unsigned pos = rank[i];
                    SIDX[tok * 128 + pos] = mine[i];
                    const float su_ = G_SU[mine[i]], gs_ = RGATE[tok * 128 + (tid & 15) + 16 * i] * G_SV[mine[i]];
                    SGATE[tok * 128 + pos] = (__float_as_uint(su_) & 0xffff0000u) | f2bf(gs_); }
            }
            __syncthreads();
            {
                const int tok0 = wave * 4; const size_t tg0 = (size_t)(t0 + tok0);
                LAS float* Wl = (LAS float*)(ldsL + 32768) + tok0 * 128;
                unsigned xn0[16], xn1[16], xn2[16], xn3[16];
#define XNLOAD(T_, XN) do { const float rs = __builtin_amdgcn_rsqf(G_SS2[tg0 + (T_)] * (1.f / DM) + EPS); \
        _Pragma("unroll") for (int q = 0; q < 8; ++q) { const size_t d0 = (size_t)q * 256 + lane * 4; \
            const v2u ha = *(const GAS v2u*)(G_HB + (tg0 + (T_)) * DM + d0); const f32x4 ga = *(const f32x4*)(G_peer_norm + d0); \
            XN[q * 2] = pk2(__uint_as_float(ha.x << 16) * rs * ga[0], __uint_as_float(ha.x & 0xffff0000u) * rs * ga[1]); XN[q * 2 + 1] = pk2(__uint_as_float(ha.y << 16) * rs * ga[2], __uint_as_float(ha.y & 0xffff0000u) * rs * ga[3]); } } while (0)
                XNLOAD(0, xn0); XNLOAD(1, xn1); XNLOAD(2, xn2); XNLOAD(3, xn3);
#undef XNLOAD
                const LAS unsigned* ridx0 = (const LAS unsigned*)ldsL + tok0 * 128; const LAS unsigned* rgs0 = (const LAS unsigned*)(ldsL + 16384) + tok0 * 128;
                const __amdgpu_buffer_rsrc_t rsT = __builtin_amdgcn_make_buffer_rsrc((void*)G_UB, 0, 64 << 20, 0x00020000);
                v4u raX0, raX1, raX2, raX3, raY0, raY1, raY2, raY3; v2u rbX0, rbX1, rbX2, rbX3, rbY0, rbY1, rbY2, rbY3;
                unsigned sgX0, sgX1, sgX2, sgX3, sgY0, sgY1, sgY2, sgY3;
#define PLDU(S, T, k) do { const unsigned ex_ = (unsigned)__builtin_amdgcn_readfirstlane((int)ridx0[(T) * 128 + (k)]); sg##S = rgs0[(T) * 128 + (k)]; \
        ra##S = __builtin_bit_cast(v4u, __builtin_amdgcn_raw_buffer_load_b128(rsT, lane * 16, ex_ * 1536u, 0)); rb##S = __builtin_bit_cast(v2u, __builtin_amdgcn_raw_buffer_load_b64(rsT, lane * 8 + 1024, ex_ * 1536u, 0)); } while (0)
#define STEP1(C, P, k, HASNEXT) do { \
        float d0_ = peer_dot(ra##C##0, rb##C##0, xn0), d1_ = peer_dot(ra##C##1, rb##C##1, xn1), d2_ = peer_dot(ra##C##2, rb##C##2, xn2), d3_ = peer_dot(ra##C##3, rb##C##3, xn3); \
        const unsigned s0_ = sg##C##0, s1_ = sg##C##1, s2_ = sg##C##2, s3_ = sg##C##3; \
        if (HASNEXT) { PLDU(P##0, 0, (k) + 1); PLDU(P##1, 1, (k) + 1); PLDU(P##2, 2, (k) + 1); PLDU(P##3, 3, (k) + 1); } \
        d0_ = wave_sum_dpp(d0_) * __uint_as_float(s0_ & 0xffff0000u); d1_ = wave_sum_dpp(d1_) * __uint_as_float(s1_ & 0xffff0000u); \
        d2_ = wave_sum_dpp(d2_) * __uint_as_float(s2_ & 0xffff0000u); d3_ = wave_sum_dpp(d3_) * __uint_as_float(s3_ & 0xffff0000u); \
        const float w0_ = gelu_f(d0_) * __uint_as_float(s0_ << 16), w1_ = gelu_f(d1_) * __uint_as_float(s1_ << 16), w2_ = gelu_f(d2_) * __uint_as_float(s2_ << 16), w3_ = gelu_f(d3_) * __uint_as_float(s3_ << 16); \
        if (lane == 0) { Wl[(k)] = w0_; Wl[128 + (k)] = w1_; Wl[256 + (k)] = w2_; Wl[384 + (k)] = w3_; } } while (0)
                PLDU(X0, 0, 0); PLDU(X1, 1, 0); PLDU(X2, 2, 0); PLDU(X3, 3, 0);
                for (int k = 0; k < 126; k += 2) { STEP1(X, Y, k, true); STEP1(Y, X, k + 1, true); }
                STEP1(X, Y, 126, true); STEP1(Y, X, 127, false);
#undef PLDU
#undef STEP1
#define PLDV(S, T, k) do { const unsigned ex_ = (unsigned)__builtin_amdgcn_readfirstlane((int)ridx0[(T) * 128 + (k)]); \
        ra##S = __builtin_bit_cast(v4u, __builtin_amdgcn_raw_buffer_load_b128(rsT, lane * 16, ex_ * 1536u + (32u << 20), 0)); rb##S = __builtin_bit_cast(v2u, __builtin_amdgcn_raw_buffer_load_b64(rsT, lane * 8 + 1024, ex_ * 1536u + (32u << 20), 0)); } while (0)
#define STEP2(C, P, TA, k, HASNEXT) do { asm volatile("" ::: "memory"); \
        if (HASNEXT) { PLDV(P##0, TA, (k) + 1); PLDV(P##1, (TA) + 1, (k) + 1); } \
        const float w0_ = Wl[(TA) * 128 + (k)], w1_ = Wl[((TA) + 1) * 128 + (k)]; \
        peer_axpy(ra##C##0, rb##C##0, w0_, oaccA); __builtin_amdgcn_sched_barrier(0); peer_axpy(ra##C##1, rb##C##1, w1_, oaccB); } while (0)
                for (int tt = 0; tt < 4; tt += 2) {
                    float oaccA[32], oaccB[32];
#pragma unroll
                    for (int e = 0; e < 32; ++e) { oaccA[e] = 0.f; oaccB[e] = 0.f; }
                    PLDV(X0, tt, 0); PLDV(X1, tt + 1, 0);
                    for (int k = 0; k < 126; k += 2) { STEP2(X, Y, tt, k, true); STEP2(Y, X, tt, k + 1, true); }
                    STEP2(X, Y, tt, 126, true); STEP2(Y, X, tt, 127, false);
#define FINISH(T_, OACC) do { float s_ = 0.f; \
        _Pragma("unroll") for (int q = 0; q < 8; ++q) { const size_t d0 = (size_t)q * 256 + lane * 4; const v2u hb = *(const GAS v2u*)(G_HB + (T_) * DM + d0); \
            const f32x4 a = {__uint_as_float(hb.x << 16), __uint_as_float(hb.x & 0xffff0000u), __uint_as_float(hb.y << 16), __uint_as_float(hb.y & 0xffff0000u)}; \
            _Pragma("unroll") for (int e = 0; e < 4; ++e) { const float y = a[e] + OACC[q * 4 + e]; OACC[q * 4 + e] = y; s_ += y * y; } } \
        const float rstd_ = __builtin_amdgcn_rsqf(wave_sum(s_) * (1.f / DM) + EPS); \
        _Pragma("unroll") for (int q = 0; q < 8; ++q) { const size_t d0 = (size_t)q * 256 + lane * 4; const f32x4 ga = *(const f32x4*)(G_final_norm + d0); f32x4 o; \
            _Pragma("unroll") for (int e = 0; e < 4; ++e) o[e] = OACC[q * 4 + e] * rstd_ * ga[e]; \
            *(f32x4*)(args.out + (T_) * DM + d0) = o; } } while (0)
                    FINISH(tg0 + tt, oaccA); FINISH(tg0 + tt + 1, oaccB);
                }
#undef FINISH
#undef PLDV
#undef STEP2
            }
            __syncthreads();
        }
    }
#undef IN
#undef SEAM
#undef G_ws
#undef G_ctl
#undef G_x
#undef G_mem
#undef G_mix_norm
#undef G_w_in
#undef G_b_forget
#undef G_pool_w
#undef G_pool_scale
#undef G_w_out
#undef G_xattn_norm
#undef G_mem_norm
#undef G_xwq
#undef G_xwk
#undef G_xwv
#undef G_xwo
#undef G_peer_norm
#undef G_peer_wq
#undef G_sub_keys
#undef G_peer_u
#undef G_peer_v
#undef G_final_norm
#undef G_W_IN
#undef G_WO1
#undef G_WO2
#undef G_WQ
#undef G_WK
#undef G_WV
#undef G_WO
#undef G_WPQ
#undef G_AEXP
#undef G_W1
#undef G_W2
#undef G_WSC
#undef G_PB
#undef G_MN
#undef G_KX
#undef G_VXT
#undef G_UB
#undef G_VB
#undef G_SU
#undef G_SV
#undef G_XN
#undef G_QX
#undef G_PROJ
#undef G_SCT
#undef G_AMIX
#undef G_OX
#undef G_H
#undef G_HB
#undef G_PP
#undef G_LF
#undef G_SS1
#undef G_SS2

}

constexpr int N_PHASES = 8;
extern "C" void kernel_launch(void* const* d_in, const int* in_sizes, int n_in, void* d_out, int out_size, void* d_ws, size_t ws_size, hipStream_t stream) {
    static int grid = 0;
    if (grid == 0) {
        if (n_in != 20 || in_sizes[0] != TOK * DM || out_size != TOK * DM || ws_size < WS_END) {
            fprintf(stderr, "kernel_launch: unexpected shapes (n_in %d, in0 %d, out %d, ws %zu < %zu)\n", n_in, n_in > 0 ? in_sizes[0] : -1, out_size, ws_size, (size_t)WS_END); grid = -1; return; }
        int dev = 0, cus = 0, per_cu = 0;
        if (hipGetDevice(&dev) != hipSuccess || hipDeviceGetAttribute(&cus, hipDeviceAttributeMultiprocessorCount, dev) != hipSuccess) { grid = -1; return; }
        if (hipFuncSetAttribute((const void*)fwd_kernel, hipFuncAttributeMaxDynamicSharedMemorySize, LDS_BYTES) != hipSuccess) { fprintf(stderr, "kernel_launch: hipFuncSetAttribute failed\n"); grid = -1; return; }
        if (hipOccupancyMaxActiveBlocksPerMultiprocessor(&per_cu, (const void*)fwd_kernel, NTHREADS, LDS_BYTES) != hipSuccess || per_cu < 1) { fprintf(stderr, "kernel_launch: occupancy query says %d\n", per_cu); per_cu = 1; }
        (void)hipGetLastError();
        grid = cus;
        if (grid != 256) fprintf(stderr, "kernel_launch: %d CUs (built for 256)\n", grid);
    }
    if (grid < 0) return;
    (void)hipMemsetAsync((char*)d_ws + WS_CTL, 0, CTL_ZERO_BYTES, stream);
    Args a{};
    for (int i = 0; i < 20; ++i) a.in[i] = (const float*)d_in[i];
    a.out = (float*)d_out; a.ws = (unsigned char*)d_ws; a.pad = DUP_MASK ? 1 : 0;
#if MK_ONE_LAUNCH
    a.ph_lo = 0; a.ph_hi = N_PHASES; a.one_launch = 1;
    void* kargs[] = {&a};
    hipError_t e = hipLaunchCooperativeKernel((const void*)fwd_kernel, dim3(grid), dim3(NTHREADS), kargs, LDS_BYTES, stream);
    if (e != hipSuccess) fprintf(stderr, "kernel_launch: cooperative launch failed: %s\n", hipGetErrorString(e));
#else
    for (int p = 0; p < N_PHASES; ++p) {
        a.ph_lo = p; a.ph_hi = p + 1; a.one_launch = 0;
        hipLaunchKernelGGL(fwd_kernel, dim3(grid), dim3(NTHREADS), LDS_BYTES, stream, a);
    }
#endif
}
```

```cpp
#include <hip/hip_runtime.h>
#include <hip/hip_bf16.h>
#include <cstdio>
#include <cstdint>

#ifndef DUP_MASK
#define DUP_MASK 0
#endif
#ifndef MK_ONE_LAUNCH
#define MK_ONE_LAUNCH 1
#endif

constexpr int BATCH = 2, SEQ = 4096, DM = 2048, TOK = BATCH * SEQ;
constexpr int INC = 4104, POOLW = 1024, FOXH = 8, FOXD = 128;
constexpr int NMEM = 256, XH = 4, XD = 512;
constexpr int PH = 8, PKEYS = 128, PEXP = 16384, TOPK = 16;
constexpr float EPS = 1e-6f;
constexpr float LOG2E = 1.4426950408889634f;

namespace pg8 {
#define PG8_LAS __attribute__((address_space(3)))
typedef unsigned short bf16_t;
typedef short bf16x8 __attribute__((ext_vector_type(8)));
typedef float f32x4 __attribute__((ext_vector_type(4)));
typedef float f32x2 __attribute__((ext_vector_type(2)));
typedef unsigned u32x4 __attribute__((ext_vector_type(4)));
typedef unsigned u32x2 __attribute__((ext_vector_type(2)));
constexpr int BM = 256, BK = 64, HALF = 128, HTB = HALF * BK * 2, STAGE_BYTES = 8 * HTB, NXCD = 8, WGM = 8;

__host__ __device__ __forceinline__ int lds_byte(int r, int c) { const int st = (r >> 4) * 2 + (c >> 5), rr = r & 15, cc = c & 31, ob = rr * 64 + cc * 2; return st * 1024 + (ob ^ (((ob >> 9) & 1) << 5)); }
__host__ __device__ __forceinline__ void stage_rc(int b, int& R, int& C) { const int st = b / 1024, sb = b % 1024, swz = sb ^ (((sb >> 9) & 1) << 5); R = (st >> 1) * 16 + swz / 64; C = (st & 1) * 32 + (swz % 64) / 2; }
__host__ __device__ __forceinline__ int perm32(int rho) { const int n = rho >> 4, i = rho & 15; return 8 * (i >> 2) + 4 * n + (i & 3); }

struct Unit { int pm, pn, z; long aoff, boff; };
struct Gemm { const bf16_t* A; const bf16_t* Bt; int K, lda, ldb; };

struct GSched {
    int nM, nN, nH, nZ, G, c; long sAb, sAh, sBb, sBh; int lda, ldb;
    __device__ __forceinline__ void init(int nM_, int nN_, int G_, int c_, int lda_, int ldb_) { nM = nM_; nN = nN_; nH = 1; nZ = 1; G = G_; c = c_; sAb = sAh = sBb = sBh = 0; lda = lda_; ldb = ldb_; }
    __device__ __forceinline__ bool next(int i, Unit& u) const {
        const long L = (long)i * G + c; const int nwg = nM * nN; if (L >= (long)nwg * nZ) return false;
        const int z = (int)(L / nwg); int wgid = (int)(L % nwg);
        { const int q = nwg / NXCD, r = nwg % NXCD, xcd = wgid % NXCD, off = wgid / NXCD; wgid = (xcd < r ? xcd * (q + 1) : r * (q + 1) + (xcd - r) * q) + off; }
        const int nig = WGM * nN, gid = wgid / nig, fm = gid * WGM, gsz = (nM - fm) < WGM ? (nM - fm) : WGM;
        u.pm = fm + ((wgid % nig) % gsz); u.pn = (wgid % nig) / gsz; u.z = z;
        const int zb = z / nH, zh = z % nH;
        u.aoff = zb * sAb + zh * sAh + (long)u.pm * BM * lda; u.boff = zb * sBb + zh * sBh + (long)u.pn * BM * ldb;
        return true;
    }
    __device__ __forceinline__ void a_ready(const Unit&) const {}
    __device__ __forceinline__ void done(const Unit&) const {}
};

struct OneSched { int pm, pn; long ao, bo;
    __device__ __forceinline__ bool next(int i, Unit& u) const { if (i) return false; u.pm = pm; u.pn = pn; u.z = 0; u.aoff = ao; u.boff = bo; return true; }
    __device__ __forceinline__ void a_ready(const Unit&) const {}
    __device__ __forceinline__ void done(const Unit&) const {} };
__device__ __forceinline__ unsigned cvt_pk_bf16(float lo, float hi) { unsigned r; asm volatile("v_cvt_pk_bf16_f32 %0, %1, %2" : "=v"(r) : "v"(lo), "v"(hi)); return r; }


template <bool NRM> struct EpiStoreT {
    static constexpr bool PERM = true, AFTER_DRAIN = false;
    bf16_t* O; int ldc; long sCb, sCh; int nH;
    const float* ss; float rs_mul;
    int t0, t1; float tscale;
    unsigned* nrm;
    __device__ __forceinline__ void operator()(const f32x4 (&acc)[2][2][4][2], const Unit& u, int wr, int wc, int fr, int fq) const {
        const int row0 = u.pm * BM + wr * 64 + fr, col0 = u.pn * BM + wc * 32 + 8 * fq;
        bf16_t* base = O + (u.z / nH) * sCb + (u.z % nH) * sCh;
        const float ts = (u.pn >= t0 && u.pn < t1) ? tscale : 1.f;
        float mx0 = 0.f, mx1 = 0.f;
#pragma unroll
        for (int ai = 0; ai < 2; ++ai)
#pragma unroll
            for (int m = 0; m < 4; ++m) { const int row = row0 + ai * HALF + m * 16;
                float sc = ts; if (ss) sc *= __builtin_amdgcn_rsqf(ss[row] * (1.f / DM) + EPS) * rs_mul;
                bf16_t* rowp = base + (size_t)row * ldc + col0;
#pragma unroll
                for (int bj = 0; bj < 2; ++bj) { const f32x4 v0 = acc[ai][bj][m][0] * sc, v1 = acc[ai][bj][m][1] * sc;
                    u32x4 w; w.x = cvt_pk_bf16(v0[0], v0[1]); w.y = cvt_pk_bf16(v0[2], v0[3]); w.z = cvt_pk_bf16(v1[0], v1[1]); w.w = cvt_pk_bf16(v1[2], v1[3]);
                    *(u32x4*)(rowp + bj * HALF) = w;
                    if constexpr (NRM) { float q = (v0[0] * v0[0] + v0[1] * v0[1]) + (v0[2] * v0[2] + v0[3] * v0[3]) + (v1[0] * v1[0] + v1[1] * v1[1]) + (v1[2] * v1[2] + v1[3] * v1[3]);
                        q += __shfl_xor(q, 16); q += __shfl_xor(q, 32); if (bj == 0) mx0 = fmaxf(mx0, q); else mx1 = fmaxf(mx1, q); } } }
        if constexpr (NRM) { if (u.pn >= 4 && u.pn < 12) {
#pragma unroll
            for (int o = 1; o < 16; o <<= 1) { mx0 = fmaxf(mx0, __shfl_xor(mx0, o)); mx1 = fmaxf(mx1, __shfl_xor(mx1, o)); }
            if ((threadIdx.x & 63) == 0) { const int kind = u.pn >= 8, b = u.pm >> 4, h2 = ((u.pn - 4) & 3) * 2; unsigned* p = nrm + ((kind * 2 + b) * 8 + h2) * 4 + wc;
                atomicMax(p, __float_as_uint(mx0)); atomicMax(p + 4, __float_as_uint(mx1)); } } }
    }
};
typedef EpiStoreT<false> EpiStore;
template <bool BASE_BF16> struct EpiResid {
    static constexpr bool PERM = true, AFTER_DRAIN = false;
    const void* base; bf16_t* HB; float* ss; int zrows;
    __device__ __forceinline__ void operator()(const f32x4 (&acc)[2][2][4][2], const Unit& u, int wr, int wc, int fr, int fq) const {
        const int row0 = u.z * zrows + u.pm * BM + wr * 64 + fr, col0 = u.pn * BM + wc * 32 + 8 * fq;
#pragma unroll
        for (int ai = 0; ai < 2; ++ai)
#pragma unroll
            for (int m = 0; m < 4; ++m) { const int row = row0 + ai * HALF + m * 16; const size_t off = (size_t)row * DM + col0; float sq = 0.f;
#pragma unroll
                for (int bj = 0; bj < 2; ++bj) {
                    f32x4 b0, b1;
                    if constexpr (BASE_BF16) { const u32x4 r = *(const u32x4*)((const bf16_t*)base + off + bj * HALF);
                        b0 = (f32x4){__uint_as_float(r.x << 16), __uint_as_float(r.x & 0xffff0000u), __uint_as_float(r.y << 16), __uint_as_float(r.y & 0xffff0000u)};
                        b1 = (f32x4){__uint_as_float(r.z << 16), __uint_as_float(r.z & 0xffff0000u), __uint_as_float(r.w << 16), __uint_as_float(r.w & 0xffff0000u)}; }
                    else { b0 = *(const f32x4*)((const float*)base + off + bj * HALF); b1 = *(const f32x4*)((const float*)base + off + bj * HALF + 4); }
                    const f32x4 h0 = b0 + acc[ai][bj][m][0], h1 = b1 + acc[ai][bj][m][1];
                    u32x4 w; w.x = cvt_pk_bf16(h0[0], h0[1]); w.y = cvt_pk_bf16(h0[2], h0[3]); w.z = cvt_pk_bf16(h1[0], h1[1]); w.w = cvt_pk_bf16(h1[2], h1[3]);
                    *(u32x4*)(HB + off + bj * HALF) = w;
                    sq += (h0[0] * h0[0] + h0[1] * h0[1]) + (h0[2] * h0[2] + h0[3] * h0[3]) + (h1[0] * h1[0] + h1[1] * h1[1]) + (h1[2] * h1[2] + h1[3] * h1[3]); }
                sq += __shfl_xor(sq, 16); sq += __shfl_xor(sq, 32);
                if (fq == 0 && ss) atomicAdd(ss + row, sq); }
    }
};
struct EpiF32Col {
    static constexpr bool PERM = true, AFTER_DRAIN = false;
    float* O; int ldc; const float* ss;
    __device__ __forceinline__ void operator()(const f32x4 (&acc)[2][2][4][2], const Unit& u, int wr, int wc, int fr, int fq) const {
        const int row0 = u.pm * BM + wr * 64 + fr, col0 = u.pn * BM + wc * 32 + 8 * fq;
        f32x4 rs[2][2];
#pragma unroll
        for (int bj = 0; bj < 2; ++bj)
#pragma unroll
            for (int n = 0; n < 2; ++n) { const f32x4 s = *(const f32x4*)(ss + col0 + bj * HALF + 4 * n);
#pragma unroll
                for (int e = 0; e < 4; ++e) rs[bj][n][e] = __builtin_amdgcn_rsqf(s[e] * (1.f / DM) + EPS); }
#pragma unroll
        for (int ai = 0; ai < 2; ++ai)
#pragma unroll
            for (int m = 0; m < 4; ++m) { float* rowp = O + (size_t)(row0 + ai * HALF + m * 16) * ldc + col0;
#pragma unroll
                for (int bj = 0; bj < 2; ++bj) { *(f32x4*)(rowp + bj * HALF) = acc[ai][bj][m][0] * rs[bj][0]; *(f32x4*)(rowp + bj * HALF + 4) = acc[ai][bj][m][1] * rs[bj][1]; } }
    }
};
struct EpiSoftmax {
    static constexpr bool PERM = true, AFTER_DRAIN = true;
    bf16_t* P; int ldc; long sCb, sCh; int nH; const float* ss; float mul; int zrows;
    __device__ __forceinline__ void fused(f32x4 (&acc)[2][2][4][2], const Unit& u, int wr, int wc, int fr, int fq, PG8_LAS unsigned char* lds, int wid, int lane) const {
        PG8_LAS float* Pm = (PG8_LAS float*)lds;
        PG8_LAS float* Ps = (PG8_LAS float*)(lds + 4096);
#pragma unroll
        for (int ai = 0; ai < 2; ++ai)
#pragma unroll
            for (int m = 0; m < 4; ++m) { float mx = -3.0e38f;
                const float rs = __builtin_amdgcn_rsqf(ss[u.z * zrows + u.pm * BM + ai * HALF + wr * 64 + m * 16 + fr] * (1.f / DM) + EPS) * mul;
#pragma unroll
                for (int bj = 0; bj < 2; ++bj)
#pragma unroll
                    for (int n = 0; n < 2; ++n) { const f32x4 x = acc[ai][bj][m][n] * rs; acc[ai][bj][m][n] = x; mx = fmaxf(mx, fmaxf(fmaxf(x[0], x[1]), fmaxf(x[2], x[3]))); }
                mx = fmaxf(mx, __shfl_xor(mx, 16)); mx = fmaxf(mx, __shfl_xor(mx, 32));
                if (fq == 0) Pm[(ai * HALF + wr * 64 + m * 16 + fr) * 4 + wc] = mx; }
        asm volatile("s_waitcnt lgkmcnt(0)" ::: "memory"); __builtin_amdgcn_s_barrier(); asm volatile("" ::: "memory");
#pragma unroll
        for (int ai = 0; ai < 2; ++ai)
#pragma unroll
            for (int m = 0; m < 4; ++m) { const int r = ai * HALF + wr * 64 + m * 16 + fr;
                const f32x4 pm4 = *(const PG8_LAS f32x4*)(Pm + r * 4); const float M = fmaxf(fmaxf(pm4[0], pm4[1]), fmaxf(pm4[2], pm4[3])); float s = 0.f;
#pragma unroll
                for (int bj = 0; bj < 2; ++bj)
#pragma unroll
                    for (int n = 0; n < 2; ++n) { f32x4 x = acc[ai][bj][m][n];
#pragma unroll
                        for (int e = 0; e < 4; ++e) { x[e] = __builtin_amdgcn_exp2f(x[e] - M); s += x[e]; }
                        acc[ai][bj][m][n] = x; }
                s += __shfl_xor(s, 16); s += __shfl_xor(s, 32);
                if (fq == 0) Ps[r * 4 + wc] = s; }
        asm volatile("s_waitcnt lgkmcnt(0)" ::: "memory"); __builtin_amdgcn_s_barrier(); asm volatile("" ::: "memory");
        bf16_t* base = P + (u.z / nH) * sCb + (u.z % nH) * sCh;
        const int row0 = u.pm * BM, col0 = u.pn * BM + wc * 32 + 8 * fq;
#pragma unroll
        for (int ai = 0; ai < 2; ++ai)
#pragma unroll
            for (int m = 0; m < 4; ++m) { const int r = ai * HALF + wr * 64 + m * 16 + fr;
                const f32x4 ps4 = *(const PG8_LAS f32x4*)(Ps + r * 4); const float inv = 1.f / ((ps4[0] + ps4[1]) + (ps4[2] + ps4[3]));
                bf16_t* rowp = base + (size_t)(row0 + r) * ldc + col0;
#pragma unroll
                for (int bj = 0; bj < 2; ++bj) { const f32x4 v0 = acc[ai][bj][m][0] * inv, v1 = acc[ai][bj][m][1] * inv;
                    u32x4 w; w.x = cvt_pk_bf16(v0[0], v0[1]); w.y = cvt_pk_bf16(v0[2], v0[3]); w.z = cvt_pk_bf16(v1[0], v1[1]); w.w = cvt_pk_bf16(v1[2], v1[3]);
                    *(u32x4*)(rowp + bj * HALF) = w; } }
    }
};

template <class Epi, class Sched, bool ALIGN_EPI>
__device__ __forceinline__ void gemm_phase(PG8_LAS unsigned char* lds, const Gemm g, const Sched& S, const Epi& E) {
    const int tid = threadIdx.x, wid = __builtin_amdgcn_readfirstlane(tid >> 6), lane = tid & 63, wr = wid >> 2, wc = wid & 3, fr = lane & 15, fq = lane >> 4;
    const int K = g.K, nt = K / BK;
    unsigned voffA[2], voffB[2];
#pragma unroll
    for (int i = 0; i < 2; ++i) { int R, C; stage_rc(tid * 16 + i * 8192, R, C); const int Rb = Epi::PERM ? ((R & ~31) + perm32(R & 31)) : R;
        voffA[i] = (unsigned)(R * g.lda + C) * 2u; voffB[i] = (unsigned)(Rb * g.ldb + C) * 2u; }
    const size_t kstep = (size_t)(BK * 2);
    const size_t hsA = (size_t)HALF * g.lda * 2, hsB = (size_t)HALF * g.ldb * 2;
    const unsigned ldsw = (unsigned)wid * 1024u;
    const int aoff = lds_byte(wr * 64 + fr, fq * 8), boff = lds_byte(wc * 32 + fr, fq * 8);
#define PG8_SA(b, h) (((b) * 2 + (h)) * HTB)
#define PG8_SB(b, h) ((4 + (b) * 2 + (h)) * HTB)
#define PG8_STAGE(bufoff, gbase, voff) do { _Pragma("unroll") for (int _i = 0; _i < 2; ++_i) \
        __builtin_amdgcn_global_load_lds((const unsigned*)((const char*)(gbase) + (voff)[_i]), (PG8_LAS unsigned*)(lds + (bufoff) + ldsw + _i * 8192), 16, 0, 0); } while (0)
#define PG8_LDA(dst, b, h) do { _Pragma("unroll") for (int m = 0; m < 4; ++m) _Pragma("unroll") for (int k = 0; k < 2; ++k) dst[m][k] = *(const PG8_LAS bf16x8*)(lds + PG8_SA(b, h) + aoff + m * 2048 + k * 1024); } while (0)
#define PG8_LDB(dst, b, h) do { _Pragma("unroll") for (int n = 0; n < 2; ++n) _Pragma("unroll") for (int k = 0; k < 2; ++k) dst[n][k] = *(const PG8_LAS bf16x8*)(lds + PG8_SB(b, h) + boff + n * 2048 + k * 1024); } while (0)
#define PG8_MMA(ai, bj, At, Bt) do { __builtin_amdgcn_s_setprio(1); _Pragma("unroll") for (int m = 0; m < 4; ++m) _Pragma("unroll") for (int n = 0; n < 2; ++n) _Pragma("unroll") for (int k = 0; k < 2; ++k) \
        acc[ai][bj][m][n] = __builtin_amdgcn_mfma_f32_16x16x32_bf16(Bt[n][k], At[m][k], acc[ai][bj][m][n], 0, 0, 0); __builtin_amdgcn_s_setprio(0); } while (0)
#define PG8_WAIT_V(n) asm volatile("s_waitcnt vmcnt(" #n ")" ::: "memory")
#define PG8_WAIT_L(n) asm volatile("s_waitcnt lgkmcnt(" #n ")" ::: "memory")
#define PG8_BAR __builtin_amdgcn_s_barrier()
#define PG8_SCHED __builtin_amdgcn_sched_barrier(0)
    Unit cur, nxt; int ui = 0;
    if (!S.next(0, cur)) return;
    f32x4 acc[2][2][4][2];
#pragma unroll
    for (int a = 0; a < 2; ++a)
#pragma unroll
        for (int b = 0; b < 2; ++b)
#pragma unroll
            for (int m = 0; m < 4; ++m)
#pragma unroll
                for (int n = 0; n < 2; ++n) acc[a][b][m][n] = (f32x4){0.f, 0.f, 0.f, 0.f};
    bf16x8 At[4][2], B0[2][2], B1[2][2];
    const char* cA = (const char*)g.A + (size_t)cur.aoff * 2; const char* cB = (const char*)g.Bt + (size_t)cur.boff * 2;
    S.a_ready(cur);
    PG8_STAGE(PG8_SB(0, 0), cB, voffB); PG8_STAGE(PG8_SB(0, 1), cB + hsB, voffB); PG8_STAGE(PG8_SA(0, 0), cA, voffA); PG8_STAGE(PG8_SA(0, 1), cA + hsA, voffA);
    if (wr == 1) PG8_BAR;
    PG8_WAIT_V(2); PG8_BAR;
    PG8_STAGE(PG8_SB(1, 0), cB + kstep, voffB); PG8_STAGE(PG8_SA(1, 0), cA + kstep, voffA); PG8_STAGE(PG8_SB(1, 1), cB + hsB + kstep, voffB);
    PG8_WAIT_V(6); PG8_BAR;
    for (;;) {
        const bool has_next = S.next(ui + 1, nxt);
        const char* nA = has_next ? (const char*)g.A + (size_t)nxt.aoff * 2 : cA; const char* nB = has_next ? (const char*)g.Bt + (size_t)nxt.boff * 2 : cB;
        for (int t = 0; t < nt; t += 2) {
            const bool last = (t == nt - 2);
            const char* a1 = cA + (size_t)(t + 1) * kstep;
            const char* a2 = last ? nA : cA + (size_t)(t + 2) * kstep; const char* b2 = last ? nB : cB + (size_t)(t + 2) * kstep;
            const char* a3 = a2 + kstep; const char* b3 = b2 + kstep;
            if (last && has_next) S.a_ready(nxt);
            PG8_LDB(B0, 0, 0); PG8_LDB(B1, 0, 1); PG8_SCHED; PG8_LDA(At, 0, 0); PG8_STAGE(PG8_SA(1, 1), a1 + hsA, voffA);
            PG8_WAIT_V(8); PG8_WAIT_L(0); PG8_BAR; PG8_MMA(0, 0, At, B0); PG8_MMA(0, 1, At, B1); PG8_BAR; PG8_SCHED;
            PG8_LDA(At, 0, 1); PG8_STAGE(PG8_SB(0, 0), b2, voffB); PG8_STAGE(PG8_SB(0, 1), b2 + hsB, voffB); PG8_STAGE(PG8_SA(0, 0), a2, voffA);
            PG8_WAIT_V(8); PG8_WAIT_L(0); PG8_BAR; PG8_MMA(1, 0, At, B0); PG8_MMA(1, 1, At, B1); PG8_BAR; PG8_SCHED;
            PG8_LDB(B0, 1, 0); PG8_LDB(B1, 1, 1); PG8_SCHED; PG8_LDA(At, 1, 0); PG8_STAGE(PG8_SA(0, 1), a2 + hsA, voffA);
            PG8_WAIT_V(8); PG8_WAIT_L(0); PG8_BAR; PG8_MMA(0, 0, At, B0); PG8_MMA(0, 1, At, B1); PG8_BAR; PG8_SCHED;
            PG8_LDA(At, 1, 1); PG8_STAGE(PG8_SB(1, 0), b3, voffB); PG8_STAGE(PG8_SB(1, 1), b3 + hsB, voffB); PG8_STAGE(PG8_SA(1, 0), a3, voffA);
            PG8_WAIT_V(8); PG8_WAIT_L(0); PG8_BAR; PG8_MMA(1, 0, At, B0); PG8_MMA(1, 1, At, B1); PG8_BAR; PG8_SCHED;
        }
        if constexpr (ALIGN_EPI) { if (wr == 0) PG8_BAR; }
        if constexpr (!Epi::AFTER_DRAIN) { E(acc, cur, wr, wc, fr, fq); S.done(cur); }
        if (!has_next) break;
#pragma unroll
        for (int a = 0; a < 2; ++a)
#pragma unroll
            for (int b = 0; b < 2; ++b)
#pragma unroll
                for (int m = 0; m < 4; ++m)
#pragma unroll
                    for (int n = 0; n < 2; ++n) acc[a][b][m][n] = (f32x4){0.f, 0.f, 0.f, 0.f};
        cur = nxt; cA = nA; cB = nB; ++ui;
        if constexpr (ALIGN_EPI) { if (wr == 1) PG8_BAR; }
    }
    PG8_WAIT_V(0);
    if constexpr (!ALIGN_EPI) { if (wr == 0) PG8_BAR; }
    PG8_BAR;
    if constexpr (Epi::AFTER_DRAIN) { E.fused(acc, cur, wr, wc, fr, fq, lds, wid, lane); S.done(cur); }
#undef PG8_SA
#undef PG8_SB
#undef PG8_STAGE
#undef PG8_LDA
#undef PG8_LDB
#undef PG8_MMA
#undef PG8_WAIT_V
#undef PG8_WAIT_L
#undef PG8_BAR
#undef PG8_SCHED
}
}

namespace fox {
typedef unsigned short bf16_t;
typedef short bf16x8 __attribute__((ext_vector_type(8)));
typedef short s16x4 __attribute__((ext_vector_type(4)));
typedef float f32x16 __attribute__((ext_vector_type(16)));
typedef float f32x4 __attribute__((ext_vector_type(4)));
typedef unsigned u32x4 __attribute__((ext_vector_type(4)));
constexpr int D = 128, NW = 8, QBLK = 32, KVBLK = 64, QB = NW * QBLK;
constexpr int SHM_V = KVBLK * D * 2, SHM_K = KVBLK * D * 2;
constexpr int LDS_C = 2 * SHM_V + 2 * SHM_K + NW * 64 * 4;
constexpr int LDS_BYTES = LDS_C + SEQ * 4;
constexpr int QP = 4096, OP = 2048;
constexpr float THR = 24.f;
#define KSWZ(row, colB) ((row) * 256 + ((colB) ^ (((row) & 7) << 4)))
#define SBAR() __builtin_amdgcn_sched_barrier(0)
__device__ __forceinline__ int v_st(int k, int c) { const int kk = (k & ~0xC) | ((k & 4) << 1) | ((k & 8) >> 1); return ((kk >> 3) * 4 + (c >> 5)) * 512 + ((kk & 7) * 32 + (c & 31)) * 2; }
__device__ __forceinline__ int v_rd_base(int lane) { return ((lane & 3) << 3) | (((lane >> 2) & 3) << 6) | (((lane >> 4) & 1) << 5) | (((lane >> 5) & 1) << 8); }
constexpr int v_rd_off(int d0, int ks, int half) { return d0 * 512 + ks * 4096 + half * 2048; }
__device__ __forceinline__ int crow(int r, int hi) { return (r & 3) + 8 * (r >> 2) + 4 * hi; }
__device__ __forceinline__ unsigned cvtpk(float lo, float hi) { unsigned r; asm volatile("v_cvt_pk_bf16_f32 %0, %1, %2" : "=v"(r) : "v"(lo), "v"(hi)); return r; }
__device__ __forceinline__ bf16x8 load8(const bf16_t* p) { return *reinterpret_cast<const bf16x8*>(p); }
__device__ __forceinline__ void mask_tile(f32x16& p0, f32x16& p1, int dq) {
    const float NEG = -__builtin_inff();
#pragma unroll
    for (int r = 0; r < 16; ++r) { const int c = (r & 3) + 8 * (r >> 2); if (dq - c < 0) p0[r] = NEG; if (dq - c - 32 < 0) p1[r] = NEG; }
}
__device__ __forceinline__ void bias_tile(f32x16& p0, f32x16& p1, const float* cb) {
#pragma unroll
    for (int i = 0; i < 4; ++i) { const f32x4 c0 = *(const f32x4*)(cb + 8 * i), c1 = *(const f32x4*)(cb + 32 + 8 * i);
#pragma unroll
        for (int j = 0; j < 4; ++j) { p0[4 * i + j] -= c0[j]; p1[4 * i + j] -= c1[j]; } }
}
__device__ __forceinline__ void partialSM(f32x16& p0, f32x16& p1, float& m_reg, float& mn, float& alpha) {
    float pmax = p0[0]; for (int r = 1; r < 16; ++r) pmax = fmaxf(pmax, p0[r]); for (int r = 0; r < 16; ++r) pmax = fmaxf(pmax, p1[r]);
    { auto rr = __builtin_amdgcn_permlane32_swap(__float_as_uint(pmax), __float_as_uint(pmax), false, false);
      pmax = fmaxf(__uint_as_float(rr[0]), __uint_as_float(rr[1])); }
    if (__builtin_expect(__all((pmax - m_reg) <= THR), 1)) { mn = m_reg; alpha = 1.f; }
    else { mn = fmaxf(m_reg, pmax); alpha = __builtin_amdgcn_exp2f(m_reg - mn); m_reg = mn; }
    for (int r = 0; r < 16; ++r) p0[r] = p0[r] - mn; for (int r = 0; r < 16; ++r) p1[r] = p1[r] - mn;
    for (int r = 0; r < 16; ++r) p0[r] = __builtin_amdgcn_exp2f(p0[r]);
}
__device__ __forceinline__ void finishSM(f32x16& p0, f32x16& p1, float alpha, float& l_reg, bf16x8& pa0, bf16x8& pa1, bf16x8& pa2, bf16x8& pa3) {
    for (int r = 0; r < 16; ++r) p1[r] = __builtin_amdgcn_exp2f(p1[r]);
    float ps = 0; for (int r = 0; r < 16; ++r) ps += p0[r]; for (int r = 0; r < 16; ++r) ps += p1[r];
    { auto rr = __builtin_amdgcn_permlane32_swap(__float_as_uint(ps), __float_as_uint(ps), false, false);
      ps = __uint_as_float(rr[0]) + __uint_as_float(rr[1]); }
    l_reg = l_reg * alpha + ps;
#define PK4(P, B_, OUT) do { unsigned a0 = cvtpk(P[B_+0], P[B_+1]), a1 = cvtpk(P[B_+2], P[B_+3]);                          \
        unsigned b0 = cvtpk(P[B_+4], P[B_+5]), b1 = cvtpk(P[B_+6], P[B_+7]);                                             \
        auto r0 = __builtin_amdgcn_permlane32_swap(a0, b0, false, false); auto r1 = __builtin_amdgcn_permlane32_swap(a1, b1, false, false); \
        u32x4 w = {r0[0], r1[0], r0[1], r1[1]}; OUT = *reinterpret_cast<bf16x8*>(&w); } while (0)
    PK4(p0, 0, pa0); PK4(p0, 8, pa1); PK4(p1, 0, pa2); PK4(p1, 8, pa3);
#undef PK4
}
template <int KB>
__device__ __forceinline__ void qkt(f32x16& p0, f32x16& p1, const char* K_lds, int r32, int hi, const bf16x8* qr) {
    p0 = f32x16{}; p1 = f32x16{};
    const char* kb[4];
#pragma unroll
    for (int dd = 0; dd < 4; ++dd) kb[dd] = K_lds + KB * SHM_K + KSWZ(r32, (dd * 16 + hi * 8) * 2);
#pragma unroll
    for (int d0 = 0; d0 < 8; ++d0) { const char* a = kb[d0 & 3] + (d0 >> 2) * 128;
        bf16x8 b0 = *reinterpret_cast<const bf16x8*>(a);
        bf16x8 b1 = *reinterpret_cast<const bf16x8*>(a + 32 * 256);
        p0 = __builtin_amdgcn_mfma_f32_32x32x16_bf16(b0, qr[d0], p0, 0, 0, 0);
        p1 = __builtin_amdgcn_mfma_f32_32x32x16_bf16(b1, qr[d0], p1, 0, 0, 0); }
}
template <int VB>
__device__ __forceinline__ void pv_tile(f32x16* o, int vb0, bf16x8 pa0, bf16x8 pa1, bf16x8 pa2, bf16x8 pa3) {
#define TRRD(dst, off) asm volatile("ds_read_b64_tr_b16 %0, %1 offset:%2" : "=&v"(dst) : "v"(vb0), "i"(off) : "memory")
#define PV_D0(d0) do { s16x4 l0, l1, l2, l3, h0, h1, h2, h3; constexpr int b_ = VB * SHM_V + v_rd_off(d0, 0, 0); \
        TRRD(l0, b_); TRRD(h0, b_ + 2048); TRRD(l1, b_ + 4096); TRRD(h1, b_ + 6144); TRRD(l2, b_ + 8192); TRRD(h2, b_ + 10240); TRRD(l3, b_ + 12288); TRRD(h3, b_ + 14336); \
        asm volatile("s_waitcnt lgkmcnt(0)" ::: "memory"); SBAR();   \
        o[d0] = __builtin_amdgcn_mfma_f32_32x32x16_bf16(pa0, (bf16x8){l0[0], l0[1], l0[2], l0[3], h0[0], h0[1], h0[2], h0[3]}, o[d0], 0, 0, 0);   \
        o[d0] = __builtin_amdgcn_mfma_f32_32x32x16_bf16(pa1, (bf16x8){l1[0], l1[1], l1[2], l1[3], h1[0], h1[1], h1[2], h1[3]}, o[d0], 0, 0, 0);   \
        o[d0] = __builtin_amdgcn_mfma_f32_32x32x16_bf16(pa2, (bf16x8){l2[0], l2[1], l2[2], l2[3], h2[0], h2[1], h2[2], h2[3]}, o[d0], 0, 0, 0);   \
        o[d0] = __builtin_amdgcn_mfma_f32_32x32x16_bf16(pa3, (bf16x8){l3[0], l3[1], l3[2], l3[3], h3[0], h3[1], h3[2], h3[3]}, o[d0], 0, 0, 0); } while (0)
    PV_D0(0); PV_D0(1); PV_D0(2); PV_D0(3);
#undef PV_D0
#undef TRRD
}
struct BlockRef { const bf16_t* Q; const bf16_t* K; const bf16_t* V; bf16_t* O; int P0; };
struct Seam { bf16x8 qr[8]; bf16x8 st_v0, st_v1, st_k0, st_k1; };
#define ROW(p, k0, rr) ((p) + (size_t)((k0) + (rr)) * QP + sc)
#define VMW() asm volatile("s_waitcnt vmcnt(0)" ::: "memory")
#define VMWN(n) asm volatile("s_waitcnt vmcnt(%0)" :: "i"(n) : "memory")
#define SLOAD_H(Kp, Vp, k0) do { S.st_v0 = load8(ROW(Vp, k0, sr)); S.st_v1 = load8(ROW(Vp, k0, 32 + sr)); S.st_k0 = load8(ROW(Kp, k0, sr)); S.st_k1 = load8(ROW(Kp, k0, 32 + sr)); } while (0)
#define SWRITE_HK(bf) do { *(bf16x8*)(K_lds + (bf) * SHM_K + kws) = S.st_k0; *(bf16x8*)(K_lds + (bf) * SHM_K + kws + 32 * 256) = S.st_k1; } while (0)
#define SWRITE_HV(bf) do { *(bf16x8*)(V_lds + (bf) * SHM_V + vst0) = S.st_v0; *(bf16x8*)(V_lds + (bf) * SHM_V + vst1) = S.st_v1; } while (0)
#define SWRITE_H(bf) do { SWRITE_HV(bf); SWRITE_HK(bf); } while (0)
__device__ __forceinline__ void prime(const BlockRef& cur, int j_lo, char* lds, Seam& S) {
    const int tid = threadIdx.x, wid = __builtin_amdgcn_readfirstlane(tid >> 6), lane = tid & 63, r32 = lane & 31, hi = lane >> 5;
    const int sr = tid >> 4, sc = (tid & 15) * 8, kws = KSWZ(sr, sc * 2); char* K_lds = lds + 2 * SHM_V;
    for (int d0 = 0; d0 < 8; ++d0) S.qr[d0] = load8(cur.Q + (size_t)(wid * QBLK + r32) * QP + d0 * 16 + hi * 8);
    SLOAD_H(cur.K, cur.V, j_lo * KVBLK); VMW(); SWRITE_HK(0);
    __syncthreads();
}
__device__ __forceinline__ void block(const BlockRef& cur, const BlockRef& nxt, int j_lo, char* lds, Seam& S) {
    const int tid = threadIdx.x, wid = __builtin_amdgcn_readfirstlane(tid >> 6), lane = tid & 63, r32 = lane & 31, hi = lane >> 5;
    const int NT = (cur.P0 + QB - 1) / KVBLK + 1 - j_lo;
    const int qlo = cur.P0 + wid * QBLK, qm = qlo + r32 - 4 * hi;
    char* V_lds = lds; char* K_lds = lds + 2 * SHM_V;
    float* ws = (float*)(lds + 2 * SHM_V + 2 * SHM_K) + wid * 64; float* li_l = ws, * al_l = ws + 32;
    const float* c_lds = (const float*)(lds + LDS_C) + 4 * hi;
    float m_reg = -1e30f, l_reg = 0; f32x16 o[4] = {};
    const int sr = tid >> 4, sc = (tid & 15) * 8, vst0 = v_st(sr, sc), vst1 = v_st(32 + sr, sc), kws = KSWZ(sr, sc * 2);
    const int vb0 = (int)(uintptr_t)V_lds + v_rd_base(lane);
    const bf16_t* Kh = cur.K; const bf16_t* Vh = cur.V;
#define RESC(a) do { if (__any((a) < 1.f)) { if (hi == 0) al_l[r32] = (a); asm volatile("s_waitcnt lgkmcnt(0)" ::: "memory");              \
                     for (int d_ = 0; d_ < 4; ++d_) for (int r = 0; r < 16; ++r) o[d_][r] *= al_l[crow(r, hi)]; } } while (0)
#define KBASE(t) ((j_lo + (t)) * KVBLK)
#define MASKT(P0_, P1_, t) do { const int kb_ = KBASE(t); bias_tile(P0_, P1_, c_lds + kb_); if (kb_ + KVBLK - 1 > qlo) mask_tile(P0_, P1_, qm - kb_); } while (0)
#define SEAM_K0() do { VMWN(8); SWRITE_HK(0); SBAR(); } while (0)
    f32x16 pA0, pA1, pB0, pB1; float mnA, mnB, alA, alB; bf16x8 pa0, pa1, pa2, pa3;
    SWRITE_HV(0); SBAR();
    if (NT > 1) { SLOAD_H(Kh, Vh, KBASE(1)); }
    SBAR(); qkt<0>(pA0, pA1, K_lds, r32, hi, S.qr);
    MASKT(pA0, pA1, 0); partialSM(pA0, pA1, m_reg, mnA, alA);
    if (NT > 1) { VMW(); SWRITE_H(1); }
    __syncthreads();
#define HALF_STEP(PX0, PX1, mnX, alX, PY0, PY1, alY, t, KB, VB, SB) do {                                                      \
        SBAR(); qkt<KB>(PX0, PX1, K_lds, r32, hi, S.qr);                                                                     \
        finishSM(PY0, PY1, alY, l_reg, pa0, pa1, pa2, pa3); SBAR();                                                           \
        if ((t) + 1 < NT) { SLOAD_H(Kh, Vh, KBASE((t) + 1)); SBAR(); }                                                        \
        pv_tile<VB>(o, vb0, pa0, pa1, pa2, pa3); MASKT(PX0, PX1, (t)); partialSM(PX0, PX1, m_reg, mnX, alX);                 \
        __syncthreads();                                                                                                      \
        if ((t) + 1 < NT) { VMW(); SWRITE_H(SB); }                                                                            \
        RESC(alX); __syncthreads(); } while (0)
    for (int t = 1; t + 1 < NT; t += 2) {
        HALF_STEP(pB0, pB1, mnB, alB, pA0, pA1, alA, t, 1, 0, 0);
        HALF_STEP(pA0, pA1, mnA, alA, pB0, pB1, alB, t + 1, 0, 1, 1);
    }
    const bool even = (NT & 1) == 0;
    if (even) { SBAR(); qkt<1>(pB0, pB1, K_lds, r32, hi, S.qr); SBAR(); }
    SLOAD_H(nxt.K, nxt.V, j_lo * KVBLK); SBAR();
#pragma unroll
    for (int d0 = 0; d0 < 8; ++d0) S.qr[d0] = load8(nxt.Q + (size_t)(wid * QBLK + r32) * QP + d0 * 16 + hi * 8);
    SBAR();
    finishSM(pA0, pA1, alA, l_reg, pa0, pa1, pa2, pa3); SBAR();
    pv_tile<0>(o, vb0, pa0, pa1, pa2, pa3);
    if (even) { MASKT(pB0, pB1, NT - 1); partialSM(pB0, pB1, m_reg, mnB, alB); __syncthreads(); RESC(alB);
        finishSM(pB0, pB1, alB, l_reg, pa0, pa1, pa2, pa3); SBAR(); pv_tile<1>(o, vb0, pa0, pa1, pa2, pa3); }
    SBAR(); SEAM_K0();
    if (hi == 0) li_l[r32] = l_reg; asm volatile("s_waitcnt lgkmcnt(0)" ::: "memory");
    float rli[16];
#pragma unroll
    for (int r = 0; r < 16; ++r) rli[r] = __builtin_amdgcn_rcpf(li_l[crow(r, hi)]);
    bf16_t* Ow = cur.O + (size_t)(wid * QBLK) * OP;
#pragma unroll
    for (int r = 0; r < 16; ++r) { const int orow = crow(r, hi);
#pragma unroll
        for (int d0 = 0; d0 < 4; ++d0) { const float v = o[d0][r] * rli[r];
            const float vn = __shfl_xor(v, 1);
            if ((r32 & 1) == 0) *(unsigned*)(Ow + (size_t)orow * OP + d0 * 32 + r32) = cvtpk(v, vn); } }
    __syncthreads();
#undef RESC
#undef KBASE
#undef MASKT
#undef SEAM_K0
#undef HALF_STEP
}
#undef ROW
#undef VMW
#undef VMWN
#undef SLOAD_H
#undef SWRITE_HK
#undef SWRITE_HV
#undef SWRITE_H
#undef KSWZ
#undef SBAR
}

constexpr int NWAVES = 8, NTHREADS = 512;
constexpr int LDS_BYTES = 147456;
constexpr int LDS_MISC = 145408;
constexpr size_t MiB = 1u << 20;
constexpr size_t WS_CTL = 0, CTL_ZERO_BYTES = 1 * MiB;
#ifndef QSPLIT
#define QSPLIT 1024
#endif
constexpr int CW_QUEUE2 = 128;
constexpr int CW_NRM = 512;
constexpr int CW_QUEUE = 64;
constexpr int CW_BAR = 4096;
constexpr size_t CTL_SS1 = 256 * 1024, CTL_SS2 = 320 * 1024;
constexpr size_t WS_LF = 1 * MiB;
constexpr size_t WS_SU = 1 * MiB + 512 * 1024, WS_SV = 1 * MiB + 640 * 1024;
constexpr size_t WS_WIN = 2 * MiB, WS_WO1 = 18 * MiB, WS_WO2 = 26 * MiB, WS_WQ = 34 * MiB, WS_WK = 42 * MiB, WS_WV = 50 * MiB, WS_WO = 58 * MiB;
constexpr size_t WS_WPQ = 66 * MiB, WS_AEXP = 74 * MiB, WS_WSC = 82 * MiB, WS_PB = 90 * MiB, WS_MN = 91 * MiB, WS_KX = 93 * MiB, WS_VXT = 95 * MiB;
constexpr size_t WS_UB = 98 * MiB, WS_VB = 130 * MiB, WS_XN = 226 * MiB, WS_PROJ = 258 * MiB, WS_AMIX = 322 * MiB, WS_H = 354 * MiB, WS_HB = 418 * MiB, WS_P = 450 * MiB, WS_END = 466 * MiB;

#define GAS __attribute__((address_space(1)))
#define LAS __attribute__((address_space(3)))
typedef unsigned short bf16;
typedef unsigned v4u __attribute__((ext_vector_type(4)));
typedef unsigned v2u __attribute__((ext_vector_type(2)));
typedef float f32x4 __attribute__((ext_vector_type(4)));
typedef __bf16 bf16x2_t __attribute__((ext_vector_type(2)));
#define LDS_WAIT() asm volatile("s_waitcnt lgkmcnt(0)" ::: "memory")
__device__ __forceinline__ unsigned f2bf(float f) { unsigned u = __builtin_bit_cast(unsigned, f); return (u + 0x7fffu + ((u >> 16) & 1u)) >> 16; }
__device__ __forceinline__ unsigned pk2(float lo, float hi) { return f2bf(lo) | (f2bf(hi) << 16); }
__device__ __forceinline__ float wave_sum(float v) {
#pragma unroll
    for (int o = 1; o < 64; o <<= 1) v += __shfl_xor(v, o);
    return v;
}

#define XB_TMO      128
#define XB_XCNT(j)  (256  + 64 * (j))
#define XB_XSUB(j)  (1280 + 64 * (j))
#define XB_XGEN(j)  (2304 + 64 * (j))
#define XB_TOP      3328
#define XB_TOPGEN   3392
#define XCD_BAR_WORDS 3456
#define XB_SPIN_CAP (1u << 22)
__device__ __forceinline__ unsigned xb_ld(unsigned* p)              { return __hip_atomic_load(p, __ATOMIC_RELAXED, __HIP_MEMORY_SCOPE_AGENT); }
__device__ __forceinline__ unsigned xb_add(unsigned* p, unsigned v) { return __hip_atomic_fetch_add(p, v, __ATOMIC_RELAXED, __HIP_MEMORY_SCOPE_AGENT); }
__device__ __forceinline__ unsigned xb_xcc_id() { return (unsigned)__builtin_amdgcn_s_getreg((3 << 11) | 20) & 0xFu; }
#define XB_SPIN(cond, bar) do { unsigned _sp = 0; while (cond) { __builtin_amdgcn_s_sleep(1); \
    if ((++_sp & 255u) == 0u) { if (xb_ld(&(bar)[XB_TMO])) break; if (_sp > XB_SPIN_CAP) { atomicAdd(&(bar)[XB_TMO], 1u); break; } } } } while (0)
struct XcdBarrier { unsigned* bar; unsigned x; volatile LAS unsigned* st; };
__device__ __forceinline__ XcdBarrier xcd_barrier_post(unsigned* bar, volatile LAS unsigned* st) {
    XcdBarrier b; b.bar = bar; b.x = xb_xcc_id(); b.st = st;
    if (threadIdx.x == 0) (void)xb_add(&bar[XB_XCNT(b.x)], 1u);
    return b;
}
__device__ __forceinline__ void xcd_barrier_complete(unsigned* bar, unsigned x, unsigned& nloc, unsigned& nx) {
    const unsigned G = gridDim.x * gridDim.y * gridDim.z;
    unsigned sum, cnt, mine, sp = 0u;
    for (;;) {
        sum = 0u; cnt = 0u; mine = 0u;
#pragma unroll
        for (unsigned j = 0; j < 16; ++j) { const unsigned c = xb_ld(&bar[XB_XCNT(j)]); sum += c; cnt += (c > 0u) ? 1u : 0u; mine = (j == x) ? c : mine; }
        if (sum == G) break;
        __builtin_amdgcn_s_sleep(1);
        if ((++sp & 255u) == 0u) { if (xb_ld(&bar[XB_TMO])) break; if (sp > XB_SPIN_CAP) { atomicAdd(&bar[XB_TMO], 1u); break; } }
    }
    nloc = mine > 0u ? mine : 1u; nx = cnt > 0u ? cnt : 1u;
}
__device__ __forceinline__ void xcd_barrier(const XcdBarrier& b) {
    asm volatile("s_waitcnt vmcnt(0)" ::: "memory");
    __syncthreads();
    if (threadIdx.x == 0) {
        unsigned* bar = b.bar;
        __builtin_amdgcn_s_waitcnt(0);
        unsigned nloc = b.st[0], nx = b.st[1];
        if (nloc == 0u) { xcd_barrier_complete(bar, b.x, nloc, nx); b.st[0] = nloc; b.st[1] = nx; }
        const unsigned old = xb_add(&bar[XB_XSUB(b.x)], 1u);
        const unsigned gen = old / nloc;
        if (old + 1u == (gen + 1u) * nloc) {
            __builtin_amdgcn_fence(__ATOMIC_RELEASE, "agent");
            asm volatile("s_waitcnt vmcnt(0)" ::: "memory");
            const unsigned og = xb_add(&bar[XB_TOP], 1u);
            const unsigned tg = og / nx;
            if (og + 1u == (tg + 1u) * nx) xb_add(&bar[XB_TOPGEN], 1u);
            else XB_SPIN(xb_ld(&bar[XB_TOPGEN]) == tg, bar);
            __builtin_amdgcn_fence(__ATOMIC_ACQUIRE, "agent");
            xb_add(&bar[XB_XGEN(b.x)], 1u);
            asm volatile("s_waitcnt vmcnt(0)" ::: "memory");
        } else {
            XB_SPIN(xb_ld(&bar[XB_XGEN(b.x)]) == gen, bar);
            __builtin_amdgcn_fence(__ATOMIC_ACQUIRE, "agent");
            asm volatile("s_waitcnt vmcnt(0)" ::: "memory");
        }
    }
    __syncthreads();
}

struct Args { const float* in[20]; float* out; unsigned char* ws; int ph_lo, ph_hi; int one_launch, pad; };

__device__ __forceinline__ void tr_load(const float* W, int ldw, int nblk, int item, int lane, f32x4 (&tv)[8]) {
    const int kb = item / nblk, nb = item % nblk, k0 = 64 * kb, n0 = 32 * nb;
#pragma unroll
    for (int i = 0; i < 8; ++i) tv[i] = *(const GAS f32x4*)(W + (size_t)(k0 + i * 8 + (lane >> 3)) * ldw + n0 + (lane & 7) * 4);
}
__device__ __forceinline__ void tr_store(const f32x4 (&tv)[8], int nblk, bf16* WT, bf16* WT2, int k2lo, int ldt, LAS float* scr, int item, int lane) {
    const int kb = item / nblk, nb = item % nblk, k0 = 64 * kb, n0 = 32 * nb;
#pragma unroll
    for (int i = 0; i < 8; ++i) { const int kk = i * 8 + (lane >> 3); LAS float* d = scr + kk * 33 + (lane & 7) * 4; d[0] = tv[i][0]; d[1] = tv[i][1]; d[2] = tv[i][2]; d[3] = tv[i][3]; }
    LDS_WAIT(); asm volatile("" ::: "memory");
    const int c = lane & 7;
#pragma unroll
    for (int j = 0; j < 4; ++j) { const int n = (lane >> 3) + 8 * j; const LAS float* s = scr + (8 * c) * 33 + n;
        v4u o; o.x = pk2(s[0 * 33], s[1 * 33]); o.y = pk2(s[2 * 33], s[3 * 33]); o.z = pk2(s[4 * 33], s[5 * 33]); o.w = pk2(s[6 * 33], s[7 * 33]);
        *(GAS v4u*)(WT + (size_t)(n0 + n) * ldt + k0 + 8 * c) = o;
        if (WT2 && k0 >= k2lo) *(GAS v4u*)(WT2 + (size_t)(n0 + n) * ldt + k0 + 8 * c) = o; }
    LDS_WAIT(); asm volatile("" ::: "memory");
}
__device__ __forceinline__ void p0_transpose_item(const float* W, int ldw, int nblk, const float* g, bf16* WT, bf16* WT2, int k2lo, int ldt, LAS float* scr, int item, int lane) {
    (void)g; f32x4 tv[8]; tr_load(W, ldw, nblk, item, lane, tv); tr_store(tv, nblk, WT, WT2, k2lo, ldt, scr, item, lane);
}
__device__ __forceinline__ v4u cvt8(const float* p, float s) {
    const f32x4 a = *(const f32x4*)p, b = *(const f32x4*)(p + 4);
    v4u o; o.x = pk2(a[0] * s, a[1] * s); o.y = pk2(a[2] * s, a[3] * s); o.z = pk2(b[0] * s, b[1] * s); o.w = pk2(b[2] * s, b[3] * s); return o;
}

__device__ __forceinline__ float gelu_f(float v) {
    const float av = fabsf(v), t = __builtin_amdgcn_rcpf(av * 0.2316418882f + 1.0f);
    float q = t * 0.5307027145f + (-0.7265760135f); q = q * t + 0.7107068705f; q = q * t + (-0.142248368f); q = q * t + 0.127414796f; q = q * t;
    const float e = __builtin_amdgcn_exp2f((v * v) * (-0.72134752044f));
    const float m = v * (q * e);
    return v < 0.f ? m : v - m;
}
__device__ __forceinline__ float dot2bf(unsigned a, unsigned b, float c) { return __builtin_amdgcn_fdot2_f32_bf16(__builtin_bit_cast(bf16x2_t, a), __builtin_bit_cast(bf16x2_t, b), c, false); }
__device__ __forceinline__ unsigned fkey(float f) { const unsigned u = __float_as_uint(f); return (u & 0x80000000u) ? ~u : (u | 0x80000000u); }
__device__ __forceinline__ float fdec(unsigned k) { const unsigned u = (k & 0x80000000u) ? (k & 0x7fffffffu) : ~k; return __uint_as_float(u); }


typedef float f32x2v __attribute__((ext_vector_type(2)));
__device__ __forceinline__ float wave_sum_dpp(float v) {
    v += __builtin_bit_cast(float, __builtin_amdgcn_update_dpp(0, __builtin_bit_cast(int, v), 0xB1, 0xf, 0xf, true));
    v += __builtin_bit_cast(float, __builtin_amdgcn_update_dpp(0, __builtin_bit_cast(int, v), 0x4E, 0xf, 0xf, true));
    v += __builtin_bit_cast(float, __builtin_amdgcn_update_dpp(0, __builtin_bit_cast(int, v), 0x141, 0xf, 0xf, true));
    v += __builtin_bit_cast(float, __builtin_amdgcn_update_dpp(0, __builtin_bit_cast(int, v), 0x140, 0xf, 0xf, true));
    const float a = __builtin_bit_cast(float, __builtin_amdgcn_readlane(__builtin_bit_cast(int, v), 0));
    const float b = __builtin_bit_cast(float, __builtin_amdgcn_readlane(__builtin_bit_cast(int, v), 16));
    const float c = __builtin_bit_cast(float, __builtin_amdgcn_readlane(__builtin_bit_cast(int, v), 32));
    const float d = __builtin_bit_cast(float, __builtin_amdgcn_readlane(__builtin_bit_cast(int, v), 48));
    return (a + b) + (c + d);
}
typedef float v32f __attribute__((ext_vector_type(32)));
typedef float v16f __attribute__((ext_vector_type(16)));
typedef unsigned v6u __attribute__((ext_vector_type(6)));
#ifndef FP6_INTERLEAVED
#define FP6_INTERLEAVED 1
#endif
__device__ __forceinline__ v32f dec_fp6(const v4u a, const v2u b) { const v6u w = {a.x, a.y, a.z, a.w, b.x, b.y}; return __builtin_amdgcn_cvt_scalef32_pk32_f32_fp6(w, 1.0f); }
typedef __bf16 v32bf __attribute__((ext_vector_type(32)));
typedef unsigned v16u __attribute__((ext_vector_type(16)));
__device__ __forceinline__ float peer_dot(const v4u ua, const v2u ub, const unsigned (&xnp)[16]) {
    const v6u w = {ua.x, ua.y, ua.z, ua.w, ub.x, ub.y};
    const v16u fu = __builtin_bit_cast(v16u, __builtin_amdgcn_cvt_scalef32_pk32_bf16_fp6(w, 1.0f));
    unsigned fa[16];
#pragma unroll
    for (int i = 0; i < 16; ++i) fa[i] = fu[i];
    float a[4] = {0.f, 0.f, 0.f, 0.f};
#pragma unroll
    for (int i = 0; i < 16; ++i) a[i & 3] = dot2bf(fa[i], xnp[i], a[i & 3]);
    return (a[0] + a[1]) + (a[2] + a[3]);
}
__device__ __forceinline__ float peer_dot_lds(const v4u ua, const v2u ub, const LAS v4u* xl) {
    const v6u w = {ua.x, ua.y, ua.z, ua.w, ub.x, ub.y};
    const v16u fu = __builtin_bit_cast(v16u, __builtin_amdgcn_cvt_scalef32_pk32_bf16_fp6(w, 1.0f));
    unsigned fa[16];
#pragma unroll
    for (int i = 0; i < 16; ++i) fa[i] = fu[i];
    float a[4] = {0.f, 0.f, 0.f, 0.f};
#pragma unroll
    for (int i4 = 0; i4 < 4; ++i4) { const v4u x4 = xl[i4 * 64];
        a[0] = dot2bf(fa[i4 * 4 + 0], x4.x, a[0]); a[1] = dot2bf(fa[i4 * 4 + 1], x4.y, a[1]); a[2] = dot2bf(fa[i4 * 4 + 2], x4.z, a[2]); a[3] = dot2bf(fa[i4 * 4 + 3], x4.w, a[3]); }
    return (a[0] + a[1]) + (a[2] + a[3]);
}
__device__ __forceinline__ void peer_axpy(const v4u va, const v2u vb, float w, float (&oacc)[32]) {
    const v32f f = dec_fp6(va, vb);
#pragma unroll
    for (int i = 0; i < 32; ++i) oacc[i] = fmaf(w, f[i], oacc[i]);
}


__device__ __forceinline__ void conv_rows2_fp6(const float* srow0, const float* srow1, unsigned char* drow0, unsigned char* drow1, float* sc0, float* sc1, int lane) {
    f32x4 v[2][8]; float am[2] = {0.f, 0.f};
#pragma unroll
    for (int q = 0; q < 8; ++q) { v[0][q] = *(const GAS f32x4*)(srow0 + lane * 4 + q * 256); v[1][q] = *(const GAS f32x4*)(srow1 + lane * 4 + q * 256); }
#pragma unroll
    for (int r = 0; r < 2; ++r)
#pragma unroll
        for (int q = 0; q < 8; ++q) am[r] = fmaxf(am[r], fmaxf(fmaxf(fabsf(v[r][q][0]), fabsf(v[r][q][1])), fmaxf(fabsf(v[r][q][2]), fabsf(v[r][q][3]))));
#pragma unroll
    for (int o = 1; o < 64; o <<= 1) { am[0] = fmaxf(am[0], __shfl_xor(am[0], o)); am[1] = fmaxf(am[1], __shfl_xor(am[1], o)); }
#pragma unroll
    for (int r = 0; r < 2; ++r) {
        int ex = 0; if (am[r] > 0.f) { (void)frexpf(am[r], &ex); ex = 3 - ex; if (ldexpf(am[r], ex) > 7.5f) ex -= 1; }
        const float sc = ldexpf(1.f, ex);
        if (lane == 0) *(r ? sc1 : sc0) = ldexpf(1.f, -ex);
        v16f xa, xb;
#pragma unroll
        for (int i = 0; i < 16; ++i) { xa[i] = v[r][(2 * i) >> 2][(2 * i) & 3] * sc; xb[i] = v[r][(2 * i + 1) >> 2][(2 * i + 1) & 3] * sc; }
        const v6u w = __builtin_amdgcn_cvt_scalef32_2xpk16_fp6_f32(xa, xb, 1.0f);
        unsigned char* drow = r ? drow1 : drow0;
        *(GAS v4u*)(drow + lane * 16) = (v4u){w[0], w[1], w[2], w[3]};
        *(GAS v2u*)(drow + 1024 + lane * 8) = (v2u){w[4], w[5]};
    }
}

#if defined(PROBE_SEL) && PROBE_SEL < 7
#define PROBE_EXPORT(T_, q) do { if ((T_) == 0 && lane == 0 && (q) == 0) { const unsigned long long a_ = ((unsigned long long)MISC[33 + 2 * PROBE_SEL] << 32) | MISC[32 + 2 * PROBE_SEL], b_ = ((unsigned long long)MISC[35 + 2 * PROBE_SEL] << 32) | MISC[34 + 2 * PROBE_SEL]; o[0] += (float)(b_ - a_) * 0.001f; } } while (0)
#else
#define PROBE_EXPORT(T_, q) do { } while (0)
#endif
__global__ void __launch_bounds__(NTHREADS, 2) fwd_kernel(Args args) {
    extern __shared__ __attribute__((aligned(16))) unsigned char lds[];
    LAS unsigned char* ldsL = (LAS unsigned char*)lds;
    volatile LAS unsigned* MISC = (volatile LAS unsigned*)(ldsL + LDS_MISC);
    const int tid = threadIdx.x, lane = tid & 63, wave = __builtin_amdgcn_readfirstlane(tid >> 6);
    const int G = gridDim.x; const int bx = blockIdx.x; const int vcu = (G % 8 == 0) ? (bx % 8) * (G / 8) + bx / 8 : bx;
#define G_ws (args.ws)
#define G_ctl ((unsigned*)(args.ws + WS_CTL))
#define G_x (args.in[0])
#define G_mem (args.in[1])
#define G_mix_norm (args.in[2])
#define G_w_in (args.in[3])
#define G_b_forget (args.in[4])
#define G_pool_w (args.in[5])
#define G_pool_scale (args.in[6])
#define G_w_out (args.in[7])
#define G_xattn_norm (args.in[8])
#define G_mem_norm (args.in[9])
#define G_xwq (args.in[10])
#define G_xwk (args.in[11])
#define G_xwv (args.in[12])
#define G_xwo (args.in[13])
#define G_peer_norm (args.in[14])
#define G_peer_wq (args.in[15])
#define G_sub_keys (args.in[16])
#define G_peer_u (args.in[17])
#define G_peer_v (args.in[18])
#define G_final_norm (args.in[19])
#define G_W_IN ((bf16*)(args.ws + WS_WIN))
#define G_WO1 ((bf16*)(args.ws + WS_WO1))
#define G_WO2 ((bf16*)(args.ws + WS_WO2))
#define G_WQ ((bf16*)(args.ws + WS_WQ))
#define G_WK ((bf16*)(args.ws + WS_WK))
#define G_WV ((bf16*)(args.ws + WS_WV))
#define G_WO ((bf16*)(args.ws + WS_WO))
#define G_WPQ ((bf16*)(args.ws + WS_WPQ))
#define G_AEXP ((bf16*)(args.ws + WS_AEXP))
#define G_W1 ((bf16*)(args.ws + WS_AEXP))
#define G_W2 ((bf16*)(args.ws + WS_WPQ))
#define G_WSC ((bf16*)(args.ws + WS_WSC))
#define G_PB ((bf16*)(args.ws + WS_PB))
#define G_MN ((bf16*)(args.ws + WS_MN))
#define G_KX ((bf16*)(args.ws + WS_KX))
#define G_VXT ((bf16*)(args.ws + WS_VXT))
#define G_UB (args.ws + WS_UB)
#define G_VB (args.ws + WS_VB)
#define G_SU ((float*)(args.ws + WS_SU))
#define G_SV ((float*)(args.ws + WS_SV))
#define G_XN ((bf16*)(args.ws + WS_XN))
#define G_QX ((bf16*)(args.ws + WS_XN))
#define G_PROJ ((bf16*)(args.ws + WS_PROJ))
#define G_SCT ((float*)(args.ws + WS_PROJ))
#define G_AMIX ((bf16*)(args.ws + WS_AMIX))
#define G_OX ((bf16*)(args.ws + WS_AMIX))
#define G_H ((float*)(args.ws + WS_H))
#define G_HB ((bf16*)(args.ws + WS_HB))
#define G_PP ((bf16*)(args.ws + WS_P))
#define G_LF ((float*)(args.ws + WS_LF))
#define G_SS1 ((float*)(args.ws + CTL_SS1))
#define G_SS2 ((float*)(args.ws + CTL_SS2))

    for (int u = tid; u < (LDS_BYTES - LDS_MISC) / 4; u += NTHREADS) ((LAS unsigned*)(ldsL + LDS_MISC))[u] = 0u;
    __syncthreads();
    XcdBarrier bar; bar.bar = G_ctl + CW_BAR; bar.x = 0; bar.st = nullptr;
    if (args.one_launch) bar = xcd_barrier_post(G_ctl + CW_BAR, MISC + 8);
    const int lo = args.ph_lo, hi = args.ph_hi;
#ifndef PH_MASK
#define PH_MASK 0xff
#endif
#define IN(k) (((PH_MASK >> (k)) & 1) && lo <= (k) && (k) < hi)
#ifdef PROBE_SEL
#define STAMP(i) do { if (bx == 0 && tid == 0) { const unsigned long long t_ = __builtin_amdgcn_s_memrealtime(); MISC[32 + 2 * (i)] = (unsigned)t_; MISC[33 + 2 * (i)] = (unsigned)(t_ >> 32); } } while (0)
#else
#define STAMP(i) do { } while (0)
#endif
#define SEAM(k) do { if (IN(k) && IN((k) + 1)) xcd_barrier(bar); STAMP((k) + 1); } while (0)
#define TABLE_CHUNK(c_) do { _Pragma("unroll 1") for (int i_ = 0; i_ < 4; i_ += 2) { const int r_ = (c_) * 32 + wave * 4 + i_; const int tb_ = r_ >> 14, rr_ = r_ & (PEXP - 1); \
        const float* sp_ = (tb_ ? G_peer_v : G_peer_u) + (size_t)rr_ * DM; unsigned char* dp_ = (tb_ ? G_VB : G_UB) + (size_t)rr_ * 1536; float* scp_ = (tb_ ? G_SV : G_SU) + rr_; \
        conv_rows2_fp6(sp_, sp_ + DM, dp_, dp_ + 1536, scp_, scp_ + 1, lane); } } while (0)
    STAMP(0);
#if defined(PROBE_SEL) && PROBE_SEL >= 7
    if (bx == 0 && tid == 0) __hip_atomic_store((unsigned long long*)(G_ctl + 256), (unsigned long long)__builtin_amdgcn_s_memrealtime(), __ATOMIC_RELAXED, __HIP_MEMORY_SCOPE_AGENT);
#endif
    const int gw = vcu * NWAVES + wave, NGW = G * NWAVES;
    const int gt = vcu * NTHREADS + tid, NGT = G * NTHREADS;

    if (IN(0)) for (int rep_ = 0; rep_ < (((DUP_MASK >> 0) & 1) ? args.pad + 1 : 1); ++rep_) {
        LAS float* wf = (LAS float*)ldsL;
        LAS float* scr = (LAS float*)(ldsL + 65536 + wave * 8704);
#pragma unroll
        for (int i = 0; i < DM / NTHREADS; ++i) { const int d = tid + i * NTHREADS; const f32x4 a = *(const GAS f32x4*)(G_w_in + (size_t)d * INC + 4096), b = *(const GAS f32x4*)(G_w_in + (size_t)d * INC + 4100);
            wf[d] = a[0]; wf[DM + d] = a[1]; wf[2 * DM + d] = a[2]; wf[3 * DM + d] = a[3]; wf[4 * DM + d] = b[0]; wf[5 * DM + d] = b[1]; wf[6 * DM + d] = b[2]; wf[7 * DM + d] = b[3]; }
        __syncthreads();
        f32x4 vnx[8];
        if (gw < TOK) {
#pragma unroll
            for (int j = 0; j < 8; ++j) vnx[j] = ((const GAS f32x4*)(G_x + (size_t)gw * DM) + lane)[64 * j]; }
        for (int m = gw; m < TOK; m += NGW) {
            const GAS f32x4* gr = (const GAS f32x4*)G_mix_norm + lane;
            f32x4 v[8]; float s = 0.f;
#pragma unroll
            for (int j = 0; j < 8; ++j) v[j] = vnx[j];
            if (m + NGW < TOK) {
#pragma unroll
                for (int j = 0; j < 8; ++j) vnx[j] = ((const GAS f32x4*)(G_x + (size_t)(m + NGW) * DM) + lane)[64 * j]; }
#pragma unroll
            for (int j = 0; j < 8; ++j) s += (v[j][0] * v[j][0] + v[j][1] * v[j][1]) + (v[j][2] * v[j][2] + v[j][3] * v[j][3]);
            const float rstd = __builtin_amdgcn_rsqf(wave_sum_dpp(s) * (1.f / DM) + EPS);
            GAS v2u* o8 = (GAS v2u*)(G_XN + (size_t)m * DM) + lane;
#pragma unroll
            for (int j = 0; j < 8; ++j) { const f32x4 gg = gr[64 * j]; v[j] = v[j] * rstd * gg;
                v2u o; o.x = pk2(v[j][0], v[j][1]); o.y = pk2(v[j][2], v[j][3]); o8[64 * j] = o; }
            float fl[8];
#pragma unroll
            for (int h = 0; h < 8; ++h) { float a = 0.f;
#pragma unroll
                for (int j = 0; j < 8; ++j) { const f32x4 w = *(const LAS f32x4*)(wf + h * DM + j * 256 + lane * 4); a += (v[j][0] * w[0] + v[j][1] * w[1]) + (v[j][2] * w[2] + v[j][3] * w[3]); }
                fl[h] = wave_sum_dpp(a);
                asm volatile("" ::: "memory"); }
            if (lane < 8) { float f = fl[0];
#pragma unroll
                for (int h = 1; h < 8; ++h) f = (lane == h) ? fl[h] : f;
                f += G_b_forget[lane];
                const float ls = fminf(f, 0.f) - log1pf(expf(-fabsf(f)));
                const int b = m / SEQ, sq = m % SEQ; G_LF[(size_t)(b * FOXH + lane) * SEQ + sq] = ls; }
        }
        for (int m = gw; m < BATCH * NMEM; m += NGW) {
            const GAS f32x4* xr = (const GAS f32x4*)(G_mem + (size_t)m * DM) + lane; const GAS f32x4* gr = (const GAS f32x4*)G_mem_norm + lane;
            f32x4 v[8]; float s = 0.f;
#pragma unroll
            for (int j = 0; j < 8; ++j) { v[j] = xr[64 * j]; s += (v[j][0] * v[j][0] + v[j][1] * v[j][1]) + (v[j][2] * v[j][2] + v[j][3] * v[j][3]); }
            const float rstd = __builtin_amdgcn_rsqf(wave_sum_dpp(s) * (1.f / DM) + EPS);
            GAS v2u* o8 = (GAS v2u*)(G_MN + (size_t)m * DM) + lane;
#pragma unroll
            for (int j = 0; j < 8; ++j) { const f32x4 gg = gr[64 * j]; v[j] = v[j] * rstd * gg; v2u o; o.x = pk2(v[j][0], v[j][1]); o.y = pk2(v[j][2], v[j][3]); o8[64 * j] = o; }
        }
        {
            constexpr int I_IN = (DM / 64) * (4096 / 32), I_SQ = (DM / 64) * (DM / 32);
            constexpr int NITEMS = I_IN + 3 * I_SQ;
#define TR_SRC(it_, W_, ldw_, nblk_, r_) do { r_ = (it_); if (r_ < I_IN) { W_ = G_w_in; ldw_ = INC; nblk_ = 4096 / 32; } else { r_ -= I_IN; ldw_ = DM; nblk_ = DM / 32; \
        if (r_ < I_SQ) W_ = G_w_out; else if (r_ < 2 * I_SQ) { W_ = G_xwk; r_ -= I_SQ; } else { W_ = G_xwv; r_ -= 2 * I_SQ; } } } while (0)
            f32x4 tvn[8]; const float* Wn; int ldwn, nblkn, rn;
            if (gw < NITEMS) { TR_SRC(gw, Wn, ldwn, nblkn, rn); tr_load(Wn, ldwn, nblkn, rn, lane, tvn); }
            for (int it = gw; it < NITEMS; it += NGW) {
                f32x4 tvc[8];
#pragma unroll
                for (int i = 0; i < 8; ++i) tvc[i] = tvn[i];
                const int nblkc = nblkn, rc = rn;
                if (it + NGW < NITEMS) { TR_SRC(it + NGW, Wn, ldwn, nblkn, rn); tr_load(Wn, ldwn, nblkn, rn, lane, tvn); }
                int r = it;
                if (r < I_IN) { tr_store(tvc, nblkc, G_W_IN, nullptr, 0, DM, scr, rc, lane); continue; } r -= I_IN;
                if (r < I_SQ) { tr_store(tvc, nblkc, G_WO1, G_WO2, POOLW, DM, scr, rc, lane); continue; } r -= I_SQ;
                if (r < I_SQ) { tr_store(tvc, nblkc, G_WK, nullptr, 0, DM, scr, rc, lane); continue; }
                tr_store(tvc, nblkc, G_WV, nullptr, 0, DM, scr, rc, lane);
            }
#undef TR_SRC
        }
        for (int i0 = gt; i0 < DM * DM / 8; i0 += 2 * NGT) {
#pragma unroll
            for (int u = 0; u < 2; ++u) { const int i = i0 + u * NGT; if (i < DM * DM / 8) {
                const int d = i / (DM / 8);
                const v4u o1 = cvt8(G_peer_wq + (size_t)i * 8, G_peer_norm[d]);
                const v4u o2 = cvt8(G_xwq + (size_t)i * 8, G_xattn_norm[d]);
                *(GAS v4u*)(G_WPQ + (size_t)i * 8) = o1; *(GAS v4u*)(G_WQ + (size_t)i * 8) = o2; } }
        }
        for (int i = gt; i < DM * 256 / 8; i += NGT) {
            const int r = i >> 5, c0 = (i & 31) * 8; const int hc = r >> 7;
            v4u o3 = {0u, 0u, 0u, 0u}; if ((c0 >> 7) == (hc & 1)) o3 = cvt8(G_sub_keys + (size_t)r * 128 + (c0 & 127), 1.f);
            *(GAS v4u*)(G_AEXP + (size_t)i * 8) = o3; }
        for (int i = gt; i < 4 * 256 * 256 / 8; i += NGT) {
            const int g = i / (256 * 256 / 8), d0 = (i % 32) * 8; const float* ps = G_pool_scale + g * 256 + d0; const float* p = G_pool_w + (size_t)i * 8;
            v4u o; o.x = pk2(p[0] * ps[0], p[1] * ps[1]); o.y = pk2(p[2] * ps[2], p[3] * ps[3]); o.z = pk2(p[4] * ps[4], p[5] * ps[5]); o.w = pk2(p[6] * ps[6], p[7] * ps[7]);
            *(GAS v4u*)(G_PB + (size_t)i * 8) = o; }
        __syncthreads();
    }
    SEAM(0);

    if (IN(1)) for (int rep_ = 0; rep_ < (((DUP_MASK >> 1) & 1) ? args.pad + 1 : 1); ++rep_) {
        pg8::Gemm g{G_XN, G_W_IN, DM, DM, DM}; pg8::GSched S; S.init(TOK / 256, 4096 / 256, G, bx, DM, DM);
        pg8::EpiStoreT<true> E{G_PROJ, 4096, 0, 0, 1, nullptr, 1.f, 4, 8, 0.08838834764831845f * LOG2E, (unsigned*)G_ctl + CW_NRM};
        pg8::gemm_phase<pg8::EpiStoreT<true>, pg8::GSched, true>(ldsL, g, S, E);
    }
    SEAM(1);

    if (IN(2)) for (int rep_ = 0; rep_ < (((DUP_MASK >> 2) & 1) ? args.pad + 1 : 1); ++rep_) {
        for (int it = vcu; it < TOK / 32; it += G) {
            const int ch = (tid & 127) * 8, rsub = tid >> 7, r0 = it * 32 + rsub * 8, w = 2 << (ch >> 8);
            const int s0 = r0 % SEQ;
            float acc[8];
#pragma unroll
            for (int e = 0; e < 8; ++e) acc[e] = 0.f;
            for (int k = 1; k < w; ++k) { if (s0 - k >= 0) { const v4u v = *(const GAS v4u*)(G_PROJ + (size_t)(r0 - k) * 4096 + ch);
#pragma unroll
                    for (int e = 0; e < 4; ++e) { acc[2 * e] += __uint_as_float(v[e] << 16); acc[2 * e + 1] += __uint_as_float(v[e] & 0xffff0000u); } } }
            for (int rr = 0; rr < 8; ++rr) {
                const v4u v = *(const GAS v4u*)(G_PROJ + (size_t)(r0 + rr) * 4096 + ch); float cur[8];
#pragma unroll
                for (int e = 0; e < 4; ++e) { cur[2 * e] = __uint_as_float(v[e] << 16); cur[2 * e + 1] = __uint_as_float(v[e] & 0xffff0000u); }
                const int sp = s0 + rr; const float inv = 1.f / (float)((sp + 1 < w) ? sp + 1 : w);
                v4u o;
#pragma unroll
                for (int e = 0; e < 8; ++e) acc[e] += cur[e];
                o.x = pk2(acc[0] * inv - cur[0], acc[1] * inv - cur[1]); o.y = pk2(acc[2] * inv - cur[2], acc[3] * inv - cur[3]);
                o.z = pk2(acc[4] * inv - cur[4], acc[5] * inv - cur[5]); o.w = pk2(acc[6] * inv - cur[6], acc[7] * inv - cur[7]);
                *(GAS v4u*)(G_AMIX + (size_t)(r0 + rr) * DM + ch) = o;
                if (sp - w + 1 >= 0) { const v4u vo = *(const GAS v4u*)(G_PROJ + (size_t)(r0 + rr - w + 1) * 4096 + ch);
#pragma unroll
                    for (int e = 0; e < 4; ++e) { acc[2 * e] -= __uint_as_float(vo[e] << 16); acc[2 * e + 1] -= __uint_as_float(vo[e] & 0xffff0000u); } }
            }
        }
        const int a_bh = vcu >> 4, a_qb = vcu & 15;
        if (a_qb < 8 && vcu < 256) {
            const int e = a_qb < 2 ? a_bh * 2 + a_qb : 32 + a_bh * 6 + (a_qb - 2);
            pg8::Gemm g; pg8::EpiStore E{nullptr, DM, 0, 0, 1, nullptr, 1.f, 0, 0, 1.f, nullptr};
            int pm, pn;
            if (e < 16)      { pm = e >> 3; pn = e & 7; g = pg8::Gemm{G_MN, G_WK, DM, DM, DM}; E.O = G_KX; E.ldc = DM; }
            else if (e < 32) { const int q = e - 16; pm = q >> 3; pn = q & 7; g = pg8::Gemm{G_MN, G_WV, DM, DM, DM}; E.O = G_VXT; E.ldc = DM; }
            else if (e < 96) { const int q = e - 32; pm = q >> 3; pn = q & 7; g = pg8::Gemm{G_AEXP, G_WPQ + pm * 256, 256, 256, DM}; E.O = G_WSC; E.ldc = DM; }
            else             { const int q = e - 96; const int gg = q >> 3; pm = q & 7; pn = 0;
                               g = pg8::Gemm{G_WO1 + gg * 256, G_PB + (size_t)gg * 65536, 256, DM, 256}; E.O = G_WO2 + gg * 256; E.ldc = DM; }
            const pg8::OneSched S1{pm, pn, (long)pm * 256 * g.lda, (long)pn * 256 * g.ldb};
            pg8::gemm_phase<pg8::EpiStore, pg8::OneSched, false>(ldsL, g, S1, E);
        }
        if (vcu < 256) {
            const int b = a_bh >> 3, h = a_bh & 7;
            float* c_lds = (float*)(lds + fox::LDS_C);
            if (wave == 0) {
                const float* lf = G_LF + (size_t)a_bh * SEQ + lane * 64; float loc[64]; float run = 0.f;
#pragma unroll
                for (int i = 0; i < 16; ++i) { const f32x4 v = *(const f32x4*)(lf + 4 * i);
#pragma unroll
                    for (int e = 0; e < 4; ++e) { run += v[e]; loc[4 * i + e] = run; } }
                float incl = run;
#pragma unroll
                for (int o = 1; o < 64; o <<= 1) { const float t = __shfl_up(incl, o); if (lane >= o) incl += t; }
                const float excl = incl - run;
#pragma unroll
                for (int i = 0; i < 16; ++i) { f32x4 v;
#pragma unroll
                    for (int e = 0; e < 4; ++e) v[e] = (loc[4 * i + e] + excl) * LOG2E;
                    *(f32x4*)(c_lds + lane * 64 + 4 * i) = v; }
            }
            __syncthreads();
            const bf16* Qb = G_PROJ + (size_t)(b * SEQ) * 4096 + 1024 + h * 128;
            fox::BlockRef cur{Qb + (size_t)(a_qb * 256) * 4096, Qb + 1024, Qb + 2048, G_AMIX + (size_t)(b * SEQ + a_qb * 256) * DM + 1024 + h * 128, a_qb * 256};
            int j_lo = 0;
            { const unsigned* nq = (const unsigned*)G_ctl + CW_NRM + (b * 8 + h) * 4; const unsigned* nk = nq + 64; float B = 0.f;
#pragma unroll
              for (int c4 = 0; c4 < 4; ++c4) B += sqrtf(__uint_as_float(__hip_atomic_load(nq + c4, __ATOMIC_RELAXED, __HIP_MEMORY_SCOPE_AGENT)) * __uint_as_float(__hip_atomic_load(nk + c4, __ATOMIC_RELAXED, __HIP_MEMORY_SCOPE_AGENT)));
              const float thr = 2.05f * B + c_lds[a_qb * 256] + 150.f;
              while (j_lo < a_qb * 4 && c_lds[64 * j_lo + 63] > thr) ++j_lo; }
            fox::Seam S;
            fox::prime(cur, j_lo, (char*)lds, S);
            fox::block(cur, cur, j_lo, (char*)lds, S);
            asm volatile("s_waitcnt vmcnt(0)" ::: "memory");
            __syncthreads();
        }
        {
            constexpr int C_T = (DM / 64) * (DM / 32) / 8, NCHUNK = C_T + QSPLIT;
            LAS float* scr = (LAS float*)(ldsL + wave * 8704);
            for (;;) {
                __syncthreads();
                if (tid == 0) MISC[16] = atomicAdd(G_ctl + CW_QUEUE, 1u);
                __syncthreads();
                const int c = (int)MISC[16];
                if (c >= NCHUNK) break;
                if (c < C_T) { p0_transpose_item(G_xwo, DM, DM / 32, nullptr, G_WO, nullptr, 0, DM, scr, c * 8 + wave, lane); }
                else { TABLE_CHUNK(c - C_T); }
            }
        }
    }
    SEAM(2);

    if (IN(3)) for (int rep_ = 0; rep_ < (((DUP_MASK >> 3) & 1) ? args.pad + 1 : 1); ++rep_) {
        { pg8::Gemm g{G_AMIX, G_WO2, DM, DM, DM}; pg8::GSched S; S.init(TOK / 256, DM / 256, G, bx, DM, DM);
          pg8::EpiResid<false> E{G_x, G_HB, rep_ ? nullptr : G_SS1, 0};
          pg8::gemm_phase<pg8::EpiResid<false>, pg8::GSched, true>(ldsL, g, S, E); }
        if (bx < 64) {
            const int f = bx & 63, b = f >> 5, h = (f >> 3) & 3, t = f & 7;
            pg8::Gemm g{G_KX + (size_t)(b * NMEM) * DM + h * XD, G_WQ + h * XD, XD, DM, DM};
            pg8::EpiStore E{G_W1 + (size_t)(b * 1024 + h * 256) * DM, DM, 0, 0, 1, nullptr, 1.f, 0, 0, 1.f, nullptr};
            const pg8::OneSched S1{0, t, 0, (long)t * 256 * DM};
            pg8::gemm_phase<pg8::EpiStore, pg8::OneSched, false>(ldsL, g, S1, E);
        }
    }
    SEAM(3);

    if (IN(4)) for (int rep_ = 0; rep_ < (((DUP_MASK >> 4) & 1) ? args.pad + 1 : 1); ++rep_) {
        pg8::Gemm g{G_HB, G_W1, DM, DM, DM}; pg8::GSched S; S.init(SEQ / 256, XH, G, bx, DM, DM);
        S.nH = 1; S.nZ = BATCH; S.sAb = (long)SEQ * DM; S.sBb = (long)1024 * DM;
        pg8::EpiSoftmax E{G_PP, 1024, (long)SEQ * 1024, 0, 1, G_SS1, 0.044194173824159216f * LOG2E, SEQ};
        pg8::gemm_phase<pg8::EpiSoftmax, pg8::GSched, false>(ldsL, g, S, E);
        if (bx >= 128 && bx < 192) {
            const int f = bx & 63, b = f >> 5, h = (f >> 3) & 3, t = f & 7;
            pg8::Gemm g2{G_WO + h * XD, G_VXT + (size_t)(b * NMEM) * DM + h * XD, XD, DM, DM};
            pg8::EpiStore E2{G_W2 + (size_t)b * DM * 1024 + h * 256, 1024, 0, 0, 1, nullptr, 1.f, 0, 0, 1.f, nullptr};
            const pg8::OneSched S2{t, 0, (long)t * 256 * DM, 0};
            pg8::gemm_phase<pg8::EpiStore, pg8::OneSched, false>(ldsL, g2, S2, E2);
        }
        for (;;) {
            __syncthreads();
            if (tid == 0) MISC[16] = atomicAdd(G_ctl + CW_QUEUE2, 1u);
            __syncthreads();
            const int c = (int)MISC[16] + QSPLIT;
            if (c >= 2 * PEXP / 32) break;
            TABLE_CHUNK(c);
        }
    }
    SEAM(4);

    if (IN(5)) for (int rep_ = 0; rep_ < (((DUP_MASK >> 5) & 1) ? args.pad + 1 : 1); ++rep_) {
        pg8::Gemm g{G_PP, G_W2, 1024, 1024, 1024}; pg8::GSched S; S.init(SEQ / 256, DM / 256, G, bx, 1024, 1024);
        S.nH = 1; S.nZ = BATCH; S.sAb = (long)SEQ * 1024; S.sBb = (long)DM * 1024;
        pg8::EpiResid<true> E{G_HB, G_HB, G_SS2, SEQ};
        pg8::gemm_phase<pg8::EpiResid<true>, pg8::GSched, true>(ldsL, g, S, E);
    }
    SEAM(5);

    if (IN(6)) for (int rep_ = 0; rep_ < (((DUP_MASK >> 6) & 1) ? args.pad + 1 : 1); ++rep_) {
        pg8::Gemm g{G_WSC, G_HB, DM, DM, DM}; pg8::GSched S; S.init(DM / 256, TOK / 256, G, bx, DM, DM);
        pg8::EpiF32Col E{G_SCT, TOK, G_SS2};
        pg8::gemm_phase<pg8::EpiF32Col, pg8::GSched, true>(ldsL, g, S, E);
    }
    SEAM(6);

#if defined(PROBE_SEL) && PROBE_SEL >= 7
    if (bx == 0 && tid == 0) __hip_atomic_store((unsigned long long*)(G_ctl + 258), (unsigned long long)__builtin_amdgcn_s_memrealtime(), __ATOMIC_RELAXED, __HIP_MEMORY_SCOPE_AGENT);
#endif
    if (IN(7)) for (int rep_ = 0; rep_ < (((DUP_MASK >> 7) & 1) ? args.pad + 1 : 1); ++rep_) {
        LAS unsigned* TOP1 = (LAS unsigned*)ldsL;
        LAS unsigned* RIDX = (LAS unsigned*)(ldsL + 32768);
        LAS float* RGATE = (LAS float*)(ldsL + 49152);
        for (int blk = vcu; blk < TOK / 32; blk += G) {
            const int t0 = blk * 32;
            {
                const int tok = tid & 31, grp = tid >> 5;
                const float* sp = G_SCT + (size_t)(grp * 128) * TOK + t0 + tok;
                unsigned lst[16];
#pragma unroll
                for (int j = 0; j < 16; ++j) lst[j] = 0u;
                for (int i0 = 0; i0 < 128; i0 += 32) {
                    float v[32];
#pragma unroll
                    for (int e = 0; e < 32; ++e) v[e] = sp[(size_t)(i0 + e) * TOK];
#pragma unroll
                    for (int e = 0; e < 32; ++e) { unsigned xk = (fkey(v[e]) & ~127u) | (unsigned)(127 - (i0 + e));
#pragma unroll
                        for (int j = 0; j < 16; ++j) { const unsigned hi_ = max(lst[j], xk); xk = min(lst[j], xk); lst[j] = hi_; } }
                }
                LAS unsigned* dst = TOP1 + (tok * 16 + grp) * 16;
#pragma unroll
                for (int j = 0; j < 16; j += 4) *(LAS v4u*)(dst + j) = (v4u){lst[j], lst[j + 1], lst[j + 2], lst[j + 3]};
            }
            __syncthreads();
            if (tid < 256) {
                const int tok = tid & 31, head = tid >> 5;
                const LAS unsigned* ka = TOP1 + (tok * 16 + head * 2) * 16; const LAS unsigned* kb = ka + 16;
                float af[16], bfv[16];
#pragma unroll
                for (int j = 0; j < 16; ++j) { af[j] = fdec(ka[j] & ~127u); bfv[j] = fdec(kb[j] & ~127u); }
                unsigned best[16];
#pragma unroll
                for (int j = 0; j < 16; ++j) best[j] = 0u;
#pragma unroll
                for (int i = 0; i < 16; ++i)
#pragma unroll
                    for (int j = 0; j < 16; ++j) if ((i + 1) * (j + 1) <= 16) {
                        unsigned xk = (fkey(af[i] + bfv[j]) & ~255u) | (unsigned)(255 - (i * 16 + j));
#pragma unroll
                        for (int q = 0; q < 16; ++q) { const unsigned hi_ = max(best[q], xk); xk = min(best[q], xk); best[q] = hi_; } }
                float ev[16]; const float m0 = fdec(best[0] & ~255u); float sum = 0.f;
#pragma unroll
                for (int q = 0; q < 16; ++q) { ev[q] = __expf(fdec(best[q] & ~255u) - m0); sum += ev[q]; }
                const float inv = 1.f / sum;
#pragma unroll
                for (int q = 0; q < 16; ++q) { const unsigned code = 255u - (best[q] & 255u); const unsigned i = code >> 4, j = code & 15u;
                    const unsigned ia = 127u - (ka[i] & 127u), ib = 127u - (kb[j] & 127u);
                    RIDX[tok * 128 + head * 16 + q] = ia * 128u + ib; RGATE[tok * 128 + head * 16 + q] = ev[q] * inv; }
            }
            __syncthreads();
            {
                LAS unsigned* SIDX = (LAS unsigned*)ldsL; LAS unsigned* SGATE = (LAS unsigned*)(ldsL + 16384);
                const int tok = tid >> 4; const LAS unsigned* src = RIDX + tok * 128;
                unsigned mine[8]; unsigned rank[8];
#pragma unroll
                for (int i = 0; i < 8; ++i) { mine[i] = (src[(tid & 15) + 16 * i] << 7) | (unsigned)((tid & 15) + 16 * i); rank[i] = 0u; }
                for (int j0 = 0; j0 < 128; j0 += 4) { const v4u o4 = *(const LAS v4u*)(src + j0);
#pragma unroll
                    for (int jj = 0; jj < 4; ++jj) { const unsigned oj = ((jj == 0 ? o4.x : jj == 1 ? o4.y : jj == 2 ? o4.z : o4.w) << 7) | (unsigned)(j0 + jj);
#pragma unroll
                        for (int i = 0; i < 8; ++i) rank[i] += (oj < mine[i]) ? 1u : 0u; } }
#pragma unroll
                for (int i = 0; i < 8; ++i) mine[i] >>= 7;
#pragma unroll
                for (int i = 0; i < 8; ++i) { const unsigned pos = rank[i];
                    SIDX[tok * 128 + pos] = mine[i];
                    const float su_ = G_SU[mine[i]], gs_ = RGATE[tok * 128 + (tid & 15) + 16 * i] * G_SV[mine[i]];
                    SGATE[tok * 128 + pos] = (__float_as_uint(su_) & 0xffff0000u) | f2bf(gs_); }
            }
            __syncthreads();
            {
                const int tok0 = wave * 4; const size_t tg0 = (size_t)(t0 + tok0);
                LAS float* Wl = (LAS float*)(ldsL + 32768) + tok0 * 128;
                unsigned xn0[16], xn1[16], xn2[16], xn3[16];
#define XNLOAD(T_, XN) do { const float rs = __builtin_amdgcn_rsqf(G_SS2[tg0 + (T_)] * (1.f / DM) + EPS); \
        _Pragma("unroll") for (int q = 0; q < 8; ++q) { const size_t d0 = (size_t)q * 256 + lane * 4; \
            const v2u ha = *(const GAS v2u*)(G_HB + (tg0 + (T_)) * DM + d0); const f32x4 ga = *(const f32x4*)(G_peer_norm + d0); \
            XN[q * 2] = pk2(__uint_as_float(ha.x << 16) * rs * ga[0], __uint_as_float(ha.x & 0xffff0000u) * rs * ga[1]); XN[q * 2 + 1] = pk2(__uint_as_float(ha.y << 16) * rs * ga[2], __uint_as_float(ha.y & 0xffff0000u) * rs * ga[3]); } } while (0)
                XNLOAD(0, xn0); XNLOAD(1, xn1); XNLOAD(2, xn2); XNLOAD(3, xn3);
#undef XNLOAD
                const LAS unsigned* ridx0 = (const LAS unsigned*)ldsL + tok0 * 128; const LAS unsigned* rgs0 = (const LAS unsigned*)(ldsL + 16384) + tok0 * 128;
                const __amdgpu_buffer_rsrc_t rsT = __builtin_amdgcn_make_buffer_rsrc((void*)G_UB, 0, 64 << 20, 0x00020000);
                v4u raX0, raX1, raX2, raX3, raY0, raY1, raY2, raY3; v2u rbX0, rbX1, rbX2, rbX3, rbY0, rbY1, rbY2, rbY3;
                unsigned sgX0, sgX1, sgX2, sgX3, sgY0, sgY1, sgY2, sgY3;
#define PLDU(S, T, k) do { const unsigned ex_ = (unsigned)__builtin_amdgcn_readfirstlane((int)ridx0[(T) * 128 + (k)]); sg##S = rgs0[(T) * 128 + (k)]; \
        ra##S = __builtin_bit_cast(v4u, __builtin_amdgcn_raw_buffer_load_b128(rsT, lane * 16, ex_ * 1536u, 0)); rb##S = __builtin_bit_cast(v2u, __builtin_amdgcn_raw_buffer_load_b64(rsT, lane * 8 + 1024, ex_ * 1536u, 0)); } while (0)
#define STEP1(C, P, k, HASNEXT) do { \
        float d0_ = peer_dot(ra##C##0, rb##C##0, xn0), d1_ = peer_dot(ra##C##1, rb##C##1, xn1), d2_ = peer_dot(ra##C##2, rb##C##2, xn2), d3_ = peer_dot(ra##C##3, rb##C##3, xn3); \
        const unsigned s0_ = sg##C##0, s1_ = sg##C##1, s2_ = sg##C##2, s3_ = sg##C##3; \
        if (HASNEXT) { PLDU(P##0, 0, (k) + 1); PLDU(P##1, 1, (k) + 1); PLDU(P##2, 2, (k) + 1); PLDU(P##3, 3, (k) + 1); } \
        d0_ = wave_sum_dpp(d0_) * __uint_as_float(s0_ & 0xffff0000u); d1_ = wave_sum_dpp(d1_) * __uint_as_float(s1_ & 0xffff0000u); \
        d2_ = wave_sum_dpp(d2_) * __uint_as_float(s2_ & 0xffff0000u); d3_ = wave_sum_dpp(d3_) * __uint_as_float(s3_ & 0xffff0000u); \
        const float w0_ = gelu_f(d0_) * __uint_as_float(s0_ << 16), w1_ = gelu_f(d1_) * __uint_as_float(s1_ << 16), w2_ = gelu_f(d2_) * __uint_as_float(s2_ << 16), w3_ = gelu_f(d3_) * __uint_as_float(s3_ << 16); \
        if (lane == 0) { Wl[(k)] = w0_; Wl[128 + (k)] = w1_; Wl[256 + (k)] = w2_; Wl[384 + (k)] = w3_; } } while (0)
                PLDU(X0, 0, 0); PLDU(X1, 1, 0); PLDU(X2, 2, 0); PLDU(X3, 3, 0);
                for (int k = 0; k < 126; k += 2) { STEP1(X, Y, k, true); STEP1(Y, X, k + 1, true); }
                STEP1(X, Y, 126, true); STEP1(Y, X, 127, false);
#undef PLDU
#undef STEP1
#define PLDV(S, T, k) do { const unsigned ex_ = (unsigned)__builtin_amdgcn_readfirstlane((int)ridx0[(T) * 128 + (k)]); \
        ra##S = __builtin_bit_cast(v4u, __builtin_amdgcn_raw_buffer_load_b128(rsT, lane * 16, ex_ * 1536u + (32u << 20), 0)); rb##S = __builtin_bit_cast(v2u, __builtin_amdgcn_raw_buffer_load_b64(rsT, lane * 8 + 1024, ex_ * 1536u + (32u << 20), 0)); } while (0)
#define STEP2(C, P, TA, k, HASNEXT) do { asm volatile("" ::: "memory"); \
        if (HASNEXT) { PLDV(P##0, TA, (k) + 1); PLDV(P##1, (TA) + 1, (k) + 1); } \
        const float w0_ = Wl[(TA) * 128 + (k)], w1_ = Wl[((TA) + 1) * 128 + (k)]; \
        peer_axpy(ra##C##0, rb##C##0, w0_, oaccA); __builtin_amdgcn_sched_barrier(0); peer_axpy(ra##C##1, rb##C##1, w1_, oaccB); } while (0)
                for (int tt = 0; tt < 4; tt += 2) {
                    float oaccA[32], oaccB[32];
#pragma unroll
                    for (int e = 0; e < 32; ++e) { oaccA[e] = 0.f; oaccB[e] = 0.f; }
                    PLDV(X0, tt, 0); PLDV(X1, tt + 1, 0);
                    for (int k = 0; k < 126; k += 2) { STEP2(X, Y, tt, k, true); STEP2(Y, X, tt, k + 1, true); }
                    STEP2(X, Y, tt, 126, true); STEP2(Y, X, tt, 127, false);
#define FINISH(T_, OACC) do { float s_ = 0.f; \
        _Pragma("unroll") for (int q = 0; q < 8; ++q) { const size_t d0 = (size_t)q * 256 + lane * 4; const v2u hb = *(const GAS v2u*)(G_HB + (T_) * DM + d0); \
            const f32x4 a = {__uint_as_float(hb.x << 16), __uint_as_float(hb.x & 0xffff0000u), __uint_as_float(hb.y << 16), __uint_as_float(hb.y & 0xffff0000u)}; \
            _Pragma("unroll") for (int e = 0; e < 4; ++e) { const float y = a[e] + OACC[q * 4 + e]; OACC[q * 4 + e] = y; s_ += y * y; } } \
        const float rstd_ = __builtin_amdgcn_rsqf(wave_sum_dpp(s_) * (1.f / DM) + EPS); \
        _Pragma("unroll") for (int q = 0; q < 8; ++q) { const size_t d0 = (size_t)q * 256 + lane * 4; const f32x4 ga = *(const f32x4*)(G_final_norm + d0); f32x4 o; \
            _Pragma("unroll") for (int e = 0; e < 4; ++e) o[e] = OACC[q * 4 + e] * rstd_ * ga[e]; \
            PROBE_EXPORT(T_, q); \
            *(f32x4*)(args.out + (T_) * DM + d0) = o; } } while (0)
                    FINISH(tg0 + tt, oaccA); FINISH(tg0 + tt + 1, oaccB);
                }
#undef FINISH
#undef PLDV
#undef STEP2
            }
            __syncthreads();
#if defined(PROBE_SEL) && PROBE_SEL >= 7
            asm volatile("s_waitcnt vmcnt(0)" ::: "memory"); __syncthreads();
            if (tid == 0) { __threadfence(); const unsigned old_ = atomicAdd(G_ctl + 192, 1u);
                if (old_ == (unsigned)G - 1u) { __threadfence(); const unsigned long long a_ = __hip_atomic_load((unsigned long long*)(G_ctl + 256 + 2 * (PROBE_SEL - 7)), __ATOMIC_RELAXED, __HIP_MEMORY_SCOPE_AGENT), b_ = __builtin_amdgcn_s_memrealtime();
                    atomicAdd(args.out + (size_t)31 * DM, (float)(b_ - a_) * 0.0001f); } }
#endif
        }
    }
#undef IN
#undef SEAM
#undef G_ws
#undef G_ctl
#undef G_x
#undef G_mem
#undef G_mix_norm
#undef G_w_in
#undef G_b_forget
#undef G_pool_w
#undef G_pool_scale
#undef G_w_out
#undef G_xattn_norm
#undef G_mem_norm
#undef G_xwq
#undef G_xwk
#undef G_xwv
#undef G_xwo
#undef G_peer_norm
#undef G_peer_wq
#undef G_sub_keys
#undef G_peer_u
#undef G_peer_v
#undef G_final_norm
#undef G_W_IN
#undef G_WO1
#undef G_WO2
#undef G_WQ
#undef G_WK
#undef G_WV
#undef G_WO
#undef G_WPQ
#undef G_AEXP
#undef G_W1
#undef G_W2
#undef G_WSC
#undef G_PB
#undef G_MN
#undef G_KX
#undef G_VXT
#undef G_UB
#undef G_VB
#undef G_SU
#undef G_SV
#undef G_XN
#undef G_QX
#undef G_PROJ
#undef G_SCT
#undef G_AMIX
#undef G_OX
#undef G_H
#undef G_HB
#undef G_PP
#undef G_LF
#undef G_SS1
#undef G_SS2

}

constexpr int N_PHASES = 8;
extern "C" void kernel_launch(void* const* d_in, const int* in_sizes, int n_in, void* d_out, int out_size, void* d_ws, size_t ws_size, hipStream_t stream) {
    static int grid = 0;
    if (grid == 0) {
        if (n_in != 20 || in_sizes[0] != TOK * DM || out_size != TOK * DM || ws_size < WS_END) {
            fprintf(stderr, "kernel_launch: unexpected shapes (n_in %d, in0 %d, out %d, ws %zu < %zu)\n", n_in, n_in > 0 ? in_sizes[0] : -1, out_size, ws_size, (size_t)WS_END); grid = -1; return; }
        int dev = 0, cus = 0, per_cu = 0;
        if (hipGetDevice(&dev) != hipSuccess || hipDeviceGetAttribute(&cus, hipDeviceAttributeMultiprocessorCount, dev) != hipSuccess) { grid = -1; return; }
        if (hipFuncSetAttribute((const void*)fwd_kernel, hipFuncAttributeMaxDynamicSharedMemorySize, LDS_BYTES) != hipSuccess) { fprintf(stderr, "kernel_launch: hipFuncSetAttribute failed\n"); grid = -1; return; }
        if (hipOccupancyMaxActiveBlocksPerMultiprocessor(&per_cu, (const void*)fwd_kernel, NTHREADS, LDS_BYTES) != hipSuccess || per_cu < 1) { fprintf(stderr, "kernel_launch: occupancy query says %d\n", per_cu); per_cu = 1; }
        (void)hipGetLastError();
        grid = cus;
        if (grid != 256) fprintf(stderr, "kernel_launch: %d CUs (built for 256)\n", grid);
    }
    if (grid < 0) return;
    (void)hipMemsetAsync((char*)d_ws + WS_CTL, 0, CTL_ZERO_BYTES, stream);
    Args a{};
    for (int i = 0; i < 20; ++i) a.in[i] = (const float*)d_in[i];
    a.out = (float*)d_out; a.ws = (unsigned char*)d_ws; a.pad = DUP_MASK ? 1 : 0;
#if MK_ONE_LAUNCH
    a.ph_lo = 0; a.ph_hi = N_PHASES; a.one_launch = 1;
    void* kargs[] = {&a};
    hipError_t e = hipLaunchCooperativeKernel((const void*)fwd_kernel, dim3(grid), dim3(NTHREADS), kargs, LDS_BYTES, stream);
    if (e != hipSuccess) fprintf(stderr, "kernel_launch: cooperative launch failed: %s\n", hipGetErrorString(e));
#else
    for (int p = 0; p < N_PHASES; ++p) {
        a.ph_lo = p; a.ph_hi = p + 1; a.one_launch = 0;
        hipLaunchKernelGGL(fwd_kernel, dim3(grid), dim3(NTHREADS), LDS_BYTES, stream, a);
    }
#endif
}
```

```cpp
#include <hip/hip_runtime.h>
#include <hip/hip_bf16.h>
#include <cstdio>
#include <cstdint>

#ifndef DUP_MASK
#define DUP_MASK 0
#endif
#ifndef MK_ONE_LAUNCH
#define MK_ONE_LAUNCH 1
#endif

constexpr int BATCH = 2, SEQ = 4096, DM = 2048, TOK = BATCH * SEQ;
constexpr int INC = 4104, POOLW = 1024, FOXH = 8, FOXD = 128;
constexpr int NMEM = 256, XH = 4, XD = 512;
constexpr int PH = 8, PKEYS = 128, PEXP = 16384, TOPK = 16;
constexpr float EPS = 1e-6f;
constexpr float LOG2E = 1.4426950408889634f;

namespace pg8 {
#define PG8_LAS __attribute__((address_space(3)))
typedef unsigned short bf16_t;
typedef short bf16x8 __attribute__((ext_vector_type(8)));
typedef float f32x4 __attribute__((ext_vector_type(4)));
typedef float f32x2 __attribute__((ext_vector_type(2)));
typedef unsigned u32x4 __attribute__((ext_vector_type(4)));
typedef unsigned u32x2 __attribute__((ext_vector_type(2)));
constexpr int BM = 256, BK = 64, HALF = 128, HTB = HALF * BK * 2, STAGE_BYTES = 8 * HTB, NXCD = 8, WGM = 8;

__host__ __device__ __forceinline__ int lds_byte(int r, int c) { const int st = (r >> 4) * 2 + (c >> 5), rr = r & 15, cc = c & 31, ob = rr * 64 + cc * 2; return st * 1024 + (ob ^ (((ob >> 9) & 1) << 5)); }
__host__ __device__ __forceinline__ void stage_rc(int b, int& R, int& C) { const int st = b / 1024, sb = b % 1024, swz = sb ^ (((sb >> 9) & 1) << 5); R = (st >> 1) * 16 + swz / 64; C = (st & 1) * 32 + (swz % 64) / 2; }
__host__ __device__ __forceinline__ int perm32(int rho) { const int n = rho >> 4, i = rho & 15; return 8 * (i >> 2) + 4 * n + (i & 3); }

struct Unit { int pm, pn, z; long aoff, boff; };
struct Gemm { const bf16_t* A; const bf16_t* Bt; int K, lda, ldb; };

struct GSched {
    int nM, nN, nH, nZ, G, c; long sAb, sAh, sBb, sBh; int lda, ldb;
    __device__ __forceinline__ void init(int nM_, int nN_, int G_, int c_, int lda_, int ldb_) { nM = nM_; nN = nN_; nH = 1; nZ = 1; G = G_; c = c_; sAb = sAh = sBb = sBh = 0; lda = lda_; ldb = ldb_; }
    __device__ __forceinline__ bool next(int i, Unit& u) const {
        const long L = (long)i * G + c; const int nwg = nM * nN; if (L >= (long)nwg * nZ) return false;
        const int z = (int)(L / nwg); int wgid = (int)(L % nwg);
        { const int q = nwg / NXCD, r = nwg % NXCD, xcd = wgid % NXCD, off = wgid / NXCD; wgid = (xcd < r ? xcd * (q + 1) : r * (q + 1) + (xcd - r) * q) + off; }
        const int nig = WGM * nN, gid = wgid / nig, fm = gid * WGM, gsz = (nM - fm) < WGM ? (nM - fm) : WGM;
        u.pm = fm + ((wgid % nig) % gsz); u.pn = (wgid % nig) / gsz; u.z = z;
        const int zb = z / nH, zh = z % nH;
        u.aoff = zb * sAb + zh * sAh + (long)u.pm * BM * lda; u.boff = zb * sBb + zh * sBh + (long)u.pn * BM * ldb;
        return true;
    }
    __device__ __forceinline__ void a_ready(const Unit&) const {}
    __device__ __forceinline__ void done(const Unit&) const {}
};

struct OneSched { int pm, pn; long ao, bo;
    __device__ __forceinline__ bool next(int i, Unit& u) const { if (i) return false; u.pm = pm; u.pn = pn; u.z = 0; u.aoff = ao; u.boff = bo; return true; }
    __device__ __forceinline__ void a_ready(const Unit&) const {}
    __device__ __forceinline__ void done(const Unit&) const {} };
__device__ __forceinline__ unsigned cvt_pk_bf16(float lo, float hi) { unsigned r; asm volatile("v_cvt_pk_bf16_f32 %0, %1, %2" : "=v"(r) : "v"(lo), "v"(hi)); return r; }


template <bool NRM> struct EpiStoreT {
    static constexpr bool PERM = true, AFTER_DRAIN = false;
    bf16_t* O; int ldc; long sCb, sCh; int nH;
    const float* ss; float rs_mul;
    int t0, t1; float tscale;
    unsigned* nrm;
    __device__ __forceinline__ void operator()(const f32x4 (&acc)[2][2][4][2], const Unit& u, int wr, int wc, int fr, int fq) const {
        const int row0 = u.pm * BM + wr * 64 + fr, col0 = u.pn * BM + wc * 32 + 8 * fq;
        bf16_t* base = O + (u.z / nH) * sCb + (u.z % nH) * sCh;
        const float ts = (u.pn >= t0 && u.pn < t1) ? tscale : 1.f;
        float mx0 = 0.f, mx1 = 0.f;
#pragma unroll
        for (int ai = 0; ai < 2; ++ai)
#pragma unroll
            for (int m = 0; m < 4; ++m) { const int row = row0 + ai * HALF + m * 16;
                float sc = ts; if (ss) sc *= __builtin_amdgcn_rsqf(ss[row] * (1.f / DM) + EPS) * rs_mul;
                bf16_t* rowp = base + (size_t)row * ldc + col0;
#pragma unroll
                for (int bj = 0; bj < 2; ++bj) { const f32x4 v0 = acc[ai][bj][m][0] * sc, v1 = acc[ai][bj][m][1] * sc;
                    u32x4 w; w.x = cvt_pk_bf16(v0[0], v0[1]); w.y = cvt_pk_bf16(v0[2], v0[3]); w.z = cvt_pk_bf16(v1[0], v1[1]); w.w = cvt_pk_bf16(v1[2], v1[3]);
                    *(u32x4*)(rowp + bj * HALF) = w;
                    if constexpr (NRM) { float q = (v0[0] * v0[0] + v0[1] * v0[1]) + (v0[2] * v0[2] + v0[3] * v0[3]) + (v1[0] * v1[0] + v1[1] * v1[1]) + (v1[2] * v1[2] + v1[3] * v1[3]);
                        q += __shfl_xor(q, 16); q += __shfl_xor(q, 32); if (bj == 0) mx0 = fmaxf(mx0, q); else mx1 = fmaxf(mx1, q); } } }
        if constexpr (NRM) { if (u.pn >= 4 && u.pn < 12) {
#pragma unroll
            for (int o = 1; o < 16; o <<= 1) { mx0 = fmaxf(mx0, __shfl_xor(mx0, o)); mx1 = fmaxf(mx1, __shfl_xor(mx1, o)); }
            if ((threadIdx.x & 63) == 0) { const int kind = u.pn >= 8, b = u.pm >> 4, h2 = ((u.pn - 4) & 3) * 2; unsigned* p = nrm + ((kind * 2 + b) * 8 + h2) * 4 + wc;
                atomicMax(p, __float_as_uint(mx0)); atomicMax(p + 4, __float_as_uint(mx1)); } } }
    }
};
typedef EpiStoreT<false> EpiStore;
template <bool BASE_BF16> struct EpiResid {
    static constexpr bool PERM = true, AFTER_DRAIN = false;
    const void* base; bf16_t* HB; float* ss; int zrows;
    __device__ __forceinline__ void operator()(const f32x4 (&acc)[2][2][4][2], const Unit& u, int wr, int wc, int fr, int fq) const {
        const int row0 = u.z * zrows + u.pm * BM + wr * 64 + fr, col0 = u.pn * BM + wc * 32 + 8 * fq;
#pragma unroll
        for (int ai = 0; ai < 2; ++ai)
#pragma unroll
            for (int m = 0; m < 4; ++m) { const int row = row0 + ai * HALF + m * 16; const size_t off = (size_t)row * DM + col0; float sq = 0.f;
#pragma unroll
                for (int bj = 0; bj < 2; ++bj) {
                    f32x4 b0, b1;
                    if constexpr (BASE_BF16) { const u32x4 r = *(const u32x4*)((const bf16_t*)base + off + bj * HALF);
                        b0 = (f32x4){__uint_as_float(r.x << 16), __uint_as_float(r.x & 0xffff0000u), __uint_as_float(r.y << 16), __uint_as_float(r.y & 0xffff0000u)};
                        b1 = (f32x4){__uint_as_float(r.z << 16), __uint_as_float(r.z & 0xffff0000u), __uint_as_float(r.w << 16), __uint_as_float(r.w & 0xffff0000u)}; }
                    else { b0 = *(const f32x4*)((const float*)base + off + bj * HALF); b1 = *(const f32x4*)((const float*)base + off + bj * HALF + 4); }
                    const f32x4 h0 = b0 + acc[ai][bj][m][0], h1 = b1 + acc[ai][bj][m][1];
                    u32x4 w; w.x = cvt_pk_bf16(h0[0], h0[1]); w.y = cvt_pk_bf16(h0[2], h0[3]); w.z = cvt_pk_bf16(h1[0], h1[1]); w.w = cvt_pk_bf16(h1[2], h1[3]);
                    *(u32x4*)(HB + off + bj * HALF) = w;
                    sq += (h0[0] * h0[0] + h0[1] * h0[1]) + (h0[2] * h0[2] + h0[3] * h0[3]) + (h1[0] * h1[0] + h1[1] * h1[1]) + (h1[2] * h1[2] + h1[3] * h1[3]); }
                sq += __shfl_xor(sq, 16); sq += __shfl_xor(sq, 32);
                if (fq == 0 && ss) atomicAdd(ss + row, sq); }
    }
};
struct EpiF32Col {
    static constexpr bool PERM = true, AFTER_DRAIN = false;
    float* O; int ldc; const float* ss;
    __device__ __forceinline__ void operator()(const f32x4 (&acc)[2][2][4][2], const Unit& u, int wr, int wc, int fr, int fq) const {
        const int row0 = u.pm * BM + wr * 64 + fr, col0 = u.pn * BM + wc * 32 + 8 * fq;
        f32x4 rs[2][2];
#pragma unroll
        for (int bj = 0; bj < 2; ++bj)
#pragma unroll
            for (int n = 0; n < 2; ++n) { const f32x4 s = *(const f32x4*)(ss + col0 + bj * HALF + 4 * n);
#pragma unroll
                for (int e = 0; e < 4; ++e) rs[bj][n][e] = __builtin_amdgcn_rsqf(s[e] * (1.f / DM) + EPS); }
#pragma unroll
        for (int ai = 0; ai < 2; ++ai)
#pragma unroll
            for (int m = 0; m < 4; ++m) { float* rowp = O + (size_t)(row0 + ai * HALF + m * 16) * ldc + col0;
#pragma unroll
                for (int bj = 0; bj < 2; ++bj) { *(f32x4*)(rowp + bj * HALF) = acc[ai][bj][m][0] * rs[bj][0]; *(f32x4*)(rowp + bj * HALF + 4) = acc[ai][bj][m][1] * rs[bj][1]; } }
    }
};
struct EpiSoftmax {
    static constexpr bool PERM = true, AFTER_DRAIN = true;
    bf16_t* P; int ldc; long sCb, sCh; int nH; const float* ss; float mul; int zrows;
    __device__ __forceinline__ void fused(f32x4 (&acc)[2][2][4][2], const Unit& u, int wr, int wc, int fr, int fq, PG8_LAS unsigned char* lds, int wid, int lane) const {
        PG8_LAS float* Pm = (PG8_LAS float*)lds;
        PG8_LAS float* Ps = (PG8_LAS float*)(lds + 4096);
#pragma unroll
        for (int ai = 0; ai < 2; ++ai)
#pragma unroll
            for (int m = 0; m < 4; ++m) { float mx = -3.0e38f;
                const float rs = __builtin_amdgcn_rsqf(ss[u.z * zrows + u.pm * BM + ai * HALF + wr * 64 + m * 16 + fr] * (1.f / DM) + EPS) * mul;
#pragma unroll
                for (int bj = 0; bj < 2; ++bj)
#pragma unroll
                    for (int n = 0; n < 2; ++n) { const f32x4 x = acc[ai][bj][m][n] * rs; acc[ai][bj][m][n] = x; mx = fmaxf(mx, fmaxf(fmaxf(x[0], x[1]), fmaxf(x[2], x[3]))); }
                mx = fmaxf(mx, __shfl_xor(mx, 16)); mx = fmaxf(mx, __shfl_xor(mx, 32));
                if (fq == 0) Pm[(ai * HALF + wr * 64 + m * 16 + fr) * 4 + wc] = mx; }
        asm volatile("s_waitcnt lgkmcnt(0)" ::: "memory"); __builtin_amdgcn_s_barrier(); asm volatile("" ::: "memory");
#pragma unroll
        for (int ai = 0; ai < 2; ++ai)
#pragma unroll
            for (int m = 0; m < 4; ++m) { const int r = ai * HALF + wr * 64 + m * 16 + fr;
                const f32x4 pm4 = *(const PG8_LAS f32x4*)(Pm + r * 4); const float M = fmaxf(fmaxf(pm4[0], pm4[1]), fmaxf(pm4[2], pm4[3])); float s = 0.f;
#pragma unroll
                for (int bj = 0; bj < 2; ++bj)
#pragma unroll
                    for (int n = 0; n < 2; ++n) { f32x4 x = acc[ai][bj][m][n];
#pragma unroll
                        for (int e = 0; e < 4; ++e) { x[e] = __builtin_amdgcn_exp2f(x[e] - M); s += x[e]; }
                        acc[ai][bj][m][n] = x; }
                s += __shfl_xor(s, 16); s += __shfl_xor(s, 32);
                if (fq == 0) Ps[r * 4 + wc] = s; }
        asm volatile("s_waitcnt lgkmcnt(0)" ::: "memory"); __builtin_amdgcn_s_barrier(); asm volatile("" ::: "memory");
        bf16_t* base = P + (u.z / nH) * sCb + (u.z % nH) * sCh;
        const int row0 = u.pm * BM, col0 = u.pn * BM + wc * 32 + 8 * fq;
#pragma unroll
        for (int ai = 0; ai < 2; ++ai)
#pragma unroll
            for (int m = 0; m < 4; ++m) { const int r = ai * HALF + wr * 64 + m * 16 + fr;
                const f32x4 ps4 = *(const PG8_LAS f32x4*)(Ps + r * 4); const float inv = 1.f / ((ps4[0] + ps4[1]) + (ps4[2] + ps4[3]));
                bf16_t* rowp = base + (size_t)(row0 + r) * ldc + col0;
#pragma unroll
                for (int bj = 0; bj < 2; ++bj) { const f32x4 v0 = acc[ai][bj][m][0] * inv, v1 = acc[ai][bj][m][1] * inv;
                    u32x4 w; w.x = cvt_pk_bf16(v0[0], v0[1]); w.y = cvt_pk_bf16(v0[2], v0[3]); w.z = cvt_pk_bf16(v1[0], v1[1]); w.w = cvt_pk_bf16(v1[2], v1[3]);
                    *(u32x4*)(rowp + bj * HALF) = w; } }
    }
};

template <class Epi, class Sched, bool ALIGN_EPI>
__device__ __forceinline__ void gemm_phase(PG8_LAS unsigned char* lds, const Gemm g, const Sched& S, const Epi& E) {
    const int tid = threadIdx.x, wid = __builtin_amdgcn_readfirstlane(tid >> 6), lane = tid & 63, wr = wid >> 2, wc = wid & 3, fr = lane & 15, fq = lane >> 4;
    const int K = g.K, nt = K / BK;
    unsigned voffA[2], voffB[2];
#pragma unroll
    for (int i = 0; i < 2; ++i) { int R, C; stage_rc(tid * 16 + i * 8192, R, C); const int Rb = Epi::PERM ? ((R & ~31) + perm32(R & 31)) : R;
        voffA[i] = (unsigned)(R * g.lda + C) * 2u; voffB[i] = (unsigned)(Rb * g.ldb + C) * 2u; }
    const size_t kstep = (size_t)(BK * 2);
    const size_t hsA = (size_t)HALF * g.lda * 2, hsB = (size_t)HALF * g.ldb * 2;
    const unsigned ldsw = (unsigned)wid * 1024u;
    const int aoff = lds_byte(wr * 64 + fr, fq * 8), boff = lds_byte(wc * 32 + fr, fq * 8);
#define PG8_SA(b, h) (((b) * 2 + (h)) * HTB)
#define PG8_SB(b, h) ((4 + (b) * 2 + (h)) * HTB)
#define PG8_STAGE(bufoff, gbase, voff) do { _Pragma("unroll") for (int _i = 0; _i < 2; ++_i) \
        __builtin_amdgcn_global_load_lds((const unsigned*)((const char*)(gbase) + (voff)[_i]), (PG8_LAS unsigned*)(lds + (bufoff) + ldsw + _i * 8192), 16, 0, 0); } while (0)
#define PG8_LDA(dst, b, h) do { _Pragma("unroll") for (int m = 0; m < 4; ++m) _Pragma("unroll") for (int k = 0; k < 2; ++k) dst[m][k] = *(const PG8_LAS bf16x8*)(lds + PG8_SA(b, h) + aoff + m * 2048 + k * 1024); } while (0)
#define PG8_LDB(dst, b, h) do { _Pragma("unroll") for (int n = 0; n < 2; ++n) _Pragma("unroll") for (int k = 0; k < 2; ++k) dst[n][k] = *(const PG8_LAS bf16x8*)(lds + PG8_SB(b, h) + boff + n * 2048 + k * 1024); } while (0)
#define PG8_MMA(ai, bj, At, Bt) do { __builtin_amdgcn_s_setprio(1); _Pragma("unroll") for (int m = 0; m < 4; ++m) _Pragma("unroll") for (int n = 0; n < 2; ++n) _Pragma("unroll") for (int k = 0; k < 2; ++k) \
        acc[ai][bj][m][n] = __builtin_amdgcn_mfma_f32_16x16x32_bf16(Bt[n][k], At[m][k], acc[ai][bj][m][n], 0, 0, 0); __builtin_amdgcn_s_setprio(0); } while (0)
#define PG8_WAIT_V(n) asm volatile("s_waitcnt vmcnt(" #n ")" ::: "memory")
#define PG8_WAIT_L(n) asm volatile("s_waitcnt lgkmcnt(" #n ")" ::: "memory")
#define PG8_BAR __builtin_amdgcn_s_barrier()
#define PG8_SCHED __builtin_amdgcn_sched_barrier(0)
    Unit cur, nxt; int ui = 0;
    if (!S.next(0, cur)) return;
    f32x4 acc[2][2][4][2];
#pragma unroll
    for (int a = 0; a < 2; ++a)
#pragma unroll
        for (int b = 0; b < 2; ++b)
#pragma unroll
            for (int m = 0; m < 4; ++m)
#pragma unroll
                for (int n = 0; n < 2; ++n) acc[a][b][m][n] = (f32x4){0.f, 0.f, 0.f, 0.f};
    bf16x8 At[4][2], B0[2][2], B1[2][2];
    const char* cA = (const char*)g.A + (size_t)cur.aoff * 2; const char* cB = (const char*)g.Bt + (size_t)cur.boff * 2;
    S.a_ready(cur);
    PG8_STAGE(PG8_SB(0, 0), cB, voffB); PG8_STAGE(PG8_SB(0, 1), cB + hsB, voffB); PG8_STAGE(PG8_SA(0, 0), cA, voffA); PG8_STAGE(PG8_SA(0, 1), cA + hsA, voffA);
    if (wr == 1) PG8_BAR;
    PG8_WAIT_V(2); PG8_BAR;
    PG8_STAGE(PG8_SB(1, 0), cB + kstep, voffB); PG8_STAGE(PG8_SA(1, 0), cA + kstep, voffA); PG8_STAGE(PG8_SB(1, 1), cB + hsB + kstep, voffB);
    PG8_WAIT_V(6); PG8_BAR;
    for (;;) {
        const bool has_next = S.next(ui + 1, nxt);
        const char* nA = has_next ? (const char*)g.A + (size_t)nxt.aoff * 2 : cA; const char* nB = has_next ? (const char*)g.Bt + (size_t)nxt.boff * 2 : cB;
        for (int t = 0; t < nt; t += 2) {
            const bool last = (t == nt - 2);
            const char* a1 = cA + (size_t)(t + 1) * kstep;
            const char* a2 = last ? nA : cA + (size_t)(t + 2) * kstep; const char* b2 = last ? nB : cB + (size_t)(t + 2) * kstep;
            const char* a3 = a2 + kstep; const char* b3 = b2 + kstep;
            if (last && has_next) S.a_ready(nxt);
            PG8_LDB(B0, 0, 0); PG8_LDB(B1, 0, 1); PG8_SCHED; PG8_LDA(At, 0, 0); PG8_STAGE(PG8_SA(1, 1), a1 + hsA, voffA);
            PG8_WAIT_V(8); PG8_WAIT_L(0); PG8_BAR; PG8_MMA(0, 0, At, B0); PG8_MMA(0, 1, At, B1); PG8_BAR; PG8_SCHED;
            PG8_LDA(At, 0, 1); PG8_STAGE(PG8_SB(0, 0), b2, voffB); PG8_STAGE(PG8_SB(0, 1), b2 + hsB, voffB); PG8_STAGE(PG8_SA(0, 0), a2, voffA);
            PG8_WAIT_V(8); PG8_WAIT_L(0); PG8_BAR; PG8_MMA(1, 0, At, B0); PG8_MMA(1, 1, At, B1); PG8_BAR; PG8_SCHED;
            PG8_LDB(B0, 1, 0); PG8_LDB(B1, 1, 1); PG8_SCHED; PG8_LDA(At, 1, 0); PG8_STAGE(PG8_SA(0, 1), a2 + hsA, voffA);
            PG8_WAIT_V(8); PG8_WAIT_L(0); PG8_BAR; PG8_MMA(0, 0, At, B0); PG8_MMA(0, 1, At, B1); PG8_BAR; PG8_SCHED;
            PG8_LDA(At, 1, 1); PG8_STAGE(PG8_SB(1, 0), b3, voffB); PG8_STAGE(PG8_SB(1, 1), b3 + hsB, voffB); PG8_STAGE(PG8_SA(1, 0), a3, voffA);
            PG8_WAIT_V(8); PG8_WAIT_L(0); PG8_BAR; PG8_MMA(1, 0, At, B0); PG8_MMA(1, 1, At, B1); PG8_BAR; PG8_SCHED;
        }
        if constexpr (ALIGN_EPI) { if (wr == 0) PG8_BAR; }
        if constexpr (!Epi::AFTER_DRAIN) { E(acc, cur, wr, wc, fr, fq); S.done(cur); }
        if (!has_next) break;
#pragma unroll
        for (int a = 0; a < 2; ++a)
#pragma unroll
            for (int b = 0; b < 2; ++b)
#pragma unroll
                for (int m = 0; m < 4; ++m)
#pragma unroll
                    for (int n = 0; n < 2; ++n) acc[a][b][m][n] = (f32x4){0.f, 0.f, 0.f, 0.f};
        cur = nxt; cA = nA; cB = nB; ++ui;
        if constexpr (ALIGN_EPI) { if (wr == 1) PG8_BAR; }
    }
    PG8_WAIT_V(0);
    if constexpr (!ALIGN_EPI) { if (wr == 0) PG8_BAR; }
    PG8_BAR;
    if constexpr (Epi::AFTER_DRAIN) { E.fused(acc, cur, wr, wc, fr, fq, lds, wid, lane); S.done(cur); }
#undef PG8_SA
#undef PG8_SB
#undef PG8_STAGE
#undef PG8_LDA
#undef PG8_LDB
#undef PG8_MMA
#undef PG8_WAIT_V
#undef PG8_WAIT_L
#undef PG8_BAR
#undef PG8_SCHED
}
}

namespace fox {
typedef unsigned short bf16_t;
typedef short bf16x8 __attribute__((ext_vector_type(8)));
typedef short s16x4 __attribute__((ext_vector_type(4)));
typedef float f32x16 __attribute__((ext_vector_type(16)));
typedef float f32x4 __attribute__((ext_vector_type(4)));
typedef unsigned u32x4 __attribute__((ext_vector_type(4)));
constexpr int D = 128, NW = 8, QBLK = 32, KVBLK = 64, QB = NW * QBLK;
constexpr int SHM_V = KVBLK * D * 2, SHM_K = KVBLK * D * 2;
constexpr int LDS_C = 2 * SHM_V + 2 * SHM_K + NW * 64 * 4;
constexpr int LDS_BYTES = LDS_C + SEQ * 4;
constexpr int QP = 4096, OP = 2048;
constexpr float THR = 24.f;
#define KSWZ(row, colB) ((row) * 256 + ((colB) ^ (((row) & 7) << 4)))
#define SBAR() __builtin_amdgcn_sched_barrier(0)
__device__ __forceinline__ int v_st(int k, int c) { const int kk = (k & ~0xC) | ((k & 4) << 1) | ((k & 8) >> 1); return ((kk >> 3) * 4 + (c >> 5)) * 512 + ((kk & 7) * 32 + (c & 31)) * 2; }
__device__ __forceinline__ int v_rd_base(int lane) { return ((lane & 3) << 3) | (((lane >> 2) & 3) << 6) | (((lane >> 4) & 1) << 5) | (((lane >> 5) & 1) << 8); }
constexpr int v_rd_off(int d0, int ks, int half) { return d0 * 512 + ks * 4096 + half * 2048; }
__device__ __forceinline__ int crow(int r, int hi) { return (r & 3) + 8 * (r >> 2) + 4 * hi; }
__device__ __forceinline__ unsigned cvtpk(float lo, float hi) { unsigned r; asm volatile("v_cvt_pk_bf16_f32 %0, %1, %2" : "=v"(r) : "v"(lo), "v"(hi)); return r; }
__device__ __forceinline__ bf16x8 load8(const bf16_t* p) { return *reinterpret_cast<const bf16x8*>(p); }
__device__ __forceinline__ void mask_tile(f32x16& p0, f32x16& p1, int dq) {
    const float NEG = -__builtin_inff();
#pragma unroll
    for (int r = 0; r < 16; ++r) { const int c = (r & 3) + 8 * (r >> 2); if (dq - c < 0) p0[r] = NEG; if (dq - c - 32 < 0) p1[r] = NEG; }
}
__device__ __forceinline__ void bias_tile(f32x16& p0, f32x16& p1, const float* cb) {
#pragma unroll
    for (int i = 0; i < 4; ++i) { const f32x4 c0 = *(const f32x4*)(cb + 8 * i), c1 = *(const f32x4*)(cb + 32 + 8 * i);
#pragma unroll
        for (int j = 0; j < 4; ++j) { p0[4 * i + j] -= c0[j]; p1[4 * i + j] -= c1[j]; } }
}
__device__ __forceinline__ void partialSM(f32x16& p0, f32x16& p1, float& m_reg, float& mn, float& alpha) {
    float pmax = p0[0]; for (int r = 1; r < 16; ++r) pmax = fmaxf(pmax, p0[r]); for (int r = 0; r < 16; ++r) pmax = fmaxf(pmax, p1[r]);
    { auto rr = __builtin_amdgcn_permlane32_swap(__float_as_uint(pmax), __float_as_uint(pmax), false, false);
      pmax = fmaxf(__uint_as_float(rr[0]), __uint_as_float(rr[1])); }
    if (__builtin_expect(__all((pmax - m_reg) <= THR), 1)) { mn = m_reg; alpha = 1.f; }
    else { mn = fmaxf(m_reg, pmax); alpha = __builtin_amdgcn_exp2f(m_reg - mn); m_reg = mn; }
    for (int r = 0; r < 16; ++r) p0[r] = p0[r] - mn; for (int r = 0; r < 16; ++r) p1[r] = p1[r] - mn;
    for (int r = 0; r < 16; ++r) p0[r] = __builtin_amdgcn_exp2f(p0[r]);
}
__device__ __forceinline__ void finishSM(f32x16& p0, f32x16& p1, float alpha, float& l_reg, bf16x8& pa0, bf16x8& pa1, bf16x8& pa2, bf16x8& pa3) {
    for (int r = 0; r < 16; ++r) p1[r] = __builtin_amdgcn_exp2f(p1[r]);
    float ps = 0; for (int r = 0; r < 16; ++r) ps += p0[r]; for (int r = 0; r < 16; ++r) ps += p1[r];
    { auto rr = __builtin_amdgcn_permlane32_swap(__float_as_uint(ps), __float_as_uint(ps), false, false);
      ps = __uint_as_float(rr[0]) + __uint_as_float(rr[1]); }
    l_reg = l_reg * alpha + ps;
#define PK4(P, B_, OUT) do { unsigned a0 = cvtpk(P[B_+0], P[B_+1]), a1 = cvtpk(P[B_+2], P[B_+3]);                          \
        unsigned b0 = cvtpk(P[B_+4], P[B_+5]), b1 = cvtpk(P[B_+6], P[B_+7]);                                             \
        auto r0 = __builtin_amdgcn_permlane32_swap(a0, b0, false, false); auto r1 = __builtin_amdgcn_permlane32_swap(a1, b1, false, false); \
        u32x4 w = {r0[0], r1[0], r0[1], r1[1]}; OUT = *reinterpret_cast<bf16x8*>(&w); } while (0)
    PK4(p0, 0, pa0); PK4(p0, 8, pa1); PK4(p1, 0, pa2); PK4(p1, 8, pa3);
#undef PK4
}
template <int KB>
__device__ __forceinline__ void qkt(f32x16& p0, f32x16& p1, const char* K_lds, int r32, int hi, const bf16x8* qr) {
    p0 = f32x16{}; p1 = f32x16{};
    const char* kb[4];
#pragma unroll
    for (int dd = 0; dd < 4; ++dd) kb[dd] = K_lds + KB * SHM_K + KSWZ(r32, (dd * 16 + hi * 8) * 2);
#pragma unroll
    for (int d0 = 0; d0 < 8; ++d0) { const char* a = kb[d0 & 3] + (d0 >> 2) * 128;
        bf16x8 b0 = *reinterpret_cast<const bf16x8*>(a);
        bf16x8 b1 = *reinterpret_cast<const bf16x8*>(a + 32 * 256);
        p0 = __builtin_amdgcn_mfma_f32_32x32x16_bf16(b0, qr[d0], p0, 0, 0, 0);
        p1 = __builtin_amdgcn_mfma_f32_32x32x16_bf16(b1, qr[d0], p1, 0, 0, 0); }
}
template <int VB>
__device__ __forceinline__ void pv_tile(f32x16* o, int vb0, bf16x8 pa0, bf16x8 pa1, bf16x8 pa2, bf16x8 pa3) {
#define TRRD(dst, off) asm volatile("ds_read_b64_tr_b16 %0, %1 offset:%2" : "=&v"(dst) : "v"(vb0), "i"(off) : "memory")
#define PV_D0(d0) do { s16x4 l0, l1, l2, l3, h0, h1, h2, h3; constexpr int b_ = VB * SHM_V + v_rd_off(d0, 0, 0); \
        TRRD(l0, b_); TRRD(h0, b_ + 2048); TRRD(l1, b_ + 4096); TRRD(h1, b_ + 6144); TRRD(l2, b_ + 8192); TRRD(h2, b_ + 10240); TRRD(l3, b_ + 12288); TRRD(h3, b_ + 14336); \
        asm volatile("s_waitcnt lgkmcnt(0)" ::: "memory"); SBAR();   \
        o[d0] = __builtin_amdgcn_mfma_f32_32x32x16_bf16(pa0, (bf16x8){l0[0], l0[1], l0[2], l0[3], h0[0], h0[1], h0[2], h0[3]}, o[d0], 0, 0, 0);   \
        o[d0] = __builtin_amdgcn_mfma_f32_32x32x16_bf16(pa1, (bf16x8){l1[0], l1[1], l1[2], l1[3], h1[0], h1[1], h1[2], h1[3]}, o[d0], 0, 0, 0);   \
        o[d0] = __builtin_amdgcn_mfma_f32_32x32x16_bf16(pa2, (bf16x8){l2[0], l2[1], l2[2], l2[3], h2[0], h2[1], h2[2], h2[3]}, o[d0], 0, 0, 0);   \
        o[d0] = __builtin_amdgcn_mfma_f32_32x32x16_bf16(pa3, (bf16x8){l3[0], l3[1], l3[2], l3[3], h3[0], h3[1], h3[2], h3[3]}, o[d0], 0, 0, 0); } while (0)
    PV_D0(0); PV_D0(1); PV_D0(2); PV_D0(3);
#undef PV_D0
#undef TRRD
}
struct BlockRef { const bf16_t* Q; const bf16_t* K; const bf16_t* V; bf16_t* O; int P0; };
struct Seam { bf16x8 qr[8]; bf16x8 st_v0, st_v1, st_k0, st_k1; };
#define ROW(p, k0, rr) ((p) + (size_t)((k0) + (rr)) * QP + sc)
#define VMW() asm volatile("s_waitcnt vmcnt(0)" ::: "memory")
#define VMWN(n) asm volatile("s_waitcnt vmcnt(%0)" :: "i"(n) : "memory")
#define SLOAD_H(Kp, Vp, k0) do { S.st_v0 = load8(ROW(Vp, k0, sr)); S.st_v1 = load8(ROW(Vp, k0, 32 + sr)); S.st_k0 = load8(ROW(Kp, k0, sr)); S.st_k1 = load8(ROW(Kp, k0, 32 + sr)); } while (0)
#define SWRITE_HK(bf) do { *(bf16x8*)(K_lds + (bf) * SHM_K + kws) = S.st_k0; *(bf16x8*)(K_lds + (bf) * SHM_K + kws + 32 * 256) = S.st_k1; } while (0)
#define SWRITE_HV(bf) do { *(bf16x8*)(V_lds + (bf) * SHM_V + vst0) = S.st_v0; *(bf16x8*)(V_lds + (bf) * SHM_V + vst1) = S.st_v1; } while (0)
#define SWRITE_H(bf) do { SWRITE_HV(bf); SWRITE_HK(bf); } while (0)
__device__ __forceinline__ void prime(const BlockRef& cur, int j_lo, char* lds, Seam& S) {
    const int tid = threadIdx.x, wid = __builtin_amdgcn_readfirstlane(tid >> 6), lane = tid & 63, r32 = lane & 31, hi = lane >> 5;
    const int sr = tid >> 4, sc = (tid & 15) * 8, kws = KSWZ(sr, sc * 2); char* K_lds = lds + 2 * SHM_V;
    for (int d0 = 0; d0 < 8; ++d0) S.qr[d0] = load8(cur.Q + (size_t)(wid * QBLK + r32) * QP + d0 * 16 + hi * 8);
    SLOAD_H(cur.K, cur.V, j_lo * KVBLK); VMW(); SWRITE_HK(0);
    __syncthreads();
}
__device__ __forceinline__ void block(const BlockRef& cur, const BlockRef& nxt, int j_lo, char* lds, Seam& S) {
    const int tid = threadIdx.x, wid = __builtin_amdgcn_readfirstlane(tid >> 6), lane = tid & 63, r32 = lane & 31, hi = lane >> 5;
    const int NT = (cur.P0 + QB - 1) / KVBLK + 1 - j_lo;
    const int qlo = cur.P0 + wid * QBLK, qm = qlo + r32 - 4 * hi;
    char* V_lds = lds; char* K_lds = lds + 2 * SHM_V;
    float* ws = (float*)(lds + 2 * SHM_V + 2 * SHM_K) + wid * 64; float* li_l = ws, * al_l = ws + 32;
    const float* c_lds = (const float*)(lds + LDS_C) + 4 * hi;
    float m_reg = -1e30f, l_reg = 0; f32x16 o[4] = {};
    const int sr = tid >> 4, sc = (tid & 15) * 8, vst0 = v_st(sr, sc), vst1 = v_st(32 + sr, sc), kws = KSWZ(sr, sc * 2);
    const int vb0 = (int)(uintptr_t)V_lds + v_rd_base(lane);
    const bf16_t* Kh = cur.K; const bf16_t* Vh = cur.V;
#define RESC(a) do { if (__any((a) < 1.f)) { if (hi == 0) al_l[r32] = (a); asm volatile("s_waitcnt lgkmcnt(0)" ::: "memory");              \
                     for (int d_ = 0; d_ < 4; ++d_) for (int r = 0; r < 16; ++r) o[d_][r] *= al_l[crow(r, hi)]; } } while (0)
#define KBASE(t) ((j_lo + (t)) * KVBLK)
#define MASKT(P0_, P1_, t) do { const int kb_ = KBASE(t); bias_tile(P0_, P1_, c_lds + kb_); if (kb_ + KVBLK - 1 > qlo) mask_tile(P0_, P1_, qm - kb_); } while (0)
#define SEAM_K0() do { VMWN(8); SWRITE_HK(0); SBAR(); } while (0)
    f32x16 pA0, pA1, pB0, pB1; float mnA, mnB, alA, alB; bf16x8 pa0, pa1, pa2, pa3;
    SWRITE_HV(0); SBAR();
    if (NT > 1) { SLOAD_H(Kh, Vh, KBASE(1)); }
    SBAR(); qkt<0>(pA0, pA1, K_lds, r32, hi, S.qr);
    MASKT(pA0, pA1, 0); partialSM(pA0, pA1, m_reg, mnA, alA);
    if (NT > 1) { VMW(); SWRITE_H(1); }
    __syncthreads();
#define HALF_STEP(PX0, PX1, mnX, alX, PY0, PY1, alY, t, KB, VB, SB) do {                                                      \
        SBAR(); qkt<KB>(PX0, PX1, K_lds, r32, hi, S.qr);                                                                     \
        finishSM(PY0, PY1, alY, l_reg, pa0, pa1, pa2, pa3); SBAR();                                                           \
        if ((t) + 1 < NT) { SLOAD_H(Kh, Vh, KBASE((t) + 1)); SBAR(); }                                                        \
        pv_tile<VB>(o, vb0, pa0, pa1, pa2, pa3); MASKT(PX0, PX1, (t)); partialSM(PX0, PX1, m_reg, mnX, alX);                 \
        __syncthreads();                                                                                                      \
        if ((t) + 1 < NT) { VMW(); SWRITE_H(SB); }                                                                            \
        RESC(alX); __syncthreads(); } while (0)
    for (int t = 1; t + 1 < NT; t += 2) {
        HALF_STEP(pB0, pB1, mnB, alB, pA0, pA1, alA, t, 1, 0, 0);
        HALF_STEP(pA0, pA1, mnA, alA, pB0, pB1, alB, t + 1, 0, 1, 1);
    }
    const bool even = (NT & 1) == 0;
    if (even) { SBAR(); qkt<1>(pB0, pB1, K_lds, r32, hi, S.qr); SBAR(); }
    SLOAD_H(nxt.K, nxt.V, j_lo * KVBLK); SBAR();
#pragma unroll
    for (int d0 = 0; d0 < 8; ++d0) S.qr[d0] = load8(nxt.Q + (size_t)(wid * QBLK + r32) * QP + d0 * 16 + hi * 8);
    SBAR();
    finishSM(pA0, pA1, alA, l_reg, pa0, pa1, pa2, pa3); SBAR();
    pv_tile<0>(o, vb0, pa0, pa1, pa2, pa3);
    if (even) { MASKT(pB0, pB1, NT - 1); partialSM(pB0, pB1, m_reg, mnB, alB); __syncthreads(); RESC(alB);
        finishSM(pB0, pB1, alB, l_reg, pa0, pa1, pa2, pa3); SBAR(); pv_tile<1>(o, vb0, pa0, pa1, pa2, pa3); }
    SBAR(); SEAM_K0();
    if (hi == 0) li_l[r32] = l_reg; asm volatile("s_waitcnt lgkmcnt(0)" ::: "memory");
    float rli[16];
#pragma unroll
    for (int r = 0; r < 16; ++r) rli[r] = __builtin_amdgcn_rcpf(li_l[crow(r, hi)]);
    bf16_t* Ow = cur.O + (size_t)(wid * QBLK) * OP;
#pragma unroll
    for (int r = 0; r < 16; ++r) { const int orow = crow(r, hi);
#pragma unroll
        for (int d0 = 0; d0 < 4; ++d0) { const float v = o[d0][r] * rli[r];
            const float vn = __shfl_xor(v, 1);
            if ((r32 & 1) == 0) *(unsigned*)(Ow + (size_t)orow * OP + d0 * 32 + r32) = cvtpk(v, vn); } }
    __syncthreads();
#undef RESC
#undef KBASE
#undef MASKT
#undef SEAM_K0
#undef HALF_STEP
}
#undef ROW
#undef VMW
#undef VMWN
#undef SLOAD_H
#undef SWRITE_HK
#undef SWRITE_HV
#undef SWRITE_H
#undef KSWZ
#undef SBAR
}

constexpr int NWAVES = 8, NTHREADS = 512;
constexpr int LDS_BYTES = 147456;
constexpr int LDS_MISC = 145408;
constexpr size_t MiB = 1u << 20;
constexpr size_t WS_CTL = 0, CTL_ZERO_BYTES = 1 * MiB;
#ifndef QSPLIT
#define QSPLIT 1024
#endif
constexpr int CW_QUEUE2 = 128;
constexpr int CW_NRM = 512;
constexpr int CW_QUEUE = 64;
constexpr int CW_BAR = 4096;
constexpr size_t CTL_SS1 = 256 * 1024, CTL_SS2 = 320 * 1024;
constexpr size_t WS_LF = 1 * MiB;
constexpr size_t WS_SU = 1 * MiB + 512 * 1024, WS_SV = 1 * MiB + 640 * 1024;
constexpr size_t WS_WIN = 2 * MiB, WS_WO1 = 18 * MiB, WS_WO2 = 26 * MiB, WS_WQ = 34 * MiB, WS_WK = 42 * MiB, WS_WV = 50 * MiB, WS_WO = 58 * MiB;
constexpr size_t WS_WPQ = 66 * MiB, WS_AEXP = 74 * MiB, WS_WSC = 82 * MiB, WS_PB = 90 * MiB, WS_MN = 91 * MiB, WS_KX = 93 * MiB, WS_VXT = 95 * MiB;
constexpr size_t WS_UB = 98 * MiB, WS_VB = 130 * MiB, WS_XN = 226 * MiB, WS_PROJ = 258 * MiB, WS_AMIX = 322 * MiB, WS_H = 354 * MiB, WS_HB = 418 * MiB, WS_P = 450 * MiB, WS_END = 466 * MiB;

#define GAS __attribute__((address_space(1)))
#define LAS __attribute__((address_space(3)))
typedef unsigned short bf16;
typedef unsigned v4u __attribute__((ext_vector_type(4)));
typedef unsigned v2u __attribute__((ext_vector_type(2)));
typedef float f32x4 __attribute__((ext_vector_type(4)));
typedef __bf16 bf16x2_t __attribute__((ext_vector_type(2)));
#define LDS_WAIT() asm volatile("s_waitcnt lgkmcnt(0)" ::: "memory")
__device__ __forceinline__ unsigned f2bf(float f) { unsigned u = __builtin_bit_cast(unsigned, f); return (u + 0x7fffu + ((u >> 16) & 1u)) >> 16; }
__device__ __forceinline__ unsigned pk2(float lo, float hi) { return f2bf(lo) | (f2bf(hi) << 16); }
__device__ __forceinline__ float wave_sum(float v) {
#pragma unroll
    for (int o = 1; o < 64; o <<= 1) v += __shfl_xor(v, o);
    return v;
}

#define XB_TMO      128
#define XB_XCNT(j)  (256  + 64 * (j))
#define XB_XSUB(j)  (1280 + 64 * (j))
#define XB_XGEN(j)  (2304 + 64 * (j))
#define XB_TOP      3328
#define XB_TOPGEN   3392
#define XCD_BAR_WORDS 3456
#define XB_SPIN_CAP (1u << 22)
__device__ __forceinline__ unsigned xb_ld(unsigned* p)              { return __hip_atomic_load(p, __ATOMIC_RELAXED, __HIP_MEMORY_SCOPE_AGENT); }
__device__ __forceinline__ unsigned xb_add(unsigned* p, unsigned v) { return __hip_atomic_fetch_add(p, v, __ATOMIC_RELAXED, __HIP_MEMORY_SCOPE_AGENT); }
__device__ __forceinline__ unsigned xb_xcc_id() { return (unsigned)__builtin_amdgcn_s_getreg((3 << 11) | 20) & 0xFu; }
#define XB_SPIN(cond, bar) do { unsigned _sp = 0; while (cond) { __builtin_amdgcn_s_sleep(1); \
    if ((++_sp & 255u) == 0u) { if (xb_ld(&(bar)[XB_TMO])) break; if (_sp > XB_SPIN_CAP) { atomicAdd(&(bar)[XB_TMO], 1u); break; } } } } while (0)
struct XcdBarrier { unsigned* bar; unsigned x; volatile LAS unsigned* st; };
__device__ __forceinline__ XcdBarrier xcd_barrier_post(unsigned* bar, volatile LAS unsigned* st) {
    XcdBarrier b; b.bar = bar; b.x = xb_xcc_id(); b.st = st;
    if (threadIdx.x == 0) (void)xb_add(&bar[XB_XCNT(b.x)], 1u);
    return b;
}
__device__ __forceinline__ void xcd_barrier_complete(unsigned* bar, unsigned x, unsigned& nloc, unsigned& nx) {
    const unsigned G = gridDim.x * gridDim.y * gridDim.z;
    unsigned sum, cnt, mine, sp = 0u;
    for (;;) {
        sum = 0u; cnt = 0u; mine = 0u;
#pragma unroll
        for (unsigned j = 0; j < 16; ++j) { const unsigned c = xb_ld(&bar[XB_XCNT(j)]); sum += c; cnt += (c > 0u) ? 1u : 0u; mine = (j == x) ? c : mine; }
        if (sum == G) break;
        __builtin_amdgcn_s_sleep(1);
        if ((++sp & 255u) == 0u) { if (xb_ld(&bar[XB_TMO])) break; if (sp > XB_SPIN_CAP) { atomicAdd(&bar[XB_TMO], 1u); break; } }
    }
    nloc = mine > 0u ? mine : 1u; nx = cnt > 0u ? cnt : 1u;
}
__device__ __forceinline__ void xcd_barrier(const XcdBarrier& b) {
    asm volatile("s_waitcnt vmcnt(0)" ::: "memory");
    __syncthreads();
    if (threadIdx.x == 0) {
        unsigned* bar = b.bar;
        __builtin_amdgcn_s_waitcnt(0);
        unsigned nloc = b.st[0], nx = b.st[1];
        if (nloc == 0u) { xcd_barrier_complete(bar, b.x, nloc, nx); b.st[0] = nloc; b.st[1] = nx; }
        const unsigned old = xb_add(&bar[XB_XSUB(b.x)], 1u);
        const unsigned gen = old / nloc;
        if (old + 1u == (gen + 1u) * nloc) {
            __builtin_amdgcn_fence(__ATOMIC_RELEASE, "agent");
            asm volatile("s_waitcnt vmcnt(0)" ::: "memory");
            const unsigned og = xb_add(&bar[XB_TOP], 1u);
            const unsigned tg = og / nx;
            if (og + 1u == (tg + 1u) * nx) xb_add(&bar[XB_TOPGEN], 1u);
            else XB_SPIN(xb_ld(&bar[XB_TOPGEN]) == tg, bar);
            __builtin_amdgcn_fence(__ATOMIC_ACQUIRE, "agent");
            xb_add(&bar[XB_XGEN(b.x)], 1u);
            asm volatile("s_waitcnt vmcnt(0)" ::: "memory");
        } else {
            XB_SPIN(xb_ld(&bar[XB_XGEN(b.x)]) == gen, bar);
            __builtin_amdgcn_fence(__ATOMIC_ACQUIRE, "agent");
            asm volatile("s_waitcnt vmcnt(0)" ::: "memory");
        }
    }
    __syncthreads();
}

struct Args { const float* in[20]; float* out; unsigned char* ws; int ph_lo, ph_hi; int one_launch, pad; };

__device__ __forceinline__ void tr_load(const float* W, int ldw, int nblk, int item, int lane, f32x4 (&tv)[8]) {
    const int kb = item / nblk, nb = item % nblk, k0 = 64 * kb, n0 = 32 * nb;
#pragma unroll
    for (int i = 0; i < 8; ++i) tv[i] = *(const GAS f32x4*)(W + (size_t)(k0 + i * 8 + (lane >> 3)) * ldw + n0 + (lane & 7) * 4);
}
__device__ __forceinline__ void tr_store(const f32x4 (&tv)[8], int nblk, bf16* WT, bf16* WT2, int k2lo, int ldt, LAS float* scr, int item, int lane) {
    const int kb = item / nblk, nb = item % nblk, k0 = 64 * kb, n0 = 32 * nb;
#pragma unroll
    for (int i = 0; i < 8; ++i) { const int kk = i * 8 + (lane >> 3); LAS float* d = scr + kk * 33 + (lane & 7) * 4; d[0] = tv[i][0]; d[1] = tv[i][1]; d[2] = tv[i][2]; d[3] = tv[i][3]; }
    LDS_WAIT(); asm volatile("" ::: "memory");
    const int c = lane & 7;
#pragma unroll
    for (int j = 0; j < 4; ++j) { const int n = (lane >> 3) + 8 * j; const LAS float* s = scr + (8 * c) * 33 + n;
        v4u o; o.x = pk2(s[0 * 33], s[1 * 33]); o.y = pk2(s[2 * 33], s[3 * 33]); o.z = pk2(s[4 * 33], s[5 * 33]); o.w = pk2(s[6 * 33], s[7 * 33]);
        *(GAS v4u*)(WT + (size_t)(n0 + n) * ldt + k0 + 8 * c) = o;
        if (WT2 && k0 >= k2lo) *(GAS v4u*)(WT2 + (size_t)(n0 + n) * ldt + k0 + 8 * c) = o; }
    LDS_WAIT(); asm volatile("" ::: "memory");
}
__device__ __forceinline__ void p0_transpose_item(const float* W, int ldw, int nblk, const float* g, bf16* WT, bf16* WT2, int k2lo, int ldt, LAS float* scr, int item, int lane) {
    (void)g; f32x4 tv[8]; tr_load(W, ldw, nblk, item, lane, tv); tr_store(tv, nblk, WT, WT2, k2lo, ldt, scr, item, lane);
}
__device__ __forceinline__ v4u cvt8(const float* p, float s) {
    const f32x4 a = *(const f32x4*)p, b = *(const f32x4*)(p + 4);
    v4u o; o.x = pk2(a[0] * s, a[1] * s); o.y = pk2(a[2] * s, a[3] * s); o.z = pk2(b[0] * s, b[1] * s); o.w = pk2(b[2] * s, b[3] * s); return o;
}

__device__ __forceinline__ float gelu_f(float v) {
    const float av = fabsf(v), t = __builtin_amdgcn_rcpf(av * 0.2316418882f + 1.0f);
    float q = t * 0.5307027145f + (-0.7265760135f); q = q * t + 0.7107068705f; q = q * t + (-0.142248368f); q = q * t + 0.127414796f; q = q * t;
    const float e = __builtin_amdgcn_exp2f((v * v) * (-0.72134752044f));
    const float m = v * (q * e);
    return v < 0.f ? m : v - m;
}
__device__ __forceinline__ float dot2bf(unsigned a, unsigned b, float c) { return __builtin_amdgcn_fdot2_f32_bf16(__builtin_bit_cast(bf16x2_t, a), __builtin_bit_cast(bf16x2_t, b), c, false); }
__device__ __forceinline__ unsigned fkey(float f) { const unsigned u = __float_as_uint(f); return (u & 0x80000000u) ? ~u : (u | 0x80000000u); }
__device__ __forceinline__ float fdec(unsigned k) { const unsigned u = (k & 0x80000000u) ? (k & 0x7fffffffu) : ~k; return __uint_as_float(u); }


typedef float f32x2v __attribute__((ext_vector_type(2)));
__device__ __forceinline__ float wave_sum_dpp(float v) {
    v += __builtin_bit_cast(float, __builtin_amdgcn_update_dpp(0, __builtin_bit_cast(int, v), 0xB1, 0xf, 0xf, true));
    v += __builtin_bit_cast(float, __builtin_amdgcn_update_dpp(0, __builtin_bit_cast(int, v), 0x4E, 0xf, 0xf, true));
    v += __builtin_bit_cast(float, __builtin_amdgcn_update_dpp(0, __builtin_bit_cast(int, v), 0x141, 0xf, 0xf, true));
    v += __builtin_bit_cast(float, __builtin_amdgcn_update_dpp(0, __builtin_bit_cast(int, v), 0x140, 0xf, 0xf, true));
    const float a = __builtin_bit_cast(float, __builtin_amdgcn_readlane(__builtin_bit_cast(int, v), 0));
    const float b = __builtin_bit_cast(float, __builtin_amdgcn_readlane(__builtin_bit_cast(int, v), 16));
    const float c = __builtin_bit_cast(float, __builtin_amdgcn_readlane(__builtin_bit_cast(int, v), 32));
    const float d = __builtin_bit_cast(float, __builtin_amdgcn_readlane(__builtin_bit_cast(int, v), 48));
    return (a + b) + (c + d);
}
typedef float v32f __attribute__((ext_vector_type(32)));
typedef float v16f __attribute__((ext_vector_type(16)));
typedef unsigned v6u __attribute__((ext_vector_type(6)));
#ifndef FP6_INTERLEAVED
#define FP6_INTERLEAVED 1
#endif
__device__ __forceinline__ v32f dec_fp6(const v4u a, const v2u b) { const v6u w = {a.x, a.y, a.z, a.w, b.x, b.y}; return __builtin_amdgcn_cvt_scalef32_pk32_f32_fp6(w, 1.0f); }
typedef __bf16 v32bf __attribute__((ext_vector_type(32)));
typedef unsigned v16u __attribute__((ext_vector_type(16)));
__device__ __forceinline__ float peer_dot(const v4u ua, const v2u ub, const unsigned (&xnp)[16]) {
    const v6u w = {ua.x, ua.y, ua.z, ua.w, ub.x, ub.y};
    const v16u fu = __builtin_bit_cast(v16u, __builtin_amdgcn_cvt_scalef32_pk32_bf16_fp6(w, 1.0f));
    unsigned fa[16];
#pragma unroll
    for (int i = 0; i < 16; ++i) fa[i] = fu[i];
    float a[4] = {0.f, 0.f, 0.f, 0.f};
#pragma unroll
    for (int i = 0; i < 16; ++i) a[i & 3] = dot2bf(fa[i], xnp[i], a[i & 3]);
    return (a[0] + a[1]) + (a[2] + a[3]);
}
__device__ __forceinline__ float peer_dot_lds(const v4u ua, const v2u ub, const LAS v4u* xl) {
    const v6u w = {ua.x, ua.y, ua.z, ua.w, ub.x, ub.y};
    const v16u fu = __builtin_bit_cast(v16u, __builtin_amdgcn_cvt_scalef32_pk32_bf16_fp6(w, 1.0f));
    unsigned fa[16];
#pragma unroll
    for (int i = 0; i < 16; ++i) fa[i] = fu[i];
    float a[4] = {0.f, 0.f, 0.f, 0.f};
#pragma unroll
    for (int i4 = 0; i4 < 4; ++i4) { const v4u x4 = xl[i4 * 64];
        a[0] = dot2bf(fa[i4 * 4 + 0], x4.x, a[0]); a[1] = dot2bf(fa[i4 * 4 + 1], x4.y, a[1]); a[2] = dot2bf(fa[i4 * 4 + 2], x4.z, a[2]); a[3] = dot2bf(fa[i4 * 4 + 3], x4.w, a[3]); }
    return (a[0] + a[1]) + (a[2] + a[3]);
}
__device__ __forceinline__ void peer_axpy(const v4u va, const v2u vb, float w, float (&oacc)[32]) {
    const v32f f = dec_fp6(va, vb);
#pragma unroll
    for (int i = 0; i < 32; ++i) oacc[i] = fmaf(w, f[i], oacc[i]);
}


__device__ __forceinline__ void conv_rows2_fp6(const float* srow0, const float* srow1, unsigned char* drow0, unsigned char* drow1, float* sc0, float* sc1, int lane) {
    f32x4 v[2][8]; float am[2] = {0.f, 0.f};
#pragma unroll
    for (int q = 0; q < 8; ++q) { v[0][q] = *(const GAS f32x4*)(srow0 + lane * 4 + q * 256); v[1][q] = *(const GAS f32x4*)(srow1 + lane * 4 + q * 256); }
#pragma unroll
    for (int r = 0; r < 2; ++r)
#pragma unroll
        for (int q = 0; q < 8; ++q) am[r] = fmaxf(am[r], fmaxf(fmaxf(fabsf(v[r][q][0]), fabsf(v[r][q][1])), fmaxf(fabsf(v[r][q][2]), fabsf(v[r][q][3]))));
#pragma unroll
    for (int o = 1; o < 64; o <<= 1) { am[0] = fmaxf(am[0], __shfl_xor(am[0], o)); am[1] = fmaxf(am[1], __shfl_xor(am[1], o)); }
#pragma unroll
    for (int r = 0; r < 2; ++r) {
        int ex = 0; if (am[r] > 0.f) { (void)frexpf(am[r], &ex); ex = 3 - ex; if (ldexpf(am[r], ex) > 7.5f) ex -= 1; }
        const float sc = ldexpf(1.f, ex);
        if (lane == 0) *(r ? sc1 : sc0) = ldexpf(1.f, -ex);
        v16f xa, xb;
#pragma unroll
        for (int i = 0; i < 16; ++i) { xa[i] = v[r][(2 * i) >> 2][(2 * i) & 3] * sc; xb[i] = v[r][(2 * i + 1) >> 2][(2 * i + 1) & 3] * sc; }
        const v6u w = __builtin_amdgcn_cvt_scalef32_2xpk16_fp6_f32(xa, xb, 1.0f);
        unsigned char* drow = r ? drow1 : drow0;
        *(GAS v4u*)(drow + lane * 16) = (v4u){w[0], w[1], w[2], w[3]};
        *(GAS v2u*)(drow + 1024 + lane * 8) = (v2u){w[4], w[5]};
    }
}

#if defined(PROBE_SEL) && PROBE_SEL < 7
#define PROBE_EXPORT(T_, q) do { if ((T_) == 0 && lane == 0 && (q) == 0) { const unsigned long long a_ = ((unsigned long long)MISC[33 + 2 * PROBE_SEL] << 32) | MISC[32 + 2 * PROBE_SEL], b_ = ((unsigned long long)MISC[35 + 2 * PROBE_SEL] << 32) | MISC[34 + 2 * PROBE_SEL]; o[0] += (float)(b_ - a_) * 0.001f; } } while (0)
#else
#define PROBE_EXPORT(T_, q) do { } while (0)
#endif
__global__ void __launch_bounds__(NTHREADS, 2) fwd_kernel(Args args) {
    extern __shared__ __attribute__((aligned(16))) unsigned char lds[];
    LAS unsigned char* ldsL = (LAS unsigned char*)lds;
    volatile LAS unsigned* MISC = (volatile LAS unsigned*)(ldsL + LDS_MISC);
    const int tid = threadIdx.x, lane = tid & 63, wave = __builtin_amdgcn_readfirstlane(tid >> 6);
    const int G = gridDim.x; const int bx = blockIdx.x; const int vcu = (G % 8 == 0) ? (bx % 8) * (G / 8) + bx / 8 : bx;
#define G_ws (args.ws)
#define G_ctl ((unsigned*)(args.ws + WS_CTL))
#define G_x (args.in[0])
#define G_mem (args.in[1])
#define G_mix_norm (args.in[2])
#define G_w_in (args.in[3])
#define G_b_forget (args.in[4])
#define G_pool_w (args.in[5])
#define G_pool_scale (args.in[6])
#define G_w_out (args.in[7])
#define G_xattn_norm (args.in[8])
#define G_mem_norm (args.in[9])
#define G_xwq (args.in[10])
#define G_xwk (args.in[11])
#define G_xwv (args.in[12])
#define G_xwo (args.in[13])
#define G_peer_norm (args.in[14])
#define G_peer_wq (args.in[15])
#define G_sub_keys (args.in[16])
#define G_peer_u (args.in[17])
#define G_peer_v (args.in[18])
#define G_final_norm (args.in[19])
#define G_W_IN ((bf16*)(args.ws + WS_WIN))
#define G_WO1 ((bf16*)(args.ws + WS_WO1))
#define G_WO2 ((bf16*)(args.ws + WS_WO2))
#define G_WQ ((bf16*)(args.ws + WS_WQ))
#define G_WK ((bf16*)(args.ws + WS_WK))
#define G_WV ((bf16*)(args.ws + WS_WV))
#define G_WO ((bf16*)(args.ws + WS_WO))
#define G_WPQ ((bf16*)(args.ws + WS_WPQ))
#define G_AEXP ((bf16*)(args.ws + WS_AEXP))
#define G_W1 ((bf16*)(args.ws + WS_AEXP))
#define G_W2 ((bf16*)(args.ws + WS_WPQ))
#define G_WSC ((bf16*)(args.ws + WS_WSC))
#define G_PB ((bf16*)(args.ws + WS_PB))
#define G_MN ((bf16*)(args.ws + WS_MN))
#define G_KX ((bf16*)(args.ws + WS_KX))
#define G_VXT ((bf16*)(args.ws + WS_VXT))
#define G_UB (args.ws + WS_UB)
#define G_VB (args.ws + WS_VB)
#define G_SU ((float*)(args.ws + WS_SU))
#define G_SV ((float*)(args.ws + WS_SV))
#define G_XN ((bf16*)(args.ws + WS_XN))
#define G_QX ((bf16*)(args.ws + WS_XN))
#define G_PROJ ((bf16*)(args.ws + WS_PROJ))
#define G_SCT ((float*)(args.ws + WS_PROJ))
#define G_AMIX ((bf16*)(args.ws + WS_AMIX))
#define G_OX ((bf16*)(args.ws + WS_AMIX))
#define G_H ((float*)(args.ws + WS_H))
#define G_HB ((bf16*)(args.ws + WS_HB))
#define G_PP ((bf16*)(args.ws + WS_P))
#define G_LF ((float*)(args.ws + WS_LF))
#define G_SS1 ((float*)(args.ws + CTL_SS1))
#define G_SS2 ((float*)(args.ws + CTL_SS2))

    for (int u = tid; u < (LDS_BYTES - LDS_MISC) / 4; u += NTHREADS) ((LAS unsigned*)(ldsL + LDS_MISC))[u] = 0u;
    __syncthreads();
    XcdBarrier bar; bar.bar = G_ctl + CW_BAR; bar.x = 0; bar.st = nullptr;
    if (args.one_launch) bar = xcd_barrier_post(G_ctl + CW_BAR, MISC + 8);
    const int lo = args.ph_lo, hi = args.ph_hi;
#ifndef PH_MASK
#define PH_MASK 0xff
#endif
#define IN(k) (((PH_MASK >> (k)) & 1) && lo <= (k) && (k) < hi)
#ifdef PROBE_SEL
#define STAMP(i) do { if (bx == 0 && tid == 0) { const unsigned long long t_ = __builtin_amdgcn_s_memrealtime(); MISC[32 + 2 * (i)] = (unsigned)t_; MISC[33 + 2 * (i)] = (unsigned)(t_ >> 32); } } while (0)
#else
#define STAMP(i) do { } while (0)
#endif
#define SEAM(k) do { if (IN(k) && IN((k) + 1)) xcd_barrier(bar); STAMP((k) + 1); } while (0)
#define TABLE_CHUNK(c_) do { _Pragma("unroll 1") for (int i_ = 0; i_ < 4; i_ += 2) { const int r_ = (c_) * 32 + wave * 4 + i_; const int tb_ = r_ >> 14, rr_ = r_ & (PEXP - 1); \
        const float* sp_ = (tb_ ? G_peer_v : G_peer_u) + (size_t)rr_ * DM; unsigned char* dp_ = (tb_ ? G_VB : G_UB) + (size_t)rr_ * 1536; float* scp_ = (tb_ ? G_SV : G_SU) + rr_; \
        conv_rows2_fp6(sp_, sp_ + DM, dp_, dp_ + 1536, scp_, scp_ + 1, lane); } } while (0)
    STAMP(0);
#if defined(PROBE_SEL) && PROBE_SEL >= 7
    if (bx == 0 && tid == 0) __hip_atomic_store((unsigned long long*)(G_ctl + 256), (unsigned long long)__builtin_amdgcn_s_memrealtime(), __ATOMIC_RELAXED, __HIP_MEMORY_SCOPE_AGENT);
#endif
    const int gw = vcu * NWAVES + wave, NGW = G * NWAVES;
    const int gt = vcu * NTHREADS + tid, NGT = G * NTHREADS;

    if (IN(0)) for (int rep_ = 0; rep_ < (((DUP_MASK >> 0) & 1) ? args.pad + 1 : 1); ++rep_) {
        LAS float* wf = (LAS float*)ldsL;
        LAS float* scr = (LAS float*)(ldsL + 65536 + wave * 8704);
#pragma unroll
        for (int i = 0; i < DM / NTHREADS; ++i) { const int d = tid + i * NTHREADS; const f32x4 a = *(const GAS f32x4*)(G_w_in + (size_t)d * INC + 4096), b = *(const GAS f32x4*)(G_w_in + (size_t)d * INC + 4100);
            wf[d] = a[0]; wf[DM + d] = a[1]; wf[2 * DM + d] = a[2]; wf[3 * DM + d] = a[3]; wf[4 * DM + d] = b[0]; wf[5 * DM + d] = b[1]; wf[6 * DM + d] = b[2]; wf[7 * DM + d] = b[3]; }
        __syncthreads();
        f32x4 vnx[8];
        if (gw < TOK) {
#pragma unroll
            for (int j = 0; j < 8; ++j) vnx[j] = ((const GAS f32x4*)(G_x + (size_t)gw * DM) + lane)[64 * j]; }
        for (int m = gw; m < TOK; m += NGW) {
            const GAS f32x4* gr = (const GAS f32x4*)G_mix_norm + lane;
            f32x4 v[8]; float s = 0.f;
#pragma unroll
            for (int j = 0; j < 8; ++j) v[j] = vnx[j];
            if (m + NGW < TOK) {
#pragma unroll
                for (int j = 0; j < 8; ++j) vnx[j] = ((const GAS f32x4*)(G_x + (size_t)(m + NGW) * DM) + lane)[64 * j]; }
#pragma unroll
            for (int j = 0; j < 8; ++j) s += (v[j][0] * v[j][0] + v[j][1] * v[j][1]) + (v[j][2] * v[j][2] + v[j][3] * v[j][3]);
            const float rstd = __builtin_amdgcn_rsqf(wave_sum_dpp(s) * (1.f / DM) + EPS);
            GAS v2u* o8 = (GAS v2u*)(G_XN + (size_t)m * DM) + lane;
#pragma unroll
            for (int j = 0; j < 8; ++j) { const f32x4 gg = gr[64 * j]; v[j] = v[j] * rstd * gg;
                v2u o; o.x = pk2(v[j][0], v[j][1]); o.y = pk2(v[j][2], v[j][3]); o8[64 * j] = o; }
            float fl[8];
#pragma unroll
            for (int h = 0; h < 8; ++h) { float a = 0.f;
#pragma unroll
                for (int j = 0; j < 8; ++j) { const f32x4 w = *(const LAS f32x4*)(wf + h * DM + j * 256 + lane * 4); a += (v[j][0] * w[0] + v[j][1] * w[1]) + (v[j][2] * w[2] + v[j][3] * w[3]); }
                fl[h] = wave_sum_dpp(a);
                asm volatile("" ::: "memory"); }
            if (lane < 8) { float f = fl[0];
#pragma unroll
                for (int h = 1; h < 8; ++h) f = (lane == h) ? fl[h] : f;
                f += G_b_forget[lane];
                const float ls = fminf(f, 0.f) - log1pf(expf(-fabsf(f)));
                const int b = m / SEQ, sq = m % SEQ; G_LF[(size_t)(b * FOXH + lane) * SEQ + sq] = ls; }
        }
        for (int m = gw; m < BATCH * NMEM; m += NGW) {
            const GAS f32x4* xr = (const GAS f32x4*)(G_mem + (size_t)m * DM) + lane; const GAS f32x4* gr = (const GAS f32x4*)G_mem_norm + lane;
            f32x4 v[8]; float s = 0.f;
#pragma unroll
            for (int j = 0; j < 8; ++j) { v[j] = xr[64 * j]; s += (v[j][0] * v[j][0] + v[j][1] * v[j][1]) + (v[j][2] * v[j][2] + v[j][3] * v[j][3]); }
            const float rstd = __builtin_amdgcn_rsqf(wave_sum_dpp(s) * (1.f / DM) + EPS);
            GAS v2u* o8 = (GAS v2u*)(G_MN + (size_t)m * DM) + lane;
#pragma unroll
            for (int j = 0; j < 8; ++j) { const f32x4 gg = gr[64 * j]; v[j] = v[j] * rstd * gg; v2u o; o.x = pk2(v[j][0], v[j][1]); o.y = pk2(v[j][2], v[j][3]); o8[64 * j] = o; }
        }
        {
            constexpr int I_IN = (DM / 64) * (4096 / 32), I_SQ = (DM / 64) * (DM / 32);
            constexpr int NITEMS = I_IN + 3 * I_SQ;
#define TR_SRC(it_, W_, ldw_, nblk_, r_) do { r_ = (it_); if (r_ < I_IN) { W_ = G_w_in; ldw_ = INC; nblk_ = 4096 / 32; } else { r_ -= I_IN; ldw_ = DM; nblk_ = DM / 32; \
        if (r_ < I_SQ) W_ = G_w_out; else if (r_ < 2 * I_SQ) { W_ = G_xwk; r_ -= I_SQ; } else { W_ = G_xwv; r_ -= 2 * I_SQ; } } } while (0)
            f32x4 tvn[8]; const float* Wn; int ldwn, nblkn, rn;
            if (gw < NITEMS) { TR_SRC(gw, Wn, ldwn, nblkn, rn); tr_load(Wn, ldwn, nblkn, rn, lane, tvn); }
            for (int it = gw; it < NITEMS; it += NGW) {
                f32x4 tvc[8];
#pragma unroll
                for (int i = 0; i < 8; ++i) tvc[i] = tvn[i];
                const int nblkc = nblkn, rc = rn;
                if (it + NGW < NITEMS) { TR_SRC(it + NGW, Wn, ldwn, nblkn, rn); tr_load(Wn, ldwn, nblkn, rn, lane, tvn); }
                int r = it;
                if (r < I_IN) { tr_store(tvc, nblkc, G_W_IN, nullptr, 0, DM, scr, rc, lane); continue; } r -= I_IN;
                if (r < I_SQ) { tr_store(tvc, nblkc, G_WO1, G_WO2, POOLW, DM, scr, rc, lane); continue; } r -= I_SQ;
                if (r < I_SQ) { tr_store(tvc, nblkc, G_WK, nullptr, 0, DM, scr, rc, lane); continue; }
                tr_store(tvc, nblkc, G_WV, nullptr, 0, DM, scr, rc, lane);
            }
#undef TR_SRC
        }
        for (int i0 = gt; i0 < DM * DM / 8; i0 += 2 * NGT) {
#pragma unroll
            for (int u = 0; u < 2; ++u) { const int i = i0 + u * NGT; if (i < DM * DM / 8) {
                const int d = i / (DM / 8);
                const v4u o1 = cvt8(G_peer_wq + (size_t)i * 8, G_peer_norm[d]);
                const v4u o2 = cvt8(G_xwq + (size_t)i * 8, G_xattn_norm[d]);
                *(GAS v4u*)(G_WPQ + (size_t)i * 8) = o1; *(GAS v4u*)(G_WQ + (size_t)i * 8) = o2; } }
        }
        for (int i = gt; i < DM * 256 / 8; i += NGT) {
            const int r = i >> 5, c0 = (i & 31) * 8; const int hc = r >> 7;
            v4u o3 = {0u, 0u, 0u, 0u}; if ((c0 >> 7) == (hc & 1)) o3 = cvt8(G_sub_keys + (size_t)r * 128 + (c0 & 127), 1.f);
            *(GAS v4u*)(G_AEXP + (size_t)i * 8) = o3; }
        for (int i = gt; i < 4 * 256 * 256 / 8; i += NGT) {
            const int g = i / (256 * 256 / 8), d0 = (i % 32) * 8; const float* ps = G_pool_scale + g * 256 + d0; const float* p = G_pool_w + (size_t)i * 8;
            v4u o; o.x = pk2(p[0] * ps[0], p[1] * ps[1]); o.y = pk2(p[2] * ps[2], p[3] * ps[3]); o.z = pk2(p[4] * ps[4], p[5] * ps[5]); o.w = pk2(p[6] * ps[6], p[7] * ps[7]);
            *(GAS v4u*)(G_PB + (size_t)i * 8) = o; }
        __syncthreads();
    }
    SEAM(0);

    if (IN(1)) for (int rep_ = 0; rep_ < (((DUP_MASK >> 1) & 1) ? args.pad + 1 : 1); ++rep_) {
        pg8::Gemm g{G_XN, G_W_IN, DM, DM, DM}; pg8::GSched S; S.init(TOK / 256, 4096 / 256, G, bx, DM, DM);
        pg8::EpiStoreT<true> E{G_PROJ, 4096, 0, 0, 1, nullptr, 1.f, 4, 8, 0.08838834764831845f * LOG2E, (unsigned*)G_ctl + CW_NRM};
        pg8::gemm_phase<pg8::EpiStoreT<true>, pg8::GSched, true>(ldsL, g, S, E);
    }
    SEAM(1);

    if (IN(2)) for (int rep_ = 0; rep_ < (((DUP_MASK >> 2) & 1) ? args.pad + 1 : 1); ++rep_) {
        for (int it = vcu; it < TOK / 32; it += G) {
            const int ch = (tid & 127) * 8, rsub = tid >> 7, r0 = it * 32 + rsub * 8, w = 2 << (ch >> 8);
            const int s0 = r0 % SEQ;
            float acc[8];
#pragma unroll
            for (int e = 0; e < 8; ++e) acc[e] = 0.f;
            for (int k = 1; k < w; ++k) { if (s0 - k >= 0) { const v4u v = *(const GAS v4u*)(G_PROJ + (size_t)(r0 - k) * 4096 + ch);
#pragma unroll
                    for (int e = 0; e < 4; ++e) { acc[2 * e] += __uint_as_float(v[e] << 16); acc[2 * e + 1] += __uint_as_float(v[e] & 0xffff0000u); } } }
            for (int rr = 0; rr < 8; ++rr) {
                const v4u v = *(const GAS v4u*)(G_PROJ + (size_t)(r0 + rr) * 4096 + ch); float cur[8];
#pragma unroll
                for (int e = 0; e < 4; ++e) { cur[2 * e] = __uint_as_float(v[e] << 16); cur[2 * e + 1] = __uint_as_float(v[e] & 0xffff0000u); }
                const int sp = s0 + rr; const float inv = 1.f / (float)((sp + 1 < w) ? sp + 1 : w);
                v4u o;
#pragma unroll
                for (int e = 0; e < 8; ++e) acc[e] += cur[e];
                o.x = pk2(acc[0] * inv - cur[0], acc[1] * inv - cur[1]); o.y = pk2(acc[2] * inv - cur[2], acc[3] * inv - cur[3]);
                o.z = pk2(acc[4] * inv - cur[4], acc[5] * inv - cur[5]); o.w = pk2(acc[6] * inv - cur[6], acc[7] * inv - cur[7]);
                *(GAS v4u*)(G_AMIX + (size_t)(r0 + rr) * DM + ch) = o;
                if (sp - w + 1 >= 0) { const v4u vo = *(const GAS v4u*)(G_PROJ + (size_t)(r0 + rr - w + 1) * 4096 + ch);
#pragma unroll
                    for (int e = 0; e < 4; ++e) { acc[2 * e] -= __uint_as_float(vo[e] << 16); acc[2 * e + 1] -= __uint_as_float(vo[e] & 0xffff0000u); } }
            }
        }
        const int a_bh = vcu >> 4, a_qb = vcu & 15;
        if (a_qb < 8 && vcu < 256) {
            const int e = a_qb < 2 ? a_bh * 2 + a_qb : 32 + a_bh * 6 + (a_qb - 2);
            pg8::Gemm g; pg8::EpiStore E{nullptr, DM, 0, 0, 1, nullptr, 1.f, 0, 0, 1.f, nullptr};
            int pm, pn;
            if (e < 16)      { pm = e >> 3; pn = e & 7; g = pg8::Gemm{G_MN, G_WK, DM, DM, DM}; E.O = G_KX; E.ldc = DM; }
            else if (e < 32) { const int q = e - 16; pm = q >> 3; pn = q & 7; g = pg8::Gemm{G_MN, G_WV, DM, DM, DM}; E.O = G_VXT; E.ldc = DM; }
            else if (e < 96) { const int q = e - 32; pm = q >> 3; pn = q & 7; g = pg8::Gemm{G_AEXP, G_WPQ + pm * 256, 256, 256, DM}; E.O = G_WSC; E.ldc = DM; }
            else             { const int q = e - 96; const int gg = q >> 3; pm = q & 7; pn = 0;
                               g = pg8::Gemm{G_WO1 + gg * 256, G_PB + (size_t)gg * 65536, 256, DM, 256}; E.O = G_WO2 + gg * 256; E.ldc = DM; }
            const pg8::OneSched S1{pm, pn, (long)pm * 256 * g.lda, (long)pn * 256 * g.ldb};
            pg8::gemm_phase<pg8::EpiStore, pg8::OneSched, false>(ldsL, g, S1, E);
        }
        if (vcu < 256) {
            const int b = a_bh >> 3, h = a_bh & 7;
            float* c_lds = (float*)(lds + fox::LDS_C);
            if (wave == 0) {
                const float* lf = G_LF + (size_t)a_bh * SEQ + lane * 64; float loc[64]; float run = 0.f;
#pragma unroll
                for (int i = 0; i < 16; ++i) { const f32x4 v = *(const f32x4*)(lf + 4 * i);
#pragma unroll
                    for (int e = 0; e < 4; ++e) { run += v[e]; loc[4 * i + e] = run; } }
                float incl = run;
#pragma unroll
                for (int o = 1; o < 64; o <<= 1) { const float t = __shfl_up(incl, o); if (lane >= o) incl += t; }
                const float excl = incl - run;
#pragma unroll
                for (int i = 0; i < 16; ++i) { f32x4 v;
#pragma unroll
                    for (int e = 0; e < 4; ++e) v[e] = (loc[4 * i + e] + excl) * LOG2E;
                    *(f32x4*)(c_lds + lane * 64 + 4 * i) = v; }
            }
            __syncthreads();
            const bf16* Qb = G_PROJ + (size_t)(b * SEQ) * 4096 + 1024 + h * 128;
            fox::BlockRef cur{Qb + (size_t)(a_qb * 256) * 4096, Qb + 1024, Qb + 2048, G_AMIX + (size_t)(b * SEQ + a_qb * 256) * DM + 1024 + h * 128, a_qb * 256};
            int j_lo = 0;
            { const unsigned* nq = (const unsigned*)G_ctl + CW_NRM + (b * 8 + h) * 4; const unsigned* nk = nq + 64; float B = 0.f;
#pragma unroll
              for (int c4 = 0; c4 < 4; ++c4) B += sqrtf(__uint_as_float(__hip_atomic_load(nq + c4, __ATOMIC_RELAXED, __HIP_MEMORY_SCOPE_AGENT)) * __uint_as_float(__hip_atomic_load(nk + c4, __ATOMIC_RELAXED, __HIP_MEMORY_SCOPE_AGENT)));
              const float thr = 2.05f * B + c_lds[a_qb * 256] + 150.f;
              while (j_lo < a_qb * 4 && c_lds[64 * j_lo + 63] > thr) ++j_lo; }
            fox::Seam S;
            fox::prime(cur, j_lo, (char*)lds, S);
            fox::block(cur, cur, j_lo, (char*)lds, S);
            asm volatile("s_waitcnt vmcnt(0)" ::: "memory");
            __syncthreads();
        }
        {
            constexpr int C_T = (DM / 64) * (DM / 32) / 8, NCHUNK = C_T + QSPLIT;
            LAS float* scr = (LAS float*)(ldsL + wave * 8704);
            for (;;) {
                __syncthreads();
                if (tid == 0) MISC[16] = atomicAdd(G_ctl + CW_QUEUE, 1u);
                __syncthreads();
                const int c = (int)MISC[16];
                if (c >= NCHUNK) break;
                if (c < C_T) { p0_transpose_item(G_xwo, DM, DM / 32, nullptr, G_WO, nullptr, 0, DM, scr, c * 8 + wave, lane); }
                else { TABLE_CHUNK(c - C_T); }
            }
        }
    }
    SEAM(2);

    if (IN(3)) for (int rep_ = 0; rep_ < (((DUP_MASK >> 3) & 1) ? args.pad + 1 : 1); ++rep_) {
        { pg8::Gemm g{G_AMIX, G_WO2, DM, DM, DM}; pg8::GSched S; S.init(TOK / 256, DM / 256, G, bx, DM, DM);
          pg8::EpiResid<false> E{G_x, G_HB, rep_ ? nullptr : G_SS1, 0};
          pg8::gemm_phase<pg8::EpiResid<false>, pg8::GSched, true>(ldsL, g, S, E); }
        if (bx < 64) {
            const int f = bx & 63, b = f >> 5, h = (f >> 3) & 3, t = f & 7;
            pg8::Gemm g{G_KX + (size_t)(b * NMEM) * DM + h * XD, G_WQ + h * XD, XD, DM, DM};
            pg8::EpiStore E{G_W1 + (size_t)(b * 1024 + h * 256) * DM, DM, 0, 0, 1, nullptr, 1.f, 0, 0, 1.f, nullptr};
            const pg8::OneSched S1{0, t, 0, (long)t * 256 * DM};
            pg8::gemm_phase<pg8::EpiStore, pg8::OneSched, false>(ldsL, g, S1, E);
        }
    }
    SEAM(3);

    if (IN(4)) for (int rep_ = 0; rep_ < (((DUP_MASK >> 4) & 1) ? args.pad + 1 : 1); ++rep_) {
        pg8::Gemm g{G_HB, G_W1, DM, DM, DM}; pg8::GSched S; S.init(SEQ / 256, XH, G, bx, DM, DM);
        S.nH = 1; S.nZ = BATCH; S.sAb = (long)SEQ * DM; S.sBb = (long)1024 * DM;
        pg8::EpiSoftmax E{G_PP, 1024, (long)SEQ * 1024, 0, 1, G_SS1, 0.044194173824159216f * LOG2E, SEQ};
        pg8::gemm_phase<pg8::EpiSoftmax, pg8::GSched, false>(ldsL, g, S, E);
        if (bx >= 128 && bx < 192) {
            const int f = bx & 63, b = f >> 5, h = (f >> 3) & 3, t = f & 7;
            pg8::Gemm g2{G_WO + h * XD, G_VXT + (size_t)(b * NMEM) * DM + h * XD, XD, DM, DM};
            pg8::EpiStore E2{G_W2 + (size_t)b * DM * 1024 + h * 256, 1024, 0, 0, 1, nullptr, 1.f, 0, 0, 1.f, nullptr};
            const pg8::OneSched S2{t, 0, (long)t * 256 * DM, 0};
            pg8::gemm_phase<pg8::EpiStore, pg8::OneSched, false>(ldsL, g2, S2, E2);
        }
        for (;;) {
            __syncthreads();
            if (tid == 0) MISC[16] = atomicAdd(G_ctl + CW_QUEUE2, 1u);
            __syncthreads();
            const int c = (int)MISC[16] + QSPLIT;
            if (c >= 2 * PEXP / 32) break;
            TABLE_CHUNK(c);
        }
    }
    SEAM(4);

    if (IN(5)) for (int rep_ = 0; rep_ < (((DUP_MASK >> 5) & 1) ? args.pad + 1 : 1); ++rep_) {
        pg8::Gemm g{G_PP, G_W2, 1024, 1024, 1024}; pg8::GSched S; S.init(SEQ / 256, DM / 256, G, bx, 1024, 1024);
        S.nH = 1; S.nZ = BATCH; S.sAb = (long)SEQ * 1024; S.sBb = (long)DM * 1024;
        pg8::EpiResid<true> E{G_HB, G_HB, G_SS2, SEQ};
        pg8::gemm_phase<pg8::EpiResid<true>, pg8::GSched, true>(ldsL, g, S, E);
    }
    SEAM(5);

    if (IN(6)) for (int rep_ = 0; rep_ < (((DUP_MASK >> 6) & 1) ? args.pad + 1 : 1); ++rep_) {
        pg8::Gemm g{G_WSC, G_HB, DM, DM, DM}; pg8::GSched S; S.init(DM / 256, TOK / 256, G, bx, DM, DM);
        pg8::EpiF32Col E{G_SCT, TOK, G_SS2};
        pg8::gemm_phase<pg8::EpiF32Col, pg8::GSched, true>(ldsL, g, S, E);
    }
    SEAM(6);

#if defined(PROBE_SEL) && PROBE_SEL >= 7
    if (bx == 0 && tid == 0) __hip_atomic_store((unsigned long long*)(G_ctl + 258), (unsigned long long)__builtin_amdgcn_s_memrealtime(), __ATOMIC_RELAXED, __HIP_MEMORY_SCOPE_AGENT);
#endif
    if (IN(7)) for (int rep_ = 0; rep_ < (((DUP_MASK >> 7) & 1) ? args.pad + 1 : 1); ++rep_) {
        LAS unsigned* TOP1 = (LAS unsigned*)ldsL;
        LAS unsigned* RIDX = (LAS unsigned*)(ldsL + 32768);
        LAS float* RGATE = (LAS float*)(ldsL + 49152);
        for (int blk = vcu; blk < TOK / 32; blk += G) {
            const int t0 = blk * 32;
            {
                const int tok = tid & 31, grp = tid >> 5;
                const float* sp = G_SCT + (size_t)(grp * 128) * TOK + t0 + tok;
                unsigned lst[16];
#pragma unroll
                for (int j = 0; j < 16; ++j) lst[j] = 0u;
                for (int i0 = 0; i0 < 128; i0 += 32) {
                    float v[32];
#pragma unroll
                    for (int e = 0; e < 32; ++e) v[e] = sp[(size_t)(i0 + e) * TOK];
#pragma unroll
                    for (int c16 = 0; c16 < 2; ++c16) { unsigned nw[16];
#pragma unroll
                        for (int e = 0; e < 16; ++e) nw[e] = (fkey(v[c16 * 16 + e]) & ~127u) | (unsigned)(127 - (i0 + c16 * 16 + e));
#pragma unroll
                        for (int k = 2; k <= 16; k <<= 1)
#pragma unroll
                            for (int j = k >> 1; j > 0; j >>= 1)
#pragma unroll
                                for (int i = 0; i < 16; ++i) { const int l = i ^ j; if (l > i) { const unsigned lo_ = min(nw[i], nw[l]), hi_ = max(nw[i], nw[l]); if ((i & k) == 0) { nw[i] = lo_; nw[l] = hi_; } else { nw[i] = hi_; nw[l] = lo_; } } }
#pragma unroll
                        for (int i = 0; i < 16; ++i) lst[i] = max(lst[i], nw[i]);
#pragma unroll
                        for (int j = 8; j > 0; j >>= 1)
#pragma unroll
                            for (int i = 0; i < 16; ++i) { const int l = i ^ j; if (l > i) { const unsigned lo_ = min(lst[i], lst[l]), hi_ = max(lst[i], lst[l]); lst[i] = hi_; lst[l] = lo_; } } }
                }
                LAS unsigned* dst = TOP1 + (tok * 16 + grp) * 16;
#pragma unroll
                for (int j = 0; j < 16; j += 4) *(LAS v4u*)(dst + j) = (v4u){lst[j], lst[j + 1], lst[j + 2], lst[j + 3]};
            }
            __syncthreads();
            if (tid < 256) {
                const int tok = tid & 31, head = tid >> 5;
                const LAS unsigned* ka = TOP1 + (tok * 16 + head * 2) * 16; const LAS unsigned* kb = ka + 16;
                float af[16], bfv[16];
#pragma unroll
                for (int j = 0; j < 16; ++j) { af[j] = fdec(ka[j] & ~127u); bfv[j] = fdec(kb[j] & ~127u); }
                unsigned best[16];
#pragma unroll
                for (int j = 0; j < 16; ++j) best[j] = 0u;
#pragma unroll
                for (int i = 0; i < 16; ++i)
#pragma unroll
                    for (int j = 0; j < 16; ++j) if ((i + 1) * (j + 1) <= 16) {
                        unsigned xk = (fkey(af[i] + bfv[j]) & ~255u) | (unsigned)(255 - (i * 16 + j));
#pragma unroll
                        for (int q = 0; q < 16; ++q) { const unsigned hi_ = max(best[q], xk); xk = min(best[q], xk); best[q] = hi_; } }
                float ev[16]; const float m0 = fdec(best[0] & ~255u); float sum = 0.f;
#pragma unroll
                for (int q = 0; q < 16; ++q) { ev[q] = __expf(fdec(best[q] & ~255u) - m0); sum += ev[q]; }
                const float inv = 1.f / sum;
#pragma unroll
                for (int q = 0; q < 16; ++q) { const unsigned code = 255u - (best[q] & 255u); const unsigned i = code >> 4, j = code & 15u;
                    const unsigned ia = 127u - (ka[i] & 127u), ib = 127u - (kb[j] & 127u);
                    RIDX[tok * 128 + head * 16 + q] = ia * 128u + ib; RGATE[tok * 128 + head * 16 + q] = ev[q] * inv; }
            }
            __syncthreads();
            {
                LAS unsigned* SIDX = (LAS unsigned*)ldsL; LAS unsigned* SGATE = (LAS unsigned*)(ldsL + 16384);
                const int tok = tid >> 4; const LAS unsigned* src = RIDX + tok * 128;
                unsigned mine[8]; unsigned rank[8];
#pragma unroll
                for (int i = 0; i < 8; ++i) { mine[i] = (src[(tid & 15) + 16 * i] << 7) | (unsigned)((tid & 15) + 16 * i); rank[i] = 0u; }
                for (int j0 = 0; j0 < 128; j0 += 4) { const v4u o4 = *(const LAS v4u*)(src + j0);
#pragma unroll
                    for (int jj = 0; jj < 4; ++jj) { const unsigned oj = ((jj == 0 ? o4.x : jj == 1 ? o4.y : jj == 2 ? o4.z : o4.w) << 7) | (unsigned)(j0 + jj);
#pragma unroll
                        for (int i = 0; i < 8; ++i) rank[i] += (oj < mine[i]) ? 1u : 0u; } }
#pragma unroll
                for (int i = 0; i < 8; ++i) mine[i] >>= 7;
#pragma unroll
                for (int i = 0; i < 8; ++i) { const unsigned pos = rank[i];
                    SIDX[tok * 128 + pos] = mine[i];
                    const float su_ = G_SU[mine[i]], gs_ = RGATE[tok * 128 + (tid & 15) + 16 * i] * G_SV[mine[i]];
                    SGATE[tok * 128 + pos] = (__float_as_uint(su_) & 0xffff0000u) | f2bf(gs_); }
            }
            __syncthreads();
            {
                const int tok0 = wave * 4; const size_t tg0 = (size_t)(t0 + tok0);
                LAS float* Wl = (LAS float*)(ldsL + 32768) + tok0 * 128;
                unsigned xn0[16], xn1[16], xn2[16], xn3[16];
#define XNLOAD(T_, XN) do { const float rs = __builtin_amdgcn_rsqf(G_SS2[tg0 + (T_)] * (1.f / DM) + EPS); \
        _Pragma("unroll") for (int q = 0; q < 8; ++q) { const size_t d0 = (size_t)q * 256 + lane * 4; \
            const v2u ha = *(const GAS v2u*)(G_HB + (tg0 + (T_)) * DM + d0); const f32x4 ga = *(const f32x4*)(G_peer_norm + d0); \
            XN[q * 2] = pk2(__uint_as_float(ha.x << 16) * rs * ga[0], __uint_as_float(ha.x & 0xffff0000u) * rs * ga[1]); XN[q * 2 + 1] = pk2(__uint_as_float(ha.y << 16) * rs * ga[2], __uint_as_float(ha.y & 0xffff0000u) * rs * ga[3]); } } while (0)
                XNLOAD(0, xn0); XNLOAD(1, xn1); XNLOAD(2, xn2); XNLOAD(3, xn3);
#undef XNLOAD
                const LAS unsigned* ridx0 = (const LAS unsigned*)ldsL + tok0 * 128; const LAS unsigned* rgs0 = (const LAS unsigned*)(ldsL + 16384) + tok0 * 128;
                const __amdgpu_buffer_rsrc_t rsT = __builtin_amdgcn_make_buffer_rsrc((void*)G_UB, 0, 64 << 20, 0x00020000);
                v4u raX0, raX1, raX2, raX3, raY0, raY1, raY2, raY3; v2u rbX0, rbX1, rbX2, rbX3, rbY0, rbY1, rbY2, rbY3;
                unsigned sgX0, sgX1, sgX2, sgX3, sgY0, sgY1, sgY2, sgY3;
#define PLDU(S, T, k) do { const unsigned ex_ = (unsigned)__builtin_amdgcn_readfirstlane((int)ridx0[(T) * 128 + (k)]); sg##S = rgs0[(T) * 128 + (k)]; \
        ra##S = __builtin_bit_cast(v4u, __builtin_amdgcn_raw_buffer_load_b128(rsT, lane * 16, ex_ * 1536u, 0)); rb##S = __builtin_bit_cast(v2u, __builtin_amdgcn_raw_buffer_load_b64(rsT, lane * 8 + 1024, ex_ * 1536u, 0)); } while (0)
                const int rowl = lane >> 4; const int wl_off = (rowl == 0 ? 0 : rowl == 1 ? 256 : rowl == 2 ? 128 : 384);
#define STEP1(C, P, k, HASNEXT) do { \
        const float d0_ = peer_dot(ra##C##0, rb##C##0, xn0), d1_ = peer_dot(ra##C##1, rb##C##1, xn1), d2_ = peer_dot(ra##C##2, rb##C##2, xn2), d3_ = peer_dot(ra##C##3, rb##C##3, xn3); \
        const unsigned sgr_ = rowl == 0 ? sg##C##0 : rowl == 1 ? sg##C##2 : rowl == 2 ? sg##C##1 : sg##C##3; \
        if (HASNEXT) { PLDU(P##0, 0, (k) + 1); PLDU(P##1, 1, (k) + 1); PLDU(P##2, 2, (k) + 1); PLDU(P##3, 3, (k) + 1); } \
        const auto s01_ = __builtin_amdgcn_permlane32_swap(__float_as_uint(d0_), __float_as_uint(d1_), false, false); const auto s23_ = __builtin_amdgcn_permlane32_swap(__float_as_uint(d2_), __float_as_uint(d3_), false, false); \
        const float p_ = __uint_as_float(s01_[0]) + __uint_as_float(s01_[1]), q_ = __uint_as_float(s23_[0]) + __uint_as_float(s23_[1]); \
        const auto spq_ = __builtin_amdgcn_permlane16_swap(__float_as_uint(p_), __float_as_uint(q_), false, false); \
        float r_ = __uint_as_float(spq_[0]) + __uint_as_float(spq_[1]); \
        r_ += __builtin_bit_cast(float, __builtin_amdgcn_update_dpp(0, __builtin_bit_cast(int, r_), 0xB1, 0xf, 0xf, true)); r_ += __builtin_bit_cast(float, __builtin_amdgcn_update_dpp(0, __builtin_bit_cast(int, r_), 0x4E, 0xf, 0xf, true)); \
        r_ += __builtin_bit_cast(float, __builtin_amdgcn_update_dpp(0, __builtin_bit_cast(int, r_), 0x141, 0xf, 0xf, true)); r_ += __builtin_bit_cast(float, __builtin_amdgcn_update_dpp(0, __builtin_bit_cast(int, r_), 0x140, 0xf, 0xf, true)); \
        const float w_ = gelu_f(r_ * __uint_as_float(sgr_ & 0xffff0000u)) * __uint_as_float(sgr_ << 16); \
        if ((lane & 15) == 0) Wl[wl_off + (k)] = w_; } while (0)
                PLDU(X0, 0, 0); PLDU(X1, 1, 0); PLDU(X2, 2, 0); PLDU(X3, 3, 0);
                for (int k = 0; k < 126; k += 2) { STEP1(X, Y, k, true); STEP1(Y, X, k + 1, true); }
                STEP1(X, Y, 126, true); STEP1(Y, X, 127, false);
#undef PLDU
#undef STEP1
#define PLDV(S, T, k) do { const unsigned ex_ = (unsigned)__builtin_amdgcn_readfirstlane((int)ridx0[(T) * 128 + (k)]); \
        ra##S = __builtin_bit_cast(v4u, __builtin_amdgcn_raw_buffer_load_b128(rsT, lane * 16, ex_ * 1536u + (32u << 20), 0)); rb##S = __builtin_bit_cast(v2u, __builtin_amdgcn_raw_buffer_load_b64(rsT, lane * 8 + 1024, ex_ * 1536u + (32u << 20), 0)); } while (0)
#define STEP2(C, P, TA, k, HASNEXT) do { asm volatile("" ::: "memory"); \
        if (HASNEXT) { PLDV(P##0, TA, (k) + 1); PLDV(P##1, (TA) + 1, (k) + 1); } \
        const float w0_ = Wl[(TA) * 128 + (k)], w1_ = Wl[((TA) + 1) * 128 + (k)]; \
        peer_axpy(ra##C##0, rb##C##0, w0_, oaccA); __builtin_amdgcn_sched_barrier(0); peer_axpy(ra##C##1, rb##C##1, w1_, oaccB); } while (0)
                for (int tt = 0; tt < 4; tt += 2) {
                    float oaccA[32], oaccB[32];
#pragma unroll
                    for (int e = 0; e < 32; ++e) { oaccA[e] = 0.f; oaccB[e] = 0.f; }
                    PLDV(X0, tt, 0); PLDV(X1, tt + 1, 0);
                    for (int k = 0; k < 126; k += 2) { STEP2(X, Y, tt, k, true); STEP2(Y, X, tt, k + 1, true); }
                    STEP2(X, Y, tt, 126, true); STEP2(Y, X, tt, 127, false);
#define FINISH(T_, OACC) do { float s_ = 0.f; \
        _Pragma("unroll") for (int q = 0; q < 8; ++q) { const size_t d0 = (size_t)q * 256 + lane * 4; const v2u hb = *(const GAS v2u*)(G_HB + (T_) * DM + d0); \
            const f32x4 a = {__uint_as_float(hb.x << 16), __uint_as_float(hb.x & 0xffff0000u), __uint_as_float(hb.y << 16), __uint_as_float(hb.y & 0xffff0000u)}; \
            _Pragma("unroll") for (int e = 0; e < 4; ++e) { const float y = a[e] + OACC[q * 4 + e]; OACC[q * 4 + e] = y; s_ += y * y; } } \
        const float rstd_ = __builtin_amdgcn_rsqf(wave_sum_dpp(s_) * (1.f / DM) + EPS); \
        _Pragma("unroll") for (int q = 0; q < 8; ++q) { const size_t d0 = (size_t)q * 256 + lane * 4; const f32x4 ga = *(const f32x4*)(G_final_norm + d0); f32x4 o; \
            _Pragma("unroll") for (int e = 0; e < 4; ++e) o[e] = OACC[q * 4 + e] * rstd_ * ga[e]; \
            PROBE_EXPORT(T_, q); \
            *(f32x4*)(args.out + (T_) * DM + d0) = o; } } while (0)
                    FINISH(tg0 + tt, oaccA); FINISH(tg0 + tt + 1, oaccB);
                }
#undef FINISH
#undef PLDV
#undef STEP2
            }
            __syncthreads();
#if defined(PROBE_SEL) && PROBE_SEL >= 7
            asm volatile("s_waitcnt vmcnt(0)" ::: "memory"); __syncthreads();
            if (tid == 0) { __threadfence(); const unsigned old_ = atomicAdd(G_ctl + 192, 1u);
                if (old_ == (unsigned)G - 1u) { __threadfence(); const unsigned long long a_ = __hip_atomic_load((unsigned long long*)(G_ctl + 256 + 2 * (PROBE_SEL - 7)), __ATOMIC_RELAXED, __HIP_MEMORY_SCOPE_AGENT), b_ = __builtin_amdgcn_s_memrealtime();
                    atomicAdd(args.out + (size_t)31 * DM, (float)(b_ - a_) * 0.0001f); } }
#endif
        }
    }
#undef IN
#undef SEAM
#undef G_ws
#undef G_ctl
#undef G_x
#undef G_mem
#undef G_mix_norm
#undef G_w_in
#undef G_b_forget
#undef G_pool_w
#undef G_pool_scale
#undef G_w_out
#undef G_xattn_norm
#undef G_mem_norm
#undef G_xwq
#undef G_xwk
#undef G_xwv
#undef G_xwo
#undef G_peer_norm
#undef G_peer_wq
#undef G_sub_keys
#undef G_peer_u
#undef G_peer_v
#undef G_final_norm
#undef G_W_IN
#undef G_WO1
#undef G_WO2
#undef G_WQ
#undef G_WK
#undef G_WV
#undef G_WO
#undef G_WPQ
#undef G_AEXP
#undef G_W1
#undef G_W2
#undef G_WSC
#undef G_PB
#undef G_MN
#undef G_KX
#undef G_VXT
#undef G_UB
#undef G_VB
#undef G_SU
#undef G_SV
#undef G_XN
#undef G_QX
#undef G_PROJ
#undef G_SCT
#undef G_AMIX
#undef G_OX
#undef G_H
#undef G_HB
#undef G_PP
#undef G_LF
#undef G_SS1
#undef G_SS2

}

constexpr int N_PHASES = 8;
extern "C" void kernel_launch(void* const* d_in, const int* in_sizes, int n_in, void* d_out, int out_size, void* d_ws, size_t ws_size, hipStream_t stream) {
    static int grid = 0;
    if (grid == 0) {
        if (n_in != 20 || in_sizes[0] != TOK * DM || out_size != TOK * DM || ws_size < WS_END) {
            fprintf(stderr, "kernel_launch: unexpected shapes (n_in %d, in0 %d, out %d, ws %zu < %zu)\n", n_in, n_in > 0 ? in_sizes[0] : -1, out_size, ws_size, (size_t)WS_END); grid = -1; return; }
        int dev = 0, cus = 0, per_cu = 0;
        if (hipGetDevice(&dev) != hipSuccess || hipDeviceGetAttribute(&cus, hipDeviceAttributeMultiprocessorCount, dev) != hipSuccess) { grid = -1; return; }
        if (hipFuncSetAttribute((const void*)fwd_kernel, hipFuncAttributeMaxDynamicSharedMemorySize, LDS_BYTES) != hipSuccess) { fprintf(stderr, "kernel_launch: hipFuncSetAttribute failed\n"); grid = -1; return; }
        if (hipOccupancyMaxActiveBlocksPerMultiprocessor(&per_cu, (const void*)fwd_kernel, NTHREADS, LDS_BYTES) != hipSuccess || per_cu < 1) { fprintf(stderr, "kernel_launch: occupancy query says %d\n", per_cu); per_cu = 1; }
        (void)hipGetLastError();
        grid = cus;
        if (grid != 256) fprintf(stderr, "kernel_launch: %d CUs (built for 256)\n", grid);
    }
    if (grid < 0) return;
    (void)hipMemsetAsync((char*)d_ws + WS_CTL, 0, CTL_ZERO_BYTES, stream);
    Args a{};
    for (int i = 0; i < 20; ++i) a.in[i] = (const float*)d_in[i];
    a.out = (float*)d_out; a.ws = (unsigned char*)d_ws; a.pad = DUP_MASK ? 1 : 0;
#if MK_ONE_LAUNCH
    a.ph_lo = 0; a.ph_hi = N_PHASES; a.one_launch = 1;
    void* kargs[] = {&a};
    hipError_t e = hipLaunchCooperativeKernel((const void*)fwd_kernel, dim3(grid), dim3(NTHREADS), kargs, LDS_BYTES, stream);
    if (e != hipSuccess) fprintf(stderr, "kernel_launch: cooperative launch failed: %s\n", hipGetErrorString(e));
#else
    for (int p = 0; p < N_PHASES; ++p) {
        a.ph_lo = p; a.ph_hi = p + 1; a.one_launch = 0;
        hipLaunchKernelGGL(fwd_kernel, dim3(grid), dim3(NTHREADS), LDS_BYTES, stream, a);
    }
#endif
}
```

```cpp
#include <hip/hip_runtime.h>
#include <hip/hip_bf16.h>
#include <cstdio>
#include <cstdint>

#ifndef DUP_MASK
#define DUP_MASK 0
#endif
#ifndef MK_ONE_LAUNCH
#define MK_ONE_LAUNCH 1
#endif

constexpr int BATCH = 2, SEQ = 4096, DM = 2048, TOK = BATCH * SEQ;
constexpr int INC = 4104, POOLW = 1024, FOXH = 8, FOXD = 128;
constexpr int NMEM = 256, XH = 4, XD = 512;
constexpr int PH = 8, PKEYS = 128, PEXP = 16384, TOPK = 16;
constexpr float EPS = 1e-6f;
constexpr float LOG2E = 1.4426950408889634f;

namespace pg8 {
#define PG8_LAS __attribute__((address_space(3)))
typedef unsigned short bf16_t;
typedef short bf16x8 __attribute__((ext_vector_type(8)));
typedef float f32x4 __attribute__((ext_vector_type(4)));
typedef float f32x2 __attribute__((ext_vector_type(2)));
typedef unsigned u32x4 __attribute__((ext_vector_type(4)));
typedef unsigned u32x2 __attribute__((ext_vector_type(2)));
constexpr int BM = 256, BK = 64, HALF = 128, HTB = HALF * BK * 2, STAGE_BYTES = 8 * HTB, NXCD = 8, WGM = 8;

__host__ __device__ __forceinline__ int lds_byte(int r, int c) { const int st = (r >> 4) * 2 + (c >> 5), rr = r & 15, cc = c & 31, ob = rr * 64 + cc * 2; return st * 1024 + (ob ^ (((ob >> 9) & 1) << 5)); }
__host__ __device__ __forceinline__ void stage_rc(int b, int& R, int& C) { const int st = b / 1024, sb = b % 1024, swz = sb ^ (((sb >> 9) & 1) << 5); R = (st >> 1) * 16 + swz / 64; C = (st & 1) * 32 + (swz % 64) / 2; }
__host__ __device__ __forceinline__ int perm32(int rho) { const int n = rho >> 4, i = rho & 15; return 8 * (i >> 2) + 4 * n + (i & 3); }

struct Unit { int pm, pn, z; long aoff, boff; };
struct Gemm { const bf16_t* A; const bf16_t* Bt; int K, lda, ldb; };

struct GSched {
    int nM, nN, nH, nZ, G, c; long sAb, sAh, sBb, sBh; int lda, ldb;
    __device__ __forceinline__ void init(int nM_, int nN_, int G_, int c_, int lda_, int ldb_) { nM = nM_; nN = nN_; nH = 1; nZ = 1; G = G_; c = c_; sAb = sAh = sBb = sBh = 0; lda = lda_; ldb = ldb_; }
    __device__ __forceinline__ bool next(int i, Unit& u) const {
        const long L = (long)i * G + c; const int nwg = nM * nN; if (L >= (long)nwg * nZ) return false;
        const int z = (int)(L / nwg); int wgid = (int)(L % nwg);
        { const int q = nwg / NXCD, r = nwg % NXCD, xcd = wgid % NXCD, off = wgid / NXCD; wgid = (xcd < r ? xcd * (q + 1) : r * (q + 1) + (xcd - r) * q) + off; }
        const int nig = WGM * nN, gid = wgid / nig, fm = gid * WGM, gsz = (nM - fm) < WGM ? (nM - fm) : WGM;
        u.pm = fm + ((wgid % nig) % gsz); u.pn = (wgid % nig) / gsz; u.z = z;
        const int zb = z / nH, zh = z % nH;
        u.aoff = zb * sAb + zh * sAh + (long)u.pm * BM * lda; u.boff = zb * sBb + zh * sBh + (long)u.pn * BM * ldb;
        return true;
    }
    __device__ __forceinline__ void a_ready(const Unit&) const {}
    __device__ __forceinline__ void done(const Unit&) const {}
};

struct OneSched { int pm, pn; long ao, bo;
    __device__ __forceinline__ bool next(int i, Unit& u) const { if (i) return false; u.pm = pm; u.pn = pn; u.z = 0; u.aoff = ao; u.boff = bo; return true; }
    __device__ __forceinline__ void a_ready(const Unit&) const {}
    __device__ __forceinline__ void done(const Unit&) const {} };
__device__ __forceinline__ unsigned cvt_pk_bf16(float lo, float hi) { unsigned r; asm volatile("v_cvt_pk_bf16_f32 %0, %1, %2" : "=v"(r) : "v"(lo), "v"(hi)); return r; }


template <bool NRM> struct EpiStoreT {
    static constexpr bool PERM = true, AFTER_DRAIN = false;
    bf16_t* O; int ldc; long sCb, sCh; int nH;
    const float* ss; float rs_mul;
    int t0, t1; float tscale;
    unsigned* nrm;
    __device__ __forceinline__ void operator()(const f32x4 (&acc)[2][2][4][2], const Unit& u, int wr, int wc, int fr, int fq) const {
        const int row0 = u.pm * BM + wr * 64 + fr, col0 = u.pn * BM + wc * 32 + 8 * fq;
        bf16_t* base = O + (u.z / nH) * sCb + (u.z % nH) * sCh;
        const float ts = (u.pn >= t0 && u.pn < t1) ? tscale : 1.f;
        float mx0 = 0.f, mx1 = 0.f;
#pragma unroll
        for (int ai = 0; ai < 2; ++ai)
#pragma unroll
            for (int m = 0; m < 4; ++m) { const int row = row0 + ai * HALF + m * 16;
                float sc = ts; if (ss) sc *= __builtin_amdgcn_rsqf(ss[row] * (1.f / DM) + EPS) * rs_mul;
                bf16_t* rowp = base + (size_t)row * ldc + col0;
#pragma unroll
                for (int bj = 0; bj < 2; ++bj) { const f32x4 v0 = acc[ai][bj][m][0] * sc, v1 = acc[ai][bj][m][1] * sc;
                    u32x4 w; w.x = cvt_pk_bf16(v0[0], v0[1]); w.y = cvt_pk_bf16(v0[2], v0[3]); w.z = cvt_pk_bf16(v1[0], v1[1]); w.w = cvt_pk_bf16(v1[2], v1[3]);
                    *(u32x4*)(rowp + bj * HALF) = w;
                    if constexpr (NRM) { float q = (v0[0] * v0[0] + v0[1] * v0[1]) + (v0[2] * v0[2] + v0[3] * v0[3]) + (v1[0] * v1[0] + v1[1] * v1[1]) + (v1[2] * v1[2] + v1[3] * v1[3]);
                        q += __shfl_xor(q, 16); q += __shfl_xor(q, 32); if (bj == 0) mx0 = fmaxf(mx0, q); else mx1 = fmaxf(mx1, q); } } }
        if constexpr (NRM) { if (u.pn >= 4 && u.pn < 12) {
#pragma unroll
            for (int o = 1; o < 16; o <<= 1) { mx0 = fmaxf(mx0, __shfl_xor(mx0, o)); mx1 = fmaxf(mx1, __shfl_xor(mx1, o)); }
            if ((threadIdx.x & 63) == 0) { const int kind = u.pn >= 8, b = u.pm >> 4, h2 = ((u.pn - 4) & 3) * 2; unsigned* p = nrm + ((kind * 2 + b) * 8 + h2) * 4 + wc;
                atomicMax(p, __float_as_uint(mx0)); atomicMax(p + 4, __float_as_uint(mx1)); } } }
    }
};
typedef EpiStoreT<false> EpiStore;
template <bool BASE_BF16> struct EpiResid {
    static constexpr bool PERM = true, AFTER_DRAIN = false;
    const void* base; bf16_t* HB; float* ss; int zrows;
    __device__ __forceinline__ void operator()(const f32x4 (&acc)[2][2][4][2], const Unit& u, int wr, int wc, int fr, int fq) const {
        const int row0 = u.z * zrows + u.pm * BM + wr * 64 + fr, col0 = u.pn * BM + wc * 32 + 8 * fq;
#pragma unroll
        for (int ai = 0; ai < 2; ++ai)
#pragma unroll
            for (int m = 0; m < 4; ++m) { const int row = row0 + ai * HALF + m * 16; const size_t off = (size_t)row * DM + col0; float sq = 0.f;
#pragma unroll
                for (int bj = 0; bj < 2; ++bj) {
                    f32x4 b0, b1;
                    if constexpr (BASE_BF16) { const u32x4 r = *(const u32x4*)((const bf16_t*)base + off + bj * HALF);
                        b0 = (f32x4){__uint_as_float(r.x << 16), __uint_as_float(r.x & 0xffff0000u), __uint_as_float(r.y << 16), __uint_as_float(r.y & 0xffff0000u)};
                        b1 = (f32x4){__uint_as_float(r.z << 16), __uint_as_float(r.z & 0xffff0000u), __uint_as_float(r.w << 16), __uint_as_float(r.w & 0xffff0000u)}; }
                    else { b0 = *(const f32x4*)((const float*)base + off + bj * HALF); b1 = *(const f32x4*)((const float*)base + off + bj * HALF + 4); }
                    const f32x4 h0 = b0 + acc[ai][bj][m][0], h1 = b1 + acc[ai][bj][m][1];
                    u32x4 w; w.x = cvt_pk_bf16(h0[0], h0[1]); w.y = cvt_pk_bf16(h0[2], h0[3]); w.z = cvt_pk_bf16(h1[0], h1[1]); w.w = cvt_pk_bf16(h1[2], h1[3]);
                    *(u32x4*)(HB + off + bj * HALF) = w;
                    sq += (h0[0] * h0[0] + h0[1] * h0[1]) + (h0[2] * h0[2] + h0[3] * h0[3]) + (h1[0] * h1[0] + h1[1] * h1[1]) + (h1[2] * h1[2] + h1[3] * h1[3]); }
                sq += __shfl_xor(sq, 16); sq += __shfl_xor(sq, 32);
                if (fq == 0 && ss) atomicAdd(ss + row, sq); }
    }
};
struct EpiF32Col {
    static constexpr bool PERM = true, AFTER_DRAIN = false;
    float* O; int ldc; const float* ss;
    __device__ __forceinline__ void operator()(const f32x4 (&acc)[2][2][4][2], const Unit& u, int wr, int wc, int fr, int fq) const {
        const int row0 = u.pm * BM + wr * 64 + fr, col0 = u.pn * BM + wc * 32 + 8 * fq;
        f32x4 rs[2][2];
#pragma unroll
        for (int bj = 0; bj < 2; ++bj)
#pragma unroll
            for (int n = 0; n < 2; ++n) { const f32x4 s = *(const f32x4*)(ss + col0 + bj * HALF + 4 * n);
#pragma unroll
                for (int e = 0; e < 4; ++e) rs[bj][n][e] = __builtin_amdgcn_rsqf(s[e] * (1.f / DM) + EPS); }
#pragma unroll
        for (int ai = 0; ai < 2; ++ai)
#pragma unroll
            for (int m = 0; m < 4; ++m) { float* rowp = O + (size_t)(row0 + ai * HALF + m * 16) * ldc + col0;
#pragma unroll
                for (int bj = 0; bj < 2; ++bj) { *(f32x4*)(rowp + bj * HALF) = acc[ai][bj][m][0] * rs[bj][0]; *(f32x4*)(rowp + bj * HALF + 4) = acc[ai][bj][m][1] * rs[bj][1]; } }
    }
};
struct EpiSoftmax {
    static constexpr bool PERM = true, AFTER_DRAIN = true;
    bf16_t* P; int ldc; long sCb, sCh; int nH; const float* ss; float mul; int zrows;
    __device__ __forceinline__ void fused(f32x4 (&acc)[2][2][4][2], const Unit& u, int wr, int wc, int fr, int fq, PG8_LAS unsigned char* lds, int wid, int lane) const {
        PG8_LAS float* Pm = (PG8_LAS float*)lds;
        PG8_LAS float* Ps = (PG8_LAS float*)(lds + 4096);
#pragma unroll
        for (int ai = 0; ai < 2; ++ai)
#pragma unroll
            for (int m = 0; m < 4; ++m) { float mx = -3.0e38f;
                const float rs = __builtin_amdgcn_rsqf(ss[u.z * zrows + u.pm * BM + ai * HALF + wr * 64 + m * 16 + fr] * (1.f / DM) + EPS) * mul;
#pragma unroll
                for (int bj = 0; bj < 2; ++bj)
#pragma unroll
                    for (int n = 0; n < 2; ++n) { const f32x4 x = acc[ai][bj][m][n] * rs; acc[ai][bj][m][n] = x; mx = fmaxf(mx, fmaxf(fmaxf(x[0], x[1]), fmaxf(x[2], x[3]))); }
                mx = fmaxf(mx, __shfl_xor(mx, 16)); mx = fmaxf(mx, __shfl_xor(mx, 32));
                if (fq == 0) Pm[(ai * HALF + wr * 64 + m * 16 + fr) * 4 + wc] = mx; }
        asm volatile("s_waitcnt lgkmcnt(0)" ::: "memory"); __builtin_amdgcn_s_barrier(); asm volatile("" ::: "memory");
#pragma unroll
        for (int ai = 0; ai < 2; ++ai)
#pragma unroll
            for (int m = 0; m < 4; ++m) { const int r = ai * HALF + wr * 64 + m * 16 + fr;
                const f32x4 pm4 = *(const PG8_LAS f32x4*)(Pm + r * 4); const float M = fmaxf(fmaxf(pm4[0], pm4[1]), fmaxf(pm4[2], pm4[3])); float s = 0.f;
#pragma unroll
                for (int bj = 0; bj < 2; ++bj)
#pragma unroll
                    for (int n = 0; n < 2; ++n) { f32x4 x = acc[ai][bj][m][n];
#pragma unroll
                        for (int e = 0; e < 4; ++e) { x[e] = __builtin_amdgcn_exp2f(x[e] - M); s += x[e]; }
                        acc[ai][bj][m][n] = x; }
                s += __shfl_xor(s, 16); s += __shfl_xor(s, 32);
                if (fq == 0) Ps[r * 4 + wc] = s; }
        asm volatile("s_waitcnt lgkmcnt(0)" ::: "memory"); __builtin_amdgcn_s_barrier(); asm volatile("" ::: "memory");
        bf16_t* base = P + (u.z / nH) * sCb + (u.z % nH) * sCh;
        const int row0 = u.pm * BM, col0 = u.pn * BM + wc * 32 + 8 * fq;
#pragma unroll
        for (int ai = 0; ai < 2; ++ai)
#pragma unroll
            for (int m = 0; m < 4; ++m) { const int r = ai * HALF + wr * 64 + m * 16 + fr;
                const f32x4 ps4 = *(const PG8_LAS f32x4*)(Ps + r * 4); const float inv = 1.f / ((ps4[0] + ps4[1]) + (ps4[2] + ps4[3]));
                bf16_t* rowp = base + (size_t)(row0 + r) * ldc + col0;
#pragma unroll
                for (int bj = 0; bj < 2; ++bj) { const f32x4 v0 = acc[ai][bj][m][0] * inv, v1 = acc[ai][bj][m][1] * inv;
                    u32x4 w; w.x = cvt_pk_bf16(v0[0], v0[1]); w.y = cvt_pk_bf16(v0[2], v0[3]); w.z = cvt_pk_bf16(v1[0], v1[1]); w.w = cvt_pk_bf16(v1[2], v1[3]);
                    *(u32x4*)(rowp + bj * HALF) = w; } }
    }
};

template <class Epi, class Sched, bool ALIGN_EPI>
__device__ __forceinline__ void gemm_phase(PG8_LAS unsigned char* lds, const Gemm g, const Sched& S, const Epi& E) {
    const int tid = threadIdx.x, wid = __builtin_amdgcn_readfirstlane(tid >> 6), lane = tid & 63, wr = wid >> 2, wc = wid & 3, fr = lane & 15, fq = lane >> 4;
    const int K = g.K, nt = K / BK;
    unsigned voffA[2], voffB[2];
#pragma unroll
    for (int i = 0; i < 2; ++i) { int R, C; stage_rc(tid * 16 + i * 8192, R, C); const int Rb = Epi::PERM ? ((R & ~31) + perm32(R & 31)) : R;
        voffA[i] = (unsigned)(R * g.lda + C) * 2u; voffB[i] = (unsigned)(Rb * g.ldb + C) * 2u; }
    const size_t kstep = (size_t)(BK * 2);
    const size_t hsA = (size_t)HALF * g.lda * 2, hsB = (size_t)HALF * g.ldb * 2;
    const unsigned ldsw = (unsigned)wid * 1024u;
    const int aoff = lds_byte(wr * 64 + fr, fq * 8), boff = lds_byte(wc * 32 + fr, fq * 8);
#define PG8_SA(b, h) (((b) * 2 + (h)) * HTB)
#define PG8_SB(b, h) ((4 + (b) * 2 + (h)) * HTB)
#define PG8_STAGE(bufoff, gbase, voff) do { _Pragma("unroll") for (int _i = 0; _i < 2; ++_i) \
        __builtin_amdgcn_global_load_lds((const unsigned*)((const char*)(gbase) + (voff)[_i]), (PG8_LAS unsigned*)(lds + (bufoff) + ldsw + _i * 8192), 16, 0, 0); } while (0)
#define PG8_LDA(dst, b, h) do { _Pragma("unroll") for (int m = 0; m < 4; ++m) _Pragma("unroll") for (int k = 0; k < 2; ++k) dst[m][k] = *(const PG8_LAS bf16x8*)(lds + PG8_SA(b, h) + aoff + m * 2048 + k * 1024); } while (0)
#define PG8_LDB(dst, b, h) do { _Pragma("unroll") for (int n = 0; n < 2; ++n) _Pragma("unroll") for (int k = 0; k < 2; ++k) dst[n][k] = *(const PG8_LAS bf16x8*)(lds + PG8_SB(b, h) + boff + n * 2048 + k * 1024); } while (0)
#define PG8_MMA(ai, bj, At, Bt) do { __builtin_amdgcn_s_setprio(1); _Pragma("unroll") for (int m = 0; m < 4; ++m) _Pragma("unroll") for (int n = 0; n < 2; ++n) _Pragma("unroll") for (int k = 0; k < 2; ++k) \
        acc[ai][bj][m][n] = __builtin_amdgcn_mfma_f32_16x16x32_bf16(Bt[n][k], At[m][k], acc[ai][bj][m][n], 0, 0, 0); __builtin_amdgcn_s_setprio(0); } while (0)
#define PG8_WAIT_V(n) asm volatile("s_waitcnt vmcnt(" #n ")" ::: "memory")
#define PG8_WAIT_L(n) asm volatile("s_waitcnt lgkmcnt(" #n ")" ::: "memory")
#define PG8_BAR __builtin_amdgcn_s_barrier()
#define PG8_SCHED __builtin_amdgcn_sched_barrier(0)
    Unit cur, nxt; int ui = 0;
    if (!S.next(0, cur)) return;
    f32x4 acc[2][2][4][2];
#pragma unroll
    for (int a = 0; a < 2; ++a)
#pragma unroll
        for (int b = 0; b < 2; ++b)
#pragma unroll
            for (int m = 0; m < 4; ++m)
#pragma unroll
                for (int n = 0; n < 2; ++n) acc[a][b][m][n] = (f32x4){0.f, 0.f, 0.f, 0.f};
    bf16x8 At[4][2], B0[2][2], B1[2][2];
    const char* cA = (const char*)g.A + (size_t)cur.aoff * 2; const char* cB = (const char*)g.Bt + (size_t)cur.boff * 2;
    S.a_ready(cur);
    PG8_STAGE(PG8_SB(0, 0), cB, voffB); PG8_STAGE(PG8_SB(0, 1), cB + hsB, voffB); PG8_STAGE(PG8_SA(0, 0), cA, voffA); PG8_STAGE(PG8_SA(0, 1), cA + hsA, voffA);
    if (wr == 1) PG8_BAR;
    PG8_WAIT_V(2); PG8_BAR;
    PG8_STAGE(PG8_SB(1, 0), cB + kstep, voffB); PG8_STAGE(PG8_SA(1, 0), cA + kstep, voffA); PG8_STAGE(PG8_SB(1, 1), cB + hsB + kstep, voffB);
    PG8_WAIT_V(6); PG8_BAR;
    for (;;) {
        const bool has_next = S.next(ui + 1, nxt);
        const char* nA = has_next ? (const char*)g.A + (size_t)nxt.aoff * 2 : cA; const char* nB = has_next ? (const char*)g.Bt + (size_t)nxt.boff * 2 : cB;
        for (int t = 0; t < nt; t += 2) {
            const bool last = (t == nt - 2);
            const char* a1 = cA + (size_t)(t + 1) * kstep;
            const char* a2 = last ? nA : cA + (size_t)(t + 2) * kstep; const char* b2 = last ? nB : cB + (size_t)(t + 2) * kstep;
            const char* a3 = a2 + kstep; const char* b3 = b2 + kstep;
            if (last && has_next) S.a_ready(nxt);
            PG8_LDB(B0, 0, 0); PG8_LDB(B1, 0, 1); PG8_SCHED; PG8_LDA(At, 0, 0); PG8_STAGE(PG8_SA(1, 1), a1 + hsA, voffA);
            PG8_WAIT_V(8); PG8_WAIT_L(0); PG8_BAR; PG8_MMA(0, 0, At, B0); PG8_MMA(0, 1, At, B1); PG8_BAR; PG8_SCHED;
            PG8_LDA(At, 0, 1); PG8_STAGE(PG8_SB(0, 0), b2, voffB); PG8_STAGE(PG8_SB(0, 1), b2 + hsB, voffB); PG8_STAGE(PG8_SA(0, 0), a2, voffA);
            PG8_WAIT_V(8); PG8_WAIT_L(0); PG8_BAR; PG8_MMA(1, 0, At, B0); PG8_MMA(1, 1, At, B1); PG8_BAR; PG8_SCHED;
            PG8_LDB(B0, 1, 0); PG8_LDB(B1, 1, 1); PG8_SCHED; PG8_LDA(At, 1, 0); PG8_STAGE(PG8_SA(0, 1), a2 + hsA, voffA);
            PG8_WAIT_V(8); PG8_WAIT_L(0); PG8_BAR; PG8_MMA(0, 0, At, B0); PG8_MMA(0, 1, At, B1); PG8_BAR; PG8_SCHED;
            PG8_LDA(At, 1, 1); PG8_STAGE(PG8_SB(1, 0), b3, voffB); PG8_STAGE(PG8_SB(1, 1), b3 + hsB, voffB); PG8_STAGE(PG8_SA(1, 0), a3, voffA);
            PG8_WAIT_V(8); PG8_WAIT_L(0); PG8_BAR; PG8_MMA(1, 0, At, B0); PG8_MMA(1, 1, At, B1); PG8_BAR; PG8_SCHED;
        }
        if constexpr (ALIGN_EPI) { if (wr == 0) PG8_BAR; }
        if constexpr (!Epi::AFTER_DRAIN) { E(acc, cur, wr, wc, fr, fq); S.done(cur); }
        if (!has_next) break;
#pragma unroll
        for (int a = 0; a < 2; ++a)
#pragma unroll
            for (int b = 0; b < 2; ++b)
#pragma unroll
                for (int m = 0; m < 4; ++m)
#pragma unroll
                    for (int n = 0; n < 2; ++n) acc[a][b][m][n] = (f32x4){0.f, 0.f, 0.f, 0.f};
        cur = nxt; cA = nA; cB = nB; ++ui;
        if constexpr (ALIGN_EPI) { if (wr == 1) PG8_BAR; }
    }
    PG8_WAIT_V(0);
    if constexpr (!ALIGN_EPI) { if (wr == 0) PG8_BAR; }
    PG8_BAR;
    if constexpr (Epi::AFTER_DRAIN) { E.fused(acc, cur, wr, wc, fr, fq, lds, wid, lane); S.done(cur); }
#undef PG8_SA
#undef PG8_SB
#undef PG8_STAGE
#undef PG8_LDA
#undef PG8_LDB
#undef PG8_MMA
#undef PG8_WAIT_V
#undef PG8_WAIT_L
#undef PG8_BAR
#undef PG8_SCHED
}
}

namespace fox {
typedef unsigned short bf16_t;
typedef short bf16x8 __attribute__((ext_vector_type(8)));
typedef short s16x4 __attribute__((ext_vector_type(4)));
typedef float f32x16 __attribute__((ext_vector_type(16)));
typedef float f32x4 __attribute__((ext_vector_type(4)));
typedef unsigned u32x4 __attribute__((ext_vector_type(4)));
constexpr int D = 128, NW = 8, QBLK = 32, KVBLK = 64, QB = NW * QBLK;
constexpr int SHM_V = KVBLK * D * 2, SHM_K = KVBLK * D * 2;
constexpr int LDS_C = 2 * SHM_V + 2 * SHM_K + NW * 64 * 4;
constexpr int LDS_BYTES = LDS_C + SEQ * 4;
constexpr int QP = 4096, OP = 2048;
constexpr float THR = 24.f;
#define KSWZ(row, colB) ((row) * 256 + ((colB) ^ (((row) & 7) << 4)))
#define SBAR() __builtin_amdgcn_sched_barrier(0)
__device__ __forceinline__ int v_st(int k, int c) { const int kk = (k & ~0xC) | ((k & 4) << 1) | ((k & 8) >> 1); return ((kk >> 3) * 4 + (c >> 5)) * 512 + ((kk & 7) * 32 + (c & 31)) * 2; }
__device__ __forceinline__ int v_rd_base(int lane) { return ((lane & 3) << 3) | (((lane >> 2) & 3) << 6) | (((lane >> 4) & 1) << 5) | (((lane >> 5) & 1) << 8); }
constexpr int v_rd_off(int d0, int ks, int half) { return d0 * 512 + ks * 4096 + half * 2048; }
__device__ __forceinline__ int crow(int r, int hi) { return (r & 3) + 8 * (r >> 2) + 4 * hi; }
__device__ __forceinline__ unsigned cvtpk(float lo, float hi) { unsigned r; asm volatile("v_cvt_pk_bf16_f32 %0, %1, %2" : "=v"(r) : "v"(lo), "v"(hi)); return r; }
__device__ __forceinline__ bf16x8 load8(const bf16_t* p) { return *reinterpret_cast<const bf16x8*>(p); }
__device__ __forceinline__ void mask_tile(f32x16& p0, f32x16& p1, int dq) {
    const float NEG = -__builtin_inff();
#pragma unroll
    for (int r = 0; r < 16; ++r) { const int c = (r & 3) + 8 * (r >> 2); if (dq - c < 0) p0[r] = NEG; if (dq - c - 32 < 0) p1[r] = NEG; }
}
__device__ __forceinline__ void bias_tile(f32x16& p0, f32x16& p1, const float* cb) {
#pragma unroll
    for (int i = 0; i < 4; ++i) { const f32x4 c0 = *(const f32x4*)(cb + 8 * i), c1 = *(const f32x4*)(cb + 32 + 8 * i);
#pragma unroll
        for (int j = 0; j < 4; ++j) { p0[4 * i + j] -= c0[j]; p1[4 * i + j] -= c1[j]; } }
}
__device__ __forceinline__ void partialSM(f32x16& p0, f32x16& p1, float& m_reg, float& mn, float& alpha) {
    float pmax = p0[0]; for (int r = 1; r < 16; ++r) pmax = fmaxf(pmax, p0[r]); for (int r = 0; r < 16; ++r) pmax = fmaxf(pmax, p1[r]);
    { auto rr = __builtin_amdgcn_permlane32_swap(__float_as_uint(pmax), __float_as_uint(pmax), false, false);
      pmax = fmaxf(__uint_as_float(rr[0]), __uint_as_float(rr[1])); }
    if (__builtin_expect(__all((pmax - m_reg) <= THR), 1)) { mn = m_reg; alpha = 1.f; }
    else { mn = fmaxf(m_reg, pmax); alpha = __builtin_amdgcn_exp2f(m_reg - mn); m_reg = mn; }
    for (int r = 0; r < 16; ++r) p0[r] = p0[r] - mn; for (int r = 0; r < 16; ++r) p1[r] = p1[r] - mn;
    for (int r = 0; r < 16; ++r) p0[r] = __builtin_amdgcn_exp2f(p0[r]);
}
__device__ __forceinline__ void finishSM(f32x16& p0, f32x16& p1, float alpha, float& l_reg, bf16x8& pa0, bf16x8& pa1, bf16x8& pa2, bf16x8& pa3) {
    for (int r = 0; r < 16; ++r) p1[r] = __builtin_amdgcn_exp2f(p1[r]);
    float ps = 0; for (int r = 0; r < 16; ++r) ps += p0[r]; for (int r = 0; r < 16; ++r) ps += p1[r];
    { auto rr = __builtin_amdgcn_permlane32_swap(__float_as_uint(ps), __float_as_uint(ps), false, false);
      ps = __uint_as_float(rr[0]) + __uint_as_float(rr[1]); }
    l_reg = l_reg * alpha + ps;
#define PK4(P, B_, OUT) do { unsigned a0 = cvtpk(P[B_+0], P[B_+1]), a1 = cvtpk(P[B_+2], P[B_+3]);                          \
        unsigned b0 = cvtpk(P[B_+4], P[B_+5]), b1 = cvtpk(P[B_+6], P[B_+7]);                                             \
        auto r0 = __builtin_amdgcn_permlane32_swap(a0, b0, false, false); auto r1 = __builtin_amdgcn_permlane32_swap(a1, b1, false, false); \
        u32x4 w = {r0[0], r1[0], r0[1], r1[1]}; OUT = *reinterpret_cast<bf16x8*>(&w); } while (0)
    PK4(p0, 0, pa0); PK4(p0, 8, pa1); PK4(p1, 0, pa2); PK4(p1, 8, pa3);
#undef PK4
}
template <int KB>
__device__ __forceinline__ void qkt(f32x16& p0, f32x16& p1, const char* K_lds, int r32, int hi, const bf16x8* qr) {
    p0 = f32x16{}; p1 = f32x16{};
    const char* kb[4];
#pragma unroll
    for (int dd = 0; dd < 4; ++dd) kb[dd] = K_lds + KB * SHM_K + KSWZ(r32, (dd * 16 + hi * 8) * 2);
#pragma unroll
    for (int d0 = 0; d0 < 8; ++d0) { const char* a = kb[d0 & 3] + (d0 >> 2) * 128;
        bf16x8 b0 = *reinterpret_cast<const bf16x8*>(a);
        bf16x8 b1 = *reinterpret_cast<const bf16x8*>(a + 32 * 256);
        p0 = __builtin_amdgcn_mfma_f32_32x32x16_bf16(b0, qr[d0], p0, 0, 0, 0);
        p1 = __builtin_amdgcn_mfma_f32_32x32x16_bf16(b1, qr[d0], p1, 0, 0, 0); }
}
template <int VB>
__device__ __forceinline__ void pv_tile(f32x16* o, int vb0, bf16x8 pa0, bf16x8 pa1, bf16x8 pa2, bf16x8 pa3) {
#define TRRD(dst, off) asm volatile("ds_read_b64_tr_b16 %0, %1 offset:%2" : "=&v"(dst) : "v"(vb0), "i"(off) : "memory")
#define PV_D0(d0) do { s16x4 l0, l1, l2, l3, h0, h1, h2, h3; constexpr int b_ = VB * SHM_V + v_rd_off(d0, 0, 0); \
        TRRD(l0, b_); TRRD(h0, b_ + 2048); TRRD(l1, b_ + 4096); TRRD(h1, b_ + 6144); TRRD(l2, b_ + 8192); TRRD(h2, b_ + 10240); TRRD(l3, b_ + 12288); TRRD(h3, b_ + 14336); \
        asm volatile("s_waitcnt lgkmcnt(0)" ::: "memory"); SBAR();   \
        o[d0] = __builtin_amdgcn_mfma_f32_32x32x16_bf16(pa0, (bf16x8){l0[0], l0[1], l0[2], l0[3], h0[0], h0[1], h0[2], h0[3]}, o[d0], 0, 0, 0);   \
        o[d0] = __builtin_amdgcn_mfma_f32_32x32x16_bf16(pa1, (bf16x8){l1[0], l1[1], l1[2], l1[3], h1[0], h1[1], h1[2], h1[3]}, o[d0], 0, 0, 0);   \
        o[d0] = __builtin_amdgcn_mfma_f32_32x32x16_bf16(pa2, (bf16x8){l2[0], l2[1], l2[2], l2[3], h2[0], h2[1], h2[2], h2[3]}, o[d0], 0, 0, 0);   \
        o[d0] = __builtin_amdgcn_mfma_f32_32x32x16_bf16(pa3, (bf16x8){l3[0], l3[1], l3[2], l3[3], h3[0], h3[1], h3[2], h3[3]}, o[d0], 0, 0, 0); } while (0)
    PV_D0(0); PV_D0(1); PV_D0(2); PV_D0(3);
#undef PV_D0
#undef TRRD
}
struct BlockRef { const bf16_t* Q; const bf16_t* K; const bf16_t* V; bf16_t* O; int P0; };
struct Seam { bf16x8 qr[8]; bf16x8 st_v0, st_v1, st_k0, st_k1; };
#define ROW(p, k0, rr) ((p) + (size_t)((k0) + (rr)) * QP + sc)
#define VMW() asm volatile("s_waitcnt vmcnt(0)" ::: "memory")
#define VMWN(n) asm volatile("s_waitcnt vmcnt(%0)" :: "i"(n) : "memory")
#define SLOAD_H(Kp, Vp, k0) do { S.st_v0 = load8(ROW(Vp, k0, sr)); S.st_v1 = load8(ROW(Vp, k0, 32 + sr)); S.st_k0 = load8(ROW(Kp, k0, sr)); S.st_k1 = load8(ROW(Kp, k0, 32 + sr)); } while (0)
#define SWRITE_HK(bf) do { *(bf16x8*)(K_lds + (bf) * SHM_K + kws) = S.st_k0; *(bf16x8*)(K_lds + (bf) * SHM_K + kws + 32 * 256) = S.st_k1; } while (0)
#define SWRITE_HV(bf) do { *(bf16x8*)(V_lds + (bf) * SHM_V + vst0) = S.st_v0; *(bf16x8*)(V_lds + (bf) * SHM_V + vst1) = S.st_v1; } while (0)
#define SWRITE_H(bf) do { SWRITE_HV(bf); SWRITE_HK(bf); } while (0)
__device__ __forceinline__ void prime(const BlockRef& cur, int j_lo, char* lds, Seam& S) {
    const int tid = threadIdx.x, wid = __builtin_amdgcn_readfirstlane(tid >> 6), lane = tid & 63, r32 = lane & 31, hi = lane >> 5;
    const int sr = tid >> 4, sc = (tid & 15) * 8, kws = KSWZ(sr, sc * 2); char* K_lds = lds + 2 * SHM_V;
    for (int d0 = 0; d0 < 8; ++d0) S.qr[d0] = load8(cur.Q + (size_t)(wid * QBLK + r32) * QP + d0 * 16 + hi * 8);
    SLOAD_H(cur.K, cur.V, j_lo * KVBLK); VMW(); SWRITE_HK(0);
    __syncthreads();
}
__device__ __forceinline__ void block(const BlockRef& cur, const BlockRef& nxt, int j_lo, char* lds, Seam& S) {
    const int tid = threadIdx.x, wid = __builtin_amdgcn_readfirstlane(tid >> 6), lane = tid & 63, r32 = lane & 31, hi = lane >> 5;
    const int NT = (cur.P0 + QB - 1) / KVBLK + 1 - j_lo;
    const int qlo = cur.P0 + wid * QBLK, qm = qlo + r32 - 4 * hi;
    char* V_lds = lds; char* K_lds = lds + 2 * SHM_V;
    float* ws = (float*)(lds + 2 * SHM_V + 2 * SHM_K) + wid * 64; float* li_l = ws, * al_l = ws + 32;
    const float* c_lds = (const float*)(lds + LDS_C) + 4 * hi;
    float m_reg = -1e30f, l_reg = 0; f32x16 o[4] = {};
    const int sr = tid >> 4, sc = (tid & 15) * 8, vst0 = v_st(sr, sc), vst1 = v_st(32 + sr, sc), kws = KSWZ(sr, sc * 2);
    const int vb0 = (int)(uintptr_t)V_lds + v_rd_base(lane);
    const bf16_t* Kh = cur.K; const bf16_t* Vh = cur.V;
#define RESC(a) do { if (__any((a) < 1.f)) { if (hi == 0) al_l[r32] = (a); asm volatile("s_waitcnt lgkmcnt(0)" ::: "memory");              \
                     for (int d_ = 0; d_ < 4; ++d_) for (int r = 0; r < 16; ++r) o[d_][r] *= al_l[crow(r, hi)]; } } while (0)
#define KBASE(t) ((j_lo + (t)) * KVBLK)
#define MASKT(P0_, P1_, t) do { const int kb_ = KBASE(t); bias_tile(P0_, P1_, c_lds + kb_); if (kb_ + KVBLK - 1 > qlo) mask_tile(P0_, P1_, qm - kb_); } while (0)
#define SEAM_K0() do { VMWN(8); SWRITE_HK(0); SBAR(); } while (0)
    f32x16 pA0, pA1, pB0, pB1; float mnA, mnB, alA, alB; bf16x8 pa0, pa1, pa2, pa3;
    SWRITE_HV(0); SBAR();
    if (NT > 1) { SLOAD_H(Kh, Vh, KBASE(1)); }
    SBAR(); qkt<0>(pA0, pA1, K_lds, r32, hi, S.qr);
    MASKT(pA0, pA1, 0); partialSM(pA0, pA1, m_reg, mnA, alA);
    if (NT > 1) { VMW(); SWRITE_H(1); }
    __syncthreads();
#define HALF_STEP(PX0, PX1, mnX, alX, PY0, PY1, alY, t, KB, VB, SB) do {                                                      \
        SBAR(); qkt<KB>(PX0, PX1, K_lds, r32, hi, S.qr);                                                                     \
        finishSM(PY0, PY1, alY, l_reg, pa0, pa1, pa2, pa3); SBAR();                                                           \
        if ((t) + 1 < NT) { SLOAD_H(Kh, Vh, KBASE((t) + 1)); SBAR(); }                                                        \
        pv_tile<VB>(o, vb0, pa0, pa1, pa2, pa3); MASKT(PX0, PX1, (t)); partialSM(PX0, PX1, m_reg, mnX, alX);                 \
        __syncthreads();                                                                                                      \
        if ((t) + 1 < NT) { VMW(); SWRITE_H(SB); }                                                                            \
        RESC(alX); __syncthreads(); } while (0)
    for (int t = 1; t + 1 < NT; t += 2) {
        HALF_STEP(pB0, pB1, mnB, alB, pA0, pA1, alA, t, 1, 0, 0);
        HALF_STEP(pA0, pA1, mnA, alA, pB0, pB1, alB, t + 1, 0, 1, 1);
    }
    const bool even = (NT & 1) == 0;
    if (even) { SBAR(); qkt<1>(pB0, pB1, K_lds, r32, hi, S.qr); SBAR(); }
    SLOAD_H(nxt.K, nxt.V, j_lo * KVBLK); SBAR();
#pragma unroll
    for (int d0 = 0; d0 < 8; ++d0) S.qr[d0] = load8(nxt.Q + (size_t)(wid * QBLK + r32) * QP + d0 * 16 + hi * 8);
    SBAR();
    finishSM(pA0, pA1, alA, l_reg, pa0, pa1, pa2, pa3); SBAR();
    pv_tile<0>(o, vb0, pa0, pa1, pa2, pa3);
    if (even) { MASKT(pB0, pB1, NT - 1); partialSM(pB0, pB1, m_reg, mnB, alB); __syncthreads(); RESC(alB);
        finishSM(pB0, pB1, alB, l_reg, pa0, pa1, pa2, pa3); SBAR(); pv_tile<1>(o, vb0, pa0, pa1, pa2, pa3); }
    SBAR(); SEAM_K0();
    if (hi == 0) li_l[r32] = l_reg; asm volatile("s_waitcnt lgkmcnt(0)" ::: "memory");
    float rli[16];
#pragma unroll
    for (int r = 0; r < 16; ++r) rli[r] = __builtin_amdgcn_rcpf(li_l[crow(r, hi)]);
    bf16_t* Ow = cur.O + (size_t)(wid * QBLK) * OP;
#pragma unroll
    for (int r = 0; r < 16; ++r) { const int orow = crow(r, hi);
#pragma unroll
        for (int d0 = 0; d0 < 4; ++d0) { const float v = o[d0][r] * rli[r];
            const float vn = __shfl_xor(v, 1);
            if ((r32 & 1) == 0) *(unsigned*)(Ow + (size_t)orow * OP + d0 * 32 + r32) = cvtpk(v, vn); } }
    __syncthreads();
#undef RESC
#undef KBASE
#undef MASKT
#undef SEAM_K0
#undef HALF_STEP
}
#undef ROW
#undef VMW
#undef VMWN
#undef SLOAD_H
#undef SWRITE_HK
#undef SWRITE_HV
#undef SWRITE_H
#undef KSWZ
#undef SBAR
}

constexpr int NWAVES = 8, NTHREADS = 512;
constexpr int LDS_BYTES = 147456;
constexpr int LDS_MISC = 145408;
constexpr size_t MiB = 1u << 20;
constexpr size_t WS_CTL = 0, CTL_ZERO_BYTES = 1 * MiB;
#ifndef QSPLIT
#define QSPLIT 1024
#endif
constexpr int CW_QUEUE2 = 128;
constexpr int CW_NRM = 512;
constexpr int CW_QUEUE = 64;
constexpr int CW_BAR = 4096;
constexpr size_t CTL_SS1 = 256 * 1024, CTL_SS2 = 320 * 1024;
constexpr size_t WS_LF = 1 * MiB;
constexpr size_t WS_SU = 1 * MiB + 512 * 1024, WS_SV = 1 * MiB + 640 * 1024;
constexpr size_t WS_WIN = 2 * MiB, WS_WO1 = 18 * MiB, WS_WO2 = 26 * MiB, WS_WQ = 34 * MiB, WS_WK = 42 * MiB, WS_WV = 50 * MiB, WS_WO = 58 * MiB;
constexpr size_t WS_WPQ = 66 * MiB, WS_AEXP = 74 * MiB, WS_WSC = 82 * MiB, WS_PB = 90 * MiB, WS_MN = 91 * MiB, WS_KX = 93 * MiB, WS_VXT = 95 * MiB;
constexpr size_t WS_UB = 98 * MiB, WS_VB = 130 * MiB, WS_XN = 226 * MiB, WS_PROJ = 258 * MiB, WS_AMIX = 322 * MiB, WS_H = 354 * MiB, WS_HB = 418 * MiB, WS_P = 450 * MiB, WS_END = 466 * MiB;

#define GAS __attribute__((address_space(1)))
#define LAS __attribute__((address_space(3)))
typedef unsigned short bf16;
typedef unsigned v4u __attribute__((ext_vector_type(4)));
typedef unsigned v2u __attribute__((ext_vector_type(2)));
typedef float f32x4 __attribute__((ext_vector_type(4)));
typedef __bf16 bf16x2_t __attribute__((ext_vector_type(2)));
#define LDS_WAIT() asm volatile("s_waitcnt lgkmcnt(0)" ::: "memory")
__device__ __forceinline__ unsigned f2bf(float f) { unsigned u = __builtin_bit_cast(unsigned, f); return (u + 0x7fffu + ((u >> 16) & 1u)) >> 16; }
__device__ __forceinline__ unsigned pk2(float lo, float hi) { return f2bf(lo) | (f2bf(hi) << 16); }
__device__ __forceinline__ float wave_sum(float v) {
#pragma unroll
    for (int o = 1; o < 64; o <<= 1) v += __shfl_xor(v, o);
    return v;
}

#define XB_TMO      128
#define XB_XCNT(j)  (256  + 64 * (j))
#define XB_XSUB(j)  (1280 + 64 * (j))
#define XB_XGEN(j)  (2304 + 64 * (j))
#define XB_TOP      3328
#define XB_TOPGEN   3392
#define XCD_BAR_WORDS 3456
#define XB_SPIN_CAP (1u << 22)
__device__ __forceinline__ unsigned xb_ld(unsigned* p)              { return __hip_atomic_load(p, __ATOMIC_RELAXED, __HIP_MEMORY_SCOPE_AGENT); }
__device__ __forceinline__ unsigned xb_add(unsigned* p, unsigned v) { return __hip_atomic_fetch_add(p, v, __ATOMIC_RELAXED, __HIP_MEMORY_SCOPE_AGENT); }
__device__ __forceinline__ unsigned xb_xcc_id() { return (unsigned)__builtin_amdgcn_s_getreg((3 << 11) | 20) & 0xFu; }
#define XB_SPIN(cond, bar) do { unsigned _sp = 0; while (cond) { __builtin_amdgcn_s_sleep(1); \
    if ((++_sp & 255u) == 0u) { if (xb_ld(&(bar)[XB_TMO])) break; if (_sp > XB_SPIN_CAP) { atomicAdd(&(bar)[XB_TMO], 1u); break; } } } } while (0)
struct XcdBarrier { unsigned* bar; unsigned x; volatile LAS unsigned* st; };
__device__ __forceinline__ XcdBarrier xcd_barrier_post(unsigned* bar, volatile LAS unsigned* st) {
    XcdBarrier b; b.bar = bar; b.x = xb_xcc_id(); b.st = st;
    if (threadIdx.x == 0) (void)xb_add(&bar[XB_XCNT(b.x)], 1u);
    return b;
}
__device__ __forceinline__ void xcd_barrier_complete(unsigned* bar, unsigned x, unsigned& nloc, unsigned& nx) {
    const unsigned G = gridDim.x * gridDim.y * gridDim.z;
    unsigned sum, cnt, mine, sp = 0u;
    for (;;) {
        sum = 0u; cnt = 0u; mine = 0u;
#pragma unroll
        for (unsigned j = 0; j < 16; ++j) { const unsigned c = xb_ld(&bar[XB_XCNT(j)]); sum += c; cnt += (c > 0u) ? 1u : 0u; mine = (j == x) ? c : mine; }
        if (sum == G) break;
        __builtin_amdgcn_s_sleep(1);
        if ((++sp & 255u) == 0u) { if (xb_ld(&bar[XB_TMO])) break; if (sp > XB_SPIN_CAP) { atomicAdd(&bar[XB_TMO], 1u); break; } }
    }
    nloc = mine > 0u ? mine : 1u; nx = cnt > 0u ? cnt : 1u;
}
__device__ __forceinline__ void xcd_barrier(const XcdBarrier& b) {
    asm volatile("s_waitcnt vmcnt(0)" ::: "memory");
    __syncthreads();
    if (threadIdx.x == 0) {
        unsigned* bar = b.bar;
        __builtin_amdgcn_s_waitcnt(0);
        unsigned nloc = b.st[0], nx = b.st[1];
        if (nloc == 0u) { xcd_barrier_complete(bar, b.x, nloc, nx); b.st[0] = nloc; b.st[1] = nx; }
        const unsigned old = xb_add(&bar[XB_XSUB(b.x)], 1u);
        const unsigned gen = old / nloc;
        if (old + 1u == (gen + 1u) * nloc) {
            __builtin_amdgcn_fence(__ATOMIC_RELEASE, "agent");
            asm volatile("s_waitcnt vmcnt(0)" ::: "memory");
            const unsigned og = xb_add(&bar[XB_TOP], 1u);
            const unsigned tg = og / nx;
            if (og + 1u == (tg + 1u) * nx) xb_add(&bar[XB_TOPGEN], 1u);
            else XB_SPIN(xb_ld(&bar[XB_TOPGEN]) == tg, bar);
            __builtin_amdgcn_fence(__ATOMIC_ACQUIRE, "agent");
            xb_add(&bar[XB_XGEN(b.x)], 1u);
            asm volatile("s_waitcnt vmcnt(0)" ::: "memory");
        } else {
            XB_SPIN(xb_ld(&bar[XB_XGEN(b.x)]) == gen, bar);
            __builtin_amdgcn_fence(__ATOMIC_ACQUIRE, "agent");
            asm volatile("s_waitcnt vmcnt(0)" ::: "memory");
        }
    }
    __syncthreads();
}

struct Args { const float* in[20]; float* out; unsigned char* ws; int ph_lo, ph_hi; int one_launch, pad; };

__device__ __forceinline__ void tr_load(const float* W, int ldw, int nblk, int item, int lane, f32x4 (&tv)[8]) {
    const int kb = item / nblk, nb = item % nblk, k0 = 64 * kb, n0 = 32 * nb;
#pragma unroll
    for (int i = 0; i < 8; ++i) tv[i] = *(const GAS f32x4*)(W + (size_t)(k0 + i * 8 + (lane >> 3)) * ldw + n0 + (lane & 7) * 4);
}
__device__ __forceinline__ void tr_store(const f32x4 (&tv)[8], int nblk, bf16* WT, bf16* WT2, int k2lo, int ldt, LAS float* scr, int item, int lane) {
    const int kb = item / nblk, nb = item % nblk, k0 = 64 * kb, n0 = 32 * nb;
#pragma unroll
    for (int i = 0; i < 8; ++i) { const int kk = i * 8 + (lane >> 3); LAS float* d = scr + kk * 33 + (lane & 7) * 4; d[0] = tv[i][0]; d[1] = tv[i][1]; d[2] = tv[i][2]; d[3] = tv[i][3]; }
    LDS_WAIT(); asm volatile("" ::: "memory");
    const int c = lane & 7;
#pragma unroll
    for (int j = 0; j < 4; ++j) { const int n = (lane >> 3) + 8 * j; const LAS float* s = scr + (8 * c) * 33 + n;
        v4u o; o.x = pk2(s[0 * 33], s[1 * 33]); o.y = pk2(s[2 * 33], s[3 * 33]); o.z = pk2(s[4 * 33], s[5 * 33]); o.w = pk2(s[6 * 33], s[7 * 33]);
        *(GAS v4u*)(WT + (size_t)(n0 + n) * ldt + k0 + 8 * c) = o;
        if (WT2 && k0 >= k2lo) *(GAS v4u*)(WT2 + (size_t)(n0 + n) * ldt + k0 + 8 * c) = o; }
    LDS_WAIT(); asm volatile("" ::: "memory");
}
__device__ __forceinline__ void p0_transpose_item(const float* W, int ldw, int nblk, const float* g, bf16* WT, bf16* WT2, int k2lo, int ldt, LAS float* scr, int item, int lane) {
    (void)g; f32x4 tv[8]; tr_load(W, ldw, nblk, item, lane, tv); tr_store(tv, nblk, WT, WT2, k2lo, ldt, scr, item, lane);
}
__device__ __forceinline__ v4u cvt8(const float* p, float s) {
    const f32x4 a = *(const f32x4*)p, b = *(const f32x4*)(p + 4);
    v4u o; o.x = pk2(a[0] * s, a[1] * s); o.y = pk2(a[2] * s, a[3] * s); o.z = pk2(b[0] * s, b[1] * s); o.w = pk2(b[2] * s, b[3] * s); return o;
}

__device__ __forceinline__ float gelu_f(float v) {
    const float av = fabsf(v), t = __builtin_amdgcn_rcpf(av * 0.2316418882f + 1.0f);
    float q = t * 0.5307027145f + (-0.7265760135f); q = q * t + 0.7107068705f; q = q * t + (-0.142248368f); q = q * t + 0.127414796f; q = q * t;
    const float e = __builtin_amdgcn_exp2f((v * v) * (-0.72134752044f));
    const float m = v * (q * e);
    return v < 0.f ? m : v - m;
}
__device__ __forceinline__ float dot2bf(unsigned a, unsigned b, float c) { return __builtin_amdgcn_fdot2_f32_bf16(__builtin_bit_cast(bf16x2_t, a), __builtin_bit_cast(bf16x2_t, b), c, false); }
__device__ __forceinline__ unsigned fkey(float f) { const unsigned u = __float_as_uint(f); return (u & 0x80000000u) ? ~u : (u | 0x80000000u); }
__device__ __forceinline__ float fdec(unsigned k) { const unsigned u = (k & 0x80000000u) ? (k & 0x7fffffffu) : ~k; return __uint_as_float(u); }


typedef float f32x2v __attribute__((ext_vector_type(2)));
__device__ __forceinline__ float wave_sum_dpp(float v) {
    v += __builtin_bit_cast(float, __builtin_amdgcn_update_dpp(0, __builtin_bit_cast(int, v), 0xB1, 0xf, 0xf, true));
    v += __builtin_bit_cast(float, __builtin_amdgcn_update_dpp(0, __builtin_bit_cast(int, v), 0x4E, 0xf, 0xf, true));
    v += __builtin_bit_cast(float, __builtin_amdgcn_update_dpp(0, __builtin_bit_cast(int, v), 0x141, 0xf, 0xf, true));
    v += __builtin_bit_cast(float, __builtin_amdgcn_update_dpp(0, __builtin_bit_cast(int, v), 0x140, 0xf, 0xf, true));
    const float a = __builtin_bit_cast(float, __builtin_amdgcn_readlane(__builtin_bit_cast(int, v), 0));
    const float b = __builtin_bit_cast(float, __builtin_amdgcn_readlane(__builtin_bit_cast(int, v), 16));
    const float c = __builtin_bit_cast(float, __builtin_amdgcn_readlane(__builtin_bit_cast(int, v), 32));
    const float d = __builtin_bit_cast(float, __builtin_amdgcn_readlane(__builtin_bit_cast(int, v), 48));
    return (a + b) + (c + d);
}
typedef float v32f __attribute__((ext_vector_type(32)));
typedef float v16f __attribute__((ext_vector_type(16)));
typedef unsigned v6u __attribute__((ext_vector_type(6)));
#ifndef FP6_INTERLEAVED
#define FP6_INTERLEAVED 1
#endif
__device__ __forceinline__ v32f dec_fp6(const v4u a, const v2u b) { const v6u w = {a.x, a.y, a.z, a.w, b.x, b.y}; return __builtin_amdgcn_cvt_scalef32_pk32_f32_fp6(w, 1.0f); }
typedef __bf16 v32bf __attribute__((ext_vector_type(32)));
typedef unsigned v16u __attribute__((ext_vector_type(16)));
__device__ __forceinline__ float peer_dot(const v4u ua, const v2u ub, const unsigned (&xnp)[16]) {
    const v6u w = {ua.x, ua.y, ua.z, ua.w, ub.x, ub.y};
    const v16u fu = __builtin_bit_cast(v16u, __builtin_amdgcn_cvt_scalef32_pk32_bf16_fp6(w, 1.0f));
    unsigned fa[16];
#pragma unroll
    for (int i = 0; i < 16; ++i) fa[i] = fu[i];
    float a[4] = {0.f, 0.f, 0.f, 0.f};
#pragma unroll
    for (int i = 0; i < 16; ++i) a[i & 3] = dot2bf(fa[i], xnp[i], a[i & 3]);
    return (a[0] + a[1]) + (a[2] + a[3]);
}
__device__ __forceinline__ float peer_dot_lds(const v4u ua, const v2u ub, const LAS v4u* xl) {
    const v6u w = {ua.x, ua.y, ua.z, ua.w, ub.x, ub.y};
    const v16u fu = __builtin_bit_cast(v16u, __builtin_amdgcn_cvt_scalef32_pk32_bf16_fp6(w, 1.0f));
    unsigned fa[16];
#pragma unroll
    for (int i = 0; i < 16; ++i) fa[i] = fu[i];
    float a[4] = {0.f, 0.f, 0.f, 0.f};
#pragma unroll
    for (int i4 = 0; i4 < 4; ++i4) { const v4u x4 = xl[i4 * 64];
        a[0] = dot2bf(fa[i4 * 4 + 0], x4.x, a[0]); a[1] = dot2bf(fa[i4 * 4 + 1], x4.y, a[1]); a[2] = dot2bf(fa[i4 * 4 + 2], x4.z, a[2]); a[3] = dot2bf(fa[i4 * 4 + 3], x4.w, a[3]); }
    return (a[0] + a[1]) + (a[2] + a[3]);
}
typedef _Float16 h16x2 __attribute__((ext_vector_type(2)));
__device__ __forceinline__ unsigned pkfma_h(unsigned a, unsigned b, unsigned c) { return __builtin_bit_cast(unsigned, __builtin_elementwise_fma(__builtin_bit_cast(h16x2, a), __builtin_bit_cast(h16x2, b), __builtin_bit_cast(h16x2, c))); }
__device__ __forceinline__ float h16lo(unsigned u) { return (float)__builtin_bit_cast(h16x2, u).x; }
__device__ __forceinline__ float h16hi(unsigned u) { return (float)__builtin_bit_cast(h16x2, u).y; }
__device__ __forceinline__ void peer_axpy_h(const v4u va, const v2u vb, float w, unsigned (&oh)[16]) {
    const v6u wv = {va.x, va.y, va.z, va.w, vb.x, vb.y};
    const v16u fu = __builtin_bit_cast(v16u, __builtin_amdgcn_cvt_scalef32_pk32_f16_fp6(wv, 1.0f));
    unsigned fa[16];
#pragma unroll
    for (int i = 0; i < 16; ++i) fa[i] = fu[i];
    const h16x2 w2 = {(_Float16)w, (_Float16)w}; const unsigned wu = __builtin_bit_cast(unsigned, w2);
#pragma unroll
    for (int i = 0; i < 16; ++i) oh[i] = pkfma_h(fa[i], wu, oh[i]);
}
__device__ __forceinline__ void peer_axpy(const v4u va, const v2u vb, float w, float (&oacc)[32]) {
    const v32f f = dec_fp6(va, vb);
#pragma unroll
    for (int i = 0; i < 32; ++i) oacc[i] = fmaf(w, f[i], oacc[i]);
}


__device__ __forceinline__ void conv_rows2_fp6(const float* srow0, const float* srow1, unsigned char* drow0, unsigned char* drow1, float* sc0, float* sc1, int lane) {
    f32x4 v[2][8]; float am[2] = {0.f, 0.f};
#pragma unroll
    for (int q = 0; q < 8; ++q) { v[0][q] = *(const GAS f32x4*)(srow0 + lane * 4 + q * 256); v[1][q] = *(const GAS f32x4*)(srow1 + lane * 4 + q * 256); }
#pragma unroll
    for (int r = 0; r < 2; ++r)
#pragma unroll
        for (int q = 0; q < 8; ++q) am[r] = fmaxf(am[r], fmaxf(fmaxf(fabsf(v[r][q][0]), fabsf(v[r][q][1])), fmaxf(fabsf(v[r][q][2]), fabsf(v[r][q][3]))));
#pragma unroll
    for (int o = 1; o < 64; o <<= 1) { am[0] = fmaxf(am[0], __shfl_xor(am[0], o)); am[1] = fmaxf(am[1], __shfl_xor(am[1], o)); }
#pragma unroll
    for (int r = 0; r < 2; ++r) {
        int ex = 0; if (am[r] > 0.f) { (void)frexpf(am[r], &ex); ex = 3 - ex; if (ldexpf(am[r], ex) > 7.5f) ex -= 1; }
        const float sc = ldexpf(1.f, ex);
        if (lane == 0) *(r ? sc1 : sc0) = ldexpf(1.f, -ex);
        v16f xa, xb;
#pragma unroll
        for (int i = 0; i < 16; ++i) { xa[i] = v[r][(2 * i) >> 2][(2 * i) & 3] * sc; xb[i] = v[r][(2 * i + 1) >> 2][(2 * i + 1) & 3] * sc; }
        const v6u w = __builtin_amdgcn_cvt_scalef32_2xpk16_fp6_f32(xa, xb, 1.0f);
        unsigned char* drow = r ? drow1 : drow0;
        *(GAS v4u*)(drow + lane * 16) = (v4u){w[0], w[1], w[2], w[3]};
        *(GAS v2u*)(drow + 1024 + lane * 8) = (v2u){w[4], w[5]};
    }
}

#if defined(PROBE_SEL) && PROBE_SEL < 7
#define PROBE_EXPORT(T_, q) do { if ((T_) == 0 && lane == 0 && (q) == 0) { const unsigned long long a_ = ((unsigned long long)MISC[33 + 2 * PROBE_SEL] << 32) | MISC[32 + 2 * PROBE_SEL], b_ = ((unsigned long long)MISC[35 + 2 * PROBE_SEL] << 32) | MISC[34 + 2 * PROBE_SEL]; o[0] += (float)(b_ - a_) * 0.001f; } } while (0)
#else
#define PROBE_EXPORT(T_, q) do { } while (0)
#endif
__global__ void __launch_bounds__(NTHREADS, 2) fwd_kernel(Args args) {
    extern __shared__ __attribute__((aligned(16))) unsigned char lds[];
    LAS unsigned char* ldsL = (LAS unsigned char*)lds;
    volatile LAS unsigned* MISC = (volatile LAS unsigned*)(ldsL + LDS_MISC);
    const int tid = threadIdx.x, lane = tid & 63, wave = __builtin_amdgcn_readfirstlane(tid >> 6);
    const int G = gridDim.x; const int bx = blockIdx.x; const int vcu = (G % 8 == 0) ? (bx % 8) * (G / 8) + bx / 8 : bx;
#define G_ws (args.ws)
#define G_ctl ((unsigned*)(args.ws + WS_CTL))
#define G_x (args.in[0])
#define G_mem (args.in[1])
#define G_mix_norm (args.in[2])
#define G_w_in (args.in[3])
#define G_b_forget (args.in[4])
#define G_pool_w (args.in[5])
#define G_pool_scale (args.in[6])
#define G_w_out (args.in[7])
#define G_xattn_norm (args.in[8])
#define G_mem_norm (args.in[9])
#define G_xwq (args.in[10])
#define G_xwk (args.in[11])
#define G_xwv (args.in[12])
#define G_xwo (args.in[13])
#define G_peer_norm (args.in[14])
#define G_peer_wq (args.in[15])
#define G_sub_keys (args.in[16])
#define G_peer_u (args.in[17])
#define G_peer_v (args.in[18])
#define G_final_norm (args.in[19])
#define G_W_IN ((bf16*)(args.ws + WS_WIN))
#define G_WO1 ((bf16*)(args.ws + WS_WO1))
#define G_WO2 ((bf16*)(args.ws + WS_WO2))
#define G_WQ ((bf16*)(args.ws + WS_WQ))
#define G_WK ((bf16*)(args.ws + WS_WK))
#define G_WV ((bf16*)(args.ws + WS_WV))
#define G_WO ((bf16*)(args.ws + WS_WO))
#define G_WPQ ((bf16*)(args.ws + WS_WPQ))
#define G_AEXP ((bf16*)(args.ws + WS_AEXP))
#define G_W1 ((bf16*)(args.ws + WS_AEXP))
#define G_W2 ((bf16*)(args.ws + WS_WPQ))
#define G_WSC ((bf16*)(args.ws + WS_WSC))
#define G_PB ((bf16*)(args.ws + WS_PB))
#define G_MN ((bf16*)(args.ws + WS_MN))
#define G_KX ((bf16*)(args.ws + WS_KX))
#define G_VXT ((bf16*)(args.ws + WS_VXT))
#define G_UB (args.ws + WS_UB)
#define G_VB (args.ws + WS_VB)
#define G_SU ((float*)(args.ws + WS_SU))
#define G_SV ((float*)(args.ws + WS_SV))
#define G_XN ((bf16*)(args.ws + WS_XN))
#define G_QX ((bf16*)(args.ws + WS_XN))
#define G_PROJ ((bf16*)(args.ws + WS_PROJ))
#define G_SCT ((float*)(args.ws + WS_PROJ))
#define G_AMIX ((bf16*)(args.ws + WS_AMIX))
#define G_OX ((bf16*)(args.ws + WS_AMIX))
#define G_H ((float*)(args.ws + WS_H))
#define G_HB ((bf16*)(args.ws + WS_HB))
#define G_PP ((bf16*)(args.ws + WS_P))
#define G_LF ((float*)(args.ws + WS_LF))
#define G_SS1 ((float*)(args.ws + CTL_SS1))
#define G_SS2 ((float*)(args.ws + CTL_SS2))

    for (int u = tid; u < (LDS_BYTES - LDS_MISC) / 4; u += NTHREADS) ((LAS unsigned*)(ldsL + LDS_MISC))[u] = 0u;
    __syncthreads();
    XcdBarrier bar; bar.bar = G_ctl + CW_BAR; bar.x = 0; bar.st = nullptr;
    if (args.one_launch) bar = xcd_barrier_post(G_ctl + CW_BAR, MISC + 8);
    const int lo = args.ph_lo, hi = args.ph_hi;
#ifndef PH_MASK
#define PH_MASK 0xff
#endif
#define IN(k) (((PH_MASK >> (k)) & 1) && lo <= (k) && (k) < hi)
#ifdef PROBE_SEL
#define STAMP(i) do { if (bx == 0 && tid == 0) { const unsigned long long t_ = __builtin_amdgcn_s_memrealtime(); MISC[32 + 2 * (i)] = (unsigned)t_; MISC[33 + 2 * (i)] = (unsigned)(t_ >> 32); } } while (0)
#else
#define STAMP(i) do { } while (0)
#endif
#define SEAM(k) do { if (IN(k) && IN((k) + 1)) xcd_barrier(bar); STAMP((k) + 1); } while (0)
#define TABLE_CHUNK(c_) do { _Pragma("unroll 1") for (int i_ = 0; i_ < 4; i_ += 2) { const int r_ = (c_) * 32 + wave * 4 + i_; const int tb_ = r_ >> 14, rr_ = r_ & (PEXP - 1); \
        const float* sp_ = (tb_ ? G_peer_v : G_peer_u) + (size_t)rr_ * DM; unsigned char* dp_ = (tb_ ? G_VB : G_UB) + (size_t)rr_ * 1536; float* scp_ = (tb_ ? G_SV : G_SU) + rr_; \
        conv_rows2_fp6(sp_, sp_ + DM, dp_, dp_ + 1536, scp_, scp_ + 1, lane); } } while (0)
    STAMP(0);
#if defined(PROBE_SEL) && PROBE_SEL >= 7
    if (bx == 0 && tid == 0) __hip_atomic_store((unsigned long long*)(G_ctl + 256), (unsigned long long)__builtin_amdgcn_s_memrealtime(), __ATOMIC_RELAXED, __HIP_MEMORY_SCOPE_AGENT);
#endif
    const int gw = vcu * NWAVES + wave, NGW = G * NWAVES;
    const int gt = vcu * NTHREADS + tid, NGT = G * NTHREADS;

    if (IN(0)) for (int rep_ = 0; rep_ < (((DUP_MASK >> 0) & 1) ? args.pad + 1 : 1); ++rep_) {
        LAS float* wf = (LAS float*)ldsL;
        LAS float* scr = (LAS float*)(ldsL + 65536 + wave * 8704);
#pragma unroll
        for (int i = 0; i < DM / NTHREADS; ++i) { const int d = tid + i * NTHREADS; const f32x4 a = *(const GAS f32x4*)(G_w_in + (size_t)d * INC + 4096), b = *(const GAS f32x4*)(G_w_in + (size_t)d * INC + 4100);
            wf[d] = a[0]; wf[DM + d] = a[1]; wf[2 * DM + d] = a[2]; wf[3 * DM + d] = a[3]; wf[4 * DM + d] = b[0]; wf[5 * DM + d] = b[1]; wf[6 * DM + d] = b[2]; wf[7 * DM + d] = b[3]; }
        __syncthreads();
        f32x4 vnx[8];
        if (gw < TOK) {
#pragma unroll
            for (int j = 0; j < 8; ++j) vnx[j] = ((const GAS f32x4*)(G_x + (size_t)gw * DM) + lane)[64 * j]; }
        for (int m = gw; m < TOK; m += NGW) {
            const GAS f32x4* gr = (const GAS f32x4*)G_mix_norm + lane;
            f32x4 v[8]; float s = 0.f;
#pragma unroll
            for (int j = 0; j < 8; ++j) v[j] = vnx[j];
            if (m + NGW < TOK) {
#pragma unroll
                for (int j = 0; j < 8; ++j) vnx[j] = ((const GAS f32x4*)(G_x + (size_t)(m + NGW) * DM) + lane)[64 * j]; }
#pragma unroll
            for (int j = 0; j < 8; ++j) s += (v[j][0] * v[j][0] + v[j][1] * v[j][1]) + (v[j][2] * v[j][2] + v[j][3] * v[j][3]);
            const float rstd = __builtin_amdgcn_rsqf(wave_sum_dpp(s) * (1.f / DM) + EPS);
            GAS v2u* o8 = (GAS v2u*)(G_XN + (size_t)m * DM) + lane;
#pragma unroll
            for (int j = 0; j < 8; ++j) { const f32x4 gg = gr[64 * j]; v[j] = v[j] * rstd * gg;
                v2u o; o.x = pk2(v[j][0], v[j][1]); o.y = pk2(v[j][2], v[j][3]); o8[64 * j] = o; }
            float fl[8];
#pragma unroll
            for (int h = 0; h < 8; ++h) { float a = 0.f;
#pragma unroll
                for (int j = 0; j < 8; ++j) { const f32x4 w = *(const LAS f32x4*)(wf + h * DM + j * 256 + lane * 4); a += (v[j][0] * w[0] + v[j][1] * w[1]) + (v[j][2] * w[2] + v[j][3] * w[3]); }
                fl[h] = wave_sum_dpp(a);
                asm volatile("" ::: "memory"); }
            if (lane < 8) { float f = fl[0];
#pragma unroll
                for (int h = 1; h < 8; ++h) f = (lane == h) ? fl[h] : f;
                f += G_b_forget[lane];
                const float ls = fminf(f, 0.f) - log1pf(expf(-fabsf(f)));
                const int b = m / SEQ, sq = m % SEQ; G_LF[(size_t)(b * FOXH + lane) * SEQ + sq] = ls; }
        }
        for (int m = gw; m < BATCH * NMEM; m += NGW) {
            const GAS f32x4* xr = (const GAS f32x4*)(G_mem + (size_t)m * DM) + lane; const GAS f32x4* gr = (const GAS f32x4*)G_mem_norm + lane;
            f32x4 v[8]; float s = 0.f;
#pragma unroll
            for (int j = 0; j < 8; ++j) { v[j] = xr[64 * j]; s += (v[j][0] * v[j][0] + v[j][1] * v[j][1]) + (v[j][2] * v[j][2] + v[j][3] * v[j][3]); }
            const float rstd = __builtin_amdgcn_rsqf(wave_sum_dpp(s) * (1.f / DM) + EPS);
            GAS v2u* o8 = (GAS v2u*)(G_MN + (size_t)m * DM) + lane;
#pragma unroll
            for (int j = 0; j < 8; ++j) { const f32x4 gg = gr[64 * j]; v[j] = v[j] * rstd * gg; v2u o; o.x = pk2(v[j][0], v[j][1]); o.y = pk2(v[j][2], v[j][3]); o8[64 * j] = o; }
        }
        {
            constexpr int I_IN = (DM / 64) * (4096 / 32), I_SQ = (DM / 64) * (DM / 32);
            constexpr int NITEMS = I_IN + 3 * I_SQ;
#define TR_SRC(it_, W_, ldw_, nblk_, r_) do { r_ = (it_); if (r_ < I_IN) { W_ = G_w_in; ldw_ = INC; nblk_ = 4096 / 32; } else { r_ -= I_IN; ldw_ = DM; nblk_ = DM / 32; \
        if (r_ < I_SQ) W_ = G_w_out; else if (r_ < 2 * I_SQ) { W_ = G_xwk; r_ -= I_SQ; } else { W_ = G_xwv; r_ -= 2 * I_SQ; } } } while (0)
            f32x4 tvn[8]; const float* Wn; int ldwn, nblkn, rn;
            if (gw < NITEMS) { TR_SRC(gw, Wn, ldwn, nblkn, rn); tr_load(Wn, ldwn, nblkn, rn, lane, tvn); }
            for (int it = gw; it < NITEMS; it += NGW) {
                f32x4 tvc[8];
#pragma unroll
                for (int i = 0; i < 8; ++i) tvc[i] = tvn[i];
                const int nblkc = nblkn, rc = rn;
                if (it + NGW < NITEMS) { TR_SRC(it + NGW, Wn, ldwn, nblkn, rn); tr_load(Wn, ldwn, nblkn, rn, lane, tvn); }
                int r = it;
                if (r < I_IN) { tr_store(tvc, nblkc, G_W_IN, nullptr, 0, DM, scr, rc, lane); continue; } r -= I_IN;
                if (r < I_SQ) { tr_store(tvc, nblkc, G_WO1, G_WO2, POOLW, DM, scr, rc, lane); continue; } r -= I_SQ;
                if (r < I_SQ) { tr_store(tvc, nblkc, G_WK, nullptr, 0, DM, scr, rc, lane); continue; }
                tr_store(tvc, nblkc, G_WV, nullptr, 0, DM, scr, rc, lane);
            }
#undef TR_SRC
        }
        for (int i0 = gt; i0 < DM * DM / 8; i0 += 2 * NGT) {
#pragma unroll
            for (int u = 0; u < 2; ++u) { const int i = i0 + u * NGT; if (i < DM * DM / 8) {
                const int d = i / (DM / 8);
                const v4u o1 = cvt8(G_peer_wq + (size_t)i * 8, G_peer_norm[d]);
                const v4u o2 = cvt8(G_xwq + (size_t)i * 8, G_xattn_norm[d]);
                *(GAS v4u*)(G_WPQ + (size_t)i * 8) = o1; *(GAS v4u*)(G_WQ + (size_t)i * 8) = o2; } }
        }
        for (int i = gt; i < DM * 256 / 8; i += NGT) {
            const int r = i >> 5, c0 = (i & 31) * 8; const int hc = r >> 7;
            v4u o3 = {0u, 0u, 0u, 0u}; if ((c0 >> 7) == (hc & 1)) o3 = cvt8(G_sub_keys + (size_t)r * 128 + (c0 & 127), 1.f);
            *(GAS v4u*)(G_AEXP + (size_t)i * 8) = o3; }
        for (int i = gt; i < 4 * 256 * 256 / 8; i += NGT) {
            const int g = i / (256 * 256 / 8), d0 = (i % 32) * 8; const float* ps = G_pool_scale + g * 256 + d0; const float* p = G_pool_w + (size_t)i * 8;
            v4u o; o.x = pk2(p[0] * ps[0], p[1] * ps[1]); o.y = pk2(p[2] * ps[2], p[3] * ps[3]); o.z = pk2(p[4] * ps[4], p[5] * ps[5]); o.w = pk2(p[6] * ps[6], p[7] * ps[7]);
            *(GAS v4u*)(G_PB + (size_t)i * 8) = o; }
        __syncthreads();
    }
    SEAM(0);

    if (IN(1)) for (int rep_ = 0; rep_ < (((DUP_MASK >> 1) & 1) ? args.pad + 1 : 1); ++rep_) {
        pg8::Gemm g{G_XN, G_W_IN, DM, DM, DM}; pg8::GSched S; S.init(TOK / 256, 4096 / 256, G, bx, DM, DM);
        pg8::EpiStoreT<true> E{G_PROJ, 4096, 0, 0, 1, nullptr, 1.f, 4, 8, 0.08838834764831845f * LOG2E, (unsigned*)G_ctl + CW_NRM};
        pg8::gemm_phase<pg8::EpiStoreT<true>, pg8::GSched, true>(ldsL, g, S, E);
    }
    SEAM(1);

    if (IN(2)) for (int rep_ = 0; rep_ < (((DUP_MASK >> 2) & 1) ? args.pad + 1 : 1); ++rep_) {
        for (int it = vcu; it < TOK / 32; it += G) {
            const int ch = (tid & 127) * 8, rsub = tid >> 7, r0 = it * 32 + rsub * 8, w = 2 << (ch >> 8);
            const int s0 = r0 % SEQ;
            float acc[8];
#pragma unroll
            for (int e = 0; e < 8; ++e) acc[e] = 0.f;
            for (int k = 1; k < w; ++k) { if (s0 - k >= 0) { const v4u v = *(const GAS v4u*)(G_PROJ + (size_t)(r0 - k) * 4096 + ch);
#pragma unroll
                    for (int e = 0; e < 4; ++e) { acc[2 * e] += __uint_as_float(v[e] << 16); acc[2 * e + 1] += __uint_as_float(v[e] & 0xffff0000u); } } }
            for (int rr = 0; rr < 8; ++rr) {
                const v4u v = *(const GAS v4u*)(G_PROJ + (size_t)(r0 + rr) * 4096 + ch); float cur[8];
#pragma unroll
                for (int e = 0; e < 4; ++e) { cur[2 * e] = __uint_as_float(v[e] << 16); cur[2 * e + 1] = __uint_as_float(v[e] & 0xffff0000u); }
                const int sp = s0 + rr; const float inv = 1.f / (float)((sp + 1 < w) ? sp + 1 : w);
                v4u o;
#pragma unroll
                for (int e = 0; e < 8; ++e) acc[e] += cur[e];
                o.x = pk2(acc[0] * inv - cur[0], acc[1] * inv - cur[1]); o.y = pk2(acc[2] * inv - cur[2], acc[3] * inv - cur[3]);
                o.z = pk2(acc[4] * inv - cur[4], acc[5] * inv - cur[5]); o.w = pk2(acc[6] * inv - cur[6], acc[7] * inv - cur[7]);
                *(GAS v4u*)(G_AMIX + (size_t)(r0 + rr) * DM + ch) = o;
                if (sp - w + 1 >= 0) { const v4u vo = *(const GAS v4u*)(G_PROJ + (size_t)(r0 + rr - w + 1) * 4096 + ch);
#pragma unroll
                    for (int e = 0; e < 4; ++e) { acc[2 * e] -= __uint_as_float(vo[e] << 16); acc[2 * e + 1] -= __uint_as_float(vo[e] & 0xffff0000u); } }
            }
        }
        const int a_bh = vcu >> 4, a_qb = vcu & 15;
        if (a_qb < 8 && vcu < 256) {
            const int e = a_qb < 2 ? a_bh * 2 + a_qb : 32 + a_bh * 6 + (a_qb - 2);
            pg8::Gemm g; pg8::EpiStore E{nullptr, DM, 0, 0, 1, nullptr, 1.f, 0, 0, 1.f, nullptr};
            int pm, pn;
            if (e < 16)      { pm = e >> 3; pn = e & 7; g = pg8::Gemm{G_MN, G_WK, DM, DM, DM}; E.O = G_KX; E.ldc = DM; }
            else if (e < 32) { const int q = e - 16; pm = q >> 3; pn = q & 7; g = pg8::Gemm{G_MN, G_WV, DM, DM, DM}; E.O = G_VXT; E.ldc = DM; }
            else if (e < 96) { const int q = e - 32; pm = q >> 3; pn = q & 7; g = pg8::Gemm{G_AEXP, G_WPQ + pm * 256, 256, 256, DM}; E.O = G_WSC; E.ldc = DM; }
            else             { const int q = e - 96; const int gg = q >> 3; pm = q & 7; pn = 0;
                               g = pg8::Gemm{G_WO1 + gg * 256, G_PB + (size_t)gg * 65536, 256, DM, 256}; E.O = G_WO2 + gg * 256; E.ldc = DM; }
            const pg8::OneSched S1{pm, pn, (long)pm * 256 * g.lda, (long)pn * 256 * g.ldb};
            pg8::gemm_phase<pg8::EpiStore, pg8::OneSched, false>(ldsL, g, S1, E);
        }
        if (vcu < 256) {
            const int b = a_bh >> 3, h = a_bh & 7;
            float* c_lds = (float*)(lds + fox::LDS_C);
            if (wave == 0) {
                const float* lf = G_LF + (size_t)a_bh * SEQ + lane * 64; float loc[64]; float run = 0.f;
#pragma unroll
                for (int i = 0; i < 16; ++i) { const f32x4 v = *(const f32x4*)(lf + 4 * i);
#pragma unroll
                    for (int e = 0; e < 4; ++e) { run += v[e]; loc[4 * i + e] = run; } }
                float incl = run;
#pragma unroll
                for (int o = 1; o < 64; o <<= 1) { const float t = __shfl_up(incl, o); if (lane >= o) incl += t; }
                const float excl = incl - run;
#pragma unroll
                for (int i = 0; i < 16; ++i) { f32x4 v;
#pragma unroll
                    for (int e = 0; e < 4; ++e) v[e] = (loc[4 * i + e] + excl) * LOG2E;
                    *(f32x4*)(c_lds + lane * 64 + 4 * i) = v; }
            }
            __syncthreads();
            const bf16* Qb = G_PROJ + (size_t)(b * SEQ) * 4096 + 1024 + h * 128;
            fox::BlockRef cur{Qb + (size_t)(a_qb * 256) * 4096, Qb + 1024, Qb + 2048, G_AMIX + (size_t)(b * SEQ + a_qb * 256) * DM + 1024 + h * 128, a_qb * 256};
            int j_lo = 0;
            { const unsigned* nq = (const unsigned*)G_ctl + CW_NRM + (b * 8 + h) * 4; const unsigned* nk = nq + 64; float B = 0.f;
#pragma unroll
              for (int c4 = 0; c4 < 4; ++c4) B += sqrtf(__uint_as_float(__hip_atomic_load(nq + c4, __ATOMIC_RELAXED, __HIP_MEMORY_SCOPE_AGENT)) * __uint_as_float(__hip_atomic_load(nk + c4, __ATOMIC_RELAXED, __HIP_MEMORY_SCOPE_AGENT)));
              const float thr = 2.05f * B + c_lds[a_qb * 256] + 150.f;
              while (j_lo < a_qb * 4 && c_lds[64 * j_lo + 63] > thr) ++j_lo; }
            fox::Seam S;
            fox::prime(cur, j_lo, (char*)lds, S);
            fox::block(cur, cur, j_lo, (char*)lds, S);
            asm volatile("s_waitcnt vmcnt(0)" ::: "memory");
            __syncthreads();
        }
        {
            constexpr int C_T = (DM / 64) * (DM / 32) / 8, NCHUNK = C_T + QSPLIT;
            LAS float* scr = (LAS float*)(ldsL + wave * 8704);
            for (;;) {
                __syncthreads();
                if (tid == 0) MISC[16] = atomicAdd(G_ctl + CW_QUEUE, 1u);
                __syncthreads();
                const int c = (int)MISC[16];
                if (c >= NCHUNK) break;
                if (c < C_T) { p0_transpose_item(G_xwo, DM, DM / 32, nullptr, G_WO, nullptr, 0, DM, scr, c * 8 + wave, lane); }
                else { TABLE_CHUNK(c - C_T); }
            }
        }
    }
    SEAM(2);

    if (IN(3)) for (int rep_ = 0; rep_ < (((DUP_MASK >> 3) & 1) ? args.pad + 1 : 1); ++rep_) {
        { pg8::Gemm g{G_AMIX, G_WO2, DM, DM, DM}; pg8::GSched S; S.init(TOK / 256, DM / 256, G, bx, DM, DM);
          pg8::EpiResid<false> E{G_x, G_HB, rep_ ? nullptr : G_SS1, 0};
          pg8::gemm_phase<pg8::EpiResid<false>, pg8::GSched, true>(ldsL, g, S, E); }
        if (bx < 64) {
            const int f = bx & 63, b = f >> 5, h = (f >> 3) & 3, t = f & 7;
            pg8::Gemm g{G_KX + (size_t)(b * NMEM) * DM + h * XD, G_WQ + h * XD, XD, DM, DM};
            pg8::EpiStore E{G_W1 + (size_t)(b * 1024 + h * 256) * DM, DM, 0, 0, 1, nullptr, 1.f, 0, 0, 1.f, nullptr};
            const pg8::OneSched S1{0, t, 0, (long)t * 256 * DM};
            pg8::gemm_phase<pg8::EpiStore, pg8::OneSched, false>(ldsL, g, S1, E);
        }
    }
    SEAM(3);

    if (IN(4)) for (int rep_ = 0; rep_ < (((DUP_MASK >> 4) & 1) ? args.pad + 1 : 1); ++rep_) {
        pg8::Gemm g{G_HB, G_W1, DM, DM, DM}; pg8::GSched S; S.init(SEQ / 256, XH, G, bx, DM, DM);
        S.nH = 1; S.nZ = BATCH; S.sAb = (long)SEQ * DM; S.sBb = (long)1024 * DM;
        pg8::EpiSoftmax E{G_PP, 1024, (long)SEQ * 1024, 0, 1, G_SS1, 0.044194173824159216f * LOG2E, SEQ};
        pg8::gemm_phase<pg8::EpiSoftmax, pg8::GSched, false>(ldsL, g, S, E);
        if (bx >= 128 && bx < 192) {
            const int f = bx & 63, b = f >> 5, h = (f >> 3) & 3, t = f & 7;
            pg8::Gemm g2{G_WO + h * XD, G_VXT + (size_t)(b * NMEM) * DM + h * XD, XD, DM, DM};
            pg8::EpiStore E2{G_W2 + (size_t)b * DM * 1024 + h * 256, 1024, 0, 0, 1, nullptr, 1.f, 0, 0, 1.f, nullptr};
            const pg8::OneSched S2{t, 0, (long)t * 256 * DM, 0};
            pg8::gemm_phase<pg8::EpiStore, pg8::OneSched, false>(ldsL, g2, S2, E2);
        }
        for (;;) {
            __syncthreads();
            if (tid == 0) MISC[16] = atomicAdd(G_ctl + CW_QUEUE2, 1u);
            __syncthreads();
            const int c = (int)MISC[16] + QSPLIT;
            if (c >= 2 * PEXP / 32) break;
            TABLE_CHUNK(c);
        }
    }
    SEAM(4);

    if (IN(5)) for (int rep_ = 0; rep_ < (((DUP_MASK >> 5) & 1) ? args.pad + 1 : 1); ++rep_) {
        pg8::Gemm g{G_PP, G_W2, 1024, 1024, 1024}; pg8::GSched S; S.init(SEQ / 256, DM / 256, G, bx, 1024, 1024);
        S.nH = 1; S.nZ = BATCH; S.sAb = (long)SEQ * 1024; S.sBb = (long)DM * 1024;
        pg8::EpiResid<true> E{G_HB, G_HB, G_SS2, SEQ};
        pg8::gemm_phase<pg8::EpiResid<true>, pg8::GSched, true>(ldsL, g, S, E);
    }
    SEAM(5);

    if (IN(6)) for (int rep_ = 0; rep_ < (((DUP_MASK >> 6) & 1) ? args.pad + 1 : 1); ++rep_) {
        pg8::Gemm g{G_WSC, G_HB, DM, DM, DM}; pg8::GSched S; S.init(DM / 256, TOK / 256, G, bx, DM, DM);
        pg8::EpiF32Col E{G_SCT, TOK, G_SS2};
        pg8::gemm_phase<pg8::EpiF32Col, pg8::GSched, true>(ldsL, g, S, E);
    }
    SEAM(6);

#if defined(PROBE_SEL) && PROBE_SEL >= 7
    if (bx == 0 && tid == 0) __hip_atomic_store((unsigned long long*)(G_ctl + 258), (unsigned long long)__builtin_amdgcn_s_memrealtime(), __ATOMIC_RELAXED, __HIP_MEMORY_SCOPE_AGENT);
#endif
    if (IN(7)) for (int rep_ = 0; rep_ < (((DUP_MASK >> 7) & 1) ? args.pad + 1 : 1); ++rep_) {
        LAS unsigned* TOP1 = (LAS unsigned*)ldsL;
        LAS unsigned* RIDX = (LAS unsigned*)(ldsL + 32768);
        LAS float* RGATE = (LAS float*)(ldsL + 49152);
        for (int blk = vcu; blk < TOK / 32; blk += G) {
            const int t0 = blk * 32;
            {
                const int tok = tid & 31, grp = tid >> 5;
                const float* sp = G_SCT + (size_t)(grp * 128) * TOK + t0 + tok;
                unsigned lst[16];
#pragma unroll
                for (int j = 0; j < 16; ++j) lst[j] = 0u;
                for (int i0 = 0; i0 < 128; i0 += 32) {
                    float v[32];
#pragma unroll
                    for (int e = 0; e < 32; ++e) v[e] = sp[(size_t)(i0 + e) * TOK];
#pragma unroll
                    for (int c16 = 0; c16 < 2; ++c16) { unsigned nw[16];
#pragma unroll
                        for (int e = 0; e < 16; ++e) nw[e] = (fkey(v[c16 * 16 + e]) & ~127u) | (unsigned)(127 - (i0 + c16 * 16 + e));
#pragma unroll
                        for (int k = 2; k <= 16; k <<= 1)
#pragma unroll
                            for (int j = k >> 1; j > 0; j >>= 1)
#pragma unroll
                                for (int i = 0; i < 16; ++i) { const int l = i ^ j; if (l > i) { const unsigned lo_ = min(nw[i], nw[l]), hi_ = max(nw[i], nw[l]); if ((i & k) == 0) { nw[i] = lo_; nw[l] = hi_; } else { nw[i] = hi_; nw[l] = lo_; } } }
#pragma unroll
                        for (int i = 0; i < 16; ++i) lst[i] = max(lst[i], nw[i]);
#pragma unroll
                        for (int j = 8; j > 0; j >>= 1)
#pragma unroll
                            for (int i = 0; i < 16; ++i) { const int l = i ^ j; if (l > i) { const unsigned lo_ = min(lst[i], lst[l]), hi_ = max(lst[i], lst[l]); lst[i] = hi_; lst[l] = lo_; } } }
                }
                LAS unsigned* dst = TOP1 + (tok * 16 + grp) * 16;
#pragma unroll
                for (int j = 0; j < 16; j += 4) *(LAS v4u*)(dst + j) = (v4u){lst[j], lst[j + 1], lst[j + 2], lst[j + 3]};
            }
            __syncthreads();
            if (tid < 256) {
                const int tok = tid & 31, head = tid >> 5;
                const LAS unsigned* ka = TOP1 + (tok * 16 + head * 2) * 16; const LAS unsigned* kb = ka + 16;
                float af[16], bfv[16];
#pragma unroll
                for (int j = 0; j < 16; ++j) { af[j] = fdec(ka[j] & ~127u); bfv[j] = fdec(kb[j] & ~127u); }
                unsigned best[16];
#pragma unroll
                for (int j = 0; j < 16; ++j) best[j] = 0u;
#pragma unroll
                for (int i = 0; i < 16; ++i)
#pragma unroll
                    for (int j = 0; j < 16; ++j) if ((i + 1) * (j + 1) <= 16) {
                        unsigned xk = (fkey(af[i] + bfv[j]) & ~255u) | (unsigned)(255 - (i * 16 + j));
#pragma unroll
                        for (int q = 0; q < 16; ++q) { const unsigned hi_ = max(best[q], xk); xk = min(best[q], xk); best[q] = hi_; } }
                float ev[16]; const float m0 = fdec(best[0] & ~255u); float sum = 0.f;
#pragma unroll
                for (int q = 0; q < 16; ++q) { ev[q] = __expf(fdec(best[q] & ~255u) - m0); sum += ev[q]; }
                const float inv = 1.f / sum;
#pragma unroll
                for (int q = 0; q < 16; ++q) { const unsigned code = 255u - (best[q] & 255u); const unsigned i = code >> 4, j = code & 15u;
                    const unsigned ia = 127u - (ka[i] & 127u), ib = 127u - (kb[j] & 127u);
                    RIDX[tok * 128 + head * 16 + q] = ia * 128u + ib; RGATE[tok * 128 + head * 16 + q] = ev[q] * inv; }
            }
            __syncthreads();
            {
                LAS unsigned* SIDX = (LAS unsigned*)ldsL; LAS unsigned* SGATE = (LAS unsigned*)(ldsL + 16384);
                const int tok = tid >> 4; const LAS unsigned* src = RIDX + tok * 128;
                unsigned mine[8]; unsigned rank[8];
#pragma unroll
                for (int i = 0; i < 8; ++i) { mine[i] = (src[(tid & 15) + 16 * i] << 7) | (unsigned)((tid & 15) + 16 * i); rank[i] = 0u; }
                for (int j0 = 0; j0 < 128; j0 += 4) { const v4u o4 = *(const LAS v4u*)(src + j0);
#pragma unroll
                    for (int jj = 0; jj < 4; ++jj) { const unsigned oj = ((jj == 0 ? o4.x : jj == 1 ? o4.y : jj == 2 ? o4.z : o4.w) << 7) | (unsigned)(j0 + jj);
#pragma unroll
                        for (int i = 0; i < 8; ++i) rank[i] += (oj < mine[i]) ? 1u : 0u; } }
#pragma unroll
                for (int i = 0; i < 8; ++i) mine[i] >>= 7;
#pragma unroll
                for (int i = 0; i < 8; ++i) { const unsigned pos = rank[i];
                    SIDX[tok * 128 + pos] = mine[i];
                    const float su_ = G_SU[mine[i]], gs_ = RGATE[tok * 128 + (tid & 15) + 16 * i] * G_SV[mine[i]];
                    SGATE[tok * 128 + pos] = (__float_as_uint(su_) & 0xffff0000u) | f2bf(gs_); }
            }
            __syncthreads();
            {
                const int tok0 = wave * 4; const size_t tg0 = (size_t)(t0 + tok0);
                LAS float* Wl = (LAS float*)(ldsL + 32768) + tok0 * 128;
                unsigned xn0[16], xn1[16], xn2[16], xn3[16];
#define XNLOAD(T_, XN) do { const float rs = __builtin_amdgcn_rsqf(G_SS2[tg0 + (T_)] * (1.f / DM) + EPS); \
        _Pragma("unroll") for (int q = 0; q < 8; ++q) { const size_t d0 = (size_t)q * 256 + lane * 4; \
            const v2u ha = *(const GAS v2u*)(G_HB + (tg0 + (T_)) * DM + d0); const f32x4 ga = *(const f32x4*)(G_peer_norm + d0); \
            XN[q * 2] = pk2(__uint_as_float(ha.x << 16) * rs * ga[0], __uint_as_float(ha.x & 0xffff0000u) * rs * ga[1]); XN[q * 2 + 1] = pk2(__uint_as_float(ha.y << 16) * rs * ga[2], __uint_as_float(ha.y & 0xffff0000u) * rs * ga[3]); } } while (0)
                XNLOAD(0, xn0); XNLOAD(1, xn1); XNLOAD(2, xn2); XNLOAD(3, xn3);
#undef XNLOAD
                const LAS unsigned* ridx0 = (const LAS unsigned*)ldsL + tok0 * 128; const LAS unsigned* rgs0 = (const LAS unsigned*)(ldsL + 16384) + tok0 * 128;
                const __amdgpu_buffer_rsrc_t rsT = __builtin_amdgcn_make_buffer_rsrc((void*)G_UB, 0, 64 << 20, 0x00020000);
                v4u raX0, raX1, raX2, raX3, raY0, raY1, raY2, raY3; v2u rbX0, rbX1, rbX2, rbX3, rbY0, rbY1, rbY2, rbY3;
                unsigned sgX0, sgX1, sgX2, sgX3, sgY0, sgY1, sgY2, sgY3;
#define PLDU(S, T, k) do { const unsigned ex_ = (unsigned)__builtin_amdgcn_readfirstlane((int)ridx0[(T) * 128 + (k)]); sg##S = rgs0[(T) * 128 + (k)]; \
        ra##S = __builtin_bit_cast(v4u, __builtin_amdgcn_raw_buffer_load_b128(rsT, lane * 16, ex_ * 1536u, 0)); rb##S = __builtin_bit_cast(v2u, __builtin_amdgcn_raw_buffer_load_b64(rsT, lane * 8 + 1024, ex_ * 1536u, 0)); } while (0)
                const int rowl = lane >> 4; const int wl_off = (rowl == 0 ? 0 : rowl == 1 ? 256 : rowl == 2 ? 128 : 384);
#define STEP1(C, P, k, HASNEXT) do { \
        const float d0_ = peer_dot(ra##C##0, rb##C##0, xn0), d1_ = peer_dot(ra##C##1, rb##C##1, xn1), d2_ = peer_dot(ra##C##2, rb##C##2, xn2), d3_ = peer_dot(ra##C##3, rb##C##3, xn3); \
        const unsigned sgr_ = rowl == 0 ? sg##C##0 : rowl == 1 ? sg##C##2 : rowl == 2 ? sg##C##1 : sg##C##3; \
        if (HASNEXT) { PLDU(P##0, 0, (k) + 1); PLDU(P##1, 1, (k) + 1); PLDU(P##2, 2, (k) + 1); PLDU(P##3, 3, (k) + 1); } \
        const auto s01_ = __builtin_amdgcn_permlane32_swap(__float_as_uint(d0_), __float_as_uint(d1_), false, false); const auto s23_ = __builtin_amdgcn_permlane32_swap(__float_as_uint(d2_), __float_as_uint(d3_), false, false); \
        const float p_ = __uint_as_float(s01_[0]) + __uint_as_float(s01_[1]), q_ = __uint_as_float(s23_[0]) + __uint_as_float(s23_[1]); \
        const auto spq_ = __builtin_amdgcn_permlane16_swap(__float_as_uint(p_), __float_as_uint(q_), false, false); \
        float r_ = __uint_as_float(spq_[0]) + __uint_as_float(spq_[1]); \
        r_ += __builtin_bit_cast(float, __builtin_amdgcn_update_dpp(0, __builtin_bit_cast(int, r_), 0xB1, 0xf, 0xf, true)); r_ += __builtin_bit_cast(float, __builtin_amdgcn_update_dpp(0, __builtin_bit_cast(int, r_), 0x4E, 0xf, 0xf, true)); \
        r_ += __builtin_bit_cast(float, __builtin_amdgcn_update_dpp(0, __builtin_bit_cast(int, r_), 0x141, 0xf, 0xf, true)); r_ += __builtin_bit_cast(float, __builtin_amdgcn_update_dpp(0, __builtin_bit_cast(int, r_), 0x140, 0xf, 0xf, true)); \
        const float w_ = gelu_f(r_ * __uint_as_float(sgr_ & 0xffff0000u)) * __uint_as_float(sgr_ << 16); \
        if ((lane & 15) == 0) Wl[wl_off + (k)] = w_; } while (0)
                PLDU(X0, 0, 0); PLDU(X1, 1, 0); PLDU(X2, 2, 0); PLDU(X3, 3, 0);
                for (int k = 0; k < 126; k += 2) { STEP1(X, Y, k, true); STEP1(Y, X, k + 1, true); }
                STEP1(X, Y, 126, true); STEP1(Y, X, 127, false);
#undef PLDU
#undef STEP1
#define PLDV(S, T, k) do { const unsigned ex_ = (unsigned)__builtin_amdgcn_readfirstlane((int)ridx0[(T) * 128 + (k)]); \
        ra##S = __builtin_bit_cast(v4u, __builtin_amdgcn_raw_buffer_load_b128(rsT, lane * 16, ex_ * 1536u + (32u << 20), 0)); rb##S = __builtin_bit_cast(v2u, __builtin_amdgcn_raw_buffer_load_b64(rsT, lane * 8 + 1024, ex_ * 1536u + (32u << 20), 0)); } while (0)
#define STEP2(C, P, k, HASNEXT) do { asm volatile("" ::: "memory"); \
        if (HASNEXT) { PLDV(P##0, 0, (k) + 1); PLDV(P##1, 1, (k) + 1); PLDV(P##2, 2, (k) + 1); PLDV(P##3, 3, (k) + 1); } \
        const float w0_ = Wl[(k)], w1_ = Wl[128 + (k)], w2_ = Wl[256 + (k)], w3_ = Wl[384 + (k)]; \
        peer_axpy_h(ra##C##0, rb##C##0, w0_, oh0); peer_axpy_h(ra##C##1, rb##C##1, w1_, oh1); peer_axpy_h(ra##C##2, rb##C##2, w2_, oh2); peer_axpy_h(ra##C##3, rb##C##3, w3_, oh3); } while (0)
                unsigned oh0[16], oh1[16], oh2[16], oh3[16];
#pragma unroll
                for (int e = 0; e < 16; ++e) { oh0[e] = 0u; oh1[e] = 0u; oh2[e] = 0u; oh3[e] = 0u; }
                PLDV(X0, 0, 0); PLDV(X1, 1, 0); PLDV(X2, 2, 0); PLDV(X3, 3, 0);
                for (int k = 0; k < 126; k += 2) { STEP2(X, Y, k, true); STEP2(Y, X, k + 1, true); }
                STEP2(X, Y, 126, true); STEP2(Y, X, 127, false);
                for (int tt = 0; tt < 4; tt += 2) {
                    float oaccA[32], oaccB[32];
#pragma unroll
                    for (int e = 0; e < 16; ++e) { const unsigned ua_ = tt ? oh2[e] : oh0[e], ub_ = tt ? oh3[e] : oh1[e];
                        oaccA[2 * e] = h16lo(ua_); oaccA[2 * e + 1] = h16hi(ua_); oaccB[2 * e] = h16lo(ub_); oaccB[2 * e + 1] = h16hi(ub_); }
#define FINISH(T_, OACC) do { float s_ = 0.f; \
        _Pragma("unroll") for (int q = 0; q < 8; ++q) { const size_t d0 = (size_t)q * 256 + lane * 4; const v2u hb = *(const GAS v2u*)(G_HB + (T_) * DM + d0); \
            const f32x4 a = {__uint_as_float(hb.x << 16), __uint_as_float(hb.x & 0xffff0000u), __uint_as_float(hb.y << 16), __uint_as_float(hb.y & 0xffff0000u)}; \
            _Pragma("unroll") for (int e = 0; e < 4; ++e) { const float y = a[e] + OACC[q * 4 + e]; OACC[q * 4 + e] = y; s_ += y * y; } } \
        const float rstd_ = __builtin_amdgcn_rsqf(wave_sum_dpp(s_) * (1.f / DM) + EPS); \
        _Pragma("unroll") for (int q = 0; q < 8; ++q) { const size_t d0 = (size_t)q * 256 + lane * 4; const f32x4 ga = *(const f32x4*)(G_final_norm + d0); f32x4 o; \
            _Pragma("unroll") for (int e = 0; e < 4; ++e) o[e] = OACC[q * 4 + e] * rstd_ * ga[e]; \
            PROBE_EXPORT(T_, q); \
            *(f32x4*)(args.out + (T_) * DM + d0) = o; } } while (0)
                    FINISH(tg0 + tt, oaccA); FINISH(tg0 + tt + 1, oaccB);
                }
#undef FINISH
#undef PLDV
#undef STEP2
            }
            __syncthreads();
#if defined(PROBE_SEL) && PROBE_SEL >= 7
            asm volatile("s_waitcnt vmcnt(0)" ::: "memory"); __syncthreads();
            if (tid == 0) { __threadfence(); const unsigned old_ = atomicAdd(G_ctl + 192, 1u);
                if (old_ == (unsigned)G - 1u) { __threadfence(); const unsigned long long a_ = __hip_atomic_load((unsigned long long*)(G_ctl + 256 + 2 * (PROBE_SEL - 7)), __ATOMIC_RELAXED, __HIP_MEMORY_SCOPE_AGENT), b_ = __builtin_amdgcn_s_memrealtime();
                    atomicAdd(args.out + (size_t)31 * DM, (float)(b_ - a_) * 0.0001f); } }
#endif
        }
    }
#undef IN
#undef SEAM
#undef G_ws
#undef G_ctl
#undef G_x
#undef G_mem
#undef G_mix_norm
#undef G_w_in
#undef G_b_forget
#undef G_pool_w
#undef G_pool_scale
#undef G_w_out
#undef G_xattn_norm
#undef G_mem_norm
#undef G_xwq
#undef G_xwk
#undef G_xwv
#undef G_xwo
#undef G_peer_norm
#undef G_peer_wq
#undef G_sub_keys
#undef G_peer_u
#undef G_peer_v
#undef G_final_norm
#undef G_W_IN
#undef G_WO1
#undef G_WO2
#undef G_WQ
#undef G_WK
#undef G_WV
#undef G_WO
#undef G_WPQ
#undef G_AEXP
#undef G_W1
#undef G_W2
#undef G_WSC
#undef G_PB
#undef G_MN
#undef G_KX
#undef G_VXT
#undef G_UB
#undef G_VB
#undef G_SU
#undef G_SV
#undef G_XN
#undef G_QX
#undef G_PROJ
#undef G_SCT
#undef G_AMIX
#undef G_OX
#undef G_H
#undef G_HB
#undef G_PP
#undef G_LF
#undef G_SS1
#undef G_SS2

}

constexpr int N_PHASES = 8;
extern "C" void kernel_launch(void* const* d_in, const int* in_sizes, int n_in, void* d_out, int out_size, void* d_ws, size_t ws_size, hipStream_t stream) {
    static int grid = 0;
    if (grid == 0) {
        if (n_in != 20 || in_sizes[0] != TOK * DM || out_size != TOK * DM || ws_size < WS_END) {
            fprintf(stderr, "kernel_launch: unexpected shapes (n_in %d, in0 %d, out %d, ws %zu < %zu)\n", n_in, n_in > 0 ? in_sizes[0] : -1, out_size, ws_size, (size_t)WS_END); grid = -1; return; }
        int dev = 0, cus = 0, per_cu = 0;
        if (hipGetDevice(&dev) != hipSuccess || hipDeviceGetAttribute(&cus, hipDeviceAttributeMultiprocessorCount, dev) != hipSuccess) { grid = -1; return; }
        if (hipFuncSetAttribute((const void*)fwd_kernel, hipFuncAttributeMaxDynamicSharedMemorySize, LDS_BYTES) != hipSuccess) { fprintf(stderr, "kernel_launch: hipFuncSetAttribute failed\n"); grid = -1; return; }
        if (hipOccupancyMaxActiveBlocksPerMultiprocessor(&per_cu, (const void*)fwd_kernel, NTHREADS, LDS_BYTES) != hipSuccess || per_cu < 1) { fprintf(stderr, "kernel_launch: occupancy query says %d\n", per_cu); per_cu = 1; }
        (void)hipGetLastError();
        grid = cus;
        if (grid != 256) fprintf(stderr, "kernel_launch: %d CUs (built for 256)\n", grid);
    }
    if (grid < 0) return;
    (void)hipMemsetAsync((char*)d_ws + WS_CTL, 0, CTL_ZERO_BYTES, stream);
    Args a{};
    for (int i = 0; i < 20; ++i) a.in[i] = (const float*)d_in[i];
    a.out = (float*)d_out; a.ws = (unsigned char*)d_ws; a.pad = DUP_MASK ? 1 : 0;
#if MK_ONE_LAUNCH
    a.ph_lo = 0; a.ph_hi = N_PHASES; a.one_launch = 1;
    void* kargs[] = {&a};
    hipError_t e = hipLaunchCooperativeKernel((const void*)fwd_kernel, dim3(grid), dim3(NTHREADS), kargs, LDS_BYTES, stream);
    if (e != hipSuccess) fprintf(stderr, "kernel_launch: cooperative launch failed: %s\n", hipGetErrorString(e));
#else
    for (int p = 0; p < N_PHASES; ++p) {
        a.ph_lo = p; a.ph_hi = p + 1; a.one_launch = 0;
        hipLaunchKernelGGL(fwd_kernel, dim3(grid), dim3(NTHREADS), LDS_BYTES, stream, a);
    }
#endif
}
```

```cpp
#include <hip/hip_runtime.h>
#include <hip/hip_bf16.h>
#include <cstdio>
#include <cstdint>

#ifndef DUP_MASK
#define DUP_MASK 0
#endif
#ifndef MK_ONE_LAUNCH
#define MK_ONE_LAUNCH 1
#endif

constexpr int BATCH = 2, SEQ = 4096, DM = 2048, TOK = BATCH * SEQ;
constexpr int INC = 4104, POOLW = 1024, FOXH = 8, FOXD = 128;
constexpr int NMEM = 256, XH = 4, XD = 512;
constexpr int PH = 8, PKEYS = 128, PEXP = 16384, TOPK = 16;
constexpr float EPS = 1e-6f;
constexpr float LOG2E = 1.4426950408889634f;

namespace pg8 {
#define PG8_LAS __attribute__((address_space(3)))
typedef unsigned short bf16_t;
typedef short bf16x8 __attribute__((ext_vector_type(8)));
typedef float f32x4 __attribute__((ext_vector_type(4)));
typedef float f32x2 __attribute__((ext_vector_type(2)));
typedef unsigned u32x4 __attribute__((ext_vector_type(4)));
typedef unsigned u32x2 __attribute__((ext_vector_type(2)));
constexpr int BM = 256, BK = 64, HALF = 128, HTB = HALF * BK * 2, STAGE_BYTES = 8 * HTB, NXCD = 8, WGM = 8;

__host__ __device__ __forceinline__ int lds_byte(int r, int c) { const int st = (r >> 4) * 2 + (c >> 5), rr = r & 15, cc = c & 31, ob = rr * 64 + cc * 2; return st * 1024 + (ob ^ (((ob >> 9) & 1) << 5)); }
__host__ __device__ __forceinline__ void stage_rc(int b, int& R, int& C) { const int st = b / 1024, sb = b % 1024, swz = sb ^ (((sb >> 9) & 1) << 5); R = (st >> 1) * 16 + swz / 64; C = (st & 1) * 32 + (swz % 64) / 2; }
__host__ __device__ __forceinline__ int perm32(int rho) { const int n = rho >> 4, i = rho & 15; return 8 * (i >> 2) + 4 * n + (i & 3); }

struct Unit { int pm, pn, z; long aoff, boff; };
struct Gemm { const bf16_t* A; const bf16_t* Bt; int K, lda, ldb; };

struct GSched {
    int nM, nN, nH, nZ, G, c; long sAb, sAh, sBb, sBh; int lda, ldb;
    __device__ __forceinline__ void init(int nM_, int nN_, int G_, int c_, int lda_, int ldb_) { nM = nM_; nN = nN_; nH = 1; nZ = 1; G = G_; c = c_; sAb = sAh = sBb = sBh = 0; lda = lda_; ldb = ldb_; }
    __device__ __forceinline__ bool next(int i, Unit& u) const {
        const long L = (long)i * G + c; const int nwg = nM * nN; if (L >= (long)nwg * nZ) return false;
        const int z = (int)(L / nwg); int wgid = (int)(L % nwg);
        { const int q = nwg / NXCD, r = nwg % NXCD, xcd = wgid % NXCD, off = wgid / NXCD; wgid = (xcd < r ? xcd * (q + 1) : r * (q + 1) + (xcd - r) * q) + off; }
        const int nig = WGM * nN, gid = wgid / nig, fm = gid * WGM, gsz = (nM - fm) < WGM ? (nM - fm) : WGM;
        u.pm = fm + ((wgid % nig) % gsz); u.pn = (wgid % nig) / gsz; u.z = z;
        const int zb = z / nH, zh = z % nH;
        u.aoff = zb * sAb + zh * sAh + (long)u.pm * BM * lda; u.boff = zb * sBb + zh * sBh + (long)u.pn * BM * ldb;
        return true;
    }
    __device__ __forceinline__ void a_ready(const Unit&) const {}
    __device__ __forceinline__ void done(const Unit&) const {}
};

struct OneSched { int pm, pn; long ao, bo;
    __device__ __forceinline__ bool next(int i, Unit& u) const { if (i) return false; u.pm = pm; u.pn = pn; u.z = 0; u.aoff = ao; u.boff = bo; return true; }
    __device__ __forceinline__ void a_ready(const Unit&) const {}
    __device__ __forceinline__ void done(const Unit&) const {} };
__device__ __forceinline__ unsigned cvt_pk_bf16(float lo, float hi) { unsigned r; asm volatile("v_cvt_pk_bf16_f32 %0, %1, %2" : "=v"(r) : "v"(lo), "v"(hi)); return r; }


template <bool NRM> struct EpiStoreT {
    static constexpr bool PERM = true, AFTER_DRAIN = false;
    bf16_t* O; int ldc; long sCb, sCh; int nH;
    const float* ss; float rs_mul;
    int t0, t1; float tscale;
    unsigned* nrm;
    __device__ __forceinline__ void operator()(const f32x4 (&acc)[2][2][4][2], const Unit& u, int wr, int wc, int fr, int fq) const {
        const int row0 = u.pm * BM + wr * 64 + fr, col0 = u.pn * BM + wc * 32 + 8 * fq;
        bf16_t* base = O + (u.z / nH) * sCb + (u.z % nH) * sCh;
        const float ts = (u.pn >= t0 && u.pn < t1) ? tscale : 1.f;
        float mx0 = 0.f, mx1 = 0.f;
#pragma unroll
        for (int ai = 0; ai < 2; ++ai)
#pragma unroll
            for (int m = 0; m < 4; ++m) { const int row = row0 + ai * HALF + m * 16;
                float sc = ts; if (ss) sc *= __builtin_amdgcn_rsqf(ss[row] * (1.f / DM) + EPS) * rs_mul;
                bf16_t* rowp = base + (size_t)row * ldc + col0;
#pragma unroll
                for (int bj = 0; bj < 2; ++bj) { const f32x4 v0 = acc[ai][bj][m][0] * sc, v1 = acc[ai][bj][m][1] * sc;
                    u32x4 w; w.x = cvt_pk_bf16(v0[0], v0[1]); w.y = cvt_pk_bf16(v0[2], v0[3]); w.z = cvt_pk_bf16(v1[0], v1[1]); w.w = cvt_pk_bf16(v1[2], v1[3]);
                    *(u32x4*)(rowp + bj * HALF) = w;
                    if constexpr (NRM) { float q = (v0[0] * v0[0] + v0[1] * v0[1]) + (v0[2] * v0[2] + v0[3] * v0[3]) + (v1[0] * v1[0] + v1[1] * v1[1]) + (v1[2] * v1[2] + v1[3] * v1[3]);
                        q += __shfl_xor(q, 16); q += __shfl_xor(q, 32); if (bj == 0) mx0 = fmaxf(mx0, q); else mx1 = fmaxf(mx1, q); } } }
        if constexpr (NRM) { if (u.pn >= 4 && u.pn < 12) {
#pragma unroll
            for (int o = 1; o < 16; o <<= 1) { mx0 = fmaxf(mx0, __shfl_xor(mx0, o)); mx1 = fmaxf(mx1, __shfl_xor(mx1, o)); }
            if ((threadIdx.x & 63) == 0) { const int kind = u.pn >= 8, b = u.pm >> 4, h2 = ((u.pn - 4) & 3) * 2; unsigned* p = nrm + ((kind * 2 + b) * 8 + h2) * 4 + wc;
                atomicMax(p, __float_as_uint(mx0)); atomicMax(p + 4, __float_as_uint(mx1)); } } }
    }
};
typedef EpiStoreT<false> EpiStore;
template <bool BASE_BF16> struct EpiResid {
    static constexpr bool PERM = true, AFTER_DRAIN = false;
    const void* base; bf16_t* HB; float* ss; int zrows;
    __device__ __forceinline__ void operator()(const f32x4 (&acc)[2][2][4][2], const Unit& u, int wr, int wc, int fr, int fq) const {
        const int row0 = u.z * zrows + u.pm * BM + wr * 64 + fr, col0 = u.pn * BM + wc * 32 + 8 * fq;
#pragma unroll
        for (int ai = 0; ai < 2; ++ai)
#pragma unroll
            for (int m = 0; m < 4; ++m) { const int row = row0 + ai * HALF + m * 16; const size_t off = (size_t)row * DM + col0; float sq = 0.f;
#pragma unroll
                for (int bj = 0; bj < 2; ++bj) {
                    f32x4 b0, b1;
                    if constexpr (BASE_BF16) { const u32x4 r = *(const u32x4*)((const bf16_t*)base + off + bj * HALF);
                        b0 = (f32x4){__uint_as_float(r.x << 16), __uint_as_float(r.x & 0xffff0000u), __uint_as_float(r.y << 16), __uint_as_float(r.y & 0xffff0000u)};
                        b1 = (f32x4){__uint_as_float(r.z << 16), __uint_as_float(r.z & 0xffff0000u), __uint_as_float(r.w << 16), __uint_as_float(r.w & 0xffff0000u)}; }
                    else { b0 = *(const f32x4*)((const float*)base + off + bj * HALF); b1 = *(const f32x4*)((const float*)base + off + bj * HALF + 4); }
                    const f32x4 h0 = b0 + acc[ai][bj][m][0], h1 = b1 + acc[ai][bj][m][1];
                    u32x4 w; w.x = cvt_pk_bf16(h0[0], h0[1]); w.y = cvt_pk_bf16(h0[2], h0[3]); w.z = cvt_pk_bf16(h1[0], h1[1]); w.w = cvt_pk_bf16(h1[2], h1[3]);
                    *(u32x4*)(HB + off + bj * HALF) = w;
                    sq += (h0[0] * h0[0] + h0[1] * h0[1]) + (h0[2] * h0[2] + h0[3] * h0[3]) + (h1[0] * h1[0] + h1[1] * h1[1]) + (h1[2] * h1[2] + h1[3] * h1[3]); }
                sq += __shfl_xor(sq, 16); sq += __shfl_xor(sq, 32);
                if (fq == 0 && ss) atomicAdd(ss + row, sq); }
    }
};
struct EpiF32Col {
    static constexpr bool PERM = true, AFTER_DRAIN = false;
    float* O; int ldc; const float* ss;
    __device__ __forceinline__ void operator()(const f32x4 (&acc)[2][2][4][2], const Unit& u, int wr, int wc, int fr, int fq) const {
        const int row0 = u.pm * BM + wr * 64 + fr, col0 = u.pn * BM + wc * 32 + 8 * fq;
        f32x4 rs[2][2];
#pragma unroll
        for (int bj = 0; bj < 2; ++bj)
#pragma unroll
            for (int n = 0; n < 2; ++n) { const f32x4 s = *(const f32x4*)(ss + col0 + bj * HALF + 4 * n);
#pragma unroll
                for (int e = 0; e < 4; ++e) rs[bj][n][e] = __builtin_amdgcn_rsqf(s[e] * (1.f / DM) + EPS); }
#pragma unroll
        for (int ai = 0; ai < 2; ++ai)
#pragma unroll
            for (int m = 0; m < 4; ++m) { const int key = row0 + ai * HALF + m * 16;
#pragma unroll
                for (int bj = 0; bj < 2; ++bj) { const int tk = col0 + bj * HALF; float* p = O + ((size_t)(tk >> 5) * DM + key) * 32 + (tk & 31);
                    *(f32x4*)p = acc[ai][bj][m][0] * rs[bj][0]; *(f32x4*)(p + 4) = acc[ai][bj][m][1] * rs[bj][1]; } }
    }
};
struct EpiSoftmax {
    static constexpr bool PERM = true, AFTER_DRAIN = true;
    bf16_t* P; int ldc; long sCb, sCh; int nH; const float* ss; float mul; int zrows;
    __device__ __forceinline__ void fused(f32x4 (&acc)[2][2][4][2], const Unit& u, int wr, int wc, int fr, int fq, PG8_LAS unsigned char* lds, int wid, int lane) const {
        PG8_LAS float* Pm = (PG8_LAS float*)lds;
        PG8_LAS float* Ps = (PG8_LAS float*)(lds + 4096);
#pragma unroll
        for (int ai = 0; ai < 2; ++ai)
#pragma unroll
            for (int m = 0; m < 4; ++m) { float mx = -3.0e38f;
                const float rs = __builtin_amdgcn_rsqf(ss[u.z * zrows + u.pm * BM + ai * HALF + wr * 64 + m * 16 + fr] * (1.f / DM) + EPS) * mul;
#pragma unroll
                for (int bj = 0; bj < 2; ++bj)
#pragma unroll
                    for (int n = 0; n < 2; ++n) { const f32x4 x = acc[ai][bj][m][n] * rs; acc[ai][bj][m][n] = x; mx = fmaxf(mx, fmaxf(fmaxf(x[0], x[1]), fmaxf(x[2], x[3]))); }
                mx = fmaxf(mx, __shfl_xor(mx, 16)); mx = fmaxf(mx, __shfl_xor(mx, 32));
                if (fq == 0) Pm[(ai * HALF + wr * 64 + m * 16 + fr) * 4 + wc] = mx; }
        asm volatile("s_waitcnt lgkmcnt(0)" ::: "memory"); __builtin_amdgcn_s_barrier(); asm volatile("" ::: "memory");
#pragma unroll
        for (int ai = 0; ai < 2; ++ai)
#pragma unroll
            for (int m = 0; m < 4; ++m) { const int r = ai * HALF + wr * 64 + m * 16 + fr;
                const f32x4 pm4 = *(const PG8_LAS f32x4*)(Pm + r * 4); const float M = fmaxf(fmaxf(pm4[0], pm4[1]), fmaxf(pm4[2], pm4[3])); float s = 0.f;
#pragma unroll
                for (int bj = 0; bj < 2; ++bj)
#pragma unroll
                    for (int n = 0; n < 2; ++n) { f32x4 x = acc[ai][bj][m][n];
#pragma unroll
                        for (int e = 0; e < 4; ++e) { x[e] = __builtin_amdgcn_exp2f(x[e] - M); s += x[e]; }
                        acc[ai][bj][m][n] = x; }
                s += __shfl_xor(s, 16); s += __shfl_xor(s, 32);
                if (fq == 0) Ps[r * 4 + wc] = s; }
        asm volatile("s_waitcnt lgkmcnt(0)" ::: "memory"); __builtin_amdgcn_s_barrier(); asm volatile("" ::: "memory");
        bf16_t* base = P + (u.z / nH) * sCb + (u.z % nH) * sCh;
        const int row0 = u.pm * BM, col0 = u.pn * BM + wc * 32 + 8 * fq;
#pragma unroll
        for (int ai = 0; ai < 2; ++ai)
#pragma unroll
            for (int m = 0; m < 4; ++m) { const int r = ai * HALF + wr * 64 + m * 16 + fr;
                const f32x4 ps4 = *(const PG8_LAS f32x4*)(Ps + r * 4); const float inv = 1.f / ((ps4[0] + ps4[1]) + (ps4[2] + ps4[3]));
                bf16_t* rowp = base + (size_t)(row0 + r) * ldc + col0;
#pragma unroll
                for (int bj = 0; bj < 2; ++bj) { const f32x4 v0 = acc[ai][bj][m][0] * inv, v1 = acc[ai][bj][m][1] * inv;
                    u32x4 w; w.x = cvt_pk_bf16(v0[0], v0[1]); w.y = cvt_pk_bf16(v0[2], v0[3]); w.z = cvt_pk_bf16(v1[0], v1[1]); w.w = cvt_pk_bf16(v1[2], v1[3]);
                    *(u32x4*)(rowp + bj * HALF) = w; } }
    }
};

template <class Epi, class Sched, bool ALIGN_EPI>
__device__ __forceinline__ void gemm_phase(PG8_LAS unsigned char* lds, const Gemm g, const Sched& S, const Epi& E) {
    const int tid = threadIdx.x, wid = __builtin_amdgcn_readfirstlane(tid >> 6), lane = tid & 63, wr = wid >> 2, wc = wid & 3, fr = lane & 15, fq = lane >> 4;
    const int K = g.K, nt = K / BK;
    unsigned voffA[2], voffB[2];
#pragma unroll
    for (int i = 0; i < 2; ++i) { int R, C; stage_rc(tid * 16 + i * 8192, R, C); const int Rb = Epi::PERM ? ((R & ~31) + perm32(R & 31)) : R;
        voffA[i] = (unsigned)(R * g.lda + C) * 2u; voffB[i] = (unsigned)(Rb * g.ldb + C) * 2u; }
    const size_t kstep = (size_t)(BK * 2);
    const size_t hsA = (size_t)HALF * g.lda * 2, hsB = (size_t)HALF * g.ldb * 2;
    const unsigned ldsw = (unsigned)wid * 1024u;
    const int aoff = lds_byte(wr * 64 + fr, fq * 8), boff = lds_byte(wc * 32 + fr, fq * 8);
#define PG8_SA(b, h) (((b) * 2 + (h)) * HTB)
#define PG8_SB(b, h) ((4 + (b) * 2 + (h)) * HTB)
#define PG8_STAGE(bufoff, gbase, voff) do { _Pragma("unroll") for (int _i = 0; _i < 2; ++_i) \
        __builtin_amdgcn_global_load_lds((const unsigned*)((const char*)(gbase) + (voff)[_i]), (PG8_LAS unsigned*)(lds + (bufoff) + ldsw + _i * 8192), 16, 0, 0); } while (0)
#define PG8_LDA(dst, b, h) do { _Pragma("unroll") for (int m = 0; m < 4; ++m) _Pragma("unroll") for (int k = 0; k < 2; ++k) dst[m][k] = *(const PG8_LAS bf16x8*)(lds + PG8_SA(b, h) + aoff + m * 2048 + k * 1024); } while (0)
#define PG8_LDB(dst, b, h) do { _Pragma("unroll") for (int n = 0; n < 2; ++n) _Pragma("unroll") for (int k = 0; k < 2; ++k) dst[n][k] = *(const PG8_LAS bf16x8*)(lds + PG8_SB(b, h) + boff + n * 2048 + k * 1024); } while (0)
#define PG8_MMA(ai, bj, At, Bt) do { __builtin_amdgcn_s_setprio(1); _Pragma("unroll") for (int m = 0; m < 4; ++m) _Pragma("unroll") for (int n = 0; n < 2; ++n) _Pragma("unroll") for (int k = 0; k < 2; ++k) \
        acc[ai][bj][m][n] = __builtin_amdgcn_mfma_f32_16x16x32_bf16(Bt[n][k], At[m][k], acc[ai][bj][m][n], 0, 0, 0); __builtin_amdgcn_s_setprio(0); } while (0)
#define PG8_WAIT_V(n) asm volatile("s_waitcnt vmcnt(" #n ")" ::: "memory")
#define PG8_WAIT_L(n) asm volatile("s_waitcnt lgkmcnt(" #n ")" ::: "memory")
#define PG8_BAR __builtin_amdgcn_s_barrier()
#define PG8_SCHED __builtin_amdgcn_sched_barrier(0)
    Unit cur, nxt; int ui = 0;
    if (!S.next(0, cur)) return;
    f32x4 acc[2][2][4][2];
#pragma unroll
    for (int a = 0; a < 2; ++a)
#pragma unroll
        for (int b = 0; b < 2; ++b)
#pragma unroll
            for (int m = 0; m < 4; ++m)
#pragma unroll
                for (int n = 0; n < 2; ++n) acc[a][b][m][n] = (f32x4){0.f, 0.f, 0.f, 0.f};
    bf16x8 At[4][2], B0[2][2], B1[2][2];
    const char* cA = (const char*)g.A + (size_t)cur.aoff * 2; const char* cB = (const char*)g.Bt + (size_t)cur.boff * 2;
    S.a_ready(cur);
    PG8_STAGE(PG8_SB(0, 0), cB, voffB); PG8_STAGE(PG8_SB(0, 1), cB + hsB, voffB); PG8_STAGE(PG8_SA(0, 0), cA, voffA); PG8_STAGE(PG8_SA(0, 1), cA + hsA, voffA);
    if (wr == 1) PG8_BAR;
    PG8_WAIT_V(2); PG8_BAR;
    PG8_STAGE(PG8_SB(1, 0), cB + kstep, voffB); PG8_STAGE(PG8_SA(1, 0), cA + kstep, voffA); PG8_STAGE(PG8_SB(1, 1), cB + hsB + kstep, voffB);
    PG8_WAIT_V(6); PG8_BAR;
    for (;;) {
        const bool has_next = S.next(ui + 1, nxt);
        const char* nA = has_next ? (const char*)g.A + (size_t)nxt.aoff * 2 : cA; const char* nB = has_next ? (const char*)g.Bt + (size_t)nxt.boff * 2 : cB;
        for (int t = 0; t < nt; t += 2) {
            const bool last = (t == nt - 2);
            const char* a1 = cA + (size_t)(t + 1) * kstep;
            const char* a2 = last ? nA : cA + (size_t)(t + 2) * kstep; const char* b2 = last ? nB : cB + (size_t)(t + 2) * kstep;
            const char* a3 = a2 + kstep; const char* b3 = b2 + kstep;
            if (last && has_next) S.a_ready(nxt);
            PG8_LDB(B0, 0, 0); PG8_LDB(B1, 0, 1); PG8_SCHED; PG8_LDA(At, 0, 0); PG8_STAGE(PG8_SA(1, 1), a1 + hsA, voffA);
            PG8_WAIT_V(8); PG8_WAIT_L(0); PG8_BAR; PG8_MMA(0, 0, At, B0); PG8_MMA(0, 1, At, B1); PG8_BAR; PG8_SCHED;
            PG8_LDA(At, 0, 1); PG8_STAGE(PG8_SB(0, 0), b2, voffB); PG8_STAGE(PG8_SB(0, 1), b2 + hsB, voffB); PG8_STAGE(PG8_SA(0, 0), a2, voffA);
            PG8_WAIT_V(8); PG8_WAIT_L(0); PG8_BAR; PG8_MMA(1, 0, At, B0); PG8_MMA(1, 1, At, B1); PG8_BAR; PG8_SCHED;
            PG8_LDB(B0, 1, 0); PG8_LDB(B1, 1, 1); PG8_SCHED; PG8_LDA(At, 1, 0); PG8_STAGE(PG8_SA(0, 1), a2 + hsA, voffA);
            PG8_WAIT_V(8); PG8_WAIT_L(0); PG8_BAR; PG8_MMA(0, 0, At, B0); PG8_MMA(0, 1, At, B1); PG8_BAR; PG8_SCHED;
            PG8_LDA(At, 1, 1); PG8_STAGE(PG8_SB(1, 0), b3, voffB); PG8_STAGE(PG8_SB(1, 1), b3 + hsB, voffB); PG8_STAGE(PG8_SA(1, 0), a3, voffA);
            PG8_WAIT_V(8); PG8_WAIT_L(0); PG8_BAR; PG8_MMA(1, 0, At, B0); PG8_MMA(1, 1, At, B1); PG8_BAR; PG8_SCHED;
        }
        if constexpr (ALIGN_EPI) { if (wr == 0) PG8_BAR; }
        if constexpr (!Epi::AFTER_DRAIN) { E(acc, cur, wr, wc, fr, fq); S.done(cur); }
        if (!has_next) break;
#pragma unroll
        for (int a = 0; a < 2; ++a)
#pragma unroll
            for (int b = 0; b < 2; ++b)
#pragma unroll
                for (int m = 0; m < 4; ++m)
#pragma unroll
                    for (int n = 0; n < 2; ++n) acc[a][b][m][n] = (f32x4){0.f, 0.f, 0.f, 0.f};
        cur = nxt; cA = nA; cB = nB; ++ui;
        if constexpr (ALIGN_EPI) { if (wr == 1) PG8_BAR; }
    }
    PG8_WAIT_V(0);
    if constexpr (!ALIGN_EPI) { if (wr == 0) PG8_BAR; }
    PG8_BAR;
    if constexpr (Epi::AFTER_DRAIN) { E.fused(acc, cur, wr, wc, fr, fq, lds, wid, lane); S.done(cur); }
#undef PG8_SA
#undef PG8_SB
#undef PG8_STAGE
#undef PG8_LDA
#undef PG8_LDB
#undef PG8_MMA
#undef PG8_WAIT_V
#undef PG8_WAIT_L
#undef PG8_BAR
#undef PG8_SCHED
}
}

namespace fox {
typedef unsigned short bf16_t;
typedef short bf16x8 __attribute__((ext_vector_type(8)));
typedef short s16x4 __attribute__((ext_vector_type(4)));
typedef float f32x16 __attribute__((ext_vector_type(16)));
typedef float f32x4 __attribute__((ext_vector_type(4)));
typedef unsigned u32x4 __attribute__((ext_vector_type(4)));
constexpr int D = 128, NW = 8, QBLK = 32, KVBLK = 64, QB = NW * QBLK;
constexpr int SHM_V = KVBLK * D * 2, SHM_K = KVBLK * D * 2;
constexpr int LDS_C = 2 * SHM_V + 2 * SHM_K + NW * 64 * 4;
constexpr int LDS_BYTES = LDS_C + SEQ * 4;
constexpr int QP = 4096, OP = 2048;
constexpr float THR = 24.f;
#define KSWZ(row, colB) ((row) * 256 + ((colB) ^ (((row) & 7) << 4)))
#define SBAR() __builtin_amdgcn_sched_barrier(0)
__device__ __forceinline__ int v_st(int k, int c) { const int kk = (k & ~0xC) | ((k & 4) << 1) | ((k & 8) >> 1); return ((kk >> 3) * 4 + (c >> 5)) * 512 + ((kk & 7) * 32 + (c & 31)) * 2; }
__device__ __forceinline__ int v_rd_base(int lane) { return ((lane & 3) << 3) | (((lane >> 2) & 3) << 6) | (((lane >> 4) & 1) << 5) | (((lane >> 5) & 1) << 8); }
constexpr int v_rd_off(int d0, int ks, int half) { return d0 * 512 + ks * 4096 + half * 2048; }
__device__ __forceinline__ int crow(int r, int hi) { return (r & 3) + 8 * (r >> 2) + 4 * hi; }
__device__ __forceinline__ unsigned cvtpk(float lo, float hi) { unsigned r; asm volatile("v_cvt_pk_bf16_f32 %0, %1, %2" : "=v"(r) : "v"(lo), "v"(hi)); return r; }
__device__ __forceinline__ bf16x8 load8(const bf16_t* p) { return *reinterpret_cast<const bf16x8*>(p); }
__device__ __forceinline__ void mask_tile(f32x16& p0, f32x16& p1, int dq) {
    const float NEG = -__builtin_inff();
#pragma unroll
    for (int r = 0; r < 16; ++r) { const int c = (r & 3) + 8 * (r >> 2); if (dq - c < 0) p0[r] = NEG; if (dq - c - 32 < 0) p1[r] = NEG; }
}
__device__ __forceinline__ void bias_tile(f32x16& p0, f32x16& p1, const float* cb) {
#pragma unroll
    for (int i = 0; i < 4; ++i) { const f32x4 c0 = *(const f32x4*)(cb + 8 * i), c1 = *(const f32x4*)(cb + 32 + 8 * i);
#pragma unroll
        for (int j = 0; j < 4; ++j) { p0[4 * i + j] -= c0[j]; p1[4 * i + j] -= c1[j]; } }
}
__device__ __forceinline__ void partialSM(f32x16& p0, f32x16& p1, float& m_reg, float& mn, float& alpha) {
    float pmax = p0[0]; for (int r = 1; r < 16; ++r) pmax = fmaxf(pmax, p0[r]); for (int r = 0; r < 16; ++r) pmax = fmaxf(pmax, p1[r]);
    { auto rr = __builtin_amdgcn_permlane32_swap(__float_as_uint(pmax), __float_as_uint(pmax), false, false);
      pmax = fmaxf(__uint_as_float(rr[0]), __uint_as_float(rr[1])); }
    if (__builtin_expect(__all((pmax - m_reg) <= THR), 1)) { mn = m_reg; alpha = 1.f; }
    else { mn = fmaxf(m_reg, pmax); alpha = __builtin_amdgcn_exp2f(m_reg - mn); m_reg = mn; }
    for (int r = 0; r < 16; ++r) p0[r] = p0[r] - mn; for (int r = 0; r < 16; ++r) p1[r] = p1[r] - mn;
    for (int r = 0; r < 16; ++r) p0[r] = __builtin_amdgcn_exp2f(p0[r]);
}
__device__ __forceinline__ void finishSM(f32x16& p0, f32x16& p1, float alpha, float& l_reg, bf16x8& pa0, bf16x8& pa1, bf16x8& pa2, bf16x8& pa3) {
    for (int r = 0; r < 16; ++r) p1[r] = __builtin_amdgcn_exp2f(p1[r]);
    float ps = 0; for (int r = 0; r < 16; ++r) ps += p0[r]; for (int r = 0; r < 16; ++r) ps += p1[r];
    { auto rr = __builtin_amdgcn_permlane32_swap(__float_as_uint(ps), __float_as_uint(ps), false, false);
      ps = __uint_as_float(rr[0]) + __uint_as_float(rr[1]); }
    l_reg = l_reg * alpha + ps;
#define PK4(P, B_, OUT) do { unsigned a0 = cvtpk(P[B_+0], P[B_+1]), a1 = cvtpk(P[B_+2], P[B_+3]);                          \
        unsigned b0 = cvtpk(P[B_+4], P[B_+5]), b1 = cvtpk(P[B_+6], P[B_+7]);                                             \
        auto r0 = __builtin_amdgcn_permlane32_swap(a0, b0, false, false); auto r1 = __builtin_amdgcn_permlane32_swap(a1, b1, false, false); \
        u32x4 w = {r0[0], r1[0], r0[1], r1[1]}; OUT = *reinterpret_cast<bf16x8*>(&w); } while (0)
    PK4(p0, 0, pa0); PK4(p0, 8, pa1); PK4(p1, 0, pa2); PK4(p1, 8, pa3);
#undef PK4
}
template <int KB>
__device__ __forceinline__ void qkt(f32x16& p0, f32x16& p1, const char* K_lds, int r32, int hi, const bf16x8* qr) {
    p0 = f32x16{}; p1 = f32x16{};
    const char* kb[4];
#pragma unroll
    for (int dd = 0; dd < 4; ++dd) kb[dd] = K_lds + KB * SHM_K + KSWZ(r32, (dd * 16 + hi * 8) * 2);
#pragma unroll
    for (int d0 = 0; d0 < 8; ++d0) { const char* a = kb[d0 & 3] + (d0 >> 2) * 128;
        bf16x8 b0 = *reinterpret_cast<const bf16x8*>(a);
        bf16x8 b1 = *reinterpret_cast<const bf16x8*>(a + 32 * 256);
        p0 = __builtin_amdgcn_mfma_f32_32x32x16_bf16(b0, qr[d0], p0, 0, 0, 0);
        p1 = __builtin_amdgcn_mfma_f32_32x32x16_bf16(b1, qr[d0], p1, 0, 0, 0); }
}
template <int VB>
__device__ __forceinline__ void pv_tile(f32x16* o, int vb0, bf16x8 pa0, bf16x8 pa1, bf16x8 pa2, bf16x8 pa3) {
#define TRRD(dst, off) asm volatile("ds_read_b64_tr_b16 %0, %1 offset:%2" : "=&v"(dst) : "v"(vb0), "i"(off) : "memory")
#define PV_D0(d0) do { s16x4 l0, l1, l2, l3, h0, h1, h2, h3; constexpr int b_ = VB * SHM_V + v_rd_off(d0, 0, 0); \
        TRRD(l0, b_); TRRD(h0, b_ + 2048); TRRD(l1, b_ + 4096); TRRD(h1, b_ + 6144); TRRD(l2, b_ + 8192); TRRD(h2, b_ + 10240); TRRD(l3, b_ + 12288); TRRD(h3, b_ + 14336); \
        asm volatile("s_waitcnt lgkmcnt(0)" ::: "memory"); SBAR();   \
        o[d0] = __builtin_amdgcn_mfma_f32_32x32x16_bf16(pa0, (bf16x8){l0[0], l0[1], l0[2], l0[3], h0[0], h0[1], h0[2], h0[3]}, o[d0], 0, 0, 0);   \
        o[d0] = __builtin_amdgcn_mfma_f32_32x32x16_bf16(pa1, (bf16x8){l1[0], l1[1], l1[2], l1[3], h1[0], h1[1], h1[2], h1[3]}, o[d0], 0, 0, 0);   \
        o[d0] = __builtin_amdgcn_mfma_f32_32x32x16_bf16(pa2, (bf16x8){l2[0], l2[1], l2[2], l2[3], h2[0], h2[1], h2[2], h2[3]}, o[d0], 0, 0, 0);   \
        o[d0] = __builtin_amdgcn_mfma_f32_32x32x16_bf16(pa3, (bf16x8){l3[0], l3[1], l3[2], l3[3], h3[0], h3[1], h3[2], h3[3]}, o[d0], 0, 0, 0); } while (0)
    PV_D0(0); PV_D0(1); PV_D0(2); PV_D0(3);
#undef PV_D0
#undef TRRD
}
struct BlockRef { const bf16_t* Q; const bf16_t* K; const bf16_t* V; bf16_t* O; int P0; };
struct Seam { bf16x8 qr[8]; bf16x8 st_v0, st_v1, st_k0, st_k1; };
#define ROW(p, k0, rr) ((p) + (size_t)((k0) + (rr)) * QP + sc)
#define VMW() asm volatile("s_waitcnt vmcnt(0)" ::: "memory")
#define VMWN(n) asm volatile("s_waitcnt vmcnt(%0)" :: "i"(n) : "memory")
#define SLOAD_H(Kp, Vp, k0) do { S.st_v0 = load8(ROW(Vp, k0, sr)); S.st_v1 = load8(ROW(Vp, k0, 32 + sr)); S.st_k0 = load8(ROW(Kp, k0, sr)); S.st_k1 = load8(ROW(Kp, k0, 32 + sr)); } while (0)
#define SWRITE_HK(bf) do { *(bf16x8*)(K_lds + (bf) * SHM_K + kws) = S.st_k0; *(bf16x8*)(K_lds + (bf) * SHM_K + kws + 32 * 256) = S.st_k1; } while (0)
#define SWRITE_HV(bf) do { *(bf16x8*)(V_lds + (bf) * SHM_V + vst0) = S.st_v0; *(bf16x8*)(V_lds + (bf) * SHM_V + vst1) = S.st_v1; } while (0)
#define SWRITE_H(bf) do { SWRITE_HV(bf); SWRITE_HK(bf); } while (0)
__device__ __forceinline__ void prime(const BlockRef& cur, int j_lo, char* lds, Seam& S) {
    const int tid = threadIdx.x, wid = __builtin_amdgcn_readfirstlane(tid >> 6), lane = tid & 63, r32 = lane & 31, hi = lane >> 5;
    const int sr = tid >> 4, sc = (tid & 15) * 8, kws = KSWZ(sr, sc * 2); char* K_lds = lds + 2 * SHM_V;
    for (int d0 = 0; d0 < 8; ++d0) S.qr[d0] = load8(cur.Q + (size_t)(wid * QBLK + r32) * QP + d0 * 16 + hi * 8);
    SLOAD_H(cur.K, cur.V, j_lo * KVBLK); VMW(); SWRITE_HK(0);
    __syncthreads();
}
__device__ __forceinline__ void block(const BlockRef& cur, const BlockRef& nxt, int j_lo, char* lds, Seam& S) {
    const int tid = threadIdx.x, wid = __builtin_amdgcn_readfirstlane(tid >> 6), lane = tid & 63, r32 = lane & 31, hi = lane >> 5;
    const int NT = (cur.P0 + QB - 1) / KVBLK + 1 - j_lo;
    const int qlo = cur.P0 + wid * QBLK, qm = qlo + r32 - 4 * hi;
    char* V_lds = lds; char* K_lds = lds + 2 * SHM_V;
    float* ws = (float*)(lds + 2 * SHM_V + 2 * SHM_K) + wid * 64; float* li_l = ws, * al_l = ws + 32;
    const float* c_lds = (const float*)(lds + LDS_C) + 4 * hi;
    float m_reg = -1e30f, l_reg = 0; f32x16 o[4] = {};
    const int sr = tid >> 4, sc = (tid & 15) * 8, vst0 = v_st(sr, sc), vst1 = v_st(32 + sr, sc), kws = KSWZ(sr, sc * 2);
    const int vb0 = (int)(uintptr_t)V_lds + v_rd_base(lane);
    const bf16_t* Kh = cur.K; const bf16_t* Vh = cur.V;
#define RESC(a) do { if (__any((a) < 1.f)) { if (hi == 0) al_l[r32] = (a); asm volatile("s_waitcnt lgkmcnt(0)" ::: "memory");              \
                     for (int d_ = 0; d_ < 4; ++d_) for (int r = 0; r < 16; ++r) o[d_][r] *= al_l[crow(r, hi)]; } } while (0)
#define KBASE(t) ((j_lo + (t)) * KVBLK)
#define MASKT(P0_, P1_, t) do { const int kb_ = KBASE(t); bias_tile(P0_, P1_, c_lds + kb_); if (kb_ + KVBLK - 1 > qlo) mask_tile(P0_, P1_, qm - kb_); } while (0)
#define SEAM_K0() do { VMWN(8); SWRITE_HK(0); SBAR(); } while (0)
    f32x16 pA0, pA1, pB0, pB1; float mnA, mnB, alA, alB; bf16x8 pa0, pa1, pa2, pa3;
    SWRITE_HV(0); SBAR();
    if (NT > 1) { SLOAD_H(Kh, Vh, KBASE(1)); }
    SBAR(); qkt<0>(pA0, pA1, K_lds, r32, hi, S.qr);
    MASKT(pA0, pA1, 0); partialSM(pA0, pA1, m_reg, mnA, alA);
    if (NT > 1) { VMW(); SWRITE_H(1); }
    __syncthreads();
#define HALF_STEP(PX0, PX1, mnX, alX, PY0, PY1, alY, t, KB, VB, SB) do {                                                      \
        SBAR(); qkt<KB>(PX0, PX1, K_lds, r32, hi, S.qr);                                                                     \
        finishSM(PY0, PY1, alY, l_reg, pa0, pa1, pa2, pa3); SBAR();                                                           \
        if ((t) + 1 < NT) { SLOAD_H(Kh, Vh, KBASE((t) + 1)); SBAR(); }                                                        \
        pv_tile<VB>(o, vb0, pa0, pa1, pa2, pa3); MASKT(PX0, PX1, (t)); partialSM(PX0, PX1, m_reg, mnX, alX);                 \
        __syncthreads();                                                                                                      \
        if ((t) + 1 < NT) { VMW(); SWRITE_H(SB); }                                                                            \
        RESC(alX); __syncthreads(); } while (0)
    for (int t = 1; t + 1 < NT; t += 2) {
        HALF_STEP(pB0, pB1, mnB, alB, pA0, pA1, alA, t, 1, 0, 0);
        HALF_STEP(pA0, pA1, mnA, alA, pB0, pB1, alB, t + 1, 0, 1, 1);
    }
    const bool even = (NT & 1) == 0;
    if (even) { SBAR(); qkt<1>(pB0, pB1, K_lds, r32, hi, S.qr); SBAR(); }
    SLOAD_H(nxt.K, nxt.V, j_lo * KVBLK); SBAR();
#pragma unroll
    for (int d0 = 0; d0 < 8; ++d0) S.qr[d0] = load8(nxt.Q + (size_t)(wid * QBLK + r32) * QP + d0 * 16 + hi * 8);
    SBAR();
    finishSM(pA0, pA1, alA, l_reg, pa0, pa1, pa2, pa3); SBAR();
    pv_tile<0>(o, vb0, pa0, pa1, pa2, pa3);
    if (even) { MASKT(pB0, pB1, NT - 1); partialSM(pB0, pB1, m_reg, mnB, alB); __syncthreads(); RESC(alB);
        finishSM(pB0, pB1, alB, l_reg, pa0, pa1, pa2, pa3); SBAR(); pv_tile<1>(o, vb0, pa0, pa1, pa2, pa3); }
    SBAR(); SEAM_K0();
    if (hi == 0) li_l[r32] = l_reg; asm volatile("s_waitcnt lgkmcnt(0)" ::: "memory");
    float rli[16];
#pragma unroll
    for (int r = 0; r < 16; ++r) rli[r] = __builtin_amdgcn_rcpf(li_l[crow(r, hi)]);
    bf16_t* Ow = cur.O + (size_t)(wid * QBLK) * OP;
#pragma unroll
    for (int r = 0; r < 16; ++r) { const int orow = crow(r, hi);
#pragma unroll
        for (int d0 = 0; d0 < 4; ++d0) { const float v = o[d0][r] * rli[r];
            const float vn = __shfl_xor(v, 1);
            if ((r32 & 1) == 0) *(unsigned*)(Ow + (size_t)orow * OP + d0 * 32 + r32) = cvtpk(v, vn); } }
    __syncthreads();
#undef RESC
#undef KBASE
#undef MASKT
#undef SEAM_K0
#undef HALF_STEP
}
#undef ROW
#undef VMW
#undef VMWN
#undef SLOAD_H
#undef SWRITE_HK
#undef SWRITE_HV
#undef SWRITE_H
#undef KSWZ
#undef SBAR
}

constexpr int NWAVES = 8, NTHREADS = 512;
constexpr int LDS_BYTES = 147456;
constexpr int LDS_MISC = 145408;
constexpr size_t MiB = 1u << 20;
constexpr size_t WS_CTL = 0, CTL_ZERO_BYTES = 1 * MiB;
#ifndef QSPLIT
#define QSPLIT 1024
#endif
constexpr int CW_QUEUE2 = 128;
constexpr int CW_NRM = 512;
constexpr int CW_QUEUE = 64;
constexpr int CW_BAR = 4096;
constexpr size_t CTL_SS1 = 256 * 1024, CTL_SS2 = 320 * 1024;
constexpr size_t WS_LF = 1 * MiB;
constexpr size_t WS_SU = 1 * MiB + 512 * 1024, WS_SV = 1 * MiB + 640 * 1024;
constexpr size_t WS_WIN = 2 * MiB, WS_WO1 = 18 * MiB, WS_WO2 = 26 * MiB, WS_WQ = 34 * MiB, WS_WK = 42 * MiB, WS_WV = 50 * MiB, WS_WO = 58 * MiB;
constexpr size_t WS_WPQ = 66 * MiB, WS_AEXP = 74 * MiB, WS_WSC = 82 * MiB, WS_PB = 90 * MiB, WS_MN = 91 * MiB, WS_KX = 93 * MiB, WS_VXT = 95 * MiB;
constexpr size_t WS_UB = 98 * MiB, WS_VB = 130 * MiB, WS_XN = 226 * MiB, WS_PROJ = 258 * MiB, WS_AMIX = 322 * MiB, WS_H = 354 * MiB, WS_HB = 418 * MiB, WS_P = 450 * MiB, WS_END = 466 * MiB;

#define GAS __attribute__((address_space(1)))
#define LAS __attribute__((address_space(3)))
typedef unsigned short bf16;
typedef unsigned v4u __attribute__((ext_vector_type(4)));
typedef unsigned v2u __attribute__((ext_vector_type(2)));
typedef float f32x4 __attribute__((ext_vector_type(4)));
typedef __bf16 bf16x2_t __attribute__((ext_vector_type(2)));
#define LDS_WAIT() asm volatile("s_waitcnt lgkmcnt(0)" ::: "memory")
__device__ __forceinline__ unsigned f2bf(float f) { unsigned u = __builtin_bit_cast(unsigned, f); return (u + 0x7fffu + ((u >> 16) & 1u)) >> 16; }
__device__ __forceinline__ unsigned pk2(float lo, float hi) { return f2bf(lo) | (f2bf(hi) << 16); }
__device__ __forceinline__ float wave_sum(float v) {
#pragma unroll
    for (int o = 1; o < 64; o <<= 1) v += __shfl_xor(v, o);
    return v;
}

#define XB_TMO      128
#define XB_XCNT(j)  (256  + 64 * (j))
#define XB_XSUB(j)  (1280 + 64 * (j))
#define XB_XGEN(j)  (2304 + 64 * (j))
#define XB_TOP      3328
#define XB_TOPGEN   3392
#define XCD_BAR_WORDS 3456
#define XB_SPIN_CAP (1u << 22)
__device__ __forceinline__ unsigned xb_ld(unsigned* p)              { return __hip_atomic_load(p, __ATOMIC_RELAXED, __HIP_MEMORY_SCOPE_AGENT); }
__device__ __forceinline__ unsigned xb_add(unsigned* p, unsigned v) { return __hip_atomic_fetch_add(p, v, __ATOMIC_RELAXED, __HIP_MEMORY_SCOPE_AGENT); }
__device__ __forceinline__ unsigned xb_xcc_id() { return (unsigned)__builtin_amdgcn_s_getreg((3 << 11) | 20) & 0xFu; }
#define XB_SPIN(cond, bar) do { unsigned _sp = 0; while (cond) { __builtin_amdgcn_s_sleep(1); \
    if ((++_sp & 255u) == 0u) { if (xb_ld(&(bar)[XB_TMO])) break; if (_sp > XB_SPIN_CAP) { atomicAdd(&(bar)[XB_TMO], 1u); break; } } } } while (0)
struct XcdBarrier { unsigned* bar; unsigned x; volatile LAS unsigned* st; };
__device__ __forceinline__ XcdBarrier xcd_barrier_post(unsigned* bar, volatile LAS unsigned* st) {
    XcdBarrier b; b.bar = bar; b.x = xb_xcc_id(); b.st = st;
    if (threadIdx.x == 0) (void)xb_add(&bar[XB_XCNT(b.x)], 1u);
    return b;
}
__device__ __forceinline__ void xcd_barrier_complete(unsigned* bar, unsigned x, unsigned& nloc, unsigned& nx) {
    const unsigned G = gridDim.x * gridDim.y * gridDim.z;
    unsigned sum, cnt, mine, sp = 0u;
    for (;;) {
        sum = 0u; cnt = 0u; mine = 0u;
#pragma unroll
        for (unsigned j = 0; j < 16; ++j) { const unsigned c = xb_ld(&bar[XB_XCNT(j)]); sum += c; cnt += (c > 0u) ? 1u : 0u; mine = (j == x) ? c : mine; }
        if (sum == G) break;
        __builtin_amdgcn_s_sleep(1);
        if ((++sp & 255u) == 0u) { if (xb_ld(&bar[XB_TMO])) break; if (sp > XB_SPIN_CAP) { atomicAdd(&bar[XB_TMO], 1u); break; } }
    }
    nloc = mine > 0u ? mine : 1u; nx = cnt > 0u ? cnt : 1u;
}
__device__ __forceinline__ void xcd_barrier(const XcdBarrier& b) {
    asm volatile("s_waitcnt vmcnt(0)" ::: "memory");
    __syncthreads();
    if (threadIdx.x == 0) {
        unsigned* bar = b.bar;
        __builtin_amdgcn_s_waitcnt(0);
        unsigned nloc = b.st[0], nx = b.st[1];
        if (nloc == 0u) { xcd_barrier_complete(bar, b.x, nloc, nx); b.st[0] = nloc; b.st[1] = nx; }
        const unsigned old = xb_add(&bar[XB_XSUB(b.x)], 1u);
        const unsigned gen = old / nloc;
        if (old + 1u == (gen + 1u) * nloc) {
            __builtin_amdgcn_fence(__ATOMIC_RELEASE, "agent");
            asm volatile("s_waitcnt vmcnt(0)" ::: "memory");
            const unsigned og = xb_add(&bar[XB_TOP], 1u);
            const unsigned tg = og / nx;
            if (og + 1u == (tg + 1u) * nx) xb_add(&bar[XB_TOPGEN], 1u);
            else XB_SPIN(xb_ld(&bar[XB_TOPGEN]) == tg, bar);
            __builtin_amdgcn_fence(__ATOMIC_ACQUIRE, "agent");
            xb_add(&bar[XB_XGEN(b.x)], 1u);
            asm volatile("s_waitcnt vmcnt(0)" ::: "memory");
        } else {
            XB_SPIN(xb_ld(&bar[XB_XGEN(b.x)]) == gen, bar);
            __builtin_amdgcn_fence(__ATOMIC_ACQUIRE, "agent");
            asm volatile("s_waitcnt vmcnt(0)" ::: "memory");
        }
    }
    __syncthreads();
}

struct Args { const float* in[20]; float* out; unsigned char* ws; int ph_lo, ph_hi; int one_launch, pad; };

__device__ __forceinline__ void tr_load(const float* W, int ldw, int nblk, int item, int lane, f32x4 (&tv)[8]) {
    const int kb = item / nblk, nb = item % nblk, k0 = 64 * kb, n0 = 32 * nb;
#pragma unroll
    for (int i = 0; i < 8; ++i) tv[i] = *(const GAS f32x4*)(W + (size_t)(k0 + i * 8 + (lane >> 3)) * ldw + n0 + (lane & 7) * 4);
}
__device__ __forceinline__ void tr_store(const f32x4 (&tv)[8], int nblk, bf16* WT, bf16* WT2, int k2lo, int ldt, LAS float* scr, int item, int lane) {
    const int kb = item / nblk, nb = item % nblk, k0 = 64 * kb, n0 = 32 * nb;
#pragma unroll
    for (int i = 0; i < 8; ++i) { const int kk = i * 8 + (lane >> 3); LAS float* d = scr + kk * 33 + (lane & 7) * 4; d[0] = tv[i][0]; d[1] = tv[i][1]; d[2] = tv[i][2]; d[3] = tv[i][3]; }
    LDS_WAIT(); asm volatile("" ::: "memory");
    const int c = lane & 7;
#pragma unroll
    for (int j = 0; j < 4; ++j) { const int n = (lane >> 3) + 8 * j; const LAS float* s = scr + (8 * c) * 33 + n;
        v4u o; o.x = pk2(s[0 * 33], s[1 * 33]); o.y = pk2(s[2 * 33], s[3 * 33]); o.z = pk2(s[4 * 33], s[5 * 33]); o.w = pk2(s[6 * 33], s[7 * 33]);
        *(GAS v4u*)(WT + (size_t)(n0 + n) * ldt + k0 + 8 * c) = o;
        if (WT2 && k0 >= k2lo) *(GAS v4u*)(WT2 + (size_t)(n0 + n) * ldt + k0 + 8 * c) = o; }
    LDS_WAIT(); asm volatile("" ::: "memory");
}
__device__ __forceinline__ void p0_transpose_item(const float* W, int ldw, int nblk, const float* g, bf16* WT, bf16* WT2, int k2lo, int ldt, LAS float* scr, int item, int lane) {
    (void)g; f32x4 tv[8]; tr_load(W, ldw, nblk, item, lane, tv); tr_store(tv, nblk, WT, WT2, k2lo, ldt, scr, item, lane);
}
__device__ __forceinline__ v4u cvt8(const float* p, float s) {
    const f32x4 a = *(const f32x4*)p, b = *(const f32x4*)(p + 4);
    v4u o; o.x = pk2(a[0] * s, a[1] * s); o.y = pk2(a[2] * s, a[3] * s); o.z = pk2(b[0] * s, b[1] * s); o.w = pk2(b[2] * s, b[3] * s); return o;
}

__device__ __forceinline__ float gelu_f(float v) {
    const float av = fabsf(v), t = __builtin_amdgcn_rcpf(av * 0.2316418882f + 1.0f);
    float q = t * 0.5307027145f + (-0.7265760135f); q = q * t + 0.7107068705f; q = q * t + (-0.142248368f); q = q * t + 0.127414796f; q = q * t;
    const float e = __builtin_amdgcn_exp2f((v * v) * (-0.72134752044f));
    const float m = v * (q * e);
    return v < 0.f ? m : v - m;
}
__device__ __forceinline__ float dot2bf(unsigned a, unsigned b, float c) { return __builtin_amdgcn_fdot2_f32_bf16(__builtin_bit_cast(bf16x2_t, a), __builtin_bit_cast(bf16x2_t, b), c, false); }
__device__ __forceinline__ unsigned fkey(float f) { const unsigned u = __float_as_uint(f); return (u & 0x80000000u) ? ~u : (u | 0x80000000u); }
__device__ __forceinline__ float fdec(unsigned k) { const unsigned u = (k & 0x80000000u) ? (k & 0x7fffffffu) : ~k; return __uint_as_float(u); }


typedef float f32x2v __attribute__((ext_vector_type(2)));
__device__ __forceinline__ float wave_sum_dpp(float v) {
    v += __builtin_bit_cast(float, __builtin_amdgcn_update_dpp(0, __builtin_bit_cast(int, v), 0xB1, 0xf, 0xf, true));
    v += __builtin_bit_cast(float, __builtin_amdgcn_update_dpp(0, __builtin_bit_cast(int, v), 0x4E, 0xf, 0xf, true));
    v += __builtin_bit_cast(float, __builtin_amdgcn_update_dpp(0, __builtin_bit_cast(int, v), 0x141, 0xf, 0xf, true));
    v += __builtin_bit_cast(float, __builtin_amdgcn_update_dpp(0, __builtin_bit_cast(int, v), 0x140, 0xf, 0xf, true));
    const float a = __builtin_bit_cast(float, __builtin_amdgcn_readlane(__builtin_bit_cast(int, v), 0));
    const float b = __builtin_bit_cast(float, __builtin_amdgcn_readlane(__builtin_bit_cast(int, v), 16));
    const float c = __builtin_bit_cast(float, __builtin_amdgcn_readlane(__builtin_bit_cast(int, v), 32));
    const float d = __builtin_bit_cast(float, __builtin_amdgcn_readlane(__builtin_bit_cast(int, v), 48));
    return (a + b) + (c + d);
}
typedef float v32f __attribute__((ext_vector_type(32)));
typedef float v16f __attribute__((ext_vector_type(16)));
typedef unsigned v6u __attribute__((ext_vector_type(6)));
#ifndef FP6_INTERLEAVED
#define FP6_INTERLEAVED 1
#endif
__device__ __forceinline__ v32f dec_fp6(const v4u a, const v2u b) { const v6u w = {a.x, a.y, a.z, a.w, b.x, b.y}; return __builtin_amdgcn_cvt_scalef32_pk32_f32_fp6(w, 1.0f); }
typedef __bf16 v32bf __attribute__((ext_vector_type(32)));
typedef unsigned v16u __attribute__((ext_vector_type(16)));
__device__ __forceinline__ float peer_dot(const v4u ua, const v2u ub, const unsigned (&xnp)[16]) {
    const v6u w = {ua.x, ua.y, ua.z, ua.w, ub.x, ub.y};
    const v16u fu = __builtin_bit_cast(v16u, __builtin_amdgcn_cvt_scalef32_pk32_bf16_fp6(w, 1.0f));
    unsigned fa[16];
#pragma unroll
    for (int i = 0; i < 16; ++i) fa[i] = fu[i];
    float a[4] = {0.f, 0.f, 0.f, 0.f};
#pragma unroll
    for (int i = 0; i < 16; ++i) a[i & 3] = dot2bf(fa[i], xnp[i], a[i & 3]);
    return (a[0] + a[1]) + (a[2] + a[3]);
}
__device__ __forceinline__ float peer_dot_lds(const v4u ua, const v2u ub, const LAS v4u* xl) {
    const v6u w = {ua.x, ua.y, ua.z, ua.w, ub.x, ub.y};
    const v16u fu = __builtin_bit_cast(v16u, __builtin_amdgcn_cvt_scalef32_pk32_bf16_fp6(w, 1.0f));
    unsigned fa[16];
#pragma unroll
    for (int i = 0; i < 16; ++i) fa[i] = fu[i];
    float a[4] = {0.f, 0.f, 0.f, 0.f};
#pragma unroll
    for (int i4 = 0; i4 < 4; ++i4) { const v4u x4 = xl[i4 * 64];
        a[0] = dot2bf(fa[i4 * 4 + 0], x4.x, a[0]); a[1] = dot2bf(fa[i4 * 4 + 1], x4.y, a[1]); a[2] = dot2bf(fa[i4 * 4 + 2], x4.z, a[2]); a[3] = dot2bf(fa[i4 * 4 + 3], x4.w, a[3]); }
    return (a[0] + a[1]) + (a[2] + a[3]);
}
typedef _Float16 h16x2 __attribute__((ext_vector_type(2)));
__device__ __forceinline__ unsigned pkfma_h(unsigned a, unsigned b, unsigned c) { return __builtin_bit_cast(unsigned, __builtin_elementwise_fma(__builtin_bit_cast(h16x2, a), __builtin_bit_cast(h16x2, b), __builtin_bit_cast(h16x2, c))); }
__device__ __forceinline__ float h16lo(unsigned u) { return (float)__builtin_bit_cast(h16x2, u).x; }
__device__ __forceinline__ float h16hi(unsigned u) { return (float)__builtin_bit_cast(h16x2, u).y; }
__device__ __forceinline__ void peer_axpy_h(const v4u va, const v2u vb, float w, unsigned (&oh)[16]) {
    const v6u wv = {va.x, va.y, va.z, va.w, vb.x, vb.y};
    const v16u fu = __builtin_bit_cast(v16u, __builtin_amdgcn_cvt_scalef32_pk32_f16_fp6(wv, 1.0f));
    unsigned fa[16];
#pragma unroll
    for (int i = 0; i < 16; ++i) fa[i] = fu[i];
    const h16x2 w2 = {(_Float16)w, (_Float16)w}; const unsigned wu = __builtin_bit_cast(unsigned, w2);
#pragma unroll
    for (int i = 0; i < 16; ++i) oh[i] = pkfma_h(fa[i], wu, oh[i]);
}
__device__ __forceinline__ void peer_axpy(const v4u va, const v2u vb, float w, float (&oacc)[32]) {
    const v32f f = dec_fp6(va, vb);
#pragma unroll
    for (int i = 0; i < 32; ++i) oacc[i] = fmaf(w, f[i], oacc[i]);
}


template <int NR>
__device__ __forceinline__ void conv_rows_fp6(const float* srow0, unsigned char* drow0, float* sc0, int lane) {
    f32x4 v[NR][8]; float am[NR];
#pragma unroll
    for (int q = 0; q < 8; ++q)
#pragma unroll
        for (int r = 0; r < NR; ++r) v[r][q] = *(const GAS f32x4*)(srow0 + (size_t)r * DM + lane * 4 + q * 256);
#pragma unroll
    for (int r = 0; r < NR; ++r) { am[r] = 0.f;
#pragma unroll
        for (int q = 0; q < 8; ++q) am[r] = fmaxf(am[r], fmaxf(fmaxf(fabsf(v[r][q][0]), fabsf(v[r][q][1])), fmaxf(fabsf(v[r][q][2]), fabsf(v[r][q][3])))); }
#pragma unroll
    for (int o = 1; o < 64; o <<= 1)
#pragma unroll
        for (int r = 0; r < NR; ++r) am[r] = fmaxf(am[r], __shfl_xor(am[r], o));
#pragma unroll
    for (int r = 0; r < NR; ++r) {
        int ex = 0; if (am[r] > 0.f) { (void)frexpf(am[r], &ex); ex = 3 - ex; if (ldexpf(am[r], ex) > 7.5f) ex -= 1; }
        const float sc = ldexpf(1.f, ex);
        if (lane == 0) sc0[r] = ldexpf(1.f, -ex);
        v16f xa, xb;
#pragma unroll
        for (int i = 0; i < 16; ++i) { xa[i] = v[r][(2 * i) >> 2][(2 * i) & 3] * sc; xb[i] = v[r][(2 * i + 1) >> 2][(2 * i + 1) & 3] * sc; }
        const v6u w = __builtin_amdgcn_cvt_scalef32_2xpk16_fp6_f32(xa, xb, 1.0f);
        unsigned char* drow = drow0 + (size_t)r * 1536;
        *(GAS v4u*)(drow + lane * 16) = (v4u){w[0], w[1], w[2], w[3]};
        *(GAS v2u*)(drow + 1024 + lane * 8) = (v2u){w[4], w[5]};
    }
}

#if defined(PROBE_SEL) && PROBE_SEL < 7
#define PROBE_EXPORT(T_, q) do { if ((T_) == 0 && lane == 0 && (q) == 0) { const unsigned long long a_ = ((unsigned long long)MISC[33 + 2 * PROBE_SEL] << 32) | MISC[32 + 2 * PROBE_SEL], b_ = ((unsigned long long)MISC[35 + 2 * PROBE_SEL] << 32) | MISC[34 + 2 * PROBE_SEL]; o[0] += (float)(b_ - a_) * 0.001f; } } while (0)
#else
#define PROBE_EXPORT(T_, q) do { } while (0)
#endif
__global__ void __launch_bounds__(NTHREADS, 2) fwd_kernel(Args args) {
    extern __shared__ __attribute__((aligned(16))) unsigned char lds[];
    LAS unsigned char* ldsL = (LAS unsigned char*)lds;
    volatile LAS unsigned* MISC = (volatile LAS unsigned*)(ldsL + LDS_MISC);
    const int tid = threadIdx.x, lane = tid & 63, wave = __builtin_amdgcn_readfirstlane(tid >> 6);
    const int G = gridDim.x; const int bx = blockIdx.x; const int vcu = (G % 8 == 0) ? (bx % 8) * (G / 8) + bx / 8 : bx;
#define G_ws (args.ws)
#define G_ctl ((unsigned*)(args.ws + WS_CTL))
#define G_x (args.in[0])
#define G_mem (args.in[1])
#define G_mix_norm (args.in[2])
#define G_w_in (args.in[3])
#define G_b_forget (args.in[4])
#define G_pool_w (args.in[5])
#define G_pool_scale (args.in[6])
#define G_w_out (args.in[7])
#define G_xattn_norm (args.in[8])
#define G_mem_norm (args.in[9])
#define G_xwq (args.in[10])
#define G_xwk (args.in[11])
#define G_xwv (args.in[12])
#define G_xwo (args.in[13])
#define G_peer_norm (args.in[14])
#define G_peer_wq (args.in[15])
#define G_sub_keys (args.in[16])
#define G_peer_u (args.in[17])
#define G_peer_v (args.in[18])
#define G_final_norm (args.in[19])
#define G_W_IN ((bf16*)(args.ws + WS_WIN))
#define G_WO1 ((bf16*)(args.ws + WS_WO1))
#define G_WO2 ((bf16*)(args.ws + WS_WO2))
#define G_WQ ((bf16*)(args.ws + WS_WQ))
#define G_WK ((bf16*)(args.ws + WS_WK))
#define G_WV ((bf16*)(args.ws + WS_WV))
#define G_WO ((bf16*)(args.ws + WS_WO))
#define G_WPQ ((bf16*)(args.ws + WS_WPQ))
#define G_AEXP ((bf16*)(args.ws + WS_AEXP))
#define G_W1 ((bf16*)(args.ws + WS_AEXP))
#define G_W2 ((bf16*)(args.ws + WS_WPQ))
#define G_WSC ((bf16*)(args.ws + WS_WSC))
#define G_PB ((bf16*)(args.ws + WS_PB))
#define G_MN ((bf16*)(args.ws + WS_MN))
#define G_KX ((bf16*)(args.ws + WS_KX))
#define G_VXT ((bf16*)(args.ws + WS_VXT))
#define G_UB (args.ws + WS_UB)
#define G_VB (args.ws + WS_VB)
#define G_SU ((float*)(args.ws + WS_SU))
#define G_SV ((float*)(args.ws + WS_SV))
#define G_XN ((bf16*)(args.ws + WS_XN))
#define G_QX ((bf16*)(args.ws + WS_XN))
#define G_PROJ ((bf16*)(args.ws + WS_PROJ))
#define G_SCT ((float*)(args.ws + WS_PROJ))
#define G_AMIX ((bf16*)(args.ws + WS_AMIX))
#define G_OX ((bf16*)(args.ws + WS_AMIX))
#define G_H ((float*)(args.ws + WS_H))
#define G_HB ((bf16*)(args.ws + WS_HB))
#define G_PP ((bf16*)(args.ws + WS_P))
#define G_LF ((float*)(args.ws + WS_LF))
#define G_SS1 ((float*)(args.ws + CTL_SS1))
#define G_SS2 ((float*)(args.ws + CTL_SS2))

    for (int u = tid; u < (LDS_BYTES - LDS_MISC) / 4; u += NTHREADS) ((LAS unsigned*)(ldsL + LDS_MISC))[u] = 0u;
    __syncthreads();
    XcdBarrier bar; bar.bar = G_ctl + CW_BAR; bar.x = 0; bar.st = nullptr;
    if (args.one_launch) bar = xcd_barrier_post(G_ctl + CW_BAR, MISC + 8);
    const int lo = args.ph_lo, hi = args.ph_hi;
#ifndef PH_MASK
#define PH_MASK 0xff
#endif
#define IN(k) (((PH_MASK >> (k)) & 1) && lo <= (k) && (k) < hi)
#ifdef PROBE_SEL
#define STAMP(i) do { if (bx == 0 && tid == 0) { const unsigned long long t_ = __builtin_amdgcn_s_memrealtime(); MISC[32 + 2 * (i)] = (unsigned)t_; MISC[33 + 2 * (i)] = (unsigned)(t_ >> 32); } } while (0)
#else
#define STAMP(i) do { } while (0)
#endif
#define SEAM(k) do { if (IN(k) && IN((k) + 1)) xcd_barrier(bar); STAMP((k) + 1); } while (0)
#define TABLE_CHUNK(c_) do { const int r_ = (c_) * 32 + wave * 4; const int tb_ = r_ >> 14, rr_ = r_ & (PEXP - 1); \
        conv_rows_fp6<4>((tb_ ? G_peer_v : G_peer_u) + (size_t)rr_ * DM, (tb_ ? G_VB : G_UB) + (size_t)rr_ * 1536, (tb_ ? G_SV : G_SU) + rr_, lane); } while (0)
    STAMP(0);
#if defined(PROBE_SEL) && PROBE_SEL >= 7
    if (bx == 0 && tid == 0) __hip_atomic_store((unsigned long long*)(G_ctl + 256), (unsigned long long)__builtin_amdgcn_s_memrealtime(), __ATOMIC_RELAXED, __HIP_MEMORY_SCOPE_AGENT);
#endif
    const int gw = vcu * NWAVES + wave, NGW = G * NWAVES;
    const int gt = vcu * NTHREADS + tid, NGT = G * NTHREADS;

    if (IN(0)) for (int rep_ = 0; rep_ < (((DUP_MASK >> 0) & 1) ? args.pad + 1 : 1); ++rep_) {
        LAS float* wf = (LAS float*)ldsL;
        LAS float* scr = (LAS float*)(ldsL + 65536 + wave * 8704);
#pragma unroll
        for (int i = 0; i < DM / NTHREADS; ++i) { const int d = tid + i * NTHREADS; const f32x4 a = *(const GAS f32x4*)(G_w_in + (size_t)d * INC + 4096), b = *(const GAS f32x4*)(G_w_in + (size_t)d * INC + 4100);
            wf[d] = a[0]; wf[DM + d] = a[1]; wf[2 * DM + d] = a[2]; wf[3 * DM + d] = a[3]; wf[4 * DM + d] = b[0]; wf[5 * DM + d] = b[1]; wf[6 * DM + d] = b[2]; wf[7 * DM + d] = b[3]; }
        __syncthreads();
        f32x4 vnx[8];
        if (gw < TOK) {
#pragma unroll
            for (int j = 0; j < 8; ++j) vnx[j] = ((const GAS f32x4*)(G_x + (size_t)gw * DM) + lane)[64 * j]; }
        for (int m = gw; m < TOK; m += NGW) {
            const GAS f32x4* gr = (const GAS f32x4*)G_mix_norm + lane;
            f32x4 v[8]; float s = 0.f;
#pragma unroll
            for (int j = 0; j < 8; ++j) v[j] = vnx[j];
            if (m + NGW < TOK) {
#pragma unroll
                for (int j = 0; j < 8; ++j) vnx[j] = ((const GAS f32x4*)(G_x + (size_t)(m + NGW) * DM) + lane)[64 * j]; }
#pragma unroll
            for (int j = 0; j < 8; ++j) s += (v[j][0] * v[j][0] + v[j][1] * v[j][1]) + (v[j][2] * v[j][2] + v[j][3] * v[j][3]);
            const float rstd = __builtin_amdgcn_rsqf(wave_sum_dpp(s) * (1.f / DM) + EPS);
            GAS v2u* o8 = (GAS v2u*)(G_XN + (size_t)m * DM) + lane;
#pragma unroll
            for (int j = 0; j < 8; ++j) { const f32x4 gg = gr[64 * j]; v[j] = v[j] * rstd * gg;
                v2u o; o.x = pk2(v[j][0], v[j][1]); o.y = pk2(v[j][2], v[j][3]); o8[64 * j] = o; }
            float fl[8];
#pragma unroll
            for (int h = 0; h < 8; ++h) { float a = 0.f;
#pragma unroll
                for (int j = 0; j < 8; ++j) { const f32x4 w = *(const LAS f32x4*)(wf + h * DM + j * 256 + lane * 4); a += (v[j][0] * w[0] + v[j][1] * w[1]) + (v[j][2] * w[2] + v[j][3] * w[3]); }
                fl[h] = wave_sum_dpp(a);
                asm volatile("" ::: "memory"); }
            if (lane < 8) { float f = fl[0];
#pragma unroll
                for (int h = 1; h < 8; ++h) f = (lane == h) ? fl[h] : f;
                f += G_b_forget[lane];
                const float ls = fminf(f, 0.f) - log1pf(expf(-fabsf(f)));
                const int b = m / SEQ, sq = m % SEQ; G_LF[(size_t)(b * FOXH + lane) * SEQ + sq] = ls; }
        }
        for (int m = gw; m < BATCH * NMEM; m += NGW) {
            const GAS f32x4* xr = (const GAS f32x4*)(G_mem + (size_t)m * DM) + lane; const GAS f32x4* gr = (const GAS f32x4*)G_mem_norm + lane;
            f32x4 v[8]; float s = 0.f;
#pragma unroll
            for (int j = 0; j < 8; ++j) { v[j] = xr[64 * j]; s += (v[j][0] * v[j][0] + v[j][1] * v[j][1]) + (v[j][2] * v[j][2] + v[j][3] * v[j][3]); }
            const float rstd = __builtin_amdgcn_rsqf(wave_sum_dpp(s) * (1.f / DM) + EPS);
            GAS v2u* o8 = (GAS v2u*)(G_MN + (size_t)m * DM) + lane;
#pragma unroll
            for (int j = 0; j < 8; ++j) { const f32x4 gg = gr[64 * j]; v[j] = v[j] * rstd * gg; v2u o; o.x = pk2(v[j][0], v[j][1]); o.y = pk2(v[j][2], v[j][3]); o8[64 * j] = o; }
        }
        {
            constexpr int I_IN = (DM / 64) * (4096 / 32), I_SQ = (DM / 64) * (DM / 32);
            constexpr int NITEMS = I_IN + 3 * I_SQ;
#define TR_SRC(it_, W_, ldw_, nblk_, r_) do { r_ = (it_); if (r_ < I_IN) { W_ = G_w_in; ldw_ = INC; nblk_ = 4096 / 32; } else { r_ -= I_IN; ldw_ = DM; nblk_ = DM / 32; \
        if (r_ < I_SQ) W_ = G_w_out; else if (r_ < 2 * I_SQ) { W_ = G_xwk; r_ -= I_SQ; } else { W_ = G_xwv; r_ -= 2 * I_SQ; } } } while (0)
            f32x4 tvn[8]; const float* Wn; int ldwn, nblkn, rn;
            if (gw < NITEMS) { TR_SRC(gw, Wn, ldwn, nblkn, rn); tr_load(Wn, ldwn, nblkn, rn, lane, tvn); }
            for (int it = gw; it < NITEMS; it += NGW) {
                f32x4 tvc[8];
#pragma unroll
                for (int i = 0; i < 8; ++i) tvc[i] = tvn[i];
                const int nblkc = nblkn, rc = rn;
                if (it + NGW < NITEMS) { TR_SRC(it + NGW, Wn, ldwn, nblkn, rn); tr_load(Wn, ldwn, nblkn, rn, lane, tvn); }
                int r = it;
                if (r < I_IN) { tr_store(tvc, nblkc, G_W_IN, nullptr, 0, DM, scr, rc, lane); continue; } r -= I_IN;
                if (r < I_SQ) { tr_store(tvc, nblkc, G_WO1, G_WO2, POOLW, DM, scr, rc, lane); continue; } r -= I_SQ;
                if (r < I_SQ) { tr_store(tvc, nblkc, G_WK, nullptr, 0, DM, scr, rc, lane); continue; }
                tr_store(tvc, nblkc, G_WV, nullptr, 0, DM, scr, rc, lane);
            }
#undef TR_SRC
        }
        for (int i0 = gt; i0 < DM * DM / 8; i0 += 2 * NGT) {
#pragma unroll
            for (int u = 0; u < 2; ++u) { const int i = i0 + u * NGT; if (i < DM * DM / 8) {
                const int d = i / (DM / 8);
                const v4u o1 = cvt8(G_peer_wq + (size_t)i * 8, G_peer_norm[d]);
                const v4u o2 = cvt8(G_xwq + (size_t)i * 8, G_xattn_norm[d]);
                *(GAS v4u*)(G_WPQ + (size_t)i * 8) = o1; *(GAS v4u*)(G_WQ + (size_t)i * 8) = o2; } }
        }
        for (int i = gt; i < DM * 256 / 8; i += NGT) {
            const int r = i >> 5, c0 = (i & 31) * 8; const int hc = r >> 7;
            v4u o3 = {0u, 0u, 0u, 0u}; if ((c0 >> 7) == (hc & 1)) o3 = cvt8(G_sub_keys + (size_t)r * 128 + (c0 & 127), 1.f);
            *(GAS v4u*)(G_AEXP + (size_t)i * 8) = o3; }
        for (int i = gt; i < 4 * 256 * 256 / 8; i += NGT) {
            const int g = i / (256 * 256 / 8), d0 = (i % 32) * 8; const float* ps = G_pool_scale + g * 256 + d0; const float* p = G_pool_w + (size_t)i * 8;
            v4u o; o.x = pk2(p[0] * ps[0], p[1] * ps[1]); o.y = pk2(p[2] * ps[2], p[3] * ps[3]); o.z = pk2(p[4] * ps[4], p[5] * ps[5]); o.w = pk2(p[6] * ps[6], p[7] * ps[7]);
            *(GAS v4u*)(G_PB + (size_t)i * 8) = o; }
        __syncthreads();
    }
    SEAM(0);

    if (IN(1)) for (int rep_ = 0; rep_ < (((DUP_MASK >> 1) & 1) ? args.pad + 1 : 1); ++rep_) {
        pg8::Gemm g{G_XN, G_W_IN, DM, DM, DM}; pg8::GSched S; S.init(TOK / 256, 4096 / 256, G, bx, DM, DM);
        pg8::EpiStoreT<true> E{G_PROJ, 4096, 0, 0, 1, nullptr, 1.f, 4, 8, 0.08838834764831845f * LOG2E, (unsigned*)G_ctl + CW_NRM};
        pg8::gemm_phase<pg8::EpiStoreT<true>, pg8::GSched, true>(ldsL, g, S, E);
    }
    SEAM(1);

    if (IN(2)) for (int rep_ = 0; rep_ < (((DUP_MASK >> 2) & 1) ? args.pad + 1 : 1); ++rep_) {
        for (int it = vcu; it < TOK / 32; it += G) {
            const int ch = (tid & 127) * 8, rsub = tid >> 7, r0 = it * 32 + rsub * 8, w = 2 << (ch >> 8);
            const int s0 = r0 % SEQ;
            float acc[8];
#pragma unroll
            for (int e = 0; e < 8; ++e) acc[e] = 0.f;
            for (int k = 1; k < w; ++k) { if (s0 - k >= 0) { const v4u v = *(const GAS v4u*)(G_PROJ + (size_t)(r0 - k) * 4096 + ch);
#pragma unroll
                    for (int e = 0; e < 4; ++e) { acc[2 * e] += __uint_as_float(v[e] << 16); acc[2 * e + 1] += __uint_as_float(v[e] & 0xffff0000u); } } }
            for (int rr = 0; rr < 8; ++rr) {
                const v4u v = *(const GAS v4u*)(G_PROJ + (size_t)(r0 + rr) * 4096 + ch); float cur[8];
#pragma unroll
                for (int e = 0; e < 4; ++e) { cur[2 * e] = __uint_as_float(v[e] << 16); cur[2 * e + 1] = __uint_as_float(v[e] & 0xffff0000u); }
                const int sp = s0 + rr; const float inv = 1.f / (float)((sp + 1 < w) ? sp + 1 : w);
                v4u o;
#pragma unroll
                for (int e = 0; e < 8; ++e) acc[e] += cur[e];
                o.x = pk2(acc[0] * inv - cur[0], acc[1] * inv - cur[1]); o.y = pk2(acc[2] * inv - cur[2], acc[3] * inv - cur[3]);
                o.z = pk2(acc[4] * inv - cur[4], acc[5] * inv - cur[5]); o.w = pk2(acc[6] * inv - cur[6], acc[7] * inv - cur[7]);
                *(GAS v4u*)(G_AMIX + (size_t)(r0 + rr) * DM + ch) = o;
                if (sp - w + 1 >= 0) { const v4u vo = *(const GAS v4u*)(G_PROJ + (size_t)(r0 + rr - w + 1) * 4096 + ch);
#pragma unroll
                    for (int e = 0; e < 4; ++e) { acc[2 * e] -= __uint_as_float(vo[e] << 16); acc[2 * e + 1] -= __uint_as_float(vo[e] & 0xffff0000u); } }
            }
        }
        const int a_bh = vcu >> 4, a_qb = vcu & 15;
        if (a_qb < 8 && vcu < 256) {
            const int e = a_qb < 2 ? a_bh * 2 + a_qb : 32 + a_bh * 6 + (a_qb - 2);
            pg8::Gemm g; pg8::EpiStore E{nullptr, DM, 0, 0, 1, nullptr, 1.f, 0, 0, 1.f, nullptr};
            int pm, pn;
            if (e < 16)      { pm = e >> 3; pn = e & 7; g = pg8::Gemm{G_MN, G_WK, DM, DM, DM}; E.O = G_KX; E.ldc = DM; }
            else if (e < 32) { const int q = e - 16; pm = q >> 3; pn = q & 7; g = pg8::Gemm{G_MN, G_WV, DM, DM, DM}; E.O = G_VXT; E.ldc = DM; }
            else if (e < 96) { const int q = e - 32; pm = q >> 3; pn = q & 7; g = pg8::Gemm{G_AEXP, G_WPQ + pm * 256, 256, 256, DM}; E.O = G_WSC; E.ldc = DM; }
            else             { const int q = e - 96; const int gg = q >> 3; pm = q & 7; pn = 0;
                               g = pg8::Gemm{G_WO1 + gg * 256, G_PB + (size_t)gg * 65536, 256, DM, 256}; E.O = G_WO2 + gg * 256; E.ldc = DM; }
            const pg8::OneSched S1{pm, pn, (long)pm * 256 * g.lda, (long)pn * 256 * g.ldb};
            pg8::gemm_phase<pg8::EpiStore, pg8::OneSched, false>(ldsL, g, S1, E);
        }
        if (vcu < 256) {
            const int b = a_bh >> 3, h = a_bh & 7;
            float* c_lds = (float*)(lds + fox::LDS_C);
            if (wave == 0) {
                const float* lf = G_LF + (size_t)a_bh * SEQ + lane * 64; float loc[64]; float run = 0.f;
#pragma unroll
                for (int i = 0; i < 16; ++i) { const f32x4 v = *(const f32x4*)(lf + 4 * i);
#pragma unroll
                    for (int e = 0; e < 4; ++e) { run += v[e]; loc[4 * i + e] = run; } }
                float incl = run;
#pragma unroll
                for (int o = 1; o < 64; o <<= 1) { const float t = __shfl_up(incl, o); if (lane >= o) incl += t; }
                const float excl = incl - run;
#pragma unroll
                for (int i = 0; i < 16; ++i) { f32x4 v;
#pragma unroll
                    for (int e = 0; e < 4; ++e) v[e] = (loc[4 * i + e] + excl) * LOG2E;
                    *(f32x4*)(c_lds + lane * 64 + 4 * i) = v; }
            }
            __syncthreads();
            const bf16* Qb = G_PROJ + (size_t)(b * SEQ) * 4096 + 1024 + h * 128;
            fox::BlockRef cur{Qb + (size_t)(a_qb * 256) * 4096, Qb + 1024, Qb + 2048, G_AMIX + (size_t)(b * SEQ + a_qb * 256) * DM + 1024 + h * 128, a_qb * 256};
            int j_lo = 0;
            { const unsigned* nq = (const unsigned*)G_ctl + CW_NRM + (b * 8 + h) * 4; const unsigned* nk = nq + 64; float B = 0.f;
#pragma unroll
              for (int c4 = 0; c4 < 4; ++c4) B += sqrtf(__uint_as_float(__hip_atomic_load(nq + c4, __ATOMIC_RELAXED, __HIP_MEMORY_SCOPE_AGENT)) * __uint_as_float(__hip_atomic_load(nk + c4, __ATOMIC_RELAXED, __HIP_MEMORY_SCOPE_AGENT)));
              const float thr = 2.05f * B + c_lds[a_qb * 256] + 150.f;
              while (j_lo < a_qb * 4 && c_lds[64 * j_lo + 63] > thr) ++j_lo; }
            fox::Seam S;
            fox::prime(cur, j_lo, (char*)lds, S);
            fox::block(cur, cur, j_lo, (char*)lds, S);
            asm volatile("s_waitcnt vmcnt(0)" ::: "memory");
            __syncthreads();
        }
        {
            constexpr int C_T = (DM / 64) * (DM / 32) / 8, NCHUNK = C_T + QSPLIT;
            LAS float* scr = (LAS float*)(ldsL + wave * 8704);
            __syncthreads();
            if (tid == 0) MISC[16] = atomicAdd(G_ctl + CW_QUEUE, 1u);
            for (int par = 0;; par ^= 1) {
                __syncthreads();
                const int c = (int)MISC[16 + par];
                if (c >= NCHUNK) break;
                unsigned nxt_ = 0u; if (tid == 0) nxt_ = atomicAdd(G_ctl + CW_QUEUE, 1u);
                if (c < C_T) { p0_transpose_item(G_xwo, DM, DM / 32, nullptr, G_WO, nullptr, 0, DM, scr, c * 8 + wave, lane); }
                else { TABLE_CHUNK(c - C_T); }
                if (tid == 0) MISC[17 - par] = nxt_;
            }
        }
    }
    SEAM(2);

    if (IN(3)) for (int rep_ = 0; rep_ < (((DUP_MASK >> 3) & 1) ? args.pad + 1 : 1); ++rep_) {
        { pg8::Gemm g{G_AMIX, G_WO2, DM, DM, DM}; pg8::GSched S; S.init(TOK / 256, DM / 256, G, bx, DM, DM);
          pg8::EpiResid<false> E{G_x, G_HB, rep_ ? nullptr : G_SS1, 0};
          pg8::gemm_phase<pg8::EpiResid<false>, pg8::GSched, true>(ldsL, g, S, E); }
        if (bx < 64) {
            const int f = bx & 63, b = f >> 5, h = (f >> 3) & 3, t = f & 7;
            pg8::Gemm g{G_KX + (size_t)(b * NMEM) * DM + h * XD, G_WQ + h * XD, XD, DM, DM};
            pg8::EpiStore E{G_W1 + (size_t)(b * 1024 + h * 256) * DM, DM, 0, 0, 1, nullptr, 1.f, 0, 0, 1.f, nullptr};
            const pg8::OneSched S1{0, t, 0, (long)t * 256 * DM};
            pg8::gemm_phase<pg8::EpiStore, pg8::OneSched, false>(ldsL, g, S1, E);
        }
    }
    SEAM(3);

    if (IN(4)) for (int rep_ = 0; rep_ < (((DUP_MASK >> 4) & 1) ? args.pad + 1 : 1); ++rep_) {
        pg8::Gemm g{G_HB, G_W1, DM, DM, DM}; pg8::GSched S; S.init(SEQ / 256, XH, G, bx, DM, DM);
        S.nH = 1; S.nZ = BATCH; S.sAb = (long)SEQ * DM; S.sBb = (long)1024 * DM;
        pg8::EpiSoftmax E{G_PP, 1024, (long)SEQ * 1024, 0, 1, G_SS1, 0.044194173824159216f * LOG2E, SEQ};
        pg8::gemm_phase<pg8::EpiSoftmax, pg8::GSched, false>(ldsL, g, S, E);
        if (bx >= 128 && bx < 192) {
            const int f = bx & 63, b = f >> 5, h = (f >> 3) & 3, t = f & 7;
            pg8::Gemm g2{G_WO + h * XD, G_VXT + (size_t)(b * NMEM) * DM + h * XD, XD, DM, DM};
            pg8::EpiStore E2{G_W2 + (size_t)b * DM * 1024 + h * 256, 1024, 0, 0, 1, nullptr, 1.f, 0, 0, 1.f, nullptr};
            const pg8::OneSched S2{t, 0, (long)t * 256 * DM, 0};
            pg8::gemm_phase<pg8::EpiStore, pg8::OneSched, false>(ldsL, g2, S2, E2);
        }
        for (;;) {
            __syncthreads();
            if (tid == 0) MISC[16] = atomicAdd(G_ctl + CW_QUEUE2, 1u);
            __syncthreads();
            const int c = (int)MISC[16] + QSPLIT;
            if (c >= 2 * PEXP / 32) break;
            TABLE_CHUNK(c);
        }
    }
    SEAM(4);

    if (IN(5)) for (int rep_ = 0; rep_ < (((DUP_MASK >> 5) & 1) ? args.pad + 1 : 1); ++rep_) {
        pg8::Gemm g{G_PP, G_W2, 1024, 1024, 1024}; pg8::GSched S; S.init(SEQ / 256, DM / 256, G, bx, 1024, 1024);
        S.nH = 1; S.nZ = BATCH; S.sAb = (long)SEQ * 1024; S.sBb = (long)DM * 1024;
        pg8::EpiResid<true> E{G_HB, G_HB, G_SS2, SEQ};
        pg8::gemm_phase<pg8::EpiResid<true>, pg8::GSched, true>(ldsL, g, S, E);
    }
    SEAM(5);

    if (IN(6)) for (int rep_ = 0; rep_ < (((DUP_MASK >> 6) & 1) ? args.pad + 1 : 1); ++rep_) {
        pg8::Gemm g{G_WSC, G_HB, DM, DM, DM}; pg8::GSched S; S.init(DM / 256, TOK / 256, G, bx, DM, DM);
        pg8::EpiF32Col E{G_SCT, TOK, G_SS2};
        pg8::gemm_phase<pg8::EpiF32Col, pg8::GSched, true>(ldsL, g, S, E);
    }
    SEAM(6);

#if defined(PROBE_SEL) && PROBE_SEL >= 7
    if (bx == 0 && tid == 0) __hip_atomic_store((unsigned long long*)(G_ctl + 258), (unsigned long long)__builtin_amdgcn_s_memrealtime(), __ATOMIC_RELAXED, __HIP_MEMORY_SCOPE_AGENT);
#endif
    if (IN(7)) for (int rep_ = 0; rep_ < (((DUP_MASK >> 7) & 1) ? args.pad + 1 : 1); ++rep_) {
        LAS unsigned* TOP1 = (LAS unsigned*)ldsL;
        LAS unsigned* RIDX = (LAS unsigned*)(ldsL + 32768);
        LAS float* RGATE = (LAS float*)(ldsL + 49152);
        for (int blk = vcu; blk < TOK / 32; blk += G) {
            const int t0 = blk * 32;
            {
                const int tok = tid & 31, grp = tid >> 5;
                const float* sp = G_SCT + ((size_t)blk * DM + grp * 128) * 32 + tok;
                unsigned lst[16];
#pragma unroll
                for (int j = 0; j < 16; ++j) lst[j] = 0u;
                for (int i0 = 0; i0 < 128; i0 += 32) {
                    float v[32];
#pragma unroll
                    for (int e = 0; e < 32; ++e) v[e] = sp[(i0 + e) * 32];
#pragma unroll
                    for (int c16 = 0; c16 < 2; ++c16) { unsigned nw[16];
#pragma unroll
                        for (int e = 0; e < 16; ++e) nw[e] = (fkey(v[c16 * 16 + e]) & ~127u) | (unsigned)(127 - (i0 + c16 * 16 + e));
#pragma unroll
                        for (int k = 2; k <= 16; k <<= 1)
#pragma unroll
                            for (int j = k >> 1; j > 0; j >>= 1)
#pragma unroll
                                for (int i = 0; i < 16; ++i) { const int l = i ^ j; if (l > i) { const unsigned lo_ = min(nw[i], nw[l]), hi_ = max(nw[i], nw[l]); if ((i & k) == 0) { nw[i] = lo_; nw[l] = hi_; } else { nw[i] = hi_; nw[l] = lo_; } } }
#pragma unroll
                        for (int i = 0; i < 16; ++i) lst[i] = max(lst[i], nw[i]);
#pragma unroll
                        for (int j = 8; j > 0; j >>= 1)
#pragma unroll
                            for (int i = 0; i < 16; ++i) { const int l = i ^ j; if (l > i) { const unsigned lo_ = min(lst[i], lst[l]), hi_ = max(lst[i], lst[l]); lst[i] = hi_; lst[l] = lo_; } } }
                }
                LAS unsigned* dst = TOP1 + (tok * 16 + grp) * 16;
#pragma unroll
                for (int j = 0; j < 16; j += 4) *(LAS v4u*)(dst + j) = (v4u){lst[j], lst[j + 1], lst[j + 2], lst[j + 3]};
            }
            __syncthreads();
            if (tid < 256) {
                const int tok = tid & 31, head = tid >> 5;
                const LAS unsigned* ka = TOP1 + (tok * 16 + head * 2) * 16; const LAS unsigned* kb = ka + 16;
                float af[16], bfv[16];
#pragma unroll
                for (int j = 0; j < 16; ++j) { af[j] = fdec(ka[j] & ~127u); bfv[j] = fdec(kb[j] & ~127u); }
                unsigned best[16];
#pragma unroll
                for (int j = 0; j < 16; ++j) best[j] = 0u;
#pragma unroll
                for (int i = 0; i < 16; ++i)
#pragma unroll
                    for (int j = 0; j < 16; ++j) if ((i + 1) * (j + 1) <= 16) {
                        unsigned xk = (fkey(af[i] + bfv[j]) & ~255u) | (unsigned)(255 - (i * 16 + j));
#pragma unroll
                        for (int q = 0; q < 16; ++q) { const unsigned hi_ = max(best[q], xk); xk = min(best[q], xk); best[q] = hi_; } }
                float ev[16]; const float m0 = fdec(best[0] & ~255u); float sum = 0.f;
#pragma unroll
                for (int q = 0; q < 16; ++q) { ev[q] = __expf(fdec(best[q] & ~255u) - m0); sum += ev[q]; }
                const float inv = 1.f / sum;
#pragma unroll
                for (int q = 0; q < 16; ++q) { const unsigned code = 255u - (best[q] & 255u); const unsigned i = code >> 4, j = code & 15u;
                    const unsigned ia = 127u - (ka[i] & 127u), ib = 127u - (kb[j] & 127u);
                    RIDX[tok * 128 + head * 16 + q] = ia * 128u + ib; RGATE[tok * 128 + head * 16 + q] = ev[q] * inv; }
            }
            __syncthreads();
            {
                LAS unsigned* SIDX = (LAS unsigned*)ldsL; LAS unsigned* SGATE = (LAS unsigned*)(ldsL + 16384);
                const int tok = tid >> 4; const LAS unsigned* src = RIDX + tok * 128;
                unsigned mine[8]; unsigned rank[8];
#pragma unroll
                for (int i = 0; i < 8; ++i) { mine[i] = (src[(tid & 15) + 16 * i] << 7) | (unsigned)((tid & 15) + 16 * i); rank[i] = 0u; }
                for (int j0 = 0; j0 < 128; j0 += 4) { const v4u o4 = *(const LAS v4u*)(src + j0);
#pragma unroll
                    for (int jj = 0; jj < 4; ++jj) { const unsigned oj = ((jj == 0 ? o4.x : jj == 1 ? o4.y : jj == 2 ? o4.z : o4.w) << 7) | (unsigned)(j0 + jj);
#pragma unroll
                        for (int i = 0; i < 8; ++i) rank[i] += (oj < mine[i]) ? 1u : 0u; } }
#pragma unroll
                for (int i = 0; i < 8; ++i) mine[i] >>= 7;
#pragma unroll
                for (int i = 0; i < 8; ++i) { const unsigned pos = rank[i];
                    SIDX[tok * 128 + pos] = mine[i];
                    const float su_ = G_SU[mine[i]], gs_ = RGATE[tok * 128 + (tid & 15) + 16 * i] * G_SV[mine[i]];
                    SGATE[tok * 128 + pos] = (__float_as_uint(su_) & 0xffff0000u) | f2bf(gs_); }
            }
            __syncthreads();
            {
                const int tok0 = wave * 4; const size_t tg0 = (size_t)(t0 + tok0);
                LAS float* Wl = (LAS float*)(ldsL + 32768) + tok0 * 128;
                unsigned xn0[16], xn1[16], xn2[16], xn3[16];
#define XNLOAD(T_, XN) do { const float rs = __builtin_amdgcn_rsqf(G_SS2[tg0 + (T_)] * (1.f / DM) + EPS); \
        _Pragma("unroll") for (int q = 0; q < 8; ++q) { const size_t d0 = (size_t)q * 256 + lane * 4; \
            const v2u ha = *(const GAS v2u*)(G_HB + (tg0 + (T_)) * DM + d0); const f32x4 ga = *(const f32x4*)(G_peer_norm + d0); \
            XN[q * 2] = pk2(__uint_as_float(ha.x << 16) * rs * ga[0], __uint_as_float(ha.x & 0xffff0000u) * rs * ga[1]); XN[q * 2 + 1] = pk2(__uint_as_float(ha.y << 16) * rs * ga[2], __uint_as_float(ha.y & 0xffff0000u) * rs * ga[3]); } } while (0)
                XNLOAD(0, xn0); XNLOAD(1, xn1); XNLOAD(2, xn2); XNLOAD(3, xn3);
#undef XNLOAD
                const LAS unsigned* ridx0 = (const LAS unsigned*)ldsL + tok0 * 128; const LAS unsigned* rgs0 = (const LAS unsigned*)(ldsL + 16384) + tok0 * 128;
                const __amdgpu_buffer_rsrc_t rsT = __builtin_amdgcn_make_buffer_rsrc((void*)G_UB, 0, 64 << 20, 0x00020000);
                v4u raX0, raX1, raX2, raX3, raY0, raY1, raY2, raY3; v2u rbX0, rbX1, rbX2, rbX3, rbY0, rbY1, rbY2, rbY3;
                unsigned sgX0, sgX1, sgX2, sgX3, sgY0, sgY1, sgY2, sgY3;
#define PLDU(S, T, k) do { const unsigned ex_ = (unsigned)__builtin_amdgcn_readfirstlane((int)ridx0[(T) * 128 + (k)]); sg##S = rgs0[(T) * 128 + (k)]; \
        ra##S = __builtin_bit_cast(v4u, __builtin_amdgcn_raw_buffer_load_b128(rsT, lane * 16, ex_ * 1536u, 0)); rb##S = __builtin_bit_cast(v2u, __builtin_amdgcn_raw_buffer_load_b64(rsT, lane * 8 + 1024, ex_ * 1536u, 0)); } while (0)
                const int rowl = lane >> 4; const int wl_off = (rowl == 0 ? 0 : rowl == 1 ? 256 : rowl == 2 ? 128 : 384);
#define STEP1(C, P, k, HASNEXT) do { \
        const float d0_ = peer_dot(ra##C##0, rb##C##0, xn0), d1_ = peer_dot(ra##C##1, rb##C##1, xn1), d2_ = peer_dot(ra##C##2, rb##C##2, xn2), d3_ = peer_dot(ra##C##3, rb##C##3, xn3); \
        const unsigned sgr_ = rowl == 0 ? sg##C##0 : rowl == 1 ? sg##C##2 : rowl == 2 ? sg##C##1 : sg##C##3; \
        if (HASNEXT) { PLDU(P##0, 0, (k) + 1); PLDU(P##1, 1, (k) + 1); PLDU(P##2, 2, (k) + 1); PLDU(P##3, 3, (k) + 1); } \
        const auto s01_ = __builtin_amdgcn_permlane32_swap(__float_as_uint(d0_), __float_as_uint(d1_), false, false); const auto s23_ = __builtin_amdgcn_permlane32_swap(__float_as_uint(d2_), __float_as_uint(d3_), false, false); \
        const float p_ = __uint_as_float(s01_[0]) + __uint_as_float(s01_[1]), q_ = __uint_as_float(s23_[0]) + __uint_as_float(s23_[1]); \
        const auto spq_ = __builtin_amdgcn_permlane16_swap(__float_as_uint(p_), __float_as_uint(q_), false, false); \
        float r_ = __uint_as_float(spq_[0]) + __uint_as_float(spq_[1]); \
        r_ += __builtin_bit_cast(float, __builtin_amdgcn_update_dpp(0, __builtin_bit_cast(int, r_), 0xB1, 0xf, 0xf, true)); r_ += __builtin_bit_cast(float, __builtin_amdgcn_update_dpp(0, __builtin_bit_cast(int, r_), 0x4E, 0xf, 0xf, true)); \
        r_ += __builtin_bit_cast(float, __builtin_amdgcn_update_dpp(0, __builtin_bit_cast(int, r_), 0x141, 0xf, 0xf, true)); r_ += __builtin_bit_cast(float, __builtin_amdgcn_update_dpp(0, __builtin_bit_cast(int, r_), 0x140, 0xf, 0xf, true)); \
        const float w_ = gelu_f(r_ * __uint_as_float(sgr_ & 0xffff0000u)) * __uint_as_float(sgr_ << 16); \
        if ((lane & 15) == 0) Wl[wl_off + (k)] = w_; } while (0)
                PLDU(X0, 0, 0); PLDU(X1, 1, 0); PLDU(X2, 2, 0); PLDU(X3, 3, 0);
                for (int k = 0; k < 126; k += 2) { STEP1(X, Y, k, true); STEP1(Y, X, k + 1, true); }
                STEP1(X, Y, 126, true); STEP1(Y, X, 127, false);
#undef PLDU
#undef STEP1
#define PLDV(S, T, k) do { const unsigned ex_ = (unsigned)__builtin_amdgcn_readfirstlane((int)ridx0[(T) * 128 + (k)]); \
        ra##S = __builtin_bit_cast(v4u, __builtin_amdgcn_raw_buffer_load_b128(rsT, lane * 16, ex_ * 1536u + (32u << 20), 0)); rb##S = __builtin_bit_cast(v2u, __builtin_amdgcn_raw_buffer_load_b64(rsT, lane * 8 + 1024, ex_ * 1536u + (32u << 20), 0)); } while (0)
#define STEP2(C, N, k, HASNEXT) do { asm volatile("" ::: "memory");     \
        if (HASNEXT) { PLDV(N##0, 0, (k) + 2); PLDV(N##1, 1, (k) + 2); PLDV(N##2, 2, (k) + 2); PLDV(N##3, 3, (k) + 2); } \
        const float w0_ = Wl[(k)], w1_ = Wl[128 + (k)], w2_ = Wl[256 + (k)], w3_ = Wl[384 + (k)]; \
        peer_axpy_h(ra##C##0, rb##C##0, w0_, oh0); peer_axpy_h(ra##C##1, rb##C##1, w1_, oh1); peer_axpy_h(ra##C##2, rb##C##2, w2_, oh2); peer_axpy_h(ra##C##3, rb##C##3, w3_, oh3); } while (0)
                unsigned oh0[16], oh1[16], oh2[16], oh3[16];
                v4u raZ0, raZ1, raZ2, raZ3; v2u rbZ0, rbZ1, rbZ2, rbZ3;
#pragma unroll
                for (int e = 0; e < 16; ++e) { oh0[e] = 0u; oh1[e] = 0u; oh2[e] = 0u; oh3[e] = 0u; }
                PLDV(X0, 0, 0); PLDV(X1, 1, 0); PLDV(X2, 2, 0); PLDV(X3, 3, 0); PLDV(Y0, 0, 1); PLDV(Y1, 1, 1); PLDV(Y2, 2, 1); PLDV(Y3, 3, 1);
#pragma unroll 1
                for (int k = 0; k < 126; k += 3) { STEP2(X, Z, k, true); STEP2(Y, X, k + 1, true); STEP2(Z, Y, k + 2, true); }
                STEP2(X, Z, 126, false); STEP2(Y, X, 127, false);
                for (int tt = 0; tt < 4; tt += 2) {
                    float oaccA[32], oaccB[32];
#pragma unroll
                    for (int e = 0; e < 16; ++e) { const unsigned ua_ = tt ? oh2[e] : oh0[e], ub_ = tt ? oh3[e] : oh1[e];
                        oaccA[2 * e] = h16lo(ua_); oaccA[2 * e + 1] = h16hi(ua_); oaccB[2 * e] = h16lo(ub_); oaccB[2 * e + 1] = h16hi(ub_); }
#define FINISH(T_, OACC) do { float s_ = 0.f; \
        _Pragma("unroll") for (int q = 0; q < 8; ++q) { const size_t d0 = (size_t)q * 256 + lane * 4; const v2u hb = *(const GAS v2u*)(G_HB + (T_) * DM + d0); \
            const f32x4 a = {__uint_as_float(hb.x << 16), __uint_as_float(hb.x & 0xffff0000u), __uint_as_float(hb.y << 16), __uint_as_float(hb.y & 0xffff0000u)}; \
            _Pragma("unroll") for (int e = 0; e < 4; ++e) { const float y = a[e] + OACC[q * 4 + e]; OACC[q * 4 + e] = y; s_ += y * y; } } \
        const float rstd_ = __builtin_amdgcn_rsqf(wave_sum_dpp(s_) * (1.f / DM) + EPS); \
        _Pragma("unroll") for (int q = 0; q < 8; ++q) { const size_t d0 = (size_t)q * 256 + lane * 4; const f32x4 ga = *(const f32x4*)(G_final_norm + d0); f32x4 o; \
            _Pragma("unroll") for (int e = 0; e < 4; ++e) o[e] = OACC[q * 4 + e] * rstd_ * ga[e]; \
            PROBE_EXPORT(T_, q); \
            *(f32x4*)(args.out + (T_) * DM + d0) = o; } } while (0)
                    FINISH(tg0 + tt, oaccA); FINISH(tg0 + tt + 1, oaccB);
                }
#undef FINISH
#undef PLDV
#undef STEP2
            }
            __syncthreads();
#if defined(PROBE_SEL) && PROBE_SEL >= 7
            asm volatile("s_waitcnt vmcnt(0)" ::: "memory"); __syncthreads();
            if (tid == 0) { __threadfence(); const unsigned old_ = atomicAdd(G_ctl + 192, 1u);
                if (old_ == (unsigned)G - 1u) { __threadfence(); const unsigned long long a_ = __hip_atomic_load((unsigned long long*)(G_ctl + 256 + 2 * (PROBE_SEL - 7)), __ATOMIC_RELAXED, __HIP_MEMORY_SCOPE_AGENT), b_ = __builtin_amdgcn_s_memrealtime();
                    atomicAdd(args.out + (size_t)31 * DM, (float)(b_ - a_) * 0.0001f); } }
#endif
        }
    }
#undef IN
#undef SEAM
#undef G_ws
#undef G_ctl
#undef G_x
#undef G_mem
#undef G_mix_norm
#undef G_w_in
#undef G_b_forget
#undef G_pool_w
#undef G_pool_scale
#undef G_w_out
#undef G_xattn_norm
#undef G_mem_norm
#undef G_xwq
#undef G_xwk
#undef G_xwv
#undef G_xwo
#undef G_peer_norm
#undef G_peer_wq
#undef G_sub_keys
#undef G_peer_u
#undef G_peer_v
#undef G_final_norm
#undef G_W_IN
#undef G_WO1
#undef G_WO2
#undef G_WQ
#undef G_WK
#undef G_WV
#undef G_WO
#undef G_WPQ
#undef G_AEXP
#undef G_W1
#undef G_W2
#undef G_WSC
#undef G_PB
#undef G_MN
#undef G_KX
#undef G_VXT
#undef G_UB
#undef G_VB
#undef G_SU
#undef G_SV
#undef G_XN
#undef G_QX
#undef G_PROJ
#undef G_SCT
#undef G_AMIX
#undef G_OX
#undef G_H
#undef G_HB
#undef G_PP
#undef G_LF
#undef G_SS1
#undef G_SS2

}

constexpr int N_PHASES = 8;
extern "C" void kernel_launch(void* const* d_in, const int* in_sizes, int n_in, void* d_out, int out_size, void* d_ws, size_t ws_size, hipStream_t stream) {
    static int grid = 0;
    if (grid == 0) {
        if (n_in != 20 || in_sizes[0] != TOK * DM || out_size != TOK * DM || ws_size < WS_END) {
            fprintf(stderr, "kernel_launch: unexpected shapes (n_in %d, in0 %d, out %d, ws %zu < %zu)\n", n_in, n_in > 0 ? in_sizes[0] : -1, out_size, ws_size, (size_t)WS_END); grid = -1; return; }
        int dev = 0, cus = 0, per_cu = 0;
        if (hipGetDevice(&dev) != hipSuccess || hipDeviceGetAttribute(&cus, hipDeviceAttributeMultiprocessorCount, dev) != hipSuccess) { grid = -1; return; }
        if (hipFuncSetAttribute((const void*)fwd_kernel, hipFuncAttributeMaxDynamicSharedMemorySize, LDS_BYTES) != hipSuccess) { fprintf(stderr, "kernel_launch: hipFuncSetAttribute failed\n"); grid = -1; return; }
        if (hipOccupancyMaxActiveBlocksPerMultiprocessor(&per_cu, (const void*)fwd_kernel, NTHREADS, LDS_BYTES) != hipSuccess || per_cu < 1) { fprintf(stderr, "kernel_launch: occupancy query says %d\n", per_cu); per_cu = 1; }
        (void)hipGetLastError();
        grid = cus;
        if (grid != 256) fprintf(stderr, "kernel_launch: %d CUs (built for 256)\n", grid);
    }
    if (grid < 0) return;
    (void)hipMemsetAsync((char*)d_ws + WS_CTL, 0, CTL_ZERO_BYTES, stream);
    Args a{};
    for (int i = 0; i < 20; ++i) a.in[i] = (const float*)d_in[i];
    a.out = (float*)d_out; a.ws = (unsigned char*)d_ws; a.pad = DUP_MASK ? 1 : 0;
#if MK_ONE_LAUNCH
    a.ph_lo = 0; a.ph_hi = N_PHASES; a.one_launch = 1;
    void* kargs[] = {&a};
    hipError_t e = hipLaunchCooperativeKernel((const void*)fwd_kernel, dim3(grid), dim3(NTHREADS), kargs, LDS_BYTES, stream);
    if (e != hipSuccess) fprintf(stderr, "kernel_launch: cooperative launch failed: %s\n", hipGetErrorString(e));
#else
    for (int p = 0; p < N_PHASES; ++p) {
        a.ph_lo = p; a.ph_hi = p + 1; a.one_launch = 0;
        hipLaunchKernelGGL(fwd_kernel, dim3(grid), dim3(NTHREADS), LDS_BYTES, stream, a);
    }
#endif
}
```

```cpp
#include <hip/hip_runtime.h>
#include <hip/hip_bf16.h>
#include <cstdio>
#include <cstdint>

#ifndef DUP_MASK
#define DUP_MASK 0
#endif
#ifndef MK_ONE_LAUNCH
#define MK_ONE_LAUNCH 1
#endif

constexpr int BATCH = 2, SEQ = 4096, DM = 2048, TOK = BATCH * SEQ;
constexpr int INC = 4104, POOLW = 1024, FOXH = 8, FOXD = 128;
constexpr int NMEM = 256, XH = 4, XD = 512;
constexpr int PH = 8, PKEYS = 128, PEXP = 16384, TOPK = 16;
constexpr float EPS = 1e-6f;
constexpr float LOG2E = 1.4426950408889634f;

namespace pg8 {
#define PG8_LAS __attribute__((address_space(3)))
typedef unsigned short bf16_t;
typedef short bf16x8 __attribute__((ext_vector_type(8)));
typedef float f32x4 __attribute__((ext_vector_type(4)));
typedef float f32x2 __attribute__((ext_vector_type(2)));
typedef unsigned u32x4 __attribute__((ext_vector_type(4)));
typedef unsigned u32x2 __attribute__((ext_vector_type(2)));
constexpr int BM = 256, BK = 64, HALF = 128, HTB = HALF * BK * 2, STAGE_BYTES = 8 * HTB, NXCD = 8, WGM = 8;

__host__ __device__ __forceinline__ int lds_byte(int r, int c) { const int st = (r >> 4) * 2 + (c >> 5), rr = r & 15, cc = c & 31, ob = rr * 64 + cc * 2; return st * 1024 + (ob ^ (((ob >> 9) & 1) << 5)); }
__host__ __device__ __forceinline__ void stage_rc(int b, int& R, int& C) { const int st = b / 1024, sb = b % 1024, swz = sb ^ (((sb >> 9) & 1) << 5); R = (st >> 1) * 16 + swz / 64; C = (st & 1) * 32 + (swz % 64) / 2; }
__host__ __device__ __forceinline__ int perm32(int rho) { const int n = rho >> 4, i = rho & 15; return 8 * (i >> 2) + 4 * n + (i & 3); }

struct Unit { int pm, pn, z; long aoff, boff; };
struct Gemm { const bf16_t* A; const bf16_t* Bt; int K, lda, ldb; };

struct GSched {
    int nM, nN, nH, nZ, G, c; long sAb, sAh, sBb, sBh; int lda, ldb;
    __device__ __forceinline__ void init(int nM_, int nN_, int G_, int c_, int lda_, int ldb_) { nM = nM_; nN = nN_; nH = 1; nZ = 1; G = G_; c = c_; sAb = sAh = sBb = sBh = 0; lda = lda_; ldb = ldb_; }
    __device__ __forceinline__ bool next(int i, Unit& u) const {
        const long L = (long)i * G + c; const int nwg = nM * nN; if (L >= (long)nwg * nZ) return false;
        const int z = (int)(L / nwg); int wgid = (int)(L % nwg);
        { const int q = nwg / NXCD, r = nwg % NXCD, xcd = wgid % NXCD, off = wgid / NXCD; wgid = (xcd < r ? xcd * (q + 1) : r * (q + 1) + (xcd - r) * q) + off; }
        const int nig = WGM * nN, gid = wgid / nig, fm = gid * WGM, gsz = (nM - fm) < WGM ? (nM - fm) : WGM;
        u.pm = fm + ((wgid % nig) % gsz); u.pn = (wgid % nig) / gsz; u.z = z;
        const int zb = z / nH, zh = z % nH;
        u.aoff = zb * sAb + zh * sAh + (long)u.pm * BM * lda; u.boff = zb * sBb + zh * sBh + (long)u.pn * BM * ldb;
        return true;
    }
    __device__ __forceinline__ void a_ready(const Unit&) const {}
    __device__ __forceinline__ void done(const Unit&) const {}
};

struct OneSched { int pm, pn; long ao, bo;
    __device__ __forceinline__ bool next(int i, Unit& u) const { if (i) return false; u.pm = pm; u.pn = pn; u.z = 0; u.aoff = ao; u.boff = bo; return true; }
    __device__ __forceinline__ void a_ready(const Unit&) const {}
    __device__ __forceinline__ void done(const Unit&) const {} };
__device__ __forceinline__ unsigned cvt_pk_bf16(float lo, float hi) { unsigned r; asm volatile("v_cvt_pk_bf16_f32 %0, %1, %2" : "=v"(r) : "v"(lo), "v"(hi)); return r; }


template <bool NRM> struct EpiStoreT {
    static constexpr bool PERM = true, AFTER_DRAIN = false;
    bf16_t* O; int ldc; long sCb, sCh; int nH;
    const float* ss; float rs_mul;
    int t0, t1; float tscale;
    unsigned* nrm;
    __device__ __forceinline__ void operator()(const f32x4 (&acc)[2][2][4][2], const Unit& u, int wr, int wc, int fr, int fq) const {
        const int row0 = u.pm * BM + wr * 64 + fr, col0 = u.pn * BM + wc * 32 + 8 * fq;
        bf16_t* base = O + (u.z / nH) * sCb + (u.z % nH) * sCh;
        const float ts = (u.pn >= t0 && u.pn < t1) ? tscale : 1.f;
        float mx0 = 0.f, mx1 = 0.f;
#pragma unroll
        for (int ai = 0; ai < 2; ++ai)
#pragma unroll
            for (int m = 0; m < 4; ++m) { const int row = row0 + ai * HALF + m * 16;
                float sc = ts; if (ss) sc *= __builtin_amdgcn_rsqf(ss[row] * (1.f / DM) + EPS) * rs_mul;
                bf16_t* rowp = base + (size_t)row * ldc + col0;
#pragma unroll
                for (int bj = 0; bj < 2; ++bj) { const f32x4 v0 = acc[ai][bj][m][0] * sc, v1 = acc[ai][bj][m][1] * sc;
                    u32x4 w; w.x = cvt_pk_bf16(v0[0], v0[1]); w.y = cvt_pk_bf16(v0[2], v0[3]); w.z = cvt_pk_bf16(v1[0], v1[1]); w.w = cvt_pk_bf16(v1[2], v1[3]);
                    *(u32x4*)(rowp + bj * HALF) = w;
                    if constexpr (NRM) { float q = (v0[0] * v0[0] + v0[1] * v0[1]) + (v0[2] * v0[2] + v0[3] * v0[3]) + (v1[0] * v1[0] + v1[1] * v1[1]) + (v1[2] * v1[2] + v1[3] * v1[3]);
                        q += __shfl_xor(q, 16); q += __shfl_xor(q, 32); if (bj == 0) mx0 = fmaxf(mx0, q); else mx1 = fmaxf(mx1, q); } } }
        if constexpr (NRM) { if (u.pn >= 4 && u.pn < 12) {
#pragma unroll
            for (int o = 1; o < 16; o <<= 1) { mx0 = fmaxf(mx0, __shfl_xor(mx0, o)); mx1 = fmaxf(mx1, __shfl_xor(mx1, o)); }
            if ((threadIdx.x & 63) == 0) { const int kind = u.pn >= 8, b = u.pm >> 4, h2 = ((u.pn - 4) & 3) * 2; unsigned* p = nrm + ((kind * 2 + b) * 8 + h2) * 4 + wc;
                atomicMax(p, __float_as_uint(mx0)); atomicMax(p + 4, __float_as_uint(mx1)); } } }
    }
};
typedef EpiStoreT<false> EpiStore;
template <bool BASE_BF16> struct EpiResid {
    static constexpr bool PERM = true, AFTER_DRAIN = false;
    const void* base; bf16_t* HB; float* ss; int zrows;
    __device__ __forceinline__ void operator()(const f32x4 (&acc)[2][2][4][2], const Unit& u, int wr, int wc, int fr, int fq) const {
        const int row0 = u.z * zrows + u.pm * BM + wr * 64 + fr, col0 = u.pn * BM + wc * 32 + 8 * fq;
#pragma unroll
        for (int ai = 0; ai < 2; ++ai)
#pragma unroll
            for (int m = 0; m < 4; ++m) { const int row = row0 + ai * HALF + m * 16; const size_t off = (size_t)row * DM + col0; float sq = 0.f;
#pragma unroll
                for (int bj = 0; bj < 2; ++bj) {
                    f32x4 b0, b1;
                    if constexpr (BASE_BF16) { const u32x4 r = *(const u32x4*)((const bf16_t*)base + off + bj * HALF);
                        b0 = (f32x4){__uint_as_float(r.x << 16), __uint_as_float(r.x & 0xffff0000u), __uint_as_float(r.y << 16), __uint_as_float(r.y & 0xffff0000u)};
                        b1 = (f32x4){__uint_as_float(r.z << 16), __uint_as_float(r.z & 0xffff0000u), __uint_as_float(r.w << 16), __uint_as_float(r.w & 0xffff0000u)}; }
                    else { b0 = __builtin_nontemporal_load((const f32x4*)((const float*)base + off + bj * HALF)); b1 = __builtin_nontemporal_load((const f32x4*)((const float*)base + off + bj * HALF + 4)); }
                    const f32x4 h0 = b0 + acc[ai][bj][m][0], h1 = b1 + acc[ai][bj][m][1];
                    u32x4 w; w.x = cvt_pk_bf16(h0[0], h0[1]); w.y = cvt_pk_bf16(h0[2], h0[3]); w.z = cvt_pk_bf16(h1[0], h1[1]); w.w = cvt_pk_bf16(h1[2], h1[3]);
                    *(u32x4*)(HB + off + bj * HALF) = w;
                    sq += (h0[0] * h0[0] + h0[1] * h0[1]) + (h0[2] * h0[2] + h0[3] * h0[3]) + (h1[0] * h1[0] + h1[1] * h1[1]) + (h1[2] * h1[2] + h1[3] * h1[3]); }
                sq += __shfl_xor(sq, 16); sq += __shfl_xor(sq, 32);
                if (fq == 0 && ss) atomicAdd(ss + row, sq); }
    }
};
struct EpiF32Col {
    static constexpr bool PERM = true, AFTER_DRAIN = false;
    float* O; int ldc; const float* ss;
    __device__ __forceinline__ void operator()(const f32x4 (&acc)[2][2][4][2], const Unit& u, int wr, int wc, int fr, int fq) const {
        const int row0 = u.pm * BM + wr * 64 + fr, col0 = u.pn * BM + wc * 32 + 8 * fq;
        f32x4 rs[2][2];
#pragma unroll
        for (int bj = 0; bj < 2; ++bj)
#pragma unroll
            for (int n = 0; n < 2; ++n) { const f32x4 s = *(const f32x4*)(ss + col0 + bj * HALF + 4 * n);
#pragma unroll
                for (int e = 0; e < 4; ++e) rs[bj][n][e] = __builtin_amdgcn_rsqf(s[e] * (1.f / DM) + EPS); }
#pragma unroll
        for (int ai = 0; ai < 2; ++ai)
#pragma unroll
            for (int m = 0; m < 4; ++m) { const int key = row0 + ai * HALF + m * 16;
#pragma unroll
                for (int bj = 0; bj < 2; ++bj) { const int tk = col0 + bj * HALF; float* p = O + ((size_t)(tk >> 5) * DM + key) * 32 + (tk & 31);
                    *(f32x4*)p = acc[ai][bj][m][0] * rs[bj][0]; *(f32x4*)(p + 4) = acc[ai][bj][m][1] * rs[bj][1]; } }
    }
};
struct EpiSoftmax {
    static constexpr bool PERM = true, AFTER_DRAIN = true;
    bf16_t* P; int ldc; long sCb, sCh; int nH; const float* ss; float mul; int zrows;
    __device__ __forceinline__ void fused(f32x4 (&acc)[2][2][4][2], const Unit& u, int wr, int wc, int fr, int fq, PG8_LAS unsigned char* lds, int wid, int lane) const {
        PG8_LAS float* Pm = (PG8_LAS float*)lds;
        PG8_LAS float* Ps = (PG8_LAS float*)(lds + 4096);
#pragma unroll
        for (int ai = 0; ai < 2; ++ai)
#pragma unroll
            for (int m = 0; m < 4; ++m) { float mx = -3.0e38f;
                const float rs = __builtin_amdgcn_rsqf(ss[u.z * zrows + u.pm * BM + ai * HALF + wr * 64 + m * 16 + fr] * (1.f / DM) + EPS) * mul;
#pragma unroll
                for (int bj = 0; bj < 2; ++bj)
#pragma unroll
                    for (int n = 0; n < 2; ++n) { const f32x4 x = acc[ai][bj][m][n] * rs; acc[ai][bj][m][n] = x; mx = fmaxf(mx, fmaxf(fmaxf(x[0], x[1]), fmaxf(x[2], x[3]))); }
                mx = fmaxf(mx, __shfl_xor(mx, 16)); mx = fmaxf(mx, __shfl_xor(mx, 32));
                if (fq == 0) Pm[(ai * HALF + wr * 64 + m * 16 + fr) * 4 + wc] = mx; }
        asm volatile("s_waitcnt lgkmcnt(0)" ::: "memory"); __builtin_amdgcn_s_barrier(); asm volatile("" ::: "memory");
#pragma unroll
        for (int ai = 0; ai < 2; ++ai)
#pragma unroll
            for (int m = 0; m < 4; ++m) { const int r = ai * HALF + wr * 64 + m * 16 + fr;
                const f32x4 pm4 = *(const PG8_LAS f32x4*)(Pm + r * 4); const float M = fmaxf(fmaxf(pm4[0], pm4[1]), fmaxf(pm4[2], pm4[3])); float s = 0.f;
#pragma unroll
                for (int bj = 0; bj < 2; ++bj)
#pragma unroll
                    for (int n = 0; n < 2; ++n) { f32x4 x = acc[ai][bj][m][n];
#pragma unroll
                        for (int e = 0; e < 4; ++e) { x[e] = __builtin_amdgcn_exp2f(x[e] - M); s += x[e]; }
                        acc[ai][bj][m][n] = x; }
                s += __shfl_xor(s, 16); s += __shfl_xor(s, 32);
                if (fq == 0) Ps[r * 4 + wc] = s; }
        asm volatile("s_waitcnt lgkmcnt(0)" ::: "memory"); __builtin_amdgcn_s_barrier(); asm volatile("" ::: "memory");
        bf16_t* base = P + (u.z / nH) * sCb + (u.z % nH) * sCh;
        const int row0 = u.pm * BM, col0 = u.pn * BM + wc * 32 + 8 * fq;
#pragma unroll
        for (int ai = 0; ai < 2; ++ai)
#pragma unroll
            for (int m = 0; m < 4; ++m) { const int r = ai * HALF + wr * 64 + m * 16 + fr;
                const f32x4 ps4 = *(const PG8_LAS f32x4*)(Ps + r * 4); const float inv = 1.f / ((ps4[0] + ps4[1]) + (ps4[2] + ps4[3]));
                bf16_t* rowp = base + (size_t)(row0 + r) * ldc + col0;
#pragma unroll
                for (int bj = 0; bj < 2; ++bj) { const f32x4 v0 = acc[ai][bj][m][0] * inv, v1 = acc[ai][bj][m][1] * inv;
                    u32x4 w; w.x = cvt_pk_bf16(v0[0], v0[1]); w.y = cvt_pk_bf16(v0[2], v0[3]); w.z = cvt_pk_bf16(v1[0], v1[1]); w.w = cvt_pk_bf16(v1[2], v1[3]);
                    *(u32x4*)(rowp + bj * HALF) = w; } }
    }
};

template <class Epi, class Sched, bool ALIGN_EPI>
__device__ __forceinline__ void gemm_phase(PG8_LAS unsigned char* lds, const Gemm g, const Sched& S, const Epi& E) {
    const int tid = threadIdx.x, wid = __builtin_amdgcn_readfirstlane(tid >> 6), lane = tid & 63, wr = wid >> 2, wc = wid & 3, fr = lane & 15, fq = lane >> 4;
    const int K = g.K, nt = K / BK;
    unsigned voffA[2], voffB[2];
#pragma unroll
    for (int i = 0; i < 2; ++i) { int R, C; stage_rc(tid * 16 + i * 8192, R, C); const int Rb = Epi::PERM ? ((R & ~31) + perm32(R & 31)) : R;
        voffA[i] = (unsigned)(R * g.lda + C) * 2u; voffB[i] = (unsigned)(Rb * g.ldb + C) * 2u; }
    const size_t kstep = (size_t)(BK * 2);
    const size_t hsA = (size_t)HALF * g.lda * 2, hsB = (size_t)HALF * g.ldb * 2;
    const unsigned ldsw = (unsigned)wid * 1024u;
    const int aoff = lds_byte(wr * 64 + fr, fq * 8), boff = lds_byte(wc * 32 + fr, fq * 8);
#define PG8_SA(b, h) (((b) * 2 + (h)) * HTB)
#define PG8_SB(b, h) ((4 + (b) * 2 + (h)) * HTB)
#define PG8_STAGE(bufoff, gbase, voff) do { _Pragma("unroll") for (int _i = 0; _i < 2; ++_i) \
        __builtin_amdgcn_global_load_lds((const unsigned*)((const char*)(gbase) + (voff)[_i]), (PG8_LAS unsigned*)(lds + (bufoff) + ldsw + _i * 8192), 16, 0, 0); } while (0)
#define PG8_LDA(dst, b, h) do { _Pragma("unroll") for (int m = 0; m < 4; ++m) _Pragma("unroll") for (int k = 0; k < 2; ++k) dst[m][k] = *(const PG8_LAS bf16x8*)(lds + PG8_SA(b, h) + aoff + m * 2048 + k * 1024); } while (0)
#define PG8_LDB(dst, b, h) do { _Pragma("unroll") for (int n = 0; n < 2; ++n) _Pragma("unroll") for (int k = 0; k < 2; ++k) dst[n][k] = *(const PG8_LAS bf16x8*)(lds + PG8_SB(b, h) + boff + n * 2048 + k * 1024); } while (0)
#define PG8_MMA(ai, bj, At, Bt) do { __builtin_amdgcn_s_setprio(1); _Pragma("unroll") for (int m = 0; m < 4; ++m) _Pragma("unroll") for (int n = 0; n < 2; ++n) _Pragma("unroll") for (int k = 0; k < 2; ++k) \
        acc[ai][bj][m][n] = __builtin_amdgcn_mfma_f32_16x16x32_bf16(Bt[n][k], At[m][k], acc[ai][bj][m][n], 0, 0, 0); __builtin_amdgcn_s_setprio(0); } while (0)
#define PG8_WAIT_V(n) asm volatile("s_waitcnt vmcnt(" #n ")" ::: "memory")
#define PG8_WAIT_L(n) asm volatile("s_waitcnt lgkmcnt(" #n ")" ::: "memory")
#define PG8_BAR __builtin_amdgcn_s_barrier()
#define PG8_SCHED __builtin_amdgcn_sched_barrier(0)
    Unit cur, nxt; int ui = 0;
    if (!S.next(0, cur)) return;
    f32x4 acc[2][2][4][2];
#pragma unroll
    for (int a = 0; a < 2; ++a)
#pragma unroll
        for (int b = 0; b < 2; ++b)
#pragma unroll
            for (int m = 0; m < 4; ++m)
#pragma unroll
                for (int n = 0; n < 2; ++n) acc[a][b][m][n] = (f32x4){0.f, 0.f, 0.f, 0.f};
    bf16x8 At[4][2], B0[2][2], B1[2][2];
    const char* cA = (const char*)g.A + (size_t)cur.aoff * 2; const char* cB = (const char*)g.Bt + (size_t)cur.boff * 2;
    S.a_ready(cur);
    PG8_STAGE(PG8_SB(0, 0), cB, voffB); PG8_STAGE(PG8_SB(0, 1), cB + hsB, voffB); PG8_STAGE(PG8_SA(0, 0), cA, voffA); PG8_STAGE(PG8_SA(0, 1), cA + hsA, voffA);
    if (wr == 1) PG8_BAR;
    PG8_WAIT_V(2); PG8_BAR;
    PG8_STAGE(PG8_SB(1, 0), cB + kstep, voffB); PG8_STAGE(PG8_SA(1, 0), cA + kstep, voffA); PG8_STAGE(PG8_SB(1, 1), cB + hsB + kstep, voffB);
    PG8_WAIT_V(6); PG8_BAR;
    for (;;) {
        const bool has_next = S.next(ui + 1, nxt);
        const char* nA = has_next ? (const char*)g.A + (size_t)nxt.aoff * 2 : cA; const char* nB = has_next ? (const char*)g.Bt + (size_t)nxt.boff * 2 : cB;
        for (int t = 0; t < nt; t += 2) {
            const bool last = (t == nt - 2);
            const char* a1 = cA + (size_t)(t + 1) * kstep;
            const char* a2 = last ? nA : cA + (size_t)(t + 2) * kstep; const char* b2 = last ? nB : cB + (size_t)(t + 2) * kstep;
            const char* a3 = a2 + kstep; const char* b3 = b2 + kstep;
            if (last && has_next) S.a_ready(nxt);
            PG8_LDB(B0, 0, 0); PG8_LDB(B1, 0, 1); PG8_SCHED; PG8_LDA(At, 0, 0); PG8_STAGE(PG8_SA(1, 1), a1 + hsA, voffA);
            PG8_WAIT_V(8); PG8_WAIT_L(0); PG8_BAR; PG8_MMA(0, 0, At, B0); PG8_MMA(0, 1, At, B1); PG8_BAR; PG8_SCHED;
            PG8_LDA(At, 0, 1); PG8_STAGE(PG8_SB(0, 0), b2, voffB); PG8_STAGE(PG8_SB(0, 1), b2 + hsB, voffB); PG8_STAGE(PG8_SA(0, 0), a2, voffA);
            PG8_WAIT_V(8); PG8_WAIT_L(0); PG8_BAR; PG8_MMA(1, 0, At, B0); PG8_MMA(1, 1, At, B1); PG8_BAR; PG8_SCHED;
            PG8_LDB(B0, 1, 0); PG8_LDB(B1, 1, 1); PG8_SCHED; PG8_LDA(At, 1, 0); PG8_STAGE(PG8_SA(0, 1), a2 + hsA, voffA);
            PG8_WAIT_V(8); PG8_WAIT_L(0); PG8_BAR; PG8_MMA(0, 0, At, B0); PG8_MMA(0, 1, At, B1); PG8_BAR; PG8_SCHED;
            PG8_LDA(At, 1, 1); PG8_STAGE(PG8_SB(1, 0), b3, voffB); PG8_STAGE(PG8_SB(1, 1), b3 + hsB, voffB); PG8_STAGE(PG8_SA(1, 0), a3, voffA);
            PG8_WAIT_V(8); PG8_WAIT_L(0); PG8_BAR; PG8_MMA(1, 0, At, B0); PG8_MMA(1, 1, At, B1); PG8_BAR; PG8_SCHED;
        }
        if constexpr (ALIGN_EPI) { if (wr == 0) PG8_BAR; }
        if constexpr (!Epi::AFTER_DRAIN) { E(acc, cur, wr, wc, fr, fq); S.done(cur); }
        if (!has_next) break;
#pragma unroll
        for (int a = 0; a < 2; ++a)
#pragma unroll
            for (int b = 0; b < 2; ++b)
#pragma unroll
                for (int m = 0; m < 4; ++m)
#pragma unroll
                    for (int n = 0; n < 2; ++n) acc[a][b][m][n] = (f32x4){0.f, 0.f, 0.f, 0.f};
        cur = nxt; cA = nA; cB = nB; ++ui;
        if constexpr (ALIGN_EPI) { if (wr == 1) PG8_BAR; }
    }
    PG8_WAIT_V(0);
    if constexpr (!ALIGN_EPI) { if (wr == 0) PG8_BAR; }
    PG8_BAR;
    if constexpr (Epi::AFTER_DRAIN) { E.fused(acc, cur, wr, wc, fr, fq, lds, wid, lane); S.done(cur); }
#undef PG8_SA
#undef PG8_SB
#undef PG8_STAGE
#undef PG8_LDA
#undef PG8_LDB
#undef PG8_MMA
#undef PG8_WAIT_V
#undef PG8_WAIT_L
#undef PG8_BAR
#undef PG8_SCHED
}
}

namespace fox {
typedef unsigned short bf16_t;
typedef short bf16x8 __attribute__((ext_vector_type(8)));
typedef short s16x4 __attribute__((ext_vector_type(4)));
typedef float f32x16 __attribute__((ext_vector_type(16)));
typedef float f32x4 __attribute__((ext_vector_type(4)));
typedef unsigned u32x4 __attribute__((ext_vector_type(4)));
constexpr int D = 128, NW = 8, QBLK = 32, KVBLK = 64, QB = NW * QBLK;
constexpr int SHM_V = KVBLK * D * 2, SHM_K = KVBLK * D * 2;
constexpr int LDS_C = 2 * SHM_V + 2 * SHM_K + NW * 64 * 4;
constexpr int LDS_BYTES = LDS_C + SEQ * 4;
constexpr int QP = 4096, OP = 2048;
constexpr float THR = 24.f;
#define KSWZ(row, colB) ((row) * 256 + ((colB) ^ (((row) & 7) << 4)))
#define SBAR() __builtin_amdgcn_sched_barrier(0)
__device__ __forceinline__ int v_st(int k, int c) { const int kk = (k & ~0xC) | ((k & 4) << 1) | ((k & 8) >> 1); return ((kk >> 3) * 4 + (c >> 5)) * 512 + ((kk & 7) * 32 + (c & 31)) * 2; }
__device__ __forceinline__ int v_rd_base(int lane) { return ((lane & 3) << 3) | (((lane >> 2) & 3) << 6) | (((lane >> 4) & 1) << 5) | (((lane >> 5) & 1) << 8); }
constexpr int v_rd_off(int d0, int ks, int half) { return d0 * 512 + ks * 4096 + half * 2048; }
__device__ __forceinline__ int crow(int r, int hi) { return (r & 3) + 8 * (r >> 2) + 4 * hi; }
__device__ __forceinline__ unsigned cvtpk(float lo, float hi) { unsigned r; asm volatile("v_cvt_pk_bf16_f32 %0, %1, %2" : "=v"(r) : "v"(lo), "v"(hi)); return r; }
__device__ __forceinline__ bf16x8 load8(const bf16_t* p) { return *reinterpret_cast<const bf16x8*>(p); }
__device__ __forceinline__ void mask_tile(f32x16& p0, f32x16& p1, int dq) {
    const float NEG = -__builtin_inff();
#pragma unroll
    for (int r = 0; r < 16; ++r) { const int c = (r & 3) + 8 * (r >> 2); if (dq - c < 0) p0[r] = NEG; if (dq - c - 32 < 0) p1[r] = NEG; }
}
__device__ __forceinline__ void bias_tile(f32x16& p0, f32x16& p1, const float* cb) {
#pragma unroll
    for (int i = 0; i < 4; ++i) { const f32x4 c0 = *(const f32x4*)(cb + 8 * i), c1 = *(const f32x4*)(cb + 32 + 8 * i);
#pragma unroll
        for (int j = 0; j < 4; ++j) { p0[4 * i + j] -= c0[j]; p1[4 * i + j] -= c1[j]; } }
}
__device__ __forceinline__ void partialSM(f32x16& p0, f32x16& p1, float& m_reg, float& mn, float& alpha) {
    float pmax = p0[0]; for (int r = 1; r < 16; ++r) pmax = fmaxf(pmax, p0[r]); for (int r = 0; r < 16; ++r) pmax = fmaxf(pmax, p1[r]);
    { auto rr = __builtin_amdgcn_permlane32_swap(__float_as_uint(pmax), __float_as_uint(pmax), false, false);
      pmax = fmaxf(__uint_as_float(rr[0]), __uint_as_float(rr[1])); }
    if (__builtin_expect(__all((pmax - m_reg) <= THR), 1)) { mn = m_reg; alpha = 1.f; }
    else { mn = fmaxf(m_reg, pmax); alpha = __builtin_amdgcn_exp2f(m_reg - mn); m_reg = mn; }
    for (int r = 0; r < 16; ++r) p0[r] = p0[r] - mn; for (int r = 0; r < 16; ++r) p1[r] = p1[r] - mn;
    for (int r = 0; r < 16; ++r) p0[r] = __builtin_amdgcn_exp2f(p0[r]);
}
__device__ __forceinline__ void finishSM(f32x16& p0, f32x16& p1, float alpha, float& l_reg, bf16x8& pa0, bf16x8& pa1, bf16x8& pa2, bf16x8& pa3) {
    for (int r = 0; r < 16; ++r) p1[r] = __builtin_amdgcn_exp2f(p1[r]);
    float ps = 0; for (int r = 0; r < 16; ++r) ps += p0[r]; for (int r = 0; r < 16; ++r) ps += p1[r];
    { auto rr = __builtin_amdgcn_permlane32_swap(__float_as_uint(ps), __float_as_uint(ps), false, false);
      ps = __uint_as_float(rr[0]) + __uint_as_float(rr[1]); }
    l_reg = l_reg * alpha + ps;
#define PK4(P, B_, OUT) do { unsigned a0 = cvtpk(P[B_+0], P[B_+1]), a1 = cvtpk(P[B_+2], P[B_+3]);                          \
        unsigned b0 = cvtpk(P[B_+4], P[B_+5]), b1 = cvtpk(P[B_+6], P[B_+7]);                                             \
        auto r0 = __builtin_amdgcn_permlane32_swap(a0, b0, false, false); auto r1 = __builtin_amdgcn_permlane32_swap(a1, b1, false, false); \
        u32x4 w = {r0[0], r1[0], r0[1], r1[1]}; OUT = *reinterpret_cast<bf16x8*>(&w); } while (0)
    PK4(p0, 0, pa0); PK4(p0, 8, pa1); PK4(p1, 0, pa2); PK4(p1, 8, pa3);
#undef PK4
}
template <int KB>
__device__ __forceinline__ void qkt(f32x16& p0, f32x16& p1, const char* K_lds, int r32, int hi, const bf16x8* qr) {
    p0 = f32x16{}; p1 = f32x16{};
    const char* kb[4];
#pragma unroll
    for (int dd = 0; dd < 4; ++dd) kb[dd] = K_lds + KB * SHM_K + KSWZ(r32, (dd * 16 + hi * 8) * 2);
#pragma unroll
    for (int d0 = 0; d0 < 8; ++d0) { const char* a = kb[d0 & 3] + (d0 >> 2) * 128;
        bf16x8 b0 = *reinterpret_cast<const bf16x8*>(a);
        bf16x8 b1 = *reinterpret_cast<const bf16x8*>(a + 32 * 256);
        p0 = __builtin_amdgcn_mfma_f32_32x32x16_bf16(b0, qr[d0], p0, 0, 0, 0);
        p1 = __builtin_amdgcn_mfma_f32_32x32x16_bf16(b1, qr[d0], p1, 0, 0, 0); }
}
template <int VB>
__device__ __forceinline__ void pv_tile(f32x16* o, int vb0, bf16x8 pa0, bf16x8 pa1, bf16x8 pa2, bf16x8 pa3) {
#define TRRD(dst, off) asm volatile("ds_read_b64_tr_b16 %0, %1 offset:%2" : "=&v"(dst) : "v"(vb0), "i"(off) : "memory")
#define PV_D0(d0) do { s16x4 l0, l1, l2, l3, h0, h1, h2, h3; constexpr int b_ = VB * SHM_V + v_rd_off(d0, 0, 0); \
        TRRD(l0, b_); TRRD(h0, b_ + 2048); TRRD(l1, b_ + 4096); TRRD(h1, b_ + 6144); TRRD(l2, b_ + 8192); TRRD(h2, b_ + 10240); TRRD(l3, b_ + 12288); TRRD(h3, b_ + 14336); \
        asm volatile("s_waitcnt lgkmcnt(0)" ::: "memory"); SBAR();   \
        o[d0] = __builtin_amdgcn_mfma_f32_32x32x16_bf16(pa0, (bf16x8){l0[0], l0[1], l0[2], l0[3], h0[0], h0[1], h0[2], h0[3]}, o[d0], 0, 0, 0);   \
        o[d0] = __builtin_amdgcn_mfma_f32_32x32x16_bf16(pa1, (bf16x8){l1[0], l1[1], l1[2], l1[3], h1[0], h1[1], h1[2], h1[3]}, o[d0], 0, 0, 0);   \
        o[d0] = __builtin_amdgcn_mfma_f32_32x32x16_bf16(pa2, (bf16x8){l2[0], l2[1], l2[2], l2[3], h2[0], h2[1], h2[2], h2[3]}, o[d0], 0, 0, 0);   \
        o[d0] = __builtin_amdgcn_mfma_f32_32x32x16_bf16(pa3, (bf16x8){l3[0], l3[1], l3[2], l3[3], h3[0], h3[1], h3[2], h3[3]}, o[d0], 0, 0, 0); } while (0)
    PV_D0(0); PV_D0(1); PV_D0(2); PV_D0(3);
#undef PV_D0
#undef TRRD
}
struct BlockRef { const bf16_t* Q; const bf16_t* K; const bf16_t* V; bf16_t* O; int P0; };
struct Seam { bf16x8 qr[8]; bf16x8 st_v0, st_v1, st_k0, st_k1; };
#define ROW(p, k0, rr) ((p) + (size_t)((k0) + (rr)) * QP + sc)
#define VMW() asm volatile("s_waitcnt vmcnt(0)" ::: "memory")
#define VMWN(n) asm volatile("s_waitcnt vmcnt(%0)" :: "i"(n) : "memory")
#define SLOAD_H(Kp, Vp, k0) do { S.st_v0 = load8(ROW(Vp, k0, sr)); S.st_v1 = load8(ROW(Vp, k0, 32 + sr)); S.st_k0 = load8(ROW(Kp, k0, sr)); S.st_k1 = load8(ROW(Kp, k0, 32 + sr)); } while (0)
#define SWRITE_HK(bf) do { *(bf16x8*)(K_lds + (bf) * SHM_K + kws) = S.st_k0; *(bf16x8*)(K_lds + (bf) * SHM_K + kws + 32 * 256) = S.st_k1; } while (0)
#define SWRITE_HV(bf) do { *(bf16x8*)(V_lds + (bf) * SHM_V + vst0) = S.st_v0; *(bf16x8*)(V_lds + (bf) * SHM_V + vst1) = S.st_v1; } while (0)
#define SWRITE_H(bf) do { SWRITE_HV(bf); SWRITE_HK(bf); } while (0)
__device__ __forceinline__ void prime(const BlockRef& cur, int j_lo, char* lds, Seam& S) {
    const int tid = threadIdx.x, wid = __builtin_amdgcn_readfirstlane(tid >> 6), lane = tid & 63, r32 = lane & 31, hi = lane >> 5;
    const int sr = tid >> 4, sc = (tid & 15) * 8, kws = KSWZ(sr, sc * 2); char* K_lds = lds + 2 * SHM_V;
    for (int d0 = 0; d0 < 8; ++d0) S.qr[d0] = load8(cur.Q + (size_t)(wid * QBLK + r32) * QP + d0 * 16 + hi * 8);
    SLOAD_H(cur.K, cur.V, j_lo * KVBLK); VMW(); SWRITE_HK(0);
    __syncthreads();
}
__device__ __forceinline__ void block(const BlockRef& cur, const BlockRef& nxt, int j_lo, char* lds, Seam& S) {
    const int tid = threadIdx.x, wid = __builtin_amdgcn_readfirstlane(tid >> 6), lane = tid & 63, r32 = lane & 31, hi = lane >> 5;
    const int NT = (cur.P0 + QB - 1) / KVBLK + 1 - j_lo;
    const int qlo = cur.P0 + wid * QBLK, qm = qlo + r32 - 4 * hi;
    char* V_lds = lds; char* K_lds = lds + 2 * SHM_V;
    float* ws = (float*)(lds + 2 * SHM_V + 2 * SHM_K) + wid * 64; float* li_l = ws, * al_l = ws + 32;
    const float* c_lds = (const float*)(lds + LDS_C) + 4 * hi;
    float m_reg = -1e30f, l_reg = 0; f32x16 o[4] = {};
    const int sr = tid >> 4, sc = (tid & 15) * 8, vst0 = v_st(sr, sc), vst1 = v_st(32 + sr, sc), kws = KSWZ(sr, sc * 2);
    const int vb0 = (int)(uintptr_t)V_lds + v_rd_base(lane);
    const bf16_t* Kh = cur.K; const bf16_t* Vh = cur.V;
#define RESC(a) do { if (__any((a) < 1.f)) { if (hi == 0) al_l[r32] = (a); asm volatile("s_waitcnt lgkmcnt(0)" ::: "memory");              \
                     for (int d_ = 0; d_ < 4; ++d_) for (int r = 0; r < 16; ++r) o[d_][r] *= al_l[crow(r, hi)]; } } while (0)
#define KBASE(t) ((j_lo + (t)) * KVBLK)
#define MASKT(P0_, P1_, t) do { const int kb_ = KBASE(t); bias_tile(P0_, P1_, c_lds + kb_); if (kb_ + KVBLK - 1 > qlo) mask_tile(P0_, P1_, qm - kb_); } while (0)
#define SEAM_K0() do { VMWN(8); SWRITE_HK(0); SBAR(); } while (0)
    f32x16 pA0, pA1, pB0, pB1; float mnA, mnB, alA, alB; bf16x8 pa0, pa1, pa2, pa3;
    SWRITE_HV(0); SBAR();
    if (NT > 1) { SLOAD_H(Kh, Vh, KBASE(1)); }
    SBAR(); qkt<0>(pA0, pA1, K_lds, r32, hi, S.qr);
    MASKT(pA0, pA1, 0); partialSM(pA0, pA1, m_reg, mnA, alA);
    if (NT > 1) { VMW(); SWRITE_H(1); }
    __syncthreads();
#define HALF_STEP(PX0, PX1, mnX, alX, PY0, PY1, alY, t, KB, VB, SB) do {                                                      \
        SBAR(); qkt<KB>(PX0, PX1, K_lds, r32, hi, S.qr);                                                                     \
        finishSM(PY0, PY1, alY, l_reg, pa0, pa1, pa2, pa3); SBAR();                                                           \
        if ((t) + 1 < NT) { SLOAD_H(Kh, Vh, KBASE((t) + 1)); SBAR(); }                                                        \
        pv_tile<VB>(o, vb0, pa0, pa1, pa2, pa3); MASKT(PX0, PX1, (t)); partialSM(PX0, PX1, m_reg, mnX, alX);                 \
        __syncthreads();                                                                                                      \
        if ((t) + 1 < NT) { VMW(); SWRITE_H(SB); }                                                                            \
        RESC(alX); __syncthreads(); } while (0)
    for (int t = 1; t + 1 < NT; t += 2) {
        HALF_STEP(pB0, pB1, mnB, alB, pA0, pA1, alA, t, 1, 0, 0);
        HALF_STEP(pA0, pA1, mnA, alA, pB0, pB1, alB, t + 1, 0, 1, 1);
    }
    const bool even = (NT & 1) == 0;
    if (even) { SBAR(); qkt<1>(pB0, pB1, K_lds, r32, hi, S.qr); SBAR(); }
    SLOAD_H(nxt.K, nxt.V, j_lo * KVBLK); SBAR();
#pragma unroll
    for (int d0 = 0; d0 < 8; ++d0) S.qr[d0] = load8(nxt.Q + (size_t)(wid * QBLK + r32) * QP + d0 * 16 + hi * 8);
    SBAR();
    finishSM(pA0, pA1, alA, l_reg, pa0, pa1, pa2, pa3); SBAR();
    pv_tile<0>(o, vb0, pa0, pa1, pa2, pa3);
    if (even) { MASKT(pB0, pB1, NT - 1); partialSM(pB0, pB1, m_reg, mnB, alB); __syncthreads(); RESC(alB);
        finishSM(pB0, pB1, alB, l_reg, pa0, pa1, pa2, pa3); SBAR(); pv_tile<1>(o, vb0, pa0, pa1, pa2, pa3); }
    SBAR(); SEAM_K0();
    if (hi == 0) li_l[r32] = l_reg; asm volatile("s_waitcnt lgkmcnt(0)" ::: "memory");
    float rli[16];
#pragma unroll
    for (int r = 0; r < 16; ++r) rli[r] = __builtin_amdgcn_rcpf(li_l[crow(r, hi)]);
    bf16_t* Ow = cur.O + (size_t)(wid * QBLK) * OP;
#pragma unroll
    for (int r = 0; r < 16; ++r) { const int orow = crow(r, hi);
#pragma unroll
        for (int d0 = 0; d0 < 4; ++d0) { const float v = o[d0][r] * rli[r];
            const float vn = __shfl_xor(v, 1);
            if ((r32 & 1) == 0) *(unsigned*)(Ow + (size_t)orow * OP + d0 * 32 + r32) = cvtpk(v, vn); } }
    __syncthreads();
#undef RESC
#undef KBASE
#undef MASKT
#undef SEAM_K0
#undef HALF_STEP
}
#undef ROW
#undef VMW
#undef VMWN
#undef SLOAD_H
#undef SWRITE_HK
#undef SWRITE_HV
#undef SWRITE_H
#undef KSWZ
#undef SBAR
}

constexpr int NWAVES = 8, NTHREADS = 512;
constexpr int LDS_BYTES = 147456;
constexpr int LDS_MISC = 145408;
constexpr size_t MiB = 1u << 20;
constexpr size_t WS_CTL = 0, CTL_ZERO_BYTES = 1 * MiB;
#ifndef QSPLIT
#define QSPLIT 1024
#endif
constexpr int CW_QUEUE2 = 128;
constexpr int CW_NRM = 512;
constexpr int CW_QUEUE = 64;
constexpr int CW_BAR = 4096;
constexpr size_t CTL_SS1 = 256 * 1024, CTL_SS2 = 320 * 1024;
constexpr size_t WS_LF = 1 * MiB;
constexpr size_t WS_SU = 1 * MiB + 512 * 1024, WS_SV = 1 * MiB + 640 * 1024;
constexpr size_t WS_WIN = 2 * MiB, WS_WO1 = 18 * MiB, WS_WO2 = 26 * MiB, WS_WQ = 34 * MiB, WS_WK = 42 * MiB, WS_WV = 50 * MiB, WS_WO = 58 * MiB;
constexpr size_t WS_WPQ = 66 * MiB, WS_AEXP = 74 * MiB, WS_WSC = 82 * MiB, WS_PB = 90 * MiB, WS_MN = 91 * MiB, WS_KX = 93 * MiB, WS_VXT = 95 * MiB;
constexpr size_t WS_UB = 98 * MiB, WS_VB = 130 * MiB, WS_XN = 226 * MiB, WS_PROJ = 258 * MiB, WS_AMIX = 322 * MiB, WS_H = 354 * MiB, WS_HB = 418 * MiB, WS_P = 450 * MiB, WS_END = 466 * MiB;

#define GAS __attribute__((address_space(1)))
#define LAS __attribute__((address_space(3)))
typedef unsigned short bf16;
typedef unsigned v4u __attribute__((ext_vector_type(4)));
typedef unsigned v2u __attribute__((ext_vector_type(2)));
typedef float f32x4 __attribute__((ext_vector_type(4)));
typedef __bf16 bf16x2_t __attribute__((ext_vector_type(2)));
#define LDS_WAIT() asm volatile("s_waitcnt lgkmcnt(0)" ::: "memory")
__device__ __forceinline__ unsigned f2bf(float f) { unsigned u = __builtin_bit_cast(unsigned, f); return (u + 0x7fffu + ((u >> 16) & 1u)) >> 16; }
__device__ __forceinline__ unsigned pk2(float lo, float hi) { return f2bf(lo) | (f2bf(hi) << 16); }
__device__ __forceinline__ float wave_sum(float v) {
#pragma unroll
    for (int o = 1; o < 64; o <<= 1) v += __shfl_xor(v, o);
    return v;
}

#define XB_TMO      128
#define XB_XCNT(j)  (256  + 64 * (j))
#define XB_XSUB(j)  (1280 + 64 * (j))
#define XB_XGEN(j)  (2304 + 64 * (j))
#define XB_TOP      3328
#define XB_TOPGEN   3392
#define XCD_BAR_WORDS 3456
#define XB_SPIN_CAP (1u << 22)
__device__ __forceinline__ unsigned xb_ld(unsigned* p)              { return __hip_atomic_load(p, __ATOMIC_RELAXED, __HIP_MEMORY_SCOPE_AGENT); }
__device__ __forceinline__ unsigned xb_add(unsigned* p, unsigned v) { return __hip_atomic_fetch_add(p, v, __ATOMIC_RELAXED, __HIP_MEMORY_SCOPE_AGENT); }
__device__ __forceinline__ unsigned xb_xcc_id() { return (unsigned)__builtin_amdgcn_s_getreg((3 << 11) | 20) & 0xFu; }
#define XB_SPIN(cond, bar) do { unsigned _sp = 0; while (cond) { __builtin_amdgcn_s_sleep(1); \
    if ((++_sp & 255u) == 0u) { if (xb_ld(&(bar)[XB_TMO])) break; if (_sp > XB_SPIN_CAP) { atomicAdd(&(bar)[XB_TMO], 1u); break; } } } } while (0)
struct XcdBarrier { unsigned* bar; unsigned x; volatile LAS unsigned* st; };
__device__ __forceinline__ XcdBarrier xcd_barrier_post(unsigned* bar, volatile LAS unsigned* st) {
    XcdBarrier b; b.bar = bar; b.x = xb_xcc_id(); b.st = st;
    if (threadIdx.x == 0) (void)xb_add(&bar[XB_XCNT(b.x)], 1u);
    return b;
}
__device__ __forceinline__ void xcd_barrier_complete(unsigned* bar, unsigned x, unsigned& nloc, unsigned& nx) {
    const unsigned G = gridDim.x * gridDim.y * gridDim.z;
    unsigned sum, cnt, mine, sp = 0u;
    for (;;) {
        sum = 0u; cnt = 0u; mine = 0u;
#pragma unroll
        for (unsigned j = 0; j < 16; ++j) { const unsigned c = xb_ld(&bar[XB_XCNT(j)]); sum += c; cnt += (c > 0u) ? 1u : 0u; mine = (j == x) ? c : mine; }
        if (sum == G) break;
        __builtin_amdgcn_s_sleep(1);
        if ((++sp & 255u) == 0u) { if (xb_ld(&bar[XB_TMO])) break; if (sp > XB_SPIN_CAP) { atomicAdd(&bar[XB_TMO], 1u); break; } }
    }
    nloc = mine > 0u ? mine : 1u; nx = cnt > 0u ? cnt : 1u;
}
__device__ __forceinline__ void xcd_barrier(const XcdBarrier& b) {
    asm volatile("s_waitcnt vmcnt(0)" ::: "memory");
    __syncthreads();
    if (threadIdx.x == 0) {
        unsigned* bar = b.bar;
        __builtin_amdgcn_s_waitcnt(0);
        unsigned nloc = b.st[0], nx = b.st[1];
        if (nloc == 0u) { xcd_barrier_complete(bar, b.x, nloc, nx); b.st[0] = nloc; b.st[1] = nx; }
        const unsigned old = xb_add(&bar[XB_XSUB(b.x)], 1u);
        const unsigned gen = old / nloc;
        if (old + 1u == (gen + 1u) * nloc) {
            __builtin_amdgcn_fence(__ATOMIC_RELEASE, "agent");
            asm volatile("s_waitcnt vmcnt(0)" ::: "memory");
            const unsigned og = xb_add(&bar[XB_TOP], 1u);
            const unsigned tg = og / nx;
            if (og + 1u == (tg + 1u) * nx) xb_add(&bar[XB_TOPGEN], 1u);
            else XB_SPIN(xb_ld(&bar[XB_TOPGEN]) == tg, bar);
            __builtin_amdgcn_fence(__ATOMIC_ACQUIRE, "agent");
            xb_add(&bar[XB_XGEN(b.x)], 1u);
            asm volatile("s_waitcnt vmcnt(0)" ::: "memory");
        } else {
            XB_SPIN(xb_ld(&bar[XB_XGEN(b.x)]) == gen, bar);
            __builtin_amdgcn_fence(__ATOMIC_ACQUIRE, "agent");
            asm volatile("s_waitcnt vmcnt(0)" ::: "memory");
        }
    }
    __syncthreads();
}

struct Args { const float* in[20]; float* out; unsigned char* ws; int ph_lo, ph_hi; int one_launch, pad; };

__device__ __forceinline__ void tr_load(const float* W, int ldw, int nblk, int item, int lane, f32x4 (&tv)[8]) {
    const int kb = item / nblk, nb = item % nblk, k0 = 64 * kb, n0 = 32 * nb;
#pragma unroll
    for (int i = 0; i < 8; ++i) tv[i] = __builtin_nontemporal_load((const GAS f32x4*)(W + (size_t)(k0 + i * 8 + (lane >> 3)) * ldw + n0 + (lane & 7) * 4));
}
__device__ __forceinline__ void tr_store(const f32x4 (&tv)[8], int nblk, bf16* WT, bf16* WT2, int k2lo, int ldt, LAS float* scr, int item, int lane) {
    const int kb = item / nblk, nb = item % nblk, k0 = 64 * kb, n0 = 32 * nb;
#pragma unroll
    for (int i = 0; i < 8; ++i) { const int kk = i * 8 + (lane >> 3); LAS float* d = scr + kk * 33 + (lane & 7) * 4; d[0] = tv[i][0]; d[1] = tv[i][1]; d[2] = tv[i][2]; d[3] = tv[i][3]; }
    LDS_WAIT(); asm volatile("" ::: "memory");
    const int c = lane & 7;
#pragma unroll
    for (int j = 0; j < 4; ++j) { const int n = (lane >> 3) + 8 * j; const LAS float* s = scr + (8 * c) * 33 + n;
        v4u o; o.x = pk2(s[0 * 33], s[1 * 33]); o.y = pk2(s[2 * 33], s[3 * 33]); o.z = pk2(s[4 * 33], s[5 * 33]); o.w = pk2(s[6 * 33], s[7 * 33]);
        *(GAS v4u*)(WT + (size_t)(n0 + n) * ldt + k0 + 8 * c) = o;
        if (WT2 && k0 >= k2lo) *(GAS v4u*)(WT2 + (size_t)(n0 + n) * ldt + k0 + 8 * c) = o; }
    LDS_WAIT(); asm volatile("" ::: "memory");
}
__device__ __forceinline__ void p0_transpose_item(const float* W, int ldw, int nblk, const float* g, bf16* WT, bf16* WT2, int k2lo, int ldt, LAS float* scr, int item, int lane) {
    (void)g; f32x4 tv[8]; tr_load(W, ldw, nblk, item, lane, tv); tr_store(tv, nblk, WT, WT2, k2lo, ldt, scr, item, lane);
}
__device__ __forceinline__ v4u cvt8(const float* p, float s) {
    const f32x4 a = __builtin_nontemporal_load((const GAS f32x4*)p), b = __builtin_nontemporal_load((const GAS f32x4*)(p + 4));
    v4u o; o.x = pk2(a[0] * s, a[1] * s); o.y = pk2(a[2] * s, a[3] * s); o.z = pk2(b[0] * s, b[1] * s); o.w = pk2(b[2] * s, b[3] * s); return o;
}

__device__ __forceinline__ float gelu_f(float v) {
    const float av = fabsf(v), t = __builtin_amdgcn_rcpf(av * 0.2316418882f + 1.0f);
    float q = t * 0.5307027145f + (-0.7265760135f); q = q * t + 0.7107068705f; q = q * t + (-0.142248368f); q = q * t + 0.127414796f; q = q * t;
    const float e = __builtin_amdgcn_exp2f((v * v) * (-0.72134752044f));
    const float m = v * (q * e);
    return v < 0.f ? m : v - m;
}
__device__ __forceinline__ float dot2bf(unsigned a, unsigned b, float c) { return __builtin_amdgcn_fdot2_f32_bf16(__builtin_bit_cast(bf16x2_t, a), __builtin_bit_cast(bf16x2_t, b), c, false); }
__device__ __forceinline__ unsigned fkey(float f) { const unsigned u = __float_as_uint(f); return (u & 0x80000000u) ? ~u : (u | 0x80000000u); }
__device__ __forceinline__ float fdec(unsigned k) { const unsigned u = (k & 0x80000000u) ? (k & 0x7fffffffu) : ~k; return __uint_as_float(u); }


typedef float f32x2v __attribute__((ext_vector_type(2)));
__device__ __forceinline__ float wave_sum_dpp(float v) {
    v += __builtin_bit_cast(float, __builtin_amdgcn_update_dpp(0, __builtin_bit_cast(int, v), 0xB1, 0xf, 0xf, true));
    v += __builtin_bit_cast(float, __builtin_amdgcn_update_dpp(0, __builtin_bit_cast(int, v), 0x4E, 0xf, 0xf, true));
    v += __builtin_bit_cast(float, __builtin_amdgcn_update_dpp(0, __builtin_bit_cast(int, v), 0x141, 0xf, 0xf, true));
    v += __builtin_bit_cast(float, __builtin_amdgcn_update_dpp(0, __builtin_bit_cast(int, v), 0x140, 0xf, 0xf, true));
    const float a = __builtin_bit_cast(float, __builtin_amdgcn_readlane(__builtin_bit_cast(int, v), 0));
    const float b = __builtin_bit_cast(float, __builtin_amdgcn_readlane(__builtin_bit_cast(int, v), 16));
    const float c = __builtin_bit_cast(float, __builtin_amdgcn_readlane(__builtin_bit_cast(int, v), 32));
    const float d = __builtin_bit_cast(float, __builtin_amdgcn_readlane(__builtin_bit_cast(int, v), 48));
    return (a + b) + (c + d);
}
typedef float v32f __attribute__((ext_vector_type(32)));
typedef float v16f __attribute__((ext_vector_type(16)));
typedef unsigned v6u __attribute__((ext_vector_type(6)));
#ifndef FP6_INTERLEAVED
#define FP6_INTERLEAVED 1
#endif
__device__ __forceinline__ v32f dec_fp6(const v4u a, const v2u b) { const v6u w = {a.x, a.y, a.z, a.w, b.x, b.y}; return __builtin_amdgcn_cvt_scalef32_pk32_f32_fp6(w, 1.0f); }
typedef __bf16 v32bf __attribute__((ext_vector_type(32)));
typedef unsigned v16u __attribute__((ext_vector_type(16)));
__device__ __forceinline__ float peer_dot(const v4u ua, const v2u ub, const unsigned (&xnp)[16]) {
    const v6u w = {ua.x, ua.y, ua.z, ua.w, ub.x, ub.y};
    const v16u fu = __builtin_bit_cast(v16u, __builtin_amdgcn_cvt_scalef32_pk32_bf16_fp6(w, 1.0f));
    unsigned fa[16];
#pragma unroll
    for (int i = 0; i < 16; ++i) fa[i] = fu[i];
    float a[4] = {0.f, 0.f, 0.f, 0.f};
#pragma unroll
    for (int i = 0; i < 16; ++i) a[i & 3] = dot2bf(fa[i], xnp[i], a[i & 3]);
    return (a[0] + a[1]) + (a[2] + a[3]);
}
__device__ __forceinline__ float peer_dot_lds(const v4u ua, const v2u ub, const LAS v4u* xl) {
    const v6u w = {ua.x, ua.y, ua.z, ua.w, ub.x, ub.y};
    const v16u fu = __builtin_bit_cast(v16u, __builtin_amdgcn_cvt_scalef32_pk32_bf16_fp6(w, 1.0f));
    unsigned fa[16];
#pragma unroll
    for (int i = 0; i < 16; ++i) fa[i] = fu[i];
    float a[4] = {0.f, 0.f, 0.f, 0.f};
#pragma unroll
    for (int i4 = 0; i4 < 4; ++i4) { const v4u x4 = xl[i4 * 64];
        a[0] = dot2bf(fa[i4 * 4 + 0], x4.x, a[0]); a[1] = dot2bf(fa[i4 * 4 + 1], x4.y, a[1]); a[2] = dot2bf(fa[i4 * 4 + 2], x4.z, a[2]); a[3] = dot2bf(fa[i4 * 4 + 3], x4.w, a[3]); }
    return (a[0] + a[1]) + (a[2] + a[3]);
}
typedef _Float16 h16x2 __attribute__((ext_vector_type(2)));
__device__ __forceinline__ unsigned pkfma_h(unsigned a, unsigned b, unsigned c) { return __builtin_bit_cast(unsigned, __builtin_elementwise_fma(__builtin_bit_cast(h16x2, a), __builtin_bit_cast(h16x2, b), __builtin_bit_cast(h16x2, c))); }
__device__ __forceinline__ float h16lo(unsigned u) { return (float)__builtin_bit_cast(h16x2, u).x; }
__device__ __forceinline__ float h16hi(unsigned u) { return (float)__builtin_bit_cast(h16x2, u).y; }
__device__ __forceinline__ void peer_axpy_h(const v4u va, const v2u vb, float w, unsigned (&oh)[16]) {
    const v6u wv = {va.x, va.y, va.z, va.w, vb.x, vb.y};
    const v16u fu = __builtin_bit_cast(v16u, __builtin_amdgcn_cvt_scalef32_pk32_f16_fp6(wv, 1.0f));
    unsigned fa[16];
#pragma unroll
    for (int i = 0; i < 16; ++i) fa[i] = fu[i];
    const h16x2 w2 = {(_Float16)w, (_Float16)w}; const unsigned wu = __builtin_bit_cast(unsigned, w2);
#pragma unroll
    for (int i = 0; i < 16; ++i) oh[i] = pkfma_h(fa[i], wu, oh[i]);
}
__device__ __forceinline__ void peer_axpy(const v4u va, const v2u vb, float w, float (&oacc)[32]) {
    const v32f f = dec_fp6(va, vb);
#pragma unroll
    for (int i = 0; i < 32; ++i) oacc[i] = fmaf(w, f[i], oacc[i]);
}


template <int NR>
__device__ __forceinline__ void conv_rows_fp6(const float* srow0, unsigned char* drow0, float* sc0, int lane) {
    f32x4 v[NR][8]; float am[NR];
#pragma unroll
    for (int q = 0; q < 8; ++q)
#pragma unroll
        for (int r = 0; r < NR; ++r) v[r][q] = __builtin_nontemporal_load((const GAS f32x4*)(srow0 + (size_t)r * DM + lane * 4 + q * 256));
#pragma unroll
    for (int r = 0; r < NR; ++r) { am[r] = 0.f;
#pragma unroll
        for (int q = 0; q < 8; ++q) am[r] = fmaxf(am[r], fmaxf(fmaxf(fabsf(v[r][q][0]), fabsf(v[r][q][1])), fmaxf(fabsf(v[r][q][2]), fabsf(v[r][q][3])))); }
#pragma unroll
    for (int o = 1; o < 64; o <<= 1)
#pragma unroll
        for (int r = 0; r < NR; ++r) am[r] = fmaxf(am[r], __shfl_xor(am[r], o));
#pragma unroll
    for (int r = 0; r < NR; ++r) {
        int ex = 0; if (am[r] > 0.f) { (void)frexpf(am[r], &ex); ex = 3 - ex; if (ldexpf(am[r], ex) > 7.5f) ex -= 1; }
        const float sc = ldexpf(1.f, ex);
        if (lane == 0) sc0[r] = ldexpf(1.f, -ex);
        v16f xa, xb;
#pragma unroll
        for (int i = 0; i < 16; ++i) { xa[i] = v[r][(2 * i) >> 2][(2 * i) & 3] * sc; xb[i] = v[r][(2 * i + 1) >> 2][(2 * i + 1) & 3] * sc; }
        const v6u w = __builtin_amdgcn_cvt_scalef32_2xpk16_fp6_f32(xa, xb, 1.0f);
        unsigned char* drow = drow0 + (size_t)r * 1536;
        *(GAS v4u*)(drow + lane * 16) = (v4u){w[0], w[1], w[2], w[3]};
        *(GAS v2u*)(drow + 1024 + lane * 8) = (v2u){w[4], w[5]};
    }
}

#if defined(PROBE_SEL) && PROBE_SEL < 7
#define PROBE_EXPORT(T_, q) do { if ((T_) == 0 && lane == 0 && (q) == 0) { const unsigned long long a_ = ((unsigned long long)MISC[33 + 2 * PROBE_SEL] << 32) | MISC[32 + 2 * PROBE_SEL], b_ = ((unsigned long long)MISC[35 + 2 * PROBE_SEL] << 32) | MISC[34 + 2 * PROBE_SEL]; o[0] += (float)(b_ - a_) * 0.001f; } } while (0)
#else
#define PROBE_EXPORT(T_, q) do { } while (0)
#endif
__global__ void __launch_bounds__(NTHREADS, 2) fwd_kernel(Args args) {
    extern __shared__ __attribute__((aligned(16))) unsigned char lds[];
    LAS unsigned char* ldsL = (LAS unsigned char*)lds;
    volatile LAS unsigned* MISC = (volatile LAS unsigned*)(ldsL + LDS_MISC);
    const int tid = threadIdx.x, lane = tid & 63, wave = __builtin_amdgcn_readfirstlane(tid >> 6);
    const int G = gridDim.x; const int bx = blockIdx.x; const int vcu = (G % 8 == 0) ? (bx % 8) * (G / 8) + bx / 8 : bx;
#define G_ws (args.ws)
#define G_ctl ((unsigned*)(args.ws + WS_CTL))
#define G_x (args.in[0])
#define G_mem (args.in[1])
#define G_mix_norm (args.in[2])
#define G_w_in (args.in[3])
#define G_b_forget (args.in[4])
#define G_pool_w (args.in[5])
#define G_pool_scale (args.in[6])
#define G_w_out (args.in[7])
#define G_xattn_norm (args.in[8])
#define G_mem_norm (args.in[9])
#define G_xwq (args.in[10])
#define G_xwk (args.in[11])
#define G_xwv (args.in[12])
#define G_xwo (args.in[13])
#define G_peer_norm (args.in[14])
#define G_peer_wq (args.in[15])
#define G_sub_keys (args.in[16])
#define G_peer_u (args.in[17])
#define G_peer_v (args.in[18])
#define G_final_norm (args.in[19])
#define G_W_IN ((bf16*)(args.ws + WS_WIN))
#define G_WO1 ((bf16*)(args.ws + WS_WO1))
#define G_WO2 ((bf16*)(args.ws + WS_WO2))
#define G_WQ ((bf16*)(args.ws + WS_WQ))
#define G_WK ((bf16*)(args.ws + WS_WK))
#define G_WV ((bf16*)(args.ws + WS_WV))
#define G_WO ((bf16*)(args.ws + WS_WO))
#define G_WPQ ((bf16*)(args.ws + WS_WPQ))
#define G_AEXP ((bf16*)(args.ws + WS_AEXP))
#define G_W1 ((bf16*)(args.ws + WS_AEXP))
#define G_W2 ((bf16*)(args.ws + WS_WPQ))
#define G_WSC ((bf16*)(args.ws + WS_WSC))
#define G_PB ((bf16*)(args.ws + WS_PB))
#define G_MN ((bf16*)(args.ws + WS_MN))
#define G_KX ((bf16*)(args.ws + WS_KX))
#define G_VXT ((bf16*)(args.ws + WS_VXT))
#define G_UB (args.ws + WS_UB)
#define G_VB (args.ws + WS_VB)
#define G_SU ((float*)(args.ws + WS_SU))
#define G_SV ((float*)(args.ws + WS_SV))
#define G_XN ((bf16*)(args.ws + WS_XN))
#define G_QX ((bf16*)(args.ws + WS_XN))
#define G_PROJ ((bf16*)(args.ws + WS_PROJ))
#define G_SCT ((float*)(args.ws + WS_PROJ))
#define G_AMIX ((bf16*)(args.ws + WS_AMIX))
#define G_OX ((bf16*)(args.ws + WS_AMIX))
#define G_H ((float*)(args.ws + WS_H))
#define G_HB ((bf16*)(args.ws + WS_HB))
#define G_PP ((bf16*)(args.ws + WS_P))
#define G_LF ((float*)(args.ws + WS_LF))
#define G_SS1 ((float*)(args.ws + CTL_SS1))
#define G_SS2 ((float*)(args.ws + CTL_SS2))

    for (int u = tid; u < (LDS_BYTES - LDS_MISC) / 4; u += NTHREADS) ((LAS unsigned*)(ldsL + LDS_MISC))[u] = 0u;
    __syncthreads();
    XcdBarrier bar; bar.bar = G_ctl + CW_BAR; bar.x = 0; bar.st = nullptr;
    if (args.one_launch) bar = xcd_barrier_post(G_ctl + CW_BAR, MISC + 8);
    const int lo = args.ph_lo, hi = args.ph_hi;
#ifndef PH_MASK
#define PH_MASK 0xff
#endif
#define IN(k) (((PH_MASK >> (k)) & 1) && lo <= (k) && (k) < hi)
#ifdef PROBE_SEL
#define STAMP(i) do { if (bx == 0 && tid == 0) { const unsigned long long t_ = __builtin_amdgcn_s_memrealtime(); MISC[32 + 2 * (i)] = (unsigned)t_; MISC[33 + 2 * (i)] = (unsigned)(t_ >> 32); } } while (0)
#else
#define STAMP(i) do { } while (0)
#endif
#define SEAM(k) do { if (IN(k) && IN((k) + 1)) xcd_barrier(bar); STAMP((k) + 1); } while (0)
#define TABLE_CHUNK(c_) do { const int r_ = (c_) * 32 + wave * 4; const int tb_ = r_ >> 14, rr_ = r_ & (PEXP - 1); \
        conv_rows_fp6<4>((tb_ ? G_peer_v : G_peer_u) + (size_t)rr_ * DM, (tb_ ? G_VB : G_UB) + (size_t)rr_ * 1536, (tb_ ? G_SV : G_SU) + rr_, lane); } while (0)
    STAMP(0);
#if defined(PROBE_SEL) && PROBE_SEL >= 7
    if (bx == 0 && tid == 0) __hip_atomic_store((unsigned long long*)(G_ctl + 256), (unsigned long long)__builtin_amdgcn_s_memrealtime(), __ATOMIC_RELAXED, __HIP_MEMORY_SCOPE_AGENT);
#endif
    const int gw = vcu * NWAVES + wave, NGW = G * NWAVES;
    const int gt = vcu * NTHREADS + tid, NGT = G * NTHREADS;

    if (IN(0)) for (int rep_ = 0; rep_ < (((DUP_MASK >> 0) & 1) ? args.pad + 1 : 1); ++rep_) {
        LAS float* wf = (LAS float*)ldsL;
        LAS float* scr = (LAS float*)(ldsL + 65536 + wave * 8704);
#pragma unroll
        for (int i = 0; i < DM / NTHREADS; ++i) { const int d = tid + i * NTHREADS; const f32x4 a = *(const GAS f32x4*)(G_w_in + (size_t)d * INC + 4096), b = *(const GAS f32x4*)(G_w_in + (size_t)d * INC + 4100);
            wf[d] = a[0]; wf[DM + d] = a[1]; wf[2 * DM + d] = a[2]; wf[3 * DM + d] = a[3]; wf[4 * DM + d] = b[0]; wf[5 * DM + d] = b[1]; wf[6 * DM + d] = b[2]; wf[7 * DM + d] = b[3]; }
        __syncthreads();
        f32x4 vnx[8];
        if (gw < TOK) {
#pragma unroll
            for (int j = 0; j < 8; ++j) vnx[j] = __builtin_nontemporal_load((const GAS f32x4*)(G_x + (size_t)gw * DM) + lane + 64 * j); }
        for (int m = gw; m < TOK; m += NGW) {
            const GAS f32x4* gr = (const GAS f32x4*)G_mix_norm + lane;
            f32x4 v[8]; float s = 0.f;
#pragma unroll
            for (int j = 0; j < 8; ++j) v[j] = vnx[j];
            if (m + NGW < TOK) {
#pragma unroll
                for (int j = 0; j < 8; ++j) vnx[j] = __builtin_nontemporal_load((const GAS f32x4*)(G_x + (size_t)(m + NGW) * DM) + lane + 64 * j); }
#pragma unroll
            for (int j = 0; j < 8; ++j) s += (v[j][0] * v[j][0] + v[j][1] * v[j][1]) + (v[j][2] * v[j][2] + v[j][3] * v[j][3]);
            const float rstd = __builtin_amdgcn_rsqf(wave_sum_dpp(s) * (1.f / DM) + EPS);
            GAS v2u* o8 = (GAS v2u*)(G_XN + (size_t)m * DM) + lane;
#pragma unroll
            for (int j = 0; j < 8; ++j) { const f32x4 gg = gr[64 * j]; v[j] = v[j] * rstd * gg;
                v2u o; o.x = pk2(v[j][0], v[j][1]); o.y = pk2(v[j][2], v[j][3]); o8[64 * j] = o; }
            float fl[8];
#pragma unroll
            for (int h = 0; h < 8; ++h) { float a = 0.f;
#pragma unroll
                for (int j = 0; j < 8; ++j) { const f32x4 w = *(const LAS f32x4*)(wf + h * DM + j * 256 + lane * 4); a += (v[j][0] * w[0] + v[j][1] * w[1]) + (v[j][2] * w[2] + v[j][3] * w[3]); }
                fl[h] = wave_sum_dpp(a);
                asm volatile("" ::: "memory"); }
            if (lane < 8) { float f = fl[0];
#pragma unroll
                for (int h = 1; h < 8; ++h) f = (lane == h) ? fl[h] : f;
                f += G_b_forget[lane];
                const float ls = fminf(f, 0.f) - log1pf(expf(-fabsf(f)));
                const int b = m / SEQ, sq = m % SEQ; G_LF[(size_t)(b * FOXH + lane) * SEQ + sq] = ls; }
        }
        for (int m = gw; m < BATCH * NMEM; m += NGW) {
            const GAS f32x4* xr = (const GAS f32x4*)(G_mem + (size_t)m * DM) + lane; const GAS f32x4* gr = (const GAS f32x4*)G_mem_norm + lane;
            f32x4 v[8]; float s = 0.f;
#pragma unroll
            for (int j = 0; j < 8; ++j) { v[j] = xr[64 * j]; s += (v[j][0] * v[j][0] + v[j][1] * v[j][1]) + (v[j][2] * v[j][2] + v[j][3] * v[j][3]); }
            const float rstd = __builtin_amdgcn_rsqf(wave_sum_dpp(s) * (1.f / DM) + EPS);
            GAS v2u* o8 = (GAS v2u*)(G_MN + (size_t)m * DM) + lane;
#pragma unroll
            for (int j = 0; j < 8; ++j) { const f32x4 gg = gr[64 * j]; v[j] = v[j] * rstd * gg; v2u o; o.x = pk2(v[j][0], v[j][1]); o.y = pk2(v[j][2], v[j][3]); o8[64 * j] = o; }
        }
        {
            constexpr int I_IN = (DM / 64) * (4096 / 32), I_SQ = (DM / 64) * (DM / 32);
            constexpr int NITEMS = I_IN + 3 * I_SQ;
#define TR_SRC(it_, W_, ldw_, nblk_, r_) do { r_ = (it_); if (r_ < I_IN) { W_ = G_w_in; ldw_ = INC; nblk_ = 4096 / 32; } else { r_ -= I_IN; ldw_ = DM; nblk_ = DM / 32; \
        if (r_ < I_SQ) W_ = G_w_out; else if (r_ < 2 * I_SQ) { W_ = G_xwk; r_ -= I_SQ; } else { W_ = G_xwv; r_ -= 2 * I_SQ; } } } while (0)
            f32x4 tvn[8]; const float* Wn; int ldwn, nblkn, rn;
            if (gw < NITEMS) { TR_SRC(gw, Wn, ldwn, nblkn, rn); tr_load(Wn, ldwn, nblkn, rn, lane, tvn); }
            for (int it = gw; it < NITEMS; it += NGW) {
                f32x4 tvc[8];
#pragma unroll
                for (int i = 0; i < 8; ++i) tvc[i] = tvn[i];
                const int nblkc = nblkn, rc = rn;
                if (it + NGW < NITEMS) { TR_SRC(it + NGW, Wn, ldwn, nblkn, rn); tr_load(Wn, ldwn, nblkn, rn, lane, tvn); }
                int r = it;
                if (r < I_IN) { tr_store(tvc, nblkc, G_W_IN, nullptr, 0, DM, scr, rc, lane); continue; } r -= I_IN;
                if (r < I_SQ) { tr_store(tvc, nblkc, G_WO1, G_WO2, POOLW, DM, scr, rc, lane); continue; } r -= I_SQ;
                if (r < I_SQ) { tr_store(tvc, nblkc, G_WK, nullptr, 0, DM, scr, rc, lane); continue; }
                tr_store(tvc, nblkc, G_WV, nullptr, 0, DM, scr, rc, lane);
            }
#undef TR_SRC
        }
        for (int i0 = gt; i0 < DM * DM / 8; i0 += 2 * NGT) {
#pragma unroll
            for (int u = 0; u < 2; ++u) { const int i = i0 + u * NGT; if (i < DM * DM / 8) {
                const int d = i / (DM / 8);
                const v4u o1 = cvt8(G_peer_wq + (size_t)i * 8, G_peer_norm[d]);
                const v4u o2 = cvt8(G_xwq + (size_t)i * 8, G_xattn_norm[d]);
                *(GAS v4u*)(G_WPQ + (size_t)i * 8) = o1; *(GAS v4u*)(G_WQ + (size_t)i * 8) = o2; } }
        }
        for (int i = gt; i < DM * 256 / 8; i += NGT) {
            const int r = i >> 5, c0 = (i & 31) * 8; const int hc = r >> 7;
            v4u o3 = {0u, 0u, 0u, 0u}; if ((c0 >> 7) == (hc & 1)) o3 = cvt8(G_sub_keys + (size_t)r * 128 + (c0 & 127), 1.f);
            *(GAS v4u*)(G_AEXP + (size_t)i * 8) = o3; }
        for (int i = gt; i < 4 * 256 * 256 / 8; i += NGT) {
            const int g = i / (256 * 256 / 8), d0 = (i % 32) * 8; const float* ps = G_pool_scale + g * 256 + d0; const float* p = G_pool_w + (size_t)i * 8;
            v4u o; o.x = pk2(p[0] * ps[0], p[1] * ps[1]); o.y = pk2(p[2] * ps[2], p[3] * ps[3]); o.z = pk2(p[4] * ps[4], p[5] * ps[5]); o.w = pk2(p[6] * ps[6], p[7] * ps[7]);
            *(GAS v4u*)(G_PB + (size_t)i * 8) = o; }
        __syncthreads();
    }
    SEAM(0);

    if (IN(1)) for (int rep_ = 0; rep_ < (((DUP_MASK >> 1) & 1) ? args.pad + 1 : 1); ++rep_) {
        pg8::Gemm g{G_XN, G_W_IN, DM, DM, DM}; pg8::GSched S; S.init(TOK / 256, 4096 / 256, G, bx, DM, DM);
        pg8::EpiStoreT<true> E{G_PROJ, 4096, 0, 0, 1, nullptr, 1.f, 4, 8, 0.08838834764831845f * LOG2E, (unsigned*)G_ctl + CW_NRM};
        pg8::gemm_phase<pg8::EpiStoreT<true>, pg8::GSched, true>(ldsL, g, S, E);
    }
    SEAM(1);

    if (IN(2)) for (int rep_ = 0; rep_ < (((DUP_MASK >> 2) & 1) ? args.pad + 1 : 1); ++rep_) {
        for (int it = vcu; it < TOK / 32; it += G) {
            const int ch = (tid & 127) * 8, rsub = tid >> 7, r0 = it * 32 + rsub * 8, w = 2 << (ch >> 8);
            const int s0 = r0 % SEQ;
            float acc[8];
#pragma unroll
            for (int e = 0; e < 8; ++e) acc[e] = 0.f;
            for (int k = 1; k < w; ++k) { if (s0 - k >= 0) { const v4u v = *(const GAS v4u*)(G_PROJ + (size_t)(r0 - k) * 4096 + ch);
#pragma unroll
                    for (int e = 0; e < 4; ++e) { acc[2 * e] += __uint_as_float(v[e] << 16); acc[2 * e + 1] += __uint_as_float(v[e] & 0xffff0000u); } } }
            for (int rr = 0; rr < 8; ++rr) {
                const v4u v = *(const GAS v4u*)(G_PROJ + (size_t)(r0 + rr) * 4096 + ch); float cur[8];
#pragma unroll
                for (int e = 0; e < 4; ++e) { cur[2 * e] = __uint_as_float(v[e] << 16); cur[2 * e + 1] = __uint_as_float(v[e] & 0xffff0000u); }
                const int sp = s0 + rr; const float inv = 1.f / (float)((sp + 1 < w) ? sp + 1 : w);
                v4u o;
#pragma unroll
                for (int e = 0; e < 8; ++e) acc[e] += cur[e];
                o.x = pk2(acc[0] * inv - cur[0], acc[1] * inv - cur[1]); o.y = pk2(acc[2] * inv - cur[2], acc[3] * inv - cur[3]);
                o.z = pk2(acc[4] * inv - cur[4], acc[5] * inv - cur[5]); o.w = pk2(acc[6] * inv - cur[6], acc[7] * inv - cur[7]);
                *(GAS v4u*)(G_AMIX + (size_t)(r0 + rr) * DM + ch) = o;
                if (sp - w + 1 >= 0) { const v4u vo = *(const GAS v4u*)(G_PROJ + (size_t)(r0 + rr - w + 1) * 4096 + ch);
#pragma unroll
                    for (int e = 0; e < 4; ++e) { acc[2 * e] -= __uint_as_float(vo[e] << 16); acc[2 * e + 1] -= __uint_as_float(vo[e] & 0xffff0000u); } }
            }
        }
        const int a_bh = vcu >> 4, a_qb = vcu & 15;
        if (a_qb < 8 && vcu < 256) {
            const int e = a_qb < 2 ? a_bh * 2 + a_qb : 32 + a_bh * 6 + (a_qb - 2);
            pg8::Gemm g; pg8::EpiStore E{nullptr, DM, 0, 0, 1, nullptr, 1.f, 0, 0, 1.f, nullptr};
            int pm, pn;
            if (e < 16)      { pm = e >> 3; pn = e & 7; g = pg8::Gemm{G_MN, G_WK, DM, DM, DM}; E.O = G_KX; E.ldc = DM; }
            else if (e < 32) { const int q = e - 16; pm = q >> 3; pn = q & 7; g = pg8::Gemm{G_MN, G_WV, DM, DM, DM}; E.O = G_VXT; E.ldc = DM; }
            else if (e < 96) { const int q = e - 32; pm = q >> 3; pn = q & 7; g = pg8::Gemm{G_AEXP, G_WPQ + pm * 256, 256, 256, DM}; E.O = G_WSC; E.ldc = DM; }
            else             { const int q = e - 96; const int gg = q >> 3; pm = q & 7; pn = 0;
                               g = pg8::Gemm{G_WO1 + gg * 256, G_PB + (size_t)gg * 65536, 256, DM, 256}; E.O = G_WO2 + gg * 256; E.ldc = DM; }
            const pg8::OneSched S1{pm, pn, (long)pm * 256 * g.lda, (long)pn * 256 * g.ldb};
            pg8::gemm_phase<pg8::EpiStore, pg8::OneSched, false>(ldsL, g, S1, E);
        }
        if (vcu < 256) {
            const int b = a_bh >> 3, h = a_bh & 7;
            float* c_lds = (float*)(lds + fox::LDS_C);
            if (wave == 0) {
                const float* lf = G_LF + (size_t)a_bh * SEQ + lane * 64; float loc[64]; float run = 0.f;
#pragma unroll
                for (int i = 0; i < 16; ++i) { const f32x4 v = *(const f32x4*)(lf + 4 * i);
#pragma unroll
                    for (int e = 0; e < 4; ++e) { run += v[e]; loc[4 * i + e] = run; } }
                float incl = run;
#pragma unroll
                for (int o = 1; o < 64; o <<= 1) { const float t = __shfl_up(incl, o); if (lane >= o) incl += t; }
                const float excl = incl - run;
#pragma unroll
                for (int i = 0; i < 16; ++i) { f32x4 v;
#pragma unroll
                    for (int e = 0; e < 4; ++e) v[e] = (loc[4 * i + e] + excl) * LOG2E;
                    *(f32x4*)(c_lds + lane * 64 + 4 * i) = v; }
            }
            __syncthreads();
            const bf16* Qb = G_PROJ + (size_t)(b * SEQ) * 4096 + 1024 + h * 128;
            fox::BlockRef cur{Qb + (size_t)(a_qb * 256) * 4096, Qb + 1024, Qb + 2048, G_AMIX + (size_t)(b * SEQ + a_qb * 256) * DM + 1024 + h * 128, a_qb * 256};
            int j_lo = 0;
            { const unsigned* nq = (const unsigned*)G_ctl + CW_NRM + (b * 8 + h) * 4; const unsigned* nk = nq + 64; float B = 0.f;
#pragma unroll
              for (int c4 = 0; c4 < 4; ++c4) B += sqrtf(__uint_as_float(__hip_atomic_load(nq + c4, __ATOMIC_RELAXED, __HIP_MEMORY_SCOPE_AGENT)) * __uint_as_float(__hip_atomic_load(nk + c4, __ATOMIC_RELAXED, __HIP_MEMORY_SCOPE_AGENT)));
              const float thr = 2.05f * B + c_lds[a_qb * 256] + 150.f;
              while (j_lo < a_qb * 4 && c_lds[64 * j_lo + 63] > thr) ++j_lo; }
            fox::Seam S;
            fox::prime(cur, j_lo, (char*)lds, S);
            fox::block(cur, cur, j_lo, (char*)lds, S);
            asm volatile("s_waitcnt vmcnt(0)" ::: "memory");
            __syncthreads();
        }
        {
            constexpr int C_T = (DM / 64) * (DM / 32) / 8, NCHUNK = C_T + QSPLIT;
            LAS float* scr = (LAS float*)(ldsL + wave * 8704);
            __syncthreads();
            if (tid == 0) MISC[16] = atomicAdd(G_ctl + CW_QUEUE, 1u);
            for (int par = 0;; par ^= 1) {
                __syncthreads();
                const int c = (int)MISC[16 + par];
                if (c >= NCHUNK) break;
                unsigned nxt_ = 0u; if (tid == 0) nxt_ = atomicAdd(G_ctl + CW_QUEUE, 1u);
                if (c < C_T) { p0_transpose_item(G_xwo, DM, DM / 32, nullptr, G_WO, nullptr, 0, DM, scr, c * 8 + wave, lane); }
                else { TABLE_CHUNK(c - C_T); }
                if (tid == 0) MISC[17 - par] = nxt_;
            }
        }
    }
    SEAM(2);

    if (IN(3)) for (int rep_ = 0; rep_ < (((DUP_MASK >> 3) & 1) ? args.pad + 1 : 1); ++rep_) {
        { pg8::Gemm g{G_AMIX, G_WO2, DM, DM, DM}; pg8::GSched S; S.init(TOK / 256, DM / 256, G, bx, DM, DM);
          pg8::EpiResid<false> E{G_x, G_HB, rep_ ? nullptr : G_SS1, 0};
          pg8::gemm_phase<pg8::EpiResid<false>, pg8::GSched, true>(ldsL, g, S, E); }
        if (bx < 64) {
            const int f = bx & 63, b = f >> 5, h = (f >> 3) & 3, t = f & 7;
            pg8::Gemm g{G_KX + (size_t)(b * NMEM) * DM + h * XD, G_WQ + h * XD, XD, DM, DM};
            pg8::EpiStore E{G_W1 + (size_t)(b * 1024 + h * 256) * DM, DM, 0, 0, 1, nullptr, 1.f, 0, 0, 1.f, nullptr};
            const pg8::OneSched S1{0, t, 0, (long)t * 256 * DM};
            pg8::gemm_phase<pg8::EpiStore, pg8::OneSched, false>(ldsL, g, S1, E);
        }
    }
    SEAM(3);

    if (IN(4)) for (int rep_ = 0; rep_ < (((DUP_MASK >> 4) & 1) ? args.pad + 1 : 1); ++rep_) {
        pg8::Gemm g{G_HB, G_W1, DM, DM, DM}; pg8::GSched S; S.init(SEQ / 256, XH, G, bx, DM, DM);
        S.nH = 1; S.nZ = BATCH; S.sAb = (long)SEQ * DM; S.sBb = (long)1024 * DM;
        pg8::EpiSoftmax E{G_PP, 1024, (long)SEQ * 1024, 0, 1, G_SS1, 0.044194173824159216f * LOG2E, SEQ};
        pg8::gemm_phase<pg8::EpiSoftmax, pg8::GSched, false>(ldsL, g, S, E);
        if (bx >= 128 && bx < 192) {
            const int f = bx & 63, b = f >> 5, h = (f >> 3) & 3, t = f & 7;
            pg8::Gemm g2{G_WO + h * XD, G_VXT + (size_t)(b * NMEM) * DM + h * XD, XD, DM, DM};
            pg8::EpiStore E2{G_W2 + (size_t)b * DM * 1024 + h * 256, 1024, 0, 0, 1, nullptr, 1.f, 0, 0, 1.f, nullptr};
            const pg8::OneSched S2{t, 0, (long)t * 256 * DM, 0};
            pg8::gemm_phase<pg8::EpiStore, pg8::OneSched, false>(ldsL, g2, S2, E2);
        }
        for (;;) {
            __syncthreads();
            if (tid == 0) MISC[16] = atomicAdd(G_ctl + CW_QUEUE2, 1u);
            __syncthreads();
            const int c = (int)MISC[16] + QSPLIT;
            if (c >= 2 * PEXP / 32) break;
            TABLE_CHUNK(c);
        }
    }
    SEAM(4);

    if (IN(5)) for (int rep_ = 0; rep_ < (((DUP_MASK >> 5) & 1) ? args.pad + 1 : 1); ++rep_) {
        pg8::Gemm g{G_PP, G_W2, 1024, 1024, 1024}; pg8::GSched S; S.init(SEQ / 256, DM / 256, G, bx, 1024, 1024);
        S.nH = 1; S.nZ = BATCH; S.sAb = (long)SEQ * 1024; S.sBb = (long)DM * 1024;
        pg8::EpiResid<true> E{G_HB, G_HB, G_SS2, SEQ};
        pg8::gemm_phase<pg8::EpiResid<true>, pg8::GSched, true>(ldsL, g, S, E);
    }
    SEAM(5);

    if (IN(6)) for (int rep_ = 0; rep_ < (((DUP_MASK >> 6) & 1) ? args.pad + 1 : 1); ++rep_) {
        pg8::Gemm g{G_WSC, G_HB, DM, DM, DM}; pg8::GSched S; S.init(DM / 256, TOK / 256, G, bx, DM, DM);
        pg8::EpiF32Col E{G_SCT, TOK, G_SS2};
        pg8::gemm_phase<pg8::EpiF32Col, pg8::GSched, true>(ldsL, g, S, E);
    }
    SEAM(6);

#if defined(PROBE_SEL) && PROBE_SEL >= 7
    if (bx == 0 && tid == 0) __hip_atomic_store((unsigned long long*)(G_ctl + 258), (unsigned long long)__builtin_amdgcn_s_memrealtime(), __ATOMIC_RELAXED, __HIP_MEMORY_SCOPE_AGENT);
#endif
    if (IN(7)) for (int rep_ = 0; rep_ < (((DUP_MASK >> 7) & 1) ? args.pad + 1 : 1); ++rep_) {
        LAS unsigned* TOP1 = (LAS unsigned*)ldsL;
        LAS unsigned* RIDX = (LAS unsigned*)(ldsL + 32768);
        LAS float* RGATE = (LAS float*)(ldsL + 49152);
        for (int blk = vcu; blk < TOK / 32; blk += G) {
            const int t0 = blk * 32;
            {
                const int tok = tid & 31, grp = tid >> 5;
                const float* sp = G_SCT + ((size_t)blk * DM + grp * 128) * 32 + tok;
                unsigned lst[16];
#pragma unroll
                for (int j = 0; j < 16; ++j) lst[j] = 0u;
                for (int i0 = 0; i0 < 128; i0 += 32) {
                    float v[32];
#pragma unroll
                    for (int e = 0; e < 32; ++e) v[e] = __builtin_nontemporal_load(sp + (i0 + e) * 32);
#pragma unroll
                    for (int c16 = 0; c16 < 2; ++c16) { unsigned nw[16];
#pragma unroll
                        for (int e = 0; e < 16; ++e) nw[e] = (fkey(v[c16 * 16 + e]) & ~127u) | (unsigned)(127 - (i0 + c16 * 16 + e));
#pragma unroll
                        for (int k = 2; k <= 16; k <<= 1)
#pragma unroll
                            for (int j = k >> 1; j > 0; j >>= 1)
#pragma unroll
                                for (int i = 0; i < 16; ++i) { const int l = i ^ j; if (l > i) { const unsigned lo_ = min(nw[i], nw[l]), hi_ = max(nw[i], nw[l]); if ((i & k) == 0) { nw[i] = lo_; nw[l] = hi_; } else { nw[i] = hi_; nw[l] = lo_; } } }
#pragma unroll
                        for (int i = 0; i < 16; ++i) lst[i] = max(lst[i], nw[i]);
#pragma unroll
                        for (int j = 8; j > 0; j >>= 1)
#pragma unroll
                            for (int i = 0; i < 16; ++i) { const int l = i ^ j; if (l > i) { const unsigned lo_ = min(lst[i], lst[l]), hi_ = max(lst[i], lst[l]); lst[i] = hi_; lst[l] = lo_; } } }
                }
                LAS unsigned* dst = TOP1 + (tok * 16 + grp) * 16;
#pragma unroll
                for (int j = 0; j < 16; j += 4) *(LAS v4u*)(dst + j) = (v4u){lst[j], lst[j + 1], lst[j + 2], lst[j + 3]};
            }
            __syncthreads();
            if (tid < 256) {
                const int tok = tid & 31, head = tid >> 5;
                const LAS unsigned* ka = TOP1 + (tok * 16 + head * 2) * 16; const LAS unsigned* kb = ka + 16;
                float af[16], bfv[16];
#pragma unroll
                for (int j = 0; j < 16; ++j) { af[j] = fdec(ka[j] & ~127u); bfv[j] = fdec(kb[j] & ~127u); }
                unsigned best[16];
#pragma unroll
                for (int j = 0; j < 16; ++j) best[j] = 0u;
#pragma unroll
                for (int i = 0; i < 16; ++i)
#pragma unroll
                    for (int j = 0; j < 16; ++j) if ((i + 1) * (j + 1) <= 16) {
                        unsigned xk = (fkey(af[i] + bfv[j]) & ~255u) | (unsigned)(255 - (i * 16 + j));
#pragma unroll
                        for (int q = 0; q < 16; ++q) { const unsigned hi_ = max(best[q], xk); xk = min(best[q], xk); best[q] = hi_; } }
                float ev[16]; const float m0 = fdec(best[0] & ~255u); float sum = 0.f;
#pragma unroll
                for (int q = 0; q < 16; ++q) { ev[q] = __expf(fdec(best[q] & ~255u) - m0); sum += ev[q]; }
                const float inv = 1.f / sum;
#pragma unroll
                for (int q = 0; q < 16; ++q) { const unsigned code = 255u - (best[q] & 255u); const unsigned i = code >> 4, j = code & 15u;
                    const unsigned ia = 127u - (ka[i] & 127u), ib = 127u - (kb[j] & 127u);
                    RIDX[tok * 128 + head * 16 + q] = ia * 128u + ib; RGATE[tok * 128 + head * 16 + q] = ev[q] * inv; }
            }
            __syncthreads();
            {
                LAS unsigned* SIDX = (LAS unsigned*)ldsL; LAS unsigned* SGATE = (LAS unsigned*)(ldsL + 16384);
                const int tok = tid >> 4; const LAS unsigned* src = RIDX + tok * 128;
                unsigned mine[8]; unsigned rank[8];
#pragma unroll
                for (int i = 0; i < 8; ++i) { mine[i] = (src[(tid & 15) + 16 * i] << 7) | (unsigned)((tid & 15) + 16 * i); rank[i] = 0u; }
                for (int j0 = 0; j0 < 128; j0 += 4) { const v4u o4 = *(const LAS v4u*)(src + j0);
#pragma unroll
                    for (int jj = 0; jj < 4; ++jj) { const unsigned oj = ((jj == 0 ? o4.x : jj == 1 ? o4.y : jj == 2 ? o4.z : o4.w) << 7) | (unsigned)(j0 + jj);
#pragma unroll
                        for (int i = 0; i < 8; ++i) rank[i] += (oj < mine[i]) ? 1u : 0u; } }
#pragma unroll
                for (int i = 0; i < 8; ++i) mine[i] >>= 7;
#pragma unroll
                for (int i = 0; i < 8; ++i) { const unsigned pos = rank[i];
                    SIDX[tok * 128 + pos] = mine[i];
                    const float su_ = G_SU[mine[i]], gs_ = RGATE[tok * 128 + (tid & 15) + 16 * i] * G_SV[mine[i]];
                    SGATE[tok * 128 + pos] = (__float_as_uint(su_) & 0xffff0000u) | f2bf(gs_); }
            }
            __syncthreads();
            {
                const int tok0 = wave * 4; const size_t tg0 = (size_t)(t0 + tok0);
                LAS float* Wl = (LAS float*)(ldsL + 32768) + tok0 * 128;
                unsigned xn0[16], xn1[16], xn2[16], xn3[16];
#define XNLOAD(T_, XN) do { const float rs = __builtin_amdgcn_rsqf(G_SS2[tg0 + (T_)] * (1.f / DM) + EPS); \
        _Pragma("unroll") for (int q = 0; q < 8; ++q) { const size_t d0 = (size_t)q * 256 + lane * 4; \
            const v2u ha = *(const GAS v2u*)(G_HB + (tg0 + (T_)) * DM + d0); const f32x4 ga = *(const f32x4*)(G_peer_norm + d0); \
            XN[q * 2] = pk2(__uint_as_float(ha.x << 16) * rs * ga[0], __uint_as_float(ha.x & 0xffff0000u) * rs * ga[1]); XN[q * 2 + 1] = pk2(__uint_as_float(ha.y << 16) * rs * ga[2], __uint_as_float(ha.y & 0xffff0000u) * rs * ga[3]); } } while (0)
                XNLOAD(0, xn0); XNLOAD(1, xn1); XNLOAD(2, xn2); XNLOAD(3, xn3);
#undef XNLOAD
                const LAS unsigned* ridx0 = (const LAS unsigned*)ldsL + tok0 * 128; const LAS unsigned* rgs0 = (const LAS unsigned*)(ldsL + 16384) + tok0 * 128;
                const __amdgpu_buffer_rsrc_t rsT = __builtin_amdgcn_make_buffer_rsrc((void*)G_UB, 0, 64 << 20, 0x00020000);
                v4u raX0, raX1, raX2, raX3, raY0, raY1, raY2, raY3; v2u rbX0, rbX1, rbX2, rbX3, rbY0, rbY1, rbY2, rbY3;
                unsigned sgX0, sgX1, sgX2, sgX3, sgY0, sgY1, sgY2, sgY3;
#define PLDU(S, T, k) do { const unsigned ex_ = (unsigned)__builtin_amdgcn_readfirstlane((int)ridx0[(T) * 128 + (k)]); sg##S = rgs0[(T) * 128 + (k)]; \
        ra##S = __builtin_bit_cast(v4u, __builtin_amdgcn_raw_buffer_load_b128(rsT, lane * 16, ex_ * 1536u, 0)); rb##S = __builtin_bit_cast(v2u, __builtin_amdgcn_raw_buffer_load_b64(rsT, lane * 8 + 1024, ex_ * 1536u, 0)); } while (0)
                const int rowl = lane >> 4; const int wl_off = (rowl == 0 ? 0 : rowl == 1 ? 256 : rowl == 2 ? 128 : 384);
#define STEP1(C, P, k, HASNEXT) do { \
        const float d0_ = peer_dot(ra##C##0, rb##C##0, xn0), d1_ = peer_dot(ra##C##1, rb##C##1, xn1), d2_ = peer_dot(ra##C##2, rb##C##2, xn2), d3_ = peer_dot(ra##C##3, rb##C##3, xn3); \
        const unsigned sgr_ = rowl == 0 ? sg##C##0 : rowl == 1 ? sg##C##2 : rowl == 2 ? sg##C##1 : sg##C##3; \
        if (HASNEXT) { PLDU(P##0, 0, (k) + 1); PLDU(P##1, 1, (k) + 1); PLDU(P##2, 2, (k) + 1); PLDU(P##3, 3, (k) + 1); } \
        const auto s01_ = __builtin_amdgcn_permlane32_swap(__float_as_uint(d0_), __float_as_uint(d1_), false, false); const auto s23_ = __builtin_amdgcn_permlane32_swap(__float_as_uint(d2_), __float_as_uint(d3_), false, false); \
        const float p_ = __uint_as_float(s01_[0]) + __uint_as_float(s01_[1]), q_ = __uint_as_float(s23_[0]) + __uint_as_float(s23_[1]); \
        const auto spq_ = __builtin_amdgcn_permlane16_swap(__float_as_uint(p_), __float_as_uint(q_), false, false); \
        float r_ = __uint_as_float(spq_[0]) + __uint_as_float(spq_[1]); \
        r_ += __builtin_bit_cast(float, __builtin_amdgcn_update_dpp(0, __builtin_bit_cast(int, r_), 0xB1, 0xf, 0xf, true)); r_ += __builtin_bit_cast(float, __builtin_amdgcn_update_dpp(0, __builtin_bit_cast(int, r_), 0x4E, 0xf, 0xf, true)); \
        r_ += __builtin_bit_cast(float, __builtin_amdgcn_update_dpp(0, __builtin_bit_cast(int, r_), 0x141, 0xf, 0xf, true)); r_ += __builtin_bit_cast(float, __builtin_amdgcn_update_dpp(0, __builtin_bit_cast(int, r_), 0x140, 0xf, 0xf, true)); \
        const float w_ = gelu_f(r_ * __uint_as_float(sgr_ & 0xffff0000u)) * __uint_as_float(sgr_ << 16); \
        if ((lane & 15) == 0) Wl[wl_off + (k)] = w_; } while (0)
                PLDU(X0, 0, 0); PLDU(X1, 1, 0); PLDU(X2, 2, 0); PLDU(X3, 3, 0);
                for (int k = 0; k < 126; k += 2) { STEP1(X, Y, k, true); STEP1(Y, X, k + 1, true); }
                STEP1(X, Y, 126, true); STEP1(Y, X, 127, false);
#undef PLDU
#undef STEP1
#define PLDV(S, T, k) do { const unsigned ex_ = (unsigned)__builtin_amdgcn_readfirstlane((int)ridx0[(T) * 128 + (k)]); \
        ra##S = __builtin_bit_cast(v4u, __builtin_amdgcn_raw_buffer_load_b128(rsT, lane * 16, ex_ * 1536u + (32u << 20), 0)); rb##S = __builtin_bit_cast(v2u, __builtin_amdgcn_raw_buffer_load_b64(rsT, lane * 8 + 1024, ex_ * 1536u + (32u << 20), 0)); } while (0)
#define STEP2(C, N, k, HASNEXT) do { asm volatile("" ::: "memory");     \
        if (HASNEXT) { PLDV(N##0, 0, (k) + 2); PLDV(N##1, 1, (k) + 2); PLDV(N##2, 2, (k) + 2); PLDV(N##3, 3, (k) + 2); } \
        const float w0_ = Wl[(k)], w1_ = Wl[128 + (k)], w2_ = Wl[256 + (k)], w3_ = Wl[384 + (k)]; \
        peer_axpy_h(ra##C##0, rb##C##0, w0_, oh0); peer_axpy_h(ra##C##1, rb##C##1, w1_, oh1); peer_axpy_h(ra##C##2, rb##C##2, w2_, oh2); peer_axpy_h(ra##C##3, rb##C##3, w3_, oh3); } while (0)
                unsigned oh0[16], oh1[16], oh2[16], oh3[16];
                v4u raZ0, raZ1, raZ2, raZ3; v2u rbZ0, rbZ1, rbZ2, rbZ3;
#pragma unroll
                for (int e = 0; e < 16; ++e) { oh0[e] = 0u; oh1[e] = 0u; oh2[e] = 0u; oh3[e] = 0u; }
                PLDV(X0, 0, 0); PLDV(X1, 1, 0); PLDV(X2, 2, 0); PLDV(X3, 3, 0); PLDV(Y0, 0, 1); PLDV(Y1, 1, 1); PLDV(Y2, 2, 1); PLDV(Y3, 3, 1);
#pragma unroll 1
                for (int k = 0; k < 126; k += 3) { STEP2(X, Z, k, true); STEP2(Y, X, k + 1, true); STEP2(Z, Y, k + 2, true); }
                STEP2(X, Z, 126, false); STEP2(Y, X, 127, false);
                for (int tt = 0; tt < 4; tt += 2) {
                    float oaccA[32], oaccB[32];
#pragma unroll
                    for (int e = 0; e < 16; ++e) { const unsigned ua_ = tt ? oh2[e] : oh0[e], ub_ = tt ? oh3[e] : oh1[e];
                        oaccA[2 * e] = h16lo(ua_); oaccA[2 * e + 1] = h16hi(ua_); oaccB[2 * e] = h16lo(ub_); oaccB[2 * e + 1] = h16hi(ub_); }
#define FINISH(T_, OACC) do { float s_ = 0.f; \
        _Pragma("unroll") for (int q = 0; q < 8; ++q) { const size_t d0 = (size_t)q * 256 + lane * 4; const v2u hb = *(const GAS v2u*)(G_HB + (T_) * DM + d0); \
            const f32x4 a = {__uint_as_float(hb.x << 16), __uint_as_float(hb.x & 0xffff0000u), __uint_as_float(hb.y << 16), __uint_as_float(hb.y & 0xffff0000u)}; \
            _Pragma("unroll") for (int e = 0; e < 4; ++e) { const float y = a[e] + OACC[q * 4 + e]; OACC[q * 4 + e] = y; s_ += y * y; } } \
        const float rstd_ = __builtin_amdgcn_rsqf(wave_sum_dpp(s_) * (1.f / DM) + EPS); \
        _Pragma("unroll") for (int q = 0; q < 8; ++q) { const size_t d0 = (size_t)q * 256 + lane * 4; const f32x4 ga = *(const f32x4*)(G_final_norm + d0); f32x4 o; \
            _Pragma("unroll") for (int e = 0; e < 4; ++e) o[e] = OACC[q * 4 + e] * rstd_ * ga[e]; \
            PROBE_EXPORT(T_, q); \
            __builtin_nontemporal_store(o, (f32x4*)(args.out + (T_) * DM + d0)); } } while (0)
                    FINISH(tg0 + tt, oaccA); FINISH(tg0 + tt + 1, oaccB);
                }
#undef FINISH
#undef PLDV
#undef STEP2
            }
            __syncthreads();
#if defined(PROBE_SEL) && PROBE_SEL >= 7
            asm volatile("s_waitcnt vmcnt(0)" ::: "memory"); __syncthreads();
            if (tid == 0) { __threadfence(); const unsigned old_ = atomicAdd(G_ctl + 192, 1u);
                if (old_ == (unsigned)G - 1u) { __threadfence(); const unsigned long long a_ = __hip_atomic_load((unsigned long long*)(G_ctl + 256 + 2 * (PROBE_SEL - 7)), __ATOMIC_RELAXED, __HIP_MEMORY_SCOPE_AGENT), b_ = __builtin_amdgcn_s_memrealtime();
                    atomicAdd(args.out + (size_t)31 * DM, (float)(b_ - a_) * 0.0001f); } }
#endif
        }
    }
#undef IN
#undef SEAM
#undef G_ws
#undef G_ctl
#undef G_x
#undef G_mem
#undef G_mix_norm
#undef G_w_in
#undef G_b_forget
#undef G_pool_w
#undef G_pool_scale
#undef G_w_out
#undef G_xattn_norm
#undef G_mem_norm
#undef G_xwq
#undef G_xwk
#undef G_xwv
#undef G_xwo
#undef G_peer_norm
#undef G_peer_wq
#undef G_sub_keys
#undef G_peer_u
#undef G_peer_v
#undef G_final_norm
#undef G_W_IN
#undef G_WO1
#undef G_WO2
#undef G_WQ
#undef G_WK
#undef G_WV
#undef G_WO
#undef G_WPQ
#undef G_AEXP
#undef G_W1
#undef G_W2
#undef G_WSC
#undef G_PB
#undef G_MN
#undef G_KX
#undef G_VXT
#undef G_UB
#undef G_VB
#undef G_SU
#undef G_SV
#undef G_XN
#undef G_QX
#undef G_PROJ
#undef G_SCT
#undef G_AMIX
#undef G_OX
#undef G_H
#undef G_HB
#undef G_PP
#undef G_LF
#undef G_SS1
#undef G_SS2

}

constexpr int N_PHASES = 8;
extern "C" void kernel_launch(void* const* d_in, const int* in_sizes, int n_in, void* d_out, int out_size, void* d_ws, size_t ws_size, hipStream_t stream) {
    static int grid = 0;
    if (grid == 0) {
        if (n_in != 20 || in_sizes[0] != TOK * DM || out_size != TOK * DM || ws_size < WS_END) {
            fprintf(stderr, "kernel_launch: unexpected shapes (n_in %d, in0 %d, out %d, ws %zu < %zu)\n", n_in, n_in > 0 ? in_sizes[0] : -1, out_size, ws_size, (size_t)WS_END); grid = -1; return; }
        int dev = 0, cus = 0, per_cu = 0;
        if (hipGetDevice(&dev) != hipSuccess || hipDeviceGetAttribute(&cus, hipDeviceAttributeMultiprocessorCount, dev) != hipSuccess) { grid = -1; return; }
        if (hipFuncSetAttribute((const void*)fwd_kernel, hipFuncAttributeMaxDynamicSharedMemorySize, LDS_BYTES) != hipSuccess) { fprintf(stderr, "kernel_launch: hipFuncSetAttribute failed\n"); grid = -1; return; }
        if (hipOccupancyMaxActiveBlocksPerMultiprocessor(&per_cu, (const void*)fwd_kernel, NTHREADS, LDS_BYTES) != hipSuccess || per_cu < 1) { fprintf(stderr, "kernel_launch: occupancy query says %d\n", per_cu); per_cu = 1; }
        (void)hipGetLastError();
        grid = cus;
        if (grid != 256) fprintf(stderr, "kernel_launch: %d CUs (built for 256)\n", grid);
    }
    if (grid < 0) return;
    (void)hipMemsetAsync((char*)d_ws + WS_CTL, 0, CTL_ZERO_BYTES, stream);
    Args a{};
    for (int i = 0; i < 20; ++i) a.in[i] = (const float*)d_in[i];
    a.out = (float*)d_out; a.ws = (unsigned char*)d_ws; a.pad = DUP_MASK ? 1 : 0;
#if MK_ONE_LAUNCH
    a.ph_lo = 0; a.ph_hi = N_PHASES; a.one_launch = 1;
    void* kargs[] = {&a};
    hipError_t e = hipLaunchCooperativeKernel((const void*)fwd_kernel, dim3(grid), dim3(NTHREADS), kargs, LDS_BYTES, stream);
    if (e != hipSuccess) fprintf(stderr, "kernel_launch: cooperative launch failed: %s\n", hipGetErrorString(e));
#else
    for (int p = 0; p < N_PHASES; ++p) {
        a.ph_lo = p; a.ph_hi = p + 1; a.one_launch = 0;
        hipLaunchKernelGGL(fwd_kernel, dim3(grid), dim3(NTHREADS), LDS_BYTES, stream, a);
    }
#endif
}
```

```cpp
#include <hip/hip_runtime.h>
#include <hip/hip_bf16.h>
#include <cstdio>
#include <cstdint>

#ifndef DUP_MASK
#define DUP_MASK 0
#endif
#ifndef MK_ONE_LAUNCH
#define MK_ONE_LAUNCH 1
#endif

constexpr int BATCH = 2, SEQ = 4096, DM = 2048, TOK = BATCH * SEQ;
constexpr int INC = 4104, POOLW = 1024, FOXH = 8, FOXD = 128;
constexpr int NMEM = 256, XH = 4, XD = 512;
constexpr int PH = 8, PKEYS = 128, PEXP = 16384, TOPK = 16;
constexpr float EPS = 1e-6f;
constexpr float LOG2E = 1.4426950408889634f;

namespace pg8 {
#define PG8_LAS __attribute__((address_space(3)))
typedef unsigned short bf16_t;
typedef short bf16x8 __attribute__((ext_vector_type(8)));
typedef float f32x4 __attribute__((ext_vector_type(4)));
typedef float f32x2 __attribute__((ext_vector_type(2)));
typedef unsigned u32x4 __attribute__((ext_vector_type(4)));
typedef unsigned u32x2 __attribute__((ext_vector_type(2)));
constexpr int BM = 256, BK = 64, HALF = 128, HTB = HALF * BK * 2, STAGE_BYTES = 8 * HTB, NXCD = 8, WGM = 8;

__host__ __device__ __forceinline__ int lds_byte(int r, int c) { const int st = (r >> 4) * 2 + (c >> 5), rr = r & 15, cc = c & 31, ob = rr * 64 + cc * 2; return st * 1024 + (ob ^ (((ob >> 9) & 1) << 5)); }
__host__ __device__ __forceinline__ void stage_rc(int b, int& R, int& C) { const int st = b / 1024, sb = b % 1024, swz = sb ^ (((sb >> 9) & 1) << 5); R = (st >> 1) * 16 + swz / 64; C = (st & 1) * 32 + (swz % 64) / 2; }
__host__ __device__ __forceinline__ int perm32(int rho) { const int n = rho >> 4, i = rho & 15; return 8 * (i >> 2) + 4 * n + (i & 3); }

struct Unit { int pm, pn, z; long aoff, boff; };
struct Gemm { const bf16_t* A; const bf16_t* Bt; int K, lda, ldb; };

struct GSched {
    int nM, nN, nH, nZ, G, c; long sAb, sAh, sBb, sBh; int lda, ldb;
    __device__ __forceinline__ void init(int nM_, int nN_, int G_, int c_, int lda_, int ldb_) { nM = nM_; nN = nN_; nH = 1; nZ = 1; G = G_; c = c_; sAb = sAh = sBb = sBh = 0; lda = lda_; ldb = ldb_; }
    __device__ __forceinline__ bool next(int i, Unit& u) const {
        const long L = (long)i * G + c; const int nwg = nM * nN; if (L >= (long)nwg * nZ) return false;
        const int z = (int)(L / nwg); int wgid = (int)(L % nwg);
        { const int q = nwg / NXCD, r = nwg % NXCD, xcd = wgid % NXCD, off = wgid / NXCD; wgid = (xcd < r ? xcd * (q + 1) : r * (q + 1) + (xcd - r) * q) + off; }
        const int nig = WGM * nN, gid = wgid / nig, fm = gid * WGM, gsz = (nM - fm) < WGM ? (nM - fm) : WGM;
        u.pm = fm + ((wgid % nig) % gsz); u.pn = (wgid % nig) / gsz; u.z = z;
        const int zb = z / nH, zh = z % nH;
        u.aoff = zb * sAb + zh * sAh + (long)u.pm * BM * lda; u.boff = zb * sBb + zh * sBh + (long)u.pn * BM * ldb;
        return true;
    }
    __device__ __forceinline__ void a_ready(const Unit&) const {}
    __device__ __forceinline__ void done(const Unit&) const {}
};

struct OneSched { int pm, pn; long ao, bo;
    __device__ __forceinline__ bool next(int i, Unit& u) const { if (i) return false; u.pm = pm; u.pn = pn; u.z = 0; u.aoff = ao; u.boff = bo; return true; }
    __device__ __forceinline__ void a_ready(const Unit&) const {}
    __device__ __forceinline__ void done(const Unit&) const {} };
__device__ __forceinline__ unsigned cvt_pk_bf16(float lo, float hi) { unsigned r; asm volatile("v_cvt_pk_bf16_f32 %0, %1, %2" : "=v"(r) : "v"(lo), "v"(hi)); return r; }


template <bool NRM> struct EpiStoreT {
    static constexpr bool PERM = true, AFTER_DRAIN = false;
    bf16_t* O; int ldc; long sCb, sCh; int nH;
    const float* ss; float rs_mul;
    int t0, t1; float tscale;
    unsigned* nrm;
    __device__ __forceinline__ void operator()(const f32x4 (&acc)[2][2][4][2], const Unit& u, int wr, int wc, int fr, int fq) const {
        const int row0 = u.pm * BM + wr * 64 + fr, col0 = u.pn * BM + wc * 32 + 8 * fq;
        bf16_t* base = O + (u.z / nH) * sCb + (u.z % nH) * sCh;
        const float ts = (u.pn >= t0 && u.pn < t1) ? tscale : 1.f;
        float mx0 = 0.f, mx1 = 0.f;
#pragma unroll
        for (int ai = 0; ai < 2; ++ai)
#pragma unroll
            for (int m = 0; m < 4; ++m) { const int row = row0 + ai * HALF + m * 16;
                float sc = ts; if (ss) sc *= __builtin_amdgcn_rsqf(ss[row] * (1.f / DM) + EPS) * rs_mul;
                bf16_t* rowp = base + (size_t)row * ldc + col0;
#pragma unroll
                for (int bj = 0; bj < 2; ++bj) { const f32x4 v0 = acc[ai][bj][m][0] * sc, v1 = acc[ai][bj][m][1] * sc;
                    u32x4 w; w.x = cvt_pk_bf16(v0[0], v0[1]); w.y = cvt_pk_bf16(v0[2], v0[3]); w.z = cvt_pk_bf16(v1[0], v1[1]); w.w = cvt_pk_bf16(v1[2], v1[3]);
                    *(u32x4*)(rowp + bj * HALF) = w;
                    if constexpr (NRM) { float q = (v0[0] * v0[0] + v0[1] * v0[1]) + (v0[2] * v0[2] + v0[3] * v0[3]) + (v1[0] * v1[0] + v1[1] * v1[1]) + (v1[2] * v1[2] + v1[3] * v1[3]);
                        q += __shfl_xor(q, 16); q += __shfl_xor(q, 32); if (bj == 0) mx0 = fmaxf(mx0, q); else mx1 = fmaxf(mx1, q); } } }
        if constexpr (NRM) { if (u.pn >= 4 && u.pn < 12) {
#pragma unroll
            for (int o = 1; o < 16; o <<= 1) { mx0 = fmaxf(mx0, __shfl_xor(mx0, o)); mx1 = fmaxf(mx1, __shfl_xor(mx1, o)); }
            if ((threadIdx.x & 63) == 0) { const int kind = u.pn >= 8, b = u.pm >> 4, h2 = ((u.pn - 4) & 3) * 2; unsigned* p = nrm + ((kind * 2 + b) * 8 + h2) * 4 + wc;
                atomicMax(p, __float_as_uint(mx0)); atomicMax(p + 4, __float_as_uint(mx1)); } } }
    }
};
typedef EpiStoreT<false> EpiStore;
template <bool BASE_BF16> struct EpiResid {
    static constexpr bool PERM = true, AFTER_DRAIN = false;
    const void* base; bf16_t* HB; float* ss; int zrows;
    __device__ __forceinline__ void operator()(const f32x4 (&acc)[2][2][4][2], const Unit& u, int wr, int wc, int fr, int fq) const {
        const int row0 = u.z * zrows + u.pm * BM + wr * 64 + fr, col0 = u.pn * BM + wc * 32 + 8 * fq;
#pragma unroll
        for (int ai = 0; ai < 2; ++ai)
#pragma unroll
            for (int m = 0; m < 4; ++m) { const int row = row0 + ai * HALF + m * 16; const size_t off = (size_t)row * DM + col0; float sq = 0.f;
#pragma unroll
                for (int bj = 0; bj < 2; ++bj) {
                    f32x4 b0, b1;
                    if constexpr (BASE_BF16) { const u32x4 r = *(const u32x4*)((const bf16_t*)base + off + bj * HALF);
                        b0 = (f32x4){__uint_as_float(r.x << 16), __uint_as_float(r.x & 0xffff0000u), __uint_as_float(r.y << 16), __uint_as_float(r.y & 0xffff0000u)};
                        b1 = (f32x4){__uint_as_float(r.z << 16), __uint_as_float(r.z & 0xffff0000u), __uint_as_float(r.w << 16), __uint_as_float(r.w & 0xffff0000u)}; }
                    else { b0 = __builtin_nontemporal_load((const f32x4*)((const float*)base + off + bj * HALF)); b1 = __builtin_nontemporal_load((const f32x4*)((const float*)base + off + bj * HALF + 4)); }
                    const f32x4 h0 = b0 + acc[ai][bj][m][0], h1 = b1 + acc[ai][bj][m][1];
                    u32x4 w; w.x = cvt_pk_bf16(h0[0], h0[1]); w.y = cvt_pk_bf16(h0[2], h0[3]); w.z = cvt_pk_bf16(h1[0], h1[1]); w.w = cvt_pk_bf16(h1[2], h1[3]);
                    *(u32x4*)(HB + off + bj * HALF) = w;
                    sq += (h0[0] * h0[0] + h0[1] * h0[1]) + (h0[2] * h0[2] + h0[3] * h0[3]) + (h1[0] * h1[0] + h1[1] * h1[1]) + (h1[2] * h1[2] + h1[3] * h1[3]); }
                sq += __shfl_xor(sq, 16); sq += __shfl_xor(sq, 32);
                if (fq == 0 && ss) atomicAdd(ss + row, sq); }
    }
};
struct EpiF32Col {
    static constexpr bool PERM = true, AFTER_DRAIN = false;
    float* O; int ldc; const float* ss;
    __device__ __forceinline__ void operator()(const f32x4 (&acc)[2][2][4][2], const Unit& u, int wr, int wc, int fr, int fq) const {
        const int row0 = u.pm * BM + wr * 64 + fr, col0 = u.pn * BM + wc * 32 + 8 * fq;
        f32x4 rs[2][2];
#pragma unroll
        for (int bj = 0; bj < 2; ++bj)
#pragma unroll
            for (int n = 0; n < 2; ++n) { const f32x4 s = *(const f32x4*)(ss + col0 + bj * HALF + 4 * n);
#pragma unroll
                for (int e = 0; e < 4; ++e) rs[bj][n][e] = __builtin_amdgcn_rsqf(s[e] * (1.f / DM) + EPS); }
#pragma unroll
        for (int ai = 0; ai < 2; ++ai)
#pragma unroll
            for (int m = 0; m < 4; ++m) { const int key = row0 + ai * HALF + m * 16;
#pragma unroll
                for (int bj = 0; bj < 2; ++bj) { const int tk = col0 + bj * HALF; float* p = O + ((size_t)(tk >> 5) * DM + key) * 32 + (tk & 31);
                    *(f32x4*)p = acc[ai][bj][m][0] * rs[bj][0]; *(f32x4*)(p + 4) = acc[ai][bj][m][1] * rs[bj][1]; } }
    }
};
struct EpiSoftmax {
    static constexpr bool PERM = true, AFTER_DRAIN = true;
    bf16_t* P; int ldc; long sCb, sCh; int nH; const float* ss; float mul; int zrows;
    __device__ __forceinline__ void fused(f32x4 (&acc)[2][2][4][2], const Unit& u, int wr, int wc, int fr, int fq, PG8_LAS unsigned char* lds, int wid, int lane) const {
        PG8_LAS float* Pm = (PG8_LAS float*)lds;
        PG8_LAS float* Ps = (PG8_LAS float*)(lds + 4096);
#pragma unroll
        for (int ai = 0; ai < 2; ++ai)
#pragma unroll
            for (int m = 0; m < 4; ++m) { float mx = -3.0e38f;
                const float rs = __builtin_amdgcn_rsqf(ss[u.z * zrows + u.pm * BM + ai * HALF + wr * 64 + m * 16 + fr] * (1.f / DM) + EPS) * mul;
#pragma unroll
                for (int bj = 0; bj < 2; ++bj)
#pragma unroll
                    for (int n = 0; n < 2; ++n) { const f32x4 x = acc[ai][bj][m][n] * rs; acc[ai][bj][m][n] = x; mx = fmaxf(mx, fmaxf(fmaxf(x[0], x[1]), fmaxf(x[2], x[3]))); }
                mx = fmaxf(mx, __shfl_xor(mx, 16)); mx = fmaxf(mx, __shfl_xor(mx, 32));
                if (fq == 0) Pm[(ai * HALF + wr * 64 + m * 16 + fr) * 4 + wc] = mx; }
        asm volatile("s_waitcnt lgkmcnt(0)" ::: "memory"); __builtin_amdgcn_s_barrier(); asm volatile("" ::: "memory");
#pragma unroll
        for (int ai = 0; ai < 2; ++ai)
#pragma unroll
            for (int m = 0; m < 4; ++m) { const int r = ai * HALF + wr * 64 + m * 16 + fr;
                const f32x4 pm4 = *(const PG8_LAS f32x4*)(Pm + r * 4); const float M = fmaxf(fmaxf(pm4[0], pm4[1]), fmaxf(pm4[2], pm4[3])); float s = 0.f;
#pragma unroll
                for (int bj = 0; bj < 2; ++bj)
#pragma unroll
                    for (int n = 0; n < 2; ++n) { f32x4 x = acc[ai][bj][m][n];
#pragma unroll
                        for (int e = 0; e < 4; ++e) { x[e] = __builtin_amdgcn_exp2f(x[e] - M); s += x[e]; }
                        acc[ai][bj][m][n] = x; }
                s += __shfl_xor(s, 16); s += __shfl_xor(s, 32);
                if (fq == 0) Ps[r * 4 + wc] = s; }
        asm volatile("s_waitcnt lgkmcnt(0)" ::: "memory"); __builtin_amdgcn_s_barrier(); asm volatile("" ::: "memory");
        bf16_t* base = P + (u.z / nH) * sCb + (u.z % nH) * sCh;
        const int row0 = u.pm * BM, col0 = u.pn * BM + wc * 32 + 8 * fq;
#pragma unroll
        for (int ai = 0; ai < 2; ++ai)
#pragma unroll
            for (int m = 0; m < 4; ++m) { const int r = ai * HALF + wr * 64 + m * 16 + fr;
                const f32x4 ps4 = *(const PG8_LAS f32x4*)(Ps + r * 4); const float inv = 1.f / ((ps4[0] + ps4[1]) + (ps4[2] + ps4[3]));
                bf16_t* rowp = base + (size_t)(row0 + r) * ldc + col0;
#pragma unroll
                for (int bj = 0; bj < 2; ++bj) { const f32x4 v0 = acc[ai][bj][m][0] * inv, v1 = acc[ai][bj][m][1] * inv;
                    u32x4 w; w.x = cvt_pk_bf16(v0[0], v0[1]); w.y = cvt_pk_bf16(v0[2], v0[3]); w.z = cvt_pk_bf16(v1[0], v1[1]); w.w = cvt_pk_bf16(v1[2], v1[3]);
                    *(u32x4*)(rowp + bj * HALF) = w; } }
    }
};

template <class Epi, class Sched, bool ALIGN_EPI>
__device__ __forceinline__ void gemm_phase(PG8_LAS unsigned char* lds, const Gemm g, const Sched& S, const Epi& E) {
    const int tid = threadIdx.x, wid = __builtin_amdgcn_readfirstlane(tid >> 6), lane = tid & 63, wr = wid >> 2, wc = wid & 3, fr = lane & 15, fq = lane >> 4;
    const int K = g.K, nt = K / BK;
    unsigned voffA[2], voffB[2];
#pragma unroll
    for (int i = 0; i < 2; ++i) { int R, C; stage_rc(tid * 16 + i * 8192, R, C); const int Rb = Epi::PERM ? ((R & ~31) + perm32(R & 31)) : R;
        voffA[i] = (unsigned)(R * g.lda + C) * 2u; voffB[i] = (unsigned)(Rb * g.ldb + C) * 2u; }
    const size_t kstep = (size_t)(BK * 2);
    const size_t hsA = (size_t)HALF * g.lda * 2, hsB = (size_t)HALF * g.ldb * 2;
    const unsigned ldsw = (unsigned)wid * 1024u;
    const int aoff = lds_byte(wr * 64 + fr, fq * 8), boff = lds_byte(wc * 32 + fr, fq * 8);
#define PG8_SA(b, h) (((b) * 2 + (h)) * HTB)
#define PG8_SB(b, h) ((4 + (b) * 2 + (h)) * HTB)
#define PG8_STAGE(bufoff, gbase, voff) do { _Pragma("unroll") for (int _i = 0; _i < 2; ++_i) \
        __builtin_amdgcn_global_load_lds((const unsigned*)((const char*)(gbase) + (voff)[_i]), (PG8_LAS unsigned*)(lds + (bufoff) + ldsw + _i * 8192), 16, 0, 0); } while (0)
#define PG8_LDA(dst, b, h) do { _Pragma("unroll") for (int m = 0; m < 4; ++m) _Pragma("unroll") for (int k = 0; k < 2; ++k) dst[m][k] = *(const PG8_LAS bf16x8*)(lds + PG8_SA(b, h) + aoff + m * 2048 + k * 1024); } while (0)
#define PG8_LDB(dst, b, h) do { _Pragma("unroll") for (int n = 0; n < 2; ++n) _Pragma("unroll") for (int k = 0; k < 2; ++k) dst[n][k] = *(const PG8_LAS bf16x8*)(lds + PG8_SB(b, h) + boff + n * 2048 + k * 1024); } while (0)
#define PG8_MMA(ai, bj, At, Bt) do { __builtin_amdgcn_s_setprio(1); _Pragma("unroll") for (int m = 0; m < 4; ++m) _Pragma("unroll") for (int n = 0; n < 2; ++n) _Pragma("unroll") for (int k = 0; k < 2; ++k) \
        acc[ai][bj][m][n] = __builtin_amdgcn_mfma_f32_16x16x32_bf16(Bt[n][k], At[m][k], acc[ai][bj][m][n], 0, 0, 0); __builtin_amdgcn_s_setprio(0); } while (0)
#define PG8_WAIT_V(n) asm volatile("s_waitcnt vmcnt(" #n ")" ::: "memory")
#define PG8_WAIT_L(n) asm volatile("s_waitcnt lgkmcnt(" #n ")" ::: "memory")
#define PG8_BAR __builtin_amdgcn_s_barrier()
#define PG8_SCHED __builtin_amdgcn_sched_barrier(0)
    Unit cur, nxt; int ui = 0;
    if (!S.next(0, cur)) return;
    f32x4 acc[2][2][4][2];
#pragma unroll
    for (int a = 0; a < 2; ++a)
#pragma unroll
        for (int b = 0; b < 2; ++b)
#pragma unroll
            for (int m = 0; m < 4; ++m)
#pragma unroll
                for (int n = 0; n < 2; ++n) acc[a][b][m][n] = (f32x4){0.f, 0.f, 0.f, 0.f};
    bf16x8 At[4][2], B0[2][2], B1[2][2];
    const char* cA = (const char*)g.A + (size_t)cur.aoff * 2; const char* cB = (const char*)g.Bt + (size_t)cur.boff * 2;
    S.a_ready(cur);
    PG8_STAGE(PG8_SB(0, 0), cB, voffB); PG8_STAGE(PG8_SB(0, 1), cB + hsB, voffB); PG8_STAGE(PG8_SA(0, 0), cA, voffA); PG8_STAGE(PG8_SA(0, 1), cA + hsA, voffA);
    if (wr == 1) PG8_BAR;
    PG8_WAIT_V(2); PG8_BAR;
    PG8_STAGE(PG8_SB(1, 0), cB + kstep, voffB); PG8_STAGE(PG8_SA(1, 0), cA + kstep, voffA); PG8_STAGE(PG8_SB(1, 1), cB + hsB + kstep, voffB);
    PG8_WAIT_V(6); PG8_BAR;
    for (;;) {
        const bool has_next = S.next(ui + 1, nxt);
        const char* nA = has_next ? (const char*)g.A + (size_t)nxt.aoff * 2 : cA; const char* nB = has_next ? (const char*)g.Bt + (size_t)nxt.boff * 2 : cB;
        for (int t = 0; t < nt; t += 2) {
            const bool last = (t == nt - 2);
            const char* a1 = cA + (size_t)(t + 1) * kstep;
            const char* a2 = last ? nA : cA + (size_t)(t + 2) * kstep; const char* b2 = last ? nB : cB + (size_t)(t + 2) * kstep;
            const char* a3 = a2 + kstep; const char* b3 = b2 + kstep;
            if (last && has_next) S.a_ready(nxt);
            PG8_LDB(B0, 0, 0); PG8_LDB(B1, 0, 1); PG8_SCHED; PG8_LDA(At, 0, 0); PG8_STAGE(PG8_SA(1, 1), a1 + hsA, voffA);
            PG8_WAIT_V(8); PG8_WAIT_L(0); PG8_BAR; PG8_MMA(0, 0, At, B0); PG8_MMA(0, 1, At, B1); PG8_BAR; PG8_SCHED;
            PG8_LDA(At, 0, 1); PG8_STAGE(PG8_SB(0, 0), b2, voffB); PG8_STAGE(PG8_SB(0, 1), b2 + hsB, voffB); PG8_STAGE(PG8_SA(0, 0), a2, voffA);
            PG8_WAIT_V(8); PG8_WAIT_L(0); PG8_BAR; PG8_MMA(1, 0, At, B0); PG8_MMA(1, 1, At, B1); PG8_BAR; PG8_SCHED;
            PG8_LDB(B0, 1, 0); PG8_LDB(B1, 1, 1); PG8_SCHED; PG8_LDA(At, 1, 0); PG8_STAGE(PG8_SA(0, 1), a2 + hsA, voffA);
            PG8_WAIT_V(8); PG8_WAIT_L(0); PG8_BAR; PG8_MMA(0, 0, At, B0); PG8_MMA(0, 1, At, B1); PG8_BAR; PG8_SCHED;
            PG8_LDA(At, 1, 1); PG8_STAGE(PG8_SB(1, 0), b3, voffB); PG8_STAGE(PG8_SB(1, 1), b3 + hsB, voffB); PG8_STAGE(PG8_SA(1, 0), a3, voffA);
            PG8_WAIT_V(8); PG8_WAIT_L(0); PG8_BAR; PG8_MMA(1, 0, At, B0); PG8_MMA(1, 1, At, B1); PG8_BAR; PG8_SCHED;
        }
        if constexpr (ALIGN_EPI) { if (wr == 0) PG8_BAR; }
        if constexpr (!Epi::AFTER_DRAIN) { E(acc, cur, wr, wc, fr, fq); S.done(cur); }
        if (!has_next) break;
#pragma unroll
        for (int a = 0; a < 2; ++a)
#pragma unroll
            for (int b = 0; b < 2; ++b)
#pragma unroll
                for (int m = 0; m < 4; ++m)
#pragma unroll
                    for (int n = 0; n < 2; ++n) acc[a][b][m][n] = (f32x4){0.f, 0.f, 0.f, 0.f};
        cur = nxt; cA = nA; cB = nB; ++ui;
        if constexpr (ALIGN_EPI) { if (wr == 1) PG8_BAR; }
    }
    PG8_WAIT_V(0);
    if constexpr (!ALIGN_EPI) { if (wr == 0) PG8_BAR; }
    PG8_BAR;
    if constexpr (Epi::AFTER_DRAIN) { E.fused(acc, cur, wr, wc, fr, fq, lds, wid, lane); S.done(cur); }
#undef PG8_SA
#undef PG8_SB
#undef PG8_STAGE
#undef PG8_LDA
#undef PG8_LDB
#undef PG8_MMA
#undef PG8_WAIT_V
#undef PG8_WAIT_L
#undef PG8_BAR
#undef PG8_SCHED
}
}

namespace fox {
typedef unsigned short bf16_t;
typedef short bf16x8 __attribute__((ext_vector_type(8)));
typedef short s16x4 __attribute__((ext_vector_type(4)));
typedef float f32x16 __attribute__((ext_vector_type(16)));
typedef float f32x4 __attribute__((ext_vector_type(4)));
typedef unsigned u32x4 __attribute__((ext_vector_type(4)));
constexpr int D = 128, NW = 8, QBLK = 32, KVBLK = 64, QB = NW * QBLK;
constexpr int SHM_V = KVBLK * D * 2, SHM_K = KVBLK * D * 2;
constexpr int LDS_C = 2 * SHM_V + 2 * SHM_K + NW * 64 * 4;
constexpr int LDS_BYTES = LDS_C + SEQ * 4;
constexpr int QP = 4096, OP = 2048;
constexpr float THR = 24.f;
#define KSWZ(row, colB) ((row) * 256 + ((colB) ^ (((row) & 7) << 4)))
#define SBAR() __builtin_amdgcn_sched_barrier(0)
__device__ __forceinline__ int v_st(int k, int c) { const int kk = (k & ~0xC) | ((k & 4) << 1) | ((k & 8) >> 1); return ((kk >> 3) * 4 + (c >> 5)) * 512 + ((kk & 7) * 32 + (c & 31)) * 2; }
__device__ __forceinline__ int v_rd_base(int lane) { return ((lane & 3) << 3) | (((lane >> 2) & 3) << 6) | (((lane >> 4) & 1) << 5) | (((lane >> 5) & 1) << 8); }
constexpr int v_rd_off(int d0, int ks, int half) { return d0 * 512 + ks * 4096 + half * 2048; }
__device__ __forceinline__ int crow(int r, int hi) { return (r & 3) + 8 * (r >> 2) + 4 * hi; }
__device__ __forceinline__ unsigned cvtpk(float lo, float hi) { unsigned r; asm volatile("v_cvt_pk_bf16_f32 %0, %1, %2" : "=v"(r) : "v"(lo), "v"(hi)); return r; }
__device__ __forceinline__ bf16x8 load8(const bf16_t* p) { return *reinterpret_cast<const bf16x8*>(p); }
__device__ __forceinline__ void mask_tile(f32x16& p0, f32x16& p1, int dq) {
    const float NEG = -__builtin_inff();
#pragma unroll
    for (int r = 0; r < 16; ++r) { const int c = (r & 3) + 8 * (r >> 2); if (dq - c < 0) p0[r] = NEG; if (dq - c - 32 < 0) p1[r] = NEG; }
}
__device__ __forceinline__ void bias_tile(f32x16& p0, f32x16& p1, const float* cb) {
#pragma unroll
    for (int i = 0; i < 4; ++i) { const f32x4 c0 = *(const f32x4*)(cb + 8 * i), c1 = *(const f32x4*)(cb + 32 + 8 * i);
#pragma unroll
        for (int j = 0; j < 4; ++j) { p0[4 * i + j] -= c0[j]; p1[4 * i + j] -= c1[j]; } }
}
__device__ __forceinline__ void partialSM(f32x16& p0, f32x16& p1, float& m_reg, float& mn, float& alpha) {
    float pmax = p0[0]; for (int r = 1; r < 16; ++r) pmax = fmaxf(pmax, p0[r]); for (int r = 0; r < 16; ++r) pmax = fmaxf(pmax, p1[r]);
    { auto rr = __builtin_amdgcn_permlane32_swap(__float_as_uint(pmax), __float_as_uint(pmax), false, false);
      pmax = fmaxf(__uint_as_float(rr[0]), __uint_as_float(rr[1])); }
    if (__builtin_expect(__all((pmax - m_reg) <= THR), 1)) { mn = m_reg; alpha = 1.f; }
    else { mn = fmaxf(m_reg, pmax); alpha = __builtin_amdgcn_exp2f(m_reg - mn); m_reg = mn; }
    for (int r = 0; r < 16; ++r) p0[r] = p0[r] - mn; for (int r = 0; r < 16; ++r) p1[r] = p1[r] - mn;
    for (int r = 0; r < 16; ++r) p0[r] = __builtin_amdgcn_exp2f(p0[r]);
}
__device__ __forceinline__ void finishSM(f32x16& p0, f32x16& p1, float alpha, float& l_reg, bf16x8& pa0, bf16x8& pa1, bf16x8& pa2, bf16x8& pa3) {
    for (int r = 0; r < 16; ++r) p1[r] = __builtin_amdgcn_exp2f(p1[r]);
    float ps = 0; for (int r = 0; r < 16; ++r) ps += p0[r]; for (int r = 0; r < 16; ++r) ps += p1[r];
    { auto rr = __builtin_amdgcn_permlane32_swap(__float_as_uint(ps), __float_as_uint(ps), false, false);
      ps = __uint_as_float(rr[0]) + __uint_as_float(rr[1]); }
    l_reg = l_reg * alpha + ps;
#define PK4(P, B_, OUT) do { unsigned a0 = cvtpk(P[B_+0], P[B_+1]), a1 = cvtpk(P[B_+2], P[B_+3]);                          \
        unsigned b0 = cvtpk(P[B_+4], P[B_+5]), b1 = cvtpk(P[B_+6], P[B_+7]);                                             \
        auto r0 = __builtin_amdgcn_permlane32_swap(a0, b0, false, false); auto r1 = __builtin_amdgcn_permlane32_swap(a1, b1, false, false); \
        u32x4 w = {r0[0], r1[0], r0[1], r1[1]}; OUT = *reinterpret_cast<bf16x8*>(&w); } while (0)
    PK4(p0, 0, pa0); PK4(p0, 8, pa1); PK4(p1, 0, pa2); PK4(p1, 8, pa3);
#undef PK4
}
template <int KB>
__device__ __forceinline__ void qkt(f32x16& p0, f32x16& p1, const char* K_lds, int r32, int hi, const bf16x8* qr) {
    p0 = f32x16{}; p1 = f32x16{};
    const char* kb[4];
#pragma unroll
    for (int dd = 0; dd < 4; ++dd) kb[dd] = K_lds + KB * SHM_K + KSWZ(r32, (dd * 16 + hi * 8) * 2);
#pragma unroll
    for (int d0 = 0; d0 < 8; ++d0) { const char* a = kb[d0 & 3] + (d0 >> 2) * 128;
        bf16x8 b0 = *reinterpret_cast<const bf16x8*>(a);
        bf16x8 b1 = *reinterpret_cast<const bf16x8*>(a + 32 * 256);
        p0 = __builtin_amdgcn_mfma_f32_32x32x16_bf16(b0, qr[d0], p0, 0, 0, 0);
        p1 = __builtin_amdgcn_mfma_f32_32x32x16_bf16(b1, qr[d0], p1, 0, 0, 0); }
}
template <int VB>
__device__ __forceinline__ void pv_tile(f32x16* o, int vb0, bf16x8 pa0, bf16x8 pa1, bf16x8 pa2, bf16x8 pa3) {
#define TRRD(dst, off) asm volatile("ds_read_b64_tr_b16 %0, %1 offset:%2" : "=&v"(dst) : "v"(vb0), "i"(off) : "memory")
#define PV_D0(d0) do { s16x4 l0, l1, l2, l3, h0, h1, h2, h3; constexpr int b_ = VB * SHM_V + v_rd_off(d0, 0, 0); \
        TRRD(l0, b_); TRRD(h0, b_ + 2048); TRRD(l1, b_ + 4096); TRRD(h1, b_ + 6144); TRRD(l2, b_ + 8192); TRRD(h2, b_ + 10240); TRRD(l3, b_ + 12288); TRRD(h3, b_ + 14336); \
        asm volatile("s_waitcnt lgkmcnt(0)" ::: "memory"); SBAR();   \
        o[d0] = __builtin_amdgcn_mfma_f32_32x32x16_bf16(pa0, (bf16x8){l0[0], l0[1], l0[2], l0[3], h0[0], h0[1], h0[2], h0[3]}, o[d0], 0, 0, 0);   \
        o[d0] = __builtin_amdgcn_mfma_f32_32x32x16_bf16(pa1, (bf16x8){l1[0], l1[1], l1[2], l1[3], h1[0], h1[1], h1[2], h1[3]}, o[d0], 0, 0, 0);   \
        o[d0] = __builtin_amdgcn_mfma_f32_32x32x16_bf16(pa2, (bf16x8){l2[0], l2[1], l2[2], l2[3], h2[0], h2[1], h2[2], h2[3]}, o[d0], 0, 0, 0);   \
        o[d0] = __builtin_amdgcn_mfma_f32_32x32x16_bf16(pa3, (bf16x8){l3[0], l3[1], l3[2], l3[3], h3[0], h3[1], h3[2], h3[3]}, o[d0], 0, 0, 0); } while (0)
    PV_D0(0); PV_D0(1); PV_D0(2); PV_D0(3);
#undef PV_D0
#undef TRRD
}
struct BlockRef { const bf16_t* Q; const bf16_t* K; const bf16_t* V; bf16_t* O; int P0; };
struct Seam { bf16x8 qr[8]; bf16x8 st_v0, st_v1, st_k0, st_k1; };
#define ROW(p, k0, rr) ((p) + (size_t)((k0) + (rr)) * QP + sc)
#define VMW() asm volatile("s_waitcnt vmcnt(0)" ::: "memory")
#define VMWN(n) asm volatile("s_waitcnt vmcnt(%0)" :: "i"(n) : "memory")
#define SLOAD_H(Kp, Vp, k0) do { S.st_v0 = load8(ROW(Vp, k0, sr)); S.st_v1 = load8(ROW(Vp, k0, 32 + sr)); S.st_k0 = load8(ROW(Kp, k0, sr)); S.st_k1 = load8(ROW(Kp, k0, 32 + sr)); } while (0)
#define SWRITE_HK(bf) do { *(bf16x8*)(K_lds + (bf) * SHM_K + kws) = S.st_k0; *(bf16x8*)(K_lds + (bf) * SHM_K + kws + 32 * 256) = S.st_k1; } while (0)
#define SWRITE_HV(bf) do { *(bf16x8*)(V_lds + (bf) * SHM_V + vst0) = S.st_v0; *(bf16x8*)(V_lds + (bf) * SHM_V + vst1) = S.st_v1; } while (0)
#define SWRITE_H(bf) do { SWRITE_HV(bf); SWRITE_HK(bf); } while (0)
__device__ __forceinline__ void prime(const BlockRef& cur, int j_lo, char* lds, Seam& S) {
    const int tid = threadIdx.x, wid = __builtin_amdgcn_readfirstlane(tid >> 6), lane = tid & 63, r32 = lane & 31, hi = lane >> 5;
    const int sr = tid >> 4, sc = (tid & 15) * 8, kws = KSWZ(sr, sc * 2); char* K_lds = lds + 2 * SHM_V;
    for (int d0 = 0; d0 < 8; ++d0) S.qr[d0] = load8(cur.Q + (size_t)(wid * QBLK + r32) * QP + d0 * 16 + hi * 8);
    SLOAD_H(cur.K, cur.V, j_lo * KVBLK); VMW(); SWRITE_HK(0);
    __syncthreads();
}
__device__ __forceinline__ void block(const BlockRef& cur, const BlockRef& nxt, int j_lo, char* lds, Seam& S) {
    const int tid = threadIdx.x, wid = __builtin_amdgcn_readfirstlane(tid >> 6), lane = tid & 63, r32 = lane & 31, hi = lane >> 5;
    const int NT = (cur.P0 + QB - 1) / KVBLK + 1 - j_lo;
    const int qlo = cur.P0 + wid * QBLK, qm = qlo + r32 - 4 * hi;
    char* V_lds = lds; char* K_lds = lds + 2 * SHM_V;
    float* ws = (float*)(lds + 2 * SHM_V + 2 * SHM_K) + wid * 64; float* li_l = ws, * al_l = ws + 32;
    const float* c_lds = (const float*)(lds + LDS_C) + 4 * hi;
    float m_reg = -1e30f, l_reg = 0; f32x16 o[4] = {};
    const int sr = tid >> 4, sc = (tid & 15) * 8, vst0 = v_st(sr, sc), vst1 = v_st(32 + sr, sc), kws = KSWZ(sr, sc * 2);
    const int vb0 = (int)(uintptr_t)V_lds + v_rd_base(lane);
    const bf16_t* Kh = cur.K; const bf16_t* Vh = cur.V;
#define RESC(a) do { if (__any((a) < 1.f)) { if (hi == 0) al_l[r32] = (a); asm volatile("s_waitcnt lgkmcnt(0)" ::: "memory");              \
                     for (int d_ = 0; d_ < 4; ++d_) for (int r = 0; r < 16; ++r) o[d_][r] *= al_l[crow(r, hi)]; } } while (0)
#define KBASE(t) ((j_lo + (t)) * KVBLK)
#define MASKT(P0_, P1_, t) do { const int kb_ = KBASE(t); bias_tile(P0_, P1_, c_lds + kb_); if (kb_ + KVBLK - 1 > qlo) mask_tile(P0_, P1_, qm - kb_); } while (0)
#define SEAM_K0() do { VMWN(8); SWRITE_HK(0); SBAR(); } while (0)
    f32x16 pA0, pA1, pB0, pB1; float mnA, mnB, alA, alB; bf16x8 pa0, pa1, pa2, pa3;
    SWRITE_HV(0); SBAR();
    if (NT > 1) { SLOAD_H(Kh, Vh, KBASE(1)); }
    SBAR(); qkt<0>(pA0, pA1, K_lds, r32, hi, S.qr);
    MASKT(pA0, pA1, 0); partialSM(pA0, pA1, m_reg, mnA, alA);
    if (NT > 1) { VMW(); SWRITE_H(1); }
    __syncthreads();
#define HALF_STEP(PX0, PX1, mnX, alX, PY0, PY1, alY, t, KB, VB, SB) do {                                                      \
        SBAR(); qkt<KB>(PX0, PX1, K_lds, r32, hi, S.qr);                                                                     \
        finishSM(PY0, PY1, alY, l_reg, pa0, pa1, pa2, pa3); SBAR();                                                           \
        if ((t) + 1 < NT) { SLOAD_H(Kh, Vh, KBASE((t) + 1)); SBAR(); }                                                        \
        pv_tile<VB>(o, vb0, pa0, pa1, pa2, pa3); MASKT(PX0, PX1, (t)); partialSM(PX0, PX1, m_reg, mnX, alX);                 \
        __syncthreads();                                                                                                      \
        if ((t) + 1 < NT) { VMW(); SWRITE_H(SB); }                                                                            \
        RESC(alX); __syncthreads(); } while (0)
    for (int t = 1; t + 1 < NT; t += 2) {
        HALF_STEP(pB0, pB1, mnB, alB, pA0, pA1, alA, t, 1, 0, 0);
        HALF_STEP(pA0, pA1, mnA, alA, pB0, pB1, alB, t + 1, 0, 1, 1);
    }
    const bool even = (NT & 1) == 0;
    if (even) { SBAR(); qkt<1>(pB0, pB1, K_lds, r32, hi, S.qr); SBAR(); }
    SLOAD_H(nxt.K, nxt.V, j_lo * KVBLK); SBAR();
#pragma unroll
    for (int d0 = 0; d0 < 8; ++d0) S.qr[d0] = load8(nxt.Q + (size_t)(wid * QBLK + r32) * QP + d0 * 16 + hi * 8);
    SBAR();
    finishSM(pA0, pA1, alA, l_reg, pa0, pa1, pa2, pa3); SBAR();
    pv_tile<0>(o, vb0, pa0, pa1, pa2, pa3);
    if (even) { MASKT(pB0, pB1, NT - 1); partialSM(pB0, pB1, m_reg, mnB, alB); __syncthreads(); RESC(alB);
        finishSM(pB0, pB1, alB, l_reg, pa0, pa1, pa2, pa3); SBAR(); pv_tile<1>(o, vb0, pa0, pa1, pa2, pa3); }
    SBAR(); SEAM_K0();
    if (hi == 0) li_l[r32] = l_reg; asm volatile("s_waitcnt lgkmcnt(0)" ::: "memory");
    float rli[16];
#pragma unroll
    for (int r = 0; r < 16; ++r) rli[r] = __builtin_amdgcn_rcpf(li_l[crow(r, hi)]);
    bf16_t* Ow = cur.O + (size_t)(wid * QBLK) * OP;
#pragma unroll
    for (int r = 0; r < 16; ++r) { const int orow = crow(r, hi);
#pragma unroll
        for (int d0 = 0; d0 < 4; ++d0) { const float v = o[d0][r] * rli[r];
            const float vn = __shfl_xor(v, 1);
            if ((r32 & 1) == 0) *(unsigned*)(Ow + (size_t)orow * OP + d0 * 32 + r32) = cvtpk(v, vn); } }
    __syncthreads();
#undef RESC
#undef KBASE
#undef MASKT
#undef SEAM_K0
#undef HALF_STEP
}
#undef ROW
#undef VMW
#undef VMWN
#undef SLOAD_H
#undef SWRITE_HK
#undef SWRITE_HV
#undef SWRITE_H
#undef KSWZ
#undef SBAR
}

constexpr int NWAVES = 8, NTHREADS = 512;
constexpr int LDS_BYTES = 147456;
constexpr int LDS_MISC = 145408;
constexpr size_t MiB = 1u << 20;
constexpr size_t WS_CTL = 0, CTL_ZERO_BYTES = 1 * MiB;
#ifndef QSPLIT
#define QSPLIT 512
#endif
constexpr int CW_QUEUE2 = 128;
constexpr int CW_NRM = 512;
constexpr int CW_QUEUE = 64;
constexpr int CW_BAR = 4096;
constexpr size_t CTL_SS1 = 256 * 1024, CTL_SS2 = 320 * 1024;
constexpr size_t WS_LF = 1 * MiB;
constexpr size_t WS_SU = 1 * MiB + 512 * 1024, WS_SV = 1 * MiB + 640 * 1024;
constexpr size_t WS_WIN = 2 * MiB, WS_WO1 = 18 * MiB, WS_WO2 = 26 * MiB, WS_WQ = 34 * MiB, WS_WK = 42 * MiB, WS_WV = 50 * MiB, WS_WO = 58 * MiB;
constexpr size_t WS_WPQ = 66 * MiB, WS_AEXP = 74 * MiB, WS_WSC = 82 * MiB, WS_PB = 90 * MiB, WS_MN = 91 * MiB, WS_KX = 93 * MiB, WS_VXT = 95 * MiB;
constexpr size_t WS_UB = 98 * MiB, WS_VB = 130 * MiB, WS_XN = 226 * MiB, WS_PROJ = 258 * MiB, WS_AMIX = 322 * MiB, WS_H = 354 * MiB, WS_HB = 418 * MiB, WS_P = 450 * MiB, WS_END = 466 * MiB;

#define GAS __attribute__((address_space(1)))
#define LAS __attribute__((address_space(3)))
typedef unsigned short bf16;
typedef unsigned v4u __attribute__((ext_vector_type(4)));
typedef unsigned v2u __attribute__((ext_vector_type(2)));
typedef float f32x4 __attribute__((ext_vector_type(4)));
typedef __bf16 bf16x2_t __attribute__((ext_vector_type(2)));
#define LDS_WAIT() asm volatile("s_waitcnt lgkmcnt(0)" ::: "memory")
__device__ __forceinline__ unsigned f2bf(float f) { unsigned u = __builtin_bit_cast(unsigned, f); return (u + 0x7fffu + ((u >> 16) & 1u)) >> 16; }
__device__ __forceinline__ unsigned pk2(float lo, float hi) { return f2bf(lo) | (f2bf(hi) << 16); }
__device__ __forceinline__ float wave_sum(float v) {
#pragma unroll
    for (int o = 1; o < 64; o <<= 1) v += __shfl_xor(v, o);
    return v;
}

#define XB_TMO      128
#define XB_XCNT(j)  (256  + 64 * (j))
#define XB_XSUB(j)  (1280 + 64 * (j))
#define XB_XGEN(j)  (2304 + 64 * (j))
#define XB_TOP      3328
#define XB_TOPGEN   3392
#define XCD_BAR_WORDS 3456
#define XB_SPIN_CAP (1u << 22)
__device__ __forceinline__ unsigned xb_ld(unsigned* p)              { return __hip_atomic_load(p, __ATOMIC_RELAXED, __HIP_MEMORY_SCOPE_AGENT); }
__device__ __forceinline__ unsigned xb_add(unsigned* p, unsigned v) { return __hip_atomic_fetch_add(p, v, __ATOMIC_RELAXED, __HIP_MEMORY_SCOPE_AGENT); }
__device__ __forceinline__ unsigned xb_xcc_id() { return (unsigned)__builtin_amdgcn_s_getreg((3 << 11) | 20) & 0xFu; }
#define XB_SPIN(cond, bar) do { unsigned _sp = 0; while (cond) { __builtin_amdgcn_s_sleep(1); \
    if ((++_sp & 255u) == 0u) { if (xb_ld(&(bar)[XB_TMO])) break; if (_sp > XB_SPIN_CAP) { atomicAdd(&(bar)[XB_TMO], 1u); break; } } } } while (0)
struct XcdBarrier { unsigned* bar; unsigned x; volatile LAS unsigned* st; };
__device__ __forceinline__ XcdBarrier xcd_barrier_post(unsigned* bar, volatile LAS unsigned* st) {
    XcdBarrier b; b.bar = bar; b.x = xb_xcc_id(); b.st = st;
    if (threadIdx.x == 0) (void)xb_add(&bar[XB_XCNT(b.x)], 1u);
    return b;
}
__device__ __forceinline__ void xcd_barrier_complete(unsigned* bar, unsigned x, unsigned& nloc, unsigned& nx) {
    const unsigned G = gridDim.x * gridDim.y * gridDim.z;
    unsigned sum, cnt, mine, sp = 0u;
    for (;;) {
        sum = 0u; cnt = 0u; mine = 0u;
#pragma unroll
        for (unsigned j = 0; j < 16; ++j) { const unsigned c = xb_ld(&bar[XB_XCNT(j)]); sum += c; cnt += (c > 0u) ? 1u : 0u; mine = (j == x) ? c : mine; }
        if (sum == G) break;
        __builtin_amdgcn_s_sleep(1);
        if ((++sp & 255u) == 0u) { if (xb_ld(&bar[XB_TMO])) break; if (sp > XB_SPIN_CAP) { atomicAdd(&bar[XB_TMO], 1u); break; } }
    }
    nloc = mine > 0u ? mine : 1u; nx = cnt > 0u ? cnt : 1u;
}
__device__ __forceinline__ void xcd_barrier(const XcdBarrier& b) {
    asm volatile("s_waitcnt vmcnt(0)" ::: "memory");
    __syncthreads();
    if (threadIdx.x == 0) {
        unsigned* bar = b.bar;
        __builtin_amdgcn_s_waitcnt(0);
        unsigned nloc = b.st[0], nx = b.st[1];
        if (nloc == 0u) { xcd_barrier_complete(bar, b.x, nloc, nx); b.st[0] = nloc; b.st[1] = nx; }
        const unsigned old = xb_add(&bar[XB_XSUB(b.x)], 1u);
        const unsigned gen = old / nloc;
        if (old + 1u == (gen + 1u) * nloc) {
            __builtin_amdgcn_fence(__ATOMIC_RELEASE, "agent");
            asm volatile("s_waitcnt vmcnt(0)" ::: "memory");
            const unsigned og = xb_add(&bar[XB_TOP], 1u);
            const unsigned tg = og / nx;
            if (og + 1u == (tg + 1u) * nx) xb_add(&bar[XB_TOPGEN], 1u);
            else XB_SPIN(xb_ld(&bar[XB_TOPGEN]) == tg, bar);
            __builtin_amdgcn_fence(__ATOMIC_ACQUIRE, "agent");
            xb_add(&bar[XB_XGEN(b.x)], 1u);
            asm volatile("s_waitcnt vmcnt(0)" ::: "memory");
        } else {
            XB_SPIN(xb_ld(&bar[XB_XGEN(b.x)]) == gen, bar);
            __builtin_amdgcn_fence(__ATOMIC_ACQUIRE, "agent");
            asm volatile("s_waitcnt vmcnt(0)" ::: "memory");
        }
    }
    __syncthreads();
}

struct Args { const float* in[20]; float* out; unsigned char* ws; int ph_lo, ph_hi; int one_launch, pad; };

__device__ __forceinline__ void tr_load(const float* W, int ldw, int nblk, int item, int lane, f32x4 (&tv)[8]) {
    const int kb = item / nblk, nb = item % nblk, k0 = 64 * kb, n0 = 32 * nb;
#pragma unroll
    for (int i = 0; i < 8; ++i) tv[i] = __builtin_nontemporal_load((const GAS f32x4*)(W + (size_t)(k0 + i * 8 + (lane >> 3)) * ldw + n0 + (lane & 7) * 4));
}
__device__ __forceinline__ void tr_store(const f32x4 (&tv)[8], int nblk, bf16* WT, bf16* WT2, int k2lo, int ldt, LAS float* scr, int item, int lane) {
    const int kb = item / nblk, nb = item % nblk, k0 = 64 * kb, n0 = 32 * nb;
#pragma unroll
    for (int i = 0; i < 8; ++i) { const int kk = i * 8 + (lane >> 3); LAS float* d = scr + kk * 33 + (lane & 7) * 4; d[0] = tv[i][0]; d[1] = tv[i][1]; d[2] = tv[i][2]; d[3] = tv[i][3]; }
    LDS_WAIT(); asm volatile("" ::: "memory");
    const int c = lane & 7;
#pragma unroll
    for (int j = 0; j < 4; ++j) { const int n = (lane >> 3) + 8 * j; const LAS float* s = scr + (8 * c) * 33 + n;
        v4u o; o.x = pk2(s[0 * 33], s[1 * 33]); o.y = pk2(s[2 * 33], s[3 * 33]); o.z = pk2(s[4 * 33], s[5 * 33]); o.w = pk2(s[6 * 33], s[7 * 33]);
        *(GAS v4u*)(WT + (size_t)(n0 + n) * ldt + k0 + 8 * c) = o;
        if (WT2 && k0 >= k2lo) *(GAS v4u*)(WT2 + (size_t)(n0 + n) * ldt + k0 + 8 * c) = o; }
    LDS_WAIT(); asm volatile("" ::: "memory");
}
__device__ __forceinline__ void p0_transpose_item(const float* W, int ldw, int nblk, const float* g, bf16* WT, bf16* WT2, int k2lo, int ldt, LAS float* scr, int item, int lane) {
    (void)g; f32x4 tv[8]; tr_load(W, ldw, nblk, item, lane, tv); tr_store(tv, nblk, WT, WT2, k2lo, ldt, scr, item, lane);
}
__device__ __forceinline__ v4u cvt8(const float* p, float s) {
    const f32x4 a = __builtin_nontemporal_load((const GAS f32x4*)p), b = __builtin_nontemporal_load((const GAS f32x4*)(p + 4));
    v4u o; o.x = pk2(a[0] * s, a[1] * s); o.y = pk2(a[2] * s, a[3] * s); o.z = pk2(b[0] * s, b[1] * s); o.w = pk2(b[2] * s, b[3] * s); return o;
}

__device__ __forceinline__ float gelu_f(float v) {
    const float av = fabsf(v), t = __builtin_amdgcn_rcpf(av * 0.2316418882f + 1.0f);
    float q = t * 0.5307027145f + (-0.7265760135f); q = q * t + 0.7107068705f; q = q * t + (-0.142248368f); q = q * t + 0.127414796f; q = q * t;
    const float e = __builtin_amdgcn_exp2f((v * v) * (-0.72134752044f));
    const float m = v * (q * e);
    return v < 0.f ? m : v - m;
}
__device__ __forceinline__ float dot2bf(unsigned a, unsigned b, float c) { return __builtin_amdgcn_fdot2_f32_bf16(__builtin_bit_cast(bf16x2_t, a), __builtin_bit_cast(bf16x2_t, b), c, false); }
__device__ __forceinline__ unsigned fkey(float f) { const unsigned u = __float_as_uint(f); return (u & 0x80000000u) ? ~u : (u | 0x80000000u); }
__device__ __forceinline__ float fdec(unsigned k) { const unsigned u = (k & 0x80000000u) ? (k & 0x7fffffffu) : ~k; return __uint_as_float(u); }


typedef float f32x2v __attribute__((ext_vector_type(2)));
__device__ __forceinline__ float wave_sum_dpp(float v) {
    v += __builtin_bit_cast(float, __builtin_amdgcn_update_dpp(0, __builtin_bit_cast(int, v), 0xB1, 0xf, 0xf, true));
    v += __builtin_bit_cast(float, __builtin_amdgcn_update_dpp(0, __builtin_bit_cast(int, v), 0x4E, 0xf, 0xf, true));
    v += __builtin_bit_cast(float, __builtin_amdgcn_update_dpp(0, __builtin_bit_cast(int, v), 0x141, 0xf, 0xf, true));
    v += __builtin_bit_cast(float, __builtin_amdgcn_update_dpp(0, __builtin_bit_cast(int, v), 0x140, 0xf, 0xf, true));
    const float a = __builtin_bit_cast(float, __builtin_amdgcn_readlane(__builtin_bit_cast(int, v), 0));
    const float b = __builtin_bit_cast(float, __builtin_amdgcn_readlane(__builtin_bit_cast(int, v), 16));
    const float c = __builtin_bit_cast(float, __builtin_amdgcn_readlane(__builtin_bit_cast(int, v), 32));
    const float d = __builtin_bit_cast(float, __builtin_amdgcn_readlane(__builtin_bit_cast(int, v), 48));
    return (a + b) + (c + d);
}
typedef float v32f __attribute__((ext_vector_type(32)));
typedef float v16f __attribute__((ext_vector_type(16)));
typedef unsigned v6u __attribute__((ext_vector_type(6)));
#ifndef FP6_INTERLEAVED
#define FP6_INTERLEAVED 1
#endif
__device__ __forceinline__ v32f dec_fp6(const v4u a, const v2u b) { const v6u w = {a.x, a.y, a.z, a.w, b.x, b.y}; return __builtin_amdgcn_cvt_scalef32_pk32_f32_fp6(w, 1.0f); }
typedef __bf16 v32bf __attribute__((ext_vector_type(32)));
typedef unsigned v16u __attribute__((ext_vector_type(16)));
__device__ __forceinline__ float peer_dot(const v4u ua, const v2u ub, const unsigned (&xnp)[16]) {
    const v6u w = {ua.x, ua.y, ua.z, ua.w, ub.x, ub.y};
    const v16u fu = __builtin_bit_cast(v16u, __builtin_amdgcn_cvt_scalef32_pk32_bf16_fp6(w, 1.0f));
    unsigned fa[16];
#pragma unroll
    for (int i = 0; i < 16; ++i) fa[i] = fu[i];
    float a[4] = {0.f, 0.f, 0.f, 0.f};
#pragma unroll
    for (int i = 0; i < 16; ++i) a[i & 3] = dot2bf(fa[i], xnp[i], a[i & 3]);
    return (a[0] + a[1]) + (a[2] + a[3]);
}
__device__ __forceinline__ float peer_dot_lds(const v4u ua, const v2u ub, const LAS v4u* xl) {
    const v6u w = {ua.x, ua.y, ua.z, ua.w, ub.x, ub.y};
    const v16u fu = __builtin_bit_cast(v16u, __builtin_amdgcn_cvt_scalef32_pk32_bf16_fp6(w, 1.0f));
    unsigned fa[16];
#pragma unroll
    for (int i = 0; i < 16; ++i) fa[i] = fu[i];
    float a[4] = {0.f, 0.f, 0.f, 0.f};
#pragma unroll
    for (int i4 = 0; i4 < 4; ++i4) { const v4u x4 = xl[i4 * 64];
        a[0] = dot2bf(fa[i4 * 4 + 0], x4.x, a[0]); a[1] = dot2bf(fa[i4 * 4 + 1], x4.y, a[1]); a[2] = dot2bf(fa[i4 * 4 + 2], x4.z, a[2]); a[3] = dot2bf(fa[i4 * 4 + 3], x4.w, a[3]); }
    return (a[0] + a[1]) + (a[2] + a[3]);
}
typedef _Float16 h16x2 __attribute__((ext_vector_type(2)));
__device__ __forceinline__ unsigned pkfma_h(unsigned a, unsigned b, unsigned c) { return __builtin_bit_cast(unsigned, __builtin_elementwise_fma(__builtin_bit_cast(h16x2, a), __builtin_bit_cast(h16x2, b), __builtin_bit_cast(h16x2, c))); }
__device__ __forceinline__ float h16lo(unsigned u) { return (float)__builtin_bit_cast(h16x2, u).x; }
__device__ __forceinline__ float h16hi(unsigned u) { return (float)__builtin_bit_cast(h16x2, u).y; }
__device__ __forceinline__ void peer_axpy_h(const v4u va, const v2u vb, float w, unsigned (&oh)[16]) {
    const v6u wv = {va.x, va.y, va.z, va.w, vb.x, vb.y};
    const v16u fu = __builtin_bit_cast(v16u, __builtin_amdgcn_cvt_scalef32_pk32_f16_fp6(wv, 1.0f));
    unsigned fa[16];
#pragma unroll
    for (int i = 0; i < 16; ++i) fa[i] = fu[i];
    const h16x2 w2 = {(_Float16)w, (_Float16)w}; const unsigned wu = __builtin_bit_cast(unsigned, w2);
#pragma unroll
    for (int i = 0; i < 16; ++i) oh[i] = pkfma_h(fa[i], wu, oh[i]);
}
__device__ __forceinline__ void peer_axpy(const v4u va, const v2u vb, float w, float (&oacc)[32]) {
    const v32f f = dec_fp6(va, vb);
#pragma unroll
    for (int i = 0; i < 32; ++i) oacc[i] = fmaf(w, f[i], oacc[i]);
}


template <int NR>
__device__ __forceinline__ void conv_rows_fp6(const float* srow0, unsigned char* drow0, float* sc0, int lane) {
    f32x4 v[NR][8]; float am[NR];
#pragma unroll
    for (int q = 0; q < 8; ++q)
#pragma unroll
        for (int r = 0; r < NR; ++r) v[r][q] = __builtin_nontemporal_load((const GAS f32x4*)(srow0 + (size_t)r * DM + lane * 4 + q * 256));
#pragma unroll
    for (int r = 0; r < NR; ++r) { am[r] = 0.f;
#pragma unroll
        for (int q = 0; q < 8; ++q) am[r] = fmaxf(am[r], fmaxf(fmaxf(fabsf(v[r][q][0]), fabsf(v[r][q][1])), fmaxf(fabsf(v[r][q][2]), fabsf(v[r][q][3])))); }
#pragma unroll
    for (int o = 1; o < 64; o <<= 1)
#pragma unroll
        for (int r = 0; r < NR; ++r) am[r] = fmaxf(am[r], __shfl_xor(am[r], o));
#pragma unroll
    for (int r = 0; r < NR; ++r) {
        int ex = 0; if (am[r] > 0.f) { (void)frexpf(am[r], &ex); ex = 3 - ex; if (ldexpf(am[r], ex) > 7.5f) ex -= 1; }
        const float sc = ldexpf(1.f, ex);
        if (lane == 0) sc0[r] = ldexpf(1.f, -ex);
        v16f xa, xb;
#pragma unroll
        for (int i = 0; i < 16; ++i) { xa[i] = v[r][(2 * i) >> 2][(2 * i) & 3] * sc; xb[i] = v[r][(2 * i + 1) >> 2][(2 * i + 1) & 3] * sc; }
        const v6u w = __builtin_amdgcn_cvt_scalef32_2xpk16_fp6_f32(xa, xb, 1.0f);
        unsigned char* drow = drow0 + (size_t)r * 1536;
        *(GAS v4u*)(drow + lane * 16) = (v4u){w[0], w[1], w[2], w[3]};
        *(GAS v2u*)(drow + 1024 + lane * 8) = (v2u){w[4], w[5]};
    }
}

#if defined(PROBE_SEL) && PROBE_SEL < 7
#define PROBE_EXPORT(T_, q) do { if ((T_) == 0 && lane == 0 && (q) == 0) { const unsigned long long a_ = ((unsigned long long)MISC[33 + 2 * PROBE_SEL] << 32) | MISC[32 + 2 * PROBE_SEL], b_ = ((unsigned long long)MISC[35 + 2 * PROBE_SEL] << 32) | MISC[34 + 2 * PROBE_SEL]; o[0] += (float)(b_ - a_) * 0.001f; } } while (0)
#else
#define PROBE_EXPORT(T_, q) do { } while (0)
#endif
__global__ void __launch_bounds__(NTHREADS, 2) fwd_kernel(Args args) {
    extern __shared__ __attribute__((aligned(16))) unsigned char lds[];
    LAS unsigned char* ldsL = (LAS unsigned char*)lds;
    volatile LAS unsigned* MISC = (volatile LAS unsigned*)(ldsL + LDS_MISC);
    const int tid = threadIdx.x, lane = tid & 63, wave = __builtin_amdgcn_readfirstlane(tid >> 6);
    const int G = gridDim.x; const int bx = blockIdx.x; const int vcu = (G % 8 == 0) ? (bx % 8) * (G / 8) + bx / 8 : bx;
#define G_ws (args.ws)
#define G_ctl ((unsigned*)(args.ws + WS_CTL))
#define G_x (args.in[0])
#define G_mem (args.in[1])
#define G_mix_norm (args.in[2])
#define G_w_in (args.in[3])
#define G_b_forget (args.in[4])
#define G_pool_w (args.in[5])
#define G_pool_scale (args.in[6])
#define G_w_out (args.in[7])
#define G_xattn_norm (args.in[8])
#define G_mem_norm (args.in[9])
#define G_xwq (args.in[10])
#define G_xwk (args.in[11])
#define G_xwv (args.in[12])
#define G_xwo (args.in[13])
#define G_peer_norm (args.in[14])
#define G_peer_wq (args.in[15])
#define G_sub_keys (args.in[16])
#define G_peer_u (args.in[17])
#define G_peer_v (args.in[18])
#define G_final_norm (args.in[19])
#define G_W_IN ((bf16*)(args.ws + WS_WIN))
#define G_WO1 ((bf16*)(args.ws + WS_WO1))
#define G_WO2 ((bf16*)(args.ws + WS_WO2))
#define G_WQ ((bf16*)(args.ws + WS_WQ))
#define G_WK ((bf16*)(args.ws + WS_WK))
#define G_WV ((bf16*)(args.ws + WS_WV))
#define G_WO ((bf16*)(args.ws + WS_WO))
#define G_WPQ ((bf16*)(args.ws + WS_WPQ))
#define G_AEXP ((bf16*)(args.ws + WS_AEXP))
#define G_W1 ((bf16*)(args.ws + WS_AEXP))
#define G_W2 ((bf16*)(args.ws + WS_WPQ))
#define G_WSC ((bf16*)(args.ws + WS_WSC))
#define G_PB ((bf16*)(args.ws + WS_PB))
#define G_MN ((bf16*)(args.ws + WS_MN))
#define G_KX ((bf16*)(args.ws + WS_KX))
#define G_VXT ((bf16*)(args.ws + WS_VXT))
#define G_UB (args.ws + WS_UB)
#define G_VB (args.ws + WS_VB)
#define G_SU ((float*)(args.ws + WS_SU))
#define G_SV ((float*)(args.ws + WS_SV))
#define G_XN ((bf16*)(args.ws + WS_XN))
#define G_QX ((bf16*)(args.ws + WS_XN))
#define G_PROJ ((bf16*)(args.ws + WS_PROJ))
#define G_SCT ((float*)(args.ws + WS_PROJ))
#define G_AMIX ((bf16*)(args.ws + WS_AMIX))
#define G_OX ((bf16*)(args.ws + WS_AMIX))
#define G_H ((float*)(args.ws + WS_H))
#define G_HB ((bf16*)(args.ws + WS_HB))
#define G_PP ((bf16*)(args.ws + WS_P))
#define G_LF ((float*)(args.ws + WS_LF))
#define G_SS1 ((float*)(args.ws + CTL_SS1))
#define G_SS2 ((float*)(args.ws + CTL_SS2))

    for (int u = tid; u < (LDS_BYTES - LDS_MISC) / 4; u += NTHREADS) ((LAS unsigned*)(ldsL + LDS_MISC))[u] = 0u;
    __syncthreads();
    XcdBarrier bar; bar.bar = G_ctl + CW_BAR; bar.x = 0; bar.st = nullptr;
    if (args.one_launch) bar = xcd_barrier_post(G_ctl + CW_BAR, MISC + 8);
    const int lo = args.ph_lo, hi = args.ph_hi;
#ifndef PH_MASK
#define PH_MASK 0xff
#endif
#define IN(k) (((PH_MASK >> (k)) & 1) && lo <= (k) && (k) < hi)
#ifdef PROBE_SEL
#define STAMP(i) do { if (bx == 0 && tid == 0) { const unsigned long long t_ = __builtin_amdgcn_s_memrealtime(); MISC[32 + 2 * (i)] = (unsigned)t_; MISC[33 + 2 * (i)] = (unsigned)(t_ >> 32); } } while (0)
#else
#define STAMP(i) do { } while (0)
#endif
#define SEAM(k) do { if (IN(k) && IN((k) + 1)) xcd_barrier(bar); STAMP((k) + 1); } while (0)
#define TABLE_CHUNK(c_) do { const int r_ = (c_) * 32 + wave * 4; const int tb_ = r_ >> 14, rr_ = r_ & (PEXP - 1); \
        conv_rows_fp6<4>((tb_ ? G_peer_v : G_peer_u) + (size_t)rr_ * DM, (tb_ ? G_VB : G_UB) + (size_t)rr_ * 1536, (tb_ ? G_SV : G_SU) + rr_, lane); } while (0)
    STAMP(0);
#if defined(PROBE_SEL) && PROBE_SEL >= 7
    if (bx == 0 && tid == 0) __hip_atomic_store((unsigned long long*)(G_ctl + 256), (unsigned long long)__builtin_amdgcn_s_memrealtime(), __ATOMIC_RELAXED, __HIP_MEMORY_SCOPE_AGENT);
#endif
    const int gw = vcu * NWAVES + wave, NGW = G * NWAVES;
    const int gt = vcu * NTHREADS + tid, NGT = G * NTHREADS;

    if (IN(0)) for (int rep_ = 0; rep_ < (((DUP_MASK >> 0) & 1) ? args.pad + 1 : 1); ++rep_) {
        LAS float* wf = (LAS float*)ldsL;
        LAS float* scr = (LAS float*)(ldsL + 65536 + wave * 8704);
#pragma unroll
        for (int i = 0; i < DM / NTHREADS; ++i) { const int d = tid + i * NTHREADS; const f32x4 a = *(const GAS f32x4*)(G_w_in + (size_t)d * INC + 4096), b = *(const GAS f32x4*)(G_w_in + (size_t)d * INC + 4100);
            wf[d] = a[0]; wf[DM + d] = a[1]; wf[2 * DM + d] = a[2]; wf[3 * DM + d] = a[3]; wf[4 * DM + d] = b[0]; wf[5 * DM + d] = b[1]; wf[6 * DM + d] = b[2]; wf[7 * DM + d] = b[3]; }
        __syncthreads();
        f32x4 vnx[8];
        if (gw < TOK) {
#pragma unroll
            for (int j = 0; j < 8; ++j) vnx[j] = __builtin_nontemporal_load((const GAS f32x4*)(G_x + (size_t)gw * DM) + lane + 64 * j); }
        for (int m = gw; m < TOK; m += NGW) {
            const GAS f32x4* gr = (const GAS f32x4*)G_mix_norm + lane;
            f32x4 v[8]; float s = 0.f;
#pragma unroll
            for (int j = 0; j < 8; ++j) v[j] = vnx[j];
            if (m + NGW < TOK) {
#pragma unroll
                for (int j = 0; j < 8; ++j) vnx[j] = __builtin_nontemporal_load((const GAS f32x4*)(G_x + (size_t)(m + NGW) * DM) + lane + 64 * j); }
#pragma unroll
            for (int j = 0; j < 8; ++j) s += (v[j][0] * v[j][0] + v[j][1] * v[j][1]) + (v[j][2] * v[j][2] + v[j][3] * v[j][3]);
            const float rstd = __builtin_amdgcn_rsqf(wave_sum_dpp(s) * (1.f / DM) + EPS);
            GAS v2u* o8 = (GAS v2u*)(G_XN + (size_t)m * DM) + lane;
#pragma unroll
            for (int j = 0; j < 8; ++j) { const f32x4 gg = gr[64 * j]; v[j] = v[j] * rstd * gg;
                v2u o; o.x = pk2(v[j][0], v[j][1]); o.y = pk2(v[j][2], v[j][3]); o8[64 * j] = o; }
            float fl[8];
#pragma unroll
            for (int h = 0; h < 8; ++h) { float a = 0.f;
#pragma unroll
                for (int j = 0; j < 8; ++j) { const f32x4 w = *(const LAS f32x4*)(wf + h * DM + j * 256 + lane * 4); a += (v[j][0] * w[0] + v[j][1] * w[1]) + (v[j][2] * w[2] + v[j][3] * w[3]); }
                fl[h] = wave_sum_dpp(a);
                asm volatile("" ::: "memory"); }
            if (lane < 8) { float f = fl[0];
#pragma unroll
                for (int h = 1; h < 8; ++h) f = (lane == h) ? fl[h] : f;
                f += G_b_forget[lane];
                const float ls = fminf(f, 0.f) - log1pf(expf(-fabsf(f)));
                const int b = m / SEQ, sq = m % SEQ; G_LF[(size_t)(b * FOXH + lane) * SEQ + sq] = ls; }
        }
        for (int m = gw; m < BATCH * NMEM; m += NGW) {
            const GAS f32x4* xr = (const GAS f32x4*)(G_mem + (size_t)m * DM) + lane; const GAS f32x4* gr = (const GAS f32x4*)G_mem_norm + lane;
            f32x4 v[8]; float s = 0.f;
#pragma unroll
            for (int j = 0; j < 8; ++j) { v[j] = xr[64 * j]; s += (v[j][0] * v[j][0] + v[j][1] * v[j][1]) + (v[j][2] * v[j][2] + v[j][3] * v[j][3]); }
            const float rstd = __builtin_amdgcn_rsqf(wave_sum_dpp(s) * (1.f / DM) + EPS);
            GAS v2u* o8 = (GAS v2u*)(G_MN + (size_t)m * DM) + lane;
#pragma unroll
            for (int j = 0; j < 8; ++j) { const f32x4 gg = gr[64 * j]; v[j] = v[j] * rstd * gg; v2u o; o.x = pk2(v[j][0], v[j][1]); o.y = pk2(v[j][2], v[j][3]); o8[64 * j] = o; }
        }
        {
            constexpr int I_IN = (DM / 64) * (4096 / 32), I_SQ = (DM / 64) * (DM / 32);
            constexpr int NITEMS = I_IN + 3 * I_SQ;
#define TR_SRC(it_, W_, ldw_, nblk_, r_) do { r_ = (it_); if (r_ < I_IN) { W_ = G_w_in; ldw_ = INC; nblk_ = 4096 / 32; } else { r_ -= I_IN; ldw_ = DM; nblk_ = DM / 32; \
        if (r_ < I_SQ) W_ = G_w_out; else if (r_ < 2 * I_SQ) { W_ = G_xwk; r_ -= I_SQ; } else { W_ = G_xwv; r_ -= 2 * I_SQ; } } } while (0)
            f32x4 tvn[8]; const float* Wn; int ldwn, nblkn, rn;
            if (gw < NITEMS) { TR_SRC(gw, Wn, ldwn, nblkn, rn); tr_load(Wn, ldwn, nblkn, rn, lane, tvn); }
            for (int it = gw; it < NITEMS; it += NGW) {
                f32x4 tvc[8];
#pragma unroll
                for (int i = 0; i < 8; ++i) tvc[i] = tvn[i];
                const int nblkc = nblkn, rc = rn;
                if (it + NGW < NITEMS) { TR_SRC(it + NGW, Wn, ldwn, nblkn, rn); tr_load(Wn, ldwn, nblkn, rn, lane, tvn); }
                int r = it;
                if (r < I_IN) { tr_store(tvc, nblkc, G_W_IN, nullptr, 0, DM, scr, rc, lane); continue; } r -= I_IN;
                if (r < I_SQ) { tr_store(tvc, nblkc, G_WO1, G_WO2, POOLW, DM, scr, rc, lane); continue; } r -= I_SQ;
                if (r < I_SQ) { tr_store(tvc, nblkc, G_WK, nullptr, 0, DM, scr, rc, lane); continue; }
                tr_store(tvc, nblkc, G_WV, nullptr, 0, DM, scr, rc, lane);
            }
#undef TR_SRC
        }
        for (int i0 = gt; i0 < DM * DM / 8; i0 += 2 * NGT) {
#pragma unroll
            for (int u = 0; u < 2; ++u) { const int i = i0 + u * NGT; if (i < DM * DM / 8) {
                const int d = i / (DM / 8);
                const v4u o1 = cvt8(G_peer_wq + (size_t)i * 8, G_peer_norm[d]);
                const v4u o2 = cvt8(G_xwq + (size_t)i * 8, G_xattn_norm[d]);
                *(GAS v4u*)(G_WPQ + (size_t)i * 8) = o1; *(GAS v4u*)(G_WQ + (size_t)i * 8) = o2; } }
        }
        for (int i = gt; i < DM * 256 / 8; i += NGT) {
            const int r = i >> 5, c0 = (i & 31) * 8; const int hc = r >> 7;
            v4u o3 = {0u, 0u, 0u, 0u}; if ((c0 >> 7) == (hc & 1)) o3 = cvt8(G_sub_keys + (size_t)r * 128 + (c0 & 127), 1.f);
            *(GAS v4u*)(G_AEXP + (size_t)i * 8) = o3; }
        for (int i = gt; i < 4 * 256 * 256 / 8; i += NGT) {
            const int g = i / (256 * 256 / 8), d0 = (i % 32) * 8; const float* ps = G_pool_scale + g * 256 + d0; const float* p = G_pool_w + (size_t)i * 8;
            v4u o; o.x = pk2(p[0] * ps[0], p[1] * ps[1]); o.y = pk2(p[2] * ps[2], p[3] * ps[3]); o.z = pk2(p[4] * ps[4], p[5] * ps[5]); o.w = pk2(p[6] * ps[6], p[7] * ps[7]);
            *(GAS v4u*)(G_PB + (size_t)i * 8) = o; }
        __syncthreads();
    }
    SEAM(0);

    if (IN(1)) for (int rep_ = 0; rep_ < (((DUP_MASK >> 1) & 1) ? args.pad + 1 : 1); ++rep_) {
        pg8::Gemm g{G_XN, G_W_IN, DM, DM, DM}; pg8::GSched S; S.init(TOK / 256, 4096 / 256, G, bx, DM, DM);
        pg8::EpiStoreT<true> E{G_PROJ, 4096, 0, 0, 1, nullptr, 1.f, 4, 8, 0.08838834764831845f * LOG2E, (unsigned*)G_ctl + CW_NRM};
        pg8::gemm_phase<pg8::EpiStoreT<true>, pg8::GSched, true>(ldsL, g, S, E);
    }
    SEAM(1);

    if (IN(2)) for (int rep_ = 0; rep_ < (((DUP_MASK >> 2) & 1) ? args.pad + 1 : 1); ++rep_) {
        for (int it = vcu; it < TOK / 32; it += G) {
            const int ch = (tid & 127) * 8, rsub = tid >> 7, r0 = it * 32 + rsub * 8, w = 2 << (ch >> 8);
            const int s0 = r0 % SEQ;
            float acc[8];
#pragma unroll
            for (int e = 0; e < 8; ++e) acc[e] = 0.f;
            for (int k = 1; k < w; ++k) { if (s0 - k >= 0) { const v4u v = *(const GAS v4u*)(G_PROJ + (size_t)(r0 - k) * 4096 + ch);
#pragma unroll
                    for (int e = 0; e < 4; ++e) { acc[2 * e] += __uint_as_float(v[e] << 16); acc[2 * e + 1] += __uint_as_float(v[e] & 0xffff0000u); } } }
            for (int rr = 0; rr < 8; ++rr) {
                const v4u v = *(const GAS v4u*)(G_PROJ + (size_t)(r0 + rr) * 4096 + ch); float cur[8];
#pragma unroll
                for (int e = 0; e < 4; ++e) { cur[2 * e] = __uint_as_float(v[e] << 16); cur[2 * e + 1] = __uint_as_float(v[e] & 0xffff0000u); }
                const int sp = s0 + rr; const float inv = 1.f / (float)((sp + 1 < w) ? sp + 1 : w);
                v4u o;
#pragma unroll
                for (int e = 0; e < 8; ++e) acc[e] += cur[e];
                o.x = pk2(acc[0] * inv - cur[0], acc[1] * inv - cur[1]); o.y = pk2(acc[2] * inv - cur[2], acc[3] * inv - cur[3]);
                o.z = pk2(acc[4] * inv - cur[4], acc[5] * inv - cur[5]); o.w = pk2(acc[6] * inv - cur[6], acc[7] * inv - cur[7]);
                *(GAS v4u*)(G_AMIX + (size_t)(r0 + rr) * DM + ch) = o;
                if (sp - w + 1 >= 0) { const v4u vo = *(const GAS v4u*)(G_PROJ + (size_t)(r0 + rr - w + 1) * 4096 + ch);
#pragma unroll
                    for (int e = 0; e < 4; ++e) { acc[2 * e] -= __uint_as_float(vo[e] << 16); acc[2 * e + 1] -= __uint_as_float(vo[e] & 0xffff0000u); } }
            }
        }
        const int a_bh = vcu >> 4, a_qb = vcu & 15;
        if (a_qb < 8 && vcu < 256) {
            const int e = a_qb < 2 ? a_bh * 2 + a_qb : 32 + a_bh * 6 + (a_qb - 2);
            pg8::Gemm g; pg8::EpiStore E{nullptr, DM, 0, 0, 1, nullptr, 1.f, 0, 0, 1.f, nullptr};
            int pm, pn;
            if (e < 16)      { pm = e >> 3; pn = e & 7; g = pg8::Gemm{G_MN, G_WK, DM, DM, DM}; E.O = G_KX; E.ldc = DM; }
            else if (e < 32) { const int q = e - 16; pm = q >> 3; pn = q & 7; g = pg8::Gemm{G_MN, G_WV, DM, DM, DM}; E.O = G_VXT; E.ldc = DM; }
            else if (e < 96) { const int q = e - 32; pm = q >> 3; pn = q & 7; g = pg8::Gemm{G_AEXP, G_WPQ + pm * 256, 256, 256, DM}; E.O = G_WSC; E.ldc = DM; }
            else             { const int q = e - 96; const int gg = q >> 3; pm = q & 7; pn = 0;
                               g = pg8::Gemm{G_WO1 + gg * 256, G_PB + (size_t)gg * 65536, 256, DM, 256}; E.O = G_WO2 + gg * 256; E.ldc = DM; }
            const pg8::OneSched S1{pm, pn, (long)pm * 256 * g.lda, (long)pn * 256 * g.ldb};
            pg8::gemm_phase<pg8::EpiStore, pg8::OneSched, false>(ldsL, g, S1, E);
        }
        if (vcu < 256) {
            const int b = a_bh >> 3, h = a_bh & 7;
            float* c_lds = (float*)(lds + fox::LDS_C);
            if (wave == 0) {
                const float* lf = G_LF + (size_t)a_bh * SEQ + lane * 64; float loc[64]; float run = 0.f;
#pragma unroll
                for (int i = 0; i < 16; ++i) { const f32x4 v = *(const f32x4*)(lf + 4 * i);
#pragma unroll
                    for (int e = 0; e < 4; ++e) { run += v[e]; loc[4 * i + e] = run; } }
                float incl = run;
#pragma unroll
                for (int o = 1; o < 64; o <<= 1) { const float t = __shfl_up(incl, o); if (lane >= o) incl += t; }
                const float excl = incl - run;
#pragma unroll
                for (int i = 0; i < 16; ++i) { f32x4 v;
#pragma unroll
                    for (int e = 0; e < 4; ++e) v[e] = (loc[4 * i + e] + excl) * LOG2E;
                    *(f32x4*)(c_lds + lane * 64 + 4 * i) = v; }
            }
            __syncthreads();
            const bf16* Qb = G_PROJ + (size_t)(b * SEQ) * 4096 + 1024 + h * 128;
            fox::BlockRef cur{Qb + (size_t)(a_qb * 256) * 4096, Qb + 1024, Qb + 2048, G_AMIX + (size_t)(b * SEQ + a_qb * 256) * DM + 1024 + h * 128, a_qb * 256};
            int j_lo = 0;
            { const unsigned* nq = (const unsigned*)G_ctl + CW_NRM + (b * 8 + h) * 4; const unsigned* nk = nq + 64; float B = 0.f;
#pragma unroll
              for (int c4 = 0; c4 < 4; ++c4) B += sqrtf(__uint_as_float(__hip_atomic_load(nq + c4, __ATOMIC_RELAXED, __HIP_MEMORY_SCOPE_AGENT)) * __uint_as_float(__hip_atomic_load(nk + c4, __ATOMIC_RELAXED, __HIP_MEMORY_SCOPE_AGENT)));
              const float thr = 2.05f * B + c_lds[a_qb * 256] + 150.f;
              while (j_lo < a_qb * 4 && c_lds[64 * j_lo + 63] > thr) ++j_lo; }
            fox::Seam S;
            fox::prime(cur, j_lo, (char*)lds, S);
            fox::block(cur, cur, j_lo, (char*)lds, S);
            asm volatile("s_waitcnt vmcnt(0)" ::: "memory");
            __syncthreads();
        }
        {
            constexpr int C_T = (DM / 64) * (DM / 32) / 8, NCHUNK = C_T + QSPLIT;
            LAS float* scr = (LAS float*)(ldsL + wave * 8704);
            __syncthreads();
            if (tid == 0) MISC[16] = atomicAdd(G_ctl + CW_QUEUE, 1u);
            for (int par = 0;; par ^= 1) {
                __syncthreads();
                const int c = (int)MISC[16 + par];
                if (c >= NCHUNK) break;
                unsigned nxt_ = 0u; if (tid == 0) nxt_ = atomicAdd(G_ctl + CW_QUEUE, 1u);
                if (c < C_T) { p0_transpose_item(G_xwo, DM, DM / 32, nullptr, G_WO, nullptr, 0, DM, scr, c * 8 + wave, lane); }
                else { TABLE_CHUNK(c - C_T); }
                if (tid == 0) MISC[17 - par] = nxt_;
            }
        }
    }
    SEAM(2);

    if (IN(3)) for (int rep_ = 0; rep_ < (((DUP_MASK >> 3) & 1) ? args.pad + 1 : 1); ++rep_) {
        { pg8::Gemm g{G_AMIX, G_WO2, DM, DM, DM}; pg8::GSched S; S.init(TOK / 256, DM / 256, G, bx, DM, DM);
          pg8::EpiResid<false> E{G_x, G_HB, rep_ ? nullptr : G_SS1, 0};
          pg8::gemm_phase<pg8::EpiResid<false>, pg8::GSched, true>(ldsL, g, S, E); }
        if (bx < 64) {
            const int f = bx & 63, b = f >> 5, h = (f >> 3) & 3, t = f & 7;
            pg8::Gemm g{G_KX + (size_t)(b * NMEM) * DM + h * XD, G_WQ + h * XD, XD, DM, DM};
            pg8::EpiStore E{G_W1 + (size_t)(b * 1024 + h * 256) * DM, DM, 0, 0, 1, nullptr, 1.f, 0, 0, 1.f, nullptr};
            const pg8::OneSched S1{0, t, 0, (long)t * 256 * DM};
            pg8::gemm_phase<pg8::EpiStore, pg8::OneSched, false>(ldsL, g, S1, E);
        }
    }
    SEAM(3);

    if (IN(4)) for (int rep_ = 0; rep_ < (((DUP_MASK >> 4) & 1) ? args.pad + 1 : 1); ++rep_) {
        pg8::Gemm g{G_HB, G_W1, DM, DM, DM}; pg8::GSched S; S.init(SEQ / 256, XH, G, bx, DM, DM);
        S.nH = 1; S.nZ = BATCH; S.sAb = (long)SEQ * DM; S.sBb = (long)1024 * DM;
        pg8::EpiSoftmax E{G_PP, 1024, (long)SEQ * 1024, 0, 1, G_SS1, 0.044194173824159216f * LOG2E, SEQ};
        pg8::gemm_phase<pg8::EpiSoftmax, pg8::GSched, false>(ldsL, g, S, E);
        if (bx >= 128 && bx < 192) {
            const int f = bx & 63, b = f >> 5, h = (f >> 3) & 3, t = f & 7;
            pg8::Gemm g2{G_WO + h * XD, G_VXT + (size_t)(b * NMEM) * DM + h * XD, XD, DM, DM};
            pg8::EpiStore E2{G_W2 + (size_t)b * DM * 1024 + h * 256, 1024, 0, 0, 1, nullptr, 1.f, 0, 0, 1.f, nullptr};
            const pg8::OneSched S2{t, 0, (long)t * 256 * DM, 0};
            pg8::gemm_phase<pg8::EpiStore, pg8::OneSched, false>(ldsL, g2, S2, E2);
        }
        for (;;) {
            __syncthreads();
            if (tid == 0) MISC[16] = atomicAdd(G_ctl + CW_QUEUE2, 1u);
            __syncthreads();
            const int c = (int)MISC[16] + QSPLIT;
            if (c >= 2 * PEXP / 32) break;
            TABLE_CHUNK(c);
        }
    }
    SEAM(4);

    if (IN(5)) for (int rep_ = 0; rep_ < (((DUP_MASK >> 5) & 1) ? args.pad + 1 : 1); ++rep_) {
        pg8::Gemm g{G_PP, G_W2, 1024, 1024, 1024}; pg8::GSched S; S.init(SEQ / 256, DM / 256, G, bx, 1024, 1024);
        S.nH = 1; S.nZ = BATCH; S.sAb = (long)SEQ * 1024; S.sBb = (long)DM * 1024;
        pg8::EpiResid<true> E{G_HB, G_HB, G_SS2, SEQ};
        pg8::gemm_phase<pg8::EpiResid<true>, pg8::GSched, true>(ldsL, g, S, E);
    }
    SEAM(5);

    if (IN(6)) for (int rep_ = 0; rep_ < (((DUP_MASK >> 6) & 1) ? args.pad + 1 : 1); ++rep_) {
        pg8::Gemm g{G_WSC, G_HB, DM, DM, DM}; pg8::GSched S; S.init(DM / 256, TOK / 256, G, bx, DM, DM);
        pg8::EpiF32Col E{G_SCT, TOK, G_SS2};
        pg8::gemm_phase<pg8::EpiF32Col, pg8::GSched, true>(ldsL, g, S, E);
    }
    SEAM(6);

#if defined(PROBE_SEL) && PROBE_SEL >= 7
    if (bx == 0 && tid == 0) __hip_atomic_store((unsigned long long*)(G_ctl + 258), (unsigned long long)__builtin_amdgcn_s_memrealtime(), __ATOMIC_RELAXED, __HIP_MEMORY_SCOPE_AGENT);
#endif
    if (IN(7)) for (int rep_ = 0; rep_ < (((DUP_MASK >> 7) & 1) ? args.pad + 1 : 1); ++rep_) {
        LAS unsigned* TOP1 = (LAS unsigned*)ldsL;
        LAS unsigned* RIDX = (LAS unsigned*)(ldsL + 32768);
        LAS float* RGATE = (LAS float*)(ldsL + 49152);
        for (int blk = vcu; blk < TOK / 32; blk += G) {
            const int t0 = blk * 32;
            {
                const int tok = tid & 31, grp = tid >> 5;
                const float* sp = G_SCT + ((size_t)blk * DM + grp * 128) * 32 + tok;
                unsigned lst[16];
#pragma unroll
                for (int j = 0; j < 16; ++j) lst[j] = 0u;
                for (int i0 = 0; i0 < 128; i0 += 32) {
                    float v[32];
#pragma unroll
                    for (int e = 0; e < 32; ++e) v[e] = __builtin_nontemporal_load(sp + (i0 + e) * 32);
#pragma unroll
                    for (int c16 = 0; c16 < 2; ++c16) { unsigned nw[16];
#pragma unroll
                        for (int e = 0; e < 16; ++e) nw[e] = (fkey(v[c16 * 16 + e]) & ~127u) | (unsigned)(127 - (i0 + c16 * 16 + e));
#pragma unroll
                        for (int k = 2; k <= 16; k <<= 1)
#pragma unroll
                            for (int j = k >> 1; j > 0; j >>= 1)
#pragma unroll
                                for (int i = 0; i < 16; ++i) { const int l = i ^ j; if (l > i) { const unsigned lo_ = min(nw[i], nw[l]), hi_ = max(nw[i], nw[l]); if ((i & k) == 0) { nw[i] = lo_; nw[l] = hi_; } else { nw[i] = hi_; nw[l] = lo_; } } }
#pragma unroll
                        for (int i = 0; i < 16; ++i) lst[i] = max(lst[i], nw[i]);
#pragma unroll
                        for (int j = 8; j > 0; j >>= 1)
#pragma unroll
                            for (int i = 0; i < 16; ++i) { const int l = i ^ j; if (l > i) { const unsigned lo_ = min(lst[i], lst[l]), hi_ = max(lst[i], lst[l]); lst[i] = hi_; lst[l] = lo_; } } }
                }
                LAS unsigned* dst = TOP1 + (tok * 16 + grp) * 16;
#pragma unroll
                for (int j = 0; j < 16; j += 4) *(LAS v4u*)(dst + j) = (v4u){lst[j], lst[j + 1], lst[j + 2], lst[j + 3]};
            }
            __syncthreads();
            if (tid < 256) {
                const int tok = tid & 31, head = tid >> 5;
                const LAS unsigned* ka = TOP1 + (tok * 16 + head * 2) * 16; const LAS unsigned* kb = ka + 16;
                float af[16], bfv[16];
#pragma unroll
                for (int j = 0; j < 16; ++j) { af[j] = fdec(ka[j] & ~127u); bfv[j] = fdec(kb[j] & ~127u); }
                unsigned best[16];
#pragma unroll
                for (int j = 0; j < 16; ++j) best[j] = 0u;
#pragma unroll
                for (int i = 0; i < 16; ++i)
#pragma unroll
                    for (int j = 0; j < 16; ++j) if ((i + 1) * (j + 1) <= 16) {
                        unsigned xk = (fkey(af[i] + bfv[j]) & ~255u) | (unsigned)(255 - (i * 16 + j));
#pragma unroll
                        for (int q = 0; q < 16; ++q) { const unsigned hi_ = max(best[q], xk); xk = min(best[q], xk); best[q] = hi_; } }
                float ev[16]; const float m0 = fdec(best[0] & ~255u); float sum = 0.f;
#pragma unroll
                for (int q = 0; q < 16; ++q) { ev[q] = __expf(fdec(best[q] & ~255u) - m0); sum += ev[q]; }
                const float inv = 1.f / sum;
#pragma unroll
                for (int q = 0; q < 16; ++q) { const unsigned code = 255u - (best[q] & 255u); const unsigned i = code >> 4, j = code & 15u;
                    const unsigned ia = 127u - (ka[i] & 127u), ib = 127u - (kb[j] & 127u);
                    RIDX[tok * 128 + head * 16 + q] = ia * 128u + ib; RGATE[tok * 128 + head * 16 + q] = ev[q] * inv; }
            }
            __syncthreads();
            {
                LAS unsigned* SIDX = (LAS unsigned*)ldsL; LAS unsigned* SGATE = (LAS unsigned*)(ldsL + 16384);
                const int tok = tid >> 4; const LAS unsigned* src = RIDX + tok * 128;
                unsigned mine[8]; unsigned rank[8];
#pragma unroll
                for (int i = 0; i < 8; ++i) { mine[i] = (src[(tid & 15) + 16 * i] << 7) | (unsigned)((tid & 15) + 16 * i); rank[i] = 0u; }
                for (int j0 = 0; j0 < 128; j0 += 4) { const v4u o4 = *(const LAS v4u*)(src + j0);
#pragma unroll
                    for (int jj = 0; jj < 4; ++jj) { const unsigned oj = ((jj == 0 ? o4.x : jj == 1 ? o4.y : jj == 2 ? o4.z : o4.w) << 7) | (unsigned)(j0 + jj);
#pragma unroll
                        for (int i = 0; i < 8; ++i) rank[i] += (oj < mine[i]) ? 1u : 0u; } }
#pragma unroll
                for (int i = 0; i < 8; ++i) mine[i] >>= 7;
#pragma unroll
                for (int i = 0; i < 8; ++i) { const unsigned pos = rank[i];
                    SIDX[tok * 128 + pos] = mine[i];
                    const float su_ = G_SU[mine[i]], gs_ = RGATE[tok * 128 + (tid & 15) + 16 * i] * G_SV[mine[i]];
                    SGATE[tok * 128 + pos] = (__float_as_uint(su_) & 0xffff0000u) | f2bf(gs_); }
            }
            __syncthreads();
            {
                const int tok0 = wave * 4; const size_t tg0 = (size_t)(t0 + tok0);
                LAS float* Wl = (LAS float*)(ldsL + 32768) + tok0 * 128;
                unsigned xn0[16], xn1[16], xn2[16], xn3[16];
#define XNLOAD(T_, XN) do { const float rs = __builtin_amdgcn_rsqf(G_SS2[tg0 + (T_)] * (1.f / DM) + EPS); \
        _Pragma("unroll") for (int q = 0; q < 8; ++q) { const size_t d0 = (size_t)q * 256 + lane * 4; \
            const v2u ha = *(const GAS v2u*)(G_HB + (tg0 + (T_)) * DM + d0); const f32x4 ga = *(const f32x4*)(G_peer_norm + d0); \
            XN[q * 2] = pk2(__uint_as_float(ha.x << 16) * rs * ga[0], __uint_as_float(ha.x & 0xffff0000u) * rs * ga[1]); XN[q * 2 + 1] = pk2(__uint_as_float(ha.y << 16) * rs * ga[2], __uint_as_float(ha.y & 0xffff0000u) * rs * ga[3]); } } while (0)
                XNLOAD(0, xn0); XNLOAD(1, xn1); XNLOAD(2, xn2); XNLOAD(3, xn3);
#undef XNLOAD
                const LAS unsigned* ridx0 = (const LAS unsigned*)ldsL + tok0 * 128; const LAS unsigned* rgs0 = (const LAS unsigned*)(ldsL + 16384) + tok0 * 128;
                const __amdgpu_buffer_rsrc_t rsT = __builtin_amdgcn_make_buffer_rsrc((void*)G_UB, 0, 64 << 20, 0x00020000);
                v4u raX0, raX1, raX2, raX3, raY0, raY1, raY2, raY3; v2u rbX0, rbX1, rbX2, rbX3, rbY0, rbY1, rbY2, rbY3;
                unsigned sgX0, sgX1, sgX2, sgX3, sgY0, sgY1, sgY2, sgY3;
#define PLDU(S, T, k) do { const unsigned ex_ = (unsigned)__builtin_amdgcn_readfirstlane((int)ridx0[(T) * 128 + (k)]); sg##S = rgs0[(T) * 128 + (k)]; \
        ra##S = __builtin_bit_cast(v4u, __builtin_amdgcn_raw_buffer_load_b128(rsT, lane * 16, ex_ * 1536u, 0)); rb##S = __builtin_bit_cast(v2u, __builtin_amdgcn_raw_buffer_load_b64(rsT, lane * 8 + 1024, ex_ * 1536u, 0)); } while (0)
                const int rowl = lane >> 4; const int wl_off = (rowl == 0 ? 0 : rowl == 1 ? 256 : rowl == 2 ? 128 : 384);
#define STEP1(C, P, k, HASNEXT) do { \
        const float d0_ = peer_dot(ra##C##0, rb##C##0, xn0), d1_ = peer_dot(ra##C##1, rb##C##1, xn1), d2_ = peer_dot(ra##C##2, rb##C##2, xn2), d3_ = peer_dot(ra##C##3, rb##C##3, xn3); \
        const unsigned sgr_ = rowl == 0 ? sg##C##0 : rowl == 1 ? sg##C##2 : rowl == 2 ? sg##C##1 : sg##C##3; \
        if (HASNEXT) { PLDU(P##0, 0, (k) + 1); PLDU(P##1, 1, (k) + 1); PLDU(P##2, 2, (k) + 1); PLDU(P##3, 3, (k) + 1); } \
        const auto s01_ = __builtin_amdgcn_permlane32_swap(__float_as_uint(d0_), __float_as_uint(d1_), false, false); const auto s23_ = __builtin_amdgcn_permlane32_swap(__float_as_uint(d2_), __float_as_uint(d3_), false, false); \
        const float p_ = __uint_as_float(s01_[0]) + __uint_as_float(s01_[1]), q_ = __uint_as_float(s23_[0]) + __uint_as_float(s23_[1]); \
        const auto spq_ = __builtin_amdgcn_permlane16_swap(__float_as_uint(p_), __float_as_uint(q_), false, false); \
        float r_ = __uint_as_float(spq_[0]) + __uint_as_float(spq_[1]); \
        r_ += __builtin_bit_cast(float, __builtin_amdgcn_update_dpp(0, __builtin_bit_cast(int, r_), 0xB1, 0xf, 0xf, true)); r_ += __builtin_bit_cast(float, __builtin_amdgcn_update_dpp(0, __builtin_bit_cast(int, r_), 0x4E, 0xf, 0xf, true)); \
        r_ += __builtin_bit_cast(float, __builtin_amdgcn_update_dpp(0, __builtin_bit_cast(int, r_), 0x141, 0xf, 0xf, true)); r_ += __builtin_bit_cast(float, __builtin_amdgcn_update_dpp(0, __builtin_bit_cast(int, r_), 0x140, 0xf, 0xf, true)); \
        const float w_ = gelu_f(r_ * __uint_as_float(sgr_ & 0xffff0000u)) * __uint_as_float(sgr_ << 16); \
        if ((lane & 15) == 0) Wl[wl_off + (k)] = w_; } while (0)
                PLDU(X0, 0, 0); PLDU(X1, 1, 0); PLDU(X2, 2, 0); PLDU(X3, 3, 0);
                for (int k = 0; k < 126; k += 2) { STEP1(X, Y, k, true); STEP1(Y, X, k + 1, true); }
                STEP1(X, Y, 126, true); STEP1(Y, X, 127, false);
#undef PLDU
#undef STEP1
#define PLDV(S, T, k) do { const unsigned ex_ = (unsigned)__builtin_amdgcn_readfirstlane((int)ridx0[(T) * 128 + (k)]); \
        ra##S = __builtin_bit_cast(v4u, __builtin_amdgcn_raw_buffer_load_b128(rsT, lane * 16, ex_ * 1536u + (32u << 20), 0)); rb##S = __builtin_bit_cast(v2u, __builtin_amdgcn_raw_buffer_load_b64(rsT, lane * 8 + 1024, ex_ * 1536u + (32u << 20), 0)); } while (0)
#define STEP2(C, N, k, HASNEXT) do { asm volatile("" ::: "memory");     \
        if (HASNEXT) { PLDV(N##0, 0, (k) + 2); PLDV(N##1, 1, (k) + 2); PLDV(N##2, 2, (k) + 2); PLDV(N##3, 3, (k) + 2); } \
        const float w0_ = Wl[(k)], w1_ = Wl[128 + (k)], w2_ = Wl[256 + (k)], w3_ = Wl[384 + (k)]; \
        peer_axpy_h(ra##C##0, rb##C##0, w0_, oh0); peer_axpy_h(ra##C##1, rb##C##1, w1_, oh1); peer_axpy_h(ra##C##2, rb##C##2, w2_, oh2); peer_axpy_h(ra##C##3, rb##C##3, w3_, oh3); } while (0)
                unsigned oh0[16], oh1[16], oh2[16], oh3[16];
                v4u raZ0, raZ1, raZ2, raZ3; v2u rbZ0, rbZ1, rbZ2, rbZ3;
#pragma unroll
                for (int e = 0; e < 16; ++e) { oh0[e] = 0u; oh1[e] = 0u; oh2[e] = 0u; oh3[e] = 0u; }
                PLDV(X0, 0, 0); PLDV(X1, 1, 0); PLDV(X2, 2, 0); PLDV(X3, 3, 0); PLDV(Y0, 0, 1); PLDV(Y1, 1, 1); PLDV(Y2, 2, 1); PLDV(Y3, 3, 1);
#pragma unroll 1
                for (int k = 0; k < 126; k += 3) { STEP2(X, Z, k, true); STEP2(Y, X, k + 1, true); STEP2(Z, Y, k + 2, true); }
                STEP2(X, Z, 126, false); STEP2(Y, X, 127, false);
                for (int tt = 0; tt < 4; tt += 2) {
                    float oaccA[32], oaccB[32];
#pragma unroll
                    for (int e = 0; e < 16; ++e) { const unsigned ua_ = tt ? oh2[e] : oh0[e], ub_ = tt ? oh3[e] : oh1[e];
                        oaccA[2 * e] = h16lo(ua_); oaccA[2 * e + 1] = h16hi(ua_); oaccB[2 * e] = h16lo(ub_); oaccB[2 * e + 1] = h16hi(ub_); }
#define FINISH(T_, OACC) do { float s_ = 0.f; \
        _Pragma("unroll") for (int q = 0; q < 8; ++q) { const size_t d0 = (size_t)q * 256 + lane * 4; const v2u hb = *(const GAS v2u*)(G_HB + (T_) * DM + d0); \
            const f32x4 a = {__uint_as_float(hb.x << 16), __uint_as_float(hb.x & 0xffff0000u), __uint_as_float(hb.y << 16), __uint_as_float(hb.y & 0xffff0000u)}; \
            _Pragma("unroll") for (int e = 0; e < 4; ++e) { const float y = a[e] + OACC[q * 4 + e]; OACC[q * 4 + e] = y; s_ += y * y; } } \
        const float rstd_ = __builtin_amdgcn_rsqf(wave_sum_dpp(s_) * (1.f / DM) + EPS); \
        _Pragma("unroll") for (int q = 0; q < 8; ++q) { const size_t d0 = (size_t)q * 256 + lane * 4; const f32x4 ga = *(const f32x4*)(G_final_norm + d0); f32x4 o; \
            _Pragma("unroll") for (int e = 0; e < 4; ++e) o[e] = OACC[q * 4 + e] * rstd_ * ga[e]; \
            PROBE_EXPORT(T_, q); \
            __builtin_nontemporal_store(o, (f32x4*)(args.out + (T_) * DM + d0)); } } while (0)
                    FINISH(tg0 + tt, oaccA); FINISH(tg0 + tt + 1, oaccB);
                }
#undef FINISH
#undef PLDV
#undef STEP2
            }
            __syncthreads();
#if defined(PROBE_SEL) && PROBE_SEL >= 7
            asm volatile("s_waitcnt vmcnt(0)" ::: "memory"); __syncthreads();
            if (tid == 0) { __threadfence(); const unsigned old_ = atomicAdd(G_ctl + 192, 1u);
                if (old_ == (unsigned)G - 1u) { __threadfence(); const unsigned long long a_ = __hip_atomic_load((unsigned long long*)(G_ctl + 256 + 2 * (PROBE_SEL - 7)), __ATOMIC_RELAXED, __HIP_MEMORY_SCOPE_AGENT), b_ = __builtin_amdgcn_s_memrealtime();
                    atomicAdd(args.out + (size_t)31 * DM, (float)(b_ - a_) * 0.0001f); } }
#endif
        }
    }
#undef IN
#undef SEAM
#undef G_ws
#undef G_ctl
#undef G_x
#undef G_mem
#undef G_mix_norm
#undef G_w_in
#undef G_b_forget
#undef G_pool_w
#undef G_pool_scale
#undef G_w_out
#undef G_xattn_norm
#undef G_mem_norm
#undef G_xwq
#undef G_xwk
#undef G_xwv
#undef G_xwo
#undef G_peer_norm
#undef G_peer_wq
#undef G_sub_keys
#undef G_peer_u
#undef G_peer_v
#undef G_final_norm
#undef G_W_IN
#undef G_WO1
#undef G_WO2
#undef G_WQ
#undef G_WK
#undef G_WV
#undef G_WO
#undef G_WPQ
#undef G_AEXP
#undef G_W1
#undef G_W2
#undef G_WSC
#undef G_PB
#undef G_MN
#undef G_KX
#undef G_VXT
#undef G_UB
#undef G_VB
#undef G_SU
#undef G_SV
#undef G_XN
#undef G_QX
#undef G_PROJ
#undef G_SCT
#undef G_AMIX
#undef G_OX
#undef G_H
#undef G_HB
#undef G_PP
#undef G_LF
#undef G_SS1
#undef G_SS2

}

constexpr int N_PHASES = 8;
extern "C" void kernel_launch(void* const* d_in, const int* in_sizes, int n_in, void* d_out, int out_size, void* d_ws, size_t ws_size, hipStream_t stream) {
    static int grid = 0;
    if (grid == 0) {
        if (n_in != 20 || in_sizes[0] != TOK * DM || out_size != TOK * DM || ws_size < WS_END) {
            fprintf(stderr, "kernel_launch: unexpected shapes (n_in %d, in0 %d, out %d, ws %zu < %zu)\n", n_in, n_in > 0 ? in_sizes[0] : -1, out_size, ws_size, (size_t)WS_END); grid = -1; return; }
        int dev = 0, cus = 0, per_cu = 0;
        if (hipGetDevice(&dev) != hipSuccess || hipDeviceGetAttribute(&cus, hipDeviceAttributeMultiprocessorCount, dev) != hipSuccess) { grid = -1; return; }
        if (hipFuncSetAttribute((const void*)fwd_kernel, hipFuncAttributeMaxDynamicSharedMemorySize, LDS_BYTES) != hipSuccess) { fprintf(stderr, "kernel_launch: hipFuncSetAttribute failed\n"); grid = -1; return; }
        if (hipOccupancyMaxActiveBlocksPerMultiprocessor(&per_cu, (const void*)fwd_kernel, NTHREADS, LDS_BYTES) != hipSuccess || per_cu < 1) { fprintf(stderr, "kernel_launch: occupancy query says %d\n", per_cu); per_cu = 1; }
        (void)hipGetLastError();
        grid = cus;
        if (grid != 256) fprintf(stderr, "kernel_launch: %d CUs (built for 256)\n", grid);
    }
    if (grid < 0) return;
    (void)hipMemsetAsync((char*)d_ws + WS_CTL, 0, CTL_ZERO_BYTES, stream);
    Args a{};
    for (int i = 0; i < 20; ++i) a.in[i] = (const float*)d_in[i];
    a.out = (float*)d_out; a.ws = (unsigned char*)d_ws; a.pad = DUP_MASK ? 1 : 0;
#if MK_ONE_LAUNCH
    a.ph_lo = 0; a.ph_hi = N_PHASES; a.one_launch = 1;
    void* kargs[] = {&a};
    hipError_t e = hipLaunchCooperativeKernel((const void*)fwd_kernel, dim3(grid), dim3(NTHREADS), kargs, LDS_BYTES, stream);
    if (e != hipSuccess) fprintf(stderr, "kernel_launch: cooperative launch failed: %s\n", hipGetErrorString(e));
#else
    for (int p = 0; p < N_PHASES; ++p) {
        a.ph_lo = p; a.ph_hi = p + 1; a.one_launch = 0;
        hipLaunchKernelGGL(fwd_kernel, dim3(grid), dim3(NTHREADS), LDS_BYTES, stream, a);
    }
#endif
}
```

```cpp
#include <hip/hip_runtime.h>
#include <hip/hip_bf16.h>
#include <cstdio>
#include <cstdint>

#ifndef DUP_MASK
#define DUP_MASK 0
#endif
#ifndef MK_ONE_LAUNCH
#define MK_ONE_LAUNCH 1
#endif

constexpr int BATCH = 2, SEQ = 4096, DM = 2048, TOK = BATCH * SEQ;
constexpr int INC = 4104, POOLW = 1024, FOXH = 8, FOXD = 128;
constexpr int NMEM = 256, XH = 4, XD = 512;
constexpr int PH = 8, PKEYS = 128, PEXP = 16384, TOPK = 16;
constexpr float EPS = 1e-6f;
constexpr float LOG2E = 1.4426950408889634f;

namespace pg8 {
#define PG8_LAS __attribute__((address_space(3)))
typedef unsigned short bf16_t;
typedef short bf16x8 __attribute__((ext_vector_type(8)));
typedef float f32x4 __attribute__((ext_vector_type(4)));
typedef float f32x2 __attribute__((ext_vector_type(2)));
typedef unsigned u32x4 __attribute__((ext_vector_type(4)));
typedef unsigned u32x2 __attribute__((ext_vector_type(2)));
constexpr int BM = 256, BK = 64, HALF = 128, HTB = HALF * BK * 2, STAGE_BYTES = 8 * HTB, NXCD = 8, WGM = 8;

__host__ __device__ __forceinline__ int lds_byte(int r, int c) { const int st = (r >> 4) * 2 + (c >> 5), rr = r & 15, cc = c & 31, ob = rr * 64 + cc * 2; return st * 1024 + (ob ^ (((ob >> 9) & 1) << 5)); }
__host__ __device__ __forceinline__ void stage_rc(int b, int& R, int& C) { const int st = b / 1024, sb = b % 1024, swz = sb ^ (((sb >> 9) & 1) << 5); R = (st >> 1) * 16 + swz / 64; C = (st & 1) * 32 + (swz % 64) / 2; }
__host__ __device__ __forceinline__ int perm32(int rho) { const int n = rho >> 4, i = rho & 15; return 8 * (i >> 2) + 4 * n + (i & 3); }

struct Unit { int pm, pn, z; long aoff, boff; };
struct Gemm { const bf16_t* A; const bf16_t* Bt; int K, lda, ldb; };

struct GSched {
    int nM, nN, nH, nZ, G, c; long sAb, sAh, sBb, sBh; int lda, ldb;
    __device__ __forceinline__ void init(int nM_, int nN_, int G_, int c_, int lda_, int ldb_) { nM = nM_; nN = nN_; nH = 1; nZ = 1; G = G_; c = c_; sAb = sAh = sBb = sBh = 0; lda = lda_; ldb = ldb_; }
    __device__ __forceinline__ bool next(int i, Unit& u) const {
        const long L = (long)i * G + c; const int nwg = nM * nN; if (L >= (long)nwg * nZ) return false;
        const int z = (int)(L / nwg); int wgid = (int)(L % nwg);
        { const int q = nwg / NXCD, r = nwg % NXCD, xcd = wgid % NXCD, off = wgid / NXCD; wgid = (xcd < r ? xcd * (q + 1) : r * (q + 1) + (xcd - r) * q) + off; }
        const int nig = WGM * nN, gid = wgid / nig, fm = gid * WGM, gsz = (nM - fm) < WGM ? (nM - fm) : WGM;
        u.pm = fm + ((wgid % nig) % gsz); u.pn = (wgid % nig) / gsz; u.z = z;
        const int zb = z / nH, zh = z % nH;
        u.aoff = zb * sAb + zh * sAh + (long)u.pm * BM * lda; u.boff = zb * sBb + zh * sBh + (long)u.pn * BM * ldb;
        return true;
    }
    __device__ __forceinline__ void a_ready(const Unit&) const {}
    __device__ __forceinline__ void done(const Unit&) const {}
};

struct OneSched { int pm, pn; long ao, bo;
    __device__ __forceinline__ bool next(int i, Unit& u) const { if (i) return false; u.pm = pm; u.pn = pn; u.z = 0; u.aoff = ao; u.boff = bo; return true; }
    __device__ __forceinline__ void a_ready(const Unit&) const {}
    __device__ __forceinline__ void done(const Unit&) const {} };
__device__ __forceinline__ unsigned cvt_pk_bf16(float lo, float hi) { unsigned r; asm volatile("v_cvt_pk_bf16_f32 %0, %1, %2" : "=v"(r) : "v"(lo), "v"(hi)); return r; }


template <bool NRM> struct EpiStoreT {
    static constexpr bool PERM = true, AFTER_DRAIN = false;
    bf16_t* O; int ldc; long sCb, sCh; int nH;
    const float* ss; float rs_mul;
    int t0, t1; float tscale;
    unsigned* nrm;
    __device__ __forceinline__ void operator()(const f32x4 (&acc)[2][2][4][2], const Unit& u, int wr, int wc, int fr, int fq) const {
        const int row0 = u.pm * BM + wr * 64 + fr, col0 = u.pn * BM + wc * 32 + 8 * fq;
        bf16_t* base = O + (u.z / nH) * sCb + (u.z % nH) * sCh;
        const float ts = (u.pn >= t0 && u.pn < t1) ? tscale : 1.f;
        float mx0 = 0.f, mx1 = 0.f;
#pragma unroll
        for (int ai = 0; ai < 2; ++ai)
#pragma unroll
            for (int m = 0; m < 4; ++m) { const int row = row0 + ai * HALF + m * 16;
                float sc = ts; if (ss) sc *= __builtin_amdgcn_rsqf(ss[row] * (1.f / DM) + EPS) * rs_mul;
                bf16_t* rowp = base + (size_t)row * ldc + col0;
#pragma unroll
                for (int bj = 0; bj < 2; ++bj) { const f32x4 v0 = acc[ai][bj][m][0] * sc, v1 = acc[ai][bj][m][1] * sc;
                    u32x4 w; w.x = cvt_pk_bf16(v0[0], v0[1]); w.y = cvt_pk_bf16(v0[2], v0[3]); w.z = cvt_pk_bf16(v1[0], v1[1]); w.w = cvt_pk_bf16(v1[2], v1[3]);
                    *(u32x4*)(rowp + bj * HALF) = w;
                    if constexpr (NRM) { float q = (v0[0] * v0[0] + v0[1] * v0[1]) + (v0[2] * v0[2] + v0[3] * v0[3]) + (v1[0] * v1[0] + v1[1] * v1[1]) + (v1[2] * v1[2] + v1[3] * v1[3]);
                        q += __shfl_xor(q, 16); q += __shfl_xor(q, 32); if (bj == 0) mx0 = fmaxf(mx0, q); else mx1 = fmaxf(mx1, q); } } }
        if constexpr (NRM) { if (u.pn >= 4 && u.pn < 12) {
#pragma unroll
            for (int o = 1; o < 16; o <<= 1) { mx0 = fmaxf(mx0, __shfl_xor(mx0, o)); mx1 = fmaxf(mx1, __shfl_xor(mx1, o)); }
            if ((threadIdx.x & 63) == 0) { const int kind = u.pn >= 8, b = u.pm >> 4, h2 = ((u.pn - 4) & 3) * 2; unsigned* p = nrm + ((kind * 2 + b) * 8 + h2) * 4 + wc;
                atomicMax(p, __float_as_uint(mx0)); atomicMax(p + 4, __float_as_uint(mx1)); } } }
    }
};
typedef EpiStoreT<false> EpiStore;
template <bool BASE_BF16> struct EpiResid {
    static constexpr bool PERM = true, AFTER_DRAIN = false;
    const void* base; bf16_t* HB; float* ss; int zrows;
    __device__ __forceinline__ void operator()(const f32x4 (&acc)[2][2][4][2], const Unit& u, int wr, int wc, int fr, int fq) const {
        const int row0 = u.z * zrows + u.pm * BM + wr * 64 + fr, col0 = u.pn * BM + wc * 32 + 8 * fq;
#pragma unroll
        for (int ai = 0; ai < 2; ++ai)
#pragma unroll
            for (int m = 0; m < 4; ++m) { const int row = row0 + ai * HALF + m * 16; const size_t off = (size_t)row * DM + col0; float sq = 0.f;
#pragma unroll
                for (int bj = 0; bj < 2; ++bj) {
                    f32x4 b0, b1;
                    if constexpr (BASE_BF16) { const u32x4 r = *(const u32x4*)((const bf16_t*)base + off + bj * HALF);
                        b0 = (f32x4){__uint_as_float(r.x << 16), __uint_as_float(r.x & 0xffff0000u), __uint_as_float(r.y << 16), __uint_as_float(r.y & 0xffff0000u)};
                        b1 = (f32x4){__uint_as_float(r.z << 16), __uint_as_float(r.z & 0xffff0000u), __uint_as_float(r.w << 16), __uint_as_float(r.w & 0xffff0000u)}; }
                    else { b0 = __builtin_nontemporal_load((const f32x4*)((const float*)base + off + bj * HALF)); b1 = __builtin_nontemporal_load((const f32x4*)((const float*)base + off + bj * HALF + 4)); }
                    const f32x4 h0 = b0 + acc[ai][bj][m][0], h1 = b1 + acc[ai][bj][m][1];
                    u32x4 w; w.x = cvt_pk_bf16(h0[0], h0[1]); w.y = cvt_pk_bf16(h0[2], h0[3]); w.z = cvt_pk_bf16(h1[0], h1[1]); w.w = cvt_pk_bf16(h1[2], h1[3]);
                    *(u32x4*)(HB + off + bj * HALF) = w;
                    sq += (h0[0] * h0[0] + h0[1] * h0[1]) + (h0[2] * h0[2] + h0[3] * h0[3]) + (h1[0] * h1[0] + h1[1] * h1[1]) + (h1[2] * h1[2] + h1[3] * h1[3]); }
                sq += __shfl_xor(sq, 16); sq += __shfl_xor(sq, 32);
                if (fq == 0 && ss) atomicAdd(ss + row, sq); }
    }
};
struct EpiF32Col {
    static constexpr bool PERM = true, AFTER_DRAIN = false;
    float* O; int ldc; const float* ss;
    __device__ __forceinline__ void operator()(const f32x4 (&acc)[2][2][4][2], const Unit& u, int wr, int wc, int fr, int fq) const {
        const int row0 = u.pm * BM + wr * 64 + fr, col0 = u.pn * BM + wc * 32 + 8 * fq;
        f32x4 rs[2][2];
#pragma unroll
        for (int bj = 0; bj < 2; ++bj)
#pragma unroll
            for (int n = 0; n < 2; ++n) { const f32x4 s = *(const f32x4*)(ss + col0 + bj * HALF + 4 * n);
#pragma unroll
                for (int e = 0; e < 4; ++e) rs[bj][n][e] = __builtin_amdgcn_rsqf(s[e] * (1.f / DM) + EPS); }
#pragma unroll
        for (int ai = 0; ai < 2; ++ai)
#pragma unroll
            for (int m = 0; m < 4; ++m) { const int key = row0 + ai * HALF + m * 16;
#pragma unroll
                for (int bj = 0; bj < 2; ++bj) { const int tk = col0 + bj * HALF; float* p = O + ((size_t)(tk >> 5) * DM + key) * 32 + (tk & 31);
                    *(f32x4*)p = acc[ai][bj][m][0] * rs[bj][0]; *(f32x4*)(p + 4) = acc[ai][bj][m][1] * rs[bj][1]; } }
    }
};
struct EpiSoftmax {
    static constexpr bool PERM = true, AFTER_DRAIN = true;
    bf16_t* P; int ldc; long sCb, sCh; int nH; const float* ss; float mul; int zrows;
    __device__ __forceinline__ void fused(f32x4 (&acc)[2][2][4][2], const Unit& u, int wr, int wc, int fr, int fq, PG8_LAS unsigned char* lds, int wid, int lane) const {
        PG8_LAS float* Pm = (PG8_LAS float*)lds;
        PG8_LAS float* Ps = (PG8_LAS float*)(lds + 4096);
#pragma unroll
        for (int ai = 0; ai < 2; ++ai)
#pragma unroll
            for (int m = 0; m < 4; ++m) { float mx = -3.0e38f;
                const float rs = __builtin_amdgcn_rsqf(ss[u.z * zrows + u.pm * BM + ai * HALF + wr * 64 + m * 16 + fr] * (1.f / DM) + EPS) * mul;
#pragma unroll
                for (int bj = 0; bj < 2; ++bj)
#pragma unroll
                    for (int n = 0; n < 2; ++n) { const f32x4 x = acc[ai][bj][m][n] * rs; acc[ai][bj][m][n] = x; mx = fmaxf(mx, fmaxf(fmaxf(x[0], x[1]), fmaxf(x[2], x[3]))); }
                mx = fmaxf(mx, __shfl_xor(mx, 16)); mx = fmaxf(mx, __shfl_xor(mx, 32));
                if (fq == 0) Pm[(ai * HALF + wr * 64 + m * 16 + fr) * 4 + wc] = mx; }
        asm volatile("s_waitcnt lgkmcnt(0)" ::: "memory"); __builtin_amdgcn_s_barrier(); asm volatile("" ::: "memory");
#pragma unroll
        for (int ai = 0; ai < 2; ++ai)
#pragma unroll
            for (int m = 0; m < 4; ++m) { const int r = ai * HALF + wr * 64 + m * 16 + fr;
                const f32x4 pm4 = *(const PG8_LAS f32x4*)(Pm + r * 4); const float M = fmaxf(fmaxf(pm4[0], pm4[1]), fmaxf(pm4[2], pm4[3])); float s = 0.f;
#pragma unroll
                for (int bj = 0; bj < 2; ++bj)
#pragma unroll
                    for (int n = 0; n < 2; ++n) { f32x4 x = acc[ai][bj][m][n];
#pragma unroll
                        for (int e = 0; e < 4; ++e) { x[e] = __builtin_amdgcn_exp2f(x[e] - M); s += x[e]; }
                        acc[ai][bj][m][n] = x; }
                s += __shfl_xor(s, 16); s += __shfl_xor(s, 32);
                if (fq == 0) Ps[r * 4 + wc] = s; }
        asm volatile("s_waitcnt lgkmcnt(0)" ::: "memory"); __builtin_amdgcn_s_barrier(); asm volatile("" ::: "memory");
        bf16_t* base = P + (u.z / nH) * sCb + (u.z % nH) * sCh;
        const int row0 = u.pm * BM, col0 = u.pn * BM + wc * 32 + 8 * fq;
#pragma unroll
        for (int ai = 0; ai < 2; ++ai)
#pragma unroll
            for (int m = 0; m < 4; ++m) { const int r = ai * HALF + wr * 64 + m * 16 + fr;
                const f32x4 ps4 = *(const PG8_LAS f32x4*)(Ps + r * 4); const float inv = 1.f / ((ps4[0] + ps4[1]) + (ps4[2] + ps4[3]));
                bf16_t* rowp = base + (size_t)(row0 + r) * ldc + col0;
#pragma unroll
                for (int bj = 0; bj < 2; ++bj) { const f32x4 v0 = acc[ai][bj][m][0] * inv, v1 = acc[ai][bj][m][1] * inv;
                    u32x4 w; w.x = cvt_pk_bf16(v0[0], v0[1]); w.y = cvt_pk_bf16(v0[2], v0[3]); w.z = cvt_pk_bf16(v1[0], v1[1]); w.w = cvt_pk_bf16(v1[2], v1[3]);
                    *(u32x4*)(rowp + bj * HALF) = w; } }
    }
};

template <class Epi, class Sched, bool ALIGN_EPI>
__device__ __forceinline__ void gemm_phase(PG8_LAS unsigned char* lds, const Gemm g, const Sched& S, const Epi& E) {
    const int tid = threadIdx.x, wid = __builtin_amdgcn_readfirstlane(tid >> 6), lane = tid & 63, wr = wid >> 2, wc = wid & 3, fr = lane & 15, fq = lane >> 4;
    const int K = g.K, nt = K / BK;
    unsigned voffA[2], voffB[2];
#pragma unroll
    for (int i = 0; i < 2; ++i) { int R, C; stage_rc(tid * 16 + i * 8192, R, C); const int Rb = Epi::PERM ? ((R & ~31) + perm32(R & 31)) : R;
        voffA[i] = (unsigned)(R * g.lda + C) * 2u; voffB[i] = (unsigned)(Rb * g.ldb + C) * 2u; }
    const size_t kstep = (size_t)(BK * 2);
    const size_t hsA = (size_t)HALF * g.lda * 2, hsB = (size_t)HALF * g.ldb * 2;
    const unsigned ldsw = (unsigned)wid * 1024u;
    const int aoff = lds_byte(wr * 64 + fr, fq * 8), boff = lds_byte(wc * 32 + fr, fq * 8);
#define PG8_SA(b, h) (((b) * 2 + (h)) * HTB)
#define PG8_SB(b, h) ((4 + (b) * 2 + (h)) * HTB)
#define PG8_STAGE(bufoff, gbase, voff) do { _Pragma("unroll") for (int _i = 0; _i < 2; ++_i) \
        __builtin_amdgcn_global_load_lds((const unsigned*)((const char*)(gbase) + (voff)[_i]), (PG8_LAS unsigned*)(lds + (bufoff) + ldsw + _i * 8192), 16, 0, 0); } while (0)
#define PG8_LDA(dst, b, h) do { _Pragma("unroll") for (int m = 0; m < 4; ++m) _Pragma("unroll") for (int k = 0; k < 2; ++k) dst[m][k] = *(const PG8_LAS bf16x8*)(lds + PG8_SA(b, h) + aoff + m * 2048 + k * 1024); } while (0)
#define PG8_LDB(dst, b, h) do { _Pragma("unroll") for (int n = 0; n < 2; ++n) _Pragma("unroll") for (int k = 0; k < 2; ++k) dst[n][k] = *(const PG8_LAS bf16x8*)(lds + PG8_SB(b, h) + boff + n * 2048 + k * 1024); } while (0)
#define PG8_MMA(ai, bj, At, Bt) do { __builtin_amdgcn_s_setprio(1); _Pragma("unroll") for (int m = 0; m < 4; ++m) _Pragma("unroll") for (int n = 0; n < 2; ++n) _Pragma("unroll") for (int k = 0; k < 2; ++k) \
        acc[ai][bj][m][n] = __builtin_amdgcn_mfma_f32_16x16x32_bf16(Bt[n][k], At[m][k], acc[ai][bj][m][n], 0, 0, 0); __builtin_amdgcn_s_setprio(0); } while (0)
#define PG8_WAIT_V(n) asm volatile("s_waitcnt vmcnt(" #n ")" ::: "memory")
#define PG8_WAIT_L(n) asm volatile("s_waitcnt lgkmcnt(" #n ")" ::: "memory")
#define PG8_BAR __builtin_amdgcn_s_barrier()
#define PG8_SCHED __builtin_amdgcn_sched_barrier(0)
    Unit cur, nxt; int ui = 0;
    if (!S.next(0, cur)) return;
    f32x4 acc[2][2][4][2];
#pragma unroll
    for (int a = 0; a < 2; ++a)
#pragma unroll
        for (int b = 0; b < 2; ++b)
#pragma unroll
            for (int m = 0; m < 4; ++m)
#pragma unroll
                for (int n = 0; n < 2; ++n) acc[a][b][m][n] = (f32x4){0.f, 0.f, 0.f, 0.f};
    bf16x8 At[4][2], B0[2][2], B1[2][2];
    const char* cA = (const char*)g.A + (size_t)cur.aoff * 2; const char* cB = (const char*)g.Bt + (size_t)cur.boff * 2;
    S.a_ready(cur);
    PG8_STAGE(PG8_SB(0, 0), cB, voffB); PG8_STAGE(PG8_SB(0, 1), cB + hsB, voffB); PG8_STAGE(PG8_SA(0, 0), cA, voffA); PG8_STAGE(PG8_SA(0, 1), cA + hsA, voffA);
    if (wr == 1) PG8_BAR;
    PG8_WAIT_V(2); PG8_BAR;
    PG8_STAGE(PG8_SB(1, 0), cB + kstep, voffB); PG8_STAGE(PG8_SA(1, 0), cA + kstep, voffA); PG8_STAGE(PG8_SB(1, 1), cB + hsB + kstep, voffB);
    PG8_WAIT_V(6); PG8_BAR;
    for (;;) {
        const bool has_next = S.next(ui + 1, nxt);
        const char* nA = has_next ? (const char*)g.A + (size_t)nxt.aoff * 2 : cA; const char* nB = has_next ? (const char*)g.Bt + (size_t)nxt.boff * 2 : cB;
        for (int t = 0; t < nt; t += 2) {
            const bool last = (t == nt - 2);
            const char* a1 = cA + (size_t)(t + 1) * kstep;
            const char* a2 = last ? nA : cA + (size_t)(t + 2) * kstep; const char* b2 = last ? nB : cB + (size_t)(t + 2) * kstep;
            const char* a3 = a2 + kstep; const char* b3 = b2 + kstep;
            if (last && has_next) S.a_ready(nxt);
            PG8_LDB(B0, 0, 0); PG8_LDB(B1, 0, 1); PG8_SCHED; PG8_LDA(At, 0, 0); PG8_STAGE(PG8_SA(1, 1), a1 + hsA, voffA);
            PG8_WAIT_V(8); PG8_WAIT_L(0); PG8_BAR; PG8_MMA(0, 0, At, B0); PG8_MMA(0, 1, At, B1); PG8_BAR; PG8_SCHED;
            PG8_LDA(At, 0, 1); PG8_STAGE(PG8_SB(0, 0), b2, voffB); PG8_STAGE(PG8_SB(0, 1), b2 + hsB, voffB); PG8_STAGE(PG8_SA(0, 0), a2, voffA);
            PG8_WAIT_V(8); PG8_WAIT_L(0); PG8_BAR; PG8_MMA(1, 0, At, B0); PG8_MMA(1, 1, At, B1); PG8_BAR; PG8_SCHED;
            PG8_LDB(B0, 1, 0); PG8_LDB(B1, 1, 1); PG8_SCHED; PG8_LDA(At, 1, 0); PG8_STAGE(PG8_SA(0, 1), a2 + hsA, voffA);
            PG8_WAIT_V(8); PG8_WAIT_L(0); PG8_BAR; PG8_MMA(0, 0, At, B0); PG8_MMA(0, 1, At, B1); PG8_BAR; PG8_SCHED;
            PG8_LDA(At, 1, 1); PG8_STAGE(PG8_SB(1, 0), b3, voffB); PG8_STAGE(PG8_SB(1, 1), b3 + hsB, voffB); PG8_STAGE(PG8_SA(1, 0), a3, voffA);
            PG8_WAIT_V(8); PG8_WAIT_L(0); PG8_BAR; PG8_MMA(1, 0, At, B0); PG8_MMA(1, 1, At, B1); PG8_BAR; PG8_SCHED;
        }
        if constexpr (ALIGN_EPI) { if (wr == 0) PG8_BAR; }
        if constexpr (!Epi::AFTER_DRAIN) { E(acc, cur, wr, wc, fr, fq); S.done(cur); }
        if (!has_next) break;
#pragma unroll
        for (int a = 0; a < 2; ++a)
#pragma unroll
            for (int b = 0; b < 2; ++b)
#pragma unroll
                for (int m = 0; m < 4; ++m)
#pragma unroll
                    for (int n = 0; n < 2; ++n) acc[a][b][m][n] = (f32x4){0.f, 0.f, 0.f, 0.f};
        cur = nxt; cA = nA; cB = nB; ++ui;
        if constexpr (ALIGN_EPI) { if (wr == 1) PG8_BAR; }
    }
    PG8_WAIT_V(0);
    if constexpr (!ALIGN_EPI) { if (wr == 0) PG8_BAR; }
    PG8_BAR;
    if constexpr (Epi::AFTER_DRAIN) { E.fused(acc, cur, wr, wc, fr, fq, lds, wid, lane); S.done(cur); }
#undef PG8_SA
#undef PG8_SB
#undef PG8_STAGE
#undef PG8_LDA
#undef PG8_LDB
#undef PG8_MMA
#undef PG8_WAIT_V
#undef PG8_WAIT_L
#undef PG8_BAR
#undef PG8_SCHED
}
}

namespace fox {
typedef unsigned short bf16_t;
typedef short bf16x8 __attribute__((ext_vector_type(8)));
typedef short s16x4 __attribute__((ext_vector_type(4)));
typedef float f32x16 __attribute__((ext_vector_type(16)));
typedef float f32x4 __attribute__((ext_vector_type(4)));
typedef unsigned u32x4 __attribute__((ext_vector_type(4)));
constexpr int D = 128, NW = 8, QBLK = 32, KVBLK = 64, QB = NW * QBLK;
constexpr int SHM_V = KVBLK * D * 2, SHM_K = KVBLK * D * 2;
constexpr int LDS_C = 2 * SHM_V + 2 * SHM_K + NW * 64 * 4;
constexpr int LDS_BYTES = LDS_C + SEQ * 4;
constexpr int QP = 4096, OP = 2048;
constexpr float THR = 24.f;
#define KSWZ(row, colB) ((row) * 256 + ((colB) ^ (((row) & 7) << 4)))
#define SBAR() __builtin_amdgcn_sched_barrier(0)
__device__ __forceinline__ int v_st(int k, int c) { const int kk = (k & ~0xC) | ((k & 4) << 1) | ((k & 8) >> 1); return ((kk >> 3) * 4 + (c >> 5)) * 512 + ((kk & 7) * 32 + (c & 31)) * 2; }
__device__ __forceinline__ int v_rd_base(int lane) { return ((lane & 3) << 3) | (((lane >> 2) & 3) << 6) | (((lane >> 4) & 1) << 5) | (((lane >> 5) & 1) << 8); }
constexpr int v_rd_off(int d0, int ks, int half) { return d0 * 512 + ks * 4096 + half * 2048; }
__device__ __forceinline__ int crow(int r, int hi) { return (r & 3) + 8 * (r >> 2) + 4 * hi; }
__device__ __forceinline__ unsigned cvtpk(float lo, float hi) { unsigned r; asm volatile("v_cvt_pk_bf16_f32 %0, %1, %2" : "=v"(r) : "v"(lo), "v"(hi)); return r; }
__device__ __forceinline__ bf16x8 load8(const bf16_t* p) { return *reinterpret_cast<const bf16x8*>(p); }
__device__ __forceinline__ void mask_tile(f32x16& p0, f32x16& p1, int dq) {
    const float NEG = -__builtin_inff();
#pragma unroll
    for (int r = 0; r < 16; ++r) { const int c = (r & 3) + 8 * (r >> 2); if (dq - c < 0) p0[r] = NEG; if (dq - c - 32 < 0) p1[r] = NEG; }
}
__device__ __forceinline__ void bias_tile(f32x16& p0, f32x16& p1, const float* cb) {
#pragma unroll
    for (int i = 0; i < 4; ++i) { const f32x4 c0 = *(const f32x4*)(cb + 8 * i), c1 = *(const f32x4*)(cb + 32 + 8 * i);
#pragma unroll
        for (int j = 0; j < 4; ++j) { p0[4 * i + j] -= c0[j]; p1[4 * i + j] -= c1[j]; } }
}
__device__ __forceinline__ void partialSM(f32x16& p0, f32x16& p1, float& m_reg, float& mn, float& alpha) {
    float pmax = p0[0]; for (int r = 1; r < 16; ++r) pmax = fmaxf(pmax, p0[r]); for (int r = 0; r < 16; ++r) pmax = fmaxf(pmax, p1[r]);
    { auto rr = __builtin_amdgcn_permlane32_swap(__float_as_uint(pmax), __float_as_uint(pmax), false, false);
      pmax = fmaxf(__uint_as_float(rr[0]), __uint_as_float(rr[1])); }
    if (__builtin_expect(__all((pmax - m_reg) <= THR), 1)) { mn = m_reg; alpha = 1.f; }
    else { mn = fmaxf(m_reg, pmax); alpha = __builtin_amdgcn_exp2f(m_reg - mn); m_reg = mn; }
    for (int r = 0; r < 16; ++r) p0[r] = p0[r] - mn; for (int r = 0; r < 16; ++r) p1[r] = p1[r] - mn;
    for (int r = 0; r < 16; ++r) p0[r] = __builtin_amdgcn_exp2f(p0[r]);
}
__device__ __forceinline__ void finishSM(f32x16& p0, f32x16& p1, float alpha, float& l_reg, bf16x8& pa0, bf16x8& pa1, bf16x8& pa2, bf16x8& pa3) {
    for (int r = 0; r < 16; ++r) p1[r] = __builtin_amdgcn_exp2f(p1[r]);
    float ps = 0; for (int r = 0; r < 16; ++r) ps += p0[r]; for (int r = 0; r < 16; ++r) ps += p1[r];
    { auto rr = __builtin_amdgcn_permlane32_swap(__float_as_uint(ps), __float_as_uint(ps), false, false);
      ps = __uint_as_float(rr[0]) + __uint_as_float(rr[1]); }
    l_reg = l_reg * alpha + ps;
#define PK4(P, B_, OUT) do { unsigned a0 = cvtpk(P[B_+0], P[B_+1]), a1 = cvtpk(P[B_+2], P[B_+3]);                          \
        unsigned b0 = cvtpk(P[B_+4], P[B_+5]), b1 = cvtpk(P[B_+6], P[B_+7]);                                             \
        auto r0 = __builtin_amdgcn_permlane32_swap(a0, b0, false, false); auto r1 = __builtin_amdgcn_permlane32_swap(a1, b1, false, false); \
        u32x4 w = {r0[0], r1[0], r0[1], r1[1]}; OUT = *reinterpret_cast<bf16x8*>(&w); } while (0)
    PK4(p0, 0, pa0); PK4(p0, 8, pa1); PK4(p1, 0, pa2); PK4(p1, 8, pa3);
#undef PK4
}
template <int KB>
__device__ __forceinline__ void qkt(f32x16& p0, f32x16& p1, const char* K_lds, int r32, int hi, const bf16x8* qr) {
    p0 = f32x16{}; p1 = f32x16{};
    const char* kb[4];
#pragma unroll
    for (int dd = 0; dd < 4; ++dd) kb[dd] = K_lds + KB * SHM_K + KSWZ(r32, (dd * 16 + hi * 8) * 2);
#pragma unroll
    for (int d0 = 0; d0 < 8; ++d0) { const char* a = kb[d0 & 3] + (d0 >> 2) * 128;
        bf16x8 b0 = *reinterpret_cast<const bf16x8*>(a);
        bf16x8 b1 = *reinterpret_cast<const bf16x8*>(a + 32 * 256);
        p0 = __builtin_amdgcn_mfma_f32_32x32x16_bf16(b0, qr[d0], p0, 0, 0, 0);
        p1 = __builtin_amdgcn_mfma_f32_32x32x16_bf16(b1, qr[d0], p1, 0, 0, 0); }
}
template <int VB>
__device__ __forceinline__ void pv_tile(f32x16* o, int vb0, bf16x8 pa0, bf16x8 pa1, bf16x8 pa2, bf16x8 pa3) {
#define TRRD(dst, off) asm volatile("ds_read_b64_tr_b16 %0, %1 offset:%2" : "=&v"(dst) : "v"(vb0), "i"(off) : "memory")
#define PV_D0(d0) do { s16x4 l0, l1, l2, l3, h0, h1, h2, h3; constexpr int b_ = VB * SHM_V + v_rd_off(d0, 0, 0); \
        TRRD(l0, b_); TRRD(h0, b_ + 2048); TRRD(l1, b_ + 4096); TRRD(h1, b_ + 6144); TRRD(l2, b_ + 8192); TRRD(h2, b_ + 10240); TRRD(l3, b_ + 12288); TRRD(h3, b_ + 14336); \
        asm volatile("s_waitcnt lgkmcnt(0)" ::: "memory"); SBAR();   \
        o[d0] = __builtin_amdgcn_mfma_f32_32x32x16_bf16(pa0, (bf16x8){l0[0], l0[1], l0[2], l0[3], h0[0], h0[1], h0[2], h0[3]}, o[d0], 0, 0, 0);   \
        o[d0] = __builtin_amdgcn_mfma_f32_32x32x16_bf16(pa1, (bf16x8){l1[0], l1[1], l1[2], l1[3], h1[0], h1[1], h1[2], h1[3]}, o[d0], 0, 0, 0);   \
        o[d0] = __builtin_amdgcn_mfma_f32_32x32x16_bf16(pa2, (bf16x8){l2[0], l2[1], l2[2], l2[3], h2[0], h2[1], h2[2], h2[3]}, o[d0], 0, 0, 0);   \
        o[d0] = __builtin_amdgcn_mfma_f32_32x32x16_bf16(pa3, (bf16x8){l3[0], l3[1], l3[2], l3[3], h3[0], h3[1], h3[2], h3[3]}, o[d0], 0, 0, 0); } while (0)
    PV_D0(0); PV_D0(1); PV_D0(2); PV_D0(3);
#undef PV_D0
#undef TRRD
}
struct BlockRef { const bf16_t* Q; const bf16_t* K; const bf16_t* V; bf16_t* O; int P0; };
struct Seam { bf16x8 qr[8]; bf16x8 st_v0, st_v1, st_k0, st_k1; };
#define ROW(p, k0, rr) ((p) + (size_t)((k0) + (rr)) * QP + sc)
#define VMW() asm volatile("s_waitcnt vmcnt(0)" ::: "memory")
#define VMWN(n) asm volatile("s_waitcnt vmcnt(%0)" :: "i"(n) : "memory")
#define SLOAD_H(Kp, Vp, k0) do { S.st_v0 = load8(ROW(Vp, k0, sr)); S.st_v1 = load8(ROW(Vp, k0, 32 + sr)); S.st_k0 = load8(ROW(Kp, k0, sr)); S.st_k1 = load8(ROW(Kp, k0, 32 + sr)); } while (0)
#define SWRITE_HK(bf) do { *(bf16x8*)(K_lds + (bf) * SHM_K + kws) = S.st_k0; *(bf16x8*)(K_lds + (bf) * SHM_K + kws + 32 * 256) = S.st_k1; } while (0)
#define SWRITE_HV(bf) do { *(bf16x8*)(V_lds + (bf) * SHM_V + vst0) = S.st_v0; *(bf16x8*)(V_lds + (bf) * SHM_V + vst1) = S.st_v1; } while (0)
#define SWRITE_H(bf) do { SWRITE_HV(bf); SWRITE_HK(bf); } while (0)
__device__ __forceinline__ void prime(const BlockRef& cur, int j_lo, char* lds, Seam& S) {
    const int tid = threadIdx.x, wid = __builtin_amdgcn_readfirstlane(tid >> 6), lane = tid & 63, r32 = lane & 31, hi = lane >> 5;
    const int sr = tid >> 4, sc = (tid & 15) * 8, kws = KSWZ(sr, sc * 2); char* K_lds = lds + 2 * SHM_V;
    for (int d0 = 0; d0 < 8; ++d0) S.qr[d0] = load8(cur.Q + (size_t)(wid * QBLK + r32) * QP + d0 * 16 + hi * 8);
    SLOAD_H(cur.K, cur.V, j_lo * KVBLK); VMW(); SWRITE_HK(0);
    __syncthreads();
}
__device__ __forceinline__ void block(const BlockRef& cur, const BlockRef& nxt, int j_lo, char* lds, Seam& S) {
    const int tid = threadIdx.x, wid = __builtin_amdgcn_readfirstlane(tid >> 6), lane = tid & 63, r32 = lane & 31, hi = lane >> 5;
    const int NT = (cur.P0 + QB - 1) / KVBLK + 1 - j_lo;
    const int qlo = cur.P0 + wid * QBLK, qm = qlo + r32 - 4 * hi;
    char* V_lds = lds; char* K_lds = lds + 2 * SHM_V;
    float* ws = (float*)(lds + 2 * SHM_V + 2 * SHM_K) + wid * 64; float* li_l = ws, * al_l = ws + 32;
    const float* c_lds = (const float*)(lds + LDS_C) + 4 * hi;
    float m_reg = -1e30f, l_reg = 0; f32x16 o[4] = {};
    const int sr = tid >> 4, sc = (tid & 15) * 8, vst0 = v_st(sr, sc), vst1 = v_st(32 + sr, sc), kws = KSWZ(sr, sc * 2);
    const int vb0 = (int)(uintptr_t)V_lds + v_rd_base(lane);
    const bf16_t* Kh = cur.K; const bf16_t* Vh = cur.V;
#define RESC(a) do { if (__any((a) < 1.f)) { if (hi == 0) al_l[r32] = (a); asm volatile("s_waitcnt lgkmcnt(0)" ::: "memory");              \
                     for (int d_ = 0; d_ < 4; ++d_) for (int r = 0; r < 16; ++r) o[d_][r] *= al_l[crow(r, hi)]; } } while (0)
#define KBASE(t) ((j_lo + (t)) * KVBLK)
#define MASKT(P0_, P1_, t) do { const int kb_ = KBASE(t); bias_tile(P0_, P1_, c_lds + kb_); if (kb_ + KVBLK - 1 > qlo) mask_tile(P0_, P1_, qm - kb_); } while (0)
#define SEAM_K0() do { VMWN(8); SWRITE_HK(0); SBAR(); } while (0)
    f32x16 pA0, pA1, pB0, pB1; float mnA, mnB, alA, alB; bf16x8 pa0, pa1, pa2, pa3;
    SWRITE_HV(0); SBAR();
    if (NT > 1) { SLOAD_H(Kh, Vh, KBASE(1)); }
    SBAR(); qkt<0>(pA0, pA1, K_lds, r32, hi, S.qr);
    MASKT(pA0, pA1, 0); partialSM(pA0, pA1, m_reg, mnA, alA);
    if (NT > 1) { VMW(); SWRITE_H(1); }
    __syncthreads();
#define HALF_STEP(PX0, PX1, mnX, alX, PY0, PY1, alY, t, KB, VB, SB) do {                                                      \
        SBAR(); qkt<KB>(PX0, PX1, K_lds, r32, hi, S.qr);                                                                     \
        finishSM(PY0, PY1, alY, l_reg, pa0, pa1, pa2, pa3); SBAR();                                                           \
        if ((t) + 1 < NT) { SLOAD_H(Kh, Vh, KBASE((t) + 1)); SBAR(); }                                                        \
        pv_tile<VB>(o, vb0, pa0, pa1, pa2, pa3); MASKT(PX0, PX1, (t)); partialSM(PX0, PX1, m_reg, mnX, alX);                 \
        __syncthreads();                                                                                                      \
        if ((t) + 1 < NT) { VMW(); SWRITE_H(SB); }                                                                            \
        RESC(alX); __syncthreads(); } while (0)
    for (int t = 1; t + 1 < NT; t += 2) {
        HALF_STEP(pB0, pB1, mnB, alB, pA0, pA1, alA, t, 1, 0, 0);
        HALF_STEP(pA0, pA1, mnA, alA, pB0, pB1, alB, t + 1, 0, 1, 1);
    }
    const bool even = (NT & 1) == 0;
    if (even) { SBAR(); qkt<1>(pB0, pB1, K_lds, r32, hi, S.qr); SBAR(); }
    SLOAD_H(nxt.K, nxt.V, j_lo * KVBLK); SBAR();
#pragma unroll
    for (int d0 = 0; d0 < 8; ++d0) S.qr[d0] = load8(nxt.Q + (size_t)(wid * QBLK + r32) * QP + d0 * 16 + hi * 8);
    SBAR();
    finishSM(pA0, pA1, alA, l_reg, pa0, pa1, pa2, pa3); SBAR();
    pv_tile<0>(o, vb0, pa0, pa1, pa2, pa3);
    if (even) { MASKT(pB0, pB1, NT - 1); partialSM(pB0, pB1, m_reg, mnB, alB); __syncthreads(); RESC(alB);
        finishSM(pB0, pB1, alB, l_reg, pa0, pa1, pa2, pa3); SBAR(); pv_tile<1>(o, vb0, pa0, pa1, pa2, pa3); }
    SBAR(); SEAM_K0();
    if (hi == 0) li_l[r32] = l_reg; asm volatile("s_waitcnt lgkmcnt(0)" ::: "memory");
    float rli[16];
#pragma unroll
    for (int r = 0; r < 16; ++r) rli[r] = __builtin_amdgcn_rcpf(li_l[crow(r, hi)]);
    bf16_t* Ow = cur.O + (size_t)(wid * QBLK) * OP;
#pragma unroll
    for (int r = 0; r < 16; ++r) { const int orow = crow(r, hi);
#pragma unroll
        for (int d0 = 0; d0 < 4; ++d0) { const float v = o[d0][r] * rli[r];
            const float vn = __shfl_xor(v, 1);
            if ((r32 & 1) == 0) *(unsigned*)(Ow + (size_t)orow * OP + d0 * 32 + r32) = cvtpk(v, vn); } }
    __syncthreads();
#undef RESC
#undef KBASE
#undef MASKT
#undef SEAM_K0
#undef HALF_STEP
}
#undef ROW
#undef VMW
#undef VMWN
#undef SLOAD_H
#undef SWRITE_HK
#undef SWRITE_HV
#undef SWRITE_H
#undef KSWZ
#undef SBAR
}

constexpr int NWAVES = 8, NTHREADS = 512;
constexpr int LDS_BYTES = 147456;
constexpr int LDS_MISC = 145408;
constexpr size_t MiB = 1u << 20;
constexpr size_t WS_CTL = 0, CTL_ZERO_BYTES = 1 * MiB;
#ifndef QSPLIT
#define QSPLIT 512
#endif
constexpr int CW_QUEUE2 = 128;
constexpr int CW_NRM = 512;
constexpr int CW_QUEUE = 64;
constexpr int CW_BAR = 4096;
constexpr size_t CTL_SS1 = 256 * 1024, CTL_SS2 = 320 * 1024;
constexpr size_t WS_LF = 1 * MiB;
constexpr size_t WS_SU = 1 * MiB + 512 * 1024, WS_SV = 1 * MiB + 640 * 1024;
constexpr size_t WS_WIN = 2 * MiB, WS_WO1 = 18 * MiB, WS_WO2 = 26 * MiB, WS_WQ = 34 * MiB, WS_WK = 42 * MiB, WS_WV = 50 * MiB, WS_WO = 58 * MiB;
constexpr size_t WS_WPQ = 66 * MiB, WS_AEXP = 74 * MiB, WS_WSC = 82 * MiB, WS_PB = 90 * MiB, WS_MN = 91 * MiB, WS_KX = 93 * MiB, WS_VXT = 95 * MiB;
constexpr size_t WS_UB = 98 * MiB, WS_VB = 130 * MiB, WS_XN = 226 * MiB, WS_PROJ = 258 * MiB, WS_AMIX = 322 * MiB, WS_H = 354 * MiB, WS_HB = 418 * MiB, WS_P = 450 * MiB, WS_END = 466 * MiB;

#define GAS __attribute__((address_space(1)))
#define LAS __attribute__((address_space(3)))
typedef unsigned short bf16;
typedef unsigned v4u __attribute__((ext_vector_type(4)));
typedef unsigned v2u __attribute__((ext_vector_type(2)));
typedef float f32x4 __attribute__((ext_vector_type(4)));
typedef __bf16 bf16x2_t __attribute__((ext_vector_type(2)));
#define LDS_WAIT() asm volatile("s_waitcnt lgkmcnt(0)" ::: "memory")
__device__ __forceinline__ unsigned f2bf(float f) { unsigned u = __builtin_bit_cast(unsigned, f); return (u + 0x7fffu + ((u >> 16) & 1u)) >> 16; }
__device__ __forceinline__ unsigned pk2(float lo, float hi) { return f2bf(lo) | (f2bf(hi) << 16); }
__device__ __forceinline__ float wave_sum(float v) {
#pragma unroll
    for (int o = 1; o < 64; o <<= 1) v += __shfl_xor(v, o);
    return v;
}

#define XB_TMO      128
#define XB_XCNT(j)  (256  + 64 * (j))
#define XB_XSUB(j)  (1280 + 64 * (j))
#define XB_XGEN(j)  (2304 + 64 * (j))
#define XB_TOP      3328
#define XB_TOPGEN   3392
#define XCD_BAR_WORDS 3456
#define XB_SPIN_CAP (1u << 22)
__device__ __forceinline__ unsigned xb_ld(unsigned* p)              { return __hip_atomic_load(p, __ATOMIC_RELAXED, __HIP_MEMORY_SCOPE_AGENT); }
__device__ __forceinline__ unsigned xb_add(unsigned* p, unsigned v) { return __hip_atomic_fetch_add(p, v, __ATOMIC_RELAXED, __HIP_MEMORY_SCOPE_AGENT); }
__device__ __forceinline__ unsigned xb_xcc_id() { return (unsigned)__builtin_amdgcn_s_getreg((3 << 11) | 20) & 0xFu; }
#define XB_SPIN(cond, bar) do { unsigned _sp = 0; while (cond) { __builtin_amdgcn_s_sleep(1); \
    if ((++_sp & 255u) == 0u) { if (xb_ld(&(bar)[XB_TMO])) break; if (_sp > XB_SPIN_CAP) { atomicAdd(&(bar)[XB_TMO], 1u); break; } } } } while (0)
struct XcdBarrier { unsigned* bar; unsigned x; volatile LAS unsigned* st; };
__device__ __forceinline__ XcdBarrier xcd_barrier_post(unsigned* bar, volatile LAS unsigned* st) {
    XcdBarrier b; b.bar = bar; b.x = xb_xcc_id(); b.st = st;
    if (threadIdx.x == 0) (void)xb_add(&bar[XB_XCNT(b.x)], 1u);
    return b;
}
__device__ __forceinline__ void xcd_barrier_complete(unsigned* bar, unsigned x, unsigned& nloc, unsigned& nx) {
    const unsigned G = gridDim.x * gridDim.y * gridDim.z;
    unsigned sum, cnt, mine, sp = 0u;
    for (;;) {
        sum = 0u; cnt = 0u; mine = 0u;
#pragma unroll
        for (unsigned j = 0; j < 16; ++j) { const unsigned c = xb_ld(&bar[XB_XCNT(j)]); sum += c; cnt += (c > 0u) ? 1u : 0u; mine = (j == x) ? c : mine; }
        if (sum == G) break;
        __builtin_amdgcn_s_sleep(1);
        if ((++sp & 255u) == 0u) { if (xb_ld(&bar[XB_TMO])) break; if (sp > XB_SPIN_CAP) { atomicAdd(&bar[XB_TMO], 1u); break; } }
    }
    nloc = mine > 0u ? mine : 1u; nx = cnt > 0u ? cnt : 1u;
}
__device__ __forceinline__ void xcd_barrier(const XcdBarrier& b) {
    asm volatile("s_waitcnt vmcnt(0)" ::: "memory");
    __syncthreads();
    if (threadIdx.x == 0) {
        unsigned* bar = b.bar;
        __builtin_amdgcn_s_waitcnt(0);
        unsigned nloc = b.st[0], nx = b.st[1];
        if (nloc == 0u) { xcd_barrier_complete(bar, b.x, nloc, nx); b.st[0] = nloc; b.st[1] = nx; }
        const unsigned old = xb_add(&bar[XB_XSUB(b.x)], 1u);
        const unsigned gen = old / nloc;
        if (old + 1u == (gen + 1u) * nloc) {
            __builtin_amdgcn_fence(__ATOMIC_RELEASE, "agent");
            asm volatile("s_waitcnt vmcnt(0)" ::: "memory");
            const unsigned og = xb_add(&bar[XB_TOP], 1u);
            const unsigned tg = og / nx;
            if (og + 1u == (tg + 1u) * nx) xb_add(&bar[XB_TOPGEN], 1u);
            else XB_SPIN(xb_ld(&bar[XB_TOPGEN]) == tg, bar);
            __builtin_amdgcn_fence(__ATOMIC_ACQUIRE, "agent");
            xb_add(&bar[XB_XGEN(b.x)], 1u);
            asm volatile("s_waitcnt vmcnt(0)" ::: "memory");
        } else {
            XB_SPIN(xb_ld(&bar[XB_XGEN(b.x)]) == gen, bar);
            __builtin_amdgcn_fence(__ATOMIC_ACQUIRE, "agent");
            asm volatile("s_waitcnt vmcnt(0)" ::: "memory");
        }
    }
    __syncthreads();
}

struct Args { const float* in[20]; float* out; unsigned char* ws; int ph_lo, ph_hi; int one_launch, pad; };

__device__ __forceinline__ void tr_load(const float* W, int ldw, int nblk, int item, int lane, f32x4 (&tv)[8]) {
    const int kb = item / nblk, nb = item % nblk, k0 = 64 * kb, n0 = 32 * nb;
#pragma unroll
    for (int i = 0; i < 8; ++i) tv[i] = __builtin_nontemporal_load((const GAS f32x4*)(W + (size_t)(k0 + i * 8 + (lane >> 3)) * ldw + n0 + (lane & 7) * 4));
}
__device__ __forceinline__ void tr_store(const f32x4 (&tv)[8], int nblk, bf16* WT, bf16* WT2, int k2lo, int ldt, LAS float* scr, int item, int lane) {
    const int kb = item / nblk, nb = item % nblk, k0 = 64 * kb, n0 = 32 * nb;
#pragma unroll
    for (int i = 0; i < 8; ++i) { const int kk = i * 8 + (lane >> 3); LAS float* d = scr + kk * 33 + (lane & 7) * 4; d[0] = tv[i][0]; d[1] = tv[i][1]; d[2] = tv[i][2]; d[3] = tv[i][3]; }
    LDS_WAIT(); asm volatile("" ::: "memory");
    const int c = lane & 7;
#pragma unroll
    for (int j = 0; j < 4; ++j) { const int n = (lane >> 3) + 8 * j; const LAS float* s = scr + (8 * c) * 33 + n;
        v4u o; o.x = pk2(s[0 * 33], s[1 * 33]); o.y = pk2(s[2 * 33], s[3 * 33]); o.z = pk2(s[4 * 33], s[5 * 33]); o.w = pk2(s[6 * 33], s[7 * 33]);
        *(GAS v4u*)(WT + (size_t)(n0 + n) * ldt + k0 + 8 * c) = o;
        if (WT2 && k0 >= k2lo) *(GAS v4u*)(WT2 + (size_t)(n0 + n) * ldt + k0 + 8 * c) = o; }
    LDS_WAIT(); asm volatile("" ::: "memory");
}
__device__ __forceinline__ void p0_transpose_item(const float* W, int ldw, int nblk, const float* g, bf16* WT, bf16* WT2, int k2lo, int ldt, LAS float* scr, int item, int lane) {
    (void)g; f32x4 tv[8]; tr_load(W, ldw, nblk, item, lane, tv); tr_store(tv, nblk, WT, WT2, k2lo, ldt, scr, item, lane);
}
__device__ __forceinline__ v4u cvt8(const float* p, float s) {
    const f32x4 a = __builtin_nontemporal_load((const GAS f32x4*)p), b = __builtin_nontemporal_load((const GAS f32x4*)(p + 4));
    v4u o; o.x = pk2(a[0] * s, a[1] * s); o.y = pk2(a[2] * s, a[3] * s); o.z = pk2(b[0] * s, b[1] * s); o.w = pk2(b[2] * s, b[3] * s); return o;
}

__device__ __forceinline__ float gelu_f(float v) {
    const float av = fabsf(v), t = __builtin_amdgcn_rcpf(av * 0.2316418882f + 1.0f);
    float q = t * 0.5307027145f + (-0.7265760135f); q = q * t + 0.7107068705f; q = q * t + (-0.142248368f); q = q * t + 0.127414796f; q = q * t;
    const float e = __builtin_amdgcn_exp2f((v * v) * (-0.72134752044f));
    const float m = v * (q * e);
    return v < 0.f ? m : v - m;
}
__device__ __forceinline__ float dot2bf(unsigned a, unsigned b, float c) { return __builtin_amdgcn_fdot2_f32_bf16(__builtin_bit_cast(bf16x2_t, a), __builtin_bit_cast(bf16x2_t, b), c, false); }
__device__ __forceinline__ unsigned fkey(float f) { const unsigned u = __float_as_uint(f); return (u & 0x80000000u) ? ~u : (u | 0x80000000u); }
__device__ __forceinline__ float fdec(unsigned k) { const unsigned u = (k & 0x80000000u) ? (k & 0x7fffffffu) : ~k; return __uint_as_float(u); }


typedef float f32x2v __attribute__((ext_vector_type(2)));
__device__ __forceinline__ float wave_sum_dpp(float v) {
    v += __builtin_bit_cast(float, __builtin_amdgcn_update_dpp(0, __builtin_bit_cast(int, v), 0xB1, 0xf, 0xf, true));
    v += __builtin_bit_cast(float, __builtin_amdgcn_update_dpp(0, __builtin_bit_cast(int, v), 0x4E, 0xf, 0xf, true));
    v += __builtin_bit_cast(float, __builtin_amdgcn_update_dpp(0, __builtin_bit_cast(int, v), 0x141, 0xf, 0xf, true));
    v += __builtin_bit_cast(float, __builtin_amdgcn_update_dpp(0, __builtin_bit_cast(int, v), 0x140, 0xf, 0xf, true));
    const float a = __builtin_bit_cast(float, __builtin_amdgcn_readlane(__builtin_bit_cast(int, v), 0));
    const float b = __builtin_bit_cast(float, __builtin_amdgcn_readlane(__builtin_bit_cast(int, v), 16));
    const float c = __builtin_bit_cast(float, __builtin_amdgcn_readlane(__builtin_bit_cast(int, v), 32));
    const float d = __builtin_bit_cast(float, __builtin_amdgcn_readlane(__builtin_bit_cast(int, v), 48));
    return (a + b) + (c + d);
}
typedef float v32f __attribute__((ext_vector_type(32)));
typedef float v16f __attribute__((ext_vector_type(16)));
typedef unsigned v6u __attribute__((ext_vector_type(6)));
#ifndef FP6_INTERLEAVED
#define FP6_INTERLEAVED 1
#endif
__device__ __forceinline__ v32f dec_fp6(const v4u a, const v2u b) { const v6u w = {a.x, a.y, a.z, a.w, b.x, b.y}; return __builtin_amdgcn_cvt_scalef32_pk32_f32_fp6(w, 1.0f); }
typedef __bf16 v32bf __attribute__((ext_vector_type(32)));
typedef unsigned v16u __attribute__((ext_vector_type(16)));
typedef int v8i_t __attribute__((ext_vector_type(8)));
__device__ __forceinline__ f32x4 peer_mfma(const v4u a, const v8i_t b) {
    const f32x4 z = {0.f, 0.f, 0.f, 0.f};
    return __builtin_amdgcn_mfma_scale_f32_16x16x128_f8f6f4((v8i_t){(int)a.x, (int)a.y, (int)a.z, (int)a.w, 0, 0, 0, 0}, b, z, 4, 0, 0, 0, 0, 0);
}
__device__ __forceinline__ float peer_dot4(const v4u ua, const unsigned (&xnp)[16]) {
    const unsigned d0 = ua.x, d1 = ua.y, d2 = ua.z, d3 = ua.w; float a[4] = {0.f, 0.f, 0.f, 0.f};
#define FP4B(D, B) __builtin_bit_cast(unsigned, __builtin_amdgcn_cvt_scalef32_pk_bf16_fp4(D, 1.0f, B))
    a[0] = dot2bf(FP4B(d0, 0), xnp[0], a[0]); a[1] = dot2bf(FP4B(d0, 1), xnp[1], a[1]); a[2] = dot2bf(FP4B(d0, 2), xnp[2], a[2]); a[3] = dot2bf(FP4B(d0, 3), xnp[3], a[3]);
    a[0] = dot2bf(FP4B(d1, 0), xnp[4], a[0]); a[1] = dot2bf(FP4B(d1, 1), xnp[5], a[1]); a[2] = dot2bf(FP4B(d1, 2), xnp[6], a[2]); a[3] = dot2bf(FP4B(d1, 3), xnp[7], a[3]);
    a[0] = dot2bf(FP4B(d2, 0), xnp[8], a[0]); a[1] = dot2bf(FP4B(d2, 1), xnp[9], a[1]); a[2] = dot2bf(FP4B(d2, 2), xnp[10], a[2]); a[3] = dot2bf(FP4B(d2, 3), xnp[11], a[3]);
    a[0] = dot2bf(FP4B(d3, 0), xnp[12], a[0]); a[1] = dot2bf(FP4B(d3, 1), xnp[13], a[1]); a[2] = dot2bf(FP4B(d3, 2), xnp[14], a[2]); a[3] = dot2bf(FP4B(d3, 3), xnp[15], a[3]);
#undef FP4B
    return (a[0] + a[1]) + (a[2] + a[3]);
}
__device__ __forceinline__ float peer_dot(const v4u ua, const v2u ub, const unsigned (&xnp)[16]) {
    const v6u w = {ua.x, ua.y, ua.z, ua.w, ub.x, ub.y};
    const v16u fu = __builtin_bit_cast(v16u, __builtin_amdgcn_cvt_scalef32_pk32_bf16_fp6(w, 1.0f));
    unsigned fa[16];
#pragma unroll
    for (int i = 0; i < 16; ++i) fa[i] = fu[i];
    float a[4] = {0.f, 0.f, 0.f, 0.f};
#pragma unroll
    for (int i = 0; i < 16; ++i) a[i & 3] = dot2bf(fa[i], xnp[i], a[i & 3]);
    return (a[0] + a[1]) + (a[2] + a[3]);
}
__device__ __forceinline__ float peer_dot_lds(const v4u ua, const v2u ub, const LAS v4u* xl) {
    const v6u w = {ua.x, ua.y, ua.z, ua.w, ub.x, ub.y};
    const v16u fu = __builtin_bit_cast(v16u, __builtin_amdgcn_cvt_scalef32_pk32_bf16_fp6(w, 1.0f));
    unsigned fa[16];
#pragma unroll
    for (int i = 0; i < 16; ++i) fa[i] = fu[i];
    float a[4] = {0.f, 0.f, 0.f, 0.f};
#pragma unroll
    for (int i4 = 0; i4 < 4; ++i4) { const v4u x4 = xl[i4 * 64];
        a[0] = dot2bf(fa[i4 * 4 + 0], x4.x, a[0]); a[1] = dot2bf(fa[i4 * 4 + 1], x4.y, a[1]); a[2] = dot2bf(fa[i4 * 4 + 2], x4.z, a[2]); a[3] = dot2bf(fa[i4 * 4 + 3], x4.w, a[3]); }
    return (a[0] + a[1]) + (a[2] + a[3]);
}
typedef _Float16 h16x2 __attribute__((ext_vector_type(2)));
__device__ __forceinline__ unsigned pkfma_h(unsigned a, unsigned b, unsigned c) { return __builtin_bit_cast(unsigned, __builtin_elementwise_fma(__builtin_bit_cast(h16x2, a), __builtin_bit_cast(h16x2, b), __builtin_bit_cast(h16x2, c))); }
__device__ __forceinline__ float h16lo(unsigned u) { return (float)__builtin_bit_cast(h16x2, u).x; }
__device__ __forceinline__ float h16hi(unsigned u) { return (float)__builtin_bit_cast(h16x2, u).y; }
__device__ __forceinline__ void peer_axpy_h4(const v4u va, float w, unsigned (&oh)[16]) {
    const h16x2 w2 = {(_Float16)w, (_Float16)w}; const unsigned wu = __builtin_bit_cast(unsigned, w2);
    const unsigned d0 = va.x, d1 = va.y, d2 = va.z, d3 = va.w;
#define FP4PAIR(D, B) __builtin_bit_cast(unsigned, __builtin_amdgcn_cvt_scalef32_pk_f16_fp4(D, 1.0f, B))
    oh[0] = pkfma_h(FP4PAIR(d0, 0), wu, oh[0]); oh[1] = pkfma_h(FP4PAIR(d0, 1), wu, oh[1]); oh[2] = pkfma_h(FP4PAIR(d0, 2), wu, oh[2]); oh[3] = pkfma_h(FP4PAIR(d0, 3), wu, oh[3]);
    oh[4] = pkfma_h(FP4PAIR(d1, 0), wu, oh[4]); oh[5] = pkfma_h(FP4PAIR(d1, 1), wu, oh[5]); oh[6] = pkfma_h(FP4PAIR(d1, 2), wu, oh[6]); oh[7] = pkfma_h(FP4PAIR(d1, 3), wu, oh[7]);
    oh[8] = pkfma_h(FP4PAIR(d2, 0), wu, oh[8]); oh[9] = pkfma_h(FP4PAIR(d2, 1), wu, oh[9]); oh[10] = pkfma_h(FP4PAIR(d2, 2), wu, oh[10]); oh[11] = pkfma_h(FP4PAIR(d2, 3), wu, oh[11]);
    oh[12] = pkfma_h(FP4PAIR(d3, 0), wu, oh[12]); oh[13] = pkfma_h(FP4PAIR(d3, 1), wu, oh[13]); oh[14] = pkfma_h(FP4PAIR(d3, 2), wu, oh[14]); oh[15] = pkfma_h(FP4PAIR(d3, 3), wu, oh[15]);
#undef FP4PAIR
}
__device__ __forceinline__ void peer_axpy_h(const v4u va, const v2u vb, float w, unsigned (&oh)[16]) {
    const v6u wv = {va.x, va.y, va.z, va.w, vb.x, vb.y};
    const v16u fu = __builtin_bit_cast(v16u, __builtin_amdgcn_cvt_scalef32_pk32_f16_fp6(wv, 1.0f));
    unsigned fa[16];
#pragma unroll
    for (int i = 0; i < 16; ++i) fa[i] = fu[i];
    const h16x2 w2 = {(_Float16)w, (_Float16)w}; const unsigned wu = __builtin_bit_cast(unsigned, w2);
#pragma unroll
    for (int i = 0; i < 16; ++i) oh[i] = pkfma_h(fa[i], wu, oh[i]);
}
__device__ __forceinline__ void peer_axpy(const v4u va, const v2u vb, float w, float (&oacc)[32]) {
    const v32f f = dec_fp6(va, vb);
#pragma unroll
    for (int i = 0; i < 32; ++i) oacc[i] = fmaf(w, f[i], oacc[i]);
}


template <int NR, bool FP4>
__device__ __forceinline__ void conv_rows_fp6(const float* srow0, unsigned char* drow0, float* sc0, int lane) {
    f32x4 v[NR][8]; float am[NR];
#pragma unroll
    for (int q = 0; q < 8; ++q)
#pragma unroll
        for (int r = 0; r < NR; ++r) v[r][q] = __builtin_nontemporal_load((const GAS f32x4*)(srow0 + (size_t)r * DM + lane * 4 + q * 256));
#pragma unroll
    for (int r = 0; r < NR; ++r) { am[r] = 0.f;
#pragma unroll
        for (int q = 0; q < 8; ++q) am[r] = fmaxf(am[r], fmaxf(fmaxf(fabsf(v[r][q][0]), fabsf(v[r][q][1])), fmaxf(fabsf(v[r][q][2]), fabsf(v[r][q][3])))); }
#pragma unroll
    for (int o = 1; o < 64; o <<= 1)
#pragma unroll
        for (int r = 0; r < NR; ++r) am[r] = fmaxf(am[r], __shfl_xor(am[r], o));
#pragma unroll
    for (int r = 0; r < NR; ++r) {
        const float top = FP4 ? 6.0f : 7.5f;
        int ex = 0; if (am[r] > 0.f) { (void)frexpf(am[r], &ex); ex = 3 - ex; if (ldexpf(am[r], ex) > top) ex -= 1; }
        const float sc = ldexpf(1.f, ex);
        if (lane == 0) sc0[r] = ldexpf(1.f, -ex);
        if constexpr (FP4) {
            unsigned char* drow = drow0 + (size_t)r * 1024; v4u w = {0u, 0u, 0u, 0u};
#pragma unroll
            for (int j = 0; j < 4; ++j) { unsigned wj = 0u;
                wj = __builtin_amdgcn_cvt_scalef32_pk_fp4_f32(wj, v[r][2 * j][0] * sc, v[r][2 * j][1] * sc, 1.0f, 0); wj = __builtin_amdgcn_cvt_scalef32_pk_fp4_f32(wj, v[r][2 * j][2] * sc, v[r][2 * j][3] * sc, 1.0f, 1);
                wj = __builtin_amdgcn_cvt_scalef32_pk_fp4_f32(wj, v[r][2 * j + 1][0] * sc, v[r][2 * j + 1][1] * sc, 1.0f, 2); wj = __builtin_amdgcn_cvt_scalef32_pk_fp4_f32(wj, v[r][2 * j + 1][2] * sc, v[r][2 * j + 1][3] * sc, 1.0f, 3);
                if (j == 0) w.x = wj; else if (j == 1) w.y = wj; else if (j == 2) w.z = wj; else w.w = wj; }
            *(GAS v4u*)(drow + lane * 16) = w;
        } else {
            v16f xa, xb;
#pragma unroll
            for (int i = 0; i < 16; ++i) { xa[i] = v[r][(2 * i) >> 2][(2 * i) & 3] * sc; xb[i] = v[r][(2 * i + 1) >> 2][(2 * i + 1) & 3] * sc; }
            const v6u w = __builtin_amdgcn_cvt_scalef32_2xpk16_fp6_f32(xa, xb, 1.0f);
            unsigned char* drow = drow0 + (size_t)r * 1536;
            *(GAS v4u*)(drow + lane * 16) = (v4u){w[0], w[1], w[2], w[3]};
            *(GAS v2u*)(drow + 1024 + lane * 8) = (v2u){w[4], w[5]};
        }
    }
}

#if defined(PROBE_SEL) && PROBE_SEL < 7
#define PROBE_EXPORT(T_, q) do { if ((T_) == 0 && lane == 0 && (q) == 0) { const unsigned long long a_ = ((unsigned long long)MISC[33 + 2 * PROBE_SEL] << 32) | MISC[32 + 2 * PROBE_SEL], b_ = ((unsigned long long)MISC[35 + 2 * PROBE_SEL] << 32) | MISC[34 + 2 * PROBE_SEL]; o[0] += (float)(b_ - a_) * 0.001f; } } while (0)
#else
#define PROBE_EXPORT(T_, q) do { } while (0)
#endif
__global__ void __launch_bounds__(NTHREADS, 2) fwd_kernel(Args args) {
    extern __shared__ __attribute__((aligned(16))) unsigned char lds[];
    LAS unsigned char* ldsL = (LAS unsigned char*)lds;
    volatile LAS unsigned* MISC = (volatile LAS unsigned*)(ldsL + LDS_MISC);
    const int tid = threadIdx.x, lane = tid & 63, wave = __builtin_amdgcn_readfirstlane(tid >> 6);
    const int G = gridDim.x; const int bx = blockIdx.x; const int vcu = (G % 8 == 0) ? (bx % 8) * (G / 8) + bx / 8 : bx;
#define G_ws (args.ws)
#define G_ctl ((unsigned*)(args.ws + WS_CTL))
#define G_x (args.in[0])
#define G_mem (args.in[1])
#define G_mix_norm (args.in[2])
#define G_w_in (args.in[3])
#define G_b_forget (args.in[4])
#define G_pool_w (args.in[5])
#define G_pool_scale (args.in[6])
#define G_w_out (args.in[7])
#define G_xattn_norm (args.in[8])
#define G_mem_norm (args.in[9])
#define G_xwq (args.in[10])
#define G_xwk (args.in[11])
#define G_xwv (args.in[12])
#define G_xwo (args.in[13])
#define G_peer_norm (args.in[14])
#define G_peer_wq (args.in[15])
#define G_sub_keys (args.in[16])
#define G_peer_u (args.in[17])
#define G_peer_v (args.in[18])
#define G_final_norm (args.in[19])
#define G_W_IN ((bf16*)(args.ws + WS_WIN))
#define G_WO1 ((bf16*)(args.ws + WS_WO1))
#define G_WO2 ((bf16*)(args.ws + WS_WO2))
#define G_WQ ((bf16*)(args.ws + WS_WQ))
#define G_WK ((bf16*)(args.ws + WS_WK))
#define G_WV ((bf16*)(args.ws + WS_WV))
#define G_WO ((bf16*)(args.ws + WS_WO))
#define G_WPQ ((bf16*)(args.ws + WS_WPQ))
#define G_AEXP ((bf16*)(args.ws + WS_AEXP))
#define G_W1 ((bf16*)(args.ws + WS_AEXP))
#define G_W2 ((bf16*)(args.ws + WS_WPQ))
#define G_WSC ((bf16*)(args.ws + WS_WSC))
#define G_PB ((bf16*)(args.ws + WS_PB))
#define G_MN ((bf16*)(args.ws + WS_MN))
#define G_KX ((bf16*)(args.ws + WS_KX))
#define G_VXT ((bf16*)(args.ws + WS_VXT))
#define G_UB (args.ws + WS_UB)
#define G_VB (args.ws + WS_VB)
#define G_SU ((float*)(args.ws + WS_SU))
#define G_SV ((float*)(args.ws + WS_SV))
#define G_XN ((bf16*)(args.ws + WS_XN))
#define G_QX ((bf16*)(args.ws + WS_XN))
#define G_PROJ ((bf16*)(args.ws + WS_PROJ))
#define G_SCT ((float*)(args.ws + WS_PROJ))
#define G_AMIX ((bf16*)(args.ws + WS_AMIX))
#define G_OX ((bf16*)(args.ws + WS_AMIX))
#define G_H ((float*)(args.ws + WS_H))
#define G_HB ((bf16*)(args.ws + WS_HB))
#define G_PP ((bf16*)(args.ws + WS_P))
#define G_LF ((float*)(args.ws + WS_LF))
#define G_SS1 ((float*)(args.ws + CTL_SS1))
#define G_SS2 ((float*)(args.ws + CTL_SS2))

    for (int u = tid; u < (LDS_BYTES - LDS_MISC) / 4; u += NTHREADS) ((LAS unsigned*)(ldsL + LDS_MISC))[u] = 0u;
    __syncthreads();
    XcdBarrier bar; bar.bar = G_ctl + CW_BAR; bar.x = 0; bar.st = nullptr;
    if (args.one_launch) bar = xcd_barrier_post(G_ctl + CW_BAR, MISC + 8);
    const int lo = args.ph_lo, hi = args.ph_hi;
#ifndef PH_MASK
#define PH_MASK 0xff
#endif
#define IN(k) (((PH_MASK >> (k)) & 1) && lo <= (k) && (k) < hi)
#ifdef PROBE_SEL
#define STAMP(i) do { if (bx == 0 && tid == 0) { const unsigned long long t_ = __builtin_amdgcn_s_memrealtime(); MISC[32 + 2 * (i)] = (unsigned)t_; MISC[33 + 2 * (i)] = (unsigned)(t_ >> 32); } } while (0)
#else
#define STAMP(i) do { } while (0)
#endif
#define SEAM(k) do { if (IN(k) && IN((k) + 1)) xcd_barrier(bar); STAMP((k) + 1); } while (0)
#define TABLE_CHUNK(c_) do { const int r_ = (c_) * 32 + wave * 4; const int rr_ = r_ & (PEXP - 1); \
        if (r_ >> 14) conv_rows_fp6<4, true>(G_peer_v + (size_t)rr_ * DM, G_VB + (size_t)rr_ * 1024, G_SV + rr_, lane); \
        else conv_rows_fp6<4, true>(G_peer_u + (size_t)rr_ * DM, G_UB + (size_t)rr_ * 1024, G_SU + rr_, lane); } while (0)
    STAMP(0);
#if defined(PROBE_SEL) && PROBE_SEL >= 7
    if (bx == 0 && tid == 0) __hip_atomic_store((unsigned long long*)(G_ctl + 256), (unsigned long long)__builtin_amdgcn_s_memrealtime(), __ATOMIC_RELAXED, __HIP_MEMORY_SCOPE_AGENT);
#endif
    const int gw = vcu * NWAVES + wave, NGW = G * NWAVES;
    const int gt = vcu * NTHREADS + tid, NGT = G * NTHREADS;

    if (IN(0)) for (int rep_ = 0; rep_ < (((DUP_MASK >> 0) & 1) ? args.pad + 1 : 1); ++rep_) {
        LAS float* wf = (LAS float*)ldsL;
        LAS float* scr = (LAS float*)(ldsL + 65536 + wave * 8704);
#pragma unroll
        for (int i = 0; i < DM / NTHREADS; ++i) { const int d = tid + i * NTHREADS; const f32x4 a = *(const GAS f32x4*)(G_w_in + (size_t)d * INC + 4096), b = *(const GAS f32x4*)(G_w_in + (size_t)d * INC + 4100);
            wf[d] = a[0]; wf[DM + d] = a[1]; wf[2 * DM + d] = a[2]; wf[3 * DM + d] = a[3]; wf[4 * DM + d] = b[0]; wf[5 * DM + d] = b[1]; wf[6 * DM + d] = b[2]; wf[7 * DM + d] = b[3]; }
        __syncthreads();
        f32x4 vnx[8];
        if (gw < TOK) {
#pragma unroll
            for (int j = 0; j < 8; ++j) vnx[j] = __builtin_nontemporal_load((const GAS f32x4*)(G_x + (size_t)gw * DM) + lane + 64 * j); }
        for (int m = gw; m < TOK; m += NGW) {
            const GAS f32x4* gr = (const GAS f32x4*)G_mix_norm + lane;
            f32x4 v[8]; float s = 0.f;
#pragma unroll
            for (int j = 0; j < 8; ++j) v[j] = vnx[j];
            if (m + NGW < TOK) {
#pragma unroll
                for (int j = 0; j < 8; ++j) vnx[j] = __builtin_nontemporal_load((const GAS f32x4*)(G_x + (size_t)(m + NGW) * DM) + lane + 64 * j); }
#pragma unroll
            for (int j = 0; j < 8; ++j) s += (v[j][0] * v[j][0] + v[j][1] * v[j][1]) + (v[j][2] * v[j][2] + v[j][3] * v[j][3]);
            const float rstd = __builtin_amdgcn_rsqf(wave_sum_dpp(s) * (1.f / DM) + EPS);
            GAS v2u* o8 = (GAS v2u*)(G_XN + (size_t)m * DM) + lane;
#pragma unroll
            for (int j = 0; j < 8; ++j) { const f32x4 gg = gr[64 * j]; v[j] = v[j] * rstd * gg;
                v2u o; o.x = pk2(v[j][0], v[j][1]); o.y = pk2(v[j][2], v[j][3]); o8[64 * j] = o; }
            float fl[8];
#pragma unroll
            for (int h = 0; h < 8; ++h) { float a = 0.f;
#pragma unroll
                for (int j = 0; j < 8; ++j) { const f32x4 w = *(const LAS f32x4*)(wf + h * DM + j * 256 + lane * 4); a += (v[j][0] * w[0] + v[j][1] * w[1]) + (v[j][2] * w[2] + v[j][3] * w[3]); }
                fl[h] = wave_sum_dpp(a);
                asm volatile("" ::: "memory"); }
            if (lane < 8) { float f = fl[0];
#pragma unroll
                for (int h = 1; h < 8; ++h) f = (lane == h) ? fl[h] : f;
                f += G_b_forget[lane];
                const float ls = fminf(f, 0.f) - log1pf(expf(-fabsf(f)));
                const int b = m / SEQ, sq = m % SEQ; G_LF[(size_t)(b * FOXH + lane) * SEQ + sq] = ls; }
        }
        for (int m = gw; m < BATCH * NMEM; m += NGW) {
            const GAS f32x4* xr = (const GAS f32x4*)(G_mem + (size_t)m * DM) + lane; const GAS f32x4* gr = (const GAS f32x4*)G_mem_norm + lane;
            f32x4 v[8]; float s = 0.f;
#pragma unroll
            for (int j = 0; j < 8; ++j) { v[j] = xr[64 * j]; s += (v[j][0] * v[j][0] + v[j][1] * v[j][1]) + (v[j][2] * v[j][2] + v[j][3] * v[j][3]); }
            const float rstd = __builtin_amdgcn_rsqf(wave_sum_dpp(s) * (1.f / DM) + EPS);
            GAS v2u* o8 = (GAS v2u*)(G_MN + (size_t)m * DM) + lane;
#pragma unroll
            for (int j = 0; j < 8; ++j) { const f32x4 gg = gr[64 * j]; v[j] = v[j] * rstd * gg; v2u o; o.x = pk2(v[j][0], v[j][1]); o.y = pk2(v[j][2], v[j][3]); o8[64 * j] = o; }
        }
        {
            constexpr int I_IN = (DM / 64) * (4096 / 32), I_SQ = (DM / 64) * (DM / 32);
            constexpr int NITEMS = I_IN + 3 * I_SQ;
#define TR_SRC(it_, W_, ldw_, nblk_, r_) do { r_ = (it_); if (r_ < I_IN) { W_ = G_w_in; ldw_ = INC; nblk_ = 4096 / 32; } else { r_ -= I_IN; ldw_ = DM; nblk_ = DM / 32; \
        if (r_ < I_SQ) W_ = G_w_out; else if (r_ < 2 * I_SQ) { W_ = G_xwk; r_ -= I_SQ; } else { W_ = G_xwv; r_ -= 2 * I_SQ; } } } while (0)
            f32x4 tvn[8]; const float* Wn; int ldwn, nblkn, rn;
            if (gw < NITEMS) { TR_SRC(gw, Wn, ldwn, nblkn, rn); tr_load(Wn, ldwn, nblkn, rn, lane, tvn); }
            for (int it = gw; it < NITEMS; it += NGW) {
                f32x4 tvc[8];
#pragma unroll
                for (int i = 0; i < 8; ++i) tvc[i] = tvn[i];
                const int nblkc = nblkn, rc = rn;
                if (it + NGW < NITEMS) { TR_SRC(it + NGW, Wn, ldwn, nblkn, rn); tr_load(Wn, ldwn, nblkn, rn, lane, tvn); }
                int r = it;
                if (r < I_IN) { tr_store(tvc, nblkc, G_W_IN, nullptr, 0, DM, scr, rc, lane); continue; } r -= I_IN;
                if (r < I_SQ) { tr_store(tvc, nblkc, G_WO1, G_WO2, POOLW, DM, scr, rc, lane); continue; } r -= I_SQ;
                if (r < I_SQ) { tr_store(tvc, nblkc, G_WK, nullptr, 0, DM, scr, rc, lane); continue; }
                tr_store(tvc, nblkc, G_WV, nullptr, 0, DM, scr, rc, lane);
            }
#undef TR_SRC
        }
        for (int i0 = gt; i0 < DM * DM / 8; i0 += 2 * NGT) {
#pragma unroll
            for (int u = 0; u < 2; ++u) { const int i = i0 + u * NGT; if (i < DM * DM / 8) {
                const int d = i / (DM / 8);
                const v4u o1 = cvt8(G_peer_wq + (size_t)i * 8, G_peer_norm[d]);
                const v4u o2 = cvt8(G_xwq + (size_t)i * 8, G_xattn_norm[d]);
                *(GAS v4u*)(G_WPQ + (size_t)i * 8) = o1; *(GAS v4u*)(G_WQ + (size_t)i * 8) = o2; } }
        }
        for (int i = gt; i < DM * 256 / 8; i += NGT) {
            const int r = i >> 5, c0 = (i & 31) * 8; const int hc = r >> 7;
            v4u o3 = {0u, 0u, 0u, 0u}; if ((c0 >> 7) == (hc & 1)) o3 = cvt8(G_sub_keys + (size_t)r * 128 + (c0 & 127), 1.f);
            *(GAS v4u*)(G_AEXP + (size_t)i * 8) = o3; }
        for (int i = gt; i < 4 * 256 * 256 / 8; i += NGT) {
            const int g = i / (256 * 256 / 8), d0 = (i % 32) * 8; const float* ps = G_pool_scale + g * 256 + d0; const float* p = G_pool_w + (size_t)i * 8;
            v4u o; o.x = pk2(p[0] * ps[0], p[1] * ps[1]); o.y = pk2(p[2] * ps[2], p[3] * ps[3]); o.z = pk2(p[4] * ps[4], p[5] * ps[5]); o.w = pk2(p[6] * ps[6], p[7] * ps[7]);
            *(GAS v4u*)(G_PB + (size_t)i * 8) = o; }
        __syncthreads();
    }
    SEAM(0);

    if (IN(1)) for (int rep_ = 0; rep_ < (((DUP_MASK >> 1) & 1) ? args.pad + 1 : 1); ++rep_) {
        pg8::Gemm g{G_XN, G_W_IN, DM, DM, DM}; pg8::GSched S; S.init(TOK / 256, 4096 / 256, G, bx, DM, DM);
        pg8::EpiStoreT<true> E{G_PROJ, 4096, 0, 0, 1, nullptr, 1.f, 4, 8, 0.08838834764831845f * LOG2E, (unsigned*)G_ctl + CW_NRM};
        pg8::gemm_phase<pg8::EpiStoreT<true>, pg8::GSched, true>(ldsL, g, S, E);
    }
    SEAM(1);

    if (IN(2)) for (int rep_ = 0; rep_ < (((DUP_MASK >> 2) & 1) ? args.pad + 1 : 1); ++rep_) {
        for (int it = vcu; it < TOK / 32; it += G) {
            const int ch = (tid & 127) * 8, rsub = tid >> 7, r0 = it * 32 + rsub * 8, w = 2 << (ch >> 8);
            const int s0 = r0 % SEQ;
            float acc[8];
#pragma unroll
            for (int e = 0; e < 8; ++e) acc[e] = 0.f;
            for (int k = 1; k < w; ++k) { if (s0 - k >= 0) { const v4u v = *(const GAS v4u*)(G_PROJ + (size_t)(r0 - k) * 4096 + ch);
#pragma unroll
                    for (int e = 0; e < 4; ++e) { acc[2 * e] += __uint_as_float(v[e] << 16); acc[2 * e + 1] += __uint_as_float(v[e] & 0xffff0000u); } } }
            for (int rr = 0; rr < 8; ++rr) {
                const v4u v = *(const GAS v4u*)(G_PROJ + (size_t)(r0 + rr) * 4096 + ch); float cur[8];
#pragma unroll
                for (int e = 0; e < 4; ++e) { cur[2 * e] = __uint_as_float(v[e] << 16); cur[2 * e + 1] = __uint_as_float(v[e] & 0xffff0000u); }
                const int sp = s0 + rr; const float inv = 1.f / (float)((sp + 1 < w) ? sp + 1 : w);
                v4u o;
#pragma unroll
                for (int e = 0; e < 8; ++e) acc[e] += cur[e];
                o.x = pk2(acc[0] * inv - cur[0], acc[1] * inv - cur[1]); o.y = pk2(acc[2] * inv - cur[2], acc[3] * inv - cur[3]);
                o.z = pk2(acc[4] * inv - cur[4], acc[5] * inv - cur[5]); o.w = pk2(acc[6] * inv - cur[6], acc[7] * inv - cur[7]);
                *(GAS v4u*)(G_AMIX + (size_t)(r0 + rr) * DM + ch) = o;
                if (sp - w + 1 >= 0) { const v4u vo = *(const GAS v4u*)(G_PROJ + (size_t)(r0 + rr - w + 1) * 4096 + ch);
#pragma unroll
                    for (int e = 0; e < 4; ++e) { acc[2 * e] -= __uint_as_float(vo[e] << 16); acc[2 * e + 1] -= __uint_as_float(vo[e] & 0xffff0000u); } }
            }
        }
        const int a_bh = vcu >> 4, a_qb = vcu & 15;
        if (a_qb < 8 && vcu < 256) {
            const int e = a_qb < 2 ? a_bh * 2 + a_qb : 32 + a_bh * 6 + (a_qb - 2);
            pg8::Gemm g; pg8::EpiStore E{nullptr, DM, 0, 0, 1, nullptr, 1.f, 0, 0, 1.f, nullptr};
            int pm, pn;
            if (e < 16)      { pm = e >> 3; pn = e & 7; g = pg8::Gemm{G_MN, G_WK, DM, DM, DM}; E.O = G_KX; E.ldc = DM; }
            else if (e < 32) { const int q = e - 16; pm = q >> 3; pn = q & 7; g = pg8::Gemm{G_MN, G_WV, DM, DM, DM}; E.O = G_VXT; E.ldc = DM; }
            else if (e < 96) { const int q = e - 32; pm = q >> 3; pn = q & 7; g = pg8::Gemm{G_AEXP, G_WPQ + pm * 256, 256, 256, DM}; E.O = G_WSC; E.ldc = DM; }
            else             { const int q = e - 96; const int gg = q >> 3; pm = q & 7; pn = 0;
                               g = pg8::Gemm{G_WO1 + gg * 256, G_PB + (size_t)gg * 65536, 256, DM, 256}; E.O = G_WO2 + gg * 256; E.ldc = DM; }
            const pg8::OneSched S1{pm, pn, (long)pm * 256 * g.lda, (long)pn * 256 * g.ldb};
            pg8::gemm_phase<pg8::EpiStore, pg8::OneSched, false>(ldsL, g, S1, E);
        }
        if (vcu < 256) {
            const int b = a_bh >> 3, h = a_bh & 7;
            float* c_lds = (float*)(lds + fox::LDS_C);
            if (wave == 0) {
                const float* lf = G_LF + (size_t)a_bh * SEQ + lane * 64; float loc[64]; float run = 0.f;
#pragma unroll
                for (int i = 0; i < 16; ++i) { const f32x4 v = *(const f32x4*)(lf + 4 * i);
#pragma unroll
                    for (int e = 0; e < 4; ++e) { run += v[e]; loc[4 * i + e] = run; } }
                float incl = run;
#pragma unroll
                for (int o = 1; o < 64; o <<= 1) { const float t = __shfl_up(incl, o); if (lane >= o) incl += t; }
                const float excl = incl - run;
#pragma unroll
                for (int i = 0; i < 16; ++i) { f32x4 v;
#pragma unroll
                    for (int e = 0; e < 4; ++e) v[e] = (loc[4 * i + e] + excl) * LOG2E;
                    *(f32x4*)(c_lds + lane * 64 + 4 * i) = v; }
            }
            __syncthreads();
            const bf16* Qb = G_PROJ + (size_t)(b * SEQ) * 4096 + 1024 + h * 128;
            fox::BlockRef cur{Qb + (size_t)(a_qb * 256) * 4096, Qb + 1024, Qb + 2048, G_AMIX + (size_t)(b * SEQ + a_qb * 256) * DM + 1024 + h * 128, a_qb * 256};
            int j_lo = 0;
            { const unsigned* nq = (const unsigned*)G_ctl + CW_NRM + (b * 8 + h) * 4; const unsigned* nk = nq + 64; float B = 0.f;
#pragma unroll
              for (int c4 = 0; c4 < 4; ++c4) B += sqrtf(__uint_as_float(__hip_atomic_load(nq + c4, __ATOMIC_RELAXED, __HIP_MEMORY_SCOPE_AGENT)) * __uint_as_float(__hip_atomic_load(nk + c4, __ATOMIC_RELAXED, __HIP_MEMORY_SCOPE_AGENT)));
              const float thr = 2.05f * B + c_lds[a_qb * 256] + 150.f;
              while (j_lo < a_qb * 4 && c_lds[64 * j_lo + 63] > thr) ++j_lo; }
            fox::Seam S;
            fox::prime(cur, j_lo, (char*)lds, S);
            fox::block(cur, cur, j_lo, (char*)lds, S);
            asm volatile("s_waitcnt vmcnt(0)" ::: "memory");
            __syncthreads();
        }
        {
            constexpr int C_T = (DM / 64) * (DM / 32) / 8, NCHUNK = C_T + QSPLIT;
            LAS float* scr = (LAS float*)(ldsL + wave * 8704);
            __syncthreads();
            if (tid == 0) MISC[16] = atomicAdd(G_ctl + CW_QUEUE, 1u);
            for (int par = 0;; par ^= 1) {
                __syncthreads();
                const int c = (int)MISC[16 + par];
                if (c >= NCHUNK) break;
                unsigned nxt_ = 0u; if (tid == 0) nxt_ = atomicAdd(G_ctl + CW_QUEUE, 1u);
                if (c < C_T) { p0_transpose_item(G_xwo, DM, DM / 32, nullptr, G_WO, nullptr, 0, DM, scr, c * 8 + wave, lane); }
                else { TABLE_CHUNK(c - C_T); }
                if (tid == 0) MISC[17 - par] = nxt_;
            }
        }
    }
    SEAM(2);

    if (IN(3)) for (int rep_ = 0; rep_ < (((DUP_MASK >> 3) & 1) ? args.pad + 1 : 1); ++rep_) {
        if (bx < 64) {
            const int f = bx & 63, b = f >> 5, h = (f >> 3) & 3, t = f & 7;
            pg8::Gemm g{G_KX + (size_t)(b * NMEM) * DM + h * XD, G_WQ + h * XD, XD, DM, DM};
            pg8::EpiStore E{G_W1 + (size_t)(b * 1024 + h * 256) * DM, DM, 0, 0, 1, nullptr, 1.f, 0, 0, 1.f, nullptr};
            const pg8::OneSched S1{0, t, 0, (long)t * 256 * DM};
            pg8::gemm_phase<pg8::EpiStore, pg8::OneSched, false>(ldsL, g, S1, E);
        }
        { pg8::Gemm g{G_AMIX, G_WO2, DM, DM, DM}; pg8::GSched S; S.init(TOK / 256, DM / 256, G, bx, DM, DM);
          pg8::EpiResid<false> E{G_x, G_HB, rep_ ? nullptr : G_SS1, 0};
          pg8::gemm_phase<pg8::EpiResid<false>, pg8::GSched, true>(ldsL, g, S, E); }
    }
    SEAM(3);

    if (IN(4)) for (int rep_ = 0; rep_ < (((DUP_MASK >> 4) & 1) ? args.pad + 1 : 1); ++rep_) {
        pg8::Gemm g{G_HB, G_W1, DM, DM, DM}; pg8::GSched S; S.init(SEQ / 256, XH, G, bx, DM, DM);
        S.nH = 1; S.nZ = BATCH; S.sAb = (long)SEQ * DM; S.sBb = (long)1024 * DM;
        pg8::EpiSoftmax E{G_PP, 1024, (long)SEQ * 1024, 0, 1, G_SS1, 0.044194173824159216f * LOG2E, SEQ};
        pg8::gemm_phase<pg8::EpiSoftmax, pg8::GSched, false>(ldsL, g, S, E);
        if (bx >= 128 && bx < 192) {
            const int f = bx & 63, b = f >> 5, h = (f >> 3) & 3, t = f & 7;
            pg8::Gemm g2{G_WO + h * XD, G_VXT + (size_t)(b * NMEM) * DM + h * XD, XD, DM, DM};
            pg8::EpiStore E2{G_W2 + (size_t)b * DM * 1024 + h * 256, 1024, 0, 0, 1, nullptr, 1.f, 0, 0, 1.f, nullptr};
            const pg8::OneSched S2{t, 0, (long)t * 256 * DM, 0};
            pg8::gemm_phase<pg8::EpiStore, pg8::OneSched, false>(ldsL, g2, S2, E2);
        }
        for (;;) {
            __syncthreads();
            if (tid == 0) MISC[16] = atomicAdd(G_ctl + CW_QUEUE2, 1u);
            __syncthreads();
            const int c = (int)MISC[16] + QSPLIT;
            if (c >= 2 * PEXP / 32) break;
            TABLE_CHUNK(c);
        }
    }
    SEAM(4);

    if (IN(5)) for (int rep_ = 0; rep_ < (((DUP_MASK >> 5) & 1) ? args.pad + 1 : 1); ++rep_) {
        pg8::Gemm g{G_PP, G_W2, 1024, 1024, 1024}; pg8::GSched S; S.init(SEQ / 256, DM / 256, G, bx, 1024, 1024);
        S.nH = 1; S.nZ = BATCH; S.sAb = (long)SEQ * 1024; S.sBb = (long)DM * 1024;
        pg8::EpiResid<true> E{G_HB, G_HB, G_SS2, SEQ};
        pg8::gemm_phase<pg8::EpiResid<true>, pg8::GSched, true>(ldsL, g, S, E);
    }
    SEAM(5);

    if (IN(6)) for (int rep_ = 0; rep_ < (((DUP_MASK >> 6) & 1) ? args.pad + 1 : 1); ++rep_) {
        pg8::Gemm g{G_WSC, G_HB, DM, DM, DM}; pg8::GSched S; S.init(DM / 256, TOK / 256, G, bx, DM, DM);
        pg8::EpiF32Col E{G_SCT, TOK, G_SS2};
        pg8::gemm_phase<pg8::EpiF32Col, pg8::GSched, true>(ldsL, g, S, E);
    }
    SEAM(6);

#if defined(PROBE_SEL) && PROBE_SEL >= 7
    if (bx == 0 && tid == 0) __hip_atomic_store((unsigned long long*)(G_ctl + 258), (unsigned long long)__builtin_amdgcn_s_memrealtime(), __ATOMIC_RELAXED, __HIP_MEMORY_SCOPE_AGENT);
#endif
    if (IN(7)) for (int rep_ = 0; rep_ < (((DUP_MASK >> 7) & 1) ? args.pad + 1 : 1); ++rep_) {
        LAS unsigned* TOP1 = (LAS unsigned*)ldsL;
        LAS unsigned* RIDX = (LAS unsigned*)(ldsL + 32768);
        LAS float* RGATE = (LAS float*)(ldsL + 49152);
        for (int blk = vcu; blk < TOK / 32; blk += G) {
            const int t0 = blk * 32;
            {
                const int tok = tid & 31, grp = tid >> 5;
                const float* sp = G_SCT + ((size_t)blk * DM + grp * 128) * 32 + tok;
                unsigned lst[16];
#pragma unroll
                for (int j = 0; j < 16; ++j) lst[j] = 0u;
                for (int i0 = 0; i0 < 128; i0 += 32) {
                    float v[32];
#pragma unroll
                    for (int e = 0; e < 32; ++e) v[e] = __builtin_nontemporal_load(sp + (i0 + e) * 32);
#pragma unroll
                    for (int c16 = 0; c16 < 2; ++c16) { unsigned nw[16];
#pragma unroll
                        for (int e = 0; e < 16; ++e) nw[e] = (fkey(v[c16 * 16 + e]) & ~127u) | (unsigned)(127 - (i0 + c16 * 16 + e));
#pragma unroll
                        for (int k = 2; k <= 16; k <<= 1)
#pragma unroll
                            for (int j = k >> 1; j > 0; j >>= 1)
#pragma unroll
                                for (int i = 0; i < 16; ++i) { const int l = i ^ j; if (l > i) { const unsigned lo_ = min(nw[i], nw[l]), hi_ = max(nw[i], nw[l]); if ((i & k) == 0) { nw[i] = lo_; nw[l] = hi_; } else { nw[i] = hi_; nw[l] = lo_; } } }
#pragma unroll
                        for (int i = 0; i < 16; ++i) lst[i] = max(lst[i], nw[i]);
#pragma unroll
                        for (int j = 8; j > 0; j >>= 1)
#pragma unroll
                            for (int i = 0; i < 16; ++i) { const int l = i ^ j; if (l > i) { const unsigned lo_ = min(lst[i], lst[l]), hi_ = max(lst[i], lst[l]); lst[i] = hi_; lst[l] = lo_; } } }
                }
                LAS unsigned* dst = TOP1 + (tok * 16 + grp) * 16;
#pragma unroll
                for (int j = 0; j < 16; j += 4) *(LAS v4u*)(dst + j) = (v4u){lst[j], lst[j + 1], lst[j + 2], lst[j + 3]};
            }
            __syncthreads();
            if (tid < 256) {
                const int tok = tid & 31, head = tid >> 5;
                const LAS unsigned* ka = TOP1 + (tok * 16 + head * 2) * 16; const LAS unsigned* kb = ka + 16;
                float af[16], bfv[16];
#pragma unroll
                for (int j = 0; j < 16; ++j) { af[j] = fdec(ka[j] & ~127u); bfv[j] = fdec(kb[j] & ~127u); }
                unsigned best[16];
#pragma unroll
                for (int j = 0; j < 16; ++j) best[j] = 0u;
#pragma unroll
                for (int i = 0; i < 16; ++i)
#pragma unroll
                    for (int j = 0; j < 16; ++j) if ((i + 1) * (j + 1) <= 16) {
                        unsigned xk = (fkey(af[i] + bfv[j]) & ~255u) | (unsigned)(255 - (i * 16 + j));
#pragma unroll
                        for (int q = 0; q < 16; ++q) { const unsigned hi_ = max(best[q], xk); xk = min(best[q], xk); best[q] = hi_; } }
                float ev[16]; const float m0 = fdec(best[0] & ~255u); float sum = 0.f;
#pragma unroll
                for (int q = 0; q < 16; ++q) { ev[q] = __expf(fdec(best[q] & ~255u) - m0); sum += ev[q]; }
                const float inv = 1.f / sum;
#pragma unroll
                for (int q = 0; q < 16; ++q) { const unsigned code = 255u - (best[q] & 255u); const unsigned i = code >> 4, j = code & 15u;
                    const unsigned ia = 127u - (ka[i] & 127u), ib = 127u - (kb[j] & 127u);
                    RIDX[tok * 128 + head * 16 + q] = ia * 128u + ib; RGATE[tok * 128 + head * 16 + q] = ev[q] * inv; }
            }
            __syncthreads();
            {
                LAS unsigned* SIDX = (LAS unsigned*)ldsL; LAS unsigned* SGATE = (LAS unsigned*)(ldsL + 16384);
                const int tok = tid >> 4; const LAS unsigned* src = RIDX + tok * 128;
                unsigned mine[8]; unsigned rank[8];
#pragma unroll
                for (int i = 0; i < 8; ++i) { mine[i] = (src[(tid & 15) + 16 * i] << 7) | (unsigned)((tid & 15) + 16 * i); rank[i] = 0u; }
                for (int j0 = 0; j0 < 128; j0 += 4) { const v4u o4 = *(const LAS v4u*)(src + j0);
#pragma unroll
                    for (int jj = 0; jj < 4; ++jj) { const unsigned oj = ((jj == 0 ? o4.x : jj == 1 ? o4.y : jj == 2 ? o4.z : o4.w) << 7) | (unsigned)(j0 + jj);
#pragma unroll
                        for (int i = 0; i < 8; ++i) rank[i] += (oj < mine[i]) ? 1u : 0u; } }
#pragma unroll
                for (int i = 0; i < 8; ++i) mine[i] >>= 7;
#pragma unroll
                for (int i = 0; i < 8; ++i) { const unsigned pos = rank[i];
                    SIDX[tok * 128 + pos] = mine[i];
                    const float su_ = G_SU[mine[i]], gs_ = RGATE[tok * 128 + (tid & 15) + 16 * i] * G_SV[mine[i]];
                    SGATE[tok * 128 + pos] = (__float_as_uint(su_) & 0xffff0000u) | f2bf(gs_); }
            }
            __syncthreads();
            {
                const int tok0 = wave * 4; const size_t tg0 = (size_t)(t0 + tok0);
                LAS float* Wl = (LAS float*)(ldsL + 32768) + tok0 * 128;
                typedef short v2s_t __attribute__((ext_vector_type(2)));
                LAS unsigned* XB = (LAS unsigned*)(ldsL + 65536) + tok0 * 512;
#define XNLOAD(T_) do { const float rs = __builtin_amdgcn_rsqf(G_SS2[tg0 + (T_)] * (1.f / DM) + EPS); unsigned xb_[8]; \
        _Pragma("unroll") for (int q = 0; q < 8; ++q) { const size_t d0 = (size_t)q * 256 + lane * 4; \
            const v2u ha = *(const GAS v2u*)(G_HB + (tg0 + (T_)) * DM + d0); const f32x4 ga = *(const f32x4*)(G_peer_norm + d0); \
            v2s_t r_ = {0, 0}; r_ = __builtin_amdgcn_cvt_scalef32_pk_fp8_f32(r_, __uint_as_float(ha.x << 16) * rs * ga[0], __uint_as_float(ha.x & 0xffff0000u) * rs * ga[1], 1.0f, false); \
            r_ = __builtin_amdgcn_cvt_scalef32_pk_fp8_f32(r_, __uint_as_float(ha.y << 16) * rs * ga[2], __uint_as_float(ha.y & 0xffff0000u) * rs * ga[3], 1.0f, true); xb_[q] = __builtin_bit_cast(unsigned, r_); } \
        *(LAS v4u*)(XB + ((T_) * 64 + lane) * 8) = (v4u){xb_[0], xb_[1], xb_[2], xb_[3]}; *(LAS v4u*)(XB + ((T_) * 64 + lane) * 8 + 4) = (v4u){xb_[4], xb_[5], xb_[6], xb_[7]}; } while (0)
                XNLOAD(0); XNLOAD(1); XNLOAD(2); XNLOAD(3);
#undef XNLOAD
                v8i_t xB0, xB1, xB2, xB3;
#define XBLD(T_, XBV) do { const LAS unsigned* p_ = XB + (T_) * 512 + (((lane >> 5) * 16 + (lane & 15)) * 8) + ((lane >> 4) & 1) * 4; const v4u lo_ = *(const LAS v4u*)p_, hi_ = *(const LAS v4u*)(p_ + 256); \
        XBV = (v8i_t){(int)lo_.x, (int)lo_.y, (int)lo_.z, (int)lo_.w, (int)hi_.x, (int)hi_.y, (int)hi_.z, (int)hi_.w}; } while (0)
                XBLD(0, xB0); XBLD(1, xB1); XBLD(2, xB2); XBLD(3, xB3);
#undef XBLD
                const float dm0 = ((lane & 15) == (lane >> 4) * 4) ? 1.f : 0.f, dm1 = ((lane & 15) == (lane >> 4) * 4 + 1) ? 1.f : 0.f, dm2 = ((lane & 15) == (lane >> 4) * 4 + 2) ? 1.f : 0.f, dm3 = ((lane & 15) == (lane >> 4) * 4 + 3) ? 1.f : 0.f;
                const LAS unsigned* ridx0 = (const LAS unsigned*)ldsL + tok0 * 128; const LAS unsigned* rgs0 = (const LAS unsigned*)(ldsL + 16384) + tok0 * 128;
                const __amdgpu_buffer_rsrc_t rsT = __builtin_amdgcn_make_buffer_rsrc((void*)G_UB, 0, 64 << 20, 0x00020000);
                v4u raX0, raX1, raX2, raX3, raY0, raY1, raY2, raY3; v2u rbX0, rbX1, rbX2, rbX3, rbY0, rbY1, rbY2, rbY3;
                unsigned sgX0, sgX1, sgX2, sgX3, sgY0, sgY1, sgY2, sgY3;
#define PLDU(S, T, k) do { const unsigned ex_ = (unsigned)__builtin_amdgcn_readfirstlane((int)ridx0[(T) * 128 + (k)]); sg##S = rgs0[(T) * 128 + (k)]; \
        ra##S = __builtin_bit_cast(v4u, __builtin_amdgcn_raw_buffer_load_b128(rsT, lane * 16, ex_ * 1024u, 0)); } while (0)
                const int rowl = lane >> 4; const int wl_off = (rowl == 0 ? 0 : rowl == 1 ? 256 : rowl == 2 ? 128 : 384);
#define STEP1(C, P, k, HASNEXT) do { \
        const f32x4 e0_ = peer_mfma(ra##C##0, xB0); \
        const f32x4 e1_ = peer_mfma(ra##C##1, xB1); \
        const f32x4 e2_ = peer_mfma(ra##C##2, xB2); \
        const f32x4 e3_ = peer_mfma(ra##C##3, xB3); \
        const float d0_ = (e0_[0] * dm0 + e0_[1] * dm1) + (e0_[2] * dm2 + e0_[3] * dm3), d1_ = (e1_[0] * dm0 + e1_[1] * dm1) + (e1_[2] * dm2 + e1_[3] * dm3); \
        const float d2_ = (e2_[0] * dm0 + e2_[1] * dm1) + (e2_[2] * dm2 + e2_[3] * dm3), d3_ = (e3_[0] * dm0 + e3_[1] * dm1) + (e3_[2] * dm2 + e3_[3] * dm3); \
        const unsigned sgr_ = rowl == 0 ? sg##C##0 : rowl == 1 ? sg##C##2 : rowl == 2 ? sg##C##1 : sg##C##3; \
        if (HASNEXT) { PLDU(P##0, 0, (k) + 1); PLDU(P##1, 1, (k) + 1); PLDU(P##2, 2, (k) + 1); PLDU(P##3, 3, (k) + 1); } \
        const auto s01_ = __builtin_amdgcn_permlane32_swap(__float_as_uint(d0_), __float_as_uint(d1_), false, false); const auto s23_ = __builtin_amdgcn_permlane32_swap(__float_as_uint(d2_), __float_as_uint(d3_), false, false); \
        const float p_ = __uint_as_float(s01_[0]) + __uint_as_float(s01_[1]), q_ = __uint_as_float(s23_[0]) + __uint_as_float(s23_[1]); \
        const auto spq_ = __builtin_amdgcn_permlane16_swap(__float_as_uint(p_), __float_as_uint(q_), false, false); \
        float r_ = __uint_as_float(spq_[0]) + __uint_as_float(spq_[1]); \
        r_ += __builtin_bit_cast(float, __builtin_amdgcn_update_dpp(0, __builtin_bit_cast(int, r_), 0xB1, 0xf, 0xf, true)); r_ += __builtin_bit_cast(float, __builtin_amdgcn_update_dpp(0, __builtin_bit_cast(int, r_), 0x4E, 0xf, 0xf, true)); \
        r_ += __builtin_bit_cast(float, __builtin_amdgcn_update_dpp(0, __builtin_bit_cast(int, r_), 0x141, 0xf, 0xf, true)); r_ += __builtin_bit_cast(float, __builtin_amdgcn_update_dpp(0, __builtin_bit_cast(int, r_), 0x140, 0xf, 0xf, true)); \
        const float w_ = gelu_f(r_ * __uint_as_float(sgr_ & 0xffff0000u)) * __uint_as_float(sgr_ << 16); \
        if ((lane & 15) == 0) Wl[wl_off + (k)] = w_; } while (0)
                PLDU(X0, 0, 0); PLDU(X1, 1, 0); PLDU(X2, 2, 0); PLDU(X3, 3, 0);
                for (int k = 0; k < 126; k += 2) { STEP1(X, Y, k, true); STEP1(Y, X, k + 1, true); }
                STEP1(X, Y, 126, true); STEP1(Y, X, 127, false);
#undef PLDU
#undef STEP1
#define PLDV(S, T, k) do { const unsigned ex_ = (unsigned)__builtin_amdgcn_readfirstlane((int)ridx0[(T) * 128 + (k)]); \
        ra##S = __builtin_bit_cast(v4u, __builtin_amdgcn_raw_buffer_load_b128(rsT, lane * 16, ex_ * 1024u + (32u << 20), 0)); } while (0)
#define STEP2(C, N, k, HASNEXT) do { asm volatile("" ::: "memory");     \
        if (HASNEXT) { PLDV(N##0, 0, (k) + 2); PLDV(N##1, 1, (k) + 2); PLDV(N##2, 2, (k) + 2); PLDV(N##3, 3, (k) + 2); } \
        const float w0_ = Wl[(k)], w1_ = Wl[128 + (k)], w2_ = Wl[256 + (k)], w3_ = Wl[384 + (k)]; \
        peer_axpy_h4(ra##C##0, w0_, oh0); peer_axpy_h4(ra##C##1, w1_, oh1); peer_axpy_h4(ra##C##2, w2_, oh2); peer_axpy_h4(ra##C##3, w3_, oh3); } while (0)
                unsigned oh0[16], oh1[16], oh2[16], oh3[16];
                v4u raZ0, raZ1, raZ2, raZ3; v2u rbZ0, rbZ1, rbZ2, rbZ3;
#pragma unroll
                for (int e = 0; e < 16; ++e) { oh0[e] = 0u; oh1[e] = 0u; oh2[e] = 0u; oh3[e] = 0u; }
                PLDV(X0, 0, 0); PLDV(X1, 1, 0); PLDV(X2, 2, 0); PLDV(X3, 3, 0); PLDV(Y0, 0, 1); PLDV(Y1, 1, 1); PLDV(Y2, 2, 1); PLDV(Y3, 3, 1);
#pragma unroll 1
                for (int k = 0; k < 126; k += 3) { STEP2(X, Z, k, true); STEP2(Y, X, k + 1, true); STEP2(Z, Y, k + 2, true); }
                STEP2(X, Z, 126, false); STEP2(Y, X, 127, false);
                v2u hbr[4][8];
#pragma unroll
                for (int T = 0; T < 4; ++T)
#pragma unroll
                    for (int q = 0; q < 8; ++q) hbr[T][q] = *(const GAS v2u*)(G_HB + (tg0 + T) * DM + (size_t)q * 256 + lane * 4);
#define FINISH(T_, OH) do { float y_[32]; float s_ = 0.f; \
        _Pragma("unroll") for (int q = 0; q < 8; ++q) { const v2u hb = hbr[T_][q]; \
            const float a0 = __uint_as_float(hb.x << 16), a1 = __uint_as_float(hb.x & 0xffff0000u), a2 = __uint_as_float(hb.y << 16), a3 = __uint_as_float(hb.y & 0xffff0000u); \
            y_[q * 4] = a0 + h16lo(OH[q * 2]); y_[q * 4 + 1] = a1 + h16hi(OH[q * 2]); y_[q * 4 + 2] = a2 + h16lo(OH[q * 2 + 1]); y_[q * 4 + 3] = a3 + h16hi(OH[q * 2 + 1]); \
            s_ += (y_[q * 4] * y_[q * 4] + y_[q * 4 + 1] * y_[q * 4 + 1]) + (y_[q * 4 + 2] * y_[q * 4 + 2] + y_[q * 4 + 3] * y_[q * 4 + 3]); } \
        const float rstd_ = __builtin_amdgcn_rsqf(wave_sum_dpp(s_) * (1.f / DM) + EPS); \
        _Pragma("unroll") for (int q = 0; q < 8; ++q) { const size_t d0 = (size_t)q * 256 + lane * 4; const f32x4 ga = *(const f32x4*)(G_final_norm + d0); f32x4 o; \
            _Pragma("unroll") for (int e = 0; e < 4; ++e) o[e] = y_[q * 4 + e] * rstd_ * ga[e]; \
            PROBE_EXPORT(tg0 + (T_), q); \
            __builtin_nontemporal_store(o, (f32x4*)(args.out + (tg0 + (T_)) * DM + d0)); } } while (0)
                FINISH(0, oh0); FINISH(1, oh1); FINISH(2, oh2); FINISH(3, oh3);
#undef FINISH
#undef PLDV
#undef STEP2
            }
            __syncthreads();
#if defined(PROBE_SEL) && PROBE_SEL >= 7
            asm volatile("s_waitcnt vmcnt(0)" ::: "memory"); __syncthreads();
            if (tid == 0) { __threadfence(); const unsigned old_ = atomicAdd(G_ctl + 192, 1u);
                if (old_ == (unsigned)G - 1u) { __threadfence(); const unsigned long long a_ = __hip_atomic_load((unsigned long long*)(G_ctl + 256 + 2 * (PROBE_SEL - 7)), __ATOMIC_RELAXED, __HIP_MEMORY_SCOPE_AGENT), b_ = __builtin_amdgcn_s_memrealtime();
                    atomicAdd(args.out + (size_t)31 * DM, (float)(b_ - a_) * 0.0001f); } }
#endif
        }
    }
#undef IN
#undef SEAM
#undef G_ws
#undef G_ctl
#undef G_x
#undef G_mem
#undef G_mix_norm
#undef G_w_in
#undef G_b_forget
#undef G_pool_w
#undef G_pool_scale
#undef G_w_out
#undef G_xattn_norm
#undef G_mem_norm
#undef G_xwq
#undef G_xwk
#undef G_xwv
#undef G_xwo
#undef G_peer_norm
#undef G_peer_wq
#undef G_sub_keys
#undef G_peer_u
#undef G_peer_v
#undef G_final_norm
#undef G_W_IN
#undef G_WO1
#undef G_WO2
#undef G_WQ
#undef G_WK
#undef G_WV
#undef G_WO
#undef G_WPQ
#undef G_AEXP
#undef G_W1
#undef G_W2
#undef G_WSC
#undef G_PB
#undef G_MN
#undef G_KX
#undef G_VXT
#undef G_UB
#undef G_VB
#undef G_SU
#undef G_SV
#undef G_XN
#undef G_QX
#undef G_PROJ
#undef G_SCT
#undef G_AMIX
#undef G_OX
#undef G_H
#undef G_HB
#undef G_PP
#undef G_LF
#undef G_SS1
#undef G_SS2

}

constexpr int N_PHASES = 8;
extern "C" void kernel_launch(void* const* d_in, const int* in_sizes, int n_in, void* d_out, int out_size, void* d_ws, size_t ws_size, hipStream_t stream) {
    static int grid = 0;
    if (grid == 0) {
        if (n_in != 20 || in_sizes[0] != TOK * DM || out_size != TOK * DM || ws_size < WS_END) {
            fprintf(stderr, "kernel_launch: unexpected shapes (n_in %d, in0 %d, out %d, ws %zu < %zu)\n", n_in, n_in > 0 ? in_sizes[0] : -1, out_size, ws_size, (size_t)WS_END); grid = -1; return; }
        int dev = 0, cus = 0, per_cu = 0;
        if (hipGetDevice(&dev) != hipSuccess || hipDeviceGetAttribute(&cus, hipDeviceAttributeMultiprocessorCount, dev) != hipSuccess) { grid = -1; return; }
        if (hipFuncSetAttribute((const void*)fwd_kernel, hipFuncAttributeMaxDynamicSharedMemorySize, LDS_BYTES) != hipSuccess) { fprintf(stderr, "kernel_launch: hipFuncSetAttribute failed\n"); grid = -1; return; }
        if (hipOccupancyMaxActiveBlocksPerMultiprocessor(&per_cu, (const void*)fwd_kernel, NTHREADS, LDS_BYTES) != hipSuccess || per_cu < 1) { fprintf(stderr, "kernel_launch: occupancy query says %d\n", per_cu); per_cu = 1; }
        (void)hipGetLastError();
        grid = cus;
        if (grid != 256) fprintf(stderr, "kernel_launch: %d CUs (built for 256)\n", grid);
    }
    if (grid < 0) return;
    (void)hipMemsetAsync((char*)d_ws + WS_CTL, 0, CTL_ZERO_BYTES, stream);
    Args a{};
    for (int i = 0; i < 20; ++i) a.in[i] = (const float*)d_in[i];
    a.out = (float*)d_out; a.ws = (unsigned char*)d_ws; a.pad = DUP_MASK ? 1 : 0;
#if MK_ONE_LAUNCH
    a.ph_lo = 0; a.ph_hi = N_PHASES; a.one_launch = 1;
    void* kargs[] = {&a};
    hipError_t e = hipLaunchCooperativeKernel((const void*)fwd_kernel, dim3(grid), dim3(NTHREADS), kargs, LDS_BYTES, stream);
    if (e != hipSuccess) fprintf(stderr, "kernel_launch: cooperative launch failed: %s\n", hipGetErrorString(e));
#else
    for (int p = 0; p < N_PHASES; ++p) {
        a.ph_lo = p; a.ph_hi = p + 1; a.one_launch = 0;
        hipLaunchKernelGGL(fwd_kernel, dim3(grid), dim3(NTHREADS), LDS_BYTES, stream, a);
    }
#endif
}
```

```cpp
#include <hip/hip_runtime.h>
#include <hip/hip_bf16.h>
#include <cstdio>
#include <cstdint>

#ifndef DUP_MASK
#define DUP_MASK 0
#endif
#ifndef MK_ONE_LAUNCH
#define MK_ONE_LAUNCH 1
#endif

constexpr int BATCH = 2, SEQ = 4096, DM = 2048, TOK = BATCH * SEQ;
constexpr int INC = 4104, POOLW = 1024, FOXH = 8, FOXD = 128;
constexpr int NMEM = 256, XH = 4, XD = 512;
constexpr int PH = 8, PKEYS = 128, PEXP = 16384, TOPK = 16;
constexpr float EPS = 1e-6f;
constexpr float LOG2E = 1.4426950408889634f;

namespace pg8 {
#define PG8_LAS __attribute__((address_space(3)))
typedef unsigned short bf16_t;
typedef short bf16x8 __attribute__((ext_vector_type(8)));
typedef float f32x4 __attribute__((ext_vector_type(4)));
typedef float f32x2 __attribute__((ext_vector_type(2)));
typedef unsigned u32x4 __attribute__((ext_vector_type(4)));
typedef unsigned u32x2 __attribute__((ext_vector_type(2)));
constexpr int BM = 256, BK = 64, HALF = 128, HTB = HALF * BK * 2, STAGE_BYTES = 8 * HTB, NXCD = 8, WGM = 8;

__host__ __device__ __forceinline__ int lds_byte(int r, int c) { const int st = (r >> 4) * 2 + (c >> 5), rr = r & 15, cc = c & 31, ob = rr * 64 + cc * 2; return st * 1024 + (ob ^ (((ob >> 9) & 1) << 5)); }
__host__ __device__ __forceinline__ void stage_rc(int b, int& R, int& C) { const int st = b / 1024, sb = b % 1024, swz = sb ^ (((sb >> 9) & 1) << 5); R = (st >> 1) * 16 + swz / 64; C = (st & 1) * 32 + (swz % 64) / 2; }
__host__ __device__ __forceinline__ int perm32(int rho) { const int n = rho >> 4, i = rho & 15; return 8 * (i >> 2) + 4 * n + (i & 3); }

struct Unit { int pm, pn, z; long aoff, boff; };
struct Gemm { const bf16_t* A; const bf16_t* Bt; int K, lda, ldb; };

struct GSched {
    int nM, nN, nH, nZ, G, c; long sAb, sAh, sBb, sBh; int lda, ldb;
    __device__ __forceinline__ void init(int nM_, int nN_, int G_, int c_, int lda_, int ldb_) { nM = nM_; nN = nN_; nH = 1; nZ = 1; G = G_; c = c_; sAb = sAh = sBb = sBh = 0; lda = lda_; ldb = ldb_; }
    __device__ __forceinline__ bool next(int i, Unit& u) const {
        const long L = (long)i * G + c; const int nwg = nM * nN; if (L >= (long)nwg * nZ) return false;
        const int z = (int)(L / nwg); int wgid = (int)(L % nwg);
        { const int q = nwg / NXCD, r = nwg % NXCD, xcd = wgid % NXCD, off = wgid / NXCD; wgid = (xcd < r ? xcd * (q + 1) : r * (q + 1) + (xcd - r) * q) + off; }
        const int nig = WGM * nN, gid = wgid / nig, fm = gid * WGM, gsz = (nM - fm) < WGM ? (nM - fm) : WGM;
        u.pm = fm + ((wgid % nig) % gsz); u.pn = (wgid % nig) / gsz; u.z = z;
        const int zb = z / nH, zh = z % nH;
        u.aoff = zb * sAb + zh * sAh + (long)u.pm * BM * lda; u.boff = zb * sBb + zh * sBh + (long)u.pn * BM * ldb;
        return true;
    }
    __device__ __forceinline__ void a_ready(const Unit&) const {}
    __device__ __forceinline__ void done(const Unit&) const {}
};

struct SubSched { GSched S; int i0;
    __device__ __forceinline__ bool next(int i, Unit& u) const { if (i) return false; return S.next(i0, u); }
    __device__ __forceinline__ void a_ready(const Unit&) const {}
    __device__ __forceinline__ void done(const Unit&) const {} };
struct OneSched { int pm, pn; long ao, bo;
    __device__ __forceinline__ bool next(int i, Unit& u) const { if (i) return false; u.pm = pm; u.pn = pn; u.z = 0; u.aoff = ao; u.boff = bo; return true; }
    __device__ __forceinline__ void a_ready(const Unit&) const {}
    __device__ __forceinline__ void done(const Unit&) const {} };
__device__ __forceinline__ unsigned cvt_pk_bf16(float lo, float hi) { unsigned r; asm volatile("v_cvt_pk_bf16_f32 %0, %1, %2" : "=v"(r) : "v"(lo), "v"(hi)); return r; }


template <bool NRM> struct EpiStoreT {
    static constexpr bool PERM = true, AFTER_DRAIN = false;
    bf16_t* O; int ldc; long sCb, sCh; int nH;
    const float* ss; float rs_mul;
    int t0, t1; float tscale;
    unsigned* nrm;
    __device__ __forceinline__ void operator()(const f32x4 (&acc)[2][2][4][2], const Unit& u, int wr, int wc, int fr, int fq) const {
        const int row0 = u.pm * BM + wr * 64 + fr, col0 = u.pn * BM + wc * 32 + 8 * fq;
        bf16_t* base = O + (u.z / nH) * sCb + (u.z % nH) * sCh;
        const float ts = (u.pn >= t0 && u.pn < t1) ? tscale : 1.f;
        float mx0 = 0.f, mx1 = 0.f;
#pragma unroll
        for (int ai = 0; ai < 2; ++ai)
#pragma unroll
            for (int m = 0; m < 4; ++m) { const int row = row0 + ai * HALF + m * 16;
                float sc = ts; if (ss) sc *= __builtin_amdgcn_rsqf(ss[row] * (1.f / DM) + EPS) * rs_mul;
                bf16_t* rowp = base + (size_t)row * ldc + col0;
#pragma unroll
                for (int bj = 0; bj < 2; ++bj) { const f32x4 v0 = acc[ai][bj][m][0] * sc, v1 = acc[ai][bj][m][1] * sc;
                    u32x4 w; w.x = cvt_pk_bf16(v0[0], v0[1]); w.y = cvt_pk_bf16(v0[2], v0[3]); w.z = cvt_pk_bf16(v1[0], v1[1]); w.w = cvt_pk_bf16(v1[2], v1[3]);
                    *(u32x4*)(rowp + bj * HALF) = w;
                    if constexpr (NRM) { float q = (v0[0] * v0[0] + v0[1] * v0[1]) + (v0[2] * v0[2] + v0[3] * v0[3]) + (v1[0] * v1[0] + v1[1] * v1[1]) + (v1[2] * v1[2] + v1[3] * v1[3]);
                        q += __shfl_xor(q, 16); q += __shfl_xor(q, 32); if (bj == 0) mx0 = fmaxf(mx0, q); else mx1 = fmaxf(mx1, q); } } }
        if constexpr (NRM) { if (u.pn >= 4 && u.pn < 12) {
#pragma unroll
            for (int o = 1; o < 16; o <<= 1) { mx0 = fmaxf(mx0, __shfl_xor(mx0, o)); mx1 = fmaxf(mx1, __shfl_xor(mx1, o)); }
            if ((threadIdx.x & 63) == 0) { const int kind = u.pn >= 8, b = u.pm >> 4, h2 = ((u.pn - 4) & 3) * 2; unsigned* p = nrm + ((kind * 2 + b) * 8 + h2) * 4 + wc;
                atomicMax(p, __float_as_uint(mx0)); atomicMax(p + 4, __float_as_uint(mx1)); } } }
    }
};
typedef EpiStoreT<false> EpiStore;
template <bool BASE_BF16> struct EpiResid {
    static constexpr bool PERM = true, AFTER_DRAIN = false;
    const void* base; bf16_t* HB; float* ss; int zrows;
    __device__ __forceinline__ void operator()(const f32x4 (&acc)[2][2][4][2], const Unit& u, int wr, int wc, int fr, int fq) const {
        const int row0 = u.z * zrows + u.pm * BM + wr * 64 + fr, col0 = u.pn * BM + wc * 32 + 8 * fq;
#pragma unroll
        for (int ai = 0; ai < 2; ++ai)
#pragma unroll
            for (int m = 0; m < 4; ++m) { const int row = row0 + ai * HALF + m * 16; const size_t off = (size_t)row * DM + col0; float sq = 0.f;
#pragma unroll
                for (int bj = 0; bj < 2; ++bj) {
                    f32x4 b0, b1;
                    if constexpr (BASE_BF16) { const u32x4 r = *(const u32x4*)((const bf16_t*)base + off + bj * HALF);
                        b0 = (f32x4){__uint_as_float(r.x << 16), __uint_as_float(r.x & 0xffff0000u), __uint_as_float(r.y << 16), __uint_as_float(r.y & 0xffff0000u)};
                        b1 = (f32x4){__uint_as_float(r.z << 16), __uint_as_float(r.z & 0xffff0000u), __uint_as_float(r.w << 16), __uint_as_float(r.w & 0xffff0000u)}; }
                    else { b0 = __builtin_nontemporal_load((const f32x4*)((const float*)base + off + bj * HALF)); b1 = __builtin_nontemporal_load((const f32x4*)((const float*)base + off + bj * HALF + 4)); }
                    const f32x4 h0 = b0 + acc[ai][bj][m][0], h1 = b1 + acc[ai][bj][m][1];
                    u32x4 w; w.x = cvt_pk_bf16(h0[0], h0[1]); w.y = cvt_pk_bf16(h0[2], h0[3]); w.z = cvt_pk_bf16(h1[0], h1[1]); w.w = cvt_pk_bf16(h1[2], h1[3]);
                    *(u32x4*)(HB + off + bj * HALF) = w;
                    sq += (h0[0] * h0[0] + h0[1] * h0[1]) + (h0[2] * h0[2] + h0[3] * h0[3]) + (h1[0] * h1[0] + h1[1] * h1[1]) + (h1[2] * h1[2] + h1[3] * h1[3]); }
                sq += __shfl_xor(sq, 16); sq += __shfl_xor(sq, 32);
                if (fq == 0 && ss) atomicAdd(ss + row, sq); }
    }
};
struct EpiF32Col {
    static constexpr bool PERM = true, AFTER_DRAIN = false;
    float* O; int ldc; const float* ss;
    __device__ __forceinline__ void operator()(const f32x4 (&acc)[2][2][4][2], const Unit& u, int wr, int wc, int fr, int fq) const {
        const int row0 = u.pm * BM + wr * 64 + fr, col0 = u.pn * BM + wc * 32 + 8 * fq;
        f32x4 rs[2][2];
#pragma unroll
        for (int bj = 0; bj < 2; ++bj)
#pragma unroll
            for (int n = 0; n < 2; ++n) { const f32x4 s = *(const f32x4*)(ss + col0 + bj * HALF + 4 * n);
#pragma unroll
                for (int e = 0; e < 4; ++e) rs[bj][n][e] = __builtin_amdgcn_rsqf(s[e] * (1.f / DM) + EPS); }
#pragma unroll
        for (int ai = 0; ai < 2; ++ai)
#pragma unroll
            for (int m = 0; m < 4; ++m) { const int key = row0 + ai * HALF + m * 16;
#pragma unroll
                for (int bj = 0; bj < 2; ++bj) { const int tk = col0 + bj * HALF; float* p = O + ((size_t)(tk >> 5) * DM + key) * 32 + (tk & 31);
                    *(f32x4*)p = acc[ai][bj][m][0] * rs[bj][0]; *(f32x4*)(p + 4) = acc[ai][bj][m][1] * rs[bj][1]; } }
    }
};
struct EpiSoftmax {
    static constexpr bool PERM = true, AFTER_DRAIN = true;
    bf16_t* P; int ldc; long sCb, sCh; int nH; const float* ss; float mul; int zrows;
    __device__ __forceinline__ void fused(f32x4 (&acc)[2][2][4][2], const Unit& u, int wr, int wc, int fr, int fq, PG8_LAS unsigned char* lds, int wid, int lane) const {
        PG8_LAS float* Pm = (PG8_LAS float*)lds;
        PG8_LAS float* Ps = (PG8_LAS float*)(lds + 4096);
#pragma unroll
        for (int ai = 0; ai < 2; ++ai)
#pragma unroll
            for (int m = 0; m < 4; ++m) { float mx = -3.0e38f;
                const float rs = __builtin_amdgcn_rsqf(ss[u.z * zrows + u.pm * BM + ai * HALF + wr * 64 + m * 16 + fr] * (1.f / DM) + EPS) * mul;
#pragma unroll
                for (int bj = 0; bj < 2; ++bj)
#pragma unroll
                    for (int n = 0; n < 2; ++n) { const f32x4 x = acc[ai][bj][m][n] * rs; acc[ai][bj][m][n] = x; mx = fmaxf(mx, fmaxf(fmaxf(x[0], x[1]), fmaxf(x[2], x[3]))); }
                mx = fmaxf(mx, __shfl_xor(mx, 16)); mx = fmaxf(mx, __shfl_xor(mx, 32));
                if (fq == 0) Pm[(ai * HALF + wr * 64 + m * 16 + fr) * 4 + wc] = mx; }
        asm volatile("s_waitcnt lgkmcnt(0)" ::: "memory"); __builtin_amdgcn_s_barrier(); asm volatile("" ::: "memory");
#pragma unroll
        for (int ai = 0; ai < 2; ++ai)
#pragma unroll
            for (int m = 0; m < 4; ++m) { const int r = ai * HALF + wr * 64 + m * 16 + fr;
                const f32x4 pm4 = *(const PG8_LAS f32x4*)(Pm + r * 4); const float M = fmaxf(fmaxf(pm4[0], pm4[1]), fmaxf(pm4[2], pm4[3])); float s = 0.f;
#pragma unroll
                for (int bj = 0; bj < 2; ++bj)
#pragma unroll
                    for (int n = 0; n < 2; ++n) { f32x4 x = acc[ai][bj][m][n];
#pragma unroll
                        for (int e = 0; e < 4; ++e) { x[e] = __builtin_amdgcn_exp2f(x[e] - M); s += x[e]; }
                        acc[ai][bj][m][n] = x; }
                s += __shfl_xor(s, 16); s += __shfl_xor(s, 32);
                if (fq == 0) Ps[r * 4 + wc] = s; }
        asm volatile("s_waitcnt lgkmcnt(0)" ::: "memory"); __builtin_amdgcn_s_barrier(); asm volatile("" ::: "memory");
        bf16_t* base = P + (u.z / nH) * sCb + (u.z % nH) * sCh;
        const int row0 = u.pm * BM, col0 = u.pn * BM + wc * 32 + 8 * fq;
#pragma unroll
        for (int ai = 0; ai < 2; ++ai)
#pragma unroll
            for (int m = 0; m < 4; ++m) { const int r = ai * HALF + wr * 64 + m * 16 + fr;
                const f32x4 ps4 = *(const PG8_LAS f32x4*)(Ps + r * 4); const float inv = 1.f / ((ps4[0] + ps4[1]) + (ps4[2] + ps4[3]));
                bf16_t* rowp = base + (size_t)(row0 + r) * ldc + col0;
#pragma unroll
                for (int bj = 0; bj < 2; ++bj) { const f32x4 v0 = acc[ai][bj][m][0] * inv, v1 = acc[ai][bj][m][1] * inv;
                    u32x4 w; w.x = cvt_pk_bf16(v0[0], v0[1]); w.y = cvt_pk_bf16(v0[2], v0[3]); w.z = cvt_pk_bf16(v1[0], v1[1]); w.w = cvt_pk_bf16(v1[2], v1[3]);
                    *(u32x4*)(rowp + bj * HALF) = w; } }
    }
};

template <class Epi, class Sched, bool ALIGN_EPI>
__device__ __forceinline__ void gemm_phase(PG8_LAS unsigned char* lds, const Gemm g, const Sched& S, const Epi& E) {
    int tid_ = threadIdx.x; asm volatile("" : "+v"(tid_));
    const int tid = tid_, wid = __builtin_amdgcn_readfirstlane(tid >> 6), lane = tid & 63, wr = wid >> 2, wc = wid & 3, fr = lane & 15, fq = lane >> 4;
    const int K = g.K, nt = K / BK;
    unsigned voffA[2], voffB[2];
#pragma unroll
    for (int i = 0; i < 2; ++i) { int R, C; stage_rc(tid * 16 + i * 8192, R, C); const int Rb = Epi::PERM ? ((R & ~31) + perm32(R & 31)) : R;
        voffA[i] = (unsigned)(R * g.lda + C) * 2u; voffB[i] = (unsigned)(Rb * g.ldb + C) * 2u; }
    const size_t kstep = (size_t)(BK * 2);
    const size_t hsA = (size_t)HALF * g.lda * 2, hsB = (size_t)HALF * g.ldb * 2;
    const unsigned ldsw = (unsigned)wid * 1024u;
    const int aoff = lds_byte(wr * 64 + fr, fq * 8), boff = lds_byte(wc * 32 + fr, fq * 8);
#define PG8_SA(b, h) (((b) * 2 + (h)) * HTB)
#define PG8_SB(b, h) ((4 + (b) * 2 + (h)) * HTB)
#define PG8_STAGE(bufoff, gbase, voff) do { _Pragma("unroll") for (int _i = 0; _i < 2; ++_i) \
        __builtin_amdgcn_global_load_lds((const unsigned*)((const char*)(gbase) + (voff)[_i]), (PG8_LAS unsigned*)(lds + (bufoff) + ldsw + _i * 8192), 16, 0, 0); } while (0)
#define PG8_LDA(dst, b, h) do { _Pragma("unroll") for (int m = 0; m < 4; ++m) _Pragma("unroll") for (int k = 0; k < 2; ++k) dst[m][k] = *(const PG8_LAS bf16x8*)(lds + PG8_SA(b, h) + aoff + m * 2048 + k * 1024); } while (0)
#define PG8_LDB(dst, b, h) do { _Pragma("unroll") for (int n = 0; n < 2; ++n) _Pragma("unroll") for (int k = 0; k < 2; ++k) dst[n][k] = *(const PG8_LAS bf16x8*)(lds + PG8_SB(b, h) + boff + n * 2048 + k * 1024); } while (0)
#define PG8_MMA(ai, bj, At, Bt) do { __builtin_amdgcn_s_setprio(1); _Pragma("unroll") for (int m = 0; m < 4; ++m) _Pragma("unroll") for (int n = 0; n < 2; ++n) _Pragma("unroll") for (int k = 0; k < 2; ++k) \
        acc[ai][bj][m][n] = __builtin_amdgcn_mfma_f32_16x16x32_bf16(Bt[n][k], At[m][k], acc[ai][bj][m][n], 0, 0, 0); __builtin_amdgcn_s_setprio(0); } while (0)
#define PG8_WAIT_V(n) asm volatile("s_waitcnt vmcnt(" #n ")" ::: "memory")
#define PG8_WAIT_L(n) asm volatile("s_waitcnt lgkmcnt(" #n ")" ::: "memory")
#define PG8_BAR __builtin_amdgcn_s_barrier()
#define PG8_SCHED __builtin_amdgcn_sched_barrier(0)
    Unit cur, nxt; int ui = 0;
    if (!S.next(0, cur)) return;
    f32x4 acc[2][2][4][2];
#pragma unroll
    for (int a = 0; a < 2; ++a)
#pragma unroll
        for (int b = 0; b < 2; ++b)
#pragma unroll
            for (int m = 0; m < 4; ++m)
#pragma unroll
                for (int n = 0; n < 2; ++n) acc[a][b][m][n] = (f32x4){0.f, 0.f, 0.f, 0.f};
    bf16x8 At[4][2], B0[2][2], B1[2][2];
    const char* cA = (const char*)g.A + (size_t)cur.aoff * 2; const char* cB = (const char*)g.Bt + (size_t)cur.boff * 2;
    S.a_ready(cur);
    PG8_STAGE(PG8_SB(0, 0), cB, voffB); PG8_STAGE(PG8_SB(0, 1), cB + hsB, voffB); PG8_STAGE(PG8_SA(0, 0), cA, voffA); PG8_STAGE(PG8_SA(0, 1), cA + hsA, voffA);
    if (wr == 1) PG8_BAR;
    PG8_WAIT_V(2); PG8_BAR;
    PG8_STAGE(PG8_SB(1, 0), cB + kstep, voffB); PG8_STAGE(PG8_SA(1, 0), cA + kstep, voffA); PG8_STAGE(PG8_SB(1, 1), cB + hsB + kstep, voffB);
    PG8_WAIT_V(6); PG8_BAR;
    for (;;) {
        const bool has_next = S.next(ui + 1, nxt);
        const char* nA = has_next ? (const char*)g.A + (size_t)nxt.aoff * 2 : cA; const char* nB = has_next ? (const char*)g.Bt + (size_t)nxt.boff * 2 : cB;
        for (int t = 0; t < nt; t += 2) {
            const bool last = (t == nt - 2);
            const char* a1 = cA + (size_t)(t + 1) * kstep;
            const char* a2 = last ? nA : cA + (size_t)(t + 2) * kstep; const char* b2 = last ? nB : cB + (size_t)(t + 2) * kstep;
            const char* a3 = a2 + kstep; const char* b3 = b2 + kstep;
            if (last && has_next) S.a_ready(nxt);
            PG8_LDB(B0, 0, 0); PG8_LDB(B1, 0, 1); PG8_SCHED; PG8_LDA(At, 0, 0); PG8_STAGE(PG8_SA(1, 1), a1 + hsA, voffA);
            PG8_WAIT_V(8); PG8_WAIT_L(0); PG8_BAR; PG8_MMA(0, 0, At, B0); PG8_MMA(0, 1, At, B1); PG8_BAR; PG8_SCHED;
            PG8_LDA(At, 0, 1); PG8_STAGE(PG8_SB(0, 0), b2, voffB); PG8_STAGE(PG8_SB(0, 1), b2 + hsB, voffB); PG8_STAGE(PG8_SA(0, 0), a2, voffA);
            PG8_WAIT_V(8); PG8_WAIT_L(0); PG8_BAR; PG8_MMA(1, 0, At, B0); PG8_MMA(1, 1, At, B1); PG8_BAR; PG8_SCHED;
            PG8_LDB(B0, 1, 0); PG8_LDB(B1, 1, 1); PG8_SCHED; PG8_LDA(At, 1, 0); PG8_STAGE(PG8_SA(0, 1), a2 + hsA, voffA);
            PG8_WAIT_V(8); PG8_WAIT_L(0); PG8_BAR; PG8_MMA(0, 0, At, B0); PG8_MMA(0, 1, At, B1); PG8_BAR; PG8_SCHED;
            PG8_LDA(At, 1, 1); PG8_STAGE(PG8_SB(1, 0), b3, voffB); PG8_STAGE(PG8_SB(1, 1), b3 + hsB, voffB); PG8_STAGE(PG8_SA(1, 0), a3, voffA);
            PG8_WAIT_V(8); PG8_WAIT_L(0); PG8_BAR; PG8_MMA(1, 0, At, B0); PG8_MMA(1, 1, At, B1); PG8_BAR; PG8_SCHED;
        }
        if constexpr (ALIGN_EPI) { if (wr == 0) PG8_BAR; }
        if constexpr (!Epi::AFTER_DRAIN) { E(acc, cur, wr, wc, fr, fq); S.done(cur); }
        if (!has_next) break;
#pragma unroll
        for (int a = 0; a < 2; ++a)
#pragma unroll
            for (int b = 0; b < 2; ++b)
#pragma unroll
                for (int m = 0; m < 4; ++m)
#pragma unroll
                    for (int n = 0; n < 2; ++n) acc[a][b][m][n] = (f32x4){0.f, 0.f, 0.f, 0.f};
        cur = nxt; cA = nA; cB = nB; ++ui;
        if constexpr (ALIGN_EPI) { if (wr == 1) PG8_BAR; }
    }
    PG8_WAIT_V(0);
    if constexpr (!ALIGN_EPI) { if (wr == 0) PG8_BAR; }
    PG8_BAR;
    if constexpr (Epi::AFTER_DRAIN) { E.fused(acc, cur, wr, wc, fr, fq, lds, wid, lane); S.done(cur); }
#undef PG8_SA
#undef PG8_SB
#undef PG8_STAGE
#undef PG8_LDA
#undef PG8_LDB
#undef PG8_MMA
#undef PG8_WAIT_V
#undef PG8_WAIT_L
#undef PG8_BAR
#undef PG8_SCHED
}
}

namespace fox {
typedef unsigned short bf16_t;
typedef short bf16x8 __attribute__((ext_vector_type(8)));
typedef short s16x4 __attribute__((ext_vector_type(4)));
typedef float f32x16 __attribute__((ext_vector_type(16)));
typedef float f32x4 __attribute__((ext_vector_type(4)));
typedef unsigned u32x4 __attribute__((ext_vector_type(4)));
constexpr int D = 128, NW = 8, QBLK = 32, KVBLK = 64, QB = NW * QBLK;
constexpr int SHM_V = KVBLK * D * 2, SHM_K = KVBLK * D * 2;
constexpr int LDS_C = 2 * SHM_V + 2 * SHM_K + NW * 64 * 4;
constexpr int LDS_BYTES = LDS_C + SEQ * 4;
constexpr int QP = 4096, OP = 2048;
constexpr float THR = 24.f;
#define KSWZ(row, colB) ((row) * 256 + ((colB) ^ (((row) & 7) << 4)))
#define SBAR() __builtin_amdgcn_sched_barrier(0)
__device__ __forceinline__ int v_st(int k, int c) { const int kk = (k & ~0xC) | ((k & 4) << 1) | ((k & 8) >> 1); return ((kk >> 3) * 4 + (c >> 5)) * 512 + ((kk & 7) * 32 + (c & 31)) * 2; }
__device__ __forceinline__ int v_rd_base(int lane) { return ((lane & 3) << 3) | (((lane >> 2) & 3) << 6) | (((lane >> 4) & 1) << 5) | (((lane >> 5) & 1) << 8); }
constexpr int v_rd_off(int d0, int ks, int half) { return d0 * 512 + ks * 4096 + half * 2048; }
__device__ __forceinline__ int crow(int r, int hi) { return (r & 3) + 8 * (r >> 2) + 4 * hi; }
__device__ __forceinline__ unsigned cvtpk(float lo, float hi) { unsigned r; asm volatile("v_cvt_pk_bf16_f32 %0, %1, %2" : "=v"(r) : "v"(lo), "v"(hi)); return r; }
__device__ __forceinline__ bf16x8 load8(const bf16_t* p) { return *reinterpret_cast<const bf16x8*>(p); }
__device__ __forceinline__ void mask_tile(f32x16& p0, f32x16& p1, int dq) {
    const float NEG = -__builtin_inff();
#pragma unroll
    for (int r = 0; r < 16; ++r) { const int c = (r & 3) + 8 * (r >> 2); if (dq - c < 0) p0[r] = NEG; if (dq - c - 32 < 0) p1[r] = NEG; }
}
__device__ __forceinline__ void bias_tile(f32x16& p0, f32x16& p1, const float* cb) {
#pragma unroll
    for (int i = 0; i < 4; ++i) { const f32x4 c0 = *(const f32x4*)(cb + 8 * i), c1 = *(const f32x4*)(cb + 32 + 8 * i);
#pragma unroll
        for (int j = 0; j < 4; ++j) { p0[4 * i + j] -= c0[j]; p1[4 * i + j] -= c1[j]; } }
}
__device__ __forceinline__ void partialSM(f32x16& p0, f32x16& p1, float& m_reg, float& mn, float& alpha) {
    float pmax = p0[0]; for (int r = 1; r < 16; ++r) pmax = fmaxf(pmax, p0[r]); for (int r = 0; r < 16; ++r) pmax = fmaxf(pmax, p1[r]);
    { auto rr = __builtin_amdgcn_permlane32_swap(__float_as_uint(pmax), __float_as_uint(pmax), false, false);
      pmax = fmaxf(__uint_as_float(rr[0]), __uint_as_float(rr[1])); }
    if (__builtin_expect(__all((pmax - m_reg) <= THR), 1)) { mn = m_reg; alpha = 1.f; }
    else { mn = fmaxf(m_reg, pmax); alpha = __builtin_amdgcn_exp2f(m_reg - mn); m_reg = mn; }
    for (int r = 0; r < 16; ++r) p0[r] = p0[r] - mn; for (int r = 0; r < 16; ++r) p1[r] = p1[r] - mn;
    for (int r = 0; r < 16; ++r) p0[r] = __builtin_amdgcn_exp2f(p0[r]);
}
__device__ __forceinline__ void finishSM(f32x16& p0, f32x16& p1, float alpha, float& l_reg, bf16x8& pa0, bf16x8& pa1, bf16x8& pa2, bf16x8& pa3) {
    for (int r = 0; r < 16; ++r) p1[r] = __builtin_amdgcn_exp2f(p1[r]);
    float ps = 0; for (int r = 0; r < 16; ++r) ps += p0[r]; for (int r = 0; r < 16; ++r) ps += p1[r];
    { auto rr = __builtin_amdgcn_permlane32_swap(__float_as_uint(ps), __float_as_uint(ps), false, false);
      ps = __uint_as_float(rr[0]) + __uint_as_float(rr[1]); }
    l_reg = l_reg * alpha + ps;
#define PK4(P, B_, OUT) do { unsigned a0 = cvtpk(P[B_+0], P[B_+1]), a1 = cvtpk(P[B_+2], P[B_+3]);                          \
        unsigned b0 = cvtpk(P[B_+4], P[B_+5]), b1 = cvtpk(P[B_+6], P[B_+7]);                                             \
        auto r0 = __builtin_amdgcn_permlane32_swap(a0, b0, false, false); auto r1 = __builtin_amdgcn_permlane32_swap(a1, b1, false, false); \
        u32x4 w = {r0[0], r1[0], r0[1], r1[1]}; OUT = *reinterpret_cast<bf16x8*>(&w); } while (0)
    PK4(p0, 0, pa0); PK4(p0, 8, pa1); PK4(p1, 0, pa2); PK4(p1, 8, pa3);
#undef PK4
}
template <int KB>
__device__ __forceinline__ void qkt(f32x16& p0, f32x16& p1, const char* K_lds, int r32, int hi, const bf16x8* qr) {
    p0 = f32x16{}; p1 = f32x16{};
    const char* kb[4];
#pragma unroll
    for (int dd = 0; dd < 4; ++dd) kb[dd] = K_lds + KB * SHM_K + KSWZ(r32, (dd * 16 + hi * 8) * 2);
#pragma unroll
    for (int d0 = 0; d0 < 8; ++d0) { const char* a = kb[d0 & 3] + (d0 >> 2) * 128;
        bf16x8 b0 = *reinterpret_cast<const bf16x8*>(a);
        bf16x8 b1 = *reinterpret_cast<const bf16x8*>(a + 32 * 256);
        p0 = __builtin_amdgcn_mfma_f32_32x32x16_bf16(b0, qr[d0], p0, 0, 0, 0);
        p1 = __builtin_amdgcn_mfma_f32_32x32x16_bf16(b1, qr[d0], p1, 0, 0, 0); }
}
template <int VB>
__device__ __forceinline__ void pv_tile(f32x16* o, int vb0, bf16x8 pa0, bf16x8 pa1, bf16x8 pa2, bf16x8 pa3) {
#define TRRD(dst, off) asm volatile("ds_read_b64_tr_b16 %0, %1 offset:%2" : "=&v"(dst) : "v"(vb0), "i"(off) : "memory")
#define PV_D0(d0) do { s16x4 l0, l1, l2, l3, h0, h1, h2, h3; constexpr int b_ = VB * SHM_V + v_rd_off(d0, 0, 0); \
        TRRD(l0, b_); TRRD(h0, b_ + 2048); TRRD(l1, b_ + 4096); TRRD(h1, b_ + 6144); TRRD(l2, b_ + 8192); TRRD(h2, b_ + 10240); TRRD(l3, b_ + 12288); TRRD(h3, b_ + 14336); \
        asm volatile("s_waitcnt lgkmcnt(0)" ::: "memory"); SBAR();   \
        o[d0] = __builtin_amdgcn_mfma_f32_32x32x16_bf16(pa0, (bf16x8){l0[0], l0[1], l0[2], l0[3], h0[0], h0[1], h0[2], h0[3]}, o[d0], 0, 0, 0);   \
        o[d0] = __builtin_amdgcn_mfma_f32_32x32x16_bf16(pa1, (bf16x8){l1[0], l1[1], l1[2], l1[3], h1[0], h1[1], h1[2], h1[3]}, o[d0], 0, 0, 0);   \
        o[d0] = __builtin_amdgcn_mfma_f32_32x32x16_bf16(pa2, (bf16x8){l2[0], l2[1], l2[2], l2[3], h2[0], h2[1], h2[2], h2[3]}, o[d0], 0, 0, 0);   \
        o[d0] = __builtin_amdgcn_mfma_f32_32x32x16_bf16(pa3, (bf16x8){l3[0], l3[1], l3[2], l3[3], h3[0], h3[1], h3[2], h3[3]}, o[d0], 0, 0, 0); } while (0)
    PV_D0(0); PV_D0(1); PV_D0(2); PV_D0(3);
#undef PV_D0
#undef TRRD
}
struct BlockRef { const bf16_t* Q; const bf16_t* K; const bf16_t* V; bf16_t* O; int P0; };
struct Seam { bf16x8 qr[8]; bf16x8 st_v0, st_v1, st_k0, st_k1; };
#define ROW(p, k0, rr) ((p) + (size_t)((k0) + (rr)) * QP + sc)
#define VMW() asm volatile("s_waitcnt vmcnt(0)" ::: "memory")
#define VMWN(n) asm volatile("s_waitcnt vmcnt(%0)" :: "i"(n) : "memory")
#define SLOAD_H(Kp, Vp, k0) do { S.st_v0 = load8(ROW(Vp, k0, sr)); S.st_v1 = load8(ROW(Vp, k0, 32 + sr)); S.st_k0 = load8(ROW(Kp, k0, sr)); S.st_k1 = load8(ROW(Kp, k0, 32 + sr)); } while (0)
#define SWRITE_HK(bf) do { *(bf16x8*)(K_lds + (bf) * SHM_K + kws) = S.st_k0; *(bf16x8*)(K_lds + (bf) * SHM_K + kws + 32 * 256) = S.st_k1; } while (0)
#define SWRITE_HV(bf) do { *(bf16x8*)(V_lds + (bf) * SHM_V + vst0) = S.st_v0; *(bf16x8*)(V_lds + (bf) * SHM_V + vst1) = S.st_v1; } while (0)
#define SWRITE_H(bf) do { SWRITE_HV(bf); SWRITE_HK(bf); } while (0)
__device__ __forceinline__ void prime(const BlockRef& cur, int j_lo, char* lds, Seam& S) {
    const int tid = threadIdx.x, wid = __builtin_amdgcn_readfirstlane(tid >> 6), lane = tid & 63, r32 = lane & 31, hi = lane >> 5;
    const int sr = tid >> 4, sc = (tid & 15) * 8, kws = KSWZ(sr, sc * 2); char* K_lds = lds + 2 * SHM_V;
    for (int d0 = 0; d0 < 8; ++d0) S.qr[d0] = load8(cur.Q + (size_t)(wid * QBLK + r32) * QP + d0 * 16 + hi * 8);
    SLOAD_H(cur.K, cur.V, j_lo * KVBLK); VMW(); SWRITE_HK(0);
    __syncthreads();
}
__device__ __forceinline__ void block(const BlockRef& cur, const BlockRef& nxt, int j_lo, char* lds, Seam& S) {
    const int tid = threadIdx.x, wid = __builtin_amdgcn_readfirstlane(tid >> 6), lane = tid & 63, r32 = lane & 31, hi = lane >> 5;
    const int NT = (cur.P0 + QB - 1) / KVBLK + 1 - j_lo;
    const int qlo = cur.P0 + wid * QBLK, qm = qlo + r32 - 4 * hi;
    char* V_lds = lds; char* K_lds = lds + 2 * SHM_V;
    float* ws = (float*)(lds + 2 * SHM_V + 2 * SHM_K) + wid * 64; float* li_l = ws, * al_l = ws + 32;
    const float* c_lds = (const float*)(lds + LDS_C) + 4 * hi;
    float m_reg = -1e30f, l_reg = 0; f32x16 o[4] = {};
    const int sr = tid >> 4, sc = (tid & 15) * 8, vst0 = v_st(sr, sc), vst1 = v_st(32 + sr, sc), kws = KSWZ(sr, sc * 2);
    const int vb0 = (int)(uintptr_t)V_lds + v_rd_base(lane);
    const bf16_t* Kh = cur.K; const bf16_t* Vh = cur.V;
#define RESC(a) do { if (__any((a) < 1.f)) { if (hi == 0) al_l[r32] = (a); asm volatile("s_waitcnt lgkmcnt(0)" ::: "memory");              \
                     for (int d_ = 0; d_ < 4; ++d_) for (int r = 0; r < 16; ++r) o[d_][r] *= al_l[crow(r, hi)]; } } while (0)
#define KBASE(t) ((j_lo + (t)) * KVBLK)
#define MASKT(P0_, P1_, t) do { const int kb_ = KBASE(t); bias_tile(P0_, P1_, c_lds + kb_); if (kb_ + KVBLK - 1 > qlo) mask_tile(P0_, P1_, qm - kb_); } while (0)
#define SEAM_K0() do { VMWN(8); SWRITE_HK(0); SBAR(); } while (0)
    f32x16 pA0, pA1, pB0, pB1; float mnA, mnB, alA, alB; bf16x8 pa0, pa1, pa2, pa3;
    SWRITE_HV(0); SBAR();
    if (NT > 1) { SLOAD_H(Kh, Vh, KBASE(1)); }
    SBAR(); qkt<0>(pA0, pA1, K_lds, r32, hi, S.qr);
    MASKT(pA0, pA1, 0); partialSM(pA0, pA1, m_reg, mnA, alA);
    if (NT > 1) { VMW(); SWRITE_H(1); }
    __syncthreads();
#define HALF_STEP(PX0, PX1, mnX, alX, PY0, PY1, alY, t, KB, VB, SB) do {                                                      \
        SBAR(); qkt<KB>(PX0, PX1, K_lds, r32, hi, S.qr);                                                                     \
        finishSM(PY0, PY1, alY, l_reg, pa0, pa1, pa2, pa3); SBAR();                                                           \
        if ((t) + 1 < NT) { SLOAD_H(Kh, Vh, KBASE((t) + 1)); SBAR(); }                                                        \
        pv_tile<VB>(o, vb0, pa0, pa1, pa2, pa3); MASKT(PX0, PX1, (t)); partialSM(PX0, PX1, m_reg, mnX, alX);                 \
        __syncthreads();                                                                                                      \
        if ((t) + 1 < NT) { VMW(); SWRITE_H(SB); }                                                                            \
        RESC(alX); __syncthreads(); } while (0)
    for (int t = 1; t + 1 < NT; t += 2) {
        HALF_STEP(pB0, pB1, mnB, alB, pA0, pA1, alA, t, 1, 0, 0);
        HALF_STEP(pA0, pA1, mnA, alA, pB0, pB1, alB, t + 1, 0, 1, 1);
    }
    const bool even = (NT & 1) == 0;
    if (even) { SBAR(); qkt<1>(pB0, pB1, K_lds, r32, hi, S.qr); SBAR(); }
    SLOAD_H(nxt.K, nxt.V, j_lo * KVBLK); SBAR();
#pragma unroll
    for (int d0 = 0; d0 < 8; ++d0) S.qr[d0] = load8(nxt.Q + (size_t)(wid * QBLK + r32) * QP + d0 * 16 + hi * 8);
    SBAR();
    finishSM(pA0, pA1, alA, l_reg, pa0, pa1, pa2, pa3); SBAR();
    pv_tile<0>(o, vb0, pa0, pa1, pa2, pa3);
    if (even) { MASKT(pB0, pB1, NT - 1); partialSM(pB0, pB1, m_reg, mnB, alB); __syncthreads(); RESC(alB);
        finishSM(pB0, pB1, alB, l_reg, pa0, pa1, pa2, pa3); SBAR(); pv_tile<1>(o, vb0, pa0, pa1, pa2, pa3); }
    SBAR(); SEAM_K0();
    if (hi == 0) li_l[r32] = l_reg; asm volatile("s_waitcnt lgkmcnt(0)" ::: "memory");
    float rli[16];
#pragma unroll
    for (int r = 0; r < 16; ++r) rli[r] = __builtin_amdgcn_rcpf(li_l[crow(r, hi)]);
    bf16_t* Ow = cur.O + (size_t)(wid * QBLK) * OP;
#pragma unroll
    for (int r = 0; r < 16; ++r) { const int orow = crow(r, hi);
#pragma unroll
        for (int d0 = 0; d0 < 4; ++d0) { const float v = o[d0][r] * rli[r];
            const float vn = __shfl_xor(v, 1);
            if ((r32 & 1) == 0) *(unsigned*)(Ow + (size_t)orow * OP + d0 * 32 + r32) = cvtpk(v, vn); } }
    __syncthreads();
#undef RESC
#undef KBASE
#undef MASKT
#undef SEAM_K0
#undef HALF_STEP
}
#undef ROW
#undef VMW
#undef VMWN
#undef SLOAD_H
#undef SWRITE_HK
#undef SWRITE_HV
#undef SWRITE_H
#undef KSWZ
#undef SBAR
}

constexpr int NWAVES = 8, NTHREADS = 512;
constexpr int LDS_BYTES = 147456;
constexpr int LDS_MISC = 145408;
constexpr size_t MiB = 1u << 20;
constexpr size_t WS_CTL = 0, CTL_ZERO_BYTES = 1 * MiB;
#ifndef QSPLIT
#define QSPLIT 512
#endif
constexpr int CW_QUEUE2 = 128;
constexpr int CW_NRM = 512;
constexpr int CW_QUEUE = 64;
constexpr int CW_BAR = 4096;
constexpr size_t CTL_SS1 = 256 * 1024, CTL_SS2 = 320 * 1024;
constexpr size_t WS_LF = 1 * MiB;
constexpr size_t WS_SU = 1 * MiB + 512 * 1024, WS_SV = 1 * MiB + 640 * 1024;
constexpr size_t WS_WIN = 2 * MiB, WS_WO1 = 18 * MiB, WS_WO2 = 26 * MiB, WS_WQ = 34 * MiB, WS_WK = 42 * MiB, WS_WV = 50 * MiB, WS_WO = 58 * MiB;
constexpr size_t WS_WPQ = 66 * MiB, WS_AEXP = 74 * MiB, WS_WSC = 82 * MiB, WS_PB = 90 * MiB, WS_MN = 91 * MiB, WS_KX = 93 * MiB, WS_VXT = 95 * MiB;
constexpr size_t WS_UB = 98 * MiB, WS_VB = 130 * MiB, WS_XN = 226 * MiB, WS_PROJ = 258 * MiB, WS_AMIX = 322 * MiB, WS_H = 354 * MiB, WS_HB = 418 * MiB, WS_P = 450 * MiB, WS_END = 466 * MiB;

#define GAS __attribute__((address_space(1)))
#define LAS __attribute__((address_space(3)))
typedef unsigned short bf16;
typedef unsigned v4u __attribute__((ext_vector_type(4)));
typedef unsigned v2u __attribute__((ext_vector_type(2)));
typedef float f32x4 __attribute__((ext_vector_type(4)));
typedef __bf16 bf16x2_t __attribute__((ext_vector_type(2)));
#define LDS_WAIT() asm volatile("s_waitcnt lgkmcnt(0)" ::: "memory")
__device__ __forceinline__ unsigned f2bf(float f) { unsigned u = __builtin_bit_cast(unsigned, f); return (u + 0x7fffu + ((u >> 16) & 1u)) >> 16; }
__device__ __forceinline__ unsigned pk2(float lo, float hi) { return f2bf(lo) | (f2bf(hi) << 16); }
__device__ __forceinline__ float wave_sum(float v) {
#pragma unroll
    for (int o = 1; o < 64; o <<= 1) v += __shfl_xor(v, o);
    return v;
}

#define XB_TMO      128
#define XB_XCNT(j)  (256  + 64 * (j))
#define XB_XSUB(j)  (1280 + 64 * (j))
#define XB_XGEN(j)  (2304 + 64 * (j))
#define XB_TOP      3328
#define XB_TOPGEN   3392
#define XCD_BAR_WORDS 3456
#define XB_SPIN_CAP (1u << 22)
__device__ __forceinline__ unsigned xb_ld(unsigned* p)              { return __hip_atomic_load(p, __ATOMIC_RELAXED, __HIP_MEMORY_SCOPE_AGENT); }
__device__ __forceinline__ unsigned xb_add(unsigned* p, unsigned v) { return __hip_atomic_fetch_add(p, v, __ATOMIC_RELAXED, __HIP_MEMORY_SCOPE_AGENT); }
__device__ __forceinline__ unsigned xb_xcc_id() { return (unsigned)__builtin_amdgcn_s_getreg((3 << 11) | 20) & 0xFu; }
#define XB_SPIN(cond, bar) do { unsigned _sp = 0; while (cond) { __builtin_amdgcn_s_sleep(1); \
    if ((++_sp & 255u) == 0u) { if (xb_ld(&(bar)[XB_TMO])) break; if (_sp > XB_SPIN_CAP) { atomicAdd(&(bar)[XB_TMO], 1u); break; } } } } while (0)
struct XcdBarrier { unsigned* bar; unsigned x; volatile LAS unsigned* st; };
__device__ __forceinline__ XcdBarrier xcd_barrier_post(unsigned* bar, volatile LAS unsigned* st) {
    XcdBarrier b; b.bar = bar; b.x = xb_xcc_id(); b.st = st;
    if (threadIdx.x == 0) (void)xb_add(&bar[XB_XCNT(b.x)], 1u);
    return b;
}
__device__ __forceinline__ void xcd_barrier_complete(unsigned* bar, unsigned x, unsigned& nloc, unsigned& nx) {
    const unsigned G = gridDim.x * gridDim.y * gridDim.z;
    unsigned sum, cnt, mine, sp = 0u;
    for (;;) {
        sum = 0u; cnt = 0u; mine = 0u;
#pragma unroll
        for (unsigned j = 0; j < 16; ++j) { const unsigned c = xb_ld(&bar[XB_XCNT(j)]); sum += c; cnt += (c > 0u) ? 1u : 0u; mine = (j == x) ? c : mine; }
        if (sum == G) break;
        __builtin_amdgcn_s_sleep(1);
        if ((++sp & 255u) == 0u) { if (xb_ld(&bar[XB_TMO])) break; if (sp > XB_SPIN_CAP) { atomicAdd(&bar[XB_TMO], 1u); break; } }
    }
    nloc = mine > 0u ? mine : 1u; nx = cnt > 0u ? cnt : 1u;
}
__device__ __forceinline__ void xcd_barrier(const XcdBarrier& b) {
    asm volatile("s_waitcnt vmcnt(0)" ::: "memory");
    __syncthreads();
    if (threadIdx.x == 0) {
        unsigned* bar = b.bar;
        __builtin_amdgcn_s_waitcnt(0);
        unsigned nloc = b.st[0], nx = b.st[1];
        if (nloc == 0u) { xcd_barrier_complete(bar, b.x, nloc, nx); b.st[0] = nloc; b.st[1] = nx; }
        const unsigned old = xb_add(&bar[XB_XSUB(b.x)], 1u);
        const unsigned gen = old / nloc;
        if (old + 1u == (gen + 1u) * nloc) {
            __builtin_amdgcn_fence(__ATOMIC_RELEASE, "agent");
            asm volatile("s_waitcnt vmcnt(0)" ::: "memory");
            const unsigned og = xb_add(&bar[XB_TOP], 1u);
            const unsigned tg = og / nx;
            if (og + 1u == (tg + 1u) * nx) xb_add(&bar[XB_TOPGEN], 1u);
            else XB_SPIN(xb_ld(&bar[XB_TOPGEN]) == tg, bar);
            __builtin_amdgcn_fence(__ATOMIC_ACQUIRE, "agent");
            xb_add(&bar[XB_XGEN(b.x)], 1u);
            asm volatile("s_waitcnt vmcnt(0)" ::: "memory");
        } else {
            XB_SPIN(xb_ld(&bar[XB_XGEN(b.x)]) == gen, bar);
            __builtin_amdgcn_fence(__ATOMIC_ACQUIRE, "agent");
            asm volatile("s_waitcnt vmcnt(0)" ::: "memory");
        }
    }
    __syncthreads();
}

struct Args { const float* in[20]; float* out; unsigned char* ws; int ph_lo, ph_hi; int one_launch, pad; };

__device__ __forceinline__ void tr_load(const float* W, int ldw, int nblk, int item, int lane, f32x4 (&tv)[8]) {
    const int kb = item / nblk, nb = item % nblk, k0 = 64 * kb, n0 = 32 * nb;
#pragma unroll
    for (int i = 0; i < 8; ++i) tv[i] = __builtin_nontemporal_load((const GAS f32x4*)(W + (size_t)(k0 + i * 8 + (lane >> 3)) * ldw + n0 + (lane & 7) * 4));
}
__device__ __forceinline__ void tr_store(const f32x4 (&tv)[8], int nblk, bf16* WT, bf16* WT2, int k2lo, int ldt, LAS float* scr, int item, int lane) {
    const int kb = item / nblk, nb = item % nblk, k0 = 64 * kb, n0 = 32 * nb;
#pragma unroll
    for (int i = 0; i < 8; ++i) { const int kk = i * 8 + (lane >> 3); LAS float* d = scr + kk * 33 + (lane & 7) * 4; d[0] = tv[i][0]; d[1] = tv[i][1]; d[2] = tv[i][2]; d[3] = tv[i][3]; }
    LDS_WAIT(); asm volatile("" ::: "memory");
    const int c = lane & 7;
#pragma unroll
    for (int j = 0; j < 4; ++j) { const int n = (lane >> 3) + 8 * j; const LAS float* s = scr + (8 * c) * 33 + n;
        v4u o; o.x = pk2(s[0 * 33], s[1 * 33]); o.y = pk2(s[2 * 33], s[3 * 33]); o.z = pk2(s[4 * 33], s[5 * 33]); o.w = pk2(s[6 * 33], s[7 * 33]);
        *(GAS v4u*)(WT + (size_t)(n0 + n) * ldt + k0 + 8 * c) = o;
        if (WT2 && k0 >= k2lo) *(GAS v4u*)(WT2 + (size_t)(n0 + n) * ldt + k0 + 8 * c) = o; }
    LDS_WAIT(); asm volatile("" ::: "memory");
}
__device__ __forceinline__ void p0_transpose_item(const float* W, int ldw, int nblk, const float* g, bf16* WT, bf16* WT2, int k2lo, int ldt, LAS float* scr, int item, int lane) {
    (void)g; f32x4 tv[8]; tr_load(W, ldw, nblk, item, lane, tv); tr_store(tv, nblk, WT, WT2, k2lo, ldt, scr, item, lane);
}
__device__ __forceinline__ v4u cvt8(const float* p, float s) {
    const f32x4 a = __builtin_nontemporal_load((const GAS f32x4*)p), b = __builtin_nontemporal_load((const GAS f32x4*)(p + 4));
    v4u o; o.x = pk2(a[0] * s, a[1] * s); o.y = pk2(a[2] * s, a[3] * s); o.z = pk2(b[0] * s, b[1] * s); o.w = pk2(b[2] * s, b[3] * s); return o;
}

__device__ __forceinline__ float gelu_f(float v) {
    const float av = fabsf(v), t = __builtin_amdgcn_rcpf(av * 0.2316418882f + 1.0f);
    float q = t * 0.5307027145f + (-0.7265760135f); q = q * t + 0.7107068705f; q = q * t + (-0.142248368f); q = q * t + 0.127414796f; q = q * t;
    const float e = __builtin_amdgcn_exp2f((v * v) * (-0.72134752044f));
    const float m = v * (q * e);
    return v < 0.f ? m : v - m;
}
__device__ __forceinline__ float dot2bf(unsigned a, unsigned b, float c) { return __builtin_amdgcn_fdot2_f32_bf16(__builtin_bit_cast(bf16x2_t, a), __builtin_bit_cast(bf16x2_t, b), c, false); }
__device__ __forceinline__ unsigned fkey(float f) { const unsigned u = __float_as_uint(f); return (u & 0x80000000u) ? ~u : (u | 0x80000000u); }
__device__ __forceinline__ float fdec(unsigned k) { const unsigned u = (k & 0x80000000u) ? (k & 0x7fffffffu) : ~k; return __uint_as_float(u); }


typedef float f32x2v __attribute__((ext_vector_type(2)));
__device__ __forceinline__ float wave_sum_dpp(float v) {
    v += __builtin_bit_cast(float, __builtin_amdgcn_update_dpp(0, __builtin_bit_cast(int, v), 0xB1, 0xf, 0xf, true));
    v += __builtin_bit_cast(float, __builtin_amdgcn_update_dpp(0, __builtin_bit_cast(int, v), 0x4E, 0xf, 0xf, true));
    v += __builtin_bit_cast(float, __builtin_amdgcn_update_dpp(0, __builtin_bit_cast(int, v), 0x141, 0xf, 0xf, true));
    v += __builtin_bit_cast(float, __builtin_amdgcn_update_dpp(0, __builtin_bit_cast(int, v), 0x140, 0xf, 0xf, true));
    const float a = __builtin_bit_cast(float, __builtin_amdgcn_readlane(__builtin_bit_cast(int, v), 0));
    const float b = __builtin_bit_cast(float, __builtin_amdgcn_readlane(__builtin_bit_cast(int, v), 16));
    const float c = __builtin_bit_cast(float, __builtin_amdgcn_readlane(__builtin_bit_cast(int, v), 32));
    const float d = __builtin_bit_cast(float, __builtin_amdgcn_readlane(__builtin_bit_cast(int, v), 48));
    return (a + b) + (c + d);
}
typedef float v32f __attribute__((ext_vector_type(32)));
typedef float v16f __attribute__((ext_vector_type(16)));
typedef unsigned v6u __attribute__((ext_vector_type(6)));
#ifndef FP6_INTERLEAVED
#define FP6_INTERLEAVED 1
#endif
__device__ __forceinline__ v32f dec_fp6(const v4u a, const v2u b) { const v6u w = {a.x, a.y, a.z, a.w, b.x, b.y}; return __builtin_amdgcn_cvt_scalef32_pk32_f32_fp6(w, 1.0f); }
typedef __bf16 v32bf __attribute__((ext_vector_type(32)));
typedef unsigned v16u __attribute__((ext_vector_type(16)));
typedef int v8i_t __attribute__((ext_vector_type(8)));
__device__ __forceinline__ f32x4 peer_mfma(const v4u a, const v8i_t b) {
    const f32x4 z = {0.f, 0.f, 0.f, 0.f};
    return __builtin_amdgcn_mfma_scale_f32_16x16x128_f8f6f4((v8i_t){(int)a.x, (int)a.y, (int)a.z, (int)a.w, 0, 0, 0, 0}, b, z, 4, 0, 0, 0, 0, 0);
}
__device__ __forceinline__ float peer_dot4(const v4u ua, const unsigned (&xnp)[16]) {
    const unsigned d0 = ua.x, d1 = ua.y, d2 = ua.z, d3 = ua.w; float a[4] = {0.f, 0.f, 0.f, 0.f};
#define FP4B(D, B) __builtin_bit_cast(unsigned, __builtin_amdgcn_cvt_scalef32_pk_bf16_fp4(D, 1.0f, B))
    a[0] = dot2bf(FP4B(d0, 0), xnp[0], a[0]); a[1] = dot2bf(FP4B(d0, 1), xnp[1], a[1]); a[2] = dot2bf(FP4B(d0, 2), xnp[2], a[2]); a[3] = dot2bf(FP4B(d0, 3), xnp[3], a[3]);
    a[0] = dot2bf(FP4B(d1, 0), xnp[4], a[0]); a[1] = dot2bf(FP4B(d1, 1), xnp[5], a[1]); a[2] = dot2bf(FP4B(d1, 2), xnp[6], a[2]); a[3] = dot2bf(FP4B(d1, 3), xnp[7], a[3]);
    a[0] = dot2bf(FP4B(d2, 0), xnp[8], a[0]); a[1] = dot2bf(FP4B(d2, 1), xnp[9], a[1]); a[2] = dot2bf(FP4B(d2, 2), xnp[10], a[2]); a[3] = dot2bf(FP4B(d2, 3), xnp[11], a[3]);
    a[0] = dot2bf(FP4B(d3, 0), xnp[12], a[0]); a[1] = dot2bf(FP4B(d3, 1), xnp[13], a[1]); a[2] = dot2bf(FP4B(d3, 2), xnp[14], a[2]); a[3] = dot2bf(FP4B(d3, 3), xnp[15], a[3]);
#undef FP4B
    return (a[0] + a[1]) + (a[2] + a[3]);
}
__device__ __forceinline__ float peer_dot(const v4u ua, const v2u ub, const unsigned (&xnp)[16]) {
    const v6u w = {ua.x, ua.y, ua.z, ua.w, ub.x, ub.y};
    const v16u fu = __builtin_bit_cast(v16u, __builtin_amdgcn_cvt_scalef32_pk32_bf16_fp6(w, 1.0f));
    unsigned fa[16];
#pragma unroll
    for (int i = 0; i < 16; ++i) fa[i] = fu[i];
    float a[4] = {0.f, 0.f, 0.f, 0.f};
#pragma unroll
    for (int i = 0; i < 16; ++i) a[i & 3] = dot2bf(fa[i], xnp[i], a[i & 3]);
    return (a[0] + a[1]) + (a[2] + a[3]);
}
__device__ __forceinline__ float peer_dot_lds(const v4u ua, const v2u ub, const LAS v4u* xl) {
    const v6u w = {ua.x, ua.y, ua.z, ua.w, ub.x, ub.y};
    const v16u fu = __builtin_bit_cast(v16u, __builtin_amdgcn_cvt_scalef32_pk32_bf16_fp6(w, 1.0f));
    unsigned fa[16];
#pragma unroll
    for (int i = 0; i < 16; ++i) fa[i] = fu[i];
    float a[4] = {0.f, 0.f, 0.f, 0.f};
#pragma unroll
    for (int i4 = 0; i4 < 4; ++i4) { const v4u x4 = xl[i4 * 64];
        a[0] = dot2bf(fa[i4 * 4 + 0], x4.x, a[0]); a[1] = dot2bf(fa[i4 * 4 + 1], x4.y, a[1]); a[2] = dot2bf(fa[i4 * 4 + 2], x4.z, a[2]); a[3] = dot2bf(fa[i4 * 4 + 3], x4.w, a[3]); }
    return (a[0] + a[1]) + (a[2] + a[3]);
}
typedef _Float16 h16x2 __attribute__((ext_vector_type(2)));
__device__ __forceinline__ unsigned pkfma_h(unsigned a, unsigned b, unsigned c) { return __builtin_bit_cast(unsigned, __builtin_elementwise_fma(__builtin_bit_cast(h16x2, a), __builtin_bit_cast(h16x2, b), __builtin_bit_cast(h16x2, c))); }
__device__ __forceinline__ float h16lo(unsigned u) { return (float)__builtin_bit_cast(h16x2, u).x; }
__device__ __forceinline__ float h16hi(unsigned u) { return (float)__builtin_bit_cast(h16x2, u).y; }
__device__ __forceinline__ void peer_axpy_h4(const v4u va, float w, unsigned (&oh)[16]) {
    const h16x2 w2 = {(_Float16)w, (_Float16)w}; const unsigned wu = __builtin_bit_cast(unsigned, w2);
    const unsigned d0 = va.x, d1 = va.y, d2 = va.z, d3 = va.w;
#define FP4PAIR(D, B) __builtin_bit_cast(unsigned, __builtin_amdgcn_cvt_scalef32_pk_f16_fp4(D, 1.0f, B))
    oh[0] = pkfma_h(FP4PAIR(d0, 0), wu, oh[0]); oh[1] = pkfma_h(FP4PAIR(d0, 1), wu, oh[1]); oh[2] = pkfma_h(FP4PAIR(d0, 2), wu, oh[2]); oh[3] = pkfma_h(FP4PAIR(d0, 3), wu, oh[3]);
    oh[4] = pkfma_h(FP4PAIR(d1, 0), wu, oh[4]); oh[5] = pkfma_h(FP4PAIR(d1, 1), wu, oh[5]); oh[6] = pkfma_h(FP4PAIR(d1, 2), wu, oh[6]); oh[7] = pkfma_h(FP4PAIR(d1, 3), wu, oh[7]);
    oh[8] = pkfma_h(FP4PAIR(d2, 0), wu, oh[8]); oh[9] = pkfma_h(FP4PAIR(d2, 1), wu, oh[9]); oh[10] = pkfma_h(FP4PAIR(d2, 2), wu, oh[10]); oh[11] = pkfma_h(FP4PAIR(d2, 3), wu, oh[11]);
    oh[12] = pkfma_h(FP4PAIR(d3, 0), wu, oh[12]); oh[13] = pkfma_h(FP4PAIR(d3, 1), wu, oh[13]); oh[14] = pkfma_h(FP4PAIR(d3, 2), wu, oh[14]); oh[15] = pkfma_h(FP4PAIR(d3, 3), wu, oh[15]);
#undef FP4PAIR
}
__device__ __forceinline__ void peer_axpy_h(const v4u va, const v2u vb, float w, unsigned (&oh)[16]) {
    const v6u wv = {va.x, va.y, va.z, va.w, vb.x, vb.y};
    const v16u fu = __builtin_bit_cast(v16u, __builtin_amdgcn_cvt_scalef32_pk32_f16_fp6(wv, 1.0f));
    unsigned fa[16];
#pragma unroll
    for (int i = 0; i < 16; ++i) fa[i] = fu[i];
    const h16x2 w2 = {(_Float16)w, (_Float16)w}; const unsigned wu = __builtin_bit_cast(unsigned, w2);
#pragma unroll
    for (int i = 0; i < 16; ++i) oh[i] = pkfma_h(fa[i], wu, oh[i]);
}
__device__ __forceinline__ void peer_axpy(const v4u va, const v2u vb, float w, float (&oacc)[32]) {
    const v32f f = dec_fp6(va, vb);
#pragma unroll
    for (int i = 0; i < 32; ++i) oacc[i] = fmaf(w, f[i], oacc[i]);
}


template <int NR, bool FP4>
__device__ __forceinline__ void conv_rows_fp6(const float* srow0, unsigned char* drow0, float* sc0, int lane) {
    f32x4 v[NR][8]; float am[NR];
#pragma unroll
    for (int q = 0; q < 8; ++q)
#pragma unroll
        for (int r = 0; r < NR; ++r) v[r][q] = __builtin_nontemporal_load((const GAS f32x4*)(srow0 + (size_t)r * DM + lane * 4 + q * 256));
#pragma unroll
    for (int r = 0; r < NR; ++r) { am[r] = 0.f;
#pragma unroll
        for (int q = 0; q < 8; ++q) am[r] = fmaxf(am[r], fmaxf(fmaxf(fabsf(v[r][q][0]), fabsf(v[r][q][1])), fmaxf(fabsf(v[r][q][2]), fabsf(v[r][q][3])))); }
#pragma unroll
    for (int o = 1; o < 64; o <<= 1)
#pragma unroll
        for (int r = 0; r < NR; ++r) am[r] = fmaxf(am[r], __shfl_xor(am[r], o));
#pragma unroll
    for (int r = 0; r < NR; ++r) {
        const float top = FP4 ? 6.0f : 7.5f;
        int ex = 0; if (am[r] > 0.f) { (void)frexpf(am[r], &ex); ex = 3 - ex; if (ldexpf(am[r], ex) > top) ex -= 1; }
        const float sc = ldexpf(1.f, ex);
        if (lane == 0) sc0[r] = ldexpf(1.f, -ex);
        if constexpr (FP4) {
            unsigned char* drow = drow0 + (size_t)r * 1024; v4u w = {0u, 0u, 0u, 0u};
#pragma unroll
            for (int j = 0; j < 4; ++j) { unsigned wj = 0u;
                wj = __builtin_amdgcn_cvt_scalef32_pk_fp4_f32(wj, v[r][2 * j][0] * sc, v[r][2 * j][1] * sc, 1.0f, 0); wj = __builtin_amdgcn_cvt_scalef32_pk_fp4_f32(wj, v[r][2 * j][2] * sc, v[r][2 * j][3] * sc, 1.0f, 1);
                wj = __builtin_amdgcn_cvt_scalef32_pk_fp4_f32(wj, v[r][2 * j + 1][0] * sc, v[r][2 * j + 1][1] * sc, 1.0f, 2); wj = __builtin_amdgcn_cvt_scalef32_pk_fp4_f32(wj, v[r][2 * j + 1][2] * sc, v[r][2 * j + 1][3] * sc, 1.0f, 3);
                if (j == 0) w.x = wj; else if (j == 1) w.y = wj; else if (j == 2) w.z = wj; else w.w = wj; }
            *(GAS v4u*)(drow + lane * 16) = w;
        } else {
            v16f xa, xb;
#pragma unroll
            for (int i = 0; i < 16; ++i) { xa[i] = v[r][(2 * i) >> 2][(2 * i) & 3] * sc; xb[i] = v[r][(2 * i + 1) >> 2][(2 * i + 1) & 3] * sc; }
            const v6u w = __builtin_amdgcn_cvt_scalef32_2xpk16_fp6_f32(xa, xb, 1.0f);
            unsigned char* drow = drow0 + (size_t)r * 1536;
            *(GAS v4u*)(drow + lane * 16) = (v4u){w[0], w[1], w[2], w[3]};
            *(GAS v2u*)(drow + 1024 + lane * 8) = (v2u){w[4], w[5]};
        }
    }
}

#if defined(PROBE_SEL) && PROBE_SEL < 7
#define PROBE_EXPORT(T_, q) do { if ((T_) == 0 && lane == 0 && (q) == 0) { const unsigned long long a_ = ((unsigned long long)MISC[33 + 2 * PROBE_SEL] << 32) | MISC[32 + 2 * PROBE_SEL], b_ = ((unsigned long long)MISC[35 + 2 * PROBE_SEL] << 32) | MISC[34 + 2 * PROBE_SEL]; o[0] += (float)(b_ - a_) * 0.001f; } } while (0)
#else
#define PROBE_EXPORT(T_, q) do { } while (0)
#endif
__global__ void __launch_bounds__(NTHREADS, 2) fwd_kernel(Args args) {
    extern __shared__ __attribute__((aligned(16))) unsigned char lds[];
    LAS unsigned char* ldsL = (LAS unsigned char*)lds;
    volatile LAS unsigned* MISC = (volatile LAS unsigned*)(ldsL + LDS_MISC);
    const int tid = threadIdx.x, lane = tid & 63, wave = __builtin_amdgcn_readfirstlane(tid >> 6);
    const int G = gridDim.x; const int bx = blockIdx.x; const int vcu = (G % 8 == 0) ? (bx % 8) * (G / 8) + bx / 8 : bx;
#define G_ws (args.ws)
#define G_ctl ((unsigned*)(args.ws + WS_CTL))
#define G_x (args.in[0])
#define G_mem (args.in[1])
#define G_mix_norm (args.in[2])
#define G_w_in (args.in[3])
#define G_b_forget (args.in[4])
#define G_pool_w (args.in[5])
#define G_pool_scale (args.in[6])
#define G_w_out (args.in[7])
#define G_xattn_norm (args.in[8])
#define G_mem_norm (args.in[9])
#define G_xwq (args.in[10])
#define G_xwk (args.in[11])
#define G_xwv (args.in[12])
#define G_xwo (args.in[13])
#define G_peer_norm (args.in[14])
#define G_peer_wq (args.in[15])
#define G_sub_keys (args.in[16])
#define G_peer_u (args.in[17])
#define G_peer_v (args.in[18])
#define G_final_norm (args.in[19])
#define G_W_IN ((bf16*)(args.ws + WS_WIN))
#define G_WO1 ((bf16*)(args.ws + WS_WO1))
#define G_WO2 ((bf16*)(args.ws + WS_WO2))
#define G_WQ ((bf16*)(args.ws + WS_WQ))
#define G_WK ((bf16*)(args.ws + WS_WK))
#define G_WV ((bf16*)(args.ws + WS_WV))
#define G_WO ((bf16*)(args.ws + WS_WO))
#define G_WPQ ((bf16*)(args.ws + WS_WPQ))
#define G_AEXP ((bf16*)(args.ws + WS_AEXP))
#define G_W1 ((bf16*)(args.ws + WS_AEXP))
#define G_W2 ((bf16*)(args.ws + WS_WPQ))
#define G_WSC ((bf16*)(args.ws + WS_WSC))
#define G_PB ((bf16*)(args.ws + WS_PB))
#define G_MN ((bf16*)(args.ws + WS_MN))
#define G_KX ((bf16*)(args.ws + WS_KX))
#define G_VXT ((bf16*)(args.ws + WS_VXT))
#define G_UB (args.ws + WS_UB)
#define G_VB (args.ws + WS_VB)
#define G_SU ((float*)(args.ws + WS_SU))
#define G_SV ((float*)(args.ws + WS_SV))
#define G_XN ((bf16*)(args.ws + WS_XN))
#define G_QX ((bf16*)(args.ws + WS_XN))
#define G_PROJ ((bf16*)(args.ws + WS_PROJ))
#define G_SCT ((float*)(args.ws + WS_PROJ))
#define G_AMIX ((bf16*)(args.ws + WS_AMIX))
#define G_OX ((bf16*)(args.ws + WS_AMIX))
#define G_H ((float*)(args.ws + WS_H))
#define G_HB ((bf16*)(args.ws + WS_HB))
#define G_PP ((bf16*)(args.ws + WS_P))
#define G_LF ((float*)(args.ws + WS_LF))
#define G_SS1 ((float*)(args.ws + CTL_SS1))
#define G_SS2 ((float*)(args.ws + CTL_SS2))

    for (int u = tid; u < (LDS_BYTES - LDS_MISC) / 4; u += NTHREADS) ((LAS unsigned*)(ldsL + LDS_MISC))[u] = 0u;
    __syncthreads();
    XcdBarrier bar; bar.bar = G_ctl + CW_BAR; bar.x = 0; bar.st = nullptr;
    if (args.one_launch) bar = xcd_barrier_post(G_ctl + CW_BAR, MISC + 8);
    const int lo = args.ph_lo, hi = args.ph_hi;
#ifndef PH_MASK
#define PH_MASK 0xff
#endif
#define IN(k) (((PH_MASK >> (k)) & 1) && lo <= (k) && (k) < hi)
#ifdef PROBE_SEL
#define STAMP(i) do { if (bx == 0 && tid == 0) { const unsigned long long t_ = __builtin_amdgcn_s_memrealtime(); MISC[32 + 2 * (i)] = (unsigned)t_; MISC[33 + 2 * (i)] = (unsigned)(t_ >> 32); } } while (0)
#else
#define STAMP(i) do { } while (0)
#endif
#define SEAM(k) do { if (IN(k) && IN((k) + 1)) xcd_barrier(bar); STAMP((k) + 1); } while (0)
#define TABLE_CHUNK(c_) do { const int r_ = (c_) * 32 + wave * 4; const int rr_ = r_ & (PEXP - 1); \
        if (r_ >> 14) conv_rows_fp6<4, true>(G_peer_v + (size_t)rr_ * DM, G_VB + (size_t)rr_ * 1024, G_SV + rr_, lane); \
        else conv_rows_fp6<4, true>(G_peer_u + (size_t)rr_ * DM, G_UB + (size_t)rr_ * 1024, G_SU + rr_, lane); } while (0)
    STAMP(0);
#if defined(PROBE_SEL) && PROBE_SEL >= 7
    if (bx == 0 && tid == 0) __hip_atomic_store((unsigned long long*)(G_ctl + 256), (unsigned long long)__builtin_amdgcn_s_memrealtime(), __ATOMIC_RELAXED, __HIP_MEMORY_SCOPE_AGENT);
#endif
    const int gw = vcu * NWAVES + wave, NGW = G * NWAVES;
    const int gt = vcu * NTHREADS + tid, NGT = G * NTHREADS;

    if (IN(0)) for (int rep_ = 0; rep_ < (((DUP_MASK >> 0) & 1) ? args.pad + 1 : 1); ++rep_) {
        LAS float* wf = (LAS float*)ldsL;
        LAS float* scr = (LAS float*)(ldsL + 65536 + wave * 8704);
#pragma unroll
        for (int i = 0; i < DM / NTHREADS; ++i) { const int d = tid + i * NTHREADS; const f32x4 a = *(const GAS f32x4*)(G_w_in + (size_t)d * INC + 4096), b = *(const GAS f32x4*)(G_w_in + (size_t)d * INC + 4100);
            wf[d] = a[0]; wf[DM + d] = a[1]; wf[2 * DM + d] = a[2]; wf[3 * DM + d] = a[3]; wf[4 * DM + d] = b[0]; wf[5 * DM + d] = b[1]; wf[6 * DM + d] = b[2]; wf[7 * DM + d] = b[3]; }
        __syncthreads();
        f32x4 vnx[8];
        if (gw < TOK) {
#pragma unroll
            for (int j = 0; j < 8; ++j) vnx[j] = __builtin_nontemporal_load((const GAS f32x4*)(G_x + (size_t)gw * DM) + lane + 64 * j); }
        for (int m = gw; m < TOK; m += NGW) {
            const GAS f32x4* gr = (const GAS f32x4*)G_mix_norm + lane;
            f32x4 v[8]; float s = 0.f;
#pragma unroll
            for (int j = 0; j < 8; ++j) v[j] = vnx[j];
            if (m + NGW < TOK) {
#pragma unroll
                for (int j = 0; j < 8; ++j) vnx[j] = __builtin_nontemporal_load((const GAS f32x4*)(G_x + (size_t)(m + NGW) * DM) + lane + 64 * j); }
#pragma unroll
            for (int j = 0; j < 8; ++j) s += (v[j][0] * v[j][0] + v[j][1] * v[j][1]) + (v[j][2] * v[j][2] + v[j][3] * v[j][3]);
            const float rstd = __builtin_amdgcn_rsqf(wave_sum_dpp(s) * (1.f / DM) + EPS);
            GAS v2u* o8 = (GAS v2u*)(G_XN + (size_t)m * DM) + lane;
#pragma unroll
            for (int j = 0; j < 8; ++j) { const f32x4 gg = gr[64 * j]; v[j] = v[j] * rstd * gg;
                v2u o; o.x = pk2(v[j][0], v[j][1]); o.y = pk2(v[j][2], v[j][3]); o8[64 * j] = o; }
            float fl[8];
#pragma unroll
            for (int h = 0; h < 8; ++h) { float a = 0.f;
#pragma unroll
                for (int j = 0; j < 8; ++j) { const f32x4 w = *(const LAS f32x4*)(wf + h * DM + j * 256 + lane * 4); a += (v[j][0] * w[0] + v[j][1] * w[1]) + (v[j][2] * w[2] + v[j][3] * w[3]); }
                fl[h] = wave_sum_dpp(a);
                asm volatile("" ::: "memory"); }
            if (lane < 8) { float f = fl[0];
#pragma unroll
                for (int h = 1; h < 8; ++h) f = (lane == h) ? fl[h] : f;
                f += G_b_forget[lane];
                const float ls = fminf(f, 0.f) - log1pf(expf(-fabsf(f)));
                const int b = m / SEQ, sq = m % SEQ; G_LF[(size_t)(b * FOXH + lane) * SEQ + sq] = ls; }
        }
        {
            constexpr int I_IN = (DM / 64) * (4096 / 32), I_SQ = (DM / 64) * (DM / 32);
            constexpr int NITEMS = I_IN + 3 * I_SQ;
#define TR_SRC(it_, W_, ldw_, nblk_, r_) do { r_ = (it_); if (r_ < I_IN) { W_ = G_w_in; ldw_ = INC; nblk_ = 4096 / 32; } else { r_ -= I_IN; ldw_ = DM; nblk_ = DM / 32; \
        if (r_ < I_SQ) W_ = G_w_out; else if (r_ < 2 * I_SQ) { W_ = G_xwk; r_ -= I_SQ; } else { W_ = G_xwv; r_ -= 2 * I_SQ; } } } while (0)
            f32x4 tvn[8]; const float* Wn; int ldwn, nblkn, rn;
            if (0 + gw < I_IN) { TR_SRC(0 + gw, Wn, ldwn, nblkn, rn); tr_load(Wn, ldwn, nblkn, rn, lane, tvn); }
            for (int it = 0 + gw; it < I_IN; it += NGW) {
                f32x4 tvc[8];
#pragma unroll
                for (int i = 0; i < 8; ++i) tvc[i] = tvn[i];
                const int nblkc = nblkn, rc = rn;
                if (it + NGW < I_IN) { TR_SRC(it + NGW, Wn, ldwn, nblkn, rn); tr_load(Wn, ldwn, nblkn, rn, lane, tvn); }
                int r = it;
                if (r < I_IN) { tr_store(tvc, nblkc, G_W_IN, nullptr, 0, DM, scr, rc, lane); continue; } r -= I_IN;
                if (r < I_SQ) { tr_store(tvc, nblkc, G_WO1, G_WO2, POOLW, DM, scr, rc, lane); continue; } r -= I_SQ;
                if (r < I_SQ) { tr_store(tvc, nblkc, G_WK, nullptr, 0, DM, scr, rc, lane); continue; }
                tr_store(tvc, nblkc, G_WV, nullptr, 0, DM, scr, rc, lane);
            }
#undef TR_SRC
        }
        __syncthreads();
    }
    SEAM(0);

    if (IN(1)) for (int rep_ = 0; rep_ < (((DUP_MASK >> 1) & 1) ? args.pad + 1 : 1); ++rep_) {
        if (bx & 1)
        {
            int oz_ = 0; asm volatile("" : "+s"(oz_));
            const int gwb = gw + oz_, gtb = gt + oz_;
            LAS float* scr = (LAS float*)(ldsL + 65536 + wave * 8704);
        for (int m = gwb; m < BATCH * NMEM; m += NGW) {
            const GAS f32x4* xr = (const GAS f32x4*)(G_mem + (size_t)m * DM) + lane; const GAS f32x4* gr = (const GAS f32x4*)G_mem_norm + lane;
            f32x4 v[8]; float s = 0.f;
#pragma unroll
            for (int j = 0; j < 8; ++j) { v[j] = xr[64 * j]; s += (v[j][0] * v[j][0] + v[j][1] * v[j][1]) + (v[j][2] * v[j][2] + v[j][3] * v[j][3]); }
            const float rstd = __builtin_amdgcn_rsqf(wave_sum_dpp(s) * (1.f / DM) + EPS);
            GAS v2u* o8 = (GAS v2u*)(G_MN + (size_t)m * DM) + lane;
#pragma unroll
            for (int j = 0; j < 8; ++j) { const f32x4 gg = gr[64 * j]; v[j] = v[j] * rstd * gg; v2u o; o.x = pk2(v[j][0], v[j][1]); o.y = pk2(v[j][2], v[j][3]); o8[64 * j] = o; }
        }
        {
            constexpr int I_IN = (DM / 64) * (4096 / 32), I_SQ = (DM / 64) * (DM / 32);
            constexpr int NITEMS = I_IN + 3 * I_SQ;
#define TR_SRC(it_, W_, ldw_, nblk_, r_) do { r_ = (it_); if (r_ < I_IN) { W_ = G_w_in; ldw_ = INC; nblk_ = 4096 / 32; } else { r_ -= I_IN; ldw_ = DM; nblk_ = DM / 32; \
        if (r_ < I_SQ) W_ = G_w_out; else if (r_ < 2 * I_SQ) { W_ = G_xwk; r_ -= I_SQ; } else { W_ = G_xwv; r_ -= 2 * I_SQ; } } } while (0)
            for (int it = I_IN + gwb; it < NITEMS; it += NGW) {
                f32x4 tvc[8]; const float* Wn; int ldwn, nblkc, rc;
                TR_SRC(it, Wn, ldwn, nblkc, rc); tr_load(Wn, ldwn, nblkc, rc, lane, tvc);
                int r = it;
                if (r < I_IN) { tr_store(tvc, nblkc, G_W_IN, nullptr, 0, DM, scr, rc, lane); continue; } r -= I_IN;
                if (r < I_SQ) { tr_store(tvc, nblkc, G_WO1, G_WO2, POOLW, DM, scr, rc, lane); continue; } r -= I_SQ;
                if (r < I_SQ) { tr_store(tvc, nblkc, G_WK, nullptr, 0, DM, scr, rc, lane); continue; }
                tr_store(tvc, nblkc, G_WV, nullptr, 0, DM, scr, rc, lane);
            }
#undef TR_SRC
        }
        for (int i0 = gtb; i0 < DM * DM / 8; i0 += 2 * NGT) {
#pragma unroll
            for (int u = 0; u < 2; ++u) { const int i = i0 + u * NGT; if (i < DM * DM / 8) {
                const int d = i / (DM / 8);
                const v4u o1 = cvt8(G_peer_wq + (size_t)i * 8, G_peer_norm[d]);
                const v4u o2 = cvt8(G_xwq + (size_t)i * 8, G_xattn_norm[d]);
                *(GAS v4u*)(G_WPQ + (size_t)i * 8) = o1; *(GAS v4u*)(G_WQ + (size_t)i * 8) = o2; } }
        }
        for (int i = gtb; i < DM * 256 / 8; i += NGT) {
            const int r = i >> 5, c0 = (i & 31) * 8; const int hc = r >> 7;
            v4u o3 = {0u, 0u, 0u, 0u}; if ((c0 >> 7) == (hc & 1)) o3 = cvt8(G_sub_keys + (size_t)r * 128 + (c0 & 127), 1.f);
            *(GAS v4u*)(G_AEXP + (size_t)i * 8) = o3; }
        for (int i = gtb; i < 4 * 256 * 256 / 8; i += NGT) {
            const int g = i / (256 * 256 / 8), d0 = (i % 32) * 8; const float* ps = G_pool_scale + g * 256 + d0; const float* p = G_pool_w + (size_t)i * 8;
            v4u o; o.x = pk2(p[0] * ps[0], p[1] * ps[1]); o.y = pk2(p[2] * ps[2], p[3] * ps[3]); o.z = pk2(p[4] * ps[4], p[5] * ps[5]); o.w = pk2(p[6] * ps[6], p[7] * ps[7]);
            *(GAS v4u*)(G_PB + (size_t)i * 8) = o; }
            __syncthreads();
        }
        { pg8::Gemm g{G_XN, G_W_IN, DM, DM, DM}; pg8::SubSched SS; SS.S.init(TOK / 256, 4096 / 256, G, bx, DM, DM); SS.i0 = 0;
          pg8::EpiStoreT<true> E{G_PROJ, 4096, 0, 0, 1, nullptr, 1.f, 4, 8, 0.08838834764831845f * LOG2E, (unsigned*)G_ctl + CW_NRM};
          pg8::gemm_phase<pg8::EpiStoreT<true>, pg8::SubSched, true>(ldsL, g, SS, E); }
        if (!(bx & 1))
        {
            int oz_ = 0; asm volatile("" : "+s"(oz_));
            const int gwb = gw + oz_, gtb = gt + oz_;
            LAS float* scr = (LAS float*)(ldsL + 65536 + wave * 8704);
        for (int m = gwb; m < BATCH * NMEM; m += NGW) {
            const GAS f32x4* xr = (const GAS f32x4*)(G_mem + (size_t)m * DM) + lane; const GAS f32x4* gr = (const GAS f32x4*)G_mem_norm + lane;
            f32x4 v[8]; float s = 0.f;
#pragma unroll
            for (int j = 0; j < 8; ++j) { v[j] = xr[64 * j]; s += (v[j][0] * v[j][0] + v[j][1] * v[j][1]) + (v[j][2] * v[j][2] + v[j][3] * v[j][3]); }
            const float rstd = __builtin_amdgcn_rsqf(wave_sum_dpp(s) * (1.f / DM) + EPS);
            GAS v2u* o8 = (GAS v2u*)(G_MN + (size_t)m * DM) + lane;
#pragma unroll
            for (int j = 0; j < 8; ++j) { const f32x4 gg = gr[64 * j]; v[j] = v[j] * rstd * gg; v2u o; o.x = pk2(v[j][0], v[j][1]); o.y = pk2(v[j][2], v[j][3]); o8[64 * j] = o; }
        }
        {
            constexpr int I_IN = (DM / 64) * (4096 / 32), I_SQ = (DM / 64) * (DM / 32);
            constexpr int NITEMS = I_IN + 3 * I_SQ;
#define TR_SRC(it_, W_, ldw_, nblk_, r_) do { r_ = (it_); if (r_ < I_IN) { W_ = G_w_in; ldw_ = INC; nblk_ = 4096 / 32; } else { r_ -= I_IN; ldw_ = DM; nblk_ = DM / 32; \
        if (r_ < I_SQ) W_ = G_w_out; else if (r_ < 2 * I_SQ) { W_ = G_xwk; r_ -= I_SQ; } else { W_ = G_xwv; r_ -= 2 * I_SQ; } } } while (0)
            for (int it = I_IN + gwb; it < NITEMS; it += NGW) {
                f32x4 tvc[8]; const float* Wn; int ldwn, nblkc, rc;
                TR_SRC(it, Wn, ldwn, nblkc, rc); tr_load(Wn, ldwn, nblkc, rc, lane, tvc);
                int r = it;
                if (r < I_IN) { tr_store(tvc, nblkc, G_W_IN, nullptr, 0, DM, scr, rc, lane); continue; } r -= I_IN;
                if (r < I_SQ) { tr_store(tvc, nblkc, G_WO1, G_WO2, POOLW, DM, scr, rc, lane); continue; } r -= I_SQ;
                if (r < I_SQ) { tr_store(tvc, nblkc, G_WK, nullptr, 0, DM, scr, rc, lane); continue; }
                tr_store(tvc, nblkc, G_WV, nullptr, 0, DM, scr, rc, lane);
            }
#undef TR_SRC
        }
        for (int i0 = gtb; i0 < DM * DM / 8; i0 += 2 * NGT) {
#pragma unroll
            for (int u = 0; u < 2; ++u) { const int i = i0 + u * NGT; if (i < DM * DM / 8) {
                const int d = i / (DM / 8);
                const v4u o1 = cvt8(G_peer_wq + (size_t)i * 8, G_peer_norm[d]);
                const v4u o2 = cvt8(G_xwq + (size_t)i * 8, G_xattn_norm[d]);
                *(GAS v4u*)(G_WPQ + (size_t)i * 8) = o1; *(GAS v4u*)(G_WQ + (size_t)i * 8) = o2; } }
        }
        for (int i = gtb; i < DM * 256 / 8; i += NGT) {
            const int r = i >> 5, c0 = (i & 31) * 8; const int hc = r >> 7;
            v4u o3 = {0u, 0u, 0u, 0u}; if ((c0 >> 7) == (hc & 1)) o3 = cvt8(G_sub_keys + (size_t)r * 128 + (c0 & 127), 1.f);
            *(GAS v4u*)(G_AEXP + (size_t)i * 8) = o3; }
        for (int i = gtb; i < 4 * 256 * 256 / 8; i += NGT) {
            const int g = i / (256 * 256 / 8), d0 = (i % 32) * 8; const float* ps = G_pool_scale + g * 256 + d0; const float* p = G_pool_w + (size_t)i * 8;
            v4u o; o.x = pk2(p[0] * ps[0], p[1] * ps[1]); o.y = pk2(p[2] * ps[2], p[3] * ps[3]); o.z = pk2(p[4] * ps[4], p[5] * ps[5]); o.w = pk2(p[6] * ps[6], p[7] * ps[7]);
            *(GAS v4u*)(G_PB + (size_t)i * 8) = o; }
            __syncthreads();
        }
        { pg8::Gemm g{G_XN, G_W_IN, DM, DM, DM}; pg8::SubSched SS; SS.S.init(TOK / 256, 4096 / 256, G, bx, DM, DM); SS.i0 = 1;
          pg8::EpiStoreT<true> E{G_PROJ, 4096, 0, 0, 1, nullptr, 1.f, 4, 8, 0.08838834764831845f * LOG2E, (unsigned*)G_ctl + CW_NRM};
          pg8::gemm_phase<pg8::EpiStoreT<true>, pg8::SubSched, true>(ldsL, g, SS, E); }
    }
    SEAM(1);

    if (IN(2)) for (int rep_ = 0; rep_ < (((DUP_MASK >> 2) & 1) ? args.pad + 1 : 1); ++rep_) {
        for (int it = vcu; it < TOK / 32; it += G) {
            const int ch = (tid & 127) * 8, rsub = tid >> 7, r0 = it * 32 + rsub * 8, w = 2 << (ch >> 8);
            const int s0 = r0 % SEQ;
            float acc[8];
#pragma unroll
            for (int e = 0; e < 8; ++e) acc[e] = 0.f;
            for (int k = 1; k < w; ++k) { if (s0 - k >= 0) { const v4u v = *(const GAS v4u*)(G_PROJ + (size_t)(r0 - k) * 4096 + ch);
#pragma unroll
                    for (int e = 0; e < 4; ++e) { acc[2 * e] += __uint_as_float(v[e] << 16); acc[2 * e + 1] += __uint_as_float(v[e] & 0xffff0000u); } } }
            for (int rr = 0; rr < 8; ++rr) {
                const v4u v = *(const GAS v4u*)(G_PROJ + (size_t)(r0 + rr) * 4096 + ch); float cur[8];
#pragma unroll
                for (int e = 0; e < 4; ++e) { cur[2 * e] = __uint_as_float(v[e] << 16); cur[2 * e + 1] = __uint_as_float(v[e] & 0xffff0000u); }
                const int sp = s0 + rr; const float inv = 1.f / (float)((sp + 1 < w) ? sp + 1 : w);
                v4u o;
#pragma unroll
                for (int e = 0; e < 8; ++e) acc[e] += cur[e];
                o.x = pk2(acc[0] * inv - cur[0], acc[1] * inv - cur[1]); o.y = pk2(acc[2] * inv - cur[2], acc[3] * inv - cur[3]);
                o.z = pk2(acc[4] * inv - cur[4], acc[5] * inv - cur[5]); o.w = pk2(acc[6] * inv - cur[6], acc[7] * inv - cur[7]);
                *(GAS v4u*)(G_AMIX + (size_t)(r0 + rr) * DM + ch) = o;
                if (sp - w + 1 >= 0) { const v4u vo = *(const GAS v4u*)(G_PROJ + (size_t)(r0 + rr - w + 1) * 4096 + ch);
#pragma unroll
                    for (int e = 0; e < 4; ++e) { acc[2 * e] -= __uint_as_float(vo[e] << 16); acc[2 * e + 1] -= __uint_as_float(vo[e] & 0xffff0000u); } }
            }
        }
        const int a_bh = vcu >> 4, a_qb = vcu & 15;
        if (a_qb < 8 && vcu < 256) {
            const int e = a_qb < 2 ? a_bh * 2 + a_qb : 32 + a_bh * 6 + (a_qb - 2);
            pg8::Gemm g; pg8::EpiStore E{nullptr, DM, 0, 0, 1, nullptr, 1.f, 0, 0, 1.f, nullptr};
            int pm, pn;
            if (e < 16)      { pm = e >> 3; pn = e & 7; g = pg8::Gemm{G_MN, G_WK, DM, DM, DM}; E.O = G_KX; E.ldc = DM; }
            else if (e < 32) { const int q = e - 16; pm = q >> 3; pn = q & 7; g = pg8::Gemm{G_MN, G_WV, DM, DM, DM}; E.O = G_VXT; E.ldc = DM; }
            else if (e < 96) { const int q = e - 32; pm = q >> 3; pn = q & 7; g = pg8::Gemm{G_AEXP, G_WPQ + pm * 256, 256, 256, DM}; E.O = G_WSC; E.ldc = DM; }
            else             { const int q = e - 96; const int gg = q >> 3; pm = q & 7; pn = 0;
                               g = pg8::Gemm{G_WO1 + gg * 256, G_PB + (size_t)gg * 65536, 256, DM, 256}; E.O = G_WO2 + gg * 256; E.ldc = DM; }
            const pg8::OneSched S1{pm, pn, (long)pm * 256 * g.lda, (long)pn * 256 * g.ldb};
            pg8::gemm_phase<pg8::EpiStore, pg8::OneSched, false>(ldsL, g, S1, E);
        }
        if (vcu < 256) {
            const int b = a_bh >> 3, h = a_bh & 7;
            float* c_lds = (float*)(lds + fox::LDS_C);
            if (wave == 0) {
                const float* lf = G_LF + (size_t)a_bh * SEQ + lane * 64; float loc[64]; float run = 0.f;
#pragma unroll
                for (int i = 0; i < 16; ++i) { const f32x4 v = *(const f32x4*)(lf + 4 * i);
#pragma unroll
                    for (int e = 0; e < 4; ++e) { run += v[e]; loc[4 * i + e] = run; } }
                float incl = run;
#pragma unroll
                for (int o = 1; o < 64; o <<= 1) { const float t = __shfl_up(incl, o); if (lane >= o) incl += t; }
                const float excl = incl - run;
#pragma unroll
                for (int i = 0; i < 16; ++i) { f32x4 v;
#pragma unroll
                    for (int e = 0; e < 4; ++e) v[e] = (loc[4 * i + e] + excl) * LOG2E;
                    *(f32x4*)(c_lds + lane * 64 + 4 * i) = v; }
            }
            __syncthreads();
            const bf16* Qb = G_PROJ + (size_t)(b * SEQ) * 4096 + 1024 + h * 128;
            fox::BlockRef cur{Qb + (size_t)(a_qb * 256) * 4096, Qb + 1024, Qb + 2048, G_AMIX + (size_t)(b * SEQ + a_qb * 256) * DM + 1024 + h * 128, a_qb * 256};
            int j_lo = 0;
            { const unsigned* nq = (const unsigned*)G_ctl + CW_NRM + (b * 8 + h) * 4; const unsigned* nk = nq + 64; float B = 0.f;
#pragma unroll
              for (int c4 = 0; c4 < 4; ++c4) B += sqrtf(__uint_as_float(__hip_atomic_load(nq + c4, __ATOMIC_RELAXED, __HIP_MEMORY_SCOPE_AGENT)) * __uint_as_float(__hip_atomic_load(nk + c4, __ATOMIC_RELAXED, __HIP_MEMORY_SCOPE_AGENT)));
              const float thr = 2.05f * B + c_lds[a_qb * 256] + 150.f;
              while (j_lo < a_qb * 4 && c_lds[64 * j_lo + 63] > thr) ++j_lo; }
            fox::Seam S;
            fox::prime(cur, j_lo, (char*)lds, S);
            fox::block(cur, cur, j_lo, (char*)lds, S);
            asm volatile("s_waitcnt vmcnt(0)" ::: "memory");
            __syncthreads();
        }
        {
            constexpr int C_T = (DM / 64) * (DM / 32) / 8, NCHUNK = C_T + QSPLIT;
            LAS float* scr = (LAS float*)(ldsL + wave * 8704);
            __syncthreads();
            if (tid == 0) MISC[16] = atomicAdd(G_ctl + CW_QUEUE, 1u);
            for (int par = 0;; par ^= 1) {
                __syncthreads();
                const int c = (int)MISC[16 + par];
                if (c >= NCHUNK) break;
                unsigned nxt_ = 0u; if (tid == 0) nxt_ = atomicAdd(G_ctl + CW_QUEUE, 1u);
                if (c < C_T) { p0_transpose_item(G_xwo, DM, DM / 32, nullptr, G_WO, nullptr, 0, DM, scr, c * 8 + wave, lane); }
                else { TABLE_CHUNK(c - C_T); }
                if (tid == 0) MISC[17 - par] = nxt_;
            }
        }
    }
    SEAM(2);

    if (IN(3)) for (int rep_ = 0; rep_ < (((DUP_MASK >> 3) & 1) ? args.pad + 1 : 1); ++rep_) {
        if (bx < 64) {
            const int f = bx & 63, b = f >> 5, h = (f >> 3) & 3, t = f & 7;
            pg8::Gemm g{G_KX + (size_t)(b * NMEM) * DM + h * XD, G_WQ + h * XD, XD, DM, DM};
            pg8::EpiStore E{G_W1 + (size_t)(b * 1024 + h * 256) * DM, DM, 0, 0, 1, nullptr, 1.f, 0, 0, 1.f, nullptr};
            const pg8::OneSched S1{0, t, 0, (long)t * 256 * DM};
            pg8::gemm_phase<pg8::EpiStore, pg8::OneSched, false>(ldsL, g, S1, E);
        }
        { pg8::Gemm g{G_AMIX, G_WO2, DM, DM, DM}; pg8::GSched S; S.init(TOK / 256, DM / 256, G, bx, DM, DM);
          pg8::EpiResid<false> E{G_x, G_HB, rep_ ? nullptr : G_SS1, 0};
          pg8::gemm_phase<pg8::EpiResid<false>, pg8::GSched, true>(ldsL, g, S, E); }
    }
    SEAM(3);

    if (IN(4)) for (int rep_ = 0; rep_ < (((DUP_MASK >> 4) & 1) ? args.pad + 1 : 1); ++rep_) {
        pg8::Gemm g{G_HB, G_W1, DM, DM, DM}; pg8::GSched S; S.init(SEQ / 256, XH, G, bx, DM, DM);
        S.nH = 1; S.nZ = BATCH; S.sAb = (long)SEQ * DM; S.sBb = (long)1024 * DM;
        pg8::EpiSoftmax E{G_PP, 1024, (long)SEQ * 1024, 0, 1, G_SS1, 0.044194173824159216f * LOG2E, SEQ};
        pg8::gemm_phase<pg8::EpiSoftmax, pg8::GSched, false>(ldsL, g, S, E);
        if (bx >= 128 && bx < 192) {
            const int f = bx & 63, b = f >> 5, h = (f >> 3) & 3, t = f & 7;
            pg8::Gemm g2{G_WO + h * XD, G_VXT + (size_t)(b * NMEM) * DM + h * XD, XD, DM, DM};
            pg8::EpiStore E2{G_W2 + (size_t)b * DM * 1024 + h * 256, 1024, 0, 0, 1, nullptr, 1.f, 0, 0, 1.f, nullptr};
            const pg8::OneSched S2{t, 0, (long)t * 256 * DM, 0};
            pg8::gemm_phase<pg8::EpiStore, pg8::OneSched, false>(ldsL, g2, S2, E2);
        }
        for (;;) {
            __syncthreads();
            if (tid == 0) MISC[16] = atomicAdd(G_ctl + CW_QUEUE2, 1u);
            __syncthreads();
            const int c = (int)MISC[16] + QSPLIT;
            if (c >= 2 * PEXP / 32) break;
            TABLE_CHUNK(c);
        }
    }
    SEAM(4);

    if (IN(5)) for (int rep_ = 0; rep_ < (((DUP_MASK >> 5) & 1) ? args.pad + 1 : 1); ++rep_) {
        pg8::Gemm g{G_PP, G_W2, 1024, 1024, 1024}; pg8::GSched S; S.init(SEQ / 256, DM / 256, G, bx, 1024, 1024);
        S.nH = 1; S.nZ = BATCH; S.sAb = (long)SEQ * 1024; S.sBb = (long)DM * 1024;
        pg8::EpiResid<true> E{G_HB, G_HB, G_SS2, SEQ};
        pg8::gemm_phase<pg8::EpiResid<true>, pg8::GSched, true>(ldsL, g, S, E);
    }
    SEAM(5);

    if (IN(6)) for (int rep_ = 0; rep_ < (((DUP_MASK >> 6) & 1) ? args.pad + 1 : 1); ++rep_) {
        pg8::Gemm g{G_WSC, G_HB, DM, DM, DM}; pg8::GSched S; S.init(DM / 256, TOK / 256, G, bx, DM, DM);
        pg8::EpiF32Col E{G_SCT, TOK, G_SS2};
        pg8::gemm_phase<pg8::EpiF32Col, pg8::GSched, true>(ldsL, g, S, E);
    }
    SEAM(6);

#if defined(PROBE_SEL) && PROBE_SEL >= 7
    if (bx == 0 && tid == 0) __hip_atomic_store((unsigned long long*)(G_ctl + 258), (unsigned long long)__builtin_amdgcn_s_memrealtime(), __ATOMIC_RELAXED, __HIP_MEMORY_SCOPE_AGENT);
#endif
    if (IN(7)) for (int rep_ = 0; rep_ < (((DUP_MASK >> 7) & 1) ? args.pad + 1 : 1); ++rep_) {
        LAS unsigned* TOP1 = (LAS unsigned*)ldsL;
        LAS unsigned* RIDX = (LAS unsigned*)(ldsL + 32768);
        LAS float* RGATE = (LAS float*)(ldsL + 49152);
        for (int blk = vcu; blk < TOK / 32; blk += G) {
            const int t0 = blk * 32;
            {
                const int tok = tid & 31, grp = tid >> 5;
                const float* sp = G_SCT + ((size_t)blk * DM + grp * 128) * 32 + tok;
                unsigned lst[16];
#pragma unroll
                for (int j = 0; j < 16; ++j) lst[j] = 0u;
                for (int i0 = 0; i0 < 128; i0 += 32) {
                    float v[32];
#pragma unroll
                    for (int e = 0; e < 32; ++e) v[e] = __builtin_nontemporal_load(sp + (i0 + e) * 32);
#pragma unroll
                    for (int c16 = 0; c16 < 2; ++c16) { unsigned nw[16];
#pragma unroll
                        for (int e = 0; e < 16; ++e) nw[e] = (fkey(v[c16 * 16 + e]) & ~127u) | (unsigned)(127 - (i0 + c16 * 16 + e));
#pragma unroll
                        for (int k = 2; k <= 16; k <<= 1)
#pragma unroll
                            for (int j = k >> 1; j > 0; j >>= 1)
#pragma unroll
                                for (int i = 0; i < 16; ++i) { const int l = i ^ j; if (l > i) { const unsigned lo_ = min(nw[i], nw[l]), hi_ = max(nw[i], nw[l]); if ((i & k) == 0) { nw[i] = lo_; nw[l] = hi_; } else { nw[i] = hi_; nw[l] = lo_; } } }
#pragma unroll
                        for (int i = 0; i < 16; ++i) lst[i] = max(lst[i], nw[i]);
#pragma unroll
                        for (int j = 8; j > 0; j >>= 1)
#pragma unroll
                            for (int i = 0; i < 16; ++i) { const int l = i ^ j; if (l > i) { const unsigned lo_ = min(lst[i], lst[l]), hi_ = max(lst[i], lst[l]); lst[i] = hi_; lst[l] = lo_; } } }
                }
                LAS unsigned* dst = TOP1 + (tok * 16 + grp) * 16;
#pragma unroll
                for (int j = 0; j < 16; j += 4) *(LAS v4u*)(dst + j) = (v4u){lst[j], lst[j + 1], lst[j + 2], lst[j + 3]};
            }
            __syncthreads();
            if (tid < 256) {
                const int tok = tid & 31, head = tid >> 5;
                const LAS unsigned* ka = TOP1 + (tok * 16 + head * 2) * 16; const LAS unsigned* kb = ka + 16;
                float af[16], bfv[16];
#pragma unroll
                for (int j = 0; j < 16; ++j) { af[j] = fdec(ka[j] & ~127u); bfv[j] = fdec(kb[j] & ~127u); }
                unsigned best[16];
#pragma unroll
                for (int j = 0; j < 16; ++j) best[j] = 0u;
#pragma unroll
                for (int i = 0; i < 16; ++i)
#pragma unroll
                    for (int j = 0; j < 16; ++j) if ((i + 1) * (j + 1) <= 16) {
                        unsigned xk = (fkey(af[i] + bfv[j]) & ~255u) | (unsigned)(255 - (i * 16 + j));
#pragma unroll
                        for (int q = 0; q < 16; ++q) { const unsigned hi_ = max(best[q], xk); xk = min(best[q], xk); best[q] = hi_; } }
                float ev[16]; const float m0 = fdec(best[0] & ~255u); float sum = 0.f;
#pragma unroll
                for (int q = 0; q < 16; ++q) { ev[q] = __expf(fdec(best[q] & ~255u) - m0); sum += ev[q]; }
                const float inv = 1.f / sum;
#pragma unroll
                for (int q = 0; q < 16; ++q) { const unsigned code = 255u - (best[q] & 255u); const unsigned i = code >> 4, j = code & 15u;
                    const unsigned ia = 127u - (ka[i] & 127u), ib = 127u - (kb[j] & 127u);
                    RIDX[tok * 128 + head * 16 + q] = ia * 128u + ib; RGATE[tok * 128 + head * 16 + q] = ev[q] * inv; }
            }
            __syncthreads();
            {
                LAS unsigned* SIDX = (LAS unsigned*)ldsL; LAS unsigned* SGATE = (LAS unsigned*)(ldsL + 16384);
                const int tok = tid >> 4; const LAS unsigned* src = RIDX + tok * 128;
                unsigned mine[8]; unsigned rank[8];
#pragma unroll
                for (int i = 0; i < 8; ++i) { mine[i] = (src[(tid & 15) + 16 * i] << 7) | (unsigned)((tid & 15) + 16 * i); rank[i] = 0u; }
                for (int j0 = 0; j0 < 128; j0 += 4) { const v4u o4 = *(const LAS v4u*)(src + j0);
#pragma unroll
                    for (int jj = 0; jj < 4; ++jj) { const unsigned oj = ((jj == 0 ? o4.x : jj == 1 ? o4.y : jj == 2 ? o4.z : o4.w) << 7) | (unsigned)(j0 + jj);
#pragma unroll
                        for (int i = 0; i < 8; ++i) rank[i] += (oj < mine[i]) ? 1u : 0u; } }
#pragma unroll
                for (int i = 0; i < 8; ++i) mine[i] >>= 7;
#pragma unroll
                for (int i = 0; i < 8; ++i) { const unsigned pos = rank[i];
                    SIDX[tok * 128 + pos] = mine[i];
                    const float su_ = G_SU[mine[i]], gs_ = RGATE[tok * 128 + (tid & 15) + 16 * i] * G_SV[mine[i]];
                    SGATE[tok * 128 + pos] = (__float_as_uint(su_) & 0xffff0000u) | f2bf(gs_); }
            }
            __syncthreads();
            {
                const int tok0 = wave * 4; const size_t tg0 = (size_t)(t0 + tok0);
                LAS float* Wl = (LAS float*)(ldsL + 32768) + tok0 * 128;
                typedef short v2s_t __attribute__((ext_vector_type(2)));
                LAS unsigned* XB = (LAS unsigned*)(ldsL + 65536) + tok0 * 512;
#define XNLOAD(T_) do { const float rs = __builtin_amdgcn_rsqf(G_SS2[tg0 + (T_)] * (1.f / DM) + EPS); unsigned xb_[8]; \
        _Pragma("unroll") for (int q = 0; q < 8; ++q) { const size_t d0 = (size_t)q * 256 + lane * 4; \
            const v2u ha = *(const GAS v2u*)(G_HB + (tg0 + (T_)) * DM + d0); const f32x4 ga = *(const f32x4*)(G_peer_norm + d0); \
            v2s_t r_ = {0, 0}; r_ = __builtin_amdgcn_cvt_scalef32_pk_fp8_f32(r_, __uint_as_float(ha.x << 16) * rs * ga[0], __uint_as_float(ha.x & 0xffff0000u) * rs * ga[1], 1.0f, false); \
            r_ = __builtin_amdgcn_cvt_scalef32_pk_fp8_f32(r_, __uint_as_float(ha.y << 16) * rs * ga[2], __uint_as_float(ha.y & 0xffff0000u) * rs * ga[3], 1.0f, true); xb_[q] = __builtin_bit_cast(unsigned, r_); } \
        *(LAS v4u*)(XB + ((T_) * 64 + lane) * 8) = (v4u){xb_[0], xb_[1], xb_[2], xb_[3]}; *(LAS v4u*)(XB + ((T_) * 64 + lane) * 8 + 4) = (v4u){xb_[4], xb_[5], xb_[6], xb_[7]}; } while (0)
                XNLOAD(0); XNLOAD(1); XNLOAD(2); XNLOAD(3);
#undef XNLOAD
                v8i_t xB0, xB1, xB2, xB3;
#define XBLD(T_, XBV) do { const LAS unsigned* p_ = XB + (T_) * 512 + (((lane >> 5) * 16 + (lane & 15)) * 8) + ((lane >> 4) & 1) * 4; const v4u lo_ = *(const LAS v4u*)p_, hi_ = *(const LAS v4u*)(p_ + 256); \
        XBV = (v8i_t){(int)lo_.x, (int)lo_.y, (int)lo_.z, (int)lo_.w, (int)hi_.x, (int)hi_.y, (int)hi_.z, (int)hi_.w}; } while (0)
                XBLD(0, xB0); XBLD(1, xB1); XBLD(2, xB2); XBLD(3, xB3);
#undef XBLD
                const float dm0 = ((lane & 15) == (lane >> 4) * 4) ? 1.f : 0.f, dm1 = ((lane & 15) == (lane >> 4) * 4 + 1) ? 1.f : 0.f, dm2 = ((lane & 15) == (lane >> 4) * 4 + 2) ? 1.f : 0.f, dm3 = ((lane & 15) == (lane >> 4) * 4 + 3) ? 1.f : 0.f;
                const LAS unsigned* ridx0 = (const LAS unsigned*)ldsL + tok0 * 128; const LAS unsigned* rgs0 = (const LAS unsigned*)(ldsL + 16384) + tok0 * 128;
                const __amdgpu_buffer_rsrc_t rsT = __builtin_amdgcn_make_buffer_rsrc((void*)G_UB, 0, 64 << 20, 0x00020000);
                v4u raX0, raX1, raX2, raX3, raY0, raY1, raY2, raY3; v2u rbX0, rbX1, rbX2, rbX3, rbY0, rbY1, rbY2, rbY3;
                unsigned sgX0, sgX1, sgX2, sgX3, sgY0, sgY1, sgY2, sgY3;
#define PLDU(S, T, k) do { const unsigned ex_ = (unsigned)__builtin_amdgcn_readfirstlane((int)ridx0[(T) * 128 + (k)]); sg##S = rgs0[(T) * 128 + (k)]; \
        ra##S = __builtin_bit_cast(v4u, __builtin_amdgcn_raw_buffer_load_b128(rsT, lane * 16, ex_ * 1024u, 0)); } while (0)
                const int rowl = lane >> 4; const int wl_off = (rowl == 0 ? 0 : rowl == 1 ? 256 : rowl == 2 ? 128 : 384);
#define STEP1(C, P, k, HASNEXT) do { \
        const f32x4 e0_ = peer_mfma(ra##C##0, xB0); \
        const f32x4 e1_ = peer_mfma(ra##C##1, xB1); \
        const f32x4 e2_ = peer_mfma(ra##C##2, xB2); \
        const f32x4 e3_ = peer_mfma(ra##C##3, xB3); \
        const float d0_ = (e0_[0] * dm0 + e0_[1] * dm1) + (e0_[2] * dm2 + e0_[3] * dm3), d1_ = (e1_[0] * dm0 + e1_[1] * dm1) + (e1_[2] * dm2 + e1_[3] * dm3); \
        const float d2_ = (e2_[0] * dm0 + e2_[1] * dm1) + (e2_[2] * dm2 + e2_[3] * dm3), d3_ = (e3_[0] * dm0 + e3_[1] * dm1) + (e3_[2] * dm2 + e3_[3] * dm3); \
        const unsigned sgr_ = rowl == 0 ? sg##C##0 : rowl == 1 ? sg##C##2 : rowl == 2 ? sg##C##1 : sg##C##3; \
        if (HASNEXT) { PLDU(P##0, 0, (k) + 1); PLDU(P##1, 1, (k) + 1); PLDU(P##2, 2, (k) + 1); PLDU(P##3, 3, (k) + 1); } \
        const auto s01_ = __builtin_amdgcn_permlane32_swap(__float_as_uint(d0_), __float_as_uint(d1_), false, false); const auto s23_ = __builtin_amdgcn_permlane32_swap(__float_as_uint(d2_), __float_as_uint(d3_), false, false); \
        const float p_ = __uint_as_float(s01_[0]) + __uint_as_float(s01_[1]), q_ = __uint_as_float(s23_[0]) + __uint_as_float(s23_[1]); \
        const auto spq_ = __builtin_amdgcn_permlane16_swap(__float_as_uint(p_), __float_as_uint(q_), false, false); \
        float r_ = __uint_as_float(spq_[0]) + __uint_as_float(spq_[1]); \
        r_ += __builtin_bit_cast(float, __builtin_amdgcn_update_dpp(0, __builtin_bit_cast(int, r_), 0xB1, 0xf, 0xf, true)); r_ += __builtin_bit_cast(float, __builtin_amdgcn_update_dpp(0, __builtin_bit_cast(int, r_), 0x4E, 0xf, 0xf, true)); \
        r_ += __builtin_bit_cast(float, __builtin_amdgcn_update_dpp(0, __builtin_bit_cast(int, r_), 0x141, 0xf, 0xf, true)); r_ += __builtin_bit_cast(float, __builtin_amdgcn_update_dpp(0, __builtin_bit_cast(int, r_), 0x140, 0xf, 0xf, true)); \
        const float w_ = gelu_f(r_ * __uint_as_float(sgr_ & 0xffff0000u)) * __uint_as_float(sgr_ << 16); \
        if ((lane & 15) == 0) Wl[wl_off + (k)] = w_; } while (0)
                PLDU(X0, 0, 0); PLDU(X1, 1, 0); PLDU(X2, 2, 0); PLDU(X3, 3, 0);
                for (int k = 0; k < 126; k += 2) { STEP1(X, Y, k, true); STEP1(Y, X, k + 1, true); }
                STEP1(X, Y, 126, true); STEP1(Y, X, 127, false);
#undef PLDU
#undef STEP1
#define PLDV(S, T, k) do { const unsigned ex_ = (unsigned)__builtin_amdgcn_readfirstlane((int)ridx0[(T) * 128 + (k)]); \
        ra##S = __builtin_bit_cast(v4u, __builtin_amdgcn_raw_buffer_load_b128(rsT, lane * 16, ex_ * 1024u + (32u << 20), 0)); } while (0)
#define STEP2(C, N, k, HASNEXT) do { asm volatile("" ::: "memory");     \
        if (HASNEXT) { PLDV(N##0, 0, (k) + 2); PLDV(N##1, 1, (k) + 2); PLDV(N##2, 2, (k) + 2); PLDV(N##3, 3, (k) + 2); } \
        const float w0_ = Wl[(k)], w1_ = Wl[128 + (k)], w2_ = Wl[256 + (k)], w3_ = Wl[384 + (k)]; \
        peer_axpy_h4(ra##C##0, w0_, oh0); peer_axpy_h4(ra##C##1, w1_, oh1); peer_axpy_h4(ra##C##2, w2_, oh2); peer_axpy_h4(ra##C##3, w3_, oh3); } while (0)
                unsigned oh0[16], oh1[16], oh2[16], oh3[16];
                v4u raZ0, raZ1, raZ2, raZ3; v2u rbZ0, rbZ1, rbZ2, rbZ3;
#pragma unroll
                for (int e = 0; e < 16; ++e) { oh0[e] = 0u; oh1[e] = 0u; oh2[e] = 0u; oh3[e] = 0u; }
                PLDV(X0, 0, 0); PLDV(X1, 1, 0); PLDV(X2, 2, 0); PLDV(X3, 3, 0); PLDV(Y0, 0, 1); PLDV(Y1, 1, 1); PLDV(Y2, 2, 1); PLDV(Y3, 3, 1);
#pragma unroll 1
                for (int k = 0; k < 126; k += 3) { STEP2(X, Z, k, true); STEP2(Y, X, k + 1, true); STEP2(Z, Y, k + 2, true); }
                STEP2(X, Z, 126, false); STEP2(Y, X, 127, false);
                v2u hbr[4][8];
#pragma unroll
                for (int T = 0; T < 4; ++T)
#pragma unroll
                    for (int q = 0; q < 8; ++q) hbr[T][q] = *(const GAS v2u*)(G_HB + (tg0 + T) * DM + (size_t)q * 256 + lane * 4);
#define FINISH(T_, OH) do { float y_[32]; float s_ = 0.f; \
        _Pragma("unroll") for (int q = 0; q < 8; ++q) { const v2u hb = hbr[T_][q]; \
            const float a0 = __uint_as_float(hb.x << 16), a1 = __uint_as_float(hb.x & 0xffff0000u), a2 = __uint_as_float(hb.y << 16), a3 = __uint_as_float(hb.y & 0xffff0000u); \
            y_[q * 4] = a0 + h16lo(OH[q * 2]); y_[q * 4 + 1] = a1 + h16hi(OH[q * 2]); y_[q * 4 + 2] = a2 + h16lo(OH[q * 2 + 1]); y_[q * 4 + 3] = a3 + h16hi(OH[q * 2 + 1]); \
            s_ += (y_[q * 4] * y_[q * 4] + y_[q * 4 + 1] * y_[q * 4 + 1]) + (y_[q * 4 + 2] * y_[q * 4 + 2] + y_[q * 4 + 3] * y_[q * 4 + 3]); } \
        const float rstd_ = __builtin_amdgcn_rsqf(wave_sum_dpp(s_) * (1.f / DM) + EPS); \
        _Pragma("unroll") for (int q = 0; q < 8; ++q) { const size_t d0 = (size_t)q * 256 + lane * 4; const f32x4 ga = *(const f32x4*)(G_final_norm + d0); f32x4 o; \
            _Pragma("unroll") for (int e = 0; e < 4; ++e) o[e] = y_[q * 4 + e] * rstd_ * ga[e]; \
            PROBE_EXPORT(tg0 + (T_), q); \
            __builtin_nontemporal_store(o, (f32x4*)(args.out + (tg0 + (T_)) * DM + d0)); } } while (0)
                FINISH(0, oh0); FINISH(1, oh1); FINISH(2, oh2); FINISH(3, oh3);
#undef FINISH
#undef PLDV
#undef STEP2
            }
            __syncthreads();
#if defined(PROBE_SEL) && PROBE_SEL >= 7
            asm volatile("s_waitcnt vmcnt(0)" ::: "memory"); __syncthreads();
            if (tid == 0) { __threadfence(); const unsigned old_ = atomicAdd(G_ctl + 192, 1u);
                if (old_ == (unsigned)G - 1u) { __threadfence(); const unsigned long long a_ = __hip_atomic_load((unsigned long long*)(G_ctl + 256 + 2 * (PROBE_SEL - 7)), __ATOMIC_RELAXED, __HIP_MEMORY_SCOPE_AGENT), b_ = __builtin_amdgcn_s_memrealtime();
                    atomicAdd(args.out + (size_t)31 * DM, (float)(b_ - a_) * 0.0001f); } }
#endif
        }
    }
#undef IN
#undef SEAM
#undef G_ws
#undef G_ctl
#undef G_x
#undef G_mem
#undef G_mix_norm
#undef G_w_in
#undef G_b_forget
#undef G_pool_w
#undef G_pool_scale
#undef G_w_out
#undef G_xattn_norm
#undef G_mem_norm
#undef G_xwq
#undef G_xwk
#undef G_xwv
#undef G_xwo
#undef G_peer_norm
#undef G_peer_wq
#undef G_sub_keys
#undef G_peer_u
#undef G_peer_v
#undef G_final_norm
#undef G_W_IN
#undef G_WO1
#undef G_WO2
#undef G_WQ
#undef G_WK
#undef G_WV
#undef G_WO
#undef G_WPQ
#undef G_AEXP
#undef G_W1
#undef G_W2
#undef G_WSC
#undef G_PB
#undef G_MN
#undef G_KX
#undef G_VXT
#undef G_UB
#undef G_VB
#undef G_SU
#undef G_SV
#undef G_XN
#undef G_QX
#undef G_PROJ
#undef G_SCT
#undef G_AMIX
#undef G_OX
#undef G_H
#undef G_HB
#undef G_PP
#undef G_LF
#undef G_SS1
#undef G_SS2

}

constexpr int N_PHASES = 8;
extern "C" void kernel_launch(void* const* d_in, const int* in_sizes, int n_in, void* d_out, int out_size, void* d_ws, size_t ws_size, hipStream_t stream) {
    static int grid = 0;
    if (grid == 0) {
        if (n_in != 20 || in_sizes[0] != TOK * DM || out_size != TOK * DM || ws_size < WS_END) {
            fprintf(stderr, "kernel_launch: unexpected shapes (n_in %d, in0 %d, out %d, ws %zu < %zu)\n", n_in, n_in > 0 ? in_sizes[0] : -1, out_size, ws_size, (size_t)WS_END); grid = -1; return; }
        int dev = 0, cus = 0, per_cu = 0;
        if (hipGetDevice(&dev) != hipSuccess || hipDeviceGetAttribute(&cus, hipDeviceAttributeMultiprocessorCount, dev) != hipSuccess) { grid = -1; return; }
        if (hipFuncSetAttribute((const void*)fwd_kernel, hipFuncAttributeMaxDynamicSharedMemorySize, LDS_BYTES) != hipSuccess) { fprintf(stderr, "kernel_launch: hipFuncSetAttribute failed\n"); grid = -1; return; }
        if (hipOccupancyMaxActiveBlocksPerMultiprocessor(&per_cu, (const void*)fwd_kernel, NTHREADS, LDS_BYTES) != hipSuccess || per_cu < 1) { fprintf(stderr, "kernel_launch: occupancy query says %d\n", per_cu); per_cu = 1; }
        (void)hipGetLastError();
        grid = cus;
        if (grid != 256) fprintf(stderr, "kernel_launch: %d CUs (built for 256)\n", grid);
    }
    if (grid < 0) return;
    (void)hipMemsetAsync((char*)d_ws + WS_CTL, 0, CTL_ZERO_BYTES, stream);
    Args a{};
    for (int i = 0; i < 20; ++i) a.in[i] = (const float*)d_in[i];
    a.out = (float*)d_out; a.ws = (unsigned char*)d_ws; a.pad = DUP_MASK ? 1 : 0;
#if MK_ONE_LAUNCH
    a.ph_lo = 0; a.ph_hi = N_PHASES; a.one_launch = 1;
    void* kargs[] = {&a};
    hipError_t e = hipLaunchCooperativeKernel((const void*)fwd_kernel, dim3(grid), dim3(NTHREADS), kargs, LDS_BYTES, stream);
    if (e != hipSuccess) fprintf(stderr, "kernel_launch: cooperative launch failed: %s\n", hipGetErrorString(e));
#else
    for (int p = 0; p < N_PHASES; ++p) {
        a.ph_lo = p; a.ph_hi = p + 1; a.one_launch = 0;
        hipLaunchKernelGGL(fwd_kernel, dim3(grid), dim3(NTHREADS), LDS_BYTES, stream, a);
    }
#endif
}
```
